# Optimizing an MI355X kernel written in HIP

```python
import math
import jax, jax.numpy as jnp
from jax import lax
import numpy as np

D_MODEL = 1024
BATCH = 8
SEQ = 4096
DEPTH = 1

CHUNK = 64
S5_WIDTH = 512
S5_GROUP = 16
S5_GROUPS = S5_WIDTH // S5_GROUP
S5_STATE = 64
DA_HEADS = 8
DA_HEAD_DIM = 64
DA_WIDTH = DA_HEADS * 2 * DA_HEAD_DIM
Q_BLOCK = 128
N_BRANCH = 2
IN_WIDTH = S5_WIDTH + 3 * DA_WIDTH + N_BRANCH * D_MODEL
N_GROUPS = 4
EXP_PER_GROUP = 8
N_EXPERTS = N_GROUPS * EXP_PER_GROUP
D_EXPERT = 256
TOP_K = 2
N_MOD = 6
EPS = 1e-6

kernel_name = "hybrid_s5_diffattn_hmoe_block"


def rms_norm(x, g):
    xf = x.astype(jnp.float32)
    y = xf * lax.rsqrt(jnp.mean(xf * xf, axis=-1, keepdims=True) + EPS)
    return (y * g.astype(jnp.float32)).astype(x.dtype)


def _complex_affine_combine(e1, e2):
    a1r, a1i, b1r, b1i = e1
    a2r, a2i, b2r, b2i = e2
    ar = a2r * a1r - a2i * a1i
    ai = a2r * a1i + a2i * a1r
    br = a2r * b1r - a2i * b1i + b2r
    bi = a2r * b1i + a2i * b1r + b2i
    return (ar, ai, br, bi)


def s5_branch(u, a_re, a_im, b_re, b_im, c_re, c_im, d_skip, log_dt, w_glu, b_glu):
    nb, L, _ = u.shape
    uf = u.astype(jnp.float32)
    ug = uf.reshape(nb, L, S5_GROUPS, S5_GROUP)
    dt = jnp.exp(log_dt.astype(jnp.float32))[:, None]
    lr = a_re.astype(jnp.float32)
    li = a_im.astype(jnp.float32)
    mag = jnp.exp(lr * dt)
    abar_re = mag * jnp.cos(li * dt)
    abar_im = mag * jnp.sin(li * dt)
    den = lr * lr + li * li
    nr = abar_re - 1.0
    f_re = (nr * lr + abar_im * li) / den
    f_im = (abar_im * lr - nr * li) / den
    bb_re = f_re[..., None] * b_re - f_im[..., None] * b_im
    bb_im = f_re[..., None] * b_im + f_im[..., None] * b_re
    bu_re = jnp.einsum('blgc,gpc->blgp', ug, bb_re)
    bu_im = jnp.einsum('blgc,gpc->blgp', ug, bb_im)
    a_seq_re = jnp.broadcast_to(abar_re[None, None], (1, L, S5_GROUPS, S5_STATE))
    a_seq_im = jnp.broadcast_to(abar_im[None, None], (1, L, S5_GROUPS, S5_STATE))
    _, _, x_re, x_im = lax.associative_scan(
        _complex_affine_combine, (a_seq_re, a_seq_im, bu_re, bu_im), axis=1)
    y = (jnp.einsum('blgp,gcp->blgc', x_re, c_re)
         - jnp.einsum('blgp,gcp->blgc', x_im, c_im))
    y = y.reshape(nb, L, S5_WIDTH) + d_skip * uf
    y = jax.nn.gelu(y)
    y = y * jax.nn.sigmoid(y @ w_glu + b_glu)
    return y.astype(u.dtype)


def diff_attention(q, k, v, lq1, lk1, lq2, lk2, g_subln, lambda_init):
    nb, L, _ = q.shape
    q = q.reshape(nb, L, DA_HEADS, 2, DA_HEAD_DIM)
    k = k.reshape(nb, L, DA_HEADS, 2, DA_HEAD_DIM)
    v = v.reshape(nb, L, DA_HEADS, 2 * DA_HEAD_DIM)
    lam = (jnp.exp(jnp.sum(lq1.astype(jnp.float32) * lk1.astype(jnp.float32)))
           - jnp.exp(jnp.sum(lq2.astype(jnp.float32) * lk2.astype(jnp.float32)))
           + lambda_init)
    n_blk = L // Q_BLOCK
    qb = q.reshape(nb, n_blk, Q_BLOCK, DA_HEADS, 2, DA_HEAD_DIM).swapaxes(0, 1)
    k_chunk = jnp.arange(L) // CHUNK
    scale = DA_HEAD_DIM ** -0.5

    def one_block(args):
        q_blk, i = args
        s = jnp.einsum('bqhmd,bkhmd->bhmqk', q_blk, k).astype(jnp.float32) * scale
        q_chunk = (i * Q_BLOCK + jnp.arange(Q_BLOCK)) // CHUNK
        mask = k_chunk[None, :] <= q_chunk[:, None]
        s = jnp.where(mask, s, -jnp.inf)
        p = jax.nn.softmax(s, axis=-1)
        attn = p[:, :, 0] - lam * p[:, :, 1]
        return jnp.einsum('bhqk,bkhe->bqhe', attn.astype(v.dtype), v)

    o = lax.map(one_block, (qb, jnp.arange(n_blk)))
    o = o.swapaxes(0, 1).reshape(nb, L, DA_HEADS, 2 * DA_HEAD_DIM)
    o = rms_norm(o, g_subln) * (1.0 - lambda_init)
    return o.reshape(nb, L, DA_WIDTH)


def hier_moe(u, w_rg, b_rg, w_re, b_re, w_g, w_u, w_d):
    nb, L, D = u.shape
    t = u.reshape(nb * L, D)
    grp_prob = jax.nn.softmax((t @ w_rg + b_rg).astype(jnp.float32), axis=-1)
    gp, gi = lax.top_k(grp_prob, 1)
    exp_logits = (t @ w_re + b_re).astype(jnp.float32).reshape(-1, N_GROUPS, EXP_PER_GROUP)
    in_grp = jnp.take_along_axis(exp_logits, gi[:, :, None], axis=1)[:, 0]
    top_v, top_i = lax.top_k(in_grp, TOP_K)
    w = jax.nn.softmax(top_v, axis=-1) * gp
    eid = gi * EXP_PER_GROUP + top_i
    combine = jnp.einsum('tk,tke->te', w,
                         jax.nn.one_hot(eid, N_EXPERTS, dtype=jnp.float32)).astype(u.dtype)

    def expert_step(acc, params):
        wg, wu, wd, cw = params
        hdn = jax.nn.silu(t @ wg) * (t @ wu)
        return acc + cw[:, None] * (hdn @ wd), None

    y, _ = lax.scan(expert_step, jnp.zeros_like(t), (w_g, w_u, w_d, combine.T))
    return y.reshape(nb, L, D)


def setup_inputs(seed: int = 0) -> dict:
    key = jax.random.key(seed)
    ks = iter(jax.random.split(key, 40))
    f32 = jnp.float32

    def nrm(shape, scale):
        return jax.random.normal(next(ks), shape, f32) * scale

    def gain(shape):
        return 1.0 + nrm(shape, 0.01)

    n_idx = jnp.arange(S5_STATE, dtype=f32)
    return {
        "x": nrm((BATCH, SEQ, D_MODEL), 1.0),
        "c": nrm((BATCH, D_MODEL), 1.0),
        "w_ada": nrm((DEPTH, D_MODEL, N_MOD * D_MODEL), 0.5 * D_MODEL ** -0.5),
        "b_ada": nrm((DEPTH, N_MOD * D_MODEL), 0.01),
        "g_norm_mix": gain((DEPTH, D_MODEL)),
        "w_in": nrm((DEPTH, D_MODEL, IN_WIDTH), D_MODEL ** -0.5),
        "b_in": nrm((DEPTH, IN_WIDTH), 0.01),
        "s5_a_re": -0.5 + nrm((DEPTH, S5_GROUPS, S5_STATE), 0.01),
        "s5_a_im": math.pi * n_idx + nrm((DEPTH, S5_GROUPS, S5_STATE), 0.01),
        "s5_b_re": nrm((DEPTH, S5_GROUPS, S5_STATE, S5_GROUP), (2 * S5_GROUP) ** -0.5),
        "s5_b_im": nrm((DEPTH, S5_GROUPS, S5_STATE, S5_GROUP), (2 * S5_GROUP) ** -0.5),
        "s5_c_re": nrm((DEPTH, S5_GROUPS, S5_GROUP, S5_STATE), S5_STATE ** -0.5),
        "s5_c_im": nrm((DEPTH, S5_GROUPS, S5_GROUP, S5_STATE), S5_STATE ** -0.5),
        "s5_d": nrm((DEPTH, S5_WIDTH), 1.0),
        "s5_log_dt": jax.random.uniform(next(ks), (DEPTH, S5_GROUPS), f32,
                                        minval=math.log(1e-3), maxval=math.log(1e-1)),
        "w_glu": nrm((DEPTH, S5_WIDTH, S5_WIDTH), S5_WIDTH ** -0.5),
        "b_glu": nrm((DEPTH, S5_WIDTH), 0.01),
        "lambda_q1": nrm((DEPTH, DA_HEAD_DIM), 0.1),
        "lambda_k1": nrm((DEPTH, DA_HEAD_DIM), 0.1),
        "lambda_q2": nrm((DEPTH, DA_HEAD_DIM), 0.1),
        "lambda_k2": nrm((DEPTH, DA_HEAD_DIM), 0.1),
        "g_subln": gain((DEPTH, 2 * DA_HEAD_DIM)),
        "w_br_ssm": nrm((DEPTH, S5_WIDTH, D_MODEL), S5_WIDTH ** -0.5),
        "w_br_attn": nrm((DEPTH, DA_WIDTH, D_MODEL), DA_WIDTH ** -0.5),
        "w_out": nrm((DEPTH, D_MODEL, D_MODEL), D_MODEL ** -0.5),
        "g_norm_ffn": gain((DEPTH, D_MODEL)),
        "w_router_grp": nrm((DEPTH, D_MODEL, N_GROUPS), D_MODEL ** -0.5),
        "b_router_grp": nrm((DEPTH, N_GROUPS), 0.01),
        "w_router_exp": nrm((DEPTH, D_MODEL, N_EXPERTS), D_MODEL ** -0.5),
        "b_router_exp": nrm((DEPTH, N_EXPERTS), 0.01),
        "w_exp_gate": nrm((DEPTH, N_EXPERTS, D_MODEL, D_EXPERT), D_MODEL ** -0.5),
        "w_exp_up": nrm((DEPTH, N_EXPERTS, D_MODEL, D_EXPERT), D_MODEL ** -0.5),
        "w_exp_down": nrm((DEPTH, N_EXPERTS, D_EXPERT, D_MODEL), D_EXPERT ** -0.5),
        "g_final": gain((D_MODEL,)),
    }


def reference(x, c, w_ada, b_ada, g_norm_mix, w_in, b_in,
              s5_a_re, s5_a_im, s5_b_re, s5_b_im, s5_c_re, s5_c_im, s5_d, s5_log_dt,
              w_glu, b_glu, lambda_q1, lambda_k1, lambda_q2, lambda_k2, g_subln,
              w_br_ssm, w_br_attn, w_out, g_norm_ffn,
              w_router_grp, b_router_grp, w_router_exp, b_router_exp,
              w_exp_gate, w_exp_up, w_exp_down, g_final):
    h = x
    cs = jax.nn.silu(c)
    splits = [S5_WIDTH, S5_WIDTH + DA_WIDTH, S5_WIDTH + 2 * DA_WIDTH, S5_WIDTH + 3 * DA_WIDTH]
    for l in range(DEPTH):
        lambda_init = 0.8 - 0.6 * math.exp(-0.3 * l)
        mod = (cs @ w_ada[l] + b_ada[l])[:, None, :]
        sh_m, sc_m, gt_m, sh_f, sc_f, gt_f = jnp.split(mod, N_MOD, axis=-1)

        u = rms_norm(h, g_norm_mix[l]) * (1.0 + sc_m) + sh_m
        proj = u @ w_in[l] + b_in[l]
        s5_in, q, k, v, gates = jnp.split(proj, splits, axis=-1)
        y_ssm = s5_branch(s5_in, s5_a_re[l], s5_a_im[l], s5_b_re[l], s5_b_im[l],
                          s5_c_re[l], s5_c_im[l], s5_d[l], s5_log_dt[l],
                          w_glu[l], b_glu[l]) @ w_br_ssm[l]
        y_att = diff_attention(q, k, v, lambda_q1[l], lambda_k1[l], lambda_q2[l],
                               lambda_k2[l], g_subln[l], lambda_init) @ w_br_attn[l]
        g_ssm, g_att = jnp.split(jax.nn.sigmoid(gates), N_BRANCH, axis=-1)
        mix = (g_ssm * y_ssm + g_att * y_att) @ w_out[l]
        h = h + gt_m * mix

        u = rms_norm(h, g_norm_ffn[l]) * (1.0 + sc_f) + sh_f
        ffn = hier_moe(u, w_router_grp[l], b_router_grp[l], w_router_exp[l], b_router_exp[l],
                       w_exp_gate[l], w_exp_up[l], w_exp_down[l])
        h = h + gt_f * ffn
    return rms_norm(h, g_final)
```

```cpp
#include <hip/hip_runtime.h>
#include <hip/hip_bf16.h>
#include <cstdio>
#include <cstdint>
#include <cmath>

#ifndef DBG_STAGE
#define DBG_STAGE 0
#endif

constexpr int D = 1024, NB = 8, SEQ = 4096, T = NB * SEQ;
constexpr int S5W = 512, NG = 32, NP = 64, INW = 5632;
constexpr int LC = 32, NCH = SEQ / LC, NRC = T / LC, KS = LC * 16, KY = KS + 128;
constexpr int NEXP = 32, DEXP = 256;
constexpr int XS_ROWS = 2 * T + NEXP * 256;
constexpr float EPS = 1e-6f;
constexpr float LAMBDA_INIT = 0.2f;

namespace pg8 {
#define PG8_LAS __attribute__((address_space(3)))
typedef unsigned short bf16_t;
typedef short bf16x8 __attribute__((ext_vector_type(8)));
typedef float f32x4 __attribute__((ext_vector_type(4)));
typedef unsigned u32x4 __attribute__((ext_vector_type(4)));
typedef float f32x2 __attribute__((ext_vector_type(2)));
constexpr int BM = 256, BK = 64, HALF = 128, HTB = HALF * BK * 2, STAGE_BYTES = 8 * HTB, NXCD = 8, WGM = 8;

__host__ __device__ __forceinline__ int lds_byte(int r, int c) { const int st = (r >> 4) * 2 + (c >> 5), rr = r & 15, cc = c & 31, ob = rr * 64 + cc * 2; return st * 1024 + (ob ^ (((ob >> 9) & 1) << 5)); }
__host__ __device__ __forceinline__ void stage_rc(int b, int& R, int& C) { const int st = b / 1024, sb = b % 1024, swz = sb ^ (((sb >> 9) & 1) << 5); R = (st >> 1) * 16 + swz / 64; C = (st & 1) * 32 + (swz % 64) / 2; }
__host__ __device__ __forceinline__ int perm32(int rho) { const int n = rho >> 4, i = rho & 15; return 8 * (i >> 2) + 4 * n + (i & 3); }

struct Unit { int pm, pn, g; const char* a; const char* b; };

struct StaticOrder {
    int nM, nN, nwg, G, c; const char* A; const char* B; size_t tsa, tsb;
    __device__ void init(const void* A_, int lda, const void* B_, int ldb, int M, int N, int G_, int c_) { nM = M / BM; nN = N / BM; nwg = nM * nN; G = G_; c = c_; A = (const char*)A_; B = (const char*)B_; tsa = (size_t)BM * lda * 2; tsb = (size_t)BM * ldb * 2; }
    __device__ bool next(int i, Unit& u) const {
        const long L = (long)i * G + c; if (L >= nwg) return false;
        int wgid = (int)L; { const int q = nwg / NXCD, r = nwg % NXCD, xcd = wgid % NXCD, off = wgid / NXCD; wgid = (xcd < r ? xcd * (q + 1) : r * (q + 1) + (xcd - r) * q) + off; }
        const int nig = WGM * nN, gid = wgid / nig, fm = gid * WGM, gsz = (nM - fm) < WGM ? (nM - fm) : WGM;
        u.pm = fm + ((wgid % nig) % gsz); u.pn = (wgid % nig) / gsz; u.g = 0; u.a = A + (size_t)u.pm * tsa; u.b = B + (size_t)u.pn * tsb; return true;
    }
};
struct GroupOrder {
    int nM, nN, ng, G, c; const char* A; const char* B; size_t tsa, tsb, gsa, gsb;
    __device__ void init(const void* A_, int lda, size_t gsa_, const void* B_, int ldb, size_t gsb_, int Mg, int Ng, int ng_, int G_, int c_) {
        nM = Mg / BM; nN = Ng / BM; ng = ng_; G = G_; c = c_; A = (const char*)A_; B = (const char*)B_; tsa = (size_t)BM * lda * 2; tsb = (size_t)BM * ldb * 2; gsa = gsa_; gsb = gsb_; }
    __device__ bool next(int i, Unit& u) const {
        const long L = (long)i * G + c; if (L >= (long)ng * nM * nN) return false;
        const int per = nM * nN, g = (int)(L / per), r = (int)(L % per);
        u.g = g; u.pm = r / nN; u.pn = r % nN; u.a = A + (size_t)g * gsa + (size_t)u.pm * tsa; u.b = B + (size_t)g * gsb + (size_t)u.pn * tsb; return true;
    }
};
struct ExpertOrder {
    const PG8_LAS int* tab; int nN, G, c; const char* A; const char* B; size_t tsa, tsb, esb;
    __device__ void init(const PG8_LAS int* tab_, const void* A_, int lda, const void* B_, int ldb, size_t esb_, int N, int G_, int c_) {
        tab = tab_; nN = N / BM; G = G_; c = c_; A = (const char*)A_; B = (const char*)B_; tsa = (size_t)BM * lda * 2; tsb = (size_t)BM * ldb * 2; esb = esb_; }
    __device__ bool next(int i, Unit& u) const {
        const long L = (long)i * G + c; int rt = (int)(L / nN); const int pn = (int)(L % nN);
        if (rt > XS_ROWS / 256) rt = XS_ROWS / 256;
        const int e = __builtin_amdgcn_readfirstlane(tab[rt]);
        if (e < 0) return false;
        u.g = e; u.pm = rt; u.pn = pn; u.a = A + (size_t)rt * tsa; u.b = B + (size_t)e * esb + (size_t)pn * tsb; return true;
    }
};

__device__ __forceinline__ unsigned cvt_pk_bf16(float lo, float hi) { unsigned r; asm volatile("v_cvt_pk_bf16_f32 %0, %1, %2" : "=v"(r) : "v"(lo), "v"(hi)); return r; }
__device__ __forceinline__ float bf_lo(unsigned w) { return __uint_as_float(w << 16); }
__device__ __forceinline__ float bf_hi(unsigned w) { return __uint_as_float(w & 0xffff0000u); }
__device__ __forceinline__ float sigmoidf_(float x) { return __builtin_amdgcn_rcpf(1.0f + __builtin_amdgcn_exp2f(-1.4426950408889634f * x)); }
__device__ __forceinline__ void unpack8(const u32x4 w, float (&f)[8]) { f[0] = bf_lo(w.x); f[1] = bf_hi(w.x); f[2] = bf_lo(w.y); f[3] = bf_hi(w.y); f[4] = bf_lo(w.z); f[5] = bf_hi(w.z); f[6] = bf_lo(w.w); f[7] = bf_hi(w.w); }
__device__ __forceinline__ u32x4 pack8(const float (&f)[8]) { u32x4 w; w.x = cvt_pk_bf16(f[0], f[1]); w.y = cvt_pk_bf16(f[2], f[3]); w.z = cvt_pk_bf16(f[4], f[5]); w.w = cvt_pk_bf16(f[6], f[7]); return w; }

#define EPI_LOOP_PERM(...) \
    _Pragma("unroll") for (int ai = 0; ai < 2; ++ai) _Pragma("unroll") for (int m = 0; m < 4; ++m) { const int lrow = ai * HALF + wr * 64 + m * 16 + fr; \
        _Pragma("unroll") for (int bj = 0; bj < 2; ++bj) { const int lcol = bj * HALF + wc * 32 + 8 * fq; \
            float v[8] = {acc[ai][bj][m][0][0], acc[ai][bj][m][0][1], acc[ai][bj][m][0][2], acc[ai][bj][m][0][3], acc[ai][bj][m][1][0], acc[ai][bj][m][1][1], acc[ai][bj][m][1][2], acc[ai][bj][m][1][3]}; __VA_ARGS__ } }

struct EpiProj {
    static constexpr bool PERM = true, AFTER_DRAIN = false;
    const float* bias; bf16_t* U; bf16_t* Q; bf16_t* Kb; bf16_t* V; bf16_t* Gt; float c2;
    __device__ __forceinline__ void operator()(const f32x4 (&acc)[2][2][4][2], const Unit& u, int wr, int wc, int fr, int fq) const {
        const int ct = u.pn;
        EPI_LOOP_PERM({
            const int row = u.pm * BM + lrow, col = ct * BM + lcol;
            const f32x4 b0 = *(const f32x4*)(bias + col), b1 = *(const f32x4*)(bias + col + 4);
            v[0] += b0[0]; v[1] += b0[1]; v[2] += b0[2]; v[3] += b0[3]; v[4] += b1[0]; v[5] += b1[1]; v[6] += b1[2]; v[7] += b1[3];
            bf16_t* dst;
            if (ct < 2) { const int g = col >> 4, ci = col & 15, rc = row / LC, s = row % LC; dst = U + ((size_t)(g * NRC + rc) * KY + s * 16 + ci); }
            else if (ct < 6) { _Pragma("unroll") for (int i = 0; i < 8; ++i) v[i] *= c2; dst = Q + (size_t)row * D + (col - 512); }
            else if (ct < 10) { dst = Kb + (size_t)row * D + (col - 1536); }
            else if (ct < 14) { dst = V + (size_t)row * D + (col - 2560); }
            else { _Pragma("unroll") for (int i = 0; i < 8; ++i) v[i] = sigmoidf_(v[i]); dst = Gt + (size_t)row * 2048 + (col - 3584); }
            *(u32x4*)dst = pack8(v);
        })
    }
};
struct EpiStates {
    static constexpr bool PERM = false, AFTER_DRAIN = false;
    float* S;
    __device__ __forceinline__ void operator()(const f32x4 (&acc)[2][2][4][2], const Unit& u, int wr, int wc, int fr, int fq) const {
#pragma unroll
        for (int ai = 0; ai < 2; ++ai)
#pragma unroll
            for (int m = 0; m < 4; ++m) { const int row = u.pm * BM + ai * HALF + wr * 64 + m * 16 + fr;
#pragma unroll
                for (int n = 0; n < 2; ++n) { const f32x4 v = acc[ai][0][m][n] + acc[ai][1][m][n]; *(f32x4*)(S + ((size_t)(u.g * NRC + row) * 128 + wc * 32 + 16 * n + 4 * fq)) = v; } }
    }
};
struct EpiY {
    static constexpr bool PERM = true, AFTER_DRAIN = false;
    const bf16_t* U; const float* dskip; bf16_t* Y;
    __device__ __forceinline__ void operator()(const f32x4 (&acc)[2][2][4][2], const Unit& u, int wr, int wc, int fr, int fq) const {
        EPI_LOOP_PERM({
            const int rc = u.pm * BM + lrow, n = u.pn * BM + lcol, tt = n >> 4, co = n & 15;
            const u32x4 uw = *(const u32x4*)(U + ((size_t)(u.g * NRC + rc) * KY + n)); float uf[8]; unpack8(uw, uf);
            const f32x4 d0 = *(const f32x4*)(dskip + u.g * 16 + co), d1 = *(const f32x4*)(dskip + u.g * 16 + co + 4);
            const float dd[8] = {d0[0], d0[1], d0[2], d0[3], d1[0], d1[1], d1[2], d1[3]};
            _Pragma("unroll") for (int i = 0; i < 8; ++i) { const float y = v[i] + dd[i] * uf[i]; const float z = 1.5957691216057308f * (y + 0.044715f * y * y * y); v[i] = y * sigmoidf_(z); }
            *(u32x4*)(Y + ((size_t)(rc * LC + tt) * S5W + u.g * 16 + co)) = pack8(v);
        })
    }
};
struct EpiGlu {
    static constexpr bool PERM = true, AFTER_DRAIN = false;
    const bf16_t* Y; const float* bias; bf16_t* O;
    __device__ __forceinline__ void operator()(const f32x4 (&acc)[2][2][4][2], const Unit& u, int wr, int wc, int fr, int fq) const {
        EPI_LOOP_PERM({
            const int row = u.pm * BM + lrow, col = u.pn * BM + lcol;
            const u32x4 yw = *(const u32x4*)(Y + (size_t)row * S5W + col); float yf[8]; unpack8(yw, yf);
            const f32x4 b0 = *(const f32x4*)(bias + col), b1 = *(const f32x4*)(bias + col + 4);
            const float bb[8] = {b0[0], b0[1], b0[2], b0[3], b1[0], b1[1], b1[2], b1[3]};
            _Pragma("unroll") for (int i = 0; i < 8; ++i) v[i] = yf[i] * sigmoidf_(v[i] + bb[i]);
            *(u32x4*)(O + (size_t)row * S5W + col) = pack8(v);
        })
    }
};
template <int MODE> struct EpiBranch {
    static constexpr bool PERM = true, AFTER_DRAIN = false;
    const bf16_t* Gt; const bf16_t* Tin; bf16_t* O;
    __device__ __forceinline__ void operator()(const f32x4 (&acc)[2][2][4][2], const Unit& u, int wr, int wc, int fr, int fq) const {
        EPI_LOOP_PERM({
            const int row = u.pm * BM + lrow, col = u.pn * BM + lcol;
            const u32x4 gw = *(const u32x4*)(Gt + (size_t)row * 2048 + MODE * D + col); float gf[8]; unpack8(gw, gf);
            if (MODE == 1) { const u32x4 tw = *(const u32x4*)(Tin + (size_t)row * D + col); float tf[8]; unpack8(tw, tf);
                _Pragma("unroll") for (int i = 0; i < 8; ++i) v[i] = tf[i] + gf[i] * v[i]; }
            else { _Pragma("unroll") for (int i = 0; i < 8; ++i) v[i] = gf[i] * v[i]; }
            *(u32x4*)(O + (size_t)row * D + col) = pack8(v);
        })
    }
};
struct EpiOut {
    static constexpr bool PERM = false, AFTER_DRAIN = false;
    const float* x; const float* mod; float* H;
    __device__ __forceinline__ void operator()(const f32x4 (&acc)[2][2][4][2], const Unit& u, int wr, int wc, int fr, int fq) const {
        const int b = (u.pm * BM) / SEQ; const float* gt = mod + (size_t)b * 6 * D + 2 * D;
#pragma unroll
        for (int bj = 0; bj < 2; ++bj)
#pragma unroll
            for (int n = 0; n < 2; ++n) { const int col = u.pn * BM + bj * HALF + wc * 32 + 16 * n + 4 * fq; const f32x4 g = *(const f32x4*)(gt + col);
#pragma unroll
                for (int ai = 0; ai < 2; ++ai)
#pragma unroll
                    for (int m = 0; m < 4; ++m) { const size_t off = (size_t)(u.pm * BM + ai * HALF + wr * 64 + m * 16 + fr) * D + col;
                        const f32x4 xv = *(const f32x4*)(x + off); *(f32x4*)(H + off) = xv + g * acc[ai][bj][m][n]; } }
    }
};
struct EpiRouter {
    static constexpr bool PERM = false, AFTER_DRAIN = false;
    float* L;
    __device__ __forceinline__ void operator()(const f32x4 (&acc)[2][2][4][2], const Unit& u, int wr, int wc, int fr, int fq) const {
        if (wc < 2) {
#pragma unroll
            for (int ai = 0; ai < 2; ++ai)
#pragma unroll
                for (int m = 0; m < 4; ++m) { const int row = u.pm * BM + ai * HALF + wr * 64 + m * 16 + fr;
#pragma unroll
                    for (int n = 0; n < 2; ++n) { const f32x4 v = acc[ai][0][m][n] + acc[ai][1][m][n]; *(f32x4*)(L + (size_t)row * 64 + wc * 32 + 16 * n + 4 * fq) = v; } }
        }
    }
};
struct EpiExp1 {
    static constexpr bool PERM = true, AFTER_DRAIN = false;
    bf16_t* Hd;
    __device__ __forceinline__ void operator()(const f32x4 (&acc)[2][2][4][2], const Unit& u, int wr, int wc, int fr, int fq) const {
#pragma unroll
        for (int ai = 0; ai < 2; ++ai)
#pragma unroll
            for (int m = 0; m < 4; ++m) { const int row = u.pm * BM + ai * HALF + wr * 64 + m * 16 + fr; float v[8];
#pragma unroll
                for (int n = 0; n < 2; ++n)
#pragma unroll
                    for (int i = 0; i < 4; ++i) { const float g = acc[ai][0][m][n][i], up = acc[ai][1][m][n][i]; v[n * 4 + i] = g * sigmoidf_(g) * up; }
                *(u32x4*)(Hd + (size_t)row * DEXP + u.pn * HALF + wc * 32 + 8 * fq) = pack8(v); }
    }
};
struct EpiExp2 {
    static constexpr bool PERM = true, AFTER_DRAIN = false;
    const int* dest; const float* cw; bf16_t* Sl;
    __device__ __forceinline__ void operator()(const f32x4 (&acc)[2][2][4][2], const Unit& u, int wr, int wc, int fr, int fq) const {
        EPI_LOOP_PERM({
            const int row = u.pm * BM + lrow, col = u.pn * BM + lcol; const int d = dest[row]; const float w = cw[row];
            if (d >= 0) { _Pragma("unroll") for (int i = 0; i < 8; ++i) v[i] *= w; *(u32x4*)(Sl + (size_t)d * D + col) = pack8(v); }
        })
    }
};

template <class Epi, class Sched, bool ALIGN_EPI = false, bool SP2 = false>
__device__ __forceinline__ void gemm_phase(PG8_LAS unsigned char* lds, const int K, const int lda, const int ldb, const Sched& S, const Epi& E) {
    int tid = threadIdx.x; asm volatile("" : "+v"(tid));
    const int wid = __builtin_amdgcn_readfirstlane(tid >> 6), lane = tid & 63, wr = wid >> 2, wc = wid & 3, fr = lane & 15, fq = lane >> 4;
    const int nt = K / BK;
    unsigned voffA[2], voffB[2];
#pragma unroll
    for (int i = 0; i < 2; ++i) { int R, C; stage_rc(tid * 16 + i * 8192, R, C); const int Rb = Epi::PERM ? ((R & ~31) + perm32(R & 31)) : R;
        voffA[i] = (unsigned)(R * lda + C) * 2u; voffB[i] = (unsigned)(Rb * ldb + C) * 2u; }
    const size_t kstep = (size_t)(BK * 2);
    const size_t hstepA = (size_t)HALF * lda * 2, hstepB = (size_t)HALF * ldb * 2;
    const unsigned ldsw = (unsigned)wid * 1024u;
    const int aoff = lds_byte(wr * 64 + fr, fq * 8), boff = lds_byte(wc * 32 + fr, fq * 8);
#define PG8_SA(b, h) (((b) * 2 + (h)) * HTB)
#define PG8_SB(b, h) ((4 + (b) * 2 + (h)) * HTB)
#define PG8_STAGE(bufoff, gbase, voff) do { _Pragma("unroll") for (int _i = 0; _i < 2; ++_i) \
        __builtin_amdgcn_global_load_lds((const unsigned*)((const char*)(gbase) + (voff)[_i]), (PG8_LAS unsigned*)(lds + (bufoff) + ldsw + _i * 8192), 16, 0, 0); } while (0)
#define PG8_LDA(dst, b, h) do { _Pragma("unroll") for (int m = 0; m < 4; ++m) _Pragma("unroll") for (int k = 0; k < 2; ++k) dst[m][k] = *(const PG8_LAS bf16x8*)(lds + PG8_SA(b, h) + aoff + m * 2048 + k * 1024); } while (0)
#define PG8_LDB(dst, b, h) do { _Pragma("unroll") for (int n = 0; n < 2; ++n) _Pragma("unroll") for (int k = 0; k < 2; ++k) dst[n][k] = *(const PG8_LAS bf16x8*)(lds + PG8_SB(b, h) + boff + n * 2048 + k * 1024); } while (0)
#define PG8_MMA(ai, bj, At, Bt) do { __builtin_amdgcn_s_setprio(1); _Pragma("unroll") for (int m = 0; m < 4; ++m) _Pragma("unroll") for (int n = 0; n < 2; ++n) _Pragma("unroll") for (int k = 0; k < 2; ++k) \
        acc[ai][bj][m][n] = __builtin_amdgcn_mfma_f32_16x16x32_bf16(Bt[n][k], At[m][k], acc[ai][bj][m][n], 0, 0, 0); __builtin_amdgcn_s_setprio(0); } while (0)
#define PG8_WAIT_V(n) asm volatile("s_waitcnt vmcnt(" #n ")" ::: "memory")
#define PG8_WAIT_L(n) asm volatile("s_waitcnt lgkmcnt(" #n ")" ::: "memory")
#define PG8_BAR __builtin_amdgcn_s_barrier()
#define PG8_SCHED __builtin_amdgcn_sched_barrier(0)
    Unit cur, nxt; int ui = 0;
    if (!S.next(0, cur)) return;
    f32x4 acc[2][2][4][2];
#pragma unroll
    for (int a = 0; a < 2; ++a)
#pragma unroll
        for (int b = 0; b < 2; ++b)
#pragma unroll
            for (int m = 0; m < 4; ++m)
#pragma unroll
                for (int n = 0; n < 2; ++n) acc[a][b][m][n] = (f32x4){0.f, 0.f, 0.f, 0.f};
    bf16x8 At[4][2], B0[2][2], B1[2][2];
    const char* cA = cur.a; const char* cB = cur.b;
    if constexpr (SP2) {
        PG8_STAGE(PG8_SB(0, 0), cB, voffB); PG8_STAGE(PG8_SB(0, 1), cB + hstepB, voffB); PG8_STAGE(PG8_SA(0, 0), cA, voffA); PG8_STAGE(PG8_SA(0, 1), cA + hstepA, voffA);
        if (wr == 1) PG8_BAR;
        PG8_WAIT_V(2); PG8_BAR;
        PG8_STAGE(PG8_SB(1, 0), cB + kstep, voffB); PG8_STAGE(PG8_SA(1, 0), cA + kstep, voffA); PG8_STAGE(PG8_SB(1, 1), cB + hstepB + kstep, voffB);
        PG8_WAIT_V(6); PG8_BAR;
    } else {
        PG8_STAGE(PG8_SB(0, 0), cB, voffB); PG8_STAGE(PG8_SA(0, 0), cA, voffA); PG8_STAGE(PG8_SB(0, 1), cB + hstepB, voffB); PG8_STAGE(PG8_SA(0, 1), cA + hstepA, voffA);
        if (wr == 1) PG8_BAR;
        PG8_WAIT_V(4); PG8_BAR;
        PG8_STAGE(PG8_SB(1, 0), cB + kstep, voffB); PG8_STAGE(PG8_SA(1, 0), cA + kstep, voffA); PG8_STAGE(PG8_SB(1, 1), cB + hstepB + kstep, voffB);
        PG8_WAIT_V(6); PG8_BAR;
    }
    for (;;) {
        const bool has_next = S.next(ui + 1, nxt);
        const char* nA = has_next ? nxt.a : cA; const char* nB = has_next ? nxt.b : cB;
        for (int t = 0; t < nt; t += 2) {
            const bool last = (t == nt - 2);
            const char* a1 = cA + (size_t)(t + 1) * kstep;
            const char* a2 = last ? nA : cA + (size_t)(t + 2) * kstep; const char* b2 = last ? nB : cB + (size_t)(t + 2) * kstep;
            const char* a3 = a2 + kstep; const char* b3 = b2 + kstep;
            if constexpr (SP2) {
            PG8_LDB(B0, 0, 0); PG8_LDB(B1, 0, 1); PG8_SCHED; PG8_LDA(At, 0, 0); PG8_STAGE(PG8_SA(1, 1), a1 + hstepA, voffA);
            PG8_WAIT_V(8); PG8_WAIT_L(0); PG8_BAR; PG8_MMA(0, 0, At, B0); PG8_MMA(0, 1, At, B1); PG8_BAR; PG8_SCHED;
            PG8_LDA(At, 0, 1); PG8_STAGE(PG8_SB(0, 0), b2, voffB); PG8_STAGE(PG8_SB(0, 1), b2 + hstepB, voffB); PG8_STAGE(PG8_SA(0, 0), a2, voffA);
            PG8_WAIT_V(8); PG8_WAIT_L(0); PG8_BAR; PG8_MMA(1, 0, At, B0); PG8_MMA(1, 1, At, B1); PG8_BAR; PG8_SCHED;
            PG8_LDB(B0, 1, 0); PG8_LDB(B1, 1, 1); PG8_SCHED; PG8_LDA(At, 1, 0); PG8_STAGE(PG8_SA(0, 1), a2 + hstepA, voffA);
            PG8_WAIT_V(8); PG8_WAIT_L(0); PG8_BAR; PG8_MMA(0, 0, At, B0); PG8_MMA(0, 1, At, B1); PG8_BAR; PG8_SCHED;
            PG8_LDA(At, 1, 1); PG8_STAGE(PG8_SB(1, 0), b3, voffB); PG8_STAGE(PG8_SB(1, 1), b3 + hstepB, voffB); PG8_STAGE(PG8_SA(1, 0), a3, voffA);
            PG8_WAIT_V(8); PG8_WAIT_L(0); PG8_BAR; PG8_MMA(1, 0, At, B0); PG8_MMA(1, 1, At, B1); PG8_BAR; PG8_SCHED;
            } else {
            PG8_LDB(B0, 0, 0); PG8_SCHED; PG8_LDA(At, 0, 0); PG8_STAGE(PG8_SA(1, 1), a1 + hstepA, voffA);
            PG8_WAIT_L(8); PG8_BAR; PG8_WAIT_L(0); PG8_MMA(0, 0, At, B0); PG8_BAR; PG8_SCHED;
            PG8_LDB(B1, 0, 1); PG8_STAGE(PG8_SB(0, 0), b2, voffB);
            PG8_BAR; PG8_WAIT_L(0); PG8_MMA(0, 1, At, B1); PG8_BAR;
            PG8_LDA(At, 0, 1); PG8_STAGE(PG8_SA(0, 0), a2, voffA);
            PG8_BAR; PG8_WAIT_L(0); PG8_MMA(1, 0, At, B0); PG8_BAR; PG8_SCHED;
            PG8_STAGE(PG8_SB(0, 1), b2 + hstepB, voffB);
            PG8_WAIT_V(6); PG8_BAR; PG8_MMA(1, 1, At, B1); PG8_BAR;
            PG8_LDB(B0, 1, 0); PG8_SCHED; PG8_LDA(At, 1, 0); PG8_STAGE(PG8_SA(0, 1), a2 + hstepA, voffA);
            PG8_WAIT_L(8); PG8_BAR; PG8_WAIT_L(0); PG8_MMA(0, 0, At, B0); PG8_BAR; PG8_SCHED;
            PG8_LDB(B1, 1, 1); PG8_STAGE(PG8_SB(1, 0), b3, voffB);
            PG8_BAR; PG8_WAIT_L(0); PG8_MMA(0, 1, At, B1); PG8_BAR;
            PG8_LDA(At, 1, 1); PG8_STAGE(PG8_SA(1, 0), a3, voffA);
            PG8_BAR; PG8_WAIT_L(0); PG8_MMA(1, 0, At, B0); PG8_BAR; PG8_SCHED;
            PG8_STAGE(PG8_SB(1, 1), b3 + hstepB, voffB);
            PG8_WAIT_V(6); PG8_BAR; PG8_MMA(1, 1, At, B1); PG8_BAR;
            }
        }
        if constexpr (ALIGN_EPI) { if (wr == 0) PG8_BAR; }
        E(acc, cur, wr, wc, fr, fq);
        if (!has_next) break;
#pragma unroll
        for (int a = 0; a < 2; ++a)
#pragma unroll
            for (int b = 0; b < 2; ++b)
#pragma unroll
                for (int m = 0; m < 4; ++m)
#pragma unroll
                    for (int n = 0; n < 2; ++n) acc[a][b][m][n] = (f32x4){0.f, 0.f, 0.f, 0.f};
        cur = nxt; cA = nA; cB = nB; ++ui;
        if constexpr (ALIGN_EPI) { if (wr == 1) PG8_BAR; }
    }
    PG8_WAIT_V(0);
    if constexpr (!ALIGN_EPI) { if (wr == 0) PG8_BAR; }
    PG8_BAR;
#undef PG8_SA
#undef PG8_SB
#undef PG8_STAGE
#undef PG8_LDA
#undef PG8_LDB
#undef PG8_MMA
#undef PG8_WAIT_V
#undef PG8_WAIT_L
#undef PG8_BAR
#undef PG8_SCHED
}
}

namespace attn_body {
using bf16=__hip_bfloat16;
using bf16x8=__attribute__((ext_vector_type(8)))short;
using s16x4=__attribute__((ext_vector_type(4)))short;
using f32x16=__attribute__((ext_vector_type(16)))float;
using u32x4=__attribute__((ext_vector_type(4)))unsigned;
constexpr int NHEAD=16,SEQ=4096,D=64,DM=NHEAD*D;
constexpr int NW=8,QBLK=32,QB=QBLK*NW,KVBLK=64,NQB=SEQ/QB;
__device__ __forceinline__ int crow(int r,int hi){return (r&3)+8*(r>>2)+4*hi;}
#define SBAR() __builtin_amdgcn_sched_barrier(0)
__device__ __forceinline__ void cmask(f32x16&p0,f32x16&p1,int jb,int wid){
  const float NEG=-INFINITY;
  if(jb>(wid>>1)){
  #pragma unroll
  for(int r=0;r<16;++r){p0[r]=NEG;p1[r]=NEG;}}
}
constexpr int NSLOT=3, SLOTB=8192;
constexpr int LDS_K=0, LDS_V=NSLOT*SLOTB, LDS_WS=2*NSLOT*SLOTB, LDS_OST=LDS_WS+NW*64*4, LDS_BYTES=LDS_OST+NW*4096;
constexpr float C2=0.125f*1.4426950408889634f;
__device__ __forceinline__ void glds16(const void*gsrc,unsigned lds_dst){unsigned keep;
  asm volatile("s_mov_b32 %0, m0\n\ts_mov_b32 m0, %2\n\ts_nop 0\n\tglobal_load_lds_dwordx4 %1, off\n\ts_mov_b32 m0, %0":"=&s"(keep):"v"(gsrc),"s"(lds_dst):"memory");}
__device__ __forceinline__ float max3f(float a,float b,float c){float r;asm("v_max3_f32 %0, %1, %2, %3":"=v"(r):"v"(a),"v"(b),"v"(c));return r;}
__device__ __forceinline__ float max2f(float a,float b){float r;asm("v_max_f32_e32 %0, %1, %2":"=v"(r):"v"(a),"v"(b));return r;}
__device__ __forceinline__ float fadd_s(float a,float b){float r;asm("v_add_f32_e32 %0, %1, %2":"=v"(r):"v"(a),"v"(b));return r;}
__device__ __forceinline__ float fsub_s(float a,float b){float r;asm("v_sub_f32_e32 %0, %1, %2":"=v"(r):"v"(a),"v"(b));return r;}
typedef float f32x2_t __attribute__((ext_vector_type(2))); typedef __bf16 bf16x2_t __attribute__((ext_vector_type(2)));
__device__ __forceinline__ unsigned cvtpk_s(float lo,float hi){f32x2_t v={lo,hi};bf16x2_t b=__builtin_convertvector(v,bf16x2_t);return __builtin_bit_cast(unsigned,b);}
#define WAIT_BAR(N) asm volatile("s_waitcnt vmcnt(" #N ") lgkmcnt(0)\n\ts_barrier":::"memory")

__device__ __forceinline__ void qkt(f32x16&p0,f32x16&p1,const char*Kslot,const bf16x8*qr,const f32x16&negm,int r32,int hi){
  const char*kb=Kslot+hi*1024+r32*16;
  #pragma unroll
  for(int d0=0;d0<4;++d0){
    const bf16x8 b0=*reinterpret_cast<const bf16x8*>(kb+d0*2048);
    const bf16x8 b1=*reinterpret_cast<const bf16x8*>(kb+d0*2048+512);
    if(d0==0){p0=__builtin_amdgcn_mfma_f32_32x32x16_bf16(b0,qr[0],negm,0,0,0);p1=__builtin_amdgcn_mfma_f32_32x32x16_bf16(b1,qr[0],negm,0,0,0);}
    else{p0=__builtin_amdgcn_mfma_f32_32x32x16_bf16(b0,qr[d0],p0,0,0,0);p1=__builtin_amdgcn_mfma_f32_32x32x16_bf16(b1,qr[d0],p1,0,0,0);}}
}
typedef __attribute__((address_space(3))) const char* lds_cptr;
typedef short v4i16_t __attribute__((ext_vector_type(4)));
__device__ __forceinline__ void kload8(bf16x8*kf,lds_cptr kp){
  kf[0]=*(const __attribute__((address_space(3))) bf16x8*)(kp);      kf[1]=*(const __attribute__((address_space(3))) bf16x8*)(kp+512);
  kf[2]=*(const __attribute__((address_space(3))) bf16x8*)(kp+2048); kf[3]=*(const __attribute__((address_space(3))) bf16x8*)(kp+2560);
  kf[4]=*(const __attribute__((address_space(3))) bf16x8*)(kp+4096); kf[5]=*(const __attribute__((address_space(3))) bf16x8*)(kp+4608);
  kf[6]=*(const __attribute__((address_space(3))) bf16x8*)(kp+6144); kf[7]=*(const __attribute__((address_space(3))) bf16x8*)(kp+6656);
}
__device__ __forceinline__ void kload2(bf16x8*kf,lds_cptr kp,int j){ kf[2*j]=*(const __attribute__((address_space(3))) bf16x8*)(kp+j*2048); kf[2*j+1]=*(const __attribute__((address_space(3))) bf16x8*)(kp+j*2048+512); }
__device__ __forceinline__ s16x4 vtr(lds_cptr p){ return __builtin_bit_cast(s16x4,__builtin_amdgcn_ds_read_tr16_b64_v4i16((__attribute__((address_space(3))) v4i16_t*)p)); }
__device__ __forceinline__ float rowmax(const f32x16&p0,const f32x16&p1){
  float a=max3f(p0[0],p0[1],p1[0]),b=max3f(p0[2],p0[3],p1[1]);a=max3f(a,p1[2],p1[3]);
  #pragma unroll
  for(int r=4;r<16;r+=4){a=max3f(a,p0[r],p0[r+1]);b=max3f(b,p0[r+2],p0[r+3]);a=max3f(a,p1[r],p1[r+1]);b=max3f(b,p1[r+2],p1[r+3]);}
  const float m=max2f(a,b);
  auto rr=__builtin_amdgcn_permlane32_swap(__float_as_uint(m),__float_as_uint(m),false,false);
  return max2f(__uint_as_float(rr[0]),__uint_as_float(rr[1]));
}
__device__ __forceinline__ void pv(f32x16*o,int vb,bf16x8 pa0,bf16x8 pa1,bf16x8 pa2,bf16x8 pa3){
  #pragma unroll
  for(int d0=0;d0<2;++d0){s16x4 lo[4],hi[4];
    #pragma unroll
    for(int ks=0;ks<4;++ks){
      asm volatile("ds_read_b64_tr_b16 %0,%1 offset:%c2":"=&v"(lo[ks]):"v"(vb),"i"(d0*4096+ks*1024):"memory");
      asm volatile("ds_read_b64_tr_b16 %0,%1 offset:%c2":"=&v"(hi[ks]):"v"(vb),"i"(d0*4096+ks*1024+512):"memory");}
    asm volatile("s_waitcnt lgkmcnt(0)":::"memory");SBAR();
    #define PK(k) (bf16x8){lo[k][0],lo[k][1],lo[k][2],lo[k][3],hi[k][0],hi[k][1],hi[k][2],hi[k][3]}
    o[d0]=__builtin_amdgcn_mfma_f32_32x32x16_bf16(pa0,PK(0),o[d0],0,0,0);
    o[d0]=__builtin_amdgcn_mfma_f32_32x32x16_bf16(pa1,PK(1),o[d0],0,0,0);
    o[d0]=__builtin_amdgcn_mfma_f32_32x32x16_bf16(pa2,PK(2),o[d0],0,0,0);
    o[d0]=__builtin_amdgcn_mfma_f32_32x32x16_bf16(pa3,PK(3),o[d0],0,0,0);
    #undef PK
  }
}
#define ATTN_STORE16(p,v) (*(u32x4*)(p)=(v))
template<int THRL> __device__ __forceinline__ void attn_unit(int b,int hq,int hv,int qb,const bf16*Q,const bf16*__restrict__ K,const bf16*__restrict__ V,bf16*O,char*shm){
  int tid=threadIdx.x; asm volatile("":"+v"(tid)); const int lane=tid&63,r32=lane&31,hi=lane>>5; const int wid=__builtin_amdgcn_readfirstlane(tid>>6);
  const long rowbase=(long)b*SEQ; const int q0=qb*QB;
  const bf16*Qw=Q+(rowbase+q0+wid*QBLK)*DM+hq*D;
  const bf16*Kh=K+rowbase*DM+hq*D,*Vh=V+rowbase*DM+hv*D;
  const unsigned lds0=(unsigned)(uintptr_t)shm;
  float*wsf=(float*)(shm+LDS_WS)+wid*64;
  const bf16*ksrc=Kh+(long)lane*DM+wid*8;
  const bf16*vsrc=Vh+(long)(16*(wid&3)+(lane>>2))*DM+(wid>>2)*32+(lane&3)*8;
  const unsigned kdst=lds0+LDS_K+wid*1024, vdst=lds0+LDS_V+wid*1024;
  #define DMA_K(t,slot) glds16(ksrc+(long)(t)*KVBLK*DM,(unsigned)__builtin_amdgcn_readfirstlane(kdst+(slot)))
  #define DMA_V(t,slot) glds16(vsrc+(long)(t)*KVBLK*DM,(unsigned)__builtin_amdgcn_readfirstlane(vdst+(slot)))
  const int vb0=(int)(lds0+LDS_V)+((lane>>4)&1)*32+(lane&3)*8+(4*hi+((lane&15)>>2))*64;
  const char*Kbase=shm+LDS_K; bf16x8 kf[8];
  const lds_cptr shm3=(lds_cptr)shm; const lds_cptr kp0=shm3+LDS_K+hi*1024+r32*16; const lds_cptr vp0=shm3+LDS_V+((lane>>4)&1)*32+(lane&3)*8+(4*hi+((lane&15)>>2))*64;
  const int NT=(q0+QB)/KVBLK;
  DMA_K(0,0);DMA_V(0,0);DMA_K(1,SLOTB);
  bf16x8 qr[4];
  #pragma unroll
  for(int d0=0;d0<4;++d0)qr[d0]=*reinterpret_cast<const bf16x8*>(&Qw[(long)r32*DM+d0*16+hi*8]);
  float mhat=0.f,l_reg=0.f;f32x16 o[2];o[0]=f32x16{};o[1]=f32x16{};f32x16 negm=f32x16{};asm volatile("":"+v"(negm));
  #define CMASK(P0,P1,t) do{int jb_=(t)-(NT-4); if(jb_>=0)cmask(P0,P1,jb_,wid);}while(0)
  bool resc=false;
  #define START(P0,P1) do{ const float rm=rowmax(P0,P1); resc=false; \
    { const float dl=rm; mhat=fadd_s(mhat,dl); \
      _Pragma("unroll") for(int r=0;r<16;++r){P0[r]=fsub_s(P0[r],dl);P1[r]=fsub_s(P1[r],dl);} \
      _Pragma("unroll") for(int r=0;r<16;++r)negm[r]=-mhat; asm volatile("":"+v"(negm)); } \
    _Pragma("unroll") for(int r=0;r<16;++r)P0[r]=__builtin_amdgcn_exp2f(P0[r]); }while(0)
  #define RESC() do{ if(resc){ asm volatile("s_waitcnt lgkmcnt(0)":::"memory"); \
      _Pragma("unroll") for(int d_=0;d_<2;++d_) _Pragma("unroll") for(int r=0;r<16;++r)o[d_][r]*=wsf[crow(r,hi)]; } }while(0)
  f32x16 pA0,pA1,pB0,pB1;
  int sl_prev=0,sl_cur=0,sl_next=SLOTB;
  #define ROT() do{sl_prev=sl_cur;sl_cur=sl_next;sl_next=(sl_next==(NSLOT-1)*SLOTB)?0:sl_next+SLOTB;}while(0)
  DMA_K(2,2*SLOTB);
  WAIT_BAR(3);
  qkt(pA0,pA1,Kbase,qr,negm,r32,hi);asm volatile("s_nop 15\n\ts_nop 7":"+v"(pA0),"+v"(pA1));CMASK(pA0,pA1,0);
  START(pA0,pA1);
  _Pragma("unroll") for(int r=0;r<16;++r)pA1[r]=__builtin_amdgcn_exp2f(pA1[r]);
  WAIT_BAR(0);
  DMA_K(3,0);DMA_V(1,SLOTB);
  ROT();
  kload8(kf,kp0+sl_cur);
  WAIT_BAR(2);
  s16x4 vlo[8],vhi[8]; u32x4 pw0,pw1,pw2,pw3;
  #define PKW(P,B) cvtpk_s(P[B],P[B+1])
  #define PAF(k) __builtin_bit_cast(bf16x8,pw##k)
  #define VFR(i) (bf16x8){vlo[i][0],vlo[i][1],vlo[i][2],vlo[i][3],vhi[i][0],vhi[i][1],vhi[i][2],vhi[i][3]}
  #define PIN(x) asm volatile("":"+v"(x))
  #define MX3(a,b,c) __builtin_fmaxf(__builtin_fmaxf((a),(b)),(c))
  #define GAPA(MF,A0,A1,A2,A3,W0,W1,PW) do{ MF; sacc+=A0; sacc+=A1; sacc+=A2; sacc+=A3; PIN(sacc); W0; W1; PIN(PW); SBAR(); }while(0)
  #define EX(v) __builtin_amdgcn_exp2f(v)
  #define GAPB(MF,X,B) do{ MF; X[B]=EX(X[B]); X[B+1]=EX(X[B+1]); X[B+2]=EX(X[B+2]); X[B+3]=EX(X[B+3]); PIN(X); SBAR(); }while(0)
  #define VRD(i) do{ vlo[i]=vtr(vp_+(((i)>>2)*4096+((i)&3)*1024)); vhi[i]=vtr(vp_+(((i)>>2)*4096+((i)&3)*1024+512)); }while(0)
  #define KRD(G,j) do{ if(G){ kload2(kf,kp0+sl_next,j); SBAR(); } }while(0)
  #define STEP(C0,C1,P0,P1,t,GK,GV,GL) do{ SBAR(); \
    const lds_cptr vp_=vp0+sl_prev; \
    VRD(0); SBAR(); float sacc=(P0[0]+P0[1]); \
    GAPA(C0=__builtin_amdgcn_mfma_f32_32x32x16_bf16(kf[0],qr[0],negm,0,0,0), P0[2],P0[3],P0[4],P0[5],     pw0[0]=PKW(P0,0), pw0[1]=PKW(P0,2), pw0); \
    VRD(4); SBAR(); GAPA(C1=__builtin_amdgcn_mfma_f32_32x32x16_bf16(kf[1],qr[0],negm,0,0,0), P0[6],P0[7],P0[8],P0[9],     pw0[2]=PKW(P0,4), pw0[3]=PKW(P0,6), pw0); \
    VRD(1); SBAR(); GAPA(C0=__builtin_amdgcn_mfma_f32_32x32x16_bf16(kf[2],qr[1],C0,0,0,0),   P0[10],P0[11],P0[12],P0[13], pw1[0]=PKW(P0,8), pw1[1]=PKW(P0,10), pw1); \
    VRD(5); SBAR(); GAPA(C1=__builtin_amdgcn_mfma_f32_32x32x16_bf16(kf[3],qr[1],C1,0,0,0),   P0[14],P0[15],P1[0],P1[1],   pw1[2]=PKW(P0,12),pw1[3]=PKW(P0,14), pw1); \
    VRD(2); SBAR(); GAPA(C0=__builtin_amdgcn_mfma_f32_32x32x16_bf16(kf[4],qr[2],C0,0,0,0),   P1[2],P1[3],P1[4],P1[5],     pw2[0]=PKW(P1,0), pw2[1]=PKW(P1,2), pw2); \
    VRD(6); SBAR(); GAPA(C1=__builtin_amdgcn_mfma_f32_32x32x16_bf16(kf[5],qr[2],C1,0,0,0),   P1[6],P1[7],P1[8],P1[9],     pw2[2]=PKW(P1,4), pw2[3]=PKW(P1,6), pw2); \
    VRD(3); SBAR(); GAPA(C0=__builtin_amdgcn_mfma_f32_32x32x16_bf16(kf[6],qr[3],C0,0,0,0),   P1[10],P1[11],P1[12],P1[13], pw3[0]=PKW(P1,8), pw3[1]=PKW(P1,10), pw3); \
    VRD(7); SBAR(); GAPA(C1=__builtin_amdgcn_mfma_f32_32x32x16_bf16(kf[7],qr[3],C1,0,0,0),   P1[14],P1[15],0.f,0.f,       pw3[2]=PKW(P1,12),pw3[3]=PKW(P1,14), pw3); \
    l_reg+=sacc; \
    if(GK){DMA_K((t)+3,sl_cur);} if(GV){DMA_V((t)+1,sl_next);} \
    CMASK(C0,C1,t); \
    { float a=MX3(C0[0],C0[1],C1[0]),b=MX3(C0[2],C0[3],C1[1]); a=MX3(a,C1[2],C1[3]); \
      _Pragma("unroll") for(int r=4;r<16;r+=4){a=MX3(a,C0[r],C0[r+1]);b=MX3(b,C0[r+2],C0[r+3]);a=MX3(a,C1[r],C1[r+1]);b=MX3(b,C1[r+2],C1[r+3]);} \
      float rm=__builtin_fmaxf(a,b); { auto rr=__builtin_amdgcn_permlane32_swap(__float_as_uint(rm),__float_as_uint(rm),false,false); rm=__builtin_fmaxf(__uint_as_float(rr[0]),__uint_as_float(rr[1])); } \
      resc=false; \
      if(__builtin_expect(__any(rm>(float)THRL),0)){ const float dl=__builtin_fmaxf(rm,0.f); mhat+=dl; \
        _Pragma("unroll") for(int r=0;r<16;++r){C0[r]-=dl;C1[r]-=dl;} \
        _Pragma("unroll") for(int r=0;r<16;++r)negm[r]=-mhat; asm volatile("":"+v"(negm)); \
        const float f=__builtin_amdgcn_exp2f(-dl); l_reg*=f; if(hi==0)wsf[r32]=f; resc=true; } } \
    SBAR(); \
    GAPB(o[0]=__builtin_amdgcn_mfma_f32_32x32x16_bf16(PAF(0),VFR(0),o[0],0,0,0), C0,0); \
    GAPB(o[1]=__builtin_amdgcn_mfma_f32_32x32x16_bf16(PAF(0),VFR(4),o[1],0,0,0), C0,4); \
    KRD(GL,0); GAPB(o[0]=__builtin_amdgcn_mfma_f32_32x32x16_bf16(PAF(1),VFR(1),o[0],0,0,0), C0,8); \
    KRD(GL,1); GAPB(o[1]=__builtin_amdgcn_mfma_f32_32x32x16_bf16(PAF(1),VFR(5),o[1],0,0,0), C0,12); \
    KRD(GL,2); GAPB(o[0]=__builtin_amdgcn_mfma_f32_32x32x16_bf16(PAF(2),VFR(2),o[0],0,0,0), C1,0); \
    KRD(GL,3); GAPB(o[1]=__builtin_amdgcn_mfma_f32_32x32x16_bf16(PAF(2),VFR(6),o[1],0,0,0), C1,4); \
    GAPB(o[0]=__builtin_amdgcn_mfma_f32_32x32x16_bf16(PAF(3),VFR(3),o[0],0,0,0), C1,8); \
    GAPB(o[1]=__builtin_amdgcn_mfma_f32_32x32x16_bf16(PAF(3),VFR(7),o[1],0,0,0), C1,12); \
    }while(0)
  int t=1;
  #undef CMASK
  #define CMASK(P0,P1,t) do{}while(0)
  for(;t+5<NT;t+=2){
    STEP(pB0,pB1,pA0,pA1,t,true,true,true);     WAIT_BAR(2); RESC(); ROT();
    STEP(pA0,pA1,pB0,pB1,t+1,true,true,true);   WAIT_BAR(2); RESC(); ROT();
  }
  #undef CMASK
  #define CMASK(P0,P1,t) do{int jb_=(t)-(NT-4); if(jb_>=0)cmask(P0,P1,jb_,wid);}while(0)
  #define ENDW(tt) do{ if((tt)+3<NT){WAIT_BAR(2);} else if((tt)+2<NT){WAIT_BAR(1);} else {WAIT_BAR(0);} }while(0)
  for(;t+1<NT;t+=2){
    STEP(pB0,pB1,pA0,pA1,t,(t+3<NT),(t+1<NT),(t+1<NT));       ENDW(t);   RESC(); ROT();
    STEP(pA0,pA1,pB0,pB1,t+1,(t+4<NT),(t+2<NT),(t+2<NT));     ENDW(t+1); RESC(); ROT();
  }
  STEP(pB0,pB1,pA0,pA1,NT-1,false,false,false); RESC();
  { float sacc=pB0[0]+pB0[1]; _Pragma("unroll") for(int r=2;r<16;++r)sacc+=pB0[r]; _Pragma("unroll") for(int r=0;r<16;++r)sacc+=pB1[r]; l_reg+=sacc;
    pw0=(u32x4){PKW(pB0,0),PKW(pB0,2),PKW(pB0,4),PKW(pB0,6)};pw1=(u32x4){PKW(pB0,8),PKW(pB0,10),PKW(pB0,12),PKW(pB0,14)};pw2=(u32x4){PKW(pB1,0),PKW(pB1,2),PKW(pB1,4),PKW(pB1,6)};pw3=(u32x4){PKW(pB1,8),PKW(pB1,10),PKW(pB1,12),PKW(pB1,14)};
    SBAR(); pv(o,vb0+sl_cur,PAF(0),PAF(1),PAF(2),PAF(3)); }
  #undef PKW
  #undef PAF
  #undef VFR
  #undef PIN
  #undef MX3
  #undef GAPA
  #undef GAPB
  #undef EX
  #undef VRD
  #undef KRD
  #undef STEP
  #undef ENDW
  {auto rr=__builtin_amdgcn_permlane32_swap(__float_as_uint(l_reg),__float_as_uint(l_reg),false,false);l_reg=__uint_as_float(rr[0])+__uint_as_float(rr[1]);}
  if(hi==0)wsf[32+r32]=l_reg;asm volatile("s_waitcnt lgkmcnt(0)":::"memory");
  float rli[16];
  #pragma unroll
  for(int r=0;r<16;++r)rli[r]=__builtin_amdgcn_rcpf(wsf[32+crow(r,hi)]);
  bf16*Ow=O+(rowbase+q0+wid*QBLK)*DM+hv*D;
  { bf16*stg=(bf16*)(shm+LDS_OST)+wid*2048;
    #pragma unroll
    for(int r=0;r<16;++r){const int orow=crow(r,hi);
      #pragma unroll
      for(int d0=0;d0<2;++d0)stg[orow*64+d0*32+r32]=__float2bfloat16(o[d0][r]*rli[r]);}
    asm volatile("s_waitcnt lgkmcnt(0)":::"memory");
    #pragma unroll
    for(int i=0;i<4;++i){const int row=i*8+(lane>>3),ch=lane&7; const u32x4 v=*(const u32x4*)(stg+row*64+ch*8); ATTN_STORE16(Ow+(long)row*DM+ch*8,v);} }
  asm volatile("s_waitcnt lgkmcnt(0)\n\ts_barrier":::"memory");
  #undef DMA_K
  #undef DMA_V
  #undef CMASK
  #undef START
  #undef RESC
  #undef ROT
}
constexpr int ATTN_LDS_BYTES=LDS_BYTES;
#undef SBAR
#undef WAIT_BAR
}

constexpr size_t MiB = 1u << 20;
constexpr size_t WS_CTL = 0, CTL_ZERO_BYTES = 1 * MiB;
constexpr size_t WS_WIN = 2 * MiB;
constexpr size_t WS_WGLU = 13 * MiB;
constexpr size_t WS_WSSM = 14 * MiB;
constexpr size_t WS_WATT = 15 * MiB;
constexpr size_t WS_WOUT = 17 * MiB;
constexpr size_t WS_WR = 19 * MiB;
constexpr size_t WS_BTP = 20 * MiB;
constexpr size_t WS_BTY = 28 * MiB;
constexpr size_t WS_WE1 = 48 * MiB;
constexpr size_t WS_WE2 = 80 * MiB;
constexpr size_t WS_ETAB = 96 * MiB;
constexpr size_t WS_MOD = 104 * MiB;
constexpr size_t WS_UG = 112 * MiB;
constexpr size_t WS_Q = 152 * MiB, WS_K = 216 * MiB, WS_V = 280 * MiB;
constexpr size_t WS_GATES = 344 * MiB;
constexpr size_t WS_SLOC = 472 * MiB;
constexpr size_t WS_YACT = 152 * MiB;
constexpr size_t WS_S5O = 184 * MiB;
constexpr size_t WS_ATTO = 216 * MiB;
constexpr size_t WS_TMP = 280 * MiB;
constexpr size_t WS_H = 344 * MiB;
constexpr size_t WS_XS = 112 * MiB;
constexpr size_t WS_HDN = 256 * MiB;
constexpr size_t WS_SLOTS = 112 * MiB;
constexpr size_t WS_LOGITS = 472 * MiB;
constexpr size_t WS_RT = 480 * MiB;
constexpr size_t WS_DEST = 482 * MiB;
constexpr size_t WS_CW = 483 * MiB;
constexpr size_t WS_END = 512 * MiB;
constexpr int CW_TMO = 0, CW_BAR = 4096, CW_CNT = 16384;

constexpr int NWAVES = 8;
constexpr int RING_OFF = 0, RING_BYTES = 131072;
constexpr int LDSCTL_OFF = RING_BYTES, MISC_OFF = LDSCTL_OFF + 320;
constexpr int LDS_BYTES = 147456;

#define GAS __attribute__((address_space(1)))
#define LAS __attribute__((address_space(3)))
typedef unsigned short bf16;
typedef unsigned v4u __attribute__((ext_vector_type(4)));
typedef unsigned v2u __attribute__((ext_vector_type(2)));
typedef float f32x4 __attribute__((ext_vector_type(4)));
typedef GAS unsigned gu32;
#define RLX_AGENT __ATOMIC_RELAXED, __HIP_MEMORY_SCOPE_AGENT
#define LDS_WAIT() asm volatile("s_waitcnt lgkmcnt(0)" ::: "memory")
#define VM_WAIT() asm volatile("s_waitcnt vmcnt(0)" ::: "memory")
__device__ __forceinline__ unsigned f2bf(float f) { unsigned u = __builtin_bit_cast(unsigned, f); return (u + 0x7fffu + ((u >> 16) & 1u)) >> 16; }
__device__ __forceinline__ unsigned pk2(float lo, float hi) { return f2bf(lo) | (f2bf(hi) << 16); }
__device__ __forceinline__ float bf2f(unsigned b) { return __uint_as_float(b << 16); }

#define XB_TMO      128
#define XB_XCNT(j)  (256  + 64 * (j))
#define XB_XSUB(j)  (1280 + 64 * (j))
#define XB_XGEN(j)  (2304 + 64 * (j))
#define XB_TOP      3328
#define XB_TOPGEN   3392
#define XCD_BAR_WORDS 3456
#define XB_SPIN_CAP (1u << 18)
__device__ __forceinline__ unsigned xb_ld(unsigned* p)              { return __hip_atomic_load(p, __ATOMIC_RELAXED, __HIP_MEMORY_SCOPE_AGENT); }
__device__ __forceinline__ unsigned xb_add(unsigned* p, unsigned v) { return __hip_atomic_fetch_add(p, v, __ATOMIC_RELAXED, __HIP_MEMORY_SCOPE_AGENT); }
__device__ __forceinline__ unsigned xb_xcc_id() { return (unsigned)__builtin_amdgcn_s_getreg((3 << 11) | 20) & 0xFu; }
#define XB_SPIN(cond, bar) do { unsigned _sp = 0; while (cond) { __builtin_amdgcn_s_sleep(1); \
    if ((++_sp & 255u) == 0u) { if (xb_ld(&(bar)[XB_TMO])) break; if (_sp > XB_SPIN_CAP) { atomicAdd(&(bar)[XB_TMO], 1u); break; } } } } while (0)
struct XcdBarrier { unsigned* bar; unsigned x; volatile LAS unsigned* st; };
__device__ __forceinline__ XcdBarrier xcd_barrier_post(unsigned* bar, volatile LAS unsigned* st) {
    XcdBarrier b; b.bar = bar; b.x = xb_xcc_id(); b.st = st;
    if (threadIdx.x == 0) (void)xb_add(&bar[XB_XCNT(b.x)], 1u);
    return b;
}
__device__ __forceinline__ void xcd_barrier_complete(unsigned* bar, unsigned x, unsigned& nloc, unsigned& nx) {
    const unsigned G = gridDim.x * gridDim.y * gridDim.z;
    unsigned sum, cnt, mine, sp = 0u;
    for (;;) {
        sum = 0u; cnt = 0u; mine = 0u;
#pragma unroll
        for (unsigned j = 0; j < 16; ++j) { const unsigned c = xb_ld(&bar[XB_XCNT(j)]); sum += c; cnt += (c > 0u) ? 1u : 0u; mine = (j == x) ? c : mine; }
        if (sum == G) break;
        __builtin_amdgcn_s_sleep(1);
        if ((++sp & 255u) == 0u) { if (xb_ld(&bar[XB_TMO])) break; if (sp > XB_SPIN_CAP) { atomicAdd(&bar[XB_TMO], 1u); break; } }
    }
    nloc = mine > 0u ? mine : 1u; nx = cnt > 0u ? cnt : 1u;
}
__device__ __forceinline__ void xcd_barrier(const XcdBarrier& b) {
    asm volatile("s_waitcnt vmcnt(0)" ::: "memory");
    __syncthreads();
    if (threadIdx.x == 0) {
        unsigned* bar = b.bar;
        __builtin_amdgcn_s_waitcnt(0);
        unsigned nloc = b.st[0], nx = b.st[1];
        if (nloc == 0u) { xcd_barrier_complete(bar, b.x, nloc, nx); b.st[0] = nloc; b.st[1] = nx; }
        const unsigned old = xb_add(&bar[XB_XSUB(b.x)], 1u);
        const unsigned gen = old / nloc;
        if (old + 1u == (gen + 1u) * nloc) {
            __builtin_amdgcn_fence(__ATOMIC_RELEASE, "agent");
            asm volatile("s_waitcnt vmcnt(0)" ::: "memory");
            const unsigned og = xb_add(&bar[XB_TOP], 1u);
            const unsigned tg = og / nx;
            if (og + 1u == (tg + 1u) * nx) xb_add(&bar[XB_TOPGEN], 1u);
            else XB_SPIN(xb_ld(&bar[XB_TOPGEN]) == tg, bar);
            __builtin_amdgcn_fence(__ATOMIC_ACQUIRE, "agent");
            xb_add(&bar[XB_XGEN(b.x)], 1u);
            asm volatile("s_waitcnt vmcnt(0)" ::: "memory");
        } else {
            XB_SPIN(xb_ld(&bar[XB_XGEN(b.x)]) == gen, bar);
            __builtin_amdgcn_fence(__ATOMIC_ACQUIRE, "agent");
            asm volatile("s_waitcnt vmcnt(0)" ::: "memory");
        }
    }
    __syncthreads();
}

__device__ __forceinline__ float shfl_xor_l(float v, int o, int lane) { return __int_as_float(__builtin_amdgcn_ds_bpermute((lane ^ o) << 2, __float_as_int(v))); }
__device__ __forceinline__ float wave_sum(float v, int lane) {
#pragma unroll
    for (int o = 1; o < 64; o <<= 1) v += shfl_xor_l(v, o, lane);
    return v;
}
__device__ __forceinline__ void transpose_tile(const float* W, int N, int k0, int n0, bf16* WT, int ldo, int orow0, int ocol0, LAS float* scr, int lane) {
#pragma unroll 8
    for (int i = 0; i < 32; ++i) { const int kk = 2 * i + (lane >> 5); scr[kk * 33 + (lane & 31)] = W[(size_t)(k0 + kk) * N + n0 + (lane & 31)]; }
    LDS_WAIT(); asm volatile("" ::: "memory");
    const int c = lane & 7;
#pragma unroll
    for (int j = 0; j < 4; ++j) { const int n = (lane >> 3) + 8 * j; const LAS float* s = scr + (8 * c) * 33 + n;
        v4u o; o.x = pk2(s[0 * 33], s[1 * 33]); o.y = pk2(s[2 * 33], s[3 * 33]); o.z = pk2(s[4 * 33], s[5 * 33]); o.w = pk2(s[6 * 33], s[7 * 33]);
        *(GAS v4u*)(WT + (size_t)(orow0 + n) * ldo + ocol0 + 8 * c) = o; }
    LDS_WAIT(); asm volatile("" ::: "memory");
}
__device__ __forceinline__ void abar_pow(float lr, float li, float dt, float j, float& re, float& im) {
    const float mag = expf(lr * dt * j); float s, c; sincosf(li * dt * j, &s, &c); re = mag * c; im = mag * s;
}

constexpr int ETAB_OFF = MISC_OFF + 256;
__device__ __forceinline__ void build_expert_table(LAS unsigned char* L, const int* CNT, int tid) {
    LAS int* tab = (LAS int*)(L + ETAB_OFF);
    __syncthreads();
    if (tid == 0) { int rt = 0;
#pragma unroll 1
        for (int e = 0; e < NEXP; ++e) { const int nt = (CNT[e] + 255) >> 8;
#pragma unroll 1
            for (int q = 0; q < nt; ++q) tab[rt++] = e; }
#pragma unroll 1
        for (; rt <= XS_ROWS / 256; ++rt) tab[rt] = -1; }
    __syncthreads();
}
struct Args { const float* in[34]; float* out; unsigned char* ws; };
typedef __attribute__((address_space(4))) const char* kconst_ptr;
__device__ __forceinline__ void* karg(int k) { kconst_ptr kp = (kconst_ptr)__builtin_amdgcn_kernarg_segment_ptr(); asm volatile("" : "+s"(kp)); return *(void* const __attribute__((address_space(4)))*)(kp + 8 * k); }

__global__ void __launch_bounds__(NWAVES * 64, 2) fwd_kernel(Args args) {
    extern __shared__ __attribute__((aligned(16))) unsigned char lds[];
    LAS unsigned char* L = (LAS unsigned char*)lds;
    volatile LAS unsigned* MISC = (volatile LAS unsigned*)(L + MISC_OFF);
#define PHASE_IDS() \
    int tid = threadIdx.x; asm volatile("" : "+v"(tid)); \
    const int lane = tid & 63, wave = __builtin_amdgcn_readfirstlane(tid >> 6); \
    int G = gridDim.x, bx = blockIdx.x; asm volatile("" : "+s"(G), "+s"(bx)); \
    const int vcu = (G % 8 == 0) ? (bx % 8) * (G / 8) + bx / 8 : bx; \
    const int gw = vcu * NWAVES + wave, NGW = G * NWAVES; \
    const int gt = bx * (NWAVES * 64) + tid, NGT = G * NWAVES * 64; \
    (void)lane; (void)wave; (void)vcu; (void)gw; (void)NGW; (void)gt; (void)NGT;
    gu32* ctl = (gu32*)(args.ws + WS_CTL);
    for (int u = threadIdx.x; u < (LDS_BYTES - LDSCTL_OFF) / 4; u += NWAVES * 64) ((LAS unsigned*)(L + LDSCTL_OFF))[u] = 0u;
    __syncthreads();
    XcdBarrier bar = xcd_barrier_post((unsigned*)(ctl + CW_BAR), MISC + 8);
#define GRID_BAR() xcd_barrier(bar)

#define KIN(k) ((const float*)karg(k))
#define WSP(T_, off) ((T_*)(((unsigned char*)karg(35)) + (off)))
#define OUTP() ((float*)karg(34))

#if DBG_STAGE != 1
    asm volatile("; PHASE_MARK P0" ::: "memory");
    {
        PHASE_IDS();
        const float* w_in = KIN(5); const float* w_glu = KIN(15); const float* w_br_ssm = KIN(22); const float* w_br_attn = KIN(23); const float* w_out = KIN(24);
        const float* w_eg = KIN(30); const float* w_eu = KIN(31); const float* w_ed = KIN(32);
        bf16* WinT = WSP(bf16, WS_WIN); bf16* WgluT = WSP(bf16, WS_WGLU); bf16* WssmT = WSP(bf16, WS_WSSM); bf16* WattT = WSP(bf16, WS_WATT); bf16* WoutT = WSP(bf16, WS_WOUT);
        bf16* WE1 = WSP(bf16, WS_WE1); bf16* WE2 = WSP(bf16, WS_WE2);
        LAS float* scr = (LAS float*)(L + RING_OFF + wave * 16384);
        constexpr int I_IN = 16 * 176, I_GLU = 8 * 16, I_SSM = 8 * 32, I_ATT = 16 * 32, I_OUT = 16 * 32, I_EG = NEXP * 16 * 8, I_EU = I_EG, I_ED = NEXP * 4 * 32;
        constexpr int NITEMS = I_IN + I_GLU + I_SSM + I_ATT + I_OUT + I_EG + I_EU + I_ED;
        for (int it = gw; it < NITEMS; it += NGW) {
            int r = it;
            if (r < I_IN) { const int kb = r / 176, nb = r % 176; transpose_tile(w_in, INW, 64 * kb, 32 * nb, WinT, D, 32 * nb, 64 * kb, scr, lane); continue; } r -= I_IN;
            if (r < I_GLU) { const int kb = r / 16, nb = r % 16; transpose_tile(w_glu, S5W, 64 * kb, 32 * nb, WgluT, S5W, 32 * nb, 64 * kb, scr, lane); continue; } r -= I_GLU;
            if (r < I_SSM) { const int kb = r / 32, nb = r % 32; transpose_tile(w_br_ssm, D, 64 * kb, 32 * nb, WssmT, S5W, 32 * nb, 64 * kb, scr, lane); continue; } r -= I_SSM;
            if (r < I_ATT) { const int kb = r / 32, nb = r % 32; transpose_tile(w_br_attn, D, 64 * kb, 32 * nb, WattT, D, 32 * nb, 64 * kb, scr, lane); continue; } r -= I_ATT;
            if (r < I_OUT) { const int kb = r / 32, nb = r % 32; transpose_tile(w_out, D, 64 * kb, 32 * nb, WoutT, D, 32 * nb, 64 * kb, scr, lane); continue; } r -= I_OUT;
            if (r < I_EG + I_EU) { const bool up = r >= I_EG; if (up) r -= I_EG; const int e = r / 128, q = r % 128, kb = q / 8, nb = q % 8;
                transpose_tile((up ? w_eu : w_eg) + (size_t)e * D * DEXP, DEXP, 64 * kb, 32 * nb, WE1 + (size_t)e * 512 * D, D, (nb >> 2) * 256 + (up ? 128 : 0) + (nb & 3) * 32, 64 * kb, scr, lane); continue; } r -= I_EG + I_EU;
            { const int e = r / 128, q = r % 128, kb = q / 32, nb = q % 32; transpose_tile(w_ed + (size_t)e * DEXP * D, D, 64 * kb, 32 * nb, WE2 + (size_t)e * D * DEXP, DEXP, 32 * nb, 64 * kb, scr, lane); }
        }
        const float* w_rg = KIN(26); const float* w_re = KIN(28); bf16* WR = WSP(bf16, WS_WR);
        for (int idx = gt; idx < 256 * 2048 / 8; idx += NGT) {
            const int row = idx / 256, c8 = (idx % 256) * 8; const int n = row & 127, part = row >> 7, k0 = c8 & 1023, khalf = c8 >> 10;
            unsigned w[4] = {0u, 0u, 0u, 0u};
            if (n < 36 && !(part == 1 && khalf == 1)) {
                float hv[8];
#pragma unroll
                for (int i = 0; i < 8; ++i) { const float f = (n < 4) ? w_rg[(size_t)(k0 + i) * 4 + n] : w_re[(size_t)(k0 + i) * NEXP + (n - 4)]; const float h = bf2f(f2bf(f)); hv[i] = part ? (f - h) : h; }
#pragma unroll
                for (int i = 0; i < 4; ++i) w[i] = pk2(hv[2 * i], hv[2 * i + 1]);
            }
            *(GAS v4u*)(WR + (size_t)row * 2048 + c8) = (v4u){w[0], w[1], w[2], w[3]};
        }
        const float* log_dt = KIN(14); const float* a_re = KIN(7); const float* a_im = KIN(8); const float* sb_re = KIN(9); const float* sb_im = KIN(10);
        float* Ere = WSP(float, WS_ETAB); float* Eim = Ere + NG * LC * NP * 16;
        for (int idx = gt; idx < NG * LC * NP; idx += NGT) {
            const int p = idx % NP, j = (idx / NP) % LC, g = idx / (NP * LC);
            const float dt = expf(log_dt[g]), lr = a_re[g * NP + p], li = a_im[g * NP + p];
            float ar, ai; abar_pow(lr, li, dt, 1.0f, ar, ai);
            const float den = lr * lr + li * li, nr = ar - 1.0f;
            const float fre = (nr * lr + ai * li) / den, fim = (ai * lr - nr * li) / den;
            float pr, pi; abar_pow(lr, li, dt, (float)j, pr, pi);
            const float gr = pr * fre - pi * fim, gi = pr * fim + pi * fre;
            const float* br = sb_re + (size_t)(g * NP + p) * 16; const float* bi = sb_im + (size_t)(g * NP + p) * 16;
            float* er = Ere + (size_t)((g * LC + j) * NP + p) * 16; float* ei = Eim + (size_t)((g * LC + j) * NP + p) * 16;
#pragma unroll
            for (int ci = 0; ci < 16; ++ci) { er[ci] = gr * br[ci] - gi * bi[ci]; ei[ci] = gr * bi[ci] + gi * br[ci]; }
        }
        {
            const float* cvec = KIN(1); const float* w_ada = KIN(2); const float* b_ada = KIN(3); float* MOD = WSP(float, WS_MOD);
            __syncthreads();
            LAS float* cs = (LAS float*)(L + RING_OFF);
            LAS float* red = (LAS float*)(L + RING_OFF + 32768);
            bool loaded = false;
            for (int it = vcu; it < 6 * D / 32; it += G) {
                if (!loaded) { __syncthreads(); for (int i = tid; i < NB * D; i += NWAVES * 64) { const float c = cvec[i]; cs[i] = c / (1.0f + expf(-c)); } __syncthreads(); loaded = true; }
                const int col = it * 32 + (lane & 31), ksub = (lane >> 5) + 2 * wave;
                float accb[NB];
#pragma unroll
                for (int b = 0; b < NB; ++b) accb[b] = 0.f;
#pragma unroll 8
                for (int i = 0; i < 64; ++i) { const int k = ksub + 16 * i; const float w = w_ada[(size_t)k * (6 * D) + col];
#pragma unroll
                    for (int b = 0; b < NB; ++b) accb[b] += cs[b * D + k] * w; }
#pragma unroll
                for (int b = 0; b < NB; ++b) red[(ksub * NB + b) * 32 + (lane & 31)] = accb[b];
                __syncthreads();
                if (tid < NB * 32) { const int b = tid >> 5, c = tid & 31; float s = 0.f;
#pragma unroll
                    for (int q = 0; q < 16; ++q) s += red[(q * NB + b) * 32 + c];
                    MOD[(size_t)b * 6 * D + it * 32 + c] = s + b_ada[it * 32 + c]; }
                __syncthreads();
            }
            __syncthreads();
        }
    }
    GRID_BAR();
#endif

#if DBG_STAGE != 1
    asm volatile("; PHASE_MARK P0b" ::: "memory");
    {
        PHASE_IDS();
        const float* x = KIN(0); const float* g_mix = KIN(4); const float* MOD = WSP(float, WS_MOD); bf16* UBUF = (bf16*)OUTP();
        const float* Ere = WSP(float, WS_ETAB); const float* Eim = Ere + NG * LC * NP * 16; bf16* BtY = WSP(bf16, WS_BTY); bf16* BtP = WSP(bf16, WS_BTP);
        const float* sc_re = KIN(11); const float* sc_im = KIN(12); const float* log_dt = KIN(14); const float* a_re = KIN(7); const float* a_im = KIN(8);
        for (int blk = gw; blk < T / 16; blk += NGW) {
            const int row0 = blk * 16, b = row0 / SEQ; const float* md = MOD + (size_t)b * 6 * D;
            f32x4 av[4], sv[4];
#pragma unroll
            for (int j = 0; j < 4; ++j) { const int c = 4 * lane + 256 * j; const f32x4 g = *(const f32x4*)(g_mix + c), sc = *(const f32x4*)(md + D + c); av[j] = g * (sc + 1.0f); sv[j] = *(const f32x4*)(md + c); }
            for (int r = 0; r < 16; ++r) {
                const float* xr = x + (size_t)(row0 + r) * D; f32x4 v[4]; float ss = 0.f;
#pragma unroll
                for (int j = 0; j < 4; ++j) { v[j] = *(const f32x4*)(xr + 4 * lane + 256 * j); ss += (v[j][0] * v[j][0] + v[j][1] * v[j][1]) + (v[j][2] * v[j][2] + v[j][3] * v[j][3]); }
                const float rstd = 1.0f / sqrtf(wave_sum(ss, lane) * (1.0f / D) + EPS);
                bf16* ur = UBUF + (size_t)(row0 + r) * D;
#pragma unroll
                for (int j = 0; j < 4; ++j) { const f32x4 o = v[j] * rstd * av[j] + sv[j]; *(GAS v2u*)(ur + 4 * lane + 256 * j) = (v2u){pk2(o[0], o[1]), pk2(o[2], o[3])}; }
            }
        }
        for (int idx = gt; idx < NG * LC * 16 * 2; idx += NGT) {
            const int cih = idx & 1, co = (idx >> 1) & 15, j = (idx >> 5) % LC, g = idx / (32 * LC);
            float kv[8];
#pragma unroll
            for (int i = 0; i < 8; ++i) kv[i] = 0.f;
            const float* er = Ere + (size_t)((g * LC + j) * NP) * 16 + cih * 8; const float* ei = Eim + (size_t)((g * LC + j) * NP) * 16 + cih * 8;
            const float* cr = sc_re + (size_t)(g * 16 + co) * NP; const float* ci_ = sc_im + (size_t)(g * 16 + co) * NP;
            for (int p = 0; p < NP; ++p) { const float c_r = cr[p], c_i = ci_[p]; const f32x4 e0 = *(const f32x4*)(er + p * 16), e1 = *(const f32x4*)(er + p * 16 + 4), f0 = *(const f32x4*)(ei + p * 16), f1 = *(const f32x4*)(ei + p * 16 + 4);
#pragma unroll
                for (int i = 0; i < 4; ++i) { kv[i] += c_r * e0[i] - c_i * f0[i]; kv[4 + i] += c_r * e1[i] - c_i * f1[i]; } }
            const v4u kw = (v4u){pk2(kv[0], kv[1]), pk2(kv[2], kv[3]), pk2(kv[4], kv[5]), pk2(kv[6], kv[7])};
            bf16* base = BtY + (size_t)g * 512 * KY;
            for (int t = j; t < LC; ++t) *(GAS v4u*)(base + (size_t)(t * 16 + co) * KY + (t - j) * 16 + cih * 8) = kw;
            if (j >= 1) for (int t = 0; t + j < LC; ++t) *(GAS v4u*)(base + (size_t)(t * 16 + co) * KY + (t + j) * 16 + cih * 8) = (v4u){0u, 0u, 0u, 0u};
        }
        for (int idx = gt; idx < NG * LC * NP; idx += NGT) {
            const int p = idx % NP, t = (idx / NP) % LC, g = idx / (NP * LC);
            const float dt = expf(log_dt[g]); float ar, ai; abar_pow(a_re[g * NP + p], a_im[g * NP + p], dt, (float)(t + 1), ar, ai);
#pragma unroll
            for (int co = 0; co < 16; ++co) { const float c_r = sc_re[(size_t)(g * 16 + co) * NP + p], c_i = sc_im[(size_t)(g * 16 + co) * NP + p];
                bf16* rowp = BtY + (size_t)(g * 512 + t * 16 + co) * KY;
                rowp[512 + p] = (bf16)f2bf(c_r * ar - c_i * ai); rowp[576 + p] = (bf16)f2bf(-(c_r * ai + c_i * ar)); }
        }
        for (int idx = gt; idx < NG * 128 * LC; idx += NGT) {
            const int s = idx % LC, nn = (idx / LC) % 128, g = idx / (LC * 128); const int p = nn & 63, im = nn >> 6;
            const float* src = (im ? Eim : Ere) + (size_t)((g * LC + (LC - 1 - s)) * NP + p) * 16;
            unsigned hw[8], lw[8];
#pragma unroll
            for (int i = 0; i < 8; ++i) { const float f0 = src[2 * i], f1 = src[2 * i + 1]; const unsigned h0 = f2bf(f0), h1 = f2bf(f1); hw[i] = h0 | (h1 << 16); lw[i] = pk2(f0 - bf2f(h0), f1 - bf2f(h1)); }
            bf16* d0 = BtP + (size_t)(g * 256 + nn) * KS + s * 16; bf16* d1 = BtP + (size_t)(g * 256 + 128 + nn) * KS + s * 16;
            *(GAS v4u*)d0 = (v4u){hw[0], hw[1], hw[2], hw[3]}; *(GAS v4u*)(d0 + 8) = (v4u){hw[4], hw[5], hw[6], hw[7]};
            *(GAS v4u*)d1 = (v4u){lw[0], lw[1], lw[2], lw[3]}; *(GAS v4u*)(d1 + 8) = (v4u){lw[4], lw[5], lw[6], lw[7]};
        }
    }
    GRID_BAR();

    asm volatile("; PHASE_MARK P1" ::: "memory");
    {
        PHASE_IDS();
        pg8::StaticOrder S; S.init(OUTP(), D, WSP(bf16, WS_WIN), D, T, INW, G, bx);
        pg8::EpiProj E{KIN(6), WSP(bf16, WS_UG), WSP(bf16, WS_Q), WSP(bf16, WS_K), WSP(bf16, WS_V), WSP(bf16, WS_GATES), attn_body::C2};
        pg8::gemm_phase<pg8::EpiProj, pg8::StaticOrder, true, true>(L + RING_OFF, D, D, D, S, E);
    }
    GRID_BAR();

    asm volatile("; PHASE_MARK P2" ::: "memory");
    {
        PHASE_IDS();
        pg8::GroupOrder S; S.init(WSP(bf16, WS_UG), KY, (size_t)NRC * KY * 2, WSP(bf16, WS_BTP), KS, (size_t)256 * KS * 2, NRC, 256, NG, G, bx);
        pg8::EpiStates E{WSP(float, WS_SLOC)};
        pg8::gemm_phase<pg8::EpiStates, pg8::GroupOrder, true, true>(L + RING_OFF, KS, KY, KS, S, E);
    }
    GRID_BAR();

    asm volatile("; PHASE_MARK P3" ::: "memory");
    {
        PHASE_IDS();
        const float* log_dt = KIN(14); const float* a_re = KIN(7); const float* a_im = KIN(8); const float* SLOC = WSP(float, WS_SLOC); bf16* UG = WSP(bf16, WS_UG);
        LAS float* seg = (LAS float*)(L + RING_OFF);
        for (int bg = vcu; bg < NB * NG; bg += G) {
            const int b = bg / NG, g = bg % NG, p = lane;
            const float dt = expf(log_dt[g]), lr = a_re[g * NP + p], li = a_im[g * NP + p];
            float alr, ali; abar_pow(lr, li, dt, (float)LC, alr, ali);
            constexpr int SEGC = NCH / NWAVES;
            float locr[SEGC], loci[SEGC]; float cr = 0.f, ci = 0.f;
            const float* sp = SLOC + ((size_t)(g * NRC + b * NCH + wave * SEGC)) * 128;
#pragma unroll
            for (int k = 0; k < SEGC; ++k) { locr[k] = cr; loci[k] = ci; const float sr = sp[k * 128 + p], si = sp[k * 128 + 64 + p]; const float nr = alr * cr - ali * ci + sr, ni = alr * ci + ali * cr + si; cr = nr; ci = ni; }
            __syncthreads();
            seg[(wave * 64 + p) * 2] = cr; seg[(wave * 64 + p) * 2 + 1] = ci;
            __syncthreads();
            float a16r = alr, a16i = ali;
#pragma unroll
            for (int q = 0; q < 4; ++q) { const float nr = a16r * a16r - a16i * a16i, ni = 2.f * a16r * a16i; a16r = nr; a16i = ni; }
            float inr = 0.f, ini = 0.f;
            for (int w = 0; w < wave; ++w) { const float er = seg[(w * 64 + p) * 2], ei = seg[(w * 64 + p) * 2 + 1]; const float nr = a16r * inr - a16i * ini + er, ni = a16r * ini + a16i * inr + ei; inr = nr; ini = ni; }
            bf16* up = UG + ((size_t)(g * NRC + b * NCH + wave * SEGC)) * KY + KS;
#pragma unroll
            for (int k = 0; k < SEGC; ++k) { up[(size_t)k * KY + p] = (bf16)f2bf(inr + locr[k]); up[(size_t)k * KY + 64 + p] = (bf16)f2bf(ini + loci[k]); const float nr = alr * inr - ali * ini, ni = alr * ini + ali * inr; inr = nr; ini = ni; }
        }
        __syncthreads();
        const bf16* Qb = WSP(bf16, WS_Q); const bf16* Kb = WSP(bf16, WS_K); const bf16* Vb = WSP(bf16, WS_V); bf16* OM = (bf16*)OUTP();
        for (int un = vcu; un < NB * 8 * 4; un += G) {
            const int half = un & 1, m = (un >> 1) & 1, h = (un >> 2) & 7, b = un >> 5;
            for (int qb = attn_body::NQB - 1; qb >= 0; --qb)
                attn_body::attn_unit<8>(b, 2 * h + m, 2 * h + half, qb, (const attn_body::bf16*)Qb, (const attn_body::bf16*)Kb, (const attn_body::bf16*)Vb, (attn_body::bf16*)(OM + (size_t)m * T * D), (char*)lds + RING_OFF);
        }
    }
    GRID_BAR();

    asm volatile("; PHASE_MARK P4" ::: "memory");
    {
        PHASE_IDS();
        pg8::GroupOrder S; S.init(WSP(bf16, WS_UG), KY, (size_t)NRC * KY * 2, WSP(bf16, WS_BTY), KY, (size_t)512 * KY * 2, NRC, 512, NG, G, bx);
        pg8::EpiY E{WSP(bf16, WS_UG), KIN(13), WSP(bf16, WS_YACT)};
        pg8::gemm_phase<pg8::EpiY, pg8::GroupOrder, true, true>(L + RING_OFF, KY, KY, KY, S, E);
        const float* lq1 = KIN(17); const float* lk1 = KIN(18); const float* lq2 = KIN(19); const float* lk2 = KIN(20); const float* g_subln = KIN(21);
        const bf16* OM = (const bf16*)OUTP(); bf16* ATTO = WSP(bf16, WS_ATTO);
        const float lam = expf(wave_sum(lq1[lane] * lk1[lane], lane)) - expf(wave_sum(lq2[lane] * lk2[lane], lane)) + LAMBDA_INIT;
        float gs[16];
#pragma unroll
        for (int i = 0; i < 16; ++i) gs[i] = g_subln[(16 * lane + i) & 127] * (1.0f - LAMBDA_INIT);
        for (int row = gw; row < T; row += NGW) {
            const bf16* o0 = OM + (size_t)row * D + 16 * lane; const bf16* o1 = o0 + (size_t)T * D;
            const v4u a0 = *(const GAS v4u*)o0, a1 = *(const GAS v4u*)(o0 + 8), c0 = *(const GAS v4u*)o1, c1 = *(const GAS v4u*)(o1 + 8);
            float fa[16], fc[16]; { float t8[8]; pg8::unpack8(a0, t8);
                _Pragma("unroll") for (int i = 0; i < 8; ++i) fa[i] = t8[i]; pg8::unpack8(a1, t8);
                _Pragma("unroll") for (int i = 0; i < 8; ++i) fa[8 + i] = t8[i]; pg8::unpack8(c0, t8);
                _Pragma("unroll") for (int i = 0; i < 8; ++i) fc[i] = t8[i]; pg8::unpack8(c1, t8);
                _Pragma("unroll") for (int i = 0; i < 8; ++i) fc[8 + i] = t8[i]; }
            float ss = 0.f;
#pragma unroll
            for (int i = 0; i < 16; ++i) { fa[i] = fa[i] - lam * fc[i]; ss += fa[i] * fa[i]; }
            ss += shfl_xor_l(ss, 1, lane); ss += shfl_xor_l(ss, 2, lane); ss += shfl_xor_l(ss, 4, lane);
            const float rstd = 1.0f / sqrtf(ss * (1.0f / 128.0f) + EPS);
            unsigned w[8];
#pragma unroll
            for (int i = 0; i < 8; ++i) w[i] = pk2(fa[2 * i] * rstd * gs[2 * i], fa[2 * i + 1] * rstd * gs[2 * i + 1]);
            bf16* dst = ATTO + (size_t)row * D + 16 * lane;
            *(GAS v4u*)dst = (v4u){w[0], w[1], w[2], w[3]}; *(GAS v4u*)(dst + 8) = (v4u){w[4], w[5], w[6], w[7]};
        }
    }
    GRID_BAR();

    asm volatile("; PHASE_MARK P5" ::: "memory");
    {
        PHASE_IDS();
        pg8::StaticOrder S; S.init(WSP(bf16, WS_YACT), S5W, WSP(bf16, WS_WGLU), S5W, T, S5W, G, bx);
        pg8::EpiGlu E{WSP(bf16, WS_YACT), KIN(16), WSP(bf16, WS_S5O)};
        pg8::gemm_phase<pg8::EpiGlu, pg8::StaticOrder, true, true>(L + RING_OFF, S5W, S5W, S5W, S, E);
    }
    GRID_BAR();

    asm volatile("; PHASE_MARK P6" ::: "memory");
    {
        PHASE_IDS();
        pg8::StaticOrder S; S.init(WSP(bf16, WS_S5O), S5W, WSP(bf16, WS_WSSM), S5W, T, D, G, bx);
        pg8::EpiBranch<0> E{WSP(bf16, WS_GATES), nullptr, WSP(bf16, WS_TMP)};
        pg8::gemm_phase<pg8::EpiBranch<0>, pg8::StaticOrder, true, true>(L + RING_OFF, S5W, S5W, S5W, S, E);
    }
    VM_WAIT(); __syncthreads();
    {
        PHASE_IDS();
        pg8::StaticOrder S; S.init(WSP(bf16, WS_ATTO), D, WSP(bf16, WS_WATT), D, T, D, G, bx);
        pg8::EpiBranch<1> E{WSP(bf16, WS_GATES), WSP(bf16, WS_TMP), (bf16*)OUTP()};
        pg8::gemm_phase<pg8::EpiBranch<1>, pg8::StaticOrder, true, true>(L + RING_OFF, D, D, D, S, E);
    }
    GRID_BAR();

    asm volatile("; PHASE_MARK P8" ::: "memory");
    {
        PHASE_IDS();
        pg8::StaticOrder S; S.init(OUTP(), D, WSP(bf16, WS_WOUT), D, T, D, G, bx);
        pg8::EpiOut E{KIN(0), WSP(float, WS_MOD), WSP(float, WS_H)};
        pg8::gemm_phase<pg8::EpiOut, pg8::StaticOrder, true, true>(L + RING_OFF, D, D, D, S, E);
    }
    GRID_BAR();
#endif

#if DBG_STAGE == 0
    asm volatile("; PHASE_MARK P9" ::: "memory");
    {
        PHASE_IDS();
        const float* g_ffn = KIN(25); const float* MOD = WSP(float, WS_MOD); const float* Hbuf = WSP(float, WS_H); bf16* U2HL = (bf16*)OUTP();
        for (int blk = gw; blk < T / 16; blk += NGW) {
            const int row0 = blk * 16, b = row0 / SEQ; const float* md = MOD + (size_t)b * 6 * D;
            f32x4 av[4], sv[4];
#pragma unroll
            for (int j = 0; j < 4; ++j) { const int c = 4 * lane + 256 * j; const f32x4 g = *(const f32x4*)(g_ffn + c), sc = *(const f32x4*)(md + 4 * D + c); av[j] = g * (sc + 1.0f); sv[j] = *(const f32x4*)(md + 3 * D + c); }
            for (int r = 0; r < 16; ++r) {
                const float* hr = Hbuf + (size_t)(row0 + r) * D; f32x4 v[4]; float ss = 0.f;
#pragma unroll
                for (int j = 0; j < 4; ++j) { v[j] = *(const f32x4*)(hr + 4 * lane + 256 * j); ss += (v[j][0] * v[j][0] + v[j][1] * v[j][1]) + (v[j][2] * v[j][2] + v[j][3] * v[j][3]); }
                const float rstd = 1.0f / sqrtf(wave_sum(ss, lane) * (1.0f / D) + EPS);
                bf16* ur = U2HL + (size_t)(row0 + r) * 2048;
#pragma unroll
                for (int j = 0; j < 4; ++j) { const f32x4 o = v[j] * rstd * av[j] + sv[j];
                    const unsigned h0 = f2bf(o[0]), h1 = f2bf(o[1]), h2 = f2bf(o[2]), h3 = f2bf(o[3]);
                    *(GAS v2u*)(ur + 4 * lane + 256 * j) = (v2u){h0 | (h1 << 16), h2 | (h3 << 16)};
                    *(GAS v2u*)(ur + D + 4 * lane + 256 * j) = (v2u){pk2(o[0] - bf2f(h0), o[1] - bf2f(h1)), pk2(o[2] - bf2f(h2), o[3] - bf2f(h3))}; }
            }
        }
    }
    GRID_BAR();

    asm volatile("; PHASE_MARK P10" ::: "memory");
    {
        PHASE_IDS();
        pg8::StaticOrder S; S.init(OUTP(), 2048, WSP(bf16, WS_WR), 2048, T, 256, G, bx);
        pg8::EpiRouter E{WSP(float, WS_LOGITS)};
        pg8::gemm_phase<pg8::EpiRouter, pg8::StaticOrder, true, true>(L + RING_OFF, 2048, 2048, 2048, S, E);
    }
    GRID_BAR();

    asm volatile("; PHASE_MARK P11" ::: "memory");
    {
        PHASE_IDS();
        const float* b_rg = KIN(27); const float* b_re = KIN(29); const float* LOGITS = WSP(float, WS_LOGITS); int* RT = WSP(int, WS_RT); int* CNT = WSP(int, WS_CTL) + CW_CNT;
        int* lcnt = (int*)(lds + RING_OFF); int* lbase = lcnt + NEXP;
        const int per = T / G;
        for (int t0 = bx * per; t0 < (bx + 1) * per; t0 += NWAVES * 64) {
            __syncthreads();
            if (tid < NEXP) lcnt[tid] = 0;
            __syncthreads();
            const int tok = t0 + tid; const bool act = tok < (bx + 1) * per;
            int e0 = 0, e1 = 0, p0 = 0, p1 = 0; float w0 = 0.f, w1 = 0.f;
            if (act) {
                const float* lg = LOGITS + (size_t)tok * 64;
                float gl[4]; int gi = 0;
#pragma unroll
                for (int i = 0; i < 4; ++i) gl[i] = lg[i] + b_rg[i];
#pragma unroll
                for (int i = 1; i < 4; ++i) if (gl[i] > gl[gi]) gi = i;
                float gsum = 0.f;
#pragma unroll
                for (int i = 0; i < 4; ++i) gsum += expf(gl[i] - gl[gi]);
                const float gp = 1.0f / gsum;
                float el[8];
#pragma unroll
                for (int i = 0; i < 8; ++i) el[i] = lg[4 + gi * 8 + i] + b_re[gi * 8 + i];
                int i0 = 0;
#pragma unroll
                for (int i = 1; i < 8; ++i) if (el[i] > el[i0]) i0 = i;
                int i1 = (i0 == 0) ? 1 : 0;
#pragma unroll
                for (int i = 0; i < 8; ++i) if (i != i0 && el[i] > el[i1]) i1 = i;
                const float ex = expf(el[i1] - el[i0]);
                w0 = gp / (1.0f + ex); w1 = gp * ex / (1.0f + ex);
                e0 = gi * 8 + i0; e1 = gi * 8 + i1;
                p0 = atomicAdd(&lcnt[e0], 1); p1 = atomicAdd(&lcnt[e1], 1);
            }
            __syncthreads();
            if (tid < NEXP) lbase[tid] = atomicAdd(&CNT[tid], lcnt[tid]);
            __syncthreads();
            if (act) { int* r = RT + (size_t)tok * 8; r[0] = e0; r[1] = lbase[e0] + p0; r[2] = __float_as_int(w0); r[3] = e1; r[4] = lbase[e1] + p1; r[5] = __float_as_int(w1); }
        }
    }
    GRID_BAR();

    asm volatile("; PHASE_MARK P12" ::: "memory");
    {
        PHASE_IDS();
        const int* RT = WSP(int, WS_RT); const int* CNT = WSP(int, WS_CTL) + CW_CNT; const bf16* U2HL = (const bf16*)OUTP(); bf16* XS = WSP(bf16, WS_XS); int* DEST = WSP(int, WS_DEST); float* CWT = WSP(float, WS_CW);
        LAS int* offs = (LAS int*)(L + RING_OFF);
        __syncthreads();
        if (tid == 0) { int a = 0; for (int e = 0; e < NEXP; ++e) { offs[e] = a; a += ((CNT[e] + 255) >> 8) << 8; } }
        __syncthreads();
        for (int tok = gw; tok < T; tok += NGW) {
            const int* r = RT + (size_t)tok * 8; const int e0 = r[0], q0 = r[1], e1 = r[3], q1 = r[4];
            const int r0 = offs[e0] + q0, r1 = offs[e1] + q1;
            const bf16* src = U2HL + (size_t)tok * 2048 + 16 * lane;
            const v4u a0 = *(const GAS v4u*)src, a1 = *(const GAS v4u*)(src + 8);
            bf16* d0 = XS + (size_t)r0 * D + 16 * lane; bf16* d1 = XS + (size_t)r1 * D + 16 * lane;
            *(GAS v4u*)d0 = a0; *(GAS v4u*)(d0 + 8) = a1; *(GAS v4u*)d1 = a0; *(GAS v4u*)(d1 + 8) = a1;
            if (lane == 0) { DEST[r0] = tok * 2; CWT[r0] = __int_as_float(r[2]); DEST[r1] = tok * 2 + 1; CWT[r1] = __int_as_float(r[5]); }
        }
        if (bx < NEXP) { const int n = CNT[bx], pad = (((n + 255) >> 8) << 8) - n; for (int i = tid; i < pad; i += NWAVES * 64) { DEST[offs[bx] + n + i] = -1; CWT[offs[bx] + n + i] = 0.f; } }
        __syncthreads();
    }
    GRID_BAR();

    asm volatile("; PHASE_MARK P13" ::: "memory");
    {
        PHASE_IDS();
        build_expert_table(L, WSP(int, WS_CTL) + CW_CNT, tid);
        pg8::ExpertOrder S; S.init((const LAS int*)(L + ETAB_OFF), WSP(bf16, WS_XS), D, WSP(bf16, WS_WE1), D, (size_t)512 * D * 2, 512, G, bx);
        pg8::EpiExp1 E{WSP(bf16, WS_HDN)};
        pg8::gemm_phase<pg8::EpiExp1, pg8::ExpertOrder, true, true>(L + RING_OFF, D, D, D, S, E);
    }
    GRID_BAR();

    asm volatile("; PHASE_MARK P14" ::: "memory");
    {
        PHASE_IDS();
        build_expert_table(L, WSP(int, WS_CTL) + CW_CNT, tid);
        pg8::ExpertOrder S; S.init((const LAS int*)(L + ETAB_OFF), WSP(bf16, WS_HDN), DEXP, WSP(bf16, WS_WE2), DEXP, (size_t)D * DEXP * 2, D, G, bx);
        pg8::EpiExp2 E{WSP(int, WS_DEST), WSP(float, WS_CW), WSP(bf16, WS_SLOTS)};
        pg8::gemm_phase<pg8::EpiExp2, pg8::ExpertOrder, true, true>(L + RING_OFF, DEXP, DEXP, DEXP, S, E);
    }
    GRID_BAR();
#endif

    asm volatile("; PHASE_MARK P15" ::: "memory");
    {
        PHASE_IDS();
        const float* x = KIN(0); const float* g_final = KIN(33); const float* Hbuf = WSP(float, WS_H); const float* MOD = WSP(float, WS_MOD); const bf16* SLOTS = WSP(bf16, WS_SLOTS); float* out = OUTP();
        (void)x; (void)Hbuf; (void)MOD; (void)SLOTS;
        for (int row = gw; row < T; row += NGW) {
            const int b = row / SEQ; f32x4 v[4]; float ss = 0.f;
#pragma unroll
            for (int j = 0; j < 4; ++j) { const int c = 4 * lane + 256 * j;
#if DBG_STAGE == 1
                v[j] = *(const f32x4*)(x + (size_t)row * D + c);
#else
                v[j] = *(const f32x4*)(Hbuf + (size_t)row * D + c);
#endif
#if DBG_STAGE == 0
                const f32x4 gt = *(const f32x4*)(MOD + (size_t)b * 6 * D + 5 * D + c);
                const v2u s0 = *(const GAS v2u*)(SLOTS + (size_t)(2 * row) * D + c), s1 = *(const GAS v2u*)(SLOTS + (size_t)(2 * row + 1) * D + c);
                const f32x4 f = (f32x4){pg8::bf_lo(s0.x) + pg8::bf_lo(s1.x), pg8::bf_hi(s0.x) + pg8::bf_hi(s1.x), pg8::bf_lo(s0.y) + pg8::bf_lo(s1.y), pg8::bf_hi(s0.y) + pg8::bf_hi(s1.y)};
                v[j] = v[j] + gt * f;
#endif
                ss += (v[j][0] * v[j][0] + v[j][1] * v[j][1]) + (v[j][2] * v[j][2] + v[j][3] * v[j][3]); }
            (void)b;
            const float rstd = 1.0f / sqrtf(wave_sum(ss, lane) * (1.0f / D) + EPS);
#pragma unroll
            for (int j = 0; j < 4; ++j) { const int c = 4 * lane + 256 * j; const f32x4 g = *(const f32x4*)(g_final + c); *(f32x4*)(out + (size_t)row * D + c) = v[j] * rstd * g; }
        }
    }
}

extern "C" void kernel_launch(void* const* d_in, const int* in_sizes, int n_in, void* d_out, int out_size, void* d_ws, size_t ws_size, hipStream_t stream) {
    static int grid = 0;
    if (grid == 0) {
        if (n_in != 34 || out_size != T * D || ws_size < WS_END) { fprintf(stderr, "kernel_launch: unexpected shapes (n_in %d, out %d, ws %zu)\n", n_in, out_size, ws_size); grid = -1; return; }
        int dev = 0, cus = 0, per_cu = 0;
        if (hipGetDevice(&dev) != hipSuccess || hipDeviceGetAttribute(&cus, hipDeviceAttributeMultiprocessorCount, dev) != hipSuccess) { grid = -1; return; }
        if (hipFuncSetAttribute((const void*)fwd_kernel, hipFuncAttributeMaxDynamicSharedMemorySize, LDS_BYTES) != hipSuccess) { fprintf(stderr, "kernel_launch: hipFuncSetAttribute failed\n"); grid = -1; return; }
        if (hipOccupancyMaxActiveBlocksPerMultiprocessor(&per_cu, (const void*)fwd_kernel, NWAVES * 64, LDS_BYTES) != hipSuccess || per_cu < 1)
            fprintf(stderr, "kernel_launch: note: occupancy query reports %d workgroups per CU\n", per_cu);
        (void)hipGetLastError();
        grid = cus;
    }
    if (grid < 0) return;
    if (hipMemsetAsync((char*)d_ws + WS_CTL, 0, CTL_ZERO_BYTES, stream) != hipSuccess) { fprintf(stderr, "kernel_launch: memset failed\n"); return; }
    Args a{};
    for (int i = 0; i < 34; ++i) a.in[i] = (const float*)d_in[i];
    a.out = (float*)d_out; a.ws = (unsigned char*)d_ws;
    hipLaunchKernelGGL(fwd_kernel, dim3(grid), dim3(NWAVES * 64), LDS_BYTES, stream, a);
    const hipError_t le = hipPeekAtLastError();
    if (le != hipSuccess) fprintf(stderr, "kernel_launch: launch failed: %s\n", hipGetErrorName(le));
}
```

```cpp
#include <hip/hip_runtime.h>
#include <hip/hip_bf16.h>
#include <cstdio>
#include <cstdint>
#include <cmath>

#ifndef DBG_STAGE
#define DBG_STAGE 0
#endif

constexpr int D = 1024, NB = 8, SEQ = 4096, T = NB * SEQ;
constexpr int S5W = 512, NG = 32, NP = 64, INW = 5632;
constexpr int LC = 32, NCH = SEQ / LC, NRC = T / LC, KS = LC * 16, KY = KS + 128;
constexpr int NEXP = 32, DEXP = 256;
constexpr int XS_ROWS = 2 * T + NEXP * 256;
constexpr float EPS = 1e-6f;
constexpr float LAMBDA_INIT = 0.2f;

namespace pg8 {
#define PG8_LAS __attribute__((address_space(3)))
typedef unsigned short bf16_t;
typedef short bf16x8 __attribute__((ext_vector_type(8)));
typedef float f32x4 __attribute__((ext_vector_type(4)));
typedef unsigned u32x4 __attribute__((ext_vector_type(4)));
typedef float f32x2 __attribute__((ext_vector_type(2)));
constexpr int BM = 256, BK = 64, HALF = 128, HTB = HALF * BK * 2, STAGE_BYTES = 8 * HTB, NXCD = 8, WGM = 8;

__host__ __device__ __forceinline__ int lds_byte(int r, int c) { const int st = (r >> 4) * 2 + (c >> 5), rr = r & 15, cc = c & 31, ob = rr * 64 + cc * 2; return st * 1024 + (ob ^ (((ob >> 9) & 1) << 5)); }
__host__ __device__ __forceinline__ void stage_rc(int b, int& R, int& C) { const int st = b / 1024, sb = b % 1024, swz = sb ^ (((sb >> 9) & 1) << 5); R = (st >> 1) * 16 + swz / 64; C = (st & 1) * 32 + (swz % 64) / 2; }
__host__ __device__ __forceinline__ int perm32(int rho) { const int n = rho >> 4, i = rho & 15; return 8 * (i >> 2) + 4 * n + (i & 3); }

struct Unit { int pm, pn, g; const char* a; const char* b; };

struct StaticOrder {
    int nM, nN, nwg, G, c; const char* A; const char* B; size_t tsa, tsb;
    __device__ void init(const void* A_, int lda, const void* B_, int ldb, int M, int N, int G_, int c_) { nM = M / BM; nN = N / BM; nwg = nM * nN; G = G_; c = c_; A = (const char*)A_; B = (const char*)B_; tsa = (size_t)BM * lda * 2; tsb = (size_t)BM * ldb * 2; }
    __device__ bool next(int i, Unit& u) const {
        const long L = (long)i * G + c; if (L >= nwg) return false;
        int wgid = (int)L; { const int q = nwg / NXCD, r = nwg % NXCD, xcd = wgid % NXCD, off = wgid / NXCD; wgid = (xcd < r ? xcd * (q + 1) : r * (q + 1) + (xcd - r) * q) + off; }
        const int nig = WGM * nN, gid = wgid / nig, fm = gid * WGM, gsz = (nM - fm) < WGM ? (nM - fm) : WGM;
        u.pm = fm + ((wgid % nig) % gsz); u.pn = (wgid % nig) / gsz; u.g = 0; u.a = A + (size_t)u.pm * tsa; u.b = B + (size_t)u.pn * tsb; return true;
    }
};
struct GroupOrder {
    int nM, nN, ng, G, c; const char* A; const char* B; size_t tsa, tsb, gsa, gsb;
    __device__ void init(const void* A_, int lda, size_t gsa_, const void* B_, int ldb, size_t gsb_, int Mg, int Ng, int ng_, int G_, int c_) {
        nM = Mg / BM; nN = Ng / BM; ng = ng_; G = G_; c = c_; A = (const char*)A_; B = (const char*)B_; tsa = (size_t)BM * lda * 2; tsb = (size_t)BM * ldb * 2; gsa = gsa_; gsb = gsb_; }
    __device__ bool next(int i, Unit& u) const {
        const long L = (long)i * G + c; if (L >= (long)ng * nM * nN) return false;
        const int per = nM * nN, g = (int)(L / per), r = (int)(L % per);
        u.g = g; u.pm = r / nN; u.pn = r % nN; u.a = A + (size_t)g * gsa + (size_t)u.pm * tsa; u.b = B + (size_t)g * gsb + (size_t)u.pn * tsb; return true;
    }
};
struct ExpertOrder {
    const PG8_LAS int* tab; int nN, G, c; const char* A; const char* B; size_t tsa, tsb, esb;
    __device__ void init(const PG8_LAS int* tab_, const void* A_, int lda, const void* B_, int ldb, size_t esb_, int N, int G_, int c_) {
        tab = tab_; nN = N / BM; G = G_; c = c_; A = (const char*)A_; B = (const char*)B_; tsa = (size_t)BM * lda * 2; tsb = (size_t)BM * ldb * 2; esb = esb_; }
    __device__ bool next(int i, Unit& u) const {
        const long L = (long)i * G + c; int rt = (int)(L / nN); const int pn = (int)(L % nN);
        if (rt > XS_ROWS / 256) rt = XS_ROWS / 256;
        const int e = __builtin_amdgcn_readfirstlane(tab[rt]);
        if (e < 0) return false;
        u.g = e; u.pm = rt; u.pn = pn; u.a = A + (size_t)rt * tsa; u.b = B + (size_t)e * esb + (size_t)pn * tsb; return true;
    }
};

__device__ __forceinline__ unsigned cvt_pk_bf16(float lo, float hi) { unsigned r; asm volatile("v_cvt_pk_bf16_f32 %0, %1, %2" : "=v"(r) : "v"(lo), "v"(hi)); return r; }
__device__ __forceinline__ float bf_lo(unsigned w) { return __uint_as_float(w << 16); }
__device__ __forceinline__ float bf_hi(unsigned w) { return __uint_as_float(w & 0xffff0000u); }
__device__ __forceinline__ float sigmoidf_(float x) { return __builtin_amdgcn_rcpf(1.0f + __builtin_amdgcn_exp2f(-1.4426950408889634f * x)); }
__device__ __forceinline__ void unpack8(const u32x4 w, float (&f)[8]) { f[0] = bf_lo(w.x); f[1] = bf_hi(w.x); f[2] = bf_lo(w.y); f[3] = bf_hi(w.y); f[4] = bf_lo(w.z); f[5] = bf_hi(w.z); f[6] = bf_lo(w.w); f[7] = bf_hi(w.w); }
__device__ __forceinline__ u32x4 pack8(const float (&f)[8]) { u32x4 w; w.x = cvt_pk_bf16(f[0], f[1]); w.y = cvt_pk_bf16(f[2], f[3]); w.z = cvt_pk_bf16(f[4], f[5]); w.w = cvt_pk_bf16(f[6], f[7]); return w; }

#define EPI_LOOP_PERM(...) \
    _Pragma("unroll") for (int ai = 0; ai < 2; ++ai) _Pragma("unroll") for (int m = 0; m < 4; ++m) { const int lrow = ai * HALF + wr * 64 + m * 16 + fr; \
        _Pragma("unroll") for (int bj = 0; bj < 2; ++bj) { const int lcol = bj * HALF + wc * 32 + 8 * fq; \
            float v[8] = {acc[ai][bj][m][0][0], acc[ai][bj][m][0][1], acc[ai][bj][m][0][2], acc[ai][bj][m][0][3], acc[ai][bj][m][1][0], acc[ai][bj][m][1][1], acc[ai][bj][m][1][2], acc[ai][bj][m][1][3]}; __VA_ARGS__ } }

struct EpiProj {
    static constexpr bool PERM = true, AFTER_DRAIN = false;
    const float* bias; bf16_t* U; bf16_t* Q; bf16_t* Kb; bf16_t* V; bf16_t* Gt; float c2;
    __device__ __forceinline__ void operator()(const f32x4 (&acc)[2][2][4][2], const Unit& u, int wr, int wc, int fr, int fq) const {
        const int ct = u.pn;
        EPI_LOOP_PERM({
            const int row = u.pm * BM + lrow, col = ct * BM + lcol;
            const f32x4 b0 = *(const f32x4*)(bias + col), b1 = *(const f32x4*)(bias + col + 4);
            v[0] += b0[0]; v[1] += b0[1]; v[2] += b0[2]; v[3] += b0[3]; v[4] += b1[0]; v[5] += b1[1]; v[6] += b1[2]; v[7] += b1[3];
            bf16_t* dst;
            if (ct < 2) { const int g = col >> 4, ci = col & 15, rc = row / LC, s = row % LC; dst = U + ((size_t)(g * NRC + rc) * KY + s * 16 + ci); }
            else if (ct < 6) { _Pragma("unroll") for (int i = 0; i < 8; ++i) v[i] *= c2; dst = Q + (size_t)row * D + (col - 512); }
            else if (ct < 10) { dst = Kb + (size_t)row * D + (col - 1536); }
            else if (ct < 14) { dst = V + (size_t)row * D + (col - 2560); }
            else { _Pragma("unroll") for (int i = 0; i < 8; ++i) v[i] = sigmoidf_(v[i]); dst = Gt + (size_t)row * 2048 + (col - 3584); }
            *(u32x4*)dst = pack8(v);
        })
    }
};
struct EpiStates {
    static constexpr bool PERM = false, AFTER_DRAIN = false;
    float* S;
    __device__ __forceinline__ void operator()(const f32x4 (&acc)[2][2][4][2], const Unit& u, int wr, int wc, int fr, int fq) const {
#pragma unroll
        for (int ai = 0; ai < 2; ++ai)
#pragma unroll
            for (int m = 0; m < 4; ++m) { const int row = u.pm * BM + ai * HALF + wr * 64 + m * 16 + fr;
#pragma unroll
                for (int n = 0; n < 2; ++n) { const f32x4 v = acc[ai][0][m][n] + acc[ai][1][m][n]; *(f32x4*)(S + ((size_t)(u.g * NRC + row) * 128 + wc * 32 + 16 * n + 4 * fq)) = v; } }
    }
};
struct EpiY {
    static constexpr bool PERM = true, AFTER_DRAIN = false;
    const bf16_t* U; const float* dskip; bf16_t* Y;
    __device__ __forceinline__ void operator()(const f32x4 (&acc)[2][2][4][2], const Unit& u, int wr, int wc, int fr, int fq) const {
        EPI_LOOP_PERM({
            const int rc = u.pm * BM + lrow, n = u.pn * BM + lcol, tt = n >> 4, co = n & 15;
            const u32x4 uw = *(const u32x4*)(U + ((size_t)(u.g * NRC + rc) * KY + n)); float uf[8]; unpack8(uw, uf);
            const f32x4 d0 = *(const f32x4*)(dskip + u.g * 16 + co), d1 = *(const f32x4*)(dskip + u.g * 16 + co + 4);
            const float dd[8] = {d0[0], d0[1], d0[2], d0[3], d1[0], d1[1], d1[2], d1[3]};
            _Pragma("unroll") for (int i = 0; i < 8; ++i) { const float y = v[i] + dd[i] * uf[i]; const float z = 1.5957691216057308f * (y + 0.044715f * y * y * y); v[i] = y * sigmoidf_(z); }
            *(u32x4*)(Y + ((size_t)(rc * LC + tt) * S5W + u.g * 16 + co)) = pack8(v);
        })
    }
};
struct EpiGlu {
    static constexpr bool PERM = true, AFTER_DRAIN = false;
    const bf16_t* Y; const float* bias; bf16_t* O;
    __device__ __forceinline__ void operator()(const f32x4 (&acc)[2][2][4][2], const Unit& u, int wr, int wc, int fr, int fq) const {
        EPI_LOOP_PERM({
            const int row = u.pm * BM + lrow, col = u.pn * BM + lcol;
            const u32x4 yw = *(const u32x4*)(Y + (size_t)row * S5W + col); float yf[8]; unpack8(yw, yf);
            const f32x4 b0 = *(const f32x4*)(bias + col), b1 = *(const f32x4*)(bias + col + 4);
            const float bb[8] = {b0[0], b0[1], b0[2], b0[3], b1[0], b1[1], b1[2], b1[3]};
            _Pragma("unroll") for (int i = 0; i < 8; ++i) v[i] = yf[i] * sigmoidf_(v[i] + bb[i]);
            *(u32x4*)(O + (size_t)row * S5W + col) = pack8(v);
        })
    }
};
template <int MODE> struct EpiBranch {
    static constexpr bool PERM = true, AFTER_DRAIN = false;
    const bf16_t* Gt; const bf16_t* Tin; bf16_t* O;
    __device__ __forceinline__ void operator()(const f32x4 (&acc)[2][2][4][2], const Unit& u, int wr, int wc, int fr, int fq) const {
        EPI_LOOP_PERM({
            const int row = u.pm * BM + lrow, col = u.pn * BM + lcol;
            const u32x4 gw = *(const u32x4*)(Gt + (size_t)row * 2048 + MODE * D + col); float gf[8]; unpack8(gw, gf);
            if (MODE == 1) { const u32x4 tw = *(const u32x4*)(Tin + (size_t)row * D + col); float tf[8]; unpack8(tw, tf);
                _Pragma("unroll") for (int i = 0; i < 8; ++i) v[i] = tf[i] + gf[i] * v[i]; }
            else { _Pragma("unroll") for (int i = 0; i < 8; ++i) v[i] = gf[i] * v[i]; }
            *(u32x4*)(O + (size_t)row * D + col) = pack8(v);
        })
    }
};
struct EpiOut {
    static constexpr bool PERM = false, AFTER_DRAIN = false;
    const float* x; const float* mod; float* H;
    __device__ __forceinline__ void operator()(const f32x4 (&acc)[2][2][4][2], const Unit& u, int wr, int wc, int fr, int fq) const {
        const int b = (u.pm * BM) / SEQ; const float* gt = mod + (size_t)b * 6 * D + 2 * D;
#pragma unroll
        for (int bj = 0; bj < 2; ++bj)
#pragma unroll
            for (int n = 0; n < 2; ++n) { const int col = u.pn * BM + bj * HALF + wc * 32 + 16 * n + 4 * fq; const f32x4 g = *(const f32x4*)(gt + col);
#pragma unroll
                for (int ai = 0; ai < 2; ++ai)
#pragma unroll
                    for (int m = 0; m < 4; ++m) { const size_t off = (size_t)(u.pm * BM + ai * HALF + wr * 64 + m * 16 + fr) * D + col;
                        const f32x4 xv = *(const f32x4*)(x + off); *(f32x4*)(H + off) = xv + g * acc[ai][bj][m][n]; } }
    }
};
struct EpiRouter {
    static constexpr bool PERM = false, AFTER_DRAIN = false;
    float* L;
    __device__ __forceinline__ void operator()(const f32x4 (&acc)[2][2][4][2], const Unit& u, int wr, int wc, int fr, int fq) const {
        if (wc < 2) {
#pragma unroll
            for (int ai = 0; ai < 2; ++ai)
#pragma unroll
                for (int m = 0; m < 4; ++m) { const int row = u.pm * BM + ai * HALF + wr * 64 + m * 16 + fr;
#pragma unroll
                    for (int n = 0; n < 2; ++n) { const f32x4 v = acc[ai][0][m][n] + acc[ai][1][m][n]; *(f32x4*)(L + (size_t)row * 64 + wc * 32 + 16 * n + 4 * fq) = v; } }
        }
    }
};
struct EpiExp1 {
    static constexpr bool PERM = true, AFTER_DRAIN = false;
    bf16_t* Hd;
    __device__ __forceinline__ void operator()(const f32x4 (&acc)[2][2][4][2], const Unit& u, int wr, int wc, int fr, int fq) const {
#pragma unroll
        for (int ai = 0; ai < 2; ++ai)
#pragma unroll
            for (int m = 0; m < 4; ++m) { const int row = u.pm * BM + ai * HALF + wr * 64 + m * 16 + fr; float v[8];
#pragma unroll
                for (int n = 0; n < 2; ++n)
#pragma unroll
                    for (int i = 0; i < 4; ++i) { const float g = acc[ai][0][m][n][i], up = acc[ai][1][m][n][i]; v[n * 4 + i] = g * sigmoidf_(g) * up; }
                *(u32x4*)(Hd + (size_t)row * DEXP + u.pn * HALF + wc * 32 + 8 * fq) = pack8(v); }
    }
};
struct EpiExp2 {
    static constexpr bool PERM = true, AFTER_DRAIN = false;
    const int* dest; const float* cw; bf16_t* Sl;
    __device__ __forceinline__ void operator()(const f32x4 (&acc)[2][2][4][2], const Unit& u, int wr, int wc, int fr, int fq) const {
        EPI_LOOP_PERM({
            const int row = u.pm * BM + lrow, col = u.pn * BM + lcol; const int d = dest[row]; const float w = cw[row];
            if (d >= 0) { _Pragma("unroll") for (int i = 0; i < 8; ++i) v[i] *= w; *(u32x4*)(Sl + (size_t)d * D + col) = pack8(v); }
        })
    }
};

template <class Epi, class Sched, bool ALIGN_EPI = false, bool SP2 = false>
__device__ __forceinline__ void gemm_phase(PG8_LAS unsigned char* lds, const int K, const int lda, const int ldb, const Sched& S, const Epi& E) {
    int tid = threadIdx.x; asm volatile("" : "+v"(tid));
    const int wid = __builtin_amdgcn_readfirstlane(tid >> 6), lane = tid & 63, wr = wid >> 2, wc = wid & 3, fr = lane & 15, fq = lane >> 4;
    const int nt = K / BK;
    unsigned voffA[2], voffB[2];
#pragma unroll
    for (int i = 0; i < 2; ++i) { int R, C; stage_rc(tid * 16 + i * 8192, R, C); const int Rb = Epi::PERM ? ((R & ~31) + perm32(R & 31)) : R;
        voffA[i] = (unsigned)(R * lda + C) * 2u; voffB[i] = (unsigned)(Rb * ldb + C) * 2u; }
    const size_t kstep = (size_t)(BK * 2);
    const size_t hstepA = (size_t)HALF * lda * 2, hstepB = (size_t)HALF * ldb * 2;
    const unsigned ldsw = (unsigned)wid * 1024u;
    const int aoff = lds_byte(wr * 64 + fr, fq * 8), boff = lds_byte(wc * 32 + fr, fq * 8);
#define PG8_SA(b, h) (((b) * 2 + (h)) * HTB)
#define PG8_SB(b, h) ((4 + (b) * 2 + (h)) * HTB)
#define PG8_STAGE(bufoff, gbase, voff) do { _Pragma("unroll") for (int _i = 0; _i < 2; ++_i) \
        __builtin_amdgcn_global_load_lds((const unsigned*)((const char*)(gbase) + (voff)[_i]), (PG8_LAS unsigned*)(lds + (bufoff) + ldsw + _i * 8192), 16, 0, 0); } while (0)
#define PG8_LDA(dst, b, h) do { _Pragma("unroll") for (int m = 0; m < 4; ++m) _Pragma("unroll") for (int k = 0; k < 2; ++k) dst[m][k] = *(const PG8_LAS bf16x8*)(lds + PG8_SA(b, h) + aoff + m * 2048 + k * 1024); } while (0)
#define PG8_LDB(dst, b, h) do { _Pragma("unroll") for (int n = 0; n < 2; ++n) _Pragma("unroll") for (int k = 0; k < 2; ++k) dst[n][k] = *(const PG8_LAS bf16x8*)(lds + PG8_SB(b, h) + boff + n * 2048 + k * 1024); } while (0)
#define PG8_MMA(ai, bj, At, Bt) do { __builtin_amdgcn_s_setprio(1); _Pragma("unroll") for (int m = 0; m < 4; ++m) _Pragma("unroll") for (int n = 0; n < 2; ++n) _Pragma("unroll") for (int k = 0; k < 2; ++k) \
        acc[ai][bj][m][n] = __builtin_amdgcn_mfma_f32_16x16x32_bf16(Bt[n][k], At[m][k], acc[ai][bj][m][n], 0, 0, 0); __builtin_amdgcn_s_setprio(0); } while (0)
#define PG8_WAIT_V(n) asm volatile("s_waitcnt vmcnt(" #n ")" ::: "memory")
#define PG8_WAIT_L(n) asm volatile("s_waitcnt lgkmcnt(" #n ")" ::: "memory")
#define PG8_BAR __builtin_amdgcn_s_barrier()
#define PG8_SCHED __builtin_amdgcn_sched_barrier(0)
    Unit cur, nxt; int ui = 0;
    if (!S.next(0, cur)) return;
    f32x4 acc[2][2][4][2];
#pragma unroll
    for (int a = 0; a < 2; ++a)
#pragma unroll
        for (int b = 0; b < 2; ++b)
#pragma unroll
            for (int m = 0; m < 4; ++m)
#pragma unroll
                for (int n = 0; n < 2; ++n) acc[a][b][m][n] = (f32x4){0.f, 0.f, 0.f, 0.f};
    bf16x8 At[4][2], B0[2][2], B1[2][2];
    const char* cA = cur.a; const char* cB = cur.b;
    if constexpr (SP2) {
        PG8_STAGE(PG8_SB(0, 0), cB, voffB); PG8_STAGE(PG8_SB(0, 1), cB + hstepB, voffB); PG8_STAGE(PG8_SA(0, 0), cA, voffA); PG8_STAGE(PG8_SA(0, 1), cA + hstepA, voffA);
        if (wr == 1) PG8_BAR;
        PG8_WAIT_V(2); PG8_BAR;
        PG8_STAGE(PG8_SB(1, 0), cB + kstep, voffB); PG8_STAGE(PG8_SA(1, 0), cA + kstep, voffA); PG8_STAGE(PG8_SB(1, 1), cB + hstepB + kstep, voffB);
        PG8_WAIT_V(6); PG8_BAR;
    } else {
        PG8_STAGE(PG8_SB(0, 0), cB, voffB); PG8_STAGE(PG8_SA(0, 0), cA, voffA); PG8_STAGE(PG8_SB(0, 1), cB + hstepB, voffB); PG8_STAGE(PG8_SA(0, 1), cA + hstepA, voffA);
        if (wr == 1) PG8_BAR;
        PG8_WAIT_V(4); PG8_BAR;
        PG8_STAGE(PG8_SB(1, 0), cB + kstep, voffB); PG8_STAGE(PG8_SA(1, 0), cA + kstep, voffA); PG8_STAGE(PG8_SB(1, 1), cB + hstepB + kstep, voffB);
        PG8_WAIT_V(6); PG8_BAR;
    }
    for (;;) {
        const bool has_next = S.next(ui + 1, nxt);
        const char* nA = has_next ? nxt.a : cA; const char* nB = has_next ? nxt.b : cB;
        for (int t = 0; t < nt; t += 2) {
            const bool last = (t == nt - 2);
            const char* a1 = cA + (size_t)(t + 1) * kstep;
            const char* a2 = last ? nA : cA + (size_t)(t + 2) * kstep; const char* b2 = last ? nB : cB + (size_t)(t + 2) * kstep;
            const char* a3 = a2 + kstep; const char* b3 = b2 + kstep;
            if constexpr (SP2) {
            PG8_LDB(B0, 0, 0); PG8_LDB(B1, 0, 1); PG8_SCHED; PG8_LDA(At, 0, 0); PG8_STAGE(PG8_SA(1, 1), a1 + hstepA, voffA);
            PG8_WAIT_V(8); PG8_WAIT_L(0); PG8_BAR; PG8_MMA(0, 0, At, B0); PG8_MMA(0, 1, At, B1); PG8_BAR; PG8_SCHED;
            PG8_LDA(At, 0, 1); PG8_STAGE(PG8_SB(0, 0), b2, voffB); PG8_STAGE(PG8_SB(0, 1), b2 + hstepB, voffB); PG8_STAGE(PG8_SA(0, 0), a2, voffA);
            PG8_WAIT_V(8); PG8_WAIT_L(0); PG8_BAR; PG8_MMA(1, 0, At, B0); PG8_MMA(1, 1, At, B1); PG8_BAR; PG8_SCHED;
            PG8_LDB(B0, 1, 0); PG8_LDB(B1, 1, 1); PG8_SCHED; PG8_LDA(At, 1, 0); PG8_STAGE(PG8_SA(0, 1), a2 + hstepA, voffA);
            PG8_WAIT_V(8); PG8_WAIT_L(0); PG8_BAR; PG8_MMA(0, 0, At, B0); PG8_MMA(0, 1, At, B1); PG8_BAR; PG8_SCHED;
            PG8_LDA(At, 1, 1); PG8_STAGE(PG8_SB(1, 0), b3, voffB); PG8_STAGE(PG8_SB(1, 1), b3 + hstepB, voffB); PG8_STAGE(PG8_SA(1, 0), a3, voffA);
            PG8_WAIT_V(8); PG8_WAIT_L(0); PG8_BAR; PG8_MMA(1, 0, At, B0); PG8_MMA(1, 1, At, B1); PG8_BAR; PG8_SCHED;
            } else {
            PG8_LDB(B0, 0, 0); PG8_SCHED; PG8_LDA(At, 0, 0); PG8_STAGE(PG8_SA(1, 1), a1 + hstepA, voffA);
            PG8_WAIT_L(8); PG8_BAR; PG8_WAIT_L(0); PG8_MMA(0, 0, At, B0); PG8_BAR; PG8_SCHED;
            PG8_LDB(B1, 0, 1); PG8_STAGE(PG8_SB(0, 0), b2, voffB);
            PG8_BAR; PG8_WAIT_L(0); PG8_MMA(0, 1, At, B1); PG8_BAR;
            PG8_LDA(At, 0, 1); PG8_STAGE(PG8_SA(0, 0), a2, voffA);
            PG8_BAR; PG8_WAIT_L(0); PG8_MMA(1, 0, At, B0); PG8_BAR; PG8_SCHED;
            PG8_STAGE(PG8_SB(0, 1), b2 + hstepB, voffB);
            PG8_WAIT_V(6); PG8_BAR; PG8_MMA(1, 1, At, B1); PG8_BAR;
            PG8_LDB(B0, 1, 0); PG8_SCHED; PG8_LDA(At, 1, 0); PG8_STAGE(PG8_SA(0, 1), a2 + hstepA, voffA);
            PG8_WAIT_L(8); PG8_BAR; PG8_WAIT_L(0); PG8_MMA(0, 0, At, B0); PG8_BAR; PG8_SCHED;
            PG8_LDB(B1, 1, 1); PG8_STAGE(PG8_SB(1, 0), b3, voffB);
            PG8_BAR; PG8_WAIT_L(0); PG8_MMA(0, 1, At, B1); PG8_BAR;
            PG8_LDA(At, 1, 1); PG8_STAGE(PG8_SA(1, 0), a3, voffA);
            PG8_BAR; PG8_WAIT_L(0); PG8_MMA(1, 0, At, B0); PG8_BAR; PG8_SCHED;
            PG8_STAGE(PG8_SB(1, 1), b3 + hstepB, voffB);
            PG8_WAIT_V(6); PG8_BAR; PG8_MMA(1, 1, At, B1); PG8_BAR;
            }
        }
        if constexpr (ALIGN_EPI) { if (wr == 0) PG8_BAR; }
        E(acc, cur, wr, wc, fr, fq);
        if (!has_next) break;
#pragma unroll
        for (int a = 0; a < 2; ++a)
#pragma unroll
            for (int b = 0; b < 2; ++b)
#pragma unroll
                for (int m = 0; m < 4; ++m)
#pragma unroll
                    for (int n = 0; n < 2; ++n) acc[a][b][m][n] = (f32x4){0.f, 0.f, 0.f, 0.f};
        cur = nxt; cA = nA; cB = nB; ++ui;
        if constexpr (ALIGN_EPI) { if (wr == 1) PG8_BAR; }
    }
    PG8_WAIT_V(0);
    if constexpr (!ALIGN_EPI) { if (wr == 0) PG8_BAR; }
    PG8_BAR;
#undef PG8_SA
#undef PG8_SB
#undef PG8_STAGE
#undef PG8_LDA
#undef PG8_LDB
#undef PG8_MMA
#undef PG8_WAIT_V
#undef PG8_WAIT_L
#undef PG8_BAR
#undef PG8_SCHED
}
}

namespace attn_body {
using bf16=__hip_bfloat16;
using bf16x8=__attribute__((ext_vector_type(8)))short;
using s16x4=__attribute__((ext_vector_type(4)))short;
using f32x16=__attribute__((ext_vector_type(16)))float;
using u32x4=__attribute__((ext_vector_type(4)))unsigned;
constexpr int NHEAD=16,SEQ=4096,D=64,DM=NHEAD*D;
constexpr int NW=8,QBLK=32,QB=QBLK*NW,KVBLK=64,NQB=SEQ/QB;
__device__ __forceinline__ int crow(int r,int hi){return (r&3)+8*(r>>2)+4*hi;}
#define SBAR() __builtin_amdgcn_sched_barrier(0)
__device__ __forceinline__ void cmask(f32x16&p0,f32x16&p1,int jb,int wid){
  const float NEG=-INFINITY;
  if(jb>(wid>>1)){
  #pragma unroll
  for(int r=0;r<16;++r){p0[r]=NEG;p1[r]=NEG;}}
}
constexpr int NSLOT=3, SLOTB=8192, VSLOTB=16384;
constexpr int LDS_K=0, LDS_V=NSLOT*SLOTB, LDS_WS=LDS_V+NSLOT*VSLOTB, LDS_OST=LDS_WS+NW*64*4, LDS_BYTES=LDS_OST+NW*8192;
constexpr float C2=0.125f*1.4426950408889634f;
__device__ __forceinline__ void glds16(const char*sbase,unsigned voff,unsigned lds_dst){unsigned keep;
  asm volatile("s_mov_b32 %0, m0\n\ts_mov_b32 m0, %2\n\ts_nop 0\n\tglobal_load_lds_dwordx4 %1, %3\n\ts_mov_b32 m0, %0":"=&s"(keep):"v"(voff),"s"(lds_dst),"s"(sbase):"memory");}
__device__ __forceinline__ float max3f(float a,float b,float c){float r;asm("v_max3_f32 %0, %1, %2, %3":"=v"(r):"v"(a),"v"(b),"v"(c));return r;}
__device__ __forceinline__ float max2f(float a,float b){float r;asm("v_max_f32_e32 %0, %1, %2":"=v"(r):"v"(a),"v"(b));return r;}
typedef float f32x2_t __attribute__((ext_vector_type(2))); typedef __bf16 bf16x2_t __attribute__((ext_vector_type(2)));
__device__ __forceinline__ unsigned cvtpk_s(float lo,float hi){f32x2_t v={lo,hi};bf16x2_t b=__builtin_convertvector(v,bf16x2_t);return __builtin_bit_cast(unsigned,b);}
#define WAIT_BAR(N) asm volatile("s_waitcnt vmcnt(" #N ") lgkmcnt(0)\n\ts_barrier":::"memory")

__device__ __forceinline__ void qkt(f32x16&p0,f32x16&p1,const char*Kslot,const bf16x8*qr,int r32,int hi){
  const char*kb=Kslot+hi*1024+r32*16; const f32x16 z=f32x16{};
  #pragma unroll
  for(int d0=0;d0<4;++d0){
    const bf16x8 b0=*reinterpret_cast<const bf16x8*>(kb+d0*2048);
    const bf16x8 b1=*reinterpret_cast<const bf16x8*>(kb+d0*2048+512);
    if(d0==0){p0=__builtin_amdgcn_mfma_f32_32x32x16_bf16(b0,qr[0],z,0,0,0);p1=__builtin_amdgcn_mfma_f32_32x32x16_bf16(b1,qr[0],z,0,0,0);}
    else{p0=__builtin_amdgcn_mfma_f32_32x32x16_bf16(b0,qr[d0],p0,0,0,0);p1=__builtin_amdgcn_mfma_f32_32x32x16_bf16(b1,qr[d0],p1,0,0,0);}}
}
typedef __attribute__((address_space(3))) const char* lds_cptr;
typedef short v4i16_t __attribute__((ext_vector_type(4)));
__device__ __forceinline__ void kload8(bf16x8*kf,lds_cptr kp){
  kf[0]=*(const __attribute__((address_space(3))) bf16x8*)(kp);      kf[1]=*(const __attribute__((address_space(3))) bf16x8*)(kp+512);
  kf[2]=*(const __attribute__((address_space(3))) bf16x8*)(kp+2048); kf[3]=*(const __attribute__((address_space(3))) bf16x8*)(kp+2560);
  kf[4]=*(const __attribute__((address_space(3))) bf16x8*)(kp+4096); kf[5]=*(const __attribute__((address_space(3))) bf16x8*)(kp+4608);
  kf[6]=*(const __attribute__((address_space(3))) bf16x8*)(kp+6144); kf[7]=*(const __attribute__((address_space(3))) bf16x8*)(kp+6656);
}
__device__ __forceinline__ void kload2(bf16x8*kf,lds_cptr kp,int j){ kf[2*j]=*(const __attribute__((address_space(3))) bf16x8*)(kp+j*2048); kf[2*j+1]=*(const __attribute__((address_space(3))) bf16x8*)(kp+j*2048+512); }
__device__ __forceinline__ s16x4 vtr(lds_cptr p){ return __builtin_bit_cast(s16x4,__builtin_amdgcn_ds_read_tr16_b64_v4i16((__attribute__((address_space(3))) v4i16_t*)p)); }
__device__ __forceinline__ float rowmax(const f32x16&p0,const f32x16&p1){
  float a=max3f(p0[0],p0[1],p1[0]),b=max3f(p0[2],p0[3],p1[1]);a=max3f(a,p1[2],p1[3]);
  #pragma unroll
  for(int r=4;r<16;r+=4){a=max3f(a,p0[r],p0[r+1]);b=max3f(b,p0[r+2],p0[r+3]);a=max3f(a,p1[r],p1[r+1]);b=max3f(b,p1[r+2],p1[r+3]);}
  const float m=max2f(a,b);
  auto rr=__builtin_amdgcn_permlane32_swap(__float_as_uint(m),__float_as_uint(m),false,false);
  return max2f(__uint_as_float(rr[0]),__uint_as_float(rr[1]));
}
__device__ __forceinline__ void pv(f32x16*o,int vb,bf16x8 pa0,bf16x8 pa1,bf16x8 pa2,bf16x8 pa3){
  #pragma unroll
  for(int d0=0;d0<4;++d0){s16x4 lo[4],hi[4];
    #pragma unroll
    for(int ks=0;ks<4;++ks){
      asm volatile("ds_read_b64_tr_b16 %0,%1 offset:%c2":"=&v"(lo[ks]):"v"(vb),"i"(d0*4096+ks*1024):"memory");
      asm volatile("ds_read_b64_tr_b16 %0,%1 offset:%c2":"=&v"(hi[ks]):"v"(vb),"i"(d0*4096+ks*1024+512):"memory");}
    asm volatile("s_waitcnt lgkmcnt(0)":::"memory");SBAR();
    #define PK(k) (bf16x8){lo[k][0],lo[k][1],lo[k][2],lo[k][3],hi[k][0],hi[k][1],hi[k][2],hi[k][3]}
    o[d0]=__builtin_amdgcn_mfma_f32_32x32x16_bf16(pa0,PK(0),o[d0],0,0,0);
    o[d0]=__builtin_amdgcn_mfma_f32_32x32x16_bf16(pa1,PK(1),o[d0],0,0,0);
    o[d0]=__builtin_amdgcn_mfma_f32_32x32x16_bf16(pa2,PK(2),o[d0],0,0,0);
    o[d0]=__builtin_amdgcn_mfma_f32_32x32x16_bf16(pa3,PK(3),o[d0],0,0,0);
    #undef PK
  }
}
template<int THRL,size_t OFF_Q,size_t OFF_K,size_t OFF_V,int GSO> __device__ __forceinline__ void attn_unit(int b,int h,int qb,const char*ws,bf16*AO,float lam,char*shm){
  const bf16*Q=(const bf16*)(ws+OFF_Q); const float*gs=(const float*)(shm+GSO);
  int tid=threadIdx.x; asm volatile("":"+v"(tid)); const int lane=tid&63,r32=lane&31,hi=lane>>5; const int wid=__builtin_amdgcn_readfirstlane(tid>>6);
  const long rowbase=(long)b*SEQ; const int q0=qb*QB;
  const unsigned lds0=(unsigned)(uintptr_t)shm;
  float*wsf=(float*)(shm+LDS_WS)+wid*64;
  bf16*stg=(bf16*)(shm+LDS_OST)+wid*4096;
  const unsigned kdst=lds0+LDS_K+wid*1024, vdst=lds0+LDS_V+wid*1024;
  const int vb0=(int)(lds0+LDS_V)+((lane>>4)&1)*32+(lane&3)*8+(4*hi+((lane&15)>>2))*64;
  const char*Kbase=shm+LDS_K;
  const lds_cptr shm3=(lds_cptr)shm; const lds_cptr kp0=shm3+LDS_K+hi*1024+r32*16; const lds_cptr vp0=shm3+LDS_V+((lane>>4)&1)*32+(lane&3)*8+(4*hi+((lane&15)>>2))*64;
  const int NT=(q0+QB)/KVBLK;
  const char*Vh=ws+OFF_V+(rowbase*DM+h*128)*2;
  const unsigned vsrc=(unsigned)(((16*(wid&3)+(lane>>2))*DM+(wid>>2)*32+(lane&3)*8)*2);
  #pragma unroll 1
  for(int mp=0;mp<2;++mp){
  const int hq=2*h+mp;
  const bf16*Qw=Q+(rowbase+q0+wid*QBLK)*DM+hq*D;
  const char*Kh=ws+OFF_K+(rowbase*DM+hq*D)*2;
  const unsigned ksrc=(unsigned)((lane*DM+wid*8)*2);
  bf16x8 kf[8];
  #define DMA_K(t,slot) glds16(Kh+(long)(t)*(KVBLK*DM*2),ksrc,(unsigned)__builtin_amdgcn_readfirstlane(kdst+(slot)))
  #define DMA_V(t,slot) do{ glds16(Vh+(long)(t)*(KVBLK*DM*2),vsrc,(unsigned)__builtin_amdgcn_readfirstlane(vdst+2*(slot))); glds16(Vh+(long)(t)*(KVBLK*DM*2)+128,vsrc,(unsigned)__builtin_amdgcn_readfirstlane(vdst+2*(slot)+8192)); }while(0)
  DMA_K(0,0);DMA_V(0,0);DMA_K(1,SLOTB);
  bf16x8 qr[4];
  #pragma unroll
  for(int d0=0;d0<4;++d0)qr[d0]=*reinterpret_cast<const bf16x8*>(&Qw[(long)r32*DM+d0*16+hi*8]);
  float mhat=0.f,l_reg=0.f;f32x16 o[4];o[0]=f32x16{};o[1]=f32x16{};o[2]=f32x16{};o[3]=f32x16{};
  #define CMASK(P0,P1,t) do{int jb_=(t)-(NT-4); if(jb_>=0)cmask(P0,P1,jb_,wid);}while(0)
  bool resc=false;
  #define RESC() do{ if(resc){ asm volatile("s_waitcnt lgkmcnt(0)":::"memory"); \
      _Pragma("unroll") for(int d_=0;d_<4;++d_) _Pragma("unroll") for(int r=0;r<16;++r)o[d_][r]*=wsf[crow(r,hi)]; } }while(0)
  f32x16 pA0,pA1,pB0,pB1;
  int sl_prev=0,sl_cur=0,sl_next=SLOTB;
  #define ROT() do{sl_prev=sl_cur;sl_cur=sl_next;sl_next=(sl_next==(NSLOT-1)*SLOTB)?0:sl_next+SLOTB;}while(0)
  DMA_K(2,2*SLOTB);
  WAIT_BAR(4);
  qkt(pA0,pA1,Kbase,qr,r32,hi);asm volatile("s_nop 15\n\ts_nop 7":"+v"(pA0),"+v"(pA1));CMASK(pA0,pA1,0);
  { const float rm=rowmax(pA0,pA1); mhat=rm; resc=false;
    _Pragma("unroll") for(int r=0;r<16;++r){pA0[r]=__builtin_amdgcn_exp2f(pA0[r]-mhat);pA1[r]=__builtin_amdgcn_exp2f(pA1[r]-mhat);} }
  WAIT_BAR(0);
  DMA_K(3,0);DMA_V(1,SLOTB);
  ROT();
  kload8(kf,kp0+sl_cur);
  WAIT_BAR(3);
  s16x4 vlo[8],vhi[8]; u32x4 pw0,pw1,pw2,pw3;
  #define PKW(P,B) cvtpk_s(P[B],P[B+1])
  #define PAF(k) __builtin_bit_cast(bf16x8,pw##k)
  #define VFR(i) (bf16x8){vlo[i][0],vlo[i][1],vlo[i][2],vlo[i][3],vhi[i][0],vhi[i][1],vhi[i][2],vhi[i][3]}
  #define PIN(x) asm volatile("":"+v"(x))
  #define MX3(a,b,c) __builtin_fmaxf(__builtin_fmaxf((a),(b)),(c))
  #define ZC (f32x16{})
  #define GAPA(MF,A0,A1,A2,A3,W0,W1,PW) do{ MF; sacc+=A0; sacc+=A1; sacc+=A2; sacc+=A3; PIN(sacc); W0; W1; PIN(PW); SBAR(); }while(0)
  #define EX(v) __builtin_amdgcn_exp2f((v)-mhat)
  #define GAPB(MF,X,B) do{ MF; X[B]=EX(X[B]); X[B+1]=EX(X[B+1]); PIN(X); SBAR(); }while(0)
  #define VRD(i) do{ vlo[i]=vtr(vp_+(((i)>>2)*4096+((i)&3)*1024)); vhi[i]=vtr(vp_+(((i)>>2)*4096+((i)&3)*1024+512)); }while(0)
  #define VRD2(i) do{ vlo[i]=vtr(vp_+((2+((i)>>2))*4096+((i)&3)*1024)); vhi[i]=vtr(vp_+((2+((i)>>2))*4096+((i)&3)*1024+512)); SBAR(); }while(0)
  #define KRD(G,j) do{ if(G){ kload2(kf,kp0+sl_next,j); SBAR(); } }while(0)
  #define STEP(C0,C1,P0,P1,t,GK,GV,GL) do{ SBAR(); \
    const lds_cptr vp_=vp0+2*sl_prev; \
    VRD(0); SBAR(); float sacc=(P0[0]+P0[1]); \
    GAPA(C0=__builtin_amdgcn_mfma_f32_32x32x16_bf16(kf[0],qr[0],ZC,0,0,0), P0[2],P0[3],P0[4],P0[5],     pw0[0]=PKW(P0,0), pw0[1]=PKW(P0,2), pw0); \
    VRD(4); SBAR(); GAPA(C1=__builtin_amdgcn_mfma_f32_32x32x16_bf16(kf[1],qr[0],ZC,0,0,0), P0[6],P0[7],P0[8],P0[9],     pw0[2]=PKW(P0,4), pw0[3]=PKW(P0,6), pw0); \
    VRD(1); SBAR(); GAPA(C0=__builtin_amdgcn_mfma_f32_32x32x16_bf16(kf[2],qr[1],C0,0,0,0),   P0[10],P0[11],P0[12],P0[13], pw1[0]=PKW(P0,8), pw1[1]=PKW(P0,10), pw1); \
    VRD(5); SBAR(); GAPA(C1=__builtin_amdgcn_mfma_f32_32x32x16_bf16(kf[3],qr[1],C1,0,0,0),   P0[14],P0[15],P1[0],P1[1],   pw1[2]=PKW(P0,12),pw1[3]=PKW(P0,14), pw1); \
    VRD(2); SBAR(); GAPA(C0=__builtin_amdgcn_mfma_f32_32x32x16_bf16(kf[4],qr[2],C0,0,0,0),   P1[2],P1[3],P1[4],P1[5],     pw2[0]=PKW(P1,0), pw2[1]=PKW(P1,2), pw2); \
    VRD(6); SBAR(); GAPA(C1=__builtin_amdgcn_mfma_f32_32x32x16_bf16(kf[5],qr[2],C1,0,0,0),   P1[6],P1[7],P1[8],P1[9],     pw2[2]=PKW(P1,4), pw2[3]=PKW(P1,6), pw2); \
    VRD(3); SBAR(); GAPA(C0=__builtin_amdgcn_mfma_f32_32x32x16_bf16(kf[6],qr[3],C0,0,0,0),   P1[10],P1[11],P1[12],P1[13], pw3[0]=PKW(P1,8), pw3[1]=PKW(P1,10), pw3); \
    VRD(7); SBAR(); GAPA(C1=__builtin_amdgcn_mfma_f32_32x32x16_bf16(kf[7],qr[3],C1,0,0,0),   P1[14],P1[15],0.f,0.f,       pw3[2]=PKW(P1,12),pw3[3]=PKW(P1,14), pw3); \
    l_reg+=sacc; \
    if(GK){DMA_K((t)+3,sl_cur);} if(GV){DMA_V((t)+1,sl_next);} \
    CMASK(C0,C1,t); \
    { float a=MX3(C0[0],C0[1],C1[0]),b=MX3(C0[2],C0[3],C1[1]); a=MX3(a,C1[2],C1[3]); \
      _Pragma("unroll") for(int r=4;r<16;r+=4){a=MX3(a,C0[r],C0[r+1]);b=MX3(b,C0[r+2],C0[r+3]);a=MX3(a,C1[r],C1[r+1]);b=MX3(b,C1[r+2],C1[r+3]);} \
      float rm=__builtin_fmaxf(a,b); { auto rr=__builtin_amdgcn_permlane32_swap(__float_as_uint(rm),__float_as_uint(rm),false,false); rm=__builtin_fmaxf(__uint_as_float(rr[0]),__uint_as_float(rr[1])); } \
      rm-=mhat; resc=false; \
      if(__builtin_expect(__any(rm>(float)THRL),0)){ const float dl=__builtin_fmaxf(rm,0.f); mhat+=dl; \
        const float f=__builtin_amdgcn_exp2f(-dl); l_reg*=f; if(hi==0)wsf[r32]=f; resc=true; } } \
    SBAR(); \
    GAPB(o[0]=__builtin_amdgcn_mfma_f32_32x32x16_bf16(PAF(0),VFR(0),o[0],0,0,0), C0,0);  VRD2(0); \
    GAPB(o[1]=__builtin_amdgcn_mfma_f32_32x32x16_bf16(PAF(0),VFR(4),o[1],0,0,0), C0,2);  VRD2(4); \
    GAPB(o[0]=__builtin_amdgcn_mfma_f32_32x32x16_bf16(PAF(1),VFR(1),o[0],0,0,0), C0,4);  VRD2(1); \
    GAPB(o[1]=__builtin_amdgcn_mfma_f32_32x32x16_bf16(PAF(1),VFR(5),o[1],0,0,0), C0,6);  VRD2(5); \
    GAPB(o[0]=__builtin_amdgcn_mfma_f32_32x32x16_bf16(PAF(2),VFR(2),o[0],0,0,0), C0,8);  VRD2(2); \
    GAPB(o[1]=__builtin_amdgcn_mfma_f32_32x32x16_bf16(PAF(2),VFR(6),o[1],0,0,0), C0,10); VRD2(6); \
    GAPB(o[0]=__builtin_amdgcn_mfma_f32_32x32x16_bf16(PAF(3),VFR(3),o[0],0,0,0), C0,12); VRD2(3); \
    GAPB(o[1]=__builtin_amdgcn_mfma_f32_32x32x16_bf16(PAF(3),VFR(7),o[1],0,0,0), C0,14); VRD2(7); \
    KRD(GL,0); GAPB(o[2]=__builtin_amdgcn_mfma_f32_32x32x16_bf16(PAF(0),VFR(0),o[2],0,0,0), C1,0); \
    KRD(GL,1); GAPB(o[3]=__builtin_amdgcn_mfma_f32_32x32x16_bf16(PAF(0),VFR(4),o[3],0,0,0), C1,2); \
    KRD(GL,2); GAPB(o[2]=__builtin_amdgcn_mfma_f32_32x32x16_bf16(PAF(1),VFR(1),o[2],0,0,0), C1,4); \
    KRD(GL,3); GAPB(o[3]=__builtin_amdgcn_mfma_f32_32x32x16_bf16(PAF(1),VFR(5),o[3],0,0,0), C1,6); \
    GAPB(o[2]=__builtin_amdgcn_mfma_f32_32x32x16_bf16(PAF(2),VFR(2),o[2],0,0,0), C1,8); \
    GAPB(o[3]=__builtin_amdgcn_mfma_f32_32x32x16_bf16(PAF(2),VFR(6),o[3],0,0,0), C1,10); \
    GAPB(o[2]=__builtin_amdgcn_mfma_f32_32x32x16_bf16(PAF(3),VFR(3),o[2],0,0,0), C1,12); \
    GAPB(o[3]=__builtin_amdgcn_mfma_f32_32x32x16_bf16(PAF(3),VFR(7),o[3],0,0,0), C1,14); \
    }while(0)
  int t=1;
  #undef CMASK
  #define CMASK(P0,P1,t) do{}while(0)
  for(;t+5<NT;t+=2){
    STEP(pB0,pB1,pA0,pA1,t,true,true,true);     WAIT_BAR(3); RESC(); ROT();
    STEP(pA0,pA1,pB0,pB1,t+1,true,true,true);   WAIT_BAR(3); RESC(); ROT();
  }
  #undef CMASK
  #define CMASK(P0,P1,t) do{int jb_=(t)-(NT-4); if(jb_>=0)cmask(P0,P1,jb_,wid);}while(0)
  #define ENDW(tt) do{ if((tt)+3<NT){WAIT_BAR(3);} else if((tt)+2<NT){WAIT_BAR(2);} else {WAIT_BAR(0);} }while(0)
  for(;t+1<NT;t+=2){
    STEP(pB0,pB1,pA0,pA1,t,(t+3<NT),(t+1<NT),(t+1<NT));       ENDW(t);   RESC(); ROT();
    STEP(pA0,pA1,pB0,pB1,t+1,(t+4<NT),(t+2<NT),(t+2<NT));     ENDW(t+1); RESC(); ROT();
  }
  STEP(pB0,pB1,pA0,pA1,NT-1,false,false,false); RESC();
  { float sacc=pB0[0]+pB0[1]; _Pragma("unroll") for(int r=2;r<16;++r)sacc+=pB0[r]; _Pragma("unroll") for(int r=0;r<16;++r)sacc+=pB1[r]; l_reg+=sacc;
    pw0=(u32x4){PKW(pB0,0),PKW(pB0,2),PKW(pB0,4),PKW(pB0,6)};pw1=(u32x4){PKW(pB0,8),PKW(pB0,10),PKW(pB0,12),PKW(pB0,14)};pw2=(u32x4){PKW(pB1,0),PKW(pB1,2),PKW(pB1,4),PKW(pB1,6)};pw3=(u32x4){PKW(pB1,8),PKW(pB1,10),PKW(pB1,12),PKW(pB1,14)};
    SBAR(); pv(o,vb0+2*sl_cur,PAF(0),PAF(1),PAF(2),PAF(3)); }
  #undef PKW
  #undef PAF
  #undef VFR
  #undef PIN
  #undef MX3
  #undef ZC
  #undef GAPA
  #undef GAPB
  #undef EX
  #undef VRD
  #undef VRD2
  #undef KRD
  #undef STEP
  #undef ENDW
  #undef DMA_K
  #undef DMA_V
  #undef CMASK
  #undef RESC
  #undef ROT
  {auto rr=__builtin_amdgcn_permlane32_swap(__float_as_uint(l_reg),__float_as_uint(l_reg),false,false);l_reg=__uint_as_float(rr[0])+__uint_as_float(rr[1]);}
  if(hi==0)wsf[32+r32]=l_reg;asm volatile("s_waitcnt lgkmcnt(0)":::"memory");
  float rli[16];
  #pragma unroll
  for(int r=0;r<16;++r)rli[r]=__builtin_amdgcn_rcpf(wsf[32+crow(r,hi)]);
  if(mp==0){
    #pragma unroll
    for(int r=0;r<16;++r){const int orow=crow(r,hi);
      #pragma unroll
      for(int d0=0;d0<4;++d0)stg[orow*128+d0*32+r32]=__float2bfloat16(o[d0][r]*rli[r]);}
  } else {
    #pragma unroll
    for(int r=0;r<16;++r){const int orow=crow(r,hi);
      #pragma unroll
      for(int d0=0;d0<4;++d0){ const float c=__bfloat162float(stg[orow*128+d0*32+r32])-lam*(o[d0][r]*rli[r]); stg[orow*128+d0*32+r32]=__float2bfloat16(c);} }
    asm volatile("s_waitcnt lgkmcnt(0)":::"memory");
    const int row=lane>>1,hf=lane&1; float cv[64]; float ss=0.f;
    #pragma unroll
    for(int i=0;i<8;++i){ const u32x4 w=*(const u32x4*)(stg+row*128+hf*64+i*8);
      cv[8*i+0]=__uint_as_float(w.x<<16);cv[8*i+1]=__uint_as_float(w.x&0xffff0000u);cv[8*i+2]=__uint_as_float(w.y<<16);cv[8*i+3]=__uint_as_float(w.y&0xffff0000u);
      cv[8*i+4]=__uint_as_float(w.z<<16);cv[8*i+5]=__uint_as_float(w.z&0xffff0000u);cv[8*i+6]=__uint_as_float(w.w<<16);cv[8*i+7]=__uint_as_float(w.w&0xffff0000u); }
    #pragma unroll
    for(int i=0;i<64;++i)ss+=cv[i]*cv[i];
    ss+=__int_as_float(__builtin_amdgcn_ds_bpermute((lane^1)<<2,__float_as_int(ss)));
    const float rstd=1.0f/sqrtf(ss*(1.0f/128.0f)+1e-6f);
    bf16*Ow=AO+(rowbase+q0+wid*QBLK+row)*DM+h*128+hf*64;
    #pragma unroll
    for(int i=0;i<8;++i){ const float4 g0=*(const float4*)(gs+hf*64+i*8),g1=*(const float4*)(gs+hf*64+i*8+4); u32x4 w;
      w.x=cvtpk_s(cv[8*i+0]*rstd*g0.x,cv[8*i+1]*rstd*g0.y); w.y=cvtpk_s(cv[8*i+2]*rstd*g0.z,cv[8*i+3]*rstd*g0.w);
      w.z=cvtpk_s(cv[8*i+4]*rstd*g1.x,cv[8*i+5]*rstd*g1.y); w.w=cvtpk_s(cv[8*i+6]*rstd*g1.z,cv[8*i+7]*rstd*g1.w);
      *(u32x4*)(Ow+i*8)=w; }
  }
  asm volatile("s_waitcnt lgkmcnt(0)\n\ts_barrier":::"memory");
  }
}
constexpr int ATTN_LDS_BYTES=LDS_BYTES;
#undef SBAR
#undef WAIT_BAR
}

constexpr size_t MiB = 1u << 20;
constexpr size_t WS_CTL = 0, CTL_ZERO_BYTES = 1 * MiB;
constexpr size_t WS_WIN = 2 * MiB;
constexpr size_t WS_WGLU = 13 * MiB;
constexpr size_t WS_WSSM = 14 * MiB;
constexpr size_t WS_WATT = 15 * MiB;
constexpr size_t WS_WOUT = 17 * MiB;
constexpr size_t WS_WR = 19 * MiB;
constexpr size_t WS_BTP = 20 * MiB;
constexpr size_t WS_BTY = 28 * MiB;
constexpr size_t WS_WE1 = 48 * MiB;
constexpr size_t WS_WE2 = 80 * MiB;
constexpr size_t WS_ETAB = 96 * MiB;
constexpr size_t WS_MOD = 104 * MiB;
constexpr size_t WS_UG = 112 * MiB;
constexpr size_t WS_Q = 152 * MiB, WS_K = 216 * MiB, WS_V = 280 * MiB;
constexpr size_t WS_GATES = 344 * MiB;
constexpr size_t WS_SLOC = 472 * MiB;
constexpr size_t WS_YACT = 152 * MiB;
constexpr size_t WS_S5O = 184 * MiB;
constexpr size_t WS_TMP = 280 * MiB;
constexpr size_t WS_H = 344 * MiB;
constexpr size_t WS_XS = 112 * MiB;
constexpr size_t WS_HDN = 256 * MiB;
constexpr size_t WS_SLOTS = 112 * MiB;
constexpr size_t WS_LOGITS = 472 * MiB;
constexpr size_t WS_RT = 480 * MiB;
constexpr size_t WS_DEST = 482 * MiB;
constexpr size_t WS_CW = 483 * MiB;
constexpr size_t WS_END = 512 * MiB;
constexpr int CW_TMO = 0, CW_BAR = 4096, CW_CNT = 16384;

constexpr int NWAVES = 8;
constexpr int RING_OFF = 0, RING_BYTES = 147456;
constexpr int LDSCTL_OFF = RING_BYTES, MISC_OFF = LDSCTL_OFF + 320;
constexpr int GS_OFF = MISC_OFF + 2048;
constexpr int LDS_BYTES = RING_BYTES + 4096;
static_assert(attn_body::ATTN_LDS_BYTES <= RING_BYTES, "attention LDS");

#define GAS __attribute__((address_space(1)))
#define LAS __attribute__((address_space(3)))
typedef unsigned short bf16;
typedef unsigned v4u __attribute__((ext_vector_type(4)));
typedef unsigned v2u __attribute__((ext_vector_type(2)));
typedef float f32x4 __attribute__((ext_vector_type(4)));
typedef GAS unsigned gu32;
#define RLX_AGENT __ATOMIC_RELAXED, __HIP_MEMORY_SCOPE_AGENT
#define LDS_WAIT() asm volatile("s_waitcnt lgkmcnt(0)" ::: "memory")
#define VM_WAIT() asm volatile("s_waitcnt vmcnt(0)" ::: "memory")
__device__ __forceinline__ unsigned f2bf(float f) { unsigned u = __builtin_bit_cast(unsigned, f); return (u + 0x7fffu + ((u >> 16) & 1u)) >> 16; }
__device__ __forceinline__ unsigned pk2(float lo, float hi) { return f2bf(lo) | (f2bf(hi) << 16); }
__device__ __forceinline__ float bf2f(unsigned b) { return __uint_as_float(b << 16); }

#define XB_TMO      128
#define XB_XCNT(j)  (256  + 64 * (j))
#define XB_XSUB(j)  (1280 + 64 * (j))
#define XB_XGEN(j)  (2304 + 64 * (j))
#define XB_TOP      3328
#define XB_TOPGEN   3392
#define XCD_BAR_WORDS 3456
#define XB_SPIN_CAP (1u << 18)
__device__ __forceinline__ unsigned xb_ld(unsigned* p)              { return __hip_atomic_load(p, __ATOMIC_RELAXED, __HIP_MEMORY_SCOPE_AGENT); }
__device__ __forceinline__ unsigned xb_add(unsigned* p, unsigned v) { return __hip_atomic_fetch_add(p, v, __ATOMIC_RELAXED, __HIP_MEMORY_SCOPE_AGENT); }
__device__ __forceinline__ unsigned xb_xcc_id() { return (unsigned)__builtin_amdgcn_s_getreg((3 << 11) | 20) & 0xFu; }
#define XB_SPIN(cond, bar) do { unsigned _sp = 0; while (cond) { __builtin_amdgcn_s_sleep(1); \
    if ((++_sp & 255u) == 0u) { if (xb_ld(&(bar)[XB_TMO])) break; if (_sp > XB_SPIN_CAP) { atomicAdd(&(bar)[XB_TMO], 1u); break; } } } } while (0)
struct XcdBarrier { unsigned* bar; unsigned x; volatile LAS unsigned* st; };
__device__ __forceinline__ XcdBarrier xcd_barrier_post(unsigned* bar, volatile LAS unsigned* st) {
    XcdBarrier b; b.bar = bar; b.x = xb_xcc_id(); b.st = st;
    if (threadIdx.x == 0) (void)xb_add(&bar[XB_XCNT(b.x)], 1u);
    return b;
}
__device__ __forceinline__ void xcd_barrier_complete(unsigned* bar, unsigned x, unsigned& nloc, unsigned& nx) {
    const unsigned G = gridDim.x * gridDim.y * gridDim.z;
    unsigned sum, cnt, mine, sp = 0u;
    for (;;) {
        sum = 0u; cnt = 0u; mine = 0u;
#pragma unroll
        for (unsigned j = 0; j < 16; ++j) { const unsigned c = xb_ld(&bar[XB_XCNT(j)]); sum += c; cnt += (c > 0u) ? 1u : 0u; mine = (j == x) ? c : mine; }
        if (sum == G) break;
        __builtin_amdgcn_s_sleep(1);
        if ((++sp & 255u) == 0u) { if (xb_ld(&bar[XB_TMO])) break; if (sp > XB_SPIN_CAP) { atomicAdd(&bar[XB_TMO], 1u); break; } }
    }
    nloc = mine > 0u ? mine : 1u; nx = cnt > 0u ? cnt : 1u;
}
__device__ __forceinline__ void xcd_barrier(const XcdBarrier& b) {
    asm volatile("s_waitcnt vmcnt(0)" ::: "memory");
    __syncthreads();
    if (threadIdx.x == 0) {
        unsigned* bar = b.bar;
        __builtin_amdgcn_s_waitcnt(0);
        unsigned nloc = b.st[0], nx = b.st[1];
        if (nloc == 0u) { xcd_barrier_complete(bar, b.x, nloc, nx); b.st[0] = nloc; b.st[1] = nx; }
        const unsigned old = xb_add(&bar[XB_XSUB(b.x)], 1u);
        const unsigned gen = old / nloc;
        if (old + 1u == (gen + 1u) * nloc) {
            __builtin_amdgcn_fence(__ATOMIC_RELEASE, "agent");
            asm volatile("s_waitcnt vmcnt(0)" ::: "memory");
            const unsigned og = xb_add(&bar[XB_TOP], 1u);
            const unsigned tg = og / nx;
            if (og + 1u == (tg + 1u) * nx) xb_add(&bar[XB_TOPGEN], 1u);
            else XB_SPIN(xb_ld(&bar[XB_TOPGEN]) == tg, bar);
            __builtin_amdgcn_fence(__ATOMIC_ACQUIRE, "agent");
            xb_add(&bar[XB_XGEN(b.x)], 1u);
            asm volatile("s_waitcnt vmcnt(0)" ::: "memory");
        } else {
            XB_SPIN(xb_ld(&bar[XB_XGEN(b.x)]) == gen, bar);
            __builtin_amdgcn_fence(__ATOMIC_ACQUIRE, "agent");
            asm volatile("s_waitcnt vmcnt(0)" ::: "memory");
        }
    }
    __syncthreads();
}

__device__ __forceinline__ float shfl_xor_l(float v, int o, int lane) { return __int_as_float(__builtin_amdgcn_ds_bpermute((lane ^ o) << 2, __float_as_int(v))); }
__device__ __forceinline__ float wave_sum(float v, int lane) {
#pragma unroll
    for (int o = 1; o < 64; o <<= 1) v += shfl_xor_l(v, o, lane);
    return v;
}
__device__ __forceinline__ void transpose_tile(const float* W, int N, int k0, int n0, bf16* WT, int ldo, int orow0, int ocol0, LAS float* scr, int lane) {
#pragma unroll 8
    for (int i = 0; i < 32; ++i) { const int kk = 2 * i + (lane >> 5); scr[kk * 33 + (lane & 31)] = W[(size_t)(k0 + kk) * N + n0 + (lane & 31)]; }
    LDS_WAIT(); asm volatile("" ::: "memory");
    const int c = lane & 7;
#pragma unroll
    for (int j = 0; j < 4; ++j) { const int n = (lane >> 3) + 8 * j; const LAS float* s = scr + (8 * c) * 33 + n;
        v4u o; o.x = pk2(s[0 * 33], s[1 * 33]); o.y = pk2(s[2 * 33], s[3 * 33]); o.z = pk2(s[4 * 33], s[5 * 33]); o.w = pk2(s[6 * 33], s[7 * 33]);
        *(GAS v4u*)(WT + (size_t)(orow0 + n) * ldo + ocol0 + 8 * c) = o; }
    LDS_WAIT(); asm volatile("" ::: "memory");
}
__device__ __forceinline__ void abar_pow(float lr, float li, float dt, float j, float& re, float& im) {
    const float mag = expf(lr * dt * j); float s, c; sincosf(li * dt * j, &s, &c); re = mag * c; im = mag * s;
}

constexpr int ETAB_OFF = MISC_OFF + 256;
__device__ __forceinline__ void build_expert_table(LAS unsigned char* L, const int* CNT, int tid) {
    LAS int* tab = (LAS int*)(L + ETAB_OFF);
    __syncthreads();
    if (tid == 0) { int rt = 0;
#pragma unroll 1
        for (int e = 0; e < NEXP; ++e) { const int nt = (CNT[e] + 255) >> 8;
#pragma unroll 1
            for (int q = 0; q < nt; ++q) tab[rt++] = e; }
#pragma unroll 1
        for (; rt <= XS_ROWS / 256; ++rt) tab[rt] = -1; }
    __syncthreads();
}
struct Args { const float* in[34]; float* out; unsigned char* ws; };
typedef __attribute__((address_space(4))) const char* kconst_ptr;
__device__ __forceinline__ void* karg(int k) { kconst_ptr kp = (kconst_ptr)__builtin_amdgcn_kernarg_segment_ptr(); asm volatile("" : "+s"(kp)); return *(void* const __attribute__((address_space(4)))*)(kp + 8 * k); }

__global__ void __launch_bounds__(NWAVES * 64, 2) fwd_kernel(Args args) {
    extern __shared__ __attribute__((aligned(16))) unsigned char lds[];
    LAS unsigned char* L = (LAS unsigned char*)lds;
    volatile LAS unsigned* MISC = (volatile LAS unsigned*)(L + MISC_OFF);
#define PHASE_IDS() \
    int tid = threadIdx.x; asm volatile("" : "+v"(tid)); \
    const int lane = tid & 63, wave = __builtin_amdgcn_readfirstlane(tid >> 6); \
    int G = gridDim.x, bx = blockIdx.x; asm volatile("" : "+s"(G), "+s"(bx)); \
    const int vcu = (G % 8 == 0) ? (bx % 8) * (G / 8) + bx / 8 : bx; \
    const int gw = vcu * NWAVES + wave, NGW = G * NWAVES; \
    const int gt = bx * (NWAVES * 64) + tid, NGT = G * NWAVES * 64; \
    (void)lane; (void)wave; (void)vcu; (void)gw; (void)NGW; (void)gt; (void)NGT;
    gu32* ctl = (gu32*)(args.ws + WS_CTL);
    for (int u = threadIdx.x; u < (LDS_BYTES - LDSCTL_OFF) / 4; u += NWAVES * 64) ((LAS unsigned*)(L + LDSCTL_OFF))[u] = 0u;
    __syncthreads();
    XcdBarrier bar = xcd_barrier_post((unsigned*)(ctl + CW_BAR), MISC + 8);
#define GRID_BAR() xcd_barrier(bar)

#define KIN(k) ((const float*)karg(k))
#define WSP(T_, off) ((T_*)(((unsigned char*)karg(35)) + (off)))
#define OUTP() ((float*)karg(34))

#if DBG_STAGE != 1
    asm volatile("; PHASE_MARK P0" ::: "memory");
    {
        PHASE_IDS();
        const float* w_in = KIN(5); const float* w_glu = KIN(15); const float* w_br_ssm = KIN(22); const float* w_br_attn = KIN(23); const float* w_out = KIN(24);
        const float* w_eg = KIN(30); const float* w_eu = KIN(31); const float* w_ed = KIN(32);
        bf16* WinT = WSP(bf16, WS_WIN); bf16* WgluT = WSP(bf16, WS_WGLU); bf16* WssmT = WSP(bf16, WS_WSSM); bf16* WattT = WSP(bf16, WS_WATT); bf16* WoutT = WSP(bf16, WS_WOUT);
        bf16* WE1 = WSP(bf16, WS_WE1); bf16* WE2 = WSP(bf16, WS_WE2);
        LAS float* scr = (LAS float*)(L + RING_OFF + wave * 16384);
        constexpr int I_IN = 16 * 176, I_GLU = 8 * 16, I_SSM = 8 * 32, I_ATT = 16 * 32, I_OUT = 16 * 32, I_EG = NEXP * 16 * 8, I_EU = I_EG, I_ED = NEXP * 4 * 32;
        constexpr int NITEMS = I_IN + I_GLU + I_SSM + I_ATT + I_OUT + I_EG + I_EU + I_ED;
        for (int it = gw; it < NITEMS; it += NGW) {
            int r = it;
            if (r < I_IN) { const int kb = r / 176, nb = r % 176; transpose_tile(w_in, INW, 64 * kb, 32 * nb, WinT, D, 32 * nb, 64 * kb, scr, lane); continue; } r -= I_IN;
            if (r < I_GLU) { const int kb = r / 16, nb = r % 16; transpose_tile(w_glu, S5W, 64 * kb, 32 * nb, WgluT, S5W, 32 * nb, 64 * kb, scr, lane); continue; } r -= I_GLU;
            if (r < I_SSM) { const int kb = r / 32, nb = r % 32; transpose_tile(w_br_ssm, D, 64 * kb, 32 * nb, WssmT, S5W, 32 * nb, 64 * kb, scr, lane); continue; } r -= I_SSM;
            if (r < I_ATT) { const int kb = r / 32, nb = r % 32; transpose_tile(w_br_attn, D, 64 * kb, 32 * nb, WattT, D, 32 * nb, 64 * kb, scr, lane); continue; } r -= I_ATT;
            if (r < I_OUT) { const int kb = r / 32, nb = r % 32; transpose_tile(w_out, D, 64 * kb, 32 * nb, WoutT, D, 32 * nb, 64 * kb, scr, lane); continue; } r -= I_OUT;
            if (r < I_EG + I_EU) { const bool up = r >= I_EG; if (up) r -= I_EG; const int e = r / 128, q = r % 128, kb = q / 8, nb = q % 8;
                transpose_tile((up ? w_eu : w_eg) + (size_t)e * D * DEXP, DEXP, 64 * kb, 32 * nb, WE1 + (size_t)e * 512 * D, D, (nb >> 2) * 256 + (up ? 128 : 0) + (nb & 3) * 32, 64 * kb, scr, lane); continue; } r -= I_EG + I_EU;
            { const int e = r / 128, q = r % 128, kb = q / 32, nb = q % 32; transpose_tile(w_ed + (size_t)e * DEXP * D, D, 64 * kb, 32 * nb, WE2 + (size_t)e * D * DEXP, DEXP, 32 * nb, 64 * kb, scr, lane); }
        }
        const float* w_rg = KIN(26); const float* w_re = KIN(28); bf16* WR = WSP(bf16, WS_WR);
        for (int idx = gt; idx < 256 * 2048 / 8; idx += NGT) {
            const int row = idx / 256, c8 = (idx % 256) * 8; const int n = row & 127, part = row >> 7, k0 = c8 & 1023, khalf = c8 >> 10;
            unsigned w[4] = {0u, 0u, 0u, 0u};
            if (n < 36 && !(part == 1 && khalf == 1)) {
                float hv[8];
#pragma unroll
                for (int i = 0; i < 8; ++i) { const float f = (n < 4) ? w_rg[(size_t)(k0 + i) * 4 + n] : w_re[(size_t)(k0 + i) * NEXP + (n - 4)]; const float h = bf2f(f2bf(f)); hv[i] = part ? (f - h) : h; }
#pragma unroll
                for (int i = 0; i < 4; ++i) w[i] = pk2(hv[2 * i], hv[2 * i + 1]);
            }
            *(GAS v4u*)(WR + (size_t)row * 2048 + c8) = (v4u){w[0], w[1], w[2], w[3]};
        }
        const float* log_dt = KIN(14); const float* a_re = KIN(7); const float* a_im = KIN(8); const float* sb_re = KIN(9); const float* sb_im = KIN(10);
        float* Ere = WSP(float, WS_ETAB); float* Eim = Ere + NG * LC * NP * 16;
        for (int idx = gt; idx < NG * LC * NP; idx += NGT) {
            const int p = idx % NP, j = (idx / NP) % LC, g = idx / (NP * LC);
            const float dt = expf(log_dt[g]), lr = a_re[g * NP + p], li = a_im[g * NP + p];
            float ar, ai; abar_pow(lr, li, dt, 1.0f, ar, ai);
            const float den = lr * lr + li * li, nr = ar - 1.0f;
            const float fre = (nr * lr + ai * li) / den, fim = (ai * lr - nr * li) / den;
            float pr, pi; abar_pow(lr, li, dt, (float)j, pr, pi);
            const float gr = pr * fre - pi * fim, gi = pr * fim + pi * fre;
            const float* br = sb_re + (size_t)(g * NP + p) * 16; const float* bi = sb_im + (size_t)(g * NP + p) * 16;
            float* er = Ere + (size_t)((g * LC + j) * NP + p) * 16; float* ei = Eim + (size_t)((g * LC + j) * NP + p) * 16;
#pragma unroll
            for (int ci = 0; ci < 16; ++ci) { er[ci] = gr * br[ci] - gi * bi[ci]; ei[ci] = gr * bi[ci] + gi * br[ci]; }
        }
        {
            const float* cvec = KIN(1); const float* w_ada = KIN(2); const float* b_ada = KIN(3); float* MOD = WSP(float, WS_MOD);
            __syncthreads();
            LAS float* cs = (LAS float*)(L + RING_OFF);
            LAS float* red = (LAS float*)(L + RING_OFF + 32768);
            bool loaded = false;
            for (int it = vcu; it < 6 * D / 32; it += G) {
                if (!loaded) { __syncthreads(); for (int i = tid; i < NB * D; i += NWAVES * 64) { const float c = cvec[i]; cs[i] = c / (1.0f + expf(-c)); } __syncthreads(); loaded = true; }
                const int col = it * 32 + (lane & 31), ksub = (lane >> 5) + 2 * wave;
                float accb[NB];
#pragma unroll
                for (int b = 0; b < NB; ++b) accb[b] = 0.f;
#pragma unroll 8
                for (int i = 0; i < 64; ++i) { const int k = ksub + 16 * i; const float w = w_ada[(size_t)k * (6 * D) + col];
#pragma unroll
                    for (int b = 0; b < NB; ++b) accb[b] += cs[b * D + k] * w; }
#pragma unroll
                for (int b = 0; b < NB; ++b) red[(ksub * NB + b) * 32 + (lane & 31)] = accb[b];
                __syncthreads();
                if (tid < NB * 32) { const int b = tid >> 5, c = tid & 31; float s = 0.f;
#pragma unroll
                    for (int q = 0; q < 16; ++q) s += red[(q * NB + b) * 32 + c];
                    MOD[(size_t)b * 6 * D + it * 32 + c] = s + b_ada[it * 32 + c]; }
                __syncthreads();
            }
            __syncthreads();
        }
    }
    GRID_BAR();
#endif

#if DBG_STAGE != 1
    asm volatile("; PHASE_MARK P0b" ::: "memory");
    {
        PHASE_IDS();
        const float* x = KIN(0); const float* g_mix = KIN(4); const float* MOD = WSP(float, WS_MOD); bf16* UBUF = (bf16*)OUTP();
        const float* Ere = WSP(float, WS_ETAB); const float* Eim = Ere + NG * LC * NP * 16; bf16* BtY = WSP(bf16, WS_BTY); bf16* BtP = WSP(bf16, WS_BTP);
        const float* sc_re = KIN(11); const float* sc_im = KIN(12); const float* log_dt = KIN(14); const float* a_re = KIN(7); const float* a_im = KIN(8);
        for (int blk = gw; blk < T / 16; blk += NGW) {
            const int row0 = blk * 16, b = row0 / SEQ; const float* md = MOD + (size_t)b * 6 * D;
            f32x4 av[4], sv[4];
#pragma unroll
            for (int j = 0; j < 4; ++j) { const int c = 4 * lane + 256 * j; const f32x4 g = *(const f32x4*)(g_mix + c), sc = *(const f32x4*)(md + D + c); av[j] = g * (sc + 1.0f); sv[j] = *(const f32x4*)(md + c); }
            for (int r = 0; r < 16; ++r) {
                const float* xr = x + (size_t)(row0 + r) * D; f32x4 v[4]; float ss = 0.f;
#pragma unroll
                for (int j = 0; j < 4; ++j) { v[j] = *(const f32x4*)(xr + 4 * lane + 256 * j); ss += (v[j][0] * v[j][0] + v[j][1] * v[j][1]) + (v[j][2] * v[j][2] + v[j][3] * v[j][3]); }
                const float rstd = 1.0f / sqrtf(wave_sum(ss, lane) * (1.0f / D) + EPS);
                bf16* ur = UBUF + (size_t)(row0 + r) * D;
#pragma unroll
                for (int j = 0; j < 4; ++j) { const f32x4 o = v[j] * rstd * av[j] + sv[j]; *(GAS v2u*)(ur + 4 * lane + 256 * j) = (v2u){pk2(o[0], o[1]), pk2(o[2], o[3])}; }
            }
        }
        for (int idx = gt; idx < NG * LC * 16 * 2; idx += NGT) {
            const int cih = idx & 1, co = (idx >> 1) & 15, j = (idx >> 5) % LC, g = idx / (32 * LC);
            float kv[8];
#pragma unroll
            for (int i = 0; i < 8; ++i) kv[i] = 0.f;
            const float* er = Ere + (size_t)((g * LC + j) * NP) * 16 + cih * 8; const float* ei = Eim + (size_t)((g * LC + j) * NP) * 16 + cih * 8;
            const float* cr = sc_re + (size_t)(g * 16 + co) * NP; const float* ci_ = sc_im + (size_t)(g * 16 + co) * NP;
            for (int p = 0; p < NP; ++p) { const float c_r = cr[p], c_i = ci_[p]; const f32x4 e0 = *(const f32x4*)(er + p * 16), e1 = *(const f32x4*)(er + p * 16 + 4), f0 = *(const f32x4*)(ei + p * 16), f1 = *(const f32x4*)(ei + p * 16 + 4);
#pragma unroll
                for (int i = 0; i < 4; ++i) { kv[i] += c_r * e0[i] - c_i * f0[i]; kv[4 + i] += c_r * e1[i] - c_i * f1[i]; } }
            const v4u kw = (v4u){pk2(kv[0], kv[1]), pk2(kv[2], kv[3]), pk2(kv[4], kv[5]), pk2(kv[6], kv[7])};
            bf16* base = BtY + (size_t)g * 512 * KY;
            for (int t = j; t < LC; ++t) *(GAS v4u*)(base + (size_t)(t * 16 + co) * KY + (t - j) * 16 + cih * 8) = kw;
            if (j >= 1) for (int t = 0; t + j < LC; ++t) *(GAS v4u*)(base + (size_t)(t * 16 + co) * KY + (t + j) * 16 + cih * 8) = (v4u){0u, 0u, 0u, 0u};
        }
        for (int idx = gt; idx < NG * LC * NP; idx += NGT) {
            const int p = idx % NP, t = (idx / NP) % LC, g = idx / (NP * LC);
            const float dt = expf(log_dt[g]); float ar, ai; abar_pow(a_re[g * NP + p], a_im[g * NP + p], dt, (float)(t + 1), ar, ai);
#pragma unroll
            for (int co = 0; co < 16; ++co) { const float c_r = sc_re[(size_t)(g * 16 + co) * NP + p], c_i = sc_im[(size_t)(g * 16 + co) * NP + p];
                bf16* rowp = BtY + (size_t)(g * 512 + t * 16 + co) * KY;
                rowp[512 + p] = (bf16)f2bf(c_r * ar - c_i * ai); rowp[576 + p] = (bf16)f2bf(-(c_r * ai + c_i * ar)); }
        }
        for (int idx = gt; idx < NG * 128 * LC; idx += NGT) {
            const int s = idx % LC, nn = (idx / LC) % 128, g = idx / (LC * 128); const int p = nn & 63, im = nn >> 6;
            const float* src = (im ? Eim : Ere) + (size_t)((g * LC + (LC - 1 - s)) * NP + p) * 16;
            unsigned hw[8], lw[8];
#pragma unroll
            for (int i = 0; i < 8; ++i) { const float f0 = src[2 * i], f1 = src[2 * i + 1]; const unsigned h0 = f2bf(f0), h1 = f2bf(f1); hw[i] = h0 | (h1 << 16); lw[i] = pk2(f0 - bf2f(h0), f1 - bf2f(h1)); }
            bf16* d0 = BtP + (size_t)(g * 256 + nn) * KS + s * 16; bf16* d1 = BtP + (size_t)(g * 256 + 128 + nn) * KS + s * 16;
            *(GAS v4u*)d0 = (v4u){hw[0], hw[1], hw[2], hw[3]}; *(GAS v4u*)(d0 + 8) = (v4u){hw[4], hw[5], hw[6], hw[7]};
            *(GAS v4u*)d1 = (v4u){lw[0], lw[1], lw[2], lw[3]}; *(GAS v4u*)(d1 + 8) = (v4u){lw[4], lw[5], lw[6], lw[7]};
        }
    }
    GRID_BAR();

    asm volatile("; PHASE_MARK P1" ::: "memory");
    {
        PHASE_IDS();
        pg8::StaticOrder S; S.init(OUTP(), D, WSP(bf16, WS_WIN), D, T, INW, G, bx);
        pg8::EpiProj E{KIN(6), WSP(bf16, WS_UG), WSP(bf16, WS_Q), WSP(bf16, WS_K), WSP(bf16, WS_V), WSP(bf16, WS_GATES), attn_body::C2};
        pg8::gemm_phase<pg8::EpiProj, pg8::StaticOrder, true, true>(L + RING_OFF, D, D, D, S, E);
    }
    GRID_BAR();

    asm volatile("; PHASE_MARK P2" ::: "memory");
    {
        PHASE_IDS();
        pg8::GroupOrder S; S.init(WSP(bf16, WS_UG), KY, (size_t)NRC * KY * 2, WSP(bf16, WS_BTP), KS, (size_t)256 * KS * 2, NRC, 256, NG, G, bx);
        pg8::EpiStates E{WSP(float, WS_SLOC)};
        pg8::gemm_phase<pg8::EpiStates, pg8::GroupOrder, true, true>(L + RING_OFF, KS, KY, KS, S, E);
    }
    GRID_BAR();

    asm volatile("; PHASE_MARK P3" ::: "memory");
    {
        PHASE_IDS();
        const float* log_dt = KIN(14); const float* a_re = KIN(7); const float* a_im = KIN(8); const float* SLOC = WSP(float, WS_SLOC); bf16* UG = WSP(bf16, WS_UG);
        LAS float* seg = (LAS float*)(L + RING_OFF);
        for (int bg = vcu; bg < NB * NG; bg += G) {
            const int b = bg / NG, g = bg % NG, p = lane;
            const float dt = expf(log_dt[g]), lr = a_re[g * NP + p], li = a_im[g * NP + p];
            float alr, ali; abar_pow(lr, li, dt, (float)LC, alr, ali);
            constexpr int SEGC = NCH / NWAVES;
            float locr[SEGC], loci[SEGC]; float cr = 0.f, ci = 0.f;
            const float* sp = SLOC + ((size_t)(g * NRC + b * NCH + wave * SEGC)) * 128;
#pragma unroll
            for (int k = 0; k < SEGC; ++k) { locr[k] = cr; loci[k] = ci; const float sr = sp[k * 128 + p], si = sp[k * 128 + 64 + p]; const float nr = alr * cr - ali * ci + sr, ni = alr * ci + ali * cr + si; cr = nr; ci = ni; }
            __syncthreads();
            seg[(wave * 64 + p) * 2] = cr; seg[(wave * 64 + p) * 2 + 1] = ci;
            __syncthreads();
            float a16r = alr, a16i = ali;
#pragma unroll
            for (int q = 0; q < 4; ++q) { const float nr = a16r * a16r - a16i * a16i, ni = 2.f * a16r * a16i; a16r = nr; a16i = ni; }
            float inr = 0.f, ini = 0.f;
            for (int w = 0; w < wave; ++w) { const float er = seg[(w * 64 + p) * 2], ei = seg[(w * 64 + p) * 2 + 1]; const float nr = a16r * inr - a16i * ini + er, ni = a16r * ini + a16i * inr + ei; inr = nr; ini = ni; }
            bf16* up = UG + ((size_t)(g * NRC + b * NCH + wave * SEGC)) * KY + KS;
#pragma unroll
            for (int k = 0; k < SEGC; ++k) { up[(size_t)k * KY + p] = (bf16)f2bf(inr + locr[k]); up[(size_t)k * KY + 64 + p] = (bf16)f2bf(ini + loci[k]); const float nr = alr * inr - ali * ini, ni = alr * ini + ali * inr; inr = nr; ini = ni; }
        }
        __syncthreads();
        const char* wsb = (const char*)karg(35);
        const float* lq1 = KIN(17); const float* lk1 = KIN(18); const float* lq2 = KIN(19); const float* lk2 = KIN(20); const float* g_subln = KIN(21);
        const float lam = expf(wave_sum(lq1[lane] * lk1[lane], lane)) - expf(wave_sum(lq2[lane] * lk2[lane], lane)) + LAMBDA_INIT;
        LAS float* gsl = (LAS float*)(L + GS_OFF);
        if (tid < 128) gsl[tid] = g_subln[tid] * (1.0f - LAMBDA_INIT);
        __syncthreads();
        for (int un = vcu; un < NB * 8 * 4; un += G) {
            const int s4 = un & 3, h = (un >> 2) & 7, b = un >> 5;
#pragma unroll 1
            for (int i = 0; i < 4; ++i) { const int qb = (i == 0) ? 15 - s4 : (i == 1) ? 8 + s4 : (i == 2) ? 7 - s4 : s4;
                attn_body::attn_unit<8, WS_Q, WS_K, WS_V, GS_OFF - RING_OFF>(b, h, qb, wsb, (attn_body::bf16*)OUTP(), lam, (char*)lds + RING_OFF); }
        }
    }
    GRID_BAR();

    asm volatile("; PHASE_MARK P4" ::: "memory");
    {
        PHASE_IDS();
        pg8::GroupOrder S; S.init(WSP(bf16, WS_UG), KY, (size_t)NRC * KY * 2, WSP(bf16, WS_BTY), KY, (size_t)512 * KY * 2, NRC, 512, NG, G, bx);
        pg8::EpiY E{WSP(bf16, WS_UG), KIN(13), WSP(bf16, WS_YACT)};
        pg8::gemm_phase<pg8::EpiY, pg8::GroupOrder, true, true>(L + RING_OFF, KY, KY, KY, S, E);
    }
    GRID_BAR();

    asm volatile("; PHASE_MARK P5" ::: "memory");
    {
        PHASE_IDS();
        pg8::StaticOrder S; S.init(WSP(bf16, WS_YACT), S5W, WSP(bf16, WS_WGLU), S5W, T, S5W, G, bx);
        pg8::EpiGlu E{WSP(bf16, WS_YACT), KIN(16), WSP(bf16, WS_S5O)};
        pg8::gemm_phase<pg8::EpiGlu, pg8::StaticOrder, true, true>(L + RING_OFF, S5W, S5W, S5W, S, E);
    }
    GRID_BAR();

    asm volatile("; PHASE_MARK P6" ::: "memory");
    {
        PHASE_IDS();
        pg8::StaticOrder S; S.init(WSP(bf16, WS_S5O), S5W, WSP(bf16, WS_WSSM), S5W, T, D, G, bx);
        pg8::EpiBranch<0> E{WSP(bf16, WS_GATES), nullptr, WSP(bf16, WS_TMP)};
        pg8::gemm_phase<pg8::EpiBranch<0>, pg8::StaticOrder, true, true>(L + RING_OFF, S5W, S5W, S5W, S, E);
    }
    VM_WAIT(); __syncthreads();
    {
        PHASE_IDS();
        pg8::StaticOrder S; S.init(OUTP(), D, WSP(bf16, WS_WATT), D, T, D, G, bx);
        pg8::EpiBranch<1> E{WSP(bf16, WS_GATES), WSP(bf16, WS_TMP), (bf16*)OUTP() + (size_t)T * D};
        pg8::gemm_phase<pg8::EpiBranch<1>, pg8::StaticOrder, true, true>(L + RING_OFF, D, D, D, S, E);
    }
    GRID_BAR();

    asm volatile("; PHASE_MARK P8" ::: "memory");
    {
        PHASE_IDS();
        pg8::StaticOrder S; S.init((bf16*)OUTP() + (size_t)T * D, D, WSP(bf16, WS_WOUT), D, T, D, G, bx);
        pg8::EpiOut E{KIN(0), WSP(float, WS_MOD), WSP(float, WS_H)};
        pg8::gemm_phase<pg8::EpiOut, pg8::StaticOrder, true, true>(L + RING_OFF, D, D, D, S, E);
    }
    GRID_BAR();
#endif

#if DBG_STAGE == 0
    asm volatile("; PHASE_MARK P9" ::: "memory");
    {
        PHASE_IDS();
        const float* g_ffn = KIN(25); const float* MOD = WSP(float, WS_MOD); const float* Hbuf = WSP(float, WS_H); bf16* U2HL = (bf16*)OUTP();
        for (int blk = gw; blk < T / 16; blk += NGW) {
            const int row0 = blk * 16, b = row0 / SEQ; const float* md = MOD + (size_t)b * 6 * D;
            f32x4 av[4], sv[4];
#pragma unroll
            for (int j = 0; j < 4; ++j) { const int c = 4 * lane + 256 * j; const f32x4 g = *(const f32x4*)(g_ffn + c), sc = *(const f32x4*)(md + 4 * D + c); av[j] = g * (sc + 1.0f); sv[j] = *(const f32x4*)(md + 3 * D + c); }
            for (int r = 0; r < 16; ++r) {
                const float* hr = Hbuf + (size_t)(row0 + r) * D; f32x4 v[4]; float ss = 0.f;
#pragma unroll
                for (int j = 0; j < 4; ++j) { v[j] = *(const f32x4*)(hr + 4 * lane + 256 * j); ss += (v[j][0] * v[j][0] + v[j][1] * v[j][1]) + (v[j][2] * v[j][2] + v[j][3] * v[j][3]); }
                const float rstd = 1.0f / sqrtf(wave_sum(ss, lane) * (1.0f / D) + EPS);
                bf16* ur = U2HL + (size_t)(row0 + r) * 2048;
#pragma unroll
                for (int j = 0; j < 4; ++j) { const f32x4 o = v[j] * rstd * av[j] + sv[j];
                    const unsigned h0 = f2bf(o[0]), h1 = f2bf(o[1]), h2 = f2bf(o[2]), h3 = f2bf(o[3]);
                    *(GAS v2u*)(ur + 4 * lane + 256 * j) = (v2u){h0 | (h1 << 16), h2 | (h3 << 16)};
                    *(GAS v2u*)(ur + D + 4 * lane + 256 * j) = (v2u){pk2(o[0] - bf2f(h0), o[1] - bf2f(h1)), pk2(o[2] - bf2f(h2), o[3] - bf2f(h3))}; }
            }
        }
    }
    GRID_BAR();

    asm volatile("; PHASE_MARK P10" ::: "memory");
    {
        PHASE_IDS();
        pg8::StaticOrder S; S.init(OUTP(), 2048, WSP(bf16, WS_WR), 2048, T, 256, G, bx);
        pg8::EpiRouter E{WSP(float, WS_LOGITS)};
        pg8::gemm_phase<pg8::EpiRouter, pg8::StaticOrder, true, true>(L + RING_OFF, 2048, 2048, 2048, S, E);
    }
    GRID_BAR();

    asm volatile("; PHASE_MARK P11" ::: "memory");
    {
        PHASE_IDS();
        const float* b_rg = KIN(27); const float* b_re = KIN(29); const float* LOGITS = WSP(float, WS_LOGITS); int* RT = WSP(int, WS_RT); int* CNT = WSP(int, WS_CTL) + CW_CNT;
        int* lcnt = (int*)(lds + RING_OFF); int* lbase = lcnt + NEXP;
        const int per = T / G;
        for (int t0 = bx * per; t0 < (bx + 1) * per; t0 += NWAVES * 64) {
            __syncthreads();
            if (tid < NEXP) lcnt[tid] = 0;
            __syncthreads();
            const int tok = t0 + tid; const bool act = tok < (bx + 1) * per;
            int e0 = 0, e1 = 0, p0 = 0, p1 = 0; float w0 = 0.f, w1 = 0.f;
            if (act) {
                const float* lg = LOGITS + (size_t)tok * 64;
                float gl[4]; int gi = 0;
#pragma unroll
                for (int i = 0; i < 4; ++i) gl[i] = lg[i] + b_rg[i];
#pragma unroll
                for (int i = 1; i < 4; ++i) if (gl[i] > gl[gi]) gi = i;
                float gsum = 0.f;
#pragma unroll
                for (int i = 0; i < 4; ++i) gsum += expf(gl[i] - gl[gi]);
                const float gp = 1.0f / gsum;
                float el[8];
#pragma unroll
                for (int i = 0; i < 8; ++i) el[i] = lg[4 + gi * 8 + i] + b_re[gi * 8 + i];
                int i0 = 0;
#pragma unroll
                for (int i = 1; i < 8; ++i) if (el[i] > el[i0]) i0 = i;
                int i1 = (i0 == 0) ? 1 : 0;
#pragma unroll
                for (int i = 0; i < 8; ++i) if (i != i0 && el[i] > el[i1]) i1 = i;
                const float ex = expf(el[i1] - el[i0]);
                w0 = gp / (1.0f + ex); w1 = gp * ex / (1.0f + ex);
                e0 = gi * 8 + i0; e1 = gi * 8 + i1;
                p0 = atomicAdd(&lcnt[e0], 1); p1 = atomicAdd(&lcnt[e1], 1);
            }
            __syncthreads();
            if (tid < NEXP) lbase[tid] = atomicAdd(&CNT[tid], lcnt[tid]);
            __syncthreads();
            if (act) { int* r = RT + (size_t)tok * 8; r[0] = e0; r[1] = lbase[e0] + p0; r[2] = __float_as_int(w0); r[3] = e1; r[4] = lbase[e1] + p1; r[5] = __float_as_int(w1); }
        }
    }
    GRID_BAR();

    asm volatile("; PHASE_MARK P12" ::: "memory");
    {
        PHASE_IDS();
        const int* RT = WSP(int, WS_RT); const int* CNT = WSP(int, WS_CTL) + CW_CNT; const bf16* U2HL = (const bf16*)OUTP(); bf16* XS = WSP(bf16, WS_XS); int* DEST = WSP(int, WS_DEST); float* CWT = WSP(float, WS_CW);
        LAS int* offs = (LAS int*)(L + RING_OFF);
        __syncthreads();
        if (tid == 0) { int a = 0; for (int e = 0; e < NEXP; ++e) { offs[e] = a; a += ((CNT[e] + 255) >> 8) << 8; } }
        __syncthreads();
        for (int tok = gw; tok < T; tok += NGW) {
            const int* r = RT + (size_t)tok * 8; const int e0 = r[0], q0 = r[1], e1 = r[3], q1 = r[4];
            const int r0 = offs[e0] + q0, r1 = offs[e1] + q1;
            const bf16* src = U2HL + (size_t)tok * 2048 + 16 * lane;
            const v4u a0 = *(const GAS v4u*)src, a1 = *(const GAS v4u*)(src + 8);
            bf16* d0 = XS + (size_t)r0 * D + 16 * lane; bf16* d1 = XS + (size_t)r1 * D + 16 * lane;
            *(GAS v4u*)d0 = a0; *(GAS v4u*)(d0 + 8) = a1; *(GAS v4u*)d1 = a0; *(GAS v4u*)(d1 + 8) = a1;
            if (lane == 0) { DEST[r0] = tok * 2; CWT[r0] = __int_as_float(r[2]); DEST[r1] = tok * 2 + 1; CWT[r1] = __int_as_float(r[5]); }
        }
        if (bx < NEXP) { const int n = CNT[bx], pad = (((n + 255) >> 8) << 8) - n; for (int i = tid; i < pad; i += NWAVES * 64) { DEST[offs[bx] + n + i] = -1; CWT[offs[bx] + n + i] = 0.f; } }
        __syncthreads();
    }
    GRID_BAR();

    asm volatile("; PHASE_MARK P13" ::: "memory");
    {
        PHASE_IDS();
        build_expert_table(L, WSP(int, WS_CTL) + CW_CNT, tid);
        pg8::ExpertOrder S; S.init((const LAS int*)(L + ETAB_OFF), WSP(bf16, WS_XS), D, WSP(bf16, WS_WE1), D, (size_t)512 * D * 2, 512, G, bx);
        pg8::EpiExp1 E{WSP(bf16, WS_HDN)};
        pg8::gemm_phase<pg8::EpiExp1, pg8::ExpertOrder, true, true>(L + RING_OFF, D, D, D, S, E);
    }
    GRID_BAR();

    asm volatile("; PHASE_MARK P14" ::: "memory");
    {
        PHASE_IDS();
        build_expert_table(L, WSP(int, WS_CTL) + CW_CNT, tid);
        pg8::ExpertOrder S; S.init((const LAS int*)(L + ETAB_OFF), WSP(bf16, WS_HDN), DEXP, WSP(bf16, WS_WE2), DEXP, (size_t)D * DEXP * 2, D, G, bx);
        pg8::EpiExp2 E{WSP(int, WS_DEST), WSP(float, WS_CW), WSP(bf16, WS_SLOTS)};
        pg8::gemm_phase<pg8::EpiExp2, pg8::ExpertOrder, true, true>(L + RING_OFF, DEXP, DEXP, DEXP, S, E);
    }
    GRID_BAR();
#endif

    asm volatile("; PHASE_MARK P15" ::: "memory");
    {
        PHASE_IDS();
        const float* x = KIN(0); const float* g_final = KIN(33); const float* Hbuf = WSP(float, WS_H); const float* MOD = WSP(float, WS_MOD); const bf16* SLOTS = WSP(bf16, WS_SLOTS); float* out = OUTP();
        (void)x; (void)Hbuf; (void)MOD; (void)SLOTS;
        for (int row = gw; row < T; row += NGW) {
            const int b = row / SEQ; f32x4 v[4]; float ss = 0.f;
#pragma unroll
            for (int j = 0; j < 4; ++j) { const int c = 4 * lane + 256 * j;
#if DBG_STAGE == 1
                v[j] = *(const f32x4*)(x + (size_t)row * D + c);
#else
                v[j] = *(const f32x4*)(Hbuf + (size_t)row * D + c);
#endif
#if DBG_STAGE == 0
                const f32x4 gt = *(const f32x4*)(MOD + (size_t)b * 6 * D + 5 * D + c);
                const v2u s0 = *(const GAS v2u*)(SLOTS + (size_t)(2 * row) * D + c), s1 = *(const GAS v2u*)(SLOTS + (size_t)(2 * row + 1) * D + c);
                const f32x4 f = (f32x4){pg8::bf_lo(s0.x) + pg8::bf_lo(s1.x), pg8::bf_hi(s0.x) + pg8::bf_hi(s1.x), pg8::bf_lo(s0.y) + pg8::bf_lo(s1.y), pg8::bf_hi(s0.y) + pg8::bf_hi(s1.y)};
                v[j] = v[j] + gt * f;
#endif
                ss += (v[j][0] * v[j][0] + v[j][1] * v[j][1]) + (v[j][2] * v[j][2] + v[j][3] * v[j][3]); }
            (void)b;
            const float rstd = 1.0f / sqrtf(wave_sum(ss, lane) * (1.0f / D) + EPS);
#pragma unroll
            for (int j = 0; j < 4; ++j) { const int c = 4 * lane + 256 * j; const f32x4 g = *(const f32x4*)(g_final + c); *(f32x4*)(out + (size_t)row * D + c) = v[j] * rstd * g; }
        }
    }
}

extern "C" void kernel_launch(void* const* d_in, const int* in_sizes, int n_in, void* d_out, int out_size, void* d_ws, size_t ws_size, hipStream_t stream) {
    static int grid = 0;
    if (grid == 0) {
        if (n_in != 34 || out_size != T * D || ws_size < WS_END) { fprintf(stderr, "kernel_launch: unexpected shapes (n_in %d, out %d, ws %zu)\n", n_in, out_size, ws_size); grid = -1; return; }
        int dev = 0, cus = 0, per_cu = 0;
        if (hipGetDevice(&dev) != hipSuccess || hipDeviceGetAttribute(&cus, hipDeviceAttributeMultiprocessorCount, dev) != hipSuccess) { grid = -1; return; }
        if (hipFuncSetAttribute((const void*)fwd_kernel, hipFuncAttributeMaxDynamicSharedMemorySize, LDS_BYTES) != hipSuccess) { fprintf(stderr, "kernel_launch: hipFuncSetAttribute failed\n"); grid = -1; return; }
        if (hipOccupancyMaxActiveBlocksPerMultiprocessor(&per_cu, (const void*)fwd_kernel, NWAVES * 64, LDS_BYTES) != hipSuccess || per_cu < 1)
            fprintf(stderr, "kernel_launch: note: occupancy query reports %d workgroups per CU\n", per_cu);
        (void)hipGetLastError();
        grid = cus;
    }
    if (grid < 0) return;
    if (hipMemsetAsync((char*)d_ws + WS_CTL, 0, CTL_ZERO_BYTES, stream) != hipSuccess) { fprintf(stderr, "kernel_launch: memset failed\n"); return; }
    Args a{};
    for (int i = 0; i < 34; ++i) a.in[i] = (const float*)d_in[i];
    a.out = (float*)d_out; a.ws = (unsigned char*)d_ws;
    hipLaunchKernelGGL(fwd_kernel, dim3(grid), dim3(NWAVES * 64), LDS_BYTES, stream, a);
    const hipError_t le = hipPeekAtLastError();
    if (le != hipSuccess) fprintf(stderr, "kernel_launch: launch failed: %s\n", hipGetErrorName(le));
}
```

```cpp
#include <hip/hip_runtime.h>
#include <hip/hip_bf16.h>
#include <cstdio>
#include <cstdint>
#include <cmath>

#ifndef DBG_STAGE
#define DBG_STAGE 0
#endif

constexpr int D = 1024, NB = 8, SEQ = 4096, T = NB * SEQ;
constexpr int S5W = 512, NG = 32, NP = 64, INW = 5632;
constexpr int LC = 32, NCH = SEQ / LC, NRC = T / LC, KS = LC * 16, KY = KS + 128;
constexpr int NEXP = 32, DEXP = 256;
constexpr int XS_ROWS = 2 * T + NEXP * 256;
constexpr float EPS = 1e-6f;
constexpr float LAMBDA_INIT = 0.2f;

namespace pg8 {
#define PG8_LAS __attribute__((address_space(3)))
typedef unsigned short bf16_t;
typedef short bf16x8 __attribute__((ext_vector_type(8)));
typedef float f32x4 __attribute__((ext_vector_type(4)));
typedef unsigned u32x4 __attribute__((ext_vector_type(4)));
typedef float f32x2 __attribute__((ext_vector_type(2)));
constexpr int BM = 256, BK = 64, HALF = 128, HTB = HALF * BK * 2, STAGE_BYTES = 8 * HTB, NXCD = 8, WGM = 8;

__host__ __device__ __forceinline__ int lds_byte(int r, int c) { const int st = (r >> 4) * 2 + (c >> 5), rr = r & 15, cc = c & 31, ob = rr * 64 + cc * 2; return st * 1024 + (ob ^ (((ob >> 9) & 1) << 5)); }
__host__ __device__ __forceinline__ void stage_rc(int b, int& R, int& C) { const int st = b / 1024, sb = b % 1024, swz = sb ^ (((sb >> 9) & 1) << 5); R = (st >> 1) * 16 + swz / 64; C = (st & 1) * 32 + (swz % 64) / 2; }
__host__ __device__ __forceinline__ int perm32(int rho) { const int n = rho >> 4, i = rho & 15; return 8 * (i >> 2) + 4 * n + (i & 3); }

struct Unit { int pm, pn, g; const char* a; const char* b; };

struct StaticOrder {
    int nM, nN, nwg, G, c; const char* A; const char* B; size_t tsa, tsb;
    __device__ void init(const void* A_, int lda, const void* B_, int ldb, int M, int N, int G_, int c_) { nM = M / BM; nN = N / BM; nwg = nM * nN; G = G_; c = c_; A = (const char*)A_; B = (const char*)B_; tsa = (size_t)BM * lda * 2; tsb = (size_t)BM * ldb * 2; }
    __device__ bool next(int i, Unit& u) const {
        const long L = (long)i * G + c; if (L >= nwg) return false;
        int wgid = (int)L; { const int q = nwg / NXCD, r = nwg % NXCD, xcd = wgid % NXCD, off = wgid / NXCD; wgid = (xcd < r ? xcd * (q + 1) : r * (q + 1) + (xcd - r) * q) + off; }
        const int nig = WGM * nN, gid = wgid / nig, fm = gid * WGM, gsz = (nM - fm) < WGM ? (nM - fm) : WGM;
        u.pm = fm + ((wgid % nig) % gsz); u.pn = (wgid % nig) / gsz; u.g = 0; u.a = A + (size_t)u.pm * tsa; u.b = B + (size_t)u.pn * tsb; return true;
    }
};
struct GroupOrder {
    int nM, nN, ng, G, c; const char* A; const char* B; size_t tsa, tsb, gsa, gsb;
    __device__ void init(const void* A_, int lda, size_t gsa_, const void* B_, int ldb, size_t gsb_, int Mg, int Ng, int ng_, int G_, int c_) {
        nM = Mg / BM; nN = Ng / BM; ng = ng_; G = G_; c = c_; A = (const char*)A_; B = (const char*)B_; tsa = (size_t)BM * lda * 2; tsb = (size_t)BM * ldb * 2; gsa = gsa_; gsb = gsb_; }
    __device__ bool next(int i, Unit& u) const {
        const long L = (long)i * G + c; if (L >= (long)ng * nM * nN) return false;
        const int per = nM * nN, g = (int)(L / per), r = (int)(L % per);
        u.g = g; u.pm = r / nN; u.pn = r % nN; u.a = A + (size_t)g * gsa + (size_t)u.pm * tsa; u.b = B + (size_t)g * gsb + (size_t)u.pn * tsb; return true;
    }
};
struct ExpertOrder {
    const PG8_LAS int* tab; int nN, G, c; const char* A; const char* B; size_t tsa, tsb, esb;
    __device__ void init(const PG8_LAS int* tab_, const void* A_, int lda, const void* B_, int ldb, size_t esb_, int N, int G_, int c_) {
        tab = tab_; nN = N / BM; G = G_; c = c_; A = (const char*)A_; B = (const char*)B_; tsa = (size_t)BM * lda * 2; tsb = (size_t)BM * ldb * 2; esb = esb_; }
    __device__ bool next(int i, Unit& u) const {
        const long L = (long)i * G + c; int rt = (int)(L / nN); const int pn = (int)(L % nN);
        if (rt > XS_ROWS / 256) rt = XS_ROWS / 256;
        const int e = __builtin_amdgcn_readfirstlane(tab[rt]);
        if (e < 0) return false;
        u.g = e; u.pm = rt; u.pn = pn; u.a = A + (size_t)rt * tsa; u.b = B + (size_t)e * esb + (size_t)pn * tsb; return true;
    }
};

__device__ __forceinline__ unsigned cvt_pk_bf16(float lo, float hi) { unsigned r; asm volatile("v_cvt_pk_bf16_f32 %0, %1, %2" : "=v"(r) : "v"(lo), "v"(hi)); return r; }
__device__ __forceinline__ float bf_lo(unsigned w) { return __uint_as_float(w << 16); }
__device__ __forceinline__ float bf_hi(unsigned w) { return __uint_as_float(w & 0xffff0000u); }
__device__ __forceinline__ float sigmoidf_(float x) { return __builtin_amdgcn_rcpf(1.0f + __builtin_amdgcn_exp2f(-1.4426950408889634f * x)); }
__device__ __forceinline__ void unpack8(const u32x4 w, float (&f)[8]) { f[0] = bf_lo(w.x); f[1] = bf_hi(w.x); f[2] = bf_lo(w.y); f[3] = bf_hi(w.y); f[4] = bf_lo(w.z); f[5] = bf_hi(w.z); f[6] = bf_lo(w.w); f[7] = bf_hi(w.w); }
__device__ __forceinline__ u32x4 pack8(const float (&f)[8]) { u32x4 w; w.x = cvt_pk_bf16(f[0], f[1]); w.y = cvt_pk_bf16(f[2], f[3]); w.z = cvt_pk_bf16(f[4], f[5]); w.w = cvt_pk_bf16(f[6], f[7]); return w; }

#define EPI_LOOP_PERM(...) \
    _Pragma("unroll") for (int ai = 0; ai < 2; ++ai) _Pragma("unroll") for (int m = 0; m < 4; ++m) { const int lrow = ai * HALF + wr * 64 + m * 16 + fr; \
        _Pragma("unroll") for (int bj = 0; bj < 2; ++bj) { const int lcol = bj * HALF + wc * 32 + 8 * fq; \
            float v[8] = {acc[ai][bj][m][0][0], acc[ai][bj][m][0][1], acc[ai][bj][m][0][2], acc[ai][bj][m][0][3], acc[ai][bj][m][1][0], acc[ai][bj][m][1][1], acc[ai][bj][m][1][2], acc[ai][bj][m][1][3]}; __VA_ARGS__ } }

struct EpiProj {
    static constexpr bool PERM = true, AFTER_DRAIN = false;
    const float* bias; bf16_t* U; bf16_t* Q; bf16_t* Kb; bf16_t* V; bf16_t* Gt; float c2;
    __device__ __forceinline__ void operator()(const f32x4 (&acc)[2][2][4][2], const Unit& u, int wr, int wc, int fr, int fq) const {
        const int ct = u.pn;
        f32x4 bv[2][2];
#pragma unroll
        for (int bj = 0; bj < 2; ++bj) { const int col = ct * BM + bj * HALF + wc * 32 + 8 * fq; bv[bj][0] = *(const f32x4*)(bias + col); bv[bj][1] = *(const f32x4*)(bias + col + 4); }
        EPI_LOOP_PERM({
            const int row = u.pm * BM + lrow, col = ct * BM + lcol;
            v[0] += bv[bj][0][0]; v[1] += bv[bj][0][1]; v[2] += bv[bj][0][2]; v[3] += bv[bj][0][3]; v[4] += bv[bj][1][0]; v[5] += bv[bj][1][1]; v[6] += bv[bj][1][2]; v[7] += bv[bj][1][3];
            bf16_t* dst;
            if (ct < 2) { const int g = col >> 4, ci = col & 15, rc = row / LC, s = row % LC; dst = U + ((size_t)(g * NRC + rc) * KY + s * 16 + ci); }
            else if (ct < 6) { _Pragma("unroll") for (int i = 0; i < 8; ++i) v[i] *= c2; dst = Q + (size_t)row * D + (col - 512); }
            else if (ct < 10) { dst = Kb + (size_t)row * D + (col - 1536); }
            else if (ct < 14) { dst = V + (size_t)row * D + (col - 2560); }
            else { _Pragma("unroll") for (int i = 0; i < 8; ++i) v[i] = sigmoidf_(v[i]); dst = Gt + (size_t)row * 2048 + (col - 3584); }
            *(u32x4*)dst = pack8(v);
        })
    }
};
struct EpiStates {
    static constexpr bool PERM = false, AFTER_DRAIN = false;
    float* S;
    __device__ __forceinline__ void operator()(const f32x4 (&acc)[2][2][4][2], const Unit& u, int wr, int wc, int fr, int fq) const {
#pragma unroll
        for (int ai = 0; ai < 2; ++ai)
#pragma unroll
            for (int m = 0; m < 4; ++m) { const int row = u.pm * BM + ai * HALF + wr * 64 + m * 16 + fr;
#pragma unroll
                for (int n = 0; n < 2; ++n) { const f32x4 v = acc[ai][0][m][n] + acc[ai][1][m][n]; *(f32x4*)(S + ((size_t)(u.g * NRC + row) * 128 + wc * 32 + 16 * n + 4 * fq)) = v; } }
    }
};
struct EpiY {
    static constexpr bool PERM = true, AFTER_DRAIN = false;
    const bf16_t* U; const float* dskip; bf16_t* Y;
    __device__ __forceinline__ void operator()(const f32x4 (&acc)[2][2][4][2], const Unit& u, int wr, int wc, int fr, int fq) const {
        EPI_LOOP_PERM({
            const int rc = u.pm * BM + lrow, n = u.pn * BM + lcol, tt = n >> 4, co = n & 15;
            const u32x4 uw = *(const u32x4*)(U + ((size_t)(u.g * NRC + rc) * KY + n)); float uf[8]; unpack8(uw, uf);
            const f32x4 d0 = *(const f32x4*)(dskip + u.g * 16 + co), d1 = *(const f32x4*)(dskip + u.g * 16 + co + 4);
            const float dd[8] = {d0[0], d0[1], d0[2], d0[3], d1[0], d1[1], d1[2], d1[3]};
            _Pragma("unroll") for (int i = 0; i < 8; ++i) { const float y = v[i] + dd[i] * uf[i]; const float z = 1.5957691216057308f * (y + 0.044715f * y * y * y); v[i] = y * sigmoidf_(z); }
            *(u32x4*)(Y + ((size_t)(rc * LC + tt) * S5W + u.g * 16 + co)) = pack8(v);
        })
    }
};
struct EpiGlu {
    static constexpr bool PERM = true, AFTER_DRAIN = false;
    const bf16_t* Y; const float* bias; bf16_t* O;
    __device__ __forceinline__ void operator()(const f32x4 (&acc)[2][2][4][2], const Unit& u, int wr, int wc, int fr, int fq) const {
        EPI_LOOP_PERM({
            const int row = u.pm * BM + lrow, col = u.pn * BM + lcol;
            const u32x4 yw = *(const u32x4*)(Y + (size_t)row * S5W + col); float yf[8]; unpack8(yw, yf);
            const f32x4 b0 = *(const f32x4*)(bias + col), b1 = *(const f32x4*)(bias + col + 4);
            const float bb[8] = {b0[0], b0[1], b0[2], b0[3], b1[0], b1[1], b1[2], b1[3]};
            _Pragma("unroll") for (int i = 0; i < 8; ++i) v[i] = yf[i] * sigmoidf_(v[i] + bb[i]);
            *(u32x4*)(O + (size_t)row * S5W + col) = pack8(v);
        })
    }
};
template <int MODE> struct EpiBranch {
    static constexpr bool PERM = true, AFTER_DRAIN = false;
    const bf16_t* Gt; const bf16_t* Tin; bf16_t* O;
    __device__ __forceinline__ void operator()(const f32x4 (&acc)[2][2][4][2], const Unit& u, int wr, int wc, int fr, int fq) const {
        EPI_LOOP_PERM({
            const int row = u.pm * BM + lrow, col = u.pn * BM + lcol;
            const u32x4 gw = *(const u32x4*)(Gt + (size_t)row * 2048 + MODE * D + col); float gf[8]; unpack8(gw, gf);
            if (MODE == 1) { const u32x4 tw = *(const u32x4*)(Tin + (size_t)row * D + col); float tf[8]; unpack8(tw, tf);
                _Pragma("unroll") for (int i = 0; i < 8; ++i) v[i] = tf[i] + gf[i] * v[i]; }
            else { _Pragma("unroll") for (int i = 0; i < 8; ++i) v[i] = gf[i] * v[i]; }
            *(u32x4*)(O + (size_t)row * D + col) = pack8(v);
        })
    }
};
struct EpiOut {
    static constexpr bool PERM = true, AFTER_DRAIN = false;
    const float* x; const float* mod; bf16_t* H;
    __device__ __forceinline__ void operator()(const f32x4 (&acc)[2][2][4][2], const Unit& u, int wr, int wc, int fr, int fq) const {
        const int b = (u.pm * BM) / SEQ; const float* gt = mod + (size_t)b * 6 * D + 2 * D;
        EPI_LOOP_PERM({
            const int row = u.pm * BM + lrow, col = u.pn * BM + lcol; const size_t off = (size_t)row * D + col;
            const f32x4 g0 = *(const f32x4*)(gt + col), g1 = *(const f32x4*)(gt + col + 4), x0 = *(const f32x4*)(x + off), x1 = *(const f32x4*)(x + off + 4);
            v[0] = x0[0] + g0[0] * v[0]; v[1] = x0[1] + g0[1] * v[1]; v[2] = x0[2] + g0[2] * v[2]; v[3] = x0[3] + g0[3] * v[3];
            v[4] = x1[0] + g1[0] * v[4]; v[5] = x1[1] + g1[1] * v[5]; v[6] = x1[2] + g1[2] * v[6]; v[7] = x1[3] + g1[3] * v[7];
            *(u32x4*)(H + off) = pack8(v);
        })
    }
};
struct EpiRouter {
    static constexpr bool PERM = false, AFTER_DRAIN = false;
    float* L;
    __device__ __forceinline__ void operator()(const f32x4 (&acc)[2][2][4][2], const Unit& u, int wr, int wc, int fr, int fq) const {
        if (wc < 2) {
#pragma unroll
            for (int ai = 0; ai < 2; ++ai)
#pragma unroll
                for (int m = 0; m < 4; ++m) { const int row = u.pm * BM + ai * HALF + wr * 64 + m * 16 + fr;
#pragma unroll
                    for (int n = 0; n < 2; ++n) { const f32x4 v = acc[ai][0][m][n] + acc[ai][1][m][n]; *(f32x4*)(L + (size_t)row * 64 + wc * 32 + 16 * n + 4 * fq) = v; } }
        }
    }
};
struct EpiExp1 {
    static constexpr bool PERM = true, AFTER_DRAIN = false;
    bf16_t* Hd;
    __device__ __forceinline__ void operator()(const f32x4 (&acc)[2][2][4][2], const Unit& u, int wr, int wc, int fr, int fq) const {
#pragma unroll
        for (int ai = 0; ai < 2; ++ai)
#pragma unroll
            for (int m = 0; m < 4; ++m) { const int row = u.pm * BM + ai * HALF + wr * 64 + m * 16 + fr; float v[8];
#pragma unroll
                for (int n = 0; n < 2; ++n)
#pragma unroll
                    for (int i = 0; i < 4; ++i) { const float g = acc[ai][0][m][n][i], up = acc[ai][1][m][n][i]; v[n * 4 + i] = g * sigmoidf_(g) * up; }
                *(u32x4*)(Hd + (size_t)row * DEXP + u.pn * HALF + wc * 32 + 8 * fq) = pack8(v); }
    }
};
struct EpiExp2 {
    static constexpr bool PERM = true, AFTER_DRAIN = false;
    const int* dest; const float* cw; bf16_t* Sl;
    __device__ __forceinline__ void operator()(const f32x4 (&acc)[2][2][4][2], const Unit& u, int wr, int wc, int fr, int fq) const {
        EPI_LOOP_PERM({
            const int row = u.pm * BM + lrow, col = u.pn * BM + lcol; const int d = dest[row]; const float w = cw[row];
            if (d >= 0) { _Pragma("unroll") for (int i = 0; i < 8; ++i) v[i] *= w; *(u32x4*)(Sl + (size_t)d * D + col) = pack8(v); }
        })
    }
};

template <class Epi, class Sched, bool ALIGN_EPI = false, bool SP2 = false>
__device__ __forceinline__ void gemm_phase(PG8_LAS unsigned char* lds, const int K, const int lda, const int ldb, const Sched& S, const Epi& E) {
    int tid = threadIdx.x; asm volatile("" : "+v"(tid));
    const int wid = __builtin_amdgcn_readfirstlane(tid >> 6), lane = tid & 63, wr = wid >> 2, wc = wid & 3, fr = lane & 15, fq = lane >> 4;
    const int nt = K / BK;
    unsigned voffA[2], voffB[2];
#pragma unroll
    for (int i = 0; i < 2; ++i) { int R, C; stage_rc(tid * 16 + i * 8192, R, C); const int Rb = Epi::PERM ? ((R & ~31) + perm32(R & 31)) : R;
        voffA[i] = (unsigned)(R * lda + C) * 2u; voffB[i] = (unsigned)(Rb * ldb + C) * 2u; }
    const size_t kstep = (size_t)(BK * 2);
    const size_t hstepA = (size_t)HALF * lda * 2, hstepB = (size_t)HALF * ldb * 2;
    const unsigned ldsw = (unsigned)wid * 1024u;
    const int aoff = lds_byte(wr * 64 + fr, fq * 8), boff = lds_byte(wc * 32 + fr, fq * 8);
#define PG8_SA(b, h) (((b) * 2 + (h)) * HTB)
#define PG8_SB(b, h) ((4 + (b) * 2 + (h)) * HTB)
#define PG8_STAGE(bufoff, gbase, voff) do { _Pragma("unroll") for (int _i = 0; _i < 2; ++_i) \
        __builtin_amdgcn_global_load_lds((const unsigned*)((const char*)(gbase) + (voff)[_i]), (PG8_LAS unsigned*)(lds + (bufoff) + ldsw + _i * 8192), 16, 0, 0); } while (0)
#define PG8_LDA(dst, b, h) do { _Pragma("unroll") for (int m = 0; m < 4; ++m) _Pragma("unroll") for (int k = 0; k < 2; ++k) dst[m][k] = *(const PG8_LAS bf16x8*)(lds + PG8_SA(b, h) + aoff + m * 2048 + k * 1024); } while (0)
#define PG8_LDB(dst, b, h) do { _Pragma("unroll") for (int n = 0; n < 2; ++n) _Pragma("unroll") for (int k = 0; k < 2; ++k) dst[n][k] = *(const PG8_LAS bf16x8*)(lds + PG8_SB(b, h) + boff + n * 2048 + k * 1024); } while (0)
#define PG8_MMA(ai, bj, At, Bt) do { __builtin_amdgcn_s_setprio(1); _Pragma("unroll") for (int m = 0; m < 4; ++m) _Pragma("unroll") for (int n = 0; n < 2; ++n) _Pragma("unroll") for (int k = 0; k < 2; ++k) \
        acc[ai][bj][m][n] = __builtin_amdgcn_mfma_f32_16x16x32_bf16(Bt[n][k], At[m][k], acc[ai][bj][m][n], 0, 0, 0); __builtin_amdgcn_s_setprio(0); } while (0)
#define PG8_WAIT_V(n) asm volatile("s_waitcnt vmcnt(" #n ")" ::: "memory")
#define PG8_WAIT_L(n) asm volatile("s_waitcnt lgkmcnt(" #n ")" ::: "memory")
#define PG8_BAR __builtin_amdgcn_s_barrier()
#define PG8_SCHED __builtin_amdgcn_sched_barrier(0)
    Unit cur, nxt; int ui = 0;
    if (!S.next(0, cur)) return;
    f32x4 acc[2][2][4][2];
#pragma unroll
    for (int a = 0; a < 2; ++a)
#pragma unroll
        for (int b = 0; b < 2; ++b)
#pragma unroll
            for (int m = 0; m < 4; ++m)
#pragma unroll
                for (int n = 0; n < 2; ++n) acc[a][b][m][n] = (f32x4){0.f, 0.f, 0.f, 0.f};
    bf16x8 At[4][2], B0[2][2], B1[2][2];
    const char* cA = cur.a; const char* cB = cur.b;
    if constexpr (SP2) {
        PG8_STAGE(PG8_SB(0, 0), cB, voffB); PG8_STAGE(PG8_SB(0, 1), cB + hstepB, voffB); PG8_STAGE(PG8_SA(0, 0), cA, voffA); PG8_STAGE(PG8_SA(0, 1), cA + hstepA, voffA);
        if (wr == 1) PG8_BAR;
        PG8_WAIT_V(2); PG8_BAR;
        PG8_STAGE(PG8_SB(1, 0), cB + kstep, voffB); PG8_STAGE(PG8_SA(1, 0), cA + kstep, voffA); PG8_STAGE(PG8_SB(1, 1), cB + hstepB + kstep, voffB);
        PG8_WAIT_V(6); PG8_BAR;
    } else {
        PG8_STAGE(PG8_SB(0, 0), cB, voffB); PG8_STAGE(PG8_SA(0, 0), cA, voffA); PG8_STAGE(PG8_SB(0, 1), cB + hstepB, voffB); PG8_STAGE(PG8_SA(0, 1), cA + hstepA, voffA);
        if (wr == 1) PG8_BAR;
        PG8_WAIT_V(4); PG8_BAR;
        PG8_STAGE(PG8_SB(1, 0), cB + kstep, voffB); PG8_STAGE(PG8_SA(1, 0), cA + kstep, voffA); PG8_STAGE(PG8_SB(1, 1), cB + hstepB + kstep, voffB);
        PG8_WAIT_V(6); PG8_BAR;
    }
    for (;;) {
        const bool has_next = S.next(ui + 1, nxt);
        const char* nA = has_next ? nxt.a : cA; const char* nB = has_next ? nxt.b : cB;
        for (int t = 0; t < nt; t += 2) {
            const bool last = (t == nt - 2);
            const char* a1 = cA + (size_t)(t + 1) * kstep;
            const char* a2 = last ? nA : cA + (size_t)(t + 2) * kstep; const char* b2 = last ? nB : cB + (size_t)(t + 2) * kstep;
            const char* a3 = a2 + kstep; const char* b3 = b2 + kstep;
            if constexpr (SP2) {
            PG8_LDB(B0, 0, 0); PG8_LDB(B1, 0, 1); PG8_SCHED; PG8_LDA(At, 0, 0); PG8_STAGE(PG8_SA(1, 1), a1 + hstepA, voffA);
            PG8_WAIT_V(8); PG8_WAIT_L(0); PG8_BAR; PG8_MMA(0, 0, At, B0); PG8_MMA(0, 1, At, B1); PG8_BAR; PG8_SCHED;
            PG8_LDA(At, 0, 1); PG8_STAGE(PG8_SB(0, 0), b2, voffB); PG8_STAGE(PG8_SB(0, 1), b2 + hstepB, voffB); PG8_STAGE(PG8_SA(0, 0), a2, voffA);
            PG8_WAIT_V(8); PG8_WAIT_L(0); PG8_BAR; PG8_MMA(1, 0, At, B0); PG8_MMA(1, 1, At, B1); PG8_BAR; PG8_SCHED;
            PG8_LDB(B0, 1, 0); PG8_LDB(B1, 1, 1); PG8_SCHED; PG8_LDA(At, 1, 0); PG8_STAGE(PG8_SA(0, 1), a2 + hstepA, voffA);
            PG8_WAIT_V(8); PG8_WAIT_L(0); PG8_BAR; PG8_MMA(0, 0, At, B0); PG8_MMA(0, 1, At, B1); PG8_BAR; PG8_SCHED;
            PG8_LDA(At, 1, 1); PG8_STAGE(PG8_SB(1, 0), b3, voffB); PG8_STAGE(PG8_SB(1, 1), b3 + hstepB, voffB); PG8_STAGE(PG8_SA(1, 0), a3, voffA);
            PG8_WAIT_V(8); PG8_WAIT_L(0); PG8_BAR; PG8_MMA(1, 0, At, B0); PG8_MMA(1, 1, At, B1); PG8_BAR; PG8_SCHED;
            } else {
            PG8_LDB(B0, 0, 0); PG8_SCHED; PG8_LDA(At, 0, 0); PG8_STAGE(PG8_SA(1, 1), a1 + hstepA, voffA);
            PG8_WAIT_L(8); PG8_BAR; PG8_WAIT_L(0); PG8_MMA(0, 0, At, B0); PG8_BAR; PG8_SCHED;
            PG8_LDB(B1, 0, 1); PG8_STAGE(PG8_SB(0, 0), b2, voffB);
            PG8_BAR; PG8_WAIT_L(0); PG8_MMA(0, 1, At, B1); PG8_BAR;
            PG8_LDA(At, 0, 1); PG8_STAGE(PG8_SA(0, 0), a2, voffA);
            PG8_BAR; PG8_WAIT_L(0); PG8_MMA(1, 0, At, B0); PG8_BAR; PG8_SCHED;
            PG8_STAGE(PG8_SB(0, 1), b2 + hstepB, voffB);
            PG8_WAIT_V(6); PG8_BAR; PG8_MMA(1, 1, At, B1); PG8_BAR;
            PG8_LDB(B0, 1, 0); PG8_SCHED; PG8_LDA(At, 1, 0); PG8_STAGE(PG8_SA(0, 1), a2 + hstepA, voffA);
            PG8_WAIT_L(8); PG8_BAR; PG8_WAIT_L(0); PG8_MMA(0, 0, At, B0); PG8_BAR; PG8_SCHED;
            PG8_LDB(B1, 1, 1); PG8_STAGE(PG8_SB(1, 0), b3, voffB);
            PG8_BAR; PG8_WAIT_L(0); PG8_MMA(0, 1, At, B1); PG8_BAR;
            PG8_LDA(At, 1, 1); PG8_STAGE(PG8_SA(1, 0), a3, voffA);
            PG8_BAR; PG8_WAIT_L(0); PG8_MMA(1, 0, At, B0); PG8_BAR; PG8_SCHED;
            PG8_STAGE(PG8_SB(1, 1), b3 + hstepB, voffB);
            PG8_WAIT_V(6); PG8_BAR; PG8_MMA(1, 1, At, B1); PG8_BAR;
            }
        }
        if constexpr (ALIGN_EPI) { if (wr == 0) PG8_BAR; }
        E(acc, cur, wr, wc, fr, fq);
        if (!has_next) break;
#pragma unroll
        for (int a = 0; a < 2; ++a)
#pragma unroll
            for (int b = 0; b < 2; ++b)
#pragma unroll
                for (int m = 0; m < 4; ++m)
#pragma unroll
                    for (int n = 0; n < 2; ++n) acc[a][b][m][n] = (f32x4){0.f, 0.f, 0.f, 0.f};
        cur = nxt; cA = nA; cB = nB; ++ui;
        if constexpr (ALIGN_EPI) { if (wr == 1) PG8_BAR; }
    }
    PG8_WAIT_V(0);
    if constexpr (!ALIGN_EPI) { if (wr == 0) PG8_BAR; }
    PG8_BAR;
#undef PG8_SA
#undef PG8_SB
#undef PG8_STAGE
#undef PG8_LDA
#undef PG8_LDB
#undef PG8_MMA
#undef PG8_WAIT_V
#undef PG8_WAIT_L
#undef PG8_BAR
#undef PG8_SCHED
}
}

namespace attn_body {
using bf16=__hip_bfloat16;
using bf16x8=__attribute__((ext_vector_type(8)))short;
using s16x4=__attribute__((ext_vector_type(4)))short;
using f32x16=__attribute__((ext_vector_type(16)))float;
using u32x4=__attribute__((ext_vector_type(4)))unsigned;
constexpr int NHEAD=16,SEQ=4096,D=64,DM=NHEAD*D;
constexpr int NW=8,QBLK=32,QB=QBLK*NW,KVBLK=64,NQB=SEQ/QB;
__device__ __forceinline__ int crow(int r,int hi){return (r&3)+8*(r>>2)+4*hi;}
#define SBAR() __builtin_amdgcn_sched_barrier(0)
__device__ __forceinline__ void cmask(f32x16&p0,f32x16&p1,int jb,int wid){
  const float NEG=-INFINITY;
  if(jb>(wid>>1)){
  #pragma unroll
  for(int r=0;r<16;++r){p0[r]=NEG;p1[r]=NEG;}}
}
constexpr int NSLOT=3, SLOTB=8192, VSLOTB=16384;
constexpr int LDS_K=0, LDS_V=NSLOT*SLOTB, LDS_WS=LDS_V+NSLOT*VSLOTB, LDS_OST=LDS_WS+NW*64*4, LDS_BYTES=LDS_OST+NW*8192;
constexpr float C2=0.125f*1.4426950408889634f;
__device__ __forceinline__ void glds16(const char*sbase,unsigned voff,unsigned lds_dst){unsigned keep;
  asm volatile("s_mov_b32 %0, m0\n\ts_mov_b32 m0, %2\n\ts_nop 0\n\tglobal_load_lds_dwordx4 %1, %3\n\ts_mov_b32 m0, %0":"=&s"(keep):"v"(voff),"s"(lds_dst),"s"(sbase):"memory");}
__device__ __forceinline__ float max3f(float a,float b,float c){float r;asm("v_max3_f32 %0, %1, %2, %3":"=v"(r):"v"(a),"v"(b),"v"(c));return r;}
__device__ __forceinline__ float max2f(float a,float b){float r;asm("v_max_f32_e32 %0, %1, %2":"=v"(r):"v"(a),"v"(b));return r;}
typedef float f32x2_t __attribute__((ext_vector_type(2))); typedef __bf16 bf16x2_t __attribute__((ext_vector_type(2)));
__device__ __forceinline__ unsigned cvtpk_s(float lo,float hi){f32x2_t v={lo,hi};bf16x2_t b=__builtin_convertvector(v,bf16x2_t);return __builtin_bit_cast(unsigned,b);}
#define WAIT_BAR(N) asm volatile("s_waitcnt vmcnt(" #N ") lgkmcnt(0)\n\ts_barrier":::"memory")

__device__ __forceinline__ void qkt(f32x16&p0,f32x16&p1,const char*Kslot,const bf16x8*qr,int r32,int hi){
  const char*kb=Kslot+hi*1024+r32*16; const f32x16 z=f32x16{};
  #pragma unroll
  for(int d0=0;d0<4;++d0){
    const bf16x8 b0=*reinterpret_cast<const bf16x8*>(kb+d0*2048);
    const bf16x8 b1=*reinterpret_cast<const bf16x8*>(kb+d0*2048+512);
    if(d0==0){p0=__builtin_amdgcn_mfma_f32_32x32x16_bf16(b0,qr[0],z,0,0,0);p1=__builtin_amdgcn_mfma_f32_32x32x16_bf16(b1,qr[0],z,0,0,0);}
    else{p0=__builtin_amdgcn_mfma_f32_32x32x16_bf16(b0,qr[d0],p0,0,0,0);p1=__builtin_amdgcn_mfma_f32_32x32x16_bf16(b1,qr[d0],p1,0,0,0);}}
}
typedef __attribute__((address_space(3))) const char* lds_cptr;
typedef short v4i16_t __attribute__((ext_vector_type(4)));
__device__ __forceinline__ void kload8(bf16x8*kf,lds_cptr kp){
  kf[0]=*(const __attribute__((address_space(3))) bf16x8*)(kp);      kf[1]=*(const __attribute__((address_space(3))) bf16x8*)(kp+512);
  kf[2]=*(const __attribute__((address_space(3))) bf16x8*)(kp+2048); kf[3]=*(const __attribute__((address_space(3))) bf16x8*)(kp+2560);
  kf[4]=*(const __attribute__((address_space(3))) bf16x8*)(kp+4096); kf[5]=*(const __attribute__((address_space(3))) bf16x8*)(kp+4608);
  kf[6]=*(const __attribute__((address_space(3))) bf16x8*)(kp+6144); kf[7]=*(const __attribute__((address_space(3))) bf16x8*)(kp+6656);
}
__device__ __forceinline__ void kload2(bf16x8*kf,lds_cptr kp,int j){ kf[2*j]=*(const __attribute__((address_space(3))) bf16x8*)(kp+j*2048); kf[2*j+1]=*(const __attribute__((address_space(3))) bf16x8*)(kp+j*2048+512); }
__device__ __forceinline__ s16x4 vtr(lds_cptr p){ return __builtin_bit_cast(s16x4,__builtin_amdgcn_ds_read_tr16_b64_v4i16((__attribute__((address_space(3))) v4i16_t*)p)); }
__device__ __forceinline__ float rowmax(const f32x16&p0,const f32x16&p1){
  float a=max3f(p0[0],p0[1],p1[0]),b=max3f(p0[2],p0[3],p1[1]);a=max3f(a,p1[2],p1[3]);
  #pragma unroll
  for(int r=4;r<16;r+=4){a=max3f(a,p0[r],p0[r+1]);b=max3f(b,p0[r+2],p0[r+3]);a=max3f(a,p1[r],p1[r+1]);b=max3f(b,p1[r+2],p1[r+3]);}
  const float m=max2f(a,b);
  auto rr=__builtin_amdgcn_permlane32_swap(__float_as_uint(m),__float_as_uint(m),false,false);
  return max2f(__uint_as_float(rr[0]),__uint_as_float(rr[1]));
}
__device__ __forceinline__ void pv(f32x16*o,int vb,bf16x8 pa0,bf16x8 pa1,bf16x8 pa2,bf16x8 pa3){
  #pragma unroll
  for(int d0=0;d0<4;++d0){s16x4 lo[4],hi[4];
    #pragma unroll
    for(int ks=0;ks<4;++ks){
      asm volatile("ds_read_b64_tr_b16 %0,%1 offset:%c2":"=&v"(lo[ks]):"v"(vb),"i"(d0*4096+ks*1024):"memory");
      asm volatile("ds_read_b64_tr_b16 %0,%1 offset:%c2":"=&v"(hi[ks]):"v"(vb),"i"(d0*4096+ks*1024+512):"memory");}
    asm volatile("s_waitcnt lgkmcnt(0)":::"memory");SBAR();
    #define PK(k) (bf16x8){lo[k][0],lo[k][1],lo[k][2],lo[k][3],hi[k][0],hi[k][1],hi[k][2],hi[k][3]}
    o[d0]=__builtin_amdgcn_mfma_f32_32x32x16_bf16(pa0,PK(0),o[d0],0,0,0);
    o[d0]=__builtin_amdgcn_mfma_f32_32x32x16_bf16(pa1,PK(1),o[d0],0,0,0);
    o[d0]=__builtin_amdgcn_mfma_f32_32x32x16_bf16(pa2,PK(2),o[d0],0,0,0);
    o[d0]=__builtin_amdgcn_mfma_f32_32x32x16_bf16(pa3,PK(3),o[d0],0,0,0);
    #undef PK
  }
}
template<int THRL,size_t OFF_Q,size_t OFF_K,size_t OFF_V,int GSO> __device__ __forceinline__ void attn_unit(int b,int h,int qb,const char*ws,bf16*AO,float lam,char*shm){
  const bf16*Q=(const bf16*)(ws+OFF_Q); const float*gs=(const float*)(shm+GSO);
  int tid=threadIdx.x; asm volatile("":"+v"(tid)); const int lane=tid&63,r32=lane&31,hi=lane>>5; const int wid=__builtin_amdgcn_readfirstlane(tid>>6);
  const long rowbase=(long)b*SEQ; const int q0=qb*QB;
  const unsigned lds0=(unsigned)(uintptr_t)shm;
  float*wsf=(float*)(shm+LDS_WS)+wid*64;
  bf16*stg=(bf16*)(shm+LDS_OST)+wid*4096;
  const unsigned kdst=lds0+LDS_K+wid*1024, vdst=lds0+LDS_V+wid*1024;
  const int vb0=(int)(lds0+LDS_V)+((lane>>4)&1)*32+(lane&3)*8+(4*hi+((lane&15)>>2))*64;
  const char*Kbase=shm+LDS_K;
  const lds_cptr shm3=(lds_cptr)shm; const lds_cptr kp0=shm3+LDS_K+hi*1024+r32*16; const lds_cptr vp0=shm3+LDS_V+((lane>>4)&1)*32+(lane&3)*8+(4*hi+((lane&15)>>2))*64;
  const int NT=(q0+QB)/KVBLK;
  const char*Vh=ws+OFF_V+(rowbase*DM+h*128)*2;
  const unsigned vsrc=(unsigned)(((16*(wid&3)+(lane>>2))*DM+(wid>>2)*32+(lane&3)*8)*2);
  #pragma unroll 1
  for(int mp=0;mp<2;++mp){
  const int hq=2*h+mp;
  const bf16*Qw=Q+(rowbase+q0+wid*QBLK)*DM+hq*D;
  const char*Kh=ws+OFF_K+(rowbase*DM+hq*D)*2;
  const unsigned ksrc=(unsigned)((lane*DM+wid*8)*2);
  bf16x8 kf[8];
  #define DMA_K(t,slot) glds16(Kh+(long)(t)*(KVBLK*DM*2),ksrc,(unsigned)__builtin_amdgcn_readfirstlane(kdst+(slot)))
  #define DMA_V(t,slot) do{ glds16(Vh+(long)(t)*(KVBLK*DM*2),vsrc,(unsigned)__builtin_amdgcn_readfirstlane(vdst+2*(slot))); glds16(Vh+(long)(t)*(KVBLK*DM*2)+128,vsrc,(unsigned)__builtin_amdgcn_readfirstlane(vdst+2*(slot)+8192)); }while(0)
  DMA_K(0,0);DMA_V(0,0);DMA_K(1,SLOTB);
  bf16x8 qr[4];
  #pragma unroll
  for(int d0=0;d0<4;++d0)qr[d0]=*reinterpret_cast<const bf16x8*>(&Qw[(long)r32*DM+d0*16+hi*8]);
  float mhat=0.f,l_reg=0.f;f32x16 o[4];o[0]=f32x16{};o[1]=f32x16{};o[2]=f32x16{};o[3]=f32x16{};
  #define CMASK(P0,P1,t) do{int jb_=(t)-(NT-4); if(jb_>=0)cmask(P0,P1,jb_,wid);}while(0)
  bool resc=false;
  #define RESC() do{ if(resc){ asm volatile("s_waitcnt lgkmcnt(0)":::"memory"); \
      _Pragma("unroll") for(int d_=0;d_<4;++d_) _Pragma("unroll") for(int r=0;r<16;++r)o[d_][r]*=wsf[crow(r,hi)]; } }while(0)
  f32x16 pA0,pA1,pB0,pB1;
  int sl_prev=0,sl_cur=0,sl_next=SLOTB;
  #define ROT() do{sl_prev=sl_cur;sl_cur=sl_next;sl_next=(sl_next==(NSLOT-1)*SLOTB)?0:sl_next+SLOTB;}while(0)
  DMA_K(2,2*SLOTB);
  WAIT_BAR(4);
  qkt(pA0,pA1,Kbase,qr,r32,hi);asm volatile("s_nop 15\n\ts_nop 7":"+v"(pA0),"+v"(pA1));CMASK(pA0,pA1,0);
  { const float rm=rowmax(pA0,pA1); mhat=rm; resc=false;
    _Pragma("unroll") for(int r=0;r<16;++r){pA0[r]=__builtin_amdgcn_exp2f(pA0[r]-mhat);pA1[r]=__builtin_amdgcn_exp2f(pA1[r]-mhat);} }
  WAIT_BAR(0);
  DMA_K(3,0);DMA_V(1,SLOTB);
  ROT();
  kload8(kf,kp0+sl_cur);
  WAIT_BAR(3);
  s16x4 vlo[8],vhi[8]; u32x4 pw0,pw1,pw2,pw3;
  #define PKW(P,B) cvtpk_s(P[B],P[B+1])
  #define PAF(k) __builtin_bit_cast(bf16x8,pw##k)
  #define VFR(i) (bf16x8){vlo[i][0],vlo[i][1],vlo[i][2],vlo[i][3],vhi[i][0],vhi[i][1],vhi[i][2],vhi[i][3]}
  #define PIN(x) asm volatile("":"+v"(x))
  #define MX3(a,b,c) __builtin_fmaxf(__builtin_fmaxf((a),(b)),(c))
  #define ZC (f32x16{})
  #define GAPA(MF,A0,A1,A2,A3,W0,W1,PW) do{ MF; sacc+=A0; sacc+=A1; sacc+=A2; sacc+=A3; PIN(sacc); W0; W1; PIN(PW); SBAR(); }while(0)
  #define EX(v) __builtin_amdgcn_exp2f((v)-mhat)
  #define GAPB(MF,X,B) do{ MF; X[B]=EX(X[B]); X[B+1]=EX(X[B+1]); PIN(X); SBAR(); }while(0)
  #define VRD(i) do{ vlo[i]=vtr(vp_+(((i)>>2)*4096+((i)&3)*1024)); vhi[i]=vtr(vp_+(((i)>>2)*4096+((i)&3)*1024+512)); }while(0)
  #define VRD2(i) do{ vlo[i]=vtr(vp_+((2+((i)>>2))*4096+((i)&3)*1024)); vhi[i]=vtr(vp_+((2+((i)>>2))*4096+((i)&3)*1024+512)); SBAR(); }while(0)
  #define KRD(G,j) do{ if(G){ kload2(kf,kp0+sl_next,j); SBAR(); } }while(0)
  #define STEP(C0,C1,P0,P1,t,GK,GV,GL) do{ SBAR(); \
    const lds_cptr vp_=vp0+2*sl_prev; \
    VRD(0); SBAR(); float sacc=(P0[0]+P0[1]); \
    GAPA(C0=__builtin_amdgcn_mfma_f32_32x32x16_bf16(kf[0],qr[0],ZC,0,0,0), P0[2],P0[3],P0[4],P0[5],     pw0[0]=PKW(P0,0), pw0[1]=PKW(P0,2), pw0); \
    VRD(4); SBAR(); GAPA(C1=__builtin_amdgcn_mfma_f32_32x32x16_bf16(kf[1],qr[0],ZC,0,0,0), P0[6],P0[7],P0[8],P0[9],     pw0[2]=PKW(P0,4), pw0[3]=PKW(P0,6), pw0); \
    VRD(1); SBAR(); GAPA(C0=__builtin_amdgcn_mfma_f32_32x32x16_bf16(kf[2],qr[1],C0,0,0,0),   P0[10],P0[11],P0[12],P0[13], pw1[0]=PKW(P0,8), pw1[1]=PKW(P0,10), pw1); \
    VRD(5); SBAR(); GAPA(C1=__builtin_amdgcn_mfma_f32_32x32x16_bf16(kf[3],qr[1],C1,0,0,0),   P0[14],P0[15],P1[0],P1[1],   pw1[2]=PKW(P0,12),pw1[3]=PKW(P0,14), pw1); \
    VRD(2); SBAR(); GAPA(C0=__builtin_amdgcn_mfma_f32_32x32x16_bf16(kf[4],qr[2],C0,0,0,0),   P1[2],P1[3],P1[4],P1[5],     pw2[0]=PKW(P1,0), pw2[1]=PKW(P1,2), pw2); \
    VRD(6); SBAR(); GAPA(C1=__builtin_amdgcn_mfma_f32_32x32x16_bf16(kf[5],qr[2],C1,0,0,0),   P1[6],P1[7],P1[8],P1[9],     pw2[2]=PKW(P1,4), pw2[3]=PKW(P1,6), pw2); \
    VRD(3); SBAR(); GAPA(C0=__builtin_amdgcn_mfma_f32_32x32x16_bf16(kf[6],qr[3],C0,0,0,0),   P1[10],P1[11],P1[12],P1[13], pw3[0]=PKW(P1,8), pw3[1]=PKW(P1,10), pw3); \
    VRD(7); SBAR(); GAPA(C1=__builtin_amdgcn_mfma_f32_32x32x16_bf16(kf[7],qr[3],C1,0,0,0),   P1[14],P1[15],0.f,0.f,       pw3[2]=PKW(P1,12),pw3[3]=PKW(P1,14), pw3); \
    l_reg+=sacc; \
    if(GK){DMA_K((t)+3,sl_cur);} if(GV){DMA_V((t)+1,sl_next);} \
    CMASK(C0,C1,t); \
    { float a=MX3(C0[0],C0[1],C1[0]),b=MX3(C0[2],C0[3],C1[1]); a=MX3(a,C1[2],C1[3]); \
      _Pragma("unroll") for(int r=4;r<16;r+=4){a=MX3(a,C0[r],C0[r+1]);b=MX3(b,C0[r+2],C0[r+3]);a=MX3(a,C1[r],C1[r+1]);b=MX3(b,C1[r+2],C1[r+3]);} \
      float rm=__builtin_fmaxf(a,b); { auto rr=__builtin_amdgcn_permlane32_swap(__float_as_uint(rm),__float_as_uint(rm),false,false); rm=__builtin_fmaxf(__uint_as_float(rr[0]),__uint_as_float(rr[1])); } \
      rm-=mhat; resc=false; \
      if(__builtin_expect(__any(rm>(float)THRL),0)){ const float dl=__builtin_fmaxf(rm,0.f); mhat+=dl; \
        const float f=__builtin_amdgcn_exp2f(-dl); l_reg*=f; if(hi==0)wsf[r32]=f; resc=true; } } \
    SBAR(); \
    GAPB(o[0]=__builtin_amdgcn_mfma_f32_32x32x16_bf16(PAF(0),VFR(0),o[0],0,0,0), C0,0);  VRD2(0); \
    GAPB(o[1]=__builtin_amdgcn_mfma_f32_32x32x16_bf16(PAF(0),VFR(4),o[1],0,0,0), C0,2);  VRD2(4); \
    GAPB(o[0]=__builtin_amdgcn_mfma_f32_32x32x16_bf16(PAF(1),VFR(1),o[0],0,0,0), C0,4);  VRD2(1); \
    GAPB(o[1]=__builtin_amdgcn_mfma_f32_32x32x16_bf16(PAF(1),VFR(5),o[1],0,0,0), C0,6);  VRD2(5); \
    GAPB(o[0]=__builtin_amdgcn_mfma_f32_32x32x16_bf16(PAF(2),VFR(2),o[0],0,0,0), C0,8);  VRD2(2); \
    GAPB(o[1]=__builtin_amdgcn_mfma_f32_32x32x16_bf16(PAF(2),VFR(6),o[1],0,0,0), C0,10); VRD2(6); \
    GAPB(o[0]=__builtin_amdgcn_mfma_f32_32x32x16_bf16(PAF(3),VFR(3),o[0],0,0,0), C0,12); VRD2(3); \
    GAPB(o[1]=__builtin_amdgcn_mfma_f32_32x32x16_bf16(PAF(3),VFR(7),o[1],0,0,0), C0,14); VRD2(7); \
    KRD(GL,0); GAPB(o[2]=__builtin_amdgcn_mfma_f32_32x32x16_bf16(PAF(0),VFR(0),o[2],0,0,0), C1,0); \
    KRD(GL,1); GAPB(o[3]=__builtin_amdgcn_mfma_f32_32x32x16_bf16(PAF(0),VFR(4),o[3],0,0,0), C1,2); \
    KRD(GL,2); GAPB(o[2]=__builtin_amdgcn_mfma_f32_32x32x16_bf16(PAF(1),VFR(1),o[2],0,0,0), C1,4); \
    KRD(GL,3); GAPB(o[3]=__builtin_amdgcn_mfma_f32_32x32x16_bf16(PAF(1),VFR(5),o[3],0,0,0), C1,6); \
    GAPB(o[2]=__builtin_amdgcn_mfma_f32_32x32x16_bf16(PAF(2),VFR(2),o[2],0,0,0), C1,8); \
    GAPB(o[3]=__builtin_amdgcn_mfma_f32_32x32x16_bf16(PAF(2),VFR(6),o[3],0,0,0), C1,10); \
    GAPB(o[2]=__builtin_amdgcn_mfma_f32_32x32x16_bf16(PAF(3),VFR(3),o[2],0,0,0), C1,12); \
    GAPB(o[3]=__builtin_amdgcn_mfma_f32_32x32x16_bf16(PAF(3),VFR(7),o[3],0,0,0), C1,14); \
    }while(0)
  int t=1;
  #undef CMASK
  #define CMASK(P0,P1,t) do{}while(0)
  for(;t+5<NT;t+=2){
    STEP(pB0,pB1,pA0,pA1,t,true,true,true);     WAIT_BAR(3); RESC(); ROT();
    STEP(pA0,pA1,pB0,pB1,t+1,true,true,true);   WAIT_BAR(3); RESC(); ROT();
  }
  #undef CMASK
  #define CMASK(P0,P1,t) do{int jb_=(t)-(NT-4); if(jb_>=0)cmask(P0,P1,jb_,wid);}while(0)
  #define ENDW(tt) do{ if((tt)+3<NT){WAIT_BAR(3);} else if((tt)+2<NT){WAIT_BAR(2);} else {WAIT_BAR(0);} }while(0)
  for(;t+1<NT;t+=2){
    STEP(pB0,pB1,pA0,pA1,t,(t+3<NT),(t+1<NT),(t+1<NT));       ENDW(t);   RESC(); ROT();
    STEP(pA0,pA1,pB0,pB1,t+1,(t+4<NT),(t+2<NT),(t+2<NT));     ENDW(t+1); RESC(); ROT();
  }
  STEP(pB0,pB1,pA0,pA1,NT-1,false,false,false); RESC();
  { float sacc=pB0[0]+pB0[1]; _Pragma("unroll") for(int r=2;r<16;++r)sacc+=pB0[r]; _Pragma("unroll") for(int r=0;r<16;++r)sacc+=pB1[r]; l_reg+=sacc;
    pw0=(u32x4){PKW(pB0,0),PKW(pB0,2),PKW(pB0,4),PKW(pB0,6)};pw1=(u32x4){PKW(pB0,8),PKW(pB0,10),PKW(pB0,12),PKW(pB0,14)};pw2=(u32x4){PKW(pB1,0),PKW(pB1,2),PKW(pB1,4),PKW(pB1,6)};pw3=(u32x4){PKW(pB1,8),PKW(pB1,10),PKW(pB1,12),PKW(pB1,14)};
    SBAR(); pv(o,vb0+2*sl_cur,PAF(0),PAF(1),PAF(2),PAF(3)); }
  #undef PKW
  #undef PAF
  #undef VFR
  #undef PIN
  #undef MX3
  #undef ZC
  #undef GAPA
  #undef GAPB
  #undef EX
  #undef VRD
  #undef VRD2
  #undef KRD
  #undef STEP
  #undef ENDW
  #undef DMA_K
  #undef DMA_V
  #undef CMASK
  #undef RESC
  #undef ROT
  {auto rr=__builtin_amdgcn_permlane32_swap(__float_as_uint(l_reg),__float_as_uint(l_reg),false,false);l_reg=__uint_as_float(rr[0])+__uint_as_float(rr[1]);}
  if(hi==0)wsf[32+r32]=l_reg;asm volatile("s_waitcnt lgkmcnt(0)":::"memory");
  float rli[16];
  #pragma unroll
  for(int r=0;r<16;++r)rli[r]=__builtin_amdgcn_rcpf(wsf[32+crow(r,hi)]);
  if(mp==0){
    #pragma unroll
    for(int r=0;r<16;++r){const int orow=crow(r,hi);
      #pragma unroll
      for(int d0=0;d0<4;++d0)stg[orow*128+d0*32+r32]=__float2bfloat16(o[d0][r]*rli[r]);}
  } else {
    #pragma unroll
    for(int r=0;r<16;++r){const int orow=crow(r,hi);
      #pragma unroll
      for(int d0=0;d0<4;++d0){ const float c=__bfloat162float(stg[orow*128+d0*32+r32])-lam*(o[d0][r]*rli[r]); stg[orow*128+d0*32+r32]=__float2bfloat16(c);} }
    asm volatile("s_waitcnt lgkmcnt(0)":::"memory");
    const int row=lane>>1,hf=lane&1; float cv[64]; float ss=0.f;
    #pragma unroll
    for(int i=0;i<8;++i){ const u32x4 w=*(const u32x4*)(stg+row*128+hf*64+i*8);
      cv[8*i+0]=__uint_as_float(w.x<<16);cv[8*i+1]=__uint_as_float(w.x&0xffff0000u);cv[8*i+2]=__uint_as_float(w.y<<16);cv[8*i+3]=__uint_as_float(w.y&0xffff0000u);
      cv[8*i+4]=__uint_as_float(w.z<<16);cv[8*i+5]=__uint_as_float(w.z&0xffff0000u);cv[8*i+6]=__uint_as_float(w.w<<16);cv[8*i+7]=__uint_as_float(w.w&0xffff0000u); }
    #pragma unroll
    for(int i=0;i<64;++i)ss+=cv[i]*cv[i];
    ss+=__int_as_float(__builtin_amdgcn_ds_bpermute((lane^1)<<2,__float_as_int(ss)));
    const float rstd=1.0f/sqrtf(ss*(1.0f/128.0f)+1e-6f);
    bf16*Ow=AO+(rowbase+q0+wid*QBLK+row)*DM+h*128+hf*64;
    #pragma unroll
    for(int i=0;i<8;++i){ const float4 g0=*(const float4*)(gs+hf*64+i*8),g1=*(const float4*)(gs+hf*64+i*8+4); u32x4 w;
      w.x=cvtpk_s(cv[8*i+0]*rstd*g0.x,cv[8*i+1]*rstd*g0.y); w.y=cvtpk_s(cv[8*i+2]*rstd*g0.z,cv[8*i+3]*rstd*g0.w);
      w.z=cvtpk_s(cv[8*i+4]*rstd*g1.x,cv[8*i+5]*rstd*g1.y); w.w=cvtpk_s(cv[8*i+6]*rstd*g1.z,cv[8*i+7]*rstd*g1.w);
      *(u32x4*)(Ow+i*8)=w; }
  }
  asm volatile("s_waitcnt lgkmcnt(0)\n\ts_barrier":::"memory");
  }
}
constexpr int ATTN_LDS_BYTES=LDS_BYTES;
#undef SBAR
#undef WAIT_BAR
}

constexpr size_t MiB = 1u << 20;
constexpr size_t WS_CTL = 0, CTL_ZERO_BYTES = 1 * MiB;
constexpr size_t WS_WIN = 2 * MiB;
constexpr size_t WS_WGLU = 13 * MiB;
constexpr size_t WS_WSSM = 14 * MiB;
constexpr size_t WS_WATT = 15 * MiB;
constexpr size_t WS_WOUT = 17 * MiB;
constexpr size_t WS_WR = 19 * MiB;
constexpr size_t WS_BTP = 20 * MiB;
constexpr size_t WS_BTY = 28 * MiB;
constexpr size_t WS_WE1 = 48 * MiB;
constexpr size_t WS_WE2 = 80 * MiB;
constexpr size_t WS_ETAB = 96 * MiB;
constexpr size_t WS_MOD = 104 * MiB;
constexpr size_t WS_UG = 112 * MiB;
constexpr size_t WS_Q = 152 * MiB, WS_K = 216 * MiB, WS_V = 280 * MiB;
constexpr size_t WS_GATES = 344 * MiB;
constexpr size_t WS_SLOC = 472 * MiB;
constexpr size_t WS_YACT = 152 * MiB;
constexpr size_t WS_S5O = 184 * MiB;
constexpr size_t WS_TMP = 280 * MiB;
constexpr size_t WS_H = 344 * MiB;
constexpr size_t WS_XS = 112 * MiB;
constexpr size_t WS_HDN = 256 * MiB;
constexpr size_t WS_SLOTS = 112 * MiB;
constexpr size_t WS_LOGITS = 472 * MiB;
constexpr size_t WS_RT = 480 * MiB;
constexpr size_t WS_DEST = 482 * MiB;
constexpr size_t WS_CW = 483 * MiB;
constexpr size_t WS_END = 512 * MiB;
constexpr int CW_TMO = 0, CW_BAR = 4096, CW_CNT = 16384;

constexpr int NWAVES = 8;
constexpr int RING_OFF = 0, RING_BYTES = 147456;
constexpr int LDSCTL_OFF = RING_BYTES, MISC_OFF = LDSCTL_OFF + 320;
constexpr int GS_OFF = MISC_OFF + 2048;
constexpr int LDS_BYTES = RING_BYTES + 4096;
static_assert(attn_body::ATTN_LDS_BYTES <= RING_BYTES, "attention LDS");

#define GAS __attribute__((address_space(1)))
#define LAS __attribute__((address_space(3)))
typedef unsigned short bf16;
typedef unsigned v4u __attribute__((ext_vector_type(4)));
typedef unsigned v2u __attribute__((ext_vector_type(2)));
typedef float f32x4 __attribute__((ext_vector_type(4)));
typedef GAS unsigned gu32;
#define RLX_AGENT __ATOMIC_RELAXED, __HIP_MEMORY_SCOPE_AGENT
#define LDS_WAIT() asm volatile("s_waitcnt lgkmcnt(0)" ::: "memory")
#define VM_WAIT() asm volatile("s_waitcnt vmcnt(0)" ::: "memory")
__device__ __forceinline__ unsigned f2bf(float f) { unsigned u = __builtin_bit_cast(unsigned, f); return (u + 0x7fffu + ((u >> 16) & 1u)) >> 16; }
__device__ __forceinline__ unsigned pk2(float lo, float hi) { return f2bf(lo) | (f2bf(hi) << 16); }
__device__ __forceinline__ float bf2f(unsigned b) { return __uint_as_float(b << 16); }

#define XB_TMO      128
#define XB_XCNT(j)  (256  + 64 * (j))
#define XB_XSUB(j)  (1280 + 64 * (j))
#define XB_XGEN(j)  (2304 + 64 * (j))
#define XB_TOP      3328
#define XB_TOPGEN   3392
#define XCD_BAR_WORDS 3456
#define XB_SPIN_CAP (1u << 18)
__device__ __forceinline__ unsigned xb_ld(unsigned* p)              { return __hip_atomic_load(p, __ATOMIC_RELAXED, __HIP_MEMORY_SCOPE_AGENT); }
__device__ __forceinline__ unsigned xb_add(unsigned* p, unsigned v) { return __hip_atomic_fetch_add(p, v, __ATOMIC_RELAXED, __HIP_MEMORY_SCOPE_AGENT); }
__device__ __forceinline__ unsigned xb_xcc_id() { return (unsigned)__builtin_amdgcn_s_getreg((3 << 11) | 20) & 0xFu; }
#define XB_SPIN(cond, bar) do { unsigned _sp = 0; while (cond) { __builtin_amdgcn_s_sleep(1); \
    if ((++_sp & 255u) == 0u) { if (xb_ld(&(bar)[XB_TMO])) break; if (_sp > XB_SPIN_CAP) { atomicAdd(&(bar)[XB_TMO], 1u); break; } } } } while (0)
struct XcdBarrier { unsigned* bar; unsigned x; volatile LAS unsigned* st; };
__device__ __forceinline__ XcdBarrier xcd_barrier_post(unsigned* bar, volatile LAS unsigned* st) {
    XcdBarrier b; b.bar = bar; b.x = xb_xcc_id(); b.st = st;
    if (threadIdx.x == 0) (void)xb_add(&bar[XB_XCNT(b.x)], 1u);
    return b;
}
__device__ __forceinline__ void xcd_barrier_complete(unsigned* bar, unsigned x, unsigned& nloc, unsigned& nx) {
    const unsigned G = gridDim.x * gridDim.y * gridDim.z;
    unsigned sum, cnt, mine, sp = 0u;
    for (;;) {
        sum = 0u; cnt = 0u; mine = 0u;
#pragma unroll
        for (unsigned j = 0; j < 16; ++j) { const unsigned c = xb_ld(&bar[XB_XCNT(j)]); sum += c; cnt += (c > 0u) ? 1u : 0u; mine = (j == x) ? c : mine; }
        if (sum == G) break;
        __builtin_amdgcn_s_sleep(1);
        if ((++sp & 255u) == 0u) { if (xb_ld(&bar[XB_TMO])) break; if (sp > XB_SPIN_CAP) { atomicAdd(&bar[XB_TMO], 1u); break; } }
    }
    nloc = mine > 0u ? mine : 1u; nx = cnt > 0u ? cnt : 1u;
}
__device__ __forceinline__ void xcd_barrier(const XcdBarrier& b) {
    asm volatile("s_waitcnt vmcnt(0)" ::: "memory");
    __syncthreads();
    if (threadIdx.x == 0) {
        unsigned* bar = b.bar;
        __builtin_amdgcn_s_waitcnt(0);
        unsigned nloc = b.st[0], nx = b.st[1];
        if (nloc == 0u) { xcd_barrier_complete(bar, b.x, nloc, nx); b.st[0] = nloc; b.st[1] = nx; }
        const unsigned old = xb_add(&bar[XB_XSUB(b.x)], 1u);
        const unsigned gen = old / nloc;
        if (old + 1u == (gen + 1u) * nloc) {
            __builtin_amdgcn_fence(__ATOMIC_RELEASE, "agent");
            asm volatile("s_waitcnt vmcnt(0)" ::: "memory");
            const unsigned og = xb_add(&bar[XB_TOP], 1u);
            const unsigned tg = og / nx;
            if (og + 1u == (tg + 1u) * nx) xb_add(&bar[XB_TOPGEN], 1u);
            else XB_SPIN(xb_ld(&bar[XB_TOPGEN]) == tg, bar);
            __builtin_amdgcn_fence(__ATOMIC_ACQUIRE, "agent");
            xb_add(&bar[XB_XGEN(b.x)], 1u);
            asm volatile("s_waitcnt vmcnt(0)" ::: "memory");
        } else {
            XB_SPIN(xb_ld(&bar[XB_XGEN(b.x)]) == gen, bar);
            __builtin_amdgcn_fence(__ATOMIC_ACQUIRE, "agent");
            asm volatile("s_waitcnt vmcnt(0)" ::: "memory");
        }
    }
    __syncthreads();
}

__device__ __forceinline__ float shfl_xor_l(float v, int o, int lane) { return __int_as_float(__builtin_amdgcn_ds_bpermute((lane ^ o) << 2, __float_as_int(v))); }
__device__ __forceinline__ float wave_sum(float v, int lane) {
#pragma unroll
    for (int o = 1; o < 64; o <<= 1) v += shfl_xor_l(v, o, lane);
    return v;
}
__device__ __forceinline__ void transpose_tile(const float* W, int N, int k0, int n0, bf16* WT, int ldo, int orow0, int ocol0, LAS float* scr, int lane) {
#pragma unroll 8
    for (int i = 0; i < 32; ++i) { const int kk = 2 * i + (lane >> 5); scr[kk * 33 + (lane & 31)] = W[(size_t)(k0 + kk) * N + n0 + (lane & 31)]; }
    LDS_WAIT(); asm volatile("" ::: "memory");
    const int c = lane & 7;
#pragma unroll
    for (int j = 0; j < 4; ++j) { const int n = (lane >> 3) + 8 * j; const LAS float* s = scr + (8 * c) * 33 + n;
        v4u o; o.x = pk2(s[0 * 33], s[1 * 33]); o.y = pk2(s[2 * 33], s[3 * 33]); o.z = pk2(s[4 * 33], s[5 * 33]); o.w = pk2(s[6 * 33], s[7 * 33]);
        *(GAS v4u*)(WT + (size_t)(orow0 + n) * ldo + ocol0 + 8 * c) = o; }
    LDS_WAIT(); asm volatile("" ::: "memory");
}
__device__ __forceinline__ void abar_pow(float lr, float li, float dt, float j, float& re, float& im) {
    const float mag = expf(lr * dt * j); float s, c; sincosf(li * dt * j, &s, &c); re = mag * c; im = mag * s;
}

constexpr int ETAB_OFF = MISC_OFF + 256;
__device__ __forceinline__ void build_expert_table(LAS unsigned char* L, const int* CNT, int tid) {
    LAS int* tab = (LAS int*)(L + ETAB_OFF);
    __syncthreads();
    if (tid == 0) { int rt = 0;
#pragma unroll 1
        for (int e = 0; e < NEXP; ++e) { const int nt = (CNT[e] + 255) >> 8;
#pragma unroll 1
            for (int q = 0; q < nt; ++q) tab[rt++] = e; }
#pragma unroll 1
        for (; rt <= XS_ROWS / 256; ++rt) tab[rt] = -1; }
    __syncthreads();
}
struct Args { const float* in[34]; float* out; unsigned char* ws; };
typedef __attribute__((address_space(4))) const char* kconst_ptr;
__device__ __forceinline__ void* karg(int k) { kconst_ptr kp = (kconst_ptr)__builtin_amdgcn_kernarg_segment_ptr(); asm volatile("" : "+s"(kp)); return *(void* const __attribute__((address_space(4)))*)(kp + 8 * k); }

__global__ void __launch_bounds__(NWAVES * 64, 2) fwd_kernel(Args args) {
    extern __shared__ __attribute__((aligned(16))) unsigned char lds[];
    LAS unsigned char* L = (LAS unsigned char*)lds;
    volatile LAS unsigned* MISC = (volatile LAS unsigned*)(L + MISC_OFF);
#define PHASE_IDS() \
    int tid = threadIdx.x; asm volatile("" : "+v"(tid)); \
    const int lane = tid & 63, wave = __builtin_amdgcn_readfirstlane(tid >> 6); \
    int G = gridDim.x, bx = blockIdx.x; asm volatile("" : "+s"(G), "+s"(bx)); \
    const int vcu = (G % 8 == 0) ? (bx % 8) * (G / 8) + bx / 8 : bx; \
    const int gw = vcu * NWAVES + wave, NGW = G * NWAVES; \
    const int gt = bx * (NWAVES * 64) + tid, NGT = G * NWAVES * 64; \
    (void)lane; (void)wave; (void)vcu; (void)gw; (void)NGW; (void)gt; (void)NGT;
    gu32* ctl = (gu32*)(args.ws + WS_CTL);
    for (int u = threadIdx.x; u < (LDS_BYTES - LDSCTL_OFF) / 4; u += NWAVES * 64) ((LAS unsigned*)(L + LDSCTL_OFF))[u] = 0u;
    __syncthreads();
    XcdBarrier bar = xcd_barrier_post((unsigned*)(ctl + CW_BAR), MISC + 8);
#define GRID_BAR() xcd_barrier(bar)

#define KIN(k) ((const float*)karg(k))
#define WSP(T_, off) ((T_*)(((unsigned char*)karg(35)) + (off)))
#define OUTP() ((float*)karg(34))

#if DBG_STAGE != 1
    asm volatile("; PHASE_MARK P0" ::: "memory");
    {
        PHASE_IDS();
        const float* w_in = KIN(5); const float* w_glu = KIN(15); const float* w_br_ssm = KIN(22); const float* w_br_attn = KIN(23); const float* w_out = KIN(24);
        const float* w_eg = KIN(30); const float* w_eu = KIN(31); const float* w_ed = KIN(32);
        bf16* WinT = WSP(bf16, WS_WIN); bf16* WgluT = WSP(bf16, WS_WGLU); bf16* WssmT = WSP(bf16, WS_WSSM); bf16* WattT = WSP(bf16, WS_WATT); bf16* WoutT = WSP(bf16, WS_WOUT);
        bf16* WE1 = WSP(bf16, WS_WE1); bf16* WE2 = WSP(bf16, WS_WE2);
        LAS float* scr = (LAS float*)(L + RING_OFF + wave * 16384);
        constexpr int I_IN = 16 * 176, I_GLU = 8 * 16, I_SSM = 8 * 32, I_ATT = 16 * 32, I_OUT = 16 * 32, I_EG = NEXP * 16 * 8, I_EU = I_EG, I_ED = NEXP * 4 * 32;
        constexpr int NITEMS = I_IN + I_GLU + I_SSM + I_ATT + I_OUT + I_EG + I_EU + I_ED;
        for (int it = gw; it < NITEMS; it += NGW) {
            int r = it;
            if (r < I_IN) { const int kb = r / 176, nb = r % 176; transpose_tile(w_in, INW, 64 * kb, 32 * nb, WinT, D, 32 * nb, 64 * kb, scr, lane); continue; } r -= I_IN;
            if (r < I_GLU) { const int kb = r / 16, nb = r % 16; transpose_tile(w_glu, S5W, 64 * kb, 32 * nb, WgluT, S5W, 32 * nb, 64 * kb, scr, lane); continue; } r -= I_GLU;
            if (r < I_SSM) { const int kb = r / 32, nb = r % 32; transpose_tile(w_br_ssm, D, 64 * kb, 32 * nb, WssmT, S5W, 32 * nb, 64 * kb, scr, lane); continue; } r -= I_SSM;
            if (r < I_ATT) { const int kb = r / 32, nb = r % 32; transpose_tile(w_br_attn, D, 64 * kb, 32 * nb, WattT, D, 32 * nb, 64 * kb, scr, lane); continue; } r -= I_ATT;
            if (r < I_OUT) { const int kb = r / 32, nb = r % 32; transpose_tile(w_out, D, 64 * kb, 32 * nb, WoutT, D, 32 * nb, 64 * kb, scr, lane); continue; } r -= I_OUT;
            if (r < I_EG + I_EU) { const bool up = r >= I_EG; if (up) r -= I_EG; const int e = r / 128, q = r % 128, kb = q / 8, nb = q % 8;
                transpose_tile((up ? w_eu : w_eg) + (size_t)e * D * DEXP, DEXP, 64 * kb, 32 * nb, WE1 + (size_t)e * 512 * D, D, (nb >> 2) * 256 + (up ? 128 : 0) + (nb & 3) * 32, 64 * kb, scr, lane); continue; } r -= I_EG + I_EU;
            { const int e = r / 128, q = r % 128, kb = q / 32, nb = q % 32; transpose_tile(w_ed + (size_t)e * DEXP * D, D, 64 * kb, 32 * nb, WE2 + (size_t)e * D * DEXP, DEXP, 32 * nb, 64 * kb, scr, lane); }
        }
        const float* w_rg = KIN(26); const float* w_re = KIN(28); bf16* WR = WSP(bf16, WS_WR);
        for (int idx = gt; idx < 256 * 2048 / 8; idx += NGT) {
            const int row = idx / 256, c8 = (idx % 256) * 8; const int n = row & 127, part = row >> 7, k0 = c8 & 1023, khalf = c8 >> 10;
            unsigned w[4] = {0u, 0u, 0u, 0u};
            if (n < 36 && !(part == 1 && khalf == 1)) {
                float hv[8];
#pragma unroll
                for (int i = 0; i < 8; ++i) { const float f = (n < 4) ? w_rg[(size_t)(k0 + i) * 4 + n] : w_re[(size_t)(k0 + i) * NEXP + (n - 4)]; const float h = bf2f(f2bf(f)); hv[i] = part ? (f - h) : h; }
#pragma unroll
                for (int i = 0; i < 4; ++i) w[i] = pk2(hv[2 * i], hv[2 * i + 1]);
            }
            *(GAS v4u*)(WR + (size_t)row * 2048 + c8) = (v4u){w[0], w[1], w[2], w[3]};
        }
        const float* log_dt = KIN(14); const float* a_re = KIN(7); const float* a_im = KIN(8); const float* sb_re = KIN(9); const float* sb_im = KIN(10);
        float* Ere = WSP(float, WS_ETAB); float* Eim = Ere + NG * LC * NP * 16;
        for (int idx = gt; idx < NG * LC * NP; idx += NGT) {
            const int p = idx % NP, j = (idx / NP) % LC, g = idx / (NP * LC);
            const float dt = expf(log_dt[g]), lr = a_re[g * NP + p], li = a_im[g * NP + p];
            float ar, ai; abar_pow(lr, li, dt, 1.0f, ar, ai);
            const float den = lr * lr + li * li, nr = ar - 1.0f;
            const float fre = (nr * lr + ai * li) / den, fim = (ai * lr - nr * li) / den;
            float pr, pi; abar_pow(lr, li, dt, (float)j, pr, pi);
            const float gr = pr * fre - pi * fim, gi = pr * fim + pi * fre;
            const float* br = sb_re + (size_t)(g * NP + p) * 16; const float* bi = sb_im + (size_t)(g * NP + p) * 16;
            float* er = Ere + (size_t)((g * LC + j) * NP + p) * 16; float* ei = Eim + (size_t)((g * LC + j) * NP + p) * 16;
#pragma unroll
            for (int ci = 0; ci < 16; ++ci) { er[ci] = gr * br[ci] - gi * bi[ci]; ei[ci] = gr * bi[ci] + gi * br[ci]; }
        }
        {
            const float* cvec = KIN(1); const float* w_ada = KIN(2); const float* b_ada = KIN(3); float* MOD = WSP(float, WS_MOD);
            __syncthreads();
            LAS float* cs = (LAS float*)(L + RING_OFF);
            LAS float* red = (LAS float*)(L + RING_OFF + 32768);
            bool loaded = false;
            for (int it = vcu; it < 6 * D / 32; it += G) {
                if (!loaded) { __syncthreads(); for (int i = tid; i < NB * D; i += NWAVES * 64) { const float c = cvec[i]; cs[i] = c / (1.0f + expf(-c)); } __syncthreads(); loaded = true; }
                const int col = it * 32 + (lane & 31), ksub = (lane >> 5) + 2 * wave;
                float accb[NB];
#pragma unroll
                for (int b = 0; b < NB; ++b) accb[b] = 0.f;
#pragma unroll 8
                for (int i = 0; i < 64; ++i) { const int k = ksub + 16 * i; const float w = w_ada[(size_t)k * (6 * D) + col];
#pragma unroll
                    for (int b = 0; b < NB; ++b) accb[b] += cs[b * D + k] * w; }
#pragma unroll
                for (int b = 0; b < NB; ++b) red[(ksub * NB + b) * 32 + (lane & 31)] = accb[b];
                __syncthreads();
                if (tid < NB * 32) { const int b = tid >> 5, c = tid & 31; float s = 0.f;
#pragma unroll
                    for (int q = 0; q < 16; ++q) s += red[(q * NB + b) * 32 + c];
                    MOD[(size_t)b * 6 * D + it * 32 + c] = s + b_ada[it * 32 + c]; }
                __syncthreads();
            }
            __syncthreads();
        }
    }
    GRID_BAR();
#endif

#if DBG_STAGE != 1
    asm volatile("; PHASE_MARK P0b" ::: "memory");
    {
        PHASE_IDS();
        const float* x = KIN(0); const float* g_mix = KIN(4); const float* MOD = WSP(float, WS_MOD); bf16* UBUF = (bf16*)OUTP();
        const float* Ere = WSP(float, WS_ETAB); const float* Eim = Ere + NG * LC * NP * 16; bf16* BtY = WSP(bf16, WS_BTY); bf16* BtP = WSP(bf16, WS_BTP);
        const float* sc_re = KIN(11); const float* sc_im = KIN(12); const float* log_dt = KIN(14); const float* a_re = KIN(7); const float* a_im = KIN(8);
        for (int blk = gw; blk < T / 16; blk += NGW) {
            const int row0 = blk * 16, b = row0 / SEQ; const float* md = MOD + (size_t)b * 6 * D;
            f32x4 av[4], sv[4];
#pragma unroll
            for (int j = 0; j < 4; ++j) { const int c = 4 * lane + 256 * j; const f32x4 g = *(const f32x4*)(g_mix + c), sc = *(const f32x4*)(md + D + c); av[j] = g * (sc + 1.0f); sv[j] = *(const f32x4*)(md + c); }
            for (int r = 0; r < 16; ++r) {
                const float* xr = x + (size_t)(row0 + r) * D; f32x4 v[4]; float ss = 0.f;
#pragma unroll
                for (int j = 0; j < 4; ++j) { v[j] = *(const f32x4*)(xr + 4 * lane + 256 * j); ss += (v[j][0] * v[j][0] + v[j][1] * v[j][1]) + (v[j][2] * v[j][2] + v[j][3] * v[j][3]); }
                const float rstd = 1.0f / sqrtf(wave_sum(ss, lane) * (1.0f / D) + EPS);
                bf16* ur = UBUF + (size_t)(row0 + r) * D;
#pragma unroll
                for (int j = 0; j < 4; ++j) { const f32x4 o = v[j] * rstd * av[j] + sv[j]; *(GAS v2u*)(ur + 4 * lane + 256 * j) = (v2u){pk2(o[0], o[1]), pk2(o[2], o[3])}; }
            }
        }
        for (int idx = gt; idx < NG * LC * 16 * 2; idx += NGT) {
            const int cih = idx & 1, co = (idx >> 1) & 15, j = (idx >> 5) % LC, g = idx / (32 * LC);
            float kv[8];
#pragma unroll
            for (int i = 0; i < 8; ++i) kv[i] = 0.f;
            const float* er = Ere + (size_t)((g * LC + j) * NP) * 16 + cih * 8; const float* ei = Eim + (size_t)((g * LC + j) * NP) * 16 + cih * 8;
            const float* cr = sc_re + (size_t)(g * 16 + co) * NP; const float* ci_ = sc_im + (size_t)(g * 16 + co) * NP;
            for (int p = 0; p < NP; ++p) { const float c_r = cr[p], c_i = ci_[p]; const f32x4 e0 = *(const f32x4*)(er + p * 16), e1 = *(const f32x4*)(er + p * 16 + 4), f0 = *(const f32x4*)(ei + p * 16), f1 = *(const f32x4*)(ei + p * 16 + 4);
#pragma unroll
                for (int i = 0; i < 4; ++i) { kv[i] += c_r * e0[i] - c_i * f0[i]; kv[4 + i] += c_r * e1[i] - c_i * f1[i]; } }
            const v4u kw = (v4u){pk2(kv[0], kv[1]), pk2(kv[2], kv[3]), pk2(kv[4], kv[5]), pk2(kv[6], kv[7])};
            bf16* base = BtY + (size_t)g * 512 * KY;
            for (int t = j; t < LC; ++t) *(GAS v4u*)(base + (size_t)(t * 16 + co) * KY + (t - j) * 16 + cih * 8) = kw;
            if (j >= 1) for (int t = 0; t + j < LC; ++t) *(GAS v4u*)(base + (size_t)(t * 16 + co) * KY + (t + j) * 16 + cih * 8) = (v4u){0u, 0u, 0u, 0u};
        }
        for (int idx = gt; idx < NG * LC * NP; idx += NGT) {
            const int p = idx % NP, t = (idx / NP) % LC, g = idx / (NP * LC);
            const float dt = expf(log_dt[g]); float ar, ai; abar_pow(a_re[g * NP + p], a_im[g * NP + p], dt, (float)(t + 1), ar, ai);
#pragma unroll
            for (int co = 0; co < 16; ++co) { const float c_r = sc_re[(size_t)(g * 16 + co) * NP + p], c_i = sc_im[(size_t)(g * 16 + co) * NP + p];
                bf16* rowp = BtY + (size_t)(g * 512 + t * 16 + co) * KY;
                rowp[512 + p] = (bf16)f2bf(c_r * ar - c_i * ai); rowp[576 + p] = (bf16)f2bf(-(c_r * ai + c_i * ar)); }
        }
        for (int idx = gt; idx < NG * 128 * LC; idx += NGT) {
            const int s = idx % LC, nn = (idx / LC) % 128, g = idx / (LC * 128); const int p = nn & 63, im = nn >> 6;
            const float* src = (im ? Eim : Ere) + (size_t)((g * LC + (LC - 1 - s)) * NP + p) * 16;
            unsigned hw[8], lw[8];
#pragma unroll
            for (int i = 0; i < 8; ++i) { const float f0 = src[2 * i], f1 = src[2 * i + 1]; const unsigned h0 = f2bf(f0), h1 = f2bf(f1); hw[i] = h0 | (h1 << 16); lw[i] = pk2(f0 - bf2f(h0), f1 - bf2f(h1)); }
            bf16* d0 = BtP + (size_t)(g * 256 + nn) * KS + s * 16; bf16* d1 = BtP + (size_t)(g * 256 + 128 + nn) * KS + s * 16;
            *(GAS v4u*)d0 = (v4u){hw[0], hw[1], hw[2], hw[3]}; *(GAS v4u*)(d0 + 8) = (v4u){hw[4], hw[5], hw[6], hw[7]};
            *(GAS v4u*)d1 = (v4u){lw[0], lw[1], lw[2], lw[3]}; *(GAS v4u*)(d1 + 8) = (v4u){lw[4], lw[5], lw[6], lw[7]};
        }
    }
    GRID_BAR();

    asm volatile("; PHASE_MARK P1" ::: "memory");
    {
        PHASE_IDS();
        pg8::StaticOrder S; S.init(OUTP(), D, WSP(bf16, WS_WIN), D, T, INW, G, bx);
        pg8::EpiProj E{KIN(6), WSP(bf16, WS_UG), WSP(bf16, WS_Q), WSP(bf16, WS_K), WSP(bf16, WS_V), WSP(bf16, WS_GATES), attn_body::C2};
        pg8::gemm_phase<pg8::EpiProj, pg8::StaticOrder, true, true>(L + RING_OFF, D, D, D, S, E);
    }
    GRID_BAR();

    asm volatile("; PHASE_MARK P2" ::: "memory");
    {
        PHASE_IDS();
        pg8::GroupOrder S; S.init(WSP(bf16, WS_UG), KY, (size_t)NRC * KY * 2, WSP(bf16, WS_BTP), KS, (size_t)256 * KS * 2, NRC, 256, NG, G, bx);
        pg8::EpiStates E{WSP(float, WS_SLOC)};
        pg8::gemm_phase<pg8::EpiStates, pg8::GroupOrder, true, true>(L + RING_OFF, KS, KY, KS, S, E);
    }
    GRID_BAR();

    asm volatile("; PHASE_MARK P3" ::: "memory");
    {
        PHASE_IDS();
        const float* log_dt = KIN(14); const float* a_re = KIN(7); const float* a_im = KIN(8); const float* SLOC = WSP(float, WS_SLOC); bf16* UG = WSP(bf16, WS_UG);
        LAS float* seg = (LAS float*)(L + RING_OFF);
        for (int bg = vcu; bg < NB * NG; bg += G) {
            const int b = bg / NG, g = bg % NG, p = lane;
            const float dt = expf(log_dt[g]), lr = a_re[g * NP + p], li = a_im[g * NP + p];
            float alr, ali; abar_pow(lr, li, dt, (float)LC, alr, ali);
            constexpr int SEGC = NCH / NWAVES;
            float locr[SEGC], loci[SEGC]; float cr = 0.f, ci = 0.f;
            const float* sp = SLOC + ((size_t)(g * NRC + b * NCH + wave * SEGC)) * 128;
#pragma unroll
            for (int k = 0; k < SEGC; ++k) { locr[k] = cr; loci[k] = ci; const float sr = sp[k * 128 + p], si = sp[k * 128 + 64 + p]; const float nr = alr * cr - ali * ci + sr, ni = alr * ci + ali * cr + si; cr = nr; ci = ni; }
            __syncthreads();
            seg[(wave * 64 + p) * 2] = cr; seg[(wave * 64 + p) * 2 + 1] = ci;
            __syncthreads();
            float a16r = alr, a16i = ali;
#pragma unroll
            for (int q = 0; q < 4; ++q) { const float nr = a16r * a16r - a16i * a16i, ni = 2.f * a16r * a16i; a16r = nr; a16i = ni; }
            float inr = 0.f, ini = 0.f;
            for (int w = 0; w < wave; ++w) { const float er = seg[(w * 64 + p) * 2], ei = seg[(w * 64 + p) * 2 + 1]; const float nr = a16r * inr - a16i * ini + er, ni = a16r * ini + a16i * inr + ei; inr = nr; ini = ni; }
            bf16* up = UG + ((size_t)(g * NRC + b * NCH + wave * SEGC)) * KY + KS;
#pragma unroll
            for (int k = 0; k < SEGC; ++k) { up[(size_t)k * KY + p] = (bf16)f2bf(inr + locr[k]); up[(size_t)k * KY + 64 + p] = (bf16)f2bf(ini + loci[k]); const float nr = alr * inr - ali * ini, ni = alr * ini + ali * inr; inr = nr; ini = ni; }
        }
        __syncthreads();
        const char* wsb = (const char*)karg(35);
        const float* lq1 = KIN(17); const float* lk1 = KIN(18); const float* lq2 = KIN(19); const float* lk2 = KIN(20); const float* g_subln = KIN(21);
        const float lam = expf(wave_sum(lq1[lane] * lk1[lane], lane)) - expf(wave_sum(lq2[lane] * lk2[lane], lane)) + LAMBDA_INIT;
        LAS float* gsl = (LAS float*)(L + GS_OFF);
        if (tid < 128) gsl[tid] = g_subln[tid] * (1.0f - LAMBDA_INIT);
        __syncthreads();
        for (int un = vcu; un < NB * 8 * 4; un += G) {
            const int s4 = un & 3, h = (un >> 2) & 7, b = un >> 5;
#pragma unroll 1
            for (int i = 0; i < 4; ++i) { const int qb = (i == 0) ? 15 - s4 : (i == 1) ? 8 + s4 : (i == 2) ? 7 - s4 : s4;
                attn_body::attn_unit<8, WS_Q, WS_K, WS_V, GS_OFF - RING_OFF>(b, h, qb, wsb, (attn_body::bf16*)OUTP(), lam, (char*)lds + RING_OFF); }
        }
    }
    GRID_BAR();

    asm volatile("; PHASE_MARK P4" ::: "memory");
    {
        PHASE_IDS();
        pg8::GroupOrder S; S.init(WSP(bf16, WS_UG), KY, (size_t)NRC * KY * 2, WSP(bf16, WS_BTY), KY, (size_t)512 * KY * 2, NRC, 512, NG, G, bx);
        pg8::EpiY E{WSP(bf16, WS_UG), KIN(13), WSP(bf16, WS_YACT)};
        pg8::gemm_phase<pg8::EpiY, pg8::GroupOrder, true, true>(L + RING_OFF, KY, KY, KY, S, E);
    }
    GRID_BAR();

    asm volatile("; PHASE_MARK P5" ::: "memory");
    {
        PHASE_IDS();
        pg8::StaticOrder S; S.init(WSP(bf16, WS_YACT), S5W, WSP(bf16, WS_WGLU), S5W, T, S5W, G, bx);
        pg8::EpiGlu E{WSP(bf16, WS_YACT), KIN(16), WSP(bf16, WS_S5O)};
        pg8::gemm_phase<pg8::EpiGlu, pg8::StaticOrder, true, true>(L + RING_OFF, S5W, S5W, S5W, S, E);
    }
    GRID_BAR();

    asm volatile("; PHASE_MARK P6" ::: "memory");
    {
        PHASE_IDS();
        pg8::StaticOrder S; S.init(WSP(bf16, WS_S5O), S5W, WSP(bf16, WS_WSSM), S5W, T, D, G, bx);
        pg8::EpiBranch<0> E{WSP(bf16, WS_GATES), nullptr, WSP(bf16, WS_TMP)};
        pg8::gemm_phase<pg8::EpiBranch<0>, pg8::StaticOrder, true, true>(L + RING_OFF, S5W, S5W, S5W, S, E);
    }
    VM_WAIT(); __syncthreads();
    {
        PHASE_IDS();
        pg8::StaticOrder S; S.init(OUTP(), D, WSP(bf16, WS_WATT), D, T, D, G, bx);
        pg8::EpiBranch<1> E{WSP(bf16, WS_GATES), WSP(bf16, WS_TMP), (bf16*)OUTP() + (size_t)T * D};
        pg8::gemm_phase<pg8::EpiBranch<1>, pg8::StaticOrder, true, true>(L + RING_OFF, D, D, D, S, E);
    }
    GRID_BAR();

    asm volatile("; PHASE_MARK P8" ::: "memory");
    {
        PHASE_IDS();
        pg8::StaticOrder S; S.init((bf16*)OUTP() + (size_t)T * D, D, WSP(bf16, WS_WOUT), D, T, D, G, bx);
        pg8::EpiOut E{KIN(0), WSP(float, WS_MOD), WSP(bf16, WS_H)};
        pg8::gemm_phase<pg8::EpiOut, pg8::StaticOrder, true, true>(L + RING_OFF, D, D, D, S, E);
    }
    GRID_BAR();
#endif

#if DBG_STAGE == 0
    asm volatile("; PHASE_MARK P9" ::: "memory");
    {
        PHASE_IDS();
        const float* g_ffn = KIN(25); const float* MOD = WSP(float, WS_MOD); const bf16* Hbuf = WSP(bf16, WS_H); bf16* U2HL = (bf16*)OUTP();
        for (int blk = gw; blk < T / 16; blk += NGW) {
            const int row0 = blk * 16, b = row0 / SEQ; const float* md = MOD + (size_t)b * 6 * D;
            f32x4 av[4], sv[4];
#pragma unroll
            for (int j = 0; j < 4; ++j) { const int c = 4 * lane + 256 * j; const f32x4 g = *(const f32x4*)(g_ffn + c), sc = *(const f32x4*)(md + 4 * D + c); av[j] = g * (sc + 1.0f); sv[j] = *(const f32x4*)(md + 3 * D + c); }
            for (int r = 0; r < 16; ++r) {
                const bf16* hr = Hbuf + (size_t)(row0 + r) * D; f32x4 v[4]; float ss = 0.f;
#pragma unroll
                for (int j = 0; j < 4; ++j) { const v2u hw = *(const GAS v2u*)(hr + 4 * lane + 256 * j); v[j] = (f32x4){pg8::bf_lo(hw.x), pg8::bf_hi(hw.x), pg8::bf_lo(hw.y), pg8::bf_hi(hw.y)}; ss += (v[j][0] * v[j][0] + v[j][1] * v[j][1]) + (v[j][2] * v[j][2] + v[j][3] * v[j][3]); }
                const float rstd = 1.0f / sqrtf(wave_sum(ss, lane) * (1.0f / D) + EPS);
                bf16* ur = U2HL + (size_t)(row0 + r) * 2048;
#pragma unroll
                for (int j = 0; j < 4; ++j) { const f32x4 o = v[j] * rstd * av[j] + sv[j];
                    const unsigned h0 = f2bf(o[0]), h1 = f2bf(o[1]), h2 = f2bf(o[2]), h3 = f2bf(o[3]);
                    *(GAS v2u*)(ur + 4 * lane + 256 * j) = (v2u){h0 | (h1 << 16), h2 | (h3 << 16)};
                    *(GAS v2u*)(ur + D + 4 * lane + 256 * j) = (v2u){pk2(o[0] - bf2f(h0), o[1] - bf2f(h1)), pk2(o[2] - bf2f(h2), o[3] - bf2f(h3))}; }
            }
        }
    }
    GRID_BAR();

    asm volatile("; PHASE_MARK P10" ::: "memory");
    {
        PHASE_IDS();
        pg8::StaticOrder S; S.init(OUTP(), 2048, WSP(bf16, WS_WR), 2048, T, 256, G, bx);
        pg8::EpiRouter E{WSP(float, WS_LOGITS)};
        pg8::gemm_phase<pg8::EpiRouter, pg8::StaticOrder, true, true>(L + RING_OFF, 2048, 2048, 2048, S, E);
    }
    GRID_BAR();

    asm volatile("; PHASE_MARK P11" ::: "memory");
    {
        PHASE_IDS();
        const float* b_rg = KIN(27); const float* b_re = KIN(29); const float* LOGITS = WSP(float, WS_LOGITS); int* RT = WSP(int, WS_RT); int* CNT = WSP(int, WS_CTL) + CW_CNT;
        int* lcnt = (int*)(lds + RING_OFF); int* lbase = lcnt + NEXP;
        const int per = T / G;
        for (int t0 = bx * per; t0 < (bx + 1) * per; t0 += NWAVES * 64) {
            __syncthreads();
            if (tid < NEXP) lcnt[tid] = 0;
            __syncthreads();
            const int tok = t0 + tid; const bool act = tok < (bx + 1) * per;
            int e0 = 0, e1 = 0, p0 = 0, p1 = 0; float w0 = 0.f, w1 = 0.f;
            if (act) {
                const float* lg = LOGITS + (size_t)tok * 64;
                float gl[4]; int gi = 0;
#pragma unroll
                for (int i = 0; i < 4; ++i) gl[i] = lg[i] + b_rg[i];
#pragma unroll
                for (int i = 1; i < 4; ++i) if (gl[i] > gl[gi]) gi = i;
                float gsum = 0.f;
#pragma unroll
                for (int i = 0; i < 4; ++i) gsum += expf(gl[i] - gl[gi]);
                const float gp = 1.0f / gsum;
                float el[8];
#pragma unroll
                for (int i = 0; i < 8; ++i) el[i] = lg[4 + gi * 8 + i] + b_re[gi * 8 + i];
                int i0 = 0;
#pragma unroll
                for (int i = 1; i < 8; ++i) if (el[i] > el[i0]) i0 = i;
                int i1 = (i0 == 0) ? 1 : 0;
#pragma unroll
                for (int i = 0; i < 8; ++i) if (i != i0 && el[i] > el[i1]) i1 = i;
                const float ex = expf(el[i1] - el[i0]);
                w0 = gp / (1.0f + ex); w1 = gp * ex / (1.0f + ex);
                e0 = gi * 8 + i0; e1 = gi * 8 + i1;
                p0 = atomicAdd(&lcnt[e0], 1); p1 = atomicAdd(&lcnt[e1], 1);
            }
            __syncthreads();
            if (tid < NEXP) lbase[tid] = atomicAdd(&CNT[tid], lcnt[tid]);
            __syncthreads();
            if (act) { int* r = RT + (size_t)tok * 8; r[0] = e0; r[1] = lbase[e0] + p0; r[2] = __float_as_int(w0); r[3] = e1; r[4] = lbase[e1] + p1; r[5] = __float_as_int(w1); }
        }
    }
    GRID_BAR();

    asm volatile("; PHASE_MARK P12" ::: "memory");
    {
        PHASE_IDS();
        const int* RT = WSP(int, WS_RT); const int* CNT = WSP(int, WS_CTL) + CW_CNT; const bf16* U2HL = (const bf16*)OUTP(); bf16* XS = WSP(bf16, WS_XS); int* DEST = WSP(int, WS_DEST); float* CWT = WSP(float, WS_CW);
        LAS int* offs = (LAS int*)(L + RING_OFF);
        __syncthreads();
        if (tid == 0) { int a = 0; for (int e = 0; e < NEXP; ++e) { offs[e] = a; a += ((CNT[e] + 255) >> 8) << 8; } }
        __syncthreads();
        for (int tok = gw; tok < T; tok += NGW) {
            const int* r = RT + (size_t)tok * 8; const int e0 = r[0], q0 = r[1], e1 = r[3], q1 = r[4];
            const int r0 = offs[e0] + q0, r1 = offs[e1] + q1;
            const bf16* src = U2HL + (size_t)tok * 2048 + 16 * lane;
            const v4u a0 = *(const GAS v4u*)src, a1 = *(const GAS v4u*)(src + 8);
            bf16* d0 = XS + (size_t)r0 * D + 16 * lane; bf16* d1 = XS + (size_t)r1 * D + 16 * lane;
            *(GAS v4u*)d0 = a0; *(GAS v4u*)(d0 + 8) = a1; *(GAS v4u*)d1 = a0; *(GAS v4u*)(d1 + 8) = a1;
            if (lane == 0) { DEST[r0] = tok * 2; CWT[r0] = __int_as_float(r[2]); DEST[r1] = tok * 2 + 1; CWT[r1] = __int_as_float(r[5]); }
        }
        if (bx < NEXP) { const int n = CNT[bx], pad = (((n + 255) >> 8) << 8) - n; for (int i = tid; i < pad; i += NWAVES * 64) { DEST[offs[bx] + n + i] = -1; CWT[offs[bx] + n + i] = 0.f; } }
        __syncthreads();
    }
    GRID_BAR();

    asm volatile("; PHASE_MARK P13" ::: "memory");
    {
        PHASE_IDS();
        build_expert_table(L, WSP(int, WS_CTL) + CW_CNT, tid);
        pg8::ExpertOrder S; S.init((const LAS int*)(L + ETAB_OFF), WSP(bf16, WS_XS), D, WSP(bf16, WS_WE1), D, (size_t)512 * D * 2, 512, G, bx);
        pg8::EpiExp1 E{WSP(bf16, WS_HDN)};
        pg8::gemm_phase<pg8::EpiExp1, pg8::ExpertOrder, true, true>(L + RING_OFF, D, D, D, S, E);
    }
    GRID_BAR();

    asm volatile("; PHASE_MARK P14" ::: "memory");
    {
        PHASE_IDS();
        build_expert_table(L, WSP(int, WS_CTL) + CW_CNT, tid);
        pg8::ExpertOrder S; S.init((const LAS int*)(L + ETAB_OFF), WSP(bf16, WS_HDN), DEXP, WSP(bf16, WS_WE2), DEXP, (size_t)D * DEXP * 2, D, G, bx);
        pg8::EpiExp2 E{WSP(int, WS_DEST), WSP(float, WS_CW), WSP(bf16, WS_SLOTS)};
        pg8::gemm_phase<pg8::EpiExp2, pg8::ExpertOrder, true, true>(L + RING_OFF, DEXP, DEXP, DEXP, S, E);
    }
    GRID_BAR();
#endif

    asm volatile("; PHASE_MARK P15" ::: "memory");
    {
        PHASE_IDS();
        const float* x = KIN(0); const float* g_final = KIN(33); const bf16* Hbuf = WSP(bf16, WS_H); const float* MOD = WSP(float, WS_MOD); const bf16* SLOTS = WSP(bf16, WS_SLOTS); float* out = OUTP();
        (void)x; (void)Hbuf; (void)MOD; (void)SLOTS;
        for (int row = gw; row < T; row += NGW) {
            const int b = row / SEQ; f32x4 v[4]; float ss = 0.f;
#pragma unroll
            for (int j = 0; j < 4; ++j) { const int c = 4 * lane + 256 * j;
#if DBG_STAGE == 1
                v[j] = *(const f32x4*)(x + (size_t)row * D + c);
#else
                { const v2u hw = *(const GAS v2u*)(Hbuf + (size_t)row * D + c); v[j] = (f32x4){pg8::bf_lo(hw.x), pg8::bf_hi(hw.x), pg8::bf_lo(hw.y), pg8::bf_hi(hw.y)}; }
#endif
#if DBG_STAGE == 0
                const f32x4 gt = *(const f32x4*)(MOD + (size_t)b * 6 * D + 5 * D + c);
                const v2u s0 = *(const GAS v2u*)(SLOTS + (size_t)(2 * row) * D + c), s1 = *(const GAS v2u*)(SLOTS + (size_t)(2 * row + 1) * D + c);
                const f32x4 f = (f32x4){pg8::bf_lo(s0.x) + pg8::bf_lo(s1.x), pg8::bf_hi(s0.x) + pg8::bf_hi(s1.x), pg8::bf_lo(s0.y) + pg8::bf_lo(s1.y), pg8::bf_hi(s0.y) + pg8::bf_hi(s1.y)};
                v[j] = v[j] + gt * f;
#endif
                ss += (v[j][0] * v[j][0] + v[j][1] * v[j][1]) + (v[j][2] * v[j][2] + v[j][3] * v[j][3]); }
            (void)b;
            const float rstd = 1.0f / sqrtf(wave_sum(ss, lane) * (1.0f / D) + EPS);
#pragma unroll
            for (int j = 0; j < 4; ++j) { const int c = 4 * lane + 256 * j; const f32x4 g = *(const f32x4*)(g_final + c); *(f32x4*)(out + (size_t)row * D + c) = v[j] * rstd * g; }
        }
    }
}

extern "C" void kernel_launch(void* const* d_in, const int* in_sizes, int n_in, void* d_out, int out_size, void* d_ws, size_t ws_size, hipStream_t stream) {
    static int grid = 0;
    if (grid == 0) {
        if (n_in != 34 || out_size != T * D || ws_size < WS_END) { fprintf(stderr, "kernel_launch: unexpected shapes (n_in %d, out %d, ws %zu)\n", n_in, out_size, ws_size); grid = -1; return; }
        int dev = 0, cus = 0, per_cu = 0;
        if (hipGetDevice(&dev) != hipSuccess || hipDeviceGetAttribute(&cus, hipDeviceAttributeMultiprocessorCount, dev) != hipSuccess) { grid = -1; return; }
        if (hipFuncSetAttribute((const void*)fwd_kernel, hipFuncAttributeMaxDynamicSharedMemorySize, LDS_BYTES) != hipSuccess) { fprintf(stderr, "kernel_launch: hipFuncSetAttribute failed\n"); grid = -1; return; }
        if (hipOccupancyMaxActiveBlocksPerMultiprocessor(&per_cu, (const void*)fwd_kernel, NWAVES * 64, LDS_BYTES) != hipSuccess || per_cu < 1)
            fprintf(stderr, "kernel_launch: note: occupancy query reports %d workgroups per CU\n", per_cu);
        (void)hipGetLastError();
        grid = cus;
    }
    if (grid < 0) return;
    if (hipMemsetAsync((char*)d_ws + WS_CTL, 0, CTL_ZERO_BYTES, stream) != hipSuccess) { fprintf(stderr, "kernel_launch: memset failed\n"); return; }
    Args a{};
    for (int i = 0; i < 34; ++i) a.in[i] = (const float*)d_in[i];
    a.out = (float*)d_out; a.ws = (unsigned char*)d_ws;
    hipLaunchKernelGGL(fwd_kernel, dim3(grid), dim3(NWAVES * 64), LDS_BYTES, stream, a);
    const hipError_t le = hipPeekAtLastError();
    if (le != hipSuccess) fprintf(stderr, "kernel_launch: launch failed: %s\n", hipGetErrorName(le));
}
```

```cpp
#include <hip/hip_runtime.h>
#include <hip/hip_bf16.h>
#include <cstdio>
#include <cstdint>
#include <cmath>

#ifndef DBG_STAGE
#define DBG_STAGE 0
#endif

constexpr int D = 1024, NB = 8, SEQ = 4096, T = NB * SEQ;
constexpr int S5W = 512, NG = 32, NP = 64, INW = 5632;
constexpr int LC = 32, NCH = SEQ / LC, NRC = T / LC, KS = LC * 16, KY = KS + 128;
constexpr int NEXP = 32, DEXP = 256;
constexpr int XS_ROWS = 2 * T + NEXP * 256;
constexpr float EPS = 1e-6f;
constexpr float LAMBDA_INIT = 0.2f;

namespace pg8 {
#define PG8_LAS __attribute__((address_space(3)))
typedef unsigned short bf16_t;
typedef short bf16x8 __attribute__((ext_vector_type(8)));
typedef float f32x4 __attribute__((ext_vector_type(4)));
typedef unsigned u32x4 __attribute__((ext_vector_type(4)));
typedef float f32x2 __attribute__((ext_vector_type(2)));
constexpr int BM = 256, BK = 64, HALF = 128, HTB = HALF * BK * 2, STAGE_BYTES = 8 * HTB, NXCD = 8, WGM = 8;

__host__ __device__ __forceinline__ int lds_byte(int r, int c) { const int st = (r >> 4) * 2 + (c >> 5), rr = r & 15, cc = c & 31, ob = rr * 64 + cc * 2; return st * 1024 + (ob ^ (((ob >> 9) & 1) << 5)); }
__host__ __device__ __forceinline__ void stage_rc(int b, int& R, int& C) { const int st = b / 1024, sb = b % 1024, swz = sb ^ (((sb >> 9) & 1) << 5); R = (st >> 1) * 16 + swz / 64; C = (st & 1) * 32 + (swz % 64) / 2; }
__host__ __device__ __forceinline__ int perm32(int rho) { const int n = rho >> 4, i = rho & 15; return 8 * (i >> 2) + 4 * n + (i & 3); }

struct Unit { int pm, pn, g, lt; const char* a; const char* b; };

struct StaticOrder {
    int nM, nN, nwg, G, c; const char* A; const char* B; size_t tsa, tsb;
    __device__ void init(const void* A_, int lda, const void* B_, int ldb, int M, int N, int G_, int c_) { nM = M / BM; nN = N / BM; nwg = nM * nN; G = G_; c = c_; A = (const char*)A_; B = (const char*)B_; tsa = (size_t)BM * lda * 2; tsb = (size_t)BM * ldb * 2; }
    __device__ bool next(int i, Unit& u) const {
        const long L = (long)i * G + c; if (L >= nwg) return false;
        int wgid = (int)L; { const int q = nwg / NXCD, r = nwg % NXCD, xcd = wgid % NXCD, off = wgid / NXCD; wgid = (xcd < r ? xcd * (q + 1) : r * (q + 1) + (xcd - r) * q) + off; }
        const int nig = WGM * nN, gid = wgid / nig, fm = gid * WGM, gsz = (nM - fm) < WGM ? (nM - fm) : WGM;
        u.pm = fm + ((wgid % nig) % gsz); u.pn = (wgid % nig) / gsz; u.g = 0; u.lt = 0; u.a = A + (size_t)u.pm * tsa; u.b = B + (size_t)u.pn * tsb; return true;
    }
};
struct GroupOrder {
    int nM, nN, ng, G, c; const char* A; const char* B; size_t tsa, tsb, gsa, gsb;
    __device__ void init(const void* A_, int lda, size_t gsa_, const void* B_, int ldb, size_t gsb_, int Mg, int Ng, int ng_, int G_, int c_) {
        nM = Mg / BM; nN = Ng / BM; ng = ng_; G = G_; c = c_; A = (const char*)A_; B = (const char*)B_; tsa = (size_t)BM * lda * 2; tsb = (size_t)BM * ldb * 2; gsa = gsa_; gsb = gsb_; }
    __device__ bool next(int i, Unit& u) const {
        const long L = (long)i * G + c; if (L >= (long)ng * nM * nN) return false;
        const int per = nM * nN, g = (int)(L / per), r = (int)(L % per);
        u.g = g; u.lt = 0; u.pm = r / nN; u.pn = r % nN; u.a = A + (size_t)g * gsa + (size_t)u.pm * tsa; u.b = B + (size_t)g * gsb + (size_t)u.pn * tsb; return true;
    }
};
struct ExpertOrder {
    const PG8_LAS int* tab; int nN, G, c; const char* A; const char* B; size_t tsa, tsb, esb;
    __device__ void init(const PG8_LAS int* tab_, const void* A_, size_t tsa_, const void* B_, int ldb, size_t esb_, int N, int G_, int c_) {
        tab = tab_; nN = N / BM; G = G_; c = c_; A = (const char*)A_; B = (const char*)B_; tsa = tsa_; tsb = (size_t)BM * ldb * 2; esb = esb_; }
    __device__ bool next(int i, Unit& u) const {
        const long L = (long)i * G + c; int rt = (int)(L / nN); const int pn = (int)(L % nN);
        if (rt > XS_ROWS / 256) rt = XS_ROWS / 256;
        const int e = __builtin_amdgcn_readfirstlane(tab[rt]);
        if (e < 0) return false;
        u.g = e & 255; u.lt = e >> 8; u.pm = rt; u.pn = pn; u.a = A + (size_t)rt * tsa; u.b = B + (size_t)u.g * esb + (size_t)pn * tsb; return true;
    }
};

__device__ __forceinline__ unsigned cvt_pk_bf16(float lo, float hi) { unsigned r; asm volatile("v_cvt_pk_bf16_f32 %0, %1, %2" : "=v"(r) : "v"(lo), "v"(hi)); return r; }
__device__ __forceinline__ float bf_lo(unsigned w) { return __uint_as_float(w << 16); }
__device__ __forceinline__ float bf_hi(unsigned w) { return __uint_as_float(w & 0xffff0000u); }
__device__ __forceinline__ float sigmoidf_(float x) { return __builtin_amdgcn_rcpf(1.0f + __builtin_amdgcn_exp2f(-1.4426950408889634f * x)); }
__device__ __forceinline__ void unpack8(const u32x4 w, float (&f)[8]) { f[0] = bf_lo(w.x); f[1] = bf_hi(w.x); f[2] = bf_lo(w.y); f[3] = bf_hi(w.y); f[4] = bf_lo(w.z); f[5] = bf_hi(w.z); f[6] = bf_lo(w.w); f[7] = bf_hi(w.w); }
__device__ __forceinline__ u32x4 pack8(const float (&f)[8]) { u32x4 w; w.x = cvt_pk_bf16(f[0], f[1]); w.y = cvt_pk_bf16(f[2], f[3]); w.z = cvt_pk_bf16(f[4], f[5]); w.w = cvt_pk_bf16(f[6], f[7]); return w; }

#define EPI_LOOP_PERM(...) \
    _Pragma("unroll") for (int ai = 0; ai < 2; ++ai) _Pragma("unroll") for (int m = 0; m < 4; ++m) { const int lrow = ai * HALF + wr * 64 + m * 16 + fr; \
        _Pragma("unroll") for (int bj = 0; bj < 2; ++bj) { const int lcol = bj * HALF + wc * 32 + 8 * fq; \
            float v[8] = {acc[ai][bj][m][0][0], acc[ai][bj][m][0][1], acc[ai][bj][m][0][2], acc[ai][bj][m][0][3], acc[ai][bj][m][1][0], acc[ai][bj][m][1][1], acc[ai][bj][m][1][2], acc[ai][bj][m][1][3]}; __VA_ARGS__ } }

struct EpiProj {
    static constexpr bool PERM = true, AFTER_DRAIN = false;
    const float* bias; bf16_t* U; bf16_t* Q; bf16_t* Kb; bf16_t* V; bf16_t* Gt; float c2;
    __device__ __forceinline__ void operator()(const f32x4 (&acc)[2][2][4][2], const Unit& u, int wr, int wc, int fr, int fq) const {
        const int ct = u.pn;
        f32x4 bv[2][2];
#pragma unroll
        for (int bj = 0; bj < 2; ++bj) { const int col = ct * BM + bj * HALF + wc * 32 + 8 * fq; bv[bj][0] = *(const f32x4*)(bias + col); bv[bj][1] = *(const f32x4*)(bias + col + 4); }
        EPI_LOOP_PERM({
            const int row = u.pm * BM + lrow, col = ct * BM + lcol;
            v[0] += bv[bj][0][0]; v[1] += bv[bj][0][1]; v[2] += bv[bj][0][2]; v[3] += bv[bj][0][3]; v[4] += bv[bj][1][0]; v[5] += bv[bj][1][1]; v[6] += bv[bj][1][2]; v[7] += bv[bj][1][3];
            bf16_t* dst;
            if (ct < 2) { const int g = col >> 4, ci = col & 15, rc = row / LC, s = row % LC; dst = U + ((size_t)(g * NRC + rc) * KY + s * 16 + ci); }
            else if (ct < 6) { _Pragma("unroll") for (int i = 0; i < 8; ++i) v[i] *= c2; dst = Q + (size_t)row * D + (col - 512); }
            else if (ct < 10) { dst = Kb + (size_t)row * D + (col - 1536); }
            else if (ct < 14) { dst = V + (size_t)row * D + (col - 2560); }
            else { _Pragma("unroll") for (int i = 0; i < 8; ++i) v[i] = sigmoidf_(v[i]); dst = Gt + (size_t)row * 2048 + (col - 3584); }
            *(u32x4*)dst = pack8(v);
        })
    }
};
struct EpiStates {
    static constexpr bool PERM = false, AFTER_DRAIN = false;
    float* S;
    __device__ __forceinline__ void operator()(const f32x4 (&acc)[2][2][4][2], const Unit& u, int wr, int wc, int fr, int fq) const {
#pragma unroll
        for (int ai = 0; ai < 2; ++ai)
#pragma unroll
            for (int m = 0; m < 4; ++m) { const int row = u.pm * BM + ai * HALF + wr * 64 + m * 16 + fr;
#pragma unroll
                for (int n = 0; n < 2; ++n) { const f32x4 v = acc[ai][0][m][n] + acc[ai][1][m][n]; *(f32x4*)(S + ((size_t)(u.g * NRC + row) * 128 + wc * 32 + 16 * n + 4 * fq)) = v; } }
    }
};
struct EpiY {
    static constexpr bool PERM = true, AFTER_DRAIN = false;
    const bf16_t* U; const float* dskip; bf16_t* Y;
    __device__ __forceinline__ void operator()(const f32x4 (&acc)[2][2][4][2], const Unit& u, int wr, int wc, int fr, int fq) const {
        EPI_LOOP_PERM({
            const int rc = u.pm * BM + lrow, n = u.pn * BM + lcol, tt = n >> 4, co = n & 15;
            const u32x4 uw = *(const u32x4*)(U + ((size_t)(u.g * NRC + rc) * KY + n)); float uf[8]; unpack8(uw, uf);
            const f32x4 d0 = *(const f32x4*)(dskip + u.g * 16 + co), d1 = *(const f32x4*)(dskip + u.g * 16 + co + 4);
            const float dd[8] = {d0[0], d0[1], d0[2], d0[3], d1[0], d1[1], d1[2], d1[3]};
            _Pragma("unroll") for (int i = 0; i < 8; ++i) { const float y = v[i] + dd[i] * uf[i]; const float z = 1.5957691216057308f * (y + 0.044715f * y * y * y); v[i] = y * sigmoidf_(z); }
            *(u32x4*)(Y + ((size_t)(rc * LC + tt) * S5W + u.g * 16 + co)) = pack8(v);
        })
    }
};
struct EpiGlu {
    static constexpr bool PERM = true, AFTER_DRAIN = false;
    const bf16_t* Y; const float* bias; bf16_t* O;
    __device__ __forceinline__ void operator()(const f32x4 (&acc)[2][2][4][2], const Unit& u, int wr, int wc, int fr, int fq) const {
        EPI_LOOP_PERM({
            const int row = u.pm * BM + lrow, col = u.pn * BM + lcol;
            const u32x4 yw = *(const u32x4*)(Y + (size_t)row * S5W + col); float yf[8]; unpack8(yw, yf);
            const f32x4 b0 = *(const f32x4*)(bias + col), b1 = *(const f32x4*)(bias + col + 4);
            const float bb[8] = {b0[0], b0[1], b0[2], b0[3], b1[0], b1[1], b1[2], b1[3]};
            _Pragma("unroll") for (int i = 0; i < 8; ++i) v[i] = yf[i] * sigmoidf_(v[i] + bb[i]);
            *(u32x4*)(O + (size_t)row * S5W + col) = pack8(v);
        })
    }
};
template <int MODE> struct EpiBranch {
    static constexpr bool PERM = true, AFTER_DRAIN = false;
    const bf16_t* Gt; const bf16_t* Tin; bf16_t* O;
    __device__ __forceinline__ void operator()(const f32x4 (&acc)[2][2][4][2], const Unit& u, int wr, int wc, int fr, int fq) const {
        EPI_LOOP_PERM({
            const int row = u.pm * BM + lrow, col = u.pn * BM + lcol;
            const u32x4 gw = *(const u32x4*)(Gt + (size_t)row * 2048 + MODE * D + col); float gf[8]; unpack8(gw, gf);
            if (MODE == 1) { const u32x4 tw = *(const u32x4*)(Tin + (size_t)row * D + col); float tf[8]; unpack8(tw, tf);
                _Pragma("unroll") for (int i = 0; i < 8; ++i) v[i] = tf[i] + gf[i] * v[i]; }
            else { _Pragma("unroll") for (int i = 0; i < 8; ++i) v[i] = gf[i] * v[i]; }
            *(u32x4*)(O + (size_t)row * D + col) = pack8(v);
        })
    }
};
struct EpiOut {
    static constexpr bool PERM = true, AFTER_DRAIN = false;
    const float* x; const float* mod; bf16_t* H;
    __device__ __forceinline__ void operator()(const f32x4 (&acc)[2][2][4][2], const Unit& u, int wr, int wc, int fr, int fq) const {
        const int b = (u.pm * BM) / SEQ; const float* gt = mod + (size_t)b * 6 * D + 2 * D;
        EPI_LOOP_PERM({
            const int row = u.pm * BM + lrow, col = u.pn * BM + lcol; const size_t off = (size_t)row * D + col;
            const f32x4 g0 = *(const f32x4*)(gt + col), g1 = *(const f32x4*)(gt + col + 4), x0 = *(const f32x4*)(x + off), x1 = *(const f32x4*)(x + off + 4);
            v[0] = x0[0] + g0[0] * v[0]; v[1] = x0[1] + g0[1] * v[1]; v[2] = x0[2] + g0[2] * v[2]; v[3] = x0[3] + g0[3] * v[3];
            v[4] = x1[0] + g1[0] * v[4]; v[5] = x1[1] + g1[1] * v[5]; v[6] = x1[2] + g1[2] * v[6]; v[7] = x1[3] + g1[3] * v[7];
            *(u32x4*)(H + off) = pack8(v);
        })
    }
};
struct EpiRouter {
    static constexpr bool PERM = false, AFTER_DRAIN = false;
    float* L;
    __device__ __forceinline__ void operator()(const f32x4 (&acc)[2][2][4][2], const Unit& u, int wr, int wc, int fr, int fq) const {
        if (wc < 2) {
#pragma unroll
            for (int ai = 0; ai < 2; ++ai)
#pragma unroll
                for (int m = 0; m < 4; ++m) { const int row = u.pm * BM + ai * HALF + wr * 64 + m * 16 + fr;
#pragma unroll
                    for (int n = 0; n < 2; ++n) { const f32x4 v = acc[ai][0][m][n] + acc[ai][1][m][n]; *(f32x4*)(L + (size_t)row * 64 + wc * 32 + 16 * n + 4 * fq) = v; } }
        }
    }
};
struct EpiExp1 {
    static constexpr bool PERM = true, AFTER_DRAIN = false;
    bf16_t* Hd;
    __device__ __forceinline__ void operator()(const f32x4 (&acc)[2][2][4][2], const Unit& u, int wr, int wc, int fr, int fq) const {
#pragma unroll
        for (int ai = 0; ai < 2; ++ai)
#pragma unroll
            for (int m = 0; m < 4; ++m) { const int row = u.pm * BM + ai * HALF + wr * 64 + m * 16 + fr; float v[8];
#pragma unroll
                for (int n = 0; n < 2; ++n)
#pragma unroll
                    for (int i = 0; i < 4; ++i) { const float g = acc[ai][0][m][n][i], up = acc[ai][1][m][n][i]; v[n * 4 + i] = g * sigmoidf_(g) * up; }
                *(u32x4*)(Hd + (size_t)row * DEXP + u.pn * HALF + wc * 32 + 8 * fq) = pack8(v); }
    }
};
struct EpiExp2 {
    static constexpr bool PERM = true, AFTER_DRAIN = false;
    const int* list; const float* cwl; const int* cnt; bf16_t* Sl;
    __device__ __forceinline__ void operator()(const f32x4 (&acc)[2][2][4][2], const Unit& u, int wr, int wc, int fr, int fq) const {
        const int n = cnt[u.g];
        EPI_LOOP_PERM({
            const int pos = u.lt * BM + lrow, col = u.pn * BM + lcol;
            if (pos < n) { const int d = list[(size_t)u.g * T + pos]; const float w = cwl[(size_t)u.g * T + pos];
                _Pragma("unroll") for (int i = 0; i < 8; ++i) v[i] *= w; *(u32x4*)(Sl + (size_t)d * D + col) = pack8(v); }
        })
    }
};

template <class Epi, class Sched, bool ALIGN_EPI = false, bool SP2 = false, bool GATHER = false>
__device__ __forceinline__ void gemm_phase(PG8_LAS unsigned char* lds, const int K, const int lda, const int ldb, const Sched& S, const Epi& E, const PG8_LAS int* rowtab = nullptr) {
    int tid = threadIdx.x; asm volatile("" : "+v"(tid));
    const int wid = __builtin_amdgcn_readfirstlane(tid >> 6), lane = tid & 63, wr = wid >> 2, wc = wid & 3, fr = lane & 15, fq = lane >> 4;
    const int nt = K / BK;
    unsigned voffA[2], voffB[2]; int gR[2]; unsigned gC[2];
#pragma unroll
    for (int i = 0; i < 2; ++i) { int R, C; stage_rc(tid * 16 + i * 8192, R, C); const int Rb = Epi::PERM ? ((R & ~31) + perm32(R & 31)) : R;
        voffA[i] = (unsigned)(R * lda + C) * 2u; voffB[i] = (unsigned)(Rb * ldb + C) * 2u; gR[i] = R; gC[i] = (unsigned)C * 2u; }
    unsigned vAc[2][2], vAn[2][2], vA2[2][2];
    (void)gR; (void)gC; (void)vAc; (void)vAn; (void)vA2;
#define PG8_GLOAD(dst, ui_) do { _Pragma("unroll") for (int _h = 0; _h < 2; ++_h) _Pragma("unroll") for (int _i = 0; _i < 2; ++_i) \
        dst[_h][_i] = (unsigned)rowtab[(ui_) * 256 + _h * HALF + gR[_i]] * (unsigned)(lda * 2) + gC[_i]; } while (0)
    const size_t kstep = (size_t)(BK * 2);
    const size_t hstepA = (size_t)HALF * lda * 2, hstepB = (size_t)HALF * ldb * 2;
    const unsigned ldsw = (unsigned)wid * 1024u;
    const int aoff = lds_byte(wr * 64 + fr, fq * 8), boff = lds_byte(wc * 32 + fr, fq * 8);
#define PG8_SA(b, h) (((b) * 2 + (h)) * HTB)
#define PG8_SB(b, h) ((4 + (b) * 2 + (h)) * HTB)
#define PG8_STAGE(bufoff, gbase, voff) do { _Pragma("unroll") for (int _i = 0; _i < 2; ++_i) \
        __builtin_amdgcn_global_load_lds((const unsigned*)((const char*)(gbase) + (voff)[_i]), (PG8_LAS unsigned*)(lds + (bufoff) + ldsw + _i * 8192), 16, 0, 0); } while (0)
#define PG8_STAGE_A(bufoff, gbase, h, vs) do { if constexpr (GATHER) { PG8_STAGE(bufoff, gbase, vs[h]); } else { PG8_STAGE(bufoff, (gbase) + (h) * hstepA, voffA); } } while (0)
#define PG8_LDA(dst, b, h) do { _Pragma("unroll") for (int m = 0; m < 4; ++m) _Pragma("unroll") for (int k = 0; k < 2; ++k) dst[m][k] = *(const PG8_LAS bf16x8*)(lds + PG8_SA(b, h) + aoff + m * 2048 + k * 1024); } while (0)
#define PG8_LDB(dst, b, h) do { _Pragma("unroll") for (int n = 0; n < 2; ++n) _Pragma("unroll") for (int k = 0; k < 2; ++k) dst[n][k] = *(const PG8_LAS bf16x8*)(lds + PG8_SB(b, h) + boff + n * 2048 + k * 1024); } while (0)
#define PG8_MMA(ai, bj, At, Bt) do { __builtin_amdgcn_s_setprio(1); _Pragma("unroll") for (int m = 0; m < 4; ++m) _Pragma("unroll") for (int n = 0; n < 2; ++n) _Pragma("unroll") for (int k = 0; k < 2; ++k) \
        acc[ai][bj][m][n] = __builtin_amdgcn_mfma_f32_16x16x32_bf16(Bt[n][k], At[m][k], acc[ai][bj][m][n], 0, 0, 0); __builtin_amdgcn_s_setprio(0); } while (0)
#define PG8_WAIT_V(n) asm volatile("s_waitcnt vmcnt(" #n ")" ::: "memory")
#define PG8_WAIT_L(n) asm volatile("s_waitcnt lgkmcnt(" #n ")" ::: "memory")
#define PG8_BAR __builtin_amdgcn_s_barrier()
#define PG8_SCHED __builtin_amdgcn_sched_barrier(0)
    Unit cur, nxt; int ui = 0;
    if (!S.next(0, cur)) return;
    f32x4 acc[2][2][4][2];
#pragma unroll
    for (int a = 0; a < 2; ++a)
#pragma unroll
        for (int b = 0; b < 2; ++b)
#pragma unroll
            for (int m = 0; m < 4; ++m)
#pragma unroll
                for (int n = 0; n < 2; ++n) acc[a][b][m][n] = (f32x4){0.f, 0.f, 0.f, 0.f};
    bf16x8 At[4][2], B0[2][2], B1[2][2];
    const char* cA = cur.a; const char* cB = cur.b;
    if constexpr (GATHER) { PG8_GLOAD(vAc, 0); }
    static_assert(SP2 || !GATHER, "GATHER is wired into the SP2 loop only");
    if constexpr (SP2) {
        PG8_STAGE(PG8_SB(0, 0), cB, voffB); PG8_STAGE(PG8_SB(0, 1), cB + hstepB, voffB); PG8_STAGE_A(PG8_SA(0, 0), cA, 0, vAc); PG8_STAGE_A(PG8_SA(0, 1), cA, 1, vAc);
        if (wr == 1) PG8_BAR;
        PG8_WAIT_V(2); PG8_BAR;
        PG8_STAGE(PG8_SB(1, 0), cB + kstep, voffB); PG8_STAGE_A(PG8_SA(1, 0), cA + kstep, 0, vAc); PG8_STAGE(PG8_SB(1, 1), cB + hstepB + kstep, voffB);
        PG8_WAIT_V(6); PG8_BAR;
    } else {
        PG8_STAGE(PG8_SB(0, 0), cB, voffB); PG8_STAGE(PG8_SA(0, 0), cA, voffA); PG8_STAGE(PG8_SB(0, 1), cB + hstepB, voffB); PG8_STAGE(PG8_SA(0, 1), cA + hstepA, voffA);
        if (wr == 1) PG8_BAR;
        PG8_WAIT_V(4); PG8_BAR;
        PG8_STAGE(PG8_SB(1, 0), cB + kstep, voffB); PG8_STAGE(PG8_SA(1, 0), cA + kstep, voffA); PG8_STAGE(PG8_SB(1, 1), cB + hstepB + kstep, voffB);
        PG8_WAIT_V(6); PG8_BAR;
    }
    for (;;) {
        const bool has_next = S.next(ui + 1, nxt);
        const char* nA = has_next ? nxt.a : cA; const char* nB = has_next ? nxt.b : cB;
        if constexpr (GATHER) { if (has_next) { PG8_GLOAD(vAn, ui + 1); } else {
            _Pragma("unroll") for (int _h = 0; _h < 2; ++_h) _Pragma("unroll") for (int _i = 0; _i < 2; ++_i) vAn[_h][_i] = vAc[_h][_i]; } }
        for (int t = 0; t < nt; t += 2) {
            const bool last = (t == nt - 2);
            if constexpr (GATHER) { _Pragma("unroll") for (int _h = 0; _h < 2; ++_h) _Pragma("unroll") for (int _i = 0; _i < 2; ++_i) vA2[_h][_i] = last ? vAn[_h][_i] : vAc[_h][_i]; }
            const char* a1 = cA + (size_t)(t + 1) * kstep;
            const char* a2 = last ? nA : cA + (size_t)(t + 2) * kstep; const char* b2 = last ? nB : cB + (size_t)(t + 2) * kstep;
            const char* a3 = a2 + kstep; const char* b3 = b2 + kstep;
            if constexpr (SP2) {
            PG8_LDB(B0, 0, 0); PG8_LDB(B1, 0, 1); PG8_SCHED; PG8_LDA(At, 0, 0); PG8_STAGE_A(PG8_SA(1, 1), a1, 1, vAc);
            PG8_WAIT_V(8); PG8_WAIT_L(0); PG8_BAR; PG8_MMA(0, 0, At, B0); PG8_MMA(0, 1, At, B1); PG8_BAR; PG8_SCHED;
            PG8_LDA(At, 0, 1); PG8_STAGE(PG8_SB(0, 0), b2, voffB); PG8_STAGE(PG8_SB(0, 1), b2 + hstepB, voffB); PG8_STAGE_A(PG8_SA(0, 0), a2, 0, vA2);
            PG8_WAIT_V(8); PG8_WAIT_L(0); PG8_BAR; PG8_MMA(1, 0, At, B0); PG8_MMA(1, 1, At, B1); PG8_BAR; PG8_SCHED;
            PG8_LDB(B0, 1, 0); PG8_LDB(B1, 1, 1); PG8_SCHED; PG8_LDA(At, 1, 0); PG8_STAGE_A(PG8_SA(0, 1), a2, 1, vA2);
            PG8_WAIT_V(8); PG8_WAIT_L(0); PG8_BAR; PG8_MMA(0, 0, At, B0); PG8_MMA(0, 1, At, B1); PG8_BAR; PG8_SCHED;
            PG8_LDA(At, 1, 1); PG8_STAGE(PG8_SB(1, 0), b3, voffB); PG8_STAGE(PG8_SB(1, 1), b3 + hstepB, voffB); PG8_STAGE_A(PG8_SA(1, 0), a3, 0, vA2);
            PG8_WAIT_V(8); PG8_WAIT_L(0); PG8_BAR; PG8_MMA(1, 0, At, B0); PG8_MMA(1, 1, At, B1); PG8_BAR; PG8_SCHED;
            } else {
            PG8_LDB(B0, 0, 0); PG8_SCHED; PG8_LDA(At, 0, 0); PG8_STAGE(PG8_SA(1, 1), a1 + hstepA, voffA);
            PG8_WAIT_L(8); PG8_BAR; PG8_WAIT_L(0); PG8_MMA(0, 0, At, B0); PG8_BAR; PG8_SCHED;
            PG8_LDB(B1, 0, 1); PG8_STAGE(PG8_SB(0, 0), b2, voffB);
            PG8_BAR; PG8_WAIT_L(0); PG8_MMA(0, 1, At, B1); PG8_BAR;
            PG8_LDA(At, 0, 1); PG8_STAGE(PG8_SA(0, 0), a2, voffA);
            PG8_BAR; PG8_WAIT_L(0); PG8_MMA(1, 0, At, B0); PG8_BAR; PG8_SCHED;
            PG8_STAGE(PG8_SB(0, 1), b2 + hstepB, voffB);
            PG8_WAIT_V(6); PG8_BAR; PG8_MMA(1, 1, At, B1); PG8_BAR;
            PG8_LDB(B0, 1, 0); PG8_SCHED; PG8_LDA(At, 1, 0); PG8_STAGE(PG8_SA(0, 1), a2 + hstepA, voffA);
            PG8_WAIT_L(8); PG8_BAR; PG8_WAIT_L(0); PG8_MMA(0, 0, At, B0); PG8_BAR; PG8_SCHED;
            PG8_LDB(B1, 1, 1); PG8_STAGE(PG8_SB(1, 0), b3, voffB);
            PG8_BAR; PG8_WAIT_L(0); PG8_MMA(0, 1, At, B1); PG8_BAR;
            PG8_LDA(At, 1, 1); PG8_STAGE(PG8_SA(1, 0), a3, voffA);
            PG8_BAR; PG8_WAIT_L(0); PG8_MMA(1, 0, At, B0); PG8_BAR; PG8_SCHED;
            PG8_STAGE(PG8_SB(1, 1), b3 + hstepB, voffB);
            PG8_WAIT_V(6); PG8_BAR; PG8_MMA(1, 1, At, B1); PG8_BAR;
            }
        }
        if constexpr (ALIGN_EPI) { if (wr == 0) PG8_BAR; }
        E(acc, cur, wr, wc, fr, fq);
        if (!has_next) break;
#pragma unroll
        for (int a = 0; a < 2; ++a)
#pragma unroll
            for (int b = 0; b < 2; ++b)
#pragma unroll
                for (int m = 0; m < 4; ++m)
#pragma unroll
                    for (int n = 0; n < 2; ++n) acc[a][b][m][n] = (f32x4){0.f, 0.f, 0.f, 0.f};
        cur = nxt; cA = nA; cB = nB; ++ui;
        if constexpr (GATHER) { _Pragma("unroll") for (int _h = 0; _h < 2; ++_h) _Pragma("unroll") for (int _i = 0; _i < 2; ++_i) vAc[_h][_i] = vAn[_h][_i]; }
        if constexpr (ALIGN_EPI) { if (wr == 1) PG8_BAR; }
    }
    PG8_WAIT_V(0);
    if constexpr (!ALIGN_EPI) { if (wr == 0) PG8_BAR; }
    PG8_BAR;
#undef PG8_SA
#undef PG8_SB
#undef PG8_STAGE
#undef PG8_STAGE_A
#undef PG8_GLOAD
#undef PG8_LDA
#undef PG8_LDB
#undef PG8_MMA
#undef PG8_WAIT_V
#undef PG8_WAIT_L
#undef PG8_BAR
#undef PG8_SCHED
}
}

namespace attn_body {
using bf16=__hip_bfloat16;
using bf16x8=__attribute__((ext_vector_type(8)))short;
using s16x4=__attribute__((ext_vector_type(4)))short;
using f32x16=__attribute__((ext_vector_type(16)))float;
using u32x4=__attribute__((ext_vector_type(4)))unsigned;
constexpr int NHEAD=16,SEQ=4096,D=64,DM=NHEAD*D;
constexpr int NW=8,QBLK=32,QB=QBLK*NW,KVBLK=64,NQB=SEQ/QB;
__device__ __forceinline__ int crow(int r,int hi){return (r&3)+8*(r>>2)+4*hi;}
#define SBAR() __builtin_amdgcn_sched_barrier(0)
__device__ __forceinline__ void cmask(f32x16&p0,f32x16&p1,int jb,int wid){
  const float NEG=-INFINITY;
  if(jb>(wid>>1)){
  #pragma unroll
  for(int r=0;r<16;++r){p0[r]=NEG;p1[r]=NEG;}}
}
constexpr int NSLOT=3, SLOTB=8192, VSLOTB=16384;
constexpr int LDS_K=0, LDS_V=NSLOT*SLOTB, LDS_WS=LDS_V+NSLOT*VSLOTB, LDS_OST=LDS_WS+NW*64*4, LDS_BYTES=LDS_OST+NW*8192;
constexpr float C2=0.125f*1.4426950408889634f;
__device__ __forceinline__ void glds16(const char*sbase,unsigned voff,unsigned lds_dst){unsigned keep;
  asm volatile("s_mov_b32 %0, m0\n\ts_mov_b32 m0, %2\n\ts_nop 0\n\tglobal_load_lds_dwordx4 %1, %3\n\ts_mov_b32 m0, %0":"=&s"(keep):"v"(voff),"s"(lds_dst),"s"(sbase):"memory");}
__device__ __forceinline__ float max3f(float a,float b,float c){float r;asm("v_max3_f32 %0, %1, %2, %3":"=v"(r):"v"(a),"v"(b),"v"(c));return r;}
__device__ __forceinline__ float max2f(float a,float b){float r;asm("v_max_f32_e32 %0, %1, %2":"=v"(r):"v"(a),"v"(b));return r;}
typedef float f32x2_t __attribute__((ext_vector_type(2))); typedef __bf16 bf16x2_t __attribute__((ext_vector_type(2)));
__device__ __forceinline__ unsigned cvtpk_s(float lo,float hi){f32x2_t v={lo,hi};bf16x2_t b=__builtin_convertvector(v,bf16x2_t);return __builtin_bit_cast(unsigned,b);}
#define WAIT_BAR(N) asm volatile("s_waitcnt vmcnt(" #N ") lgkmcnt(0)\n\ts_barrier":::"memory")

__device__ __forceinline__ void qkt(f32x16&p0,f32x16&p1,const char*Kslot,const bf16x8*qr,int r32,int hi){
  const char*kb=Kslot+hi*1024+r32*16; const f32x16 z=f32x16{};
  #pragma unroll
  for(int d0=0;d0<4;++d0){
    const bf16x8 b0=*reinterpret_cast<const bf16x8*>(kb+d0*2048);
    const bf16x8 b1=*reinterpret_cast<const bf16x8*>(kb+d0*2048+512);
    if(d0==0){p0=__builtin_amdgcn_mfma_f32_32x32x16_bf16(b0,qr[0],z,0,0,0);p1=__builtin_amdgcn_mfma_f32_32x32x16_bf16(b1,qr[0],z,0,0,0);}
    else{p0=__builtin_amdgcn_mfma_f32_32x32x16_bf16(b0,qr[d0],p0,0,0,0);p1=__builtin_amdgcn_mfma_f32_32x32x16_bf16(b1,qr[d0],p1,0,0,0);}}
}
typedef __attribute__((address_space(3))) const char* lds_cptr;
typedef short v4i16_t __attribute__((ext_vector_type(4)));
__device__ __forceinline__ void kload8(bf16x8*kf,lds_cptr kp){
  kf[0]=*(const __attribute__((address_space(3))) bf16x8*)(kp);      kf[1]=*(const __attribute__((address_space(3))) bf16x8*)(kp+512);
  kf[2]=*(const __attribute__((address_space(3))) bf16x8*)(kp+2048); kf[3]=*(const __attribute__((address_space(3))) bf16x8*)(kp+2560);
  kf[4]=*(const __attribute__((address_space(3))) bf16x8*)(kp+4096); kf[5]=*(const __attribute__((address_space(3))) bf16x8*)(kp+4608);
  kf[6]=*(const __attribute__((address_space(3))) bf16x8*)(kp+6144); kf[7]=*(const __attribute__((address_space(3))) bf16x8*)(kp+6656);
}
__device__ __forceinline__ void kload2(bf16x8*kf,lds_cptr kp,int j){ kf[2*j]=*(const __attribute__((address_space(3))) bf16x8*)(kp+j*2048); kf[2*j+1]=*(const __attribute__((address_space(3))) bf16x8*)(kp+j*2048+512); }
__device__ __forceinline__ s16x4 vtr(lds_cptr p){ return __builtin_bit_cast(s16x4,__builtin_amdgcn_ds_read_tr16_b64_v4i16((__attribute__((address_space(3))) v4i16_t*)p)); }
__device__ __forceinline__ float rowmax(const f32x16&p0,const f32x16&p1){
  float a=max3f(p0[0],p0[1],p1[0]),b=max3f(p0[2],p0[3],p1[1]);a=max3f(a,p1[2],p1[3]);
  #pragma unroll
  for(int r=4;r<16;r+=4){a=max3f(a,p0[r],p0[r+1]);b=max3f(b,p0[r+2],p0[r+3]);a=max3f(a,p1[r],p1[r+1]);b=max3f(b,p1[r+2],p1[r+3]);}
  const float m=max2f(a,b);
  auto rr=__builtin_amdgcn_permlane32_swap(__float_as_uint(m),__float_as_uint(m),false,false);
  return max2f(__uint_as_float(rr[0]),__uint_as_float(rr[1]));
}
__device__ __forceinline__ void pv(f32x16*o,int vb,bf16x8 pa0,bf16x8 pa1,bf16x8 pa2,bf16x8 pa3){
  #pragma unroll
  for(int d0=0;d0<4;++d0){s16x4 lo[4],hi[4];
    #pragma unroll
    for(int ks=0;ks<4;++ks){
      asm volatile("ds_read_b64_tr_b16 %0,%1 offset:%c2":"=&v"(lo[ks]):"v"(vb),"i"(d0*4096+ks*1024):"memory");
      asm volatile("ds_read_b64_tr_b16 %0,%1 offset:%c2":"=&v"(hi[ks]):"v"(vb),"i"(d0*4096+ks*1024+512):"memory");}
    asm volatile("s_waitcnt lgkmcnt(0)":::"memory");SBAR();
    #define PK(k) (bf16x8){lo[k][0],lo[k][1],lo[k][2],lo[k][3],hi[k][0],hi[k][1],hi[k][2],hi[k][3]}
    o[d0]=__builtin_amdgcn_mfma_f32_32x32x16_bf16(pa0,PK(0),o[d0],0,0,0);
    o[d0]=__builtin_amdgcn_mfma_f32_32x32x16_bf16(pa1,PK(1),o[d0],0,0,0);
    o[d0]=__builtin_amdgcn_mfma_f32_32x32x16_bf16(pa2,PK(2),o[d0],0,0,0);
    o[d0]=__builtin_amdgcn_mfma_f32_32x32x16_bf16(pa3,PK(3),o[d0],0,0,0);
    #undef PK
  }
}
template<int THRL,size_t OFF_Q,size_t OFF_K,size_t OFF_V,int GSO> __device__ __forceinline__ void attn_unit(int b,int h,int qb,const char*ws,bf16*AO,float lam,char*shm){
  const bf16*Q=(const bf16*)(ws+OFF_Q); const float*gs=(const float*)(shm+GSO);
  int tid=threadIdx.x; asm volatile("":"+v"(tid)); const int lane=tid&63,r32=lane&31,hi=lane>>5; const int wid=__builtin_amdgcn_readfirstlane(tid>>6);
  const long rowbase=(long)b*SEQ; const int q0=qb*QB;
  const unsigned lds0=(unsigned)(uintptr_t)shm;
  float*wsf=(float*)(shm+LDS_WS)+wid*64;
  bf16*stg=(bf16*)(shm+LDS_OST)+wid*4096;
  const unsigned kdst=lds0+LDS_K+wid*1024, vdst=lds0+LDS_V+wid*1024;
  const int vb0=(int)(lds0+LDS_V)+((lane>>4)&1)*32+(lane&3)*8+(4*hi+((lane&15)>>2))*64;
  const char*Kbase=shm+LDS_K;
  const lds_cptr shm3=(lds_cptr)shm; const lds_cptr kp0=shm3+LDS_K+hi*1024+r32*16; const lds_cptr vp0=shm3+LDS_V+((lane>>4)&1)*32+(lane&3)*8+(4*hi+((lane&15)>>2))*64;
  const int NT=(q0+QB)/KVBLK;
  const char*Vh=ws+OFF_V+(rowbase*DM+h*128)*2;
  const unsigned vsrc=(unsigned)(((16*(wid&3)+(lane>>2))*DM+(wid>>2)*32+(lane&3)*8)*2);
  #pragma unroll 1
  for(int mp=0;mp<2;++mp){
  const int hq=2*h+mp;
  const bf16*Qw=Q+(rowbase+q0+wid*QBLK)*DM+hq*D;
  const char*Kh=ws+OFF_K+(rowbase*DM+hq*D)*2;
  const unsigned ksrc=(unsigned)((lane*DM+wid*8)*2);
  bf16x8 kf[8];
  #define DMA_K(t,slot) glds16(Kh+(long)(t)*(KVBLK*DM*2),ksrc,(unsigned)__builtin_amdgcn_readfirstlane(kdst+(slot)))
  #define DMA_V(t,slot) do{ glds16(Vh+(long)(t)*(KVBLK*DM*2),vsrc,(unsigned)__builtin_amdgcn_readfirstlane(vdst+2*(slot))); glds16(Vh+(long)(t)*(KVBLK*DM*2)+128,vsrc,(unsigned)__builtin_amdgcn_readfirstlane(vdst+2*(slot)+8192)); }while(0)
  DMA_K(0,0);DMA_V(0,0);DMA_K(1,SLOTB);
  bf16x8 qr[4];
  #pragma unroll
  for(int d0=0;d0<4;++d0)qr[d0]=*reinterpret_cast<const bf16x8*>(&Qw[(long)r32*DM+d0*16+hi*8]);
  float mhat=0.f,l_reg=0.f;f32x16 o[4];o[0]=f32x16{};o[1]=f32x16{};o[2]=f32x16{};o[3]=f32x16{};
  #define CMASK(P0,P1,t) do{int jb_=(t)-(NT-4); if(jb_>=0)cmask(P0,P1,jb_,wid);}while(0)
  bool resc=false;
  #define RESC() do{ if(resc){ asm volatile("s_waitcnt lgkmcnt(0)":::"memory"); \
      _Pragma("unroll") for(int d_=0;d_<4;++d_) _Pragma("unroll") for(int r=0;r<16;++r)o[d_][r]*=wsf[crow(r,hi)]; } }while(0)
  f32x16 pA0,pA1,pB0,pB1;
  int sl_prev=0,sl_cur=0,sl_next=SLOTB;
  #define ROT() do{sl_prev=sl_cur;sl_cur=sl_next;sl_next=(sl_next==(NSLOT-1)*SLOTB)?0:sl_next+SLOTB;}while(0)
  DMA_K(2,2*SLOTB);
  WAIT_BAR(4);
  qkt(pA0,pA1,Kbase,qr,r32,hi);asm volatile("s_nop 15\n\ts_nop 7":"+v"(pA0),"+v"(pA1));CMASK(pA0,pA1,0);
  { const float rm=rowmax(pA0,pA1); mhat=rm; resc=false;
    _Pragma("unroll") for(int r=0;r<16;++r){pA0[r]=__builtin_amdgcn_exp2f(pA0[r]-mhat);pA1[r]=__builtin_amdgcn_exp2f(pA1[r]-mhat);} }
  WAIT_BAR(0);
  DMA_K(3,0);DMA_V(1,SLOTB);
  ROT();
  kload8(kf,kp0+sl_cur);
  WAIT_BAR(3);
  s16x4 vlo[8],vhi[8]; u32x4 pw0,pw1,pw2,pw3;
  #define PKW(P,B) cvtpk_s(P[B],P[B+1])
  #define PAF(k) __builtin_bit_cast(bf16x8,pw##k)
  #define VFR(i) (bf16x8){vlo[i][0],vlo[i][1],vlo[i][2],vlo[i][3],vhi[i][0],vhi[i][1],vhi[i][2],vhi[i][3]}
  #define PIN(x) asm volatile("":"+v"(x))
  #define MX3(a,b,c) __builtin_fmaxf(__builtin_fmaxf((a),(b)),(c))
  #define ZC (f32x16{})
  #define GAPA(MF,A0,A1,A2,A3,W0,W1,PW) do{ MF; sacc+=A0; sacc+=A1; sacc+=A2; sacc+=A3; PIN(sacc); W0; W1; PIN(PW); SBAR(); }while(0)
  #define EX(v) __builtin_amdgcn_exp2f((v)-mhat)
  #define GAPB(MF,X,B) do{ MF; X[B]=EX(X[B]); X[B+1]=EX(X[B+1]); PIN(X); SBAR(); }while(0)
  #define VRD(i) do{ vlo[i]=vtr(vp_+(((i)>>2)*4096+((i)&3)*1024)); vhi[i]=vtr(vp_+(((i)>>2)*4096+((i)&3)*1024+512)); }while(0)
  #define VRD2(i) do{ vlo[i]=vtr(vp_+((2+((i)>>2))*4096+((i)&3)*1024)); vhi[i]=vtr(vp_+((2+((i)>>2))*4096+((i)&3)*1024+512)); SBAR(); }while(0)
  #define KRD(G,j) do{ if(G){ kload2(kf,kp0+sl_next,j); SBAR(); } }while(0)
  #define STEP(C0,C1,P0,P1,t,GK,GV,GL) do{ SBAR(); \
    const lds_cptr vp_=vp0+2*sl_prev; \
    VRD(0); SBAR(); float sacc=(P0[0]+P0[1]); \
    GAPA(C0=__builtin_amdgcn_mfma_f32_32x32x16_bf16(kf[0],qr[0],ZC,0,0,0), P0[2],P0[3],P0[4],P0[5],     pw0[0]=PKW(P0,0), pw0[1]=PKW(P0,2), pw0); \
    VRD(4); SBAR(); GAPA(C1=__builtin_amdgcn_mfma_f32_32x32x16_bf16(kf[1],qr[0],ZC,0,0,0), P0[6],P0[7],P0[8],P0[9],     pw0[2]=PKW(P0,4), pw0[3]=PKW(P0,6), pw0); \
    VRD(1); SBAR(); GAPA(C0=__builtin_amdgcn_mfma_f32_32x32x16_bf16(kf[2],qr[1],C0,0,0,0),   P0[10],P0[11],P0[12],P0[13], pw1[0]=PKW(P0,8), pw1[1]=PKW(P0,10), pw1); \
    VRD(5); SBAR(); GAPA(C1=__builtin_amdgcn_mfma_f32_32x32x16_bf16(kf[3],qr[1],C1,0,0,0),   P0[14],P0[15],P1[0],P1[1],   pw1[2]=PKW(P0,12),pw1[3]=PKW(P0,14), pw1); \
    VRD(2); SBAR(); GAPA(C0=__builtin_amdgcn_mfma_f32_32x32x16_bf16(kf[4],qr[2],C0,0,0,0),   P1[2],P1[3],P1[4],P1[5],     pw2[0]=PKW(P1,0), pw2[1]=PKW(P1,2), pw2); \
    VRD(6); SBAR(); GAPA(C1=__builtin_amdgcn_mfma_f32_32x32x16_bf16(kf[5],qr[2],C1,0,0,0),   P1[6],P1[7],P1[8],P1[9],     pw2[2]=PKW(P1,4), pw2[3]=PKW(P1,6), pw2); \
    VRD(3); SBAR(); GAPA(C0=__builtin_amdgcn_mfma_f32_32x32x16_bf16(kf[6],qr[3],C0,0,0,0),   P1[10],P1[11],P1[12],P1[13], pw3[0]=PKW(P1,8), pw3[1]=PKW(P1,10), pw3); \
    VRD(7); SBAR(); GAPA(C1=__builtin_amdgcn_mfma_f32_32x32x16_bf16(kf[7],qr[3],C1,0,0,0),   P1[14],P1[15],0.f,0.f,       pw3[2]=PKW(P1,12),pw3[3]=PKW(P1,14), pw3); \
    l_reg+=sacc; \
    if(GK){DMA_K((t)+3,sl_cur);} if(GV){DMA_V((t)+1,sl_next);} \
    CMASK(C0,C1,t); \
    { float a=MX3(C0[0],C0[1],C1[0]),b=MX3(C0[2],C0[3],C1[1]); a=MX3(a,C1[2],C1[3]); \
      _Pragma("unroll") for(int r=4;r<16;r+=4){a=MX3(a,C0[r],C0[r+1]);b=MX3(b,C0[r+2],C0[r+3]);a=MX3(a,C1[r],C1[r+1]);b=MX3(b,C1[r+2],C1[r+3]);} \
      float rm=__builtin_fmaxf(a,b); { auto rr=__builtin_amdgcn_permlane32_swap(__float_as_uint(rm),__float_as_uint(rm),false,false); rm=__builtin_fmaxf(__uint_as_float(rr[0]),__uint_as_float(rr[1])); } \
      rm-=mhat; resc=false; \
      if(__builtin_expect(__any(rm>(float)THRL),0)){ const float dl=__builtin_fmaxf(rm,0.f); mhat+=dl; \
        const float f=__builtin_amdgcn_exp2f(-dl); l_reg*=f; if(hi==0)wsf[r32]=f; resc=true; } } \
    SBAR(); \
    GAPB(o[0]=__builtin_amdgcn_mfma_f32_32x32x16_bf16(PAF(0),VFR(0),o[0],0,0,0), C0,0);  VRD2(0); \
    GAPB(o[1]=__builtin_amdgcn_mfma_f32_32x32x16_bf16(PAF(0),VFR(4),o[1],0,0,0), C0,2);  VRD2(4); \
    GAPB(o[0]=__builtin_amdgcn_mfma_f32_32x32x16_bf16(PAF(1),VFR(1),o[0],0,0,0), C0,4);  VRD2(1); \
    GAPB(o[1]=__builtin_amdgcn_mfma_f32_32x32x16_bf16(PAF(1),VFR(5),o[1],0,0,0), C0,6);  VRD2(5); \
    GAPB(o[0]=__builtin_amdgcn_mfma_f32_32x32x16_bf16(PAF(2),VFR(2),o[0],0,0,0), C0,8);  VRD2(2); \
    GAPB(o[1]=__builtin_amdgcn_mfma_f32_32x32x16_bf16(PAF(2),VFR(6),o[1],0,0,0), C0,10); VRD2(6); \
    GAPB(o[0]=__builtin_amdgcn_mfma_f32_32x32x16_bf16(PAF(3),VFR(3),o[0],0,0,0), C0,12); VRD2(3); \
    GAPB(o[1]=__builtin_amdgcn_mfma_f32_32x32x16_bf16(PAF(3),VFR(7),o[1],0,0,0), C0,14); VRD2(7); \
    KRD(GL,0); GAPB(o[2]=__builtin_amdgcn_mfma_f32_32x32x16_bf16(PAF(0),VFR(0),o[2],0,0,0), C1,0); \
    KRD(GL,1); GAPB(o[3]=__builtin_amdgcn_mfma_f32_32x32x16_bf16(PAF(0),VFR(4),o[3],0,0,0), C1,2); \
    KRD(GL,2); GAPB(o[2]=__builtin_amdgcn_mfma_f32_32x32x16_bf16(PAF(1),VFR(1),o[2],0,0,0), C1,4); \
    KRD(GL,3); GAPB(o[3]=__builtin_amdgcn_mfma_f32_32x32x16_bf16(PAF(1),VFR(5),o[3],0,0,0), C1,6); \
    GAPB(o[2]=__builtin_amdgcn_mfma_f32_32x32x16_bf16(PAF(2),VFR(2),o[2],0,0,0), C1,8); \
    GAPB(o[3]=__builtin_amdgcn_mfma_f32_32x32x16_bf16(PAF(2),VFR(6),o[3],0,0,0), C1,10); \
    GAPB(o[2]=__builtin_amdgcn_mfma_f32_32x32x16_bf16(PAF(3),VFR(3),o[2],0,0,0), C1,12); \
    GAPB(o[3]=__builtin_amdgcn_mfma_f32_32x32x16_bf16(PAF(3),VFR(7),o[3],0,0,0), C1,14); \
    }while(0)
  int t=1;
  #undef CMASK
  #define CMASK(P0,P1,t) do{}while(0)
  for(;t+5<NT;t+=2){
    STEP(pB0,pB1,pA0,pA1,t,true,true,true);     WAIT_BAR(3); RESC(); ROT();
    STEP(pA0,pA1,pB0,pB1,t+1,true,true,true);   WAIT_BAR(3); RESC(); ROT();
  }
  #undef CMASK
  #define CMASK(P0,P1,t) do{int jb_=(t)-(NT-4); if(jb_>=0)cmask(P0,P1,jb_,wid);}while(0)
  #define ENDW(tt) do{ if((tt)+3<NT){WAIT_BAR(3);} else if((tt)+2<NT){WAIT_BAR(2);} else {WAIT_BAR(0);} }while(0)
  for(;t+1<NT;t+=2){
    STEP(pB0,pB1,pA0,pA1,t,(t+3<NT),(t+1<NT),(t+1<NT));       ENDW(t);   RESC(); ROT();
    STEP(pA0,pA1,pB0,pB1,t+1,(t+4<NT),(t+2<NT),(t+2<NT));     ENDW(t+1); RESC(); ROT();
  }
  STEP(pB0,pB1,pA0,pA1,NT-1,false,false,false); RESC();
  { float sacc=pB0[0]+pB0[1]; _Pragma("unroll") for(int r=2;r<16;++r)sacc+=pB0[r]; _Pragma("unroll") for(int r=0;r<16;++r)sacc+=pB1[r]; l_reg+=sacc;
    pw0=(u32x4){PKW(pB0,0),PKW(pB0,2),PKW(pB0,4),PKW(pB0,6)};pw1=(u32x4){PKW(pB0,8),PKW(pB0,10),PKW(pB0,12),PKW(pB0,14)};pw2=(u32x4){PKW(pB1,0),PKW(pB1,2),PKW(pB1,4),PKW(pB1,6)};pw3=(u32x4){PKW(pB1,8),PKW(pB1,10),PKW(pB1,12),PKW(pB1,14)};
    SBAR(); pv(o,vb0+2*sl_cur,PAF(0),PAF(1),PAF(2),PAF(3)); }
  #undef PKW
  #undef PAF
  #undef VFR
  #undef PIN
  #undef MX3
  #undef ZC
  #undef GAPA
  #undef GAPB
  #undef EX
  #undef VRD
  #undef VRD2
  #undef KRD
  #undef STEP
  #undef ENDW
  #undef DMA_K
  #undef DMA_V
  #undef CMASK
  #undef RESC
  #undef ROT
  {auto rr=__builtin_amdgcn_permlane32_swap(__float_as_uint(l_reg),__float_as_uint(l_reg),false,false);l_reg=__uint_as_float(rr[0])+__uint_as_float(rr[1]);}
  if(hi==0)wsf[32+r32]=l_reg;asm volatile("s_waitcnt lgkmcnt(0)":::"memory");
  float rli[16];
  #pragma unroll
  for(int r=0;r<16;++r)rli[r]=__builtin_amdgcn_rcpf(wsf[32+crow(r,hi)]);
  if(mp==0){
    #pragma unroll
    for(int r=0;r<16;++r){const int orow=crow(r,hi);
      #pragma unroll
      for(int d0=0;d0<4;++d0)stg[orow*128+d0*32+r32]=__float2bfloat16(o[d0][r]*rli[r]);}
  } else {
    #pragma unroll
    for(int r=0;r<16;++r){const int orow=crow(r,hi);
      #pragma unroll
      for(int d0=0;d0<4;++d0){ const float c=__bfloat162float(stg[orow*128+d0*32+r32])-lam*(o[d0][r]*rli[r]); stg[orow*128+d0*32+r32]=__float2bfloat16(c);} }
    asm volatile("s_waitcnt lgkmcnt(0)":::"memory");
    const int row=lane>>1,hf=lane&1; float cv[64]; float ss=0.f;
    #pragma unroll
    for(int i=0;i<8;++i){ const u32x4 w=*(const u32x4*)(stg+row*128+hf*64+i*8);
      cv[8*i+0]=__uint_as_float(w.x<<16);cv[8*i+1]=__uint_as_float(w.x&0xffff0000u);cv[8*i+2]=__uint_as_float(w.y<<16);cv[8*i+3]=__uint_as_float(w.y&0xffff0000u);
      cv[8*i+4]=__uint_as_float(w.z<<16);cv[8*i+5]=__uint_as_float(w.z&0xffff0000u);cv[8*i+6]=__uint_as_float(w.w<<16);cv[8*i+7]=__uint_as_float(w.w&0xffff0000u); }
    #pragma unroll
    for(int i=0;i<64;++i)ss+=cv[i]*cv[i];
    ss+=__int_as_float(__builtin_amdgcn_ds_bpermute((lane^1)<<2,__float_as_int(ss)));
    const float rstd=1.0f/sqrtf(ss*(1.0f/128.0f)+1e-6f);
    bf16*Ow=AO+(rowbase+q0+wid*QBLK+row)*DM+h*128+hf*64;
    #pragma unroll
    for(int i=0;i<8;++i){ const float4 g0=*(const float4*)(gs+hf*64+i*8),g1=*(const float4*)(gs+hf*64+i*8+4); u32x4 w;
      w.x=cvtpk_s(cv[8*i+0]*rstd*g0.x,cv[8*i+1]*rstd*g0.y); w.y=cvtpk_s(cv[8*i+2]*rstd*g0.z,cv[8*i+3]*rstd*g0.w);
      w.z=cvtpk_s(cv[8*i+4]*rstd*g1.x,cv[8*i+5]*rstd*g1.y); w.w=cvtpk_s(cv[8*i+6]*rstd*g1.z,cv[8*i+7]*rstd*g1.w);
      *(u32x4*)(Ow+i*8)=w; }
  }
  asm volatile("s_waitcnt lgkmcnt(0)\n\ts_barrier":::"memory");
  }
}
constexpr int ATTN_LDS_BYTES=LDS_BYTES;
#undef SBAR
#undef WAIT_BAR
}

constexpr size_t MiB = 1u << 20;
constexpr size_t WS_CTL = 0, CTL_ZERO_BYTES = 1 * MiB;
constexpr size_t WS_WIN = 2 * MiB;
constexpr size_t WS_WGLU = 13 * MiB;
constexpr size_t WS_WSSM = 14 * MiB;
constexpr size_t WS_WATT = 15 * MiB;
constexpr size_t WS_WOUT = 17 * MiB;
constexpr size_t WS_WR = 19 * MiB;
constexpr size_t WS_BTP = 20 * MiB;
constexpr size_t WS_BTY = 28 * MiB;
constexpr size_t WS_WE1 = 48 * MiB;
constexpr size_t WS_WE2 = 80 * MiB;
constexpr size_t WS_ETAB = 96 * MiB;
constexpr size_t WS_MOD = 104 * MiB;
constexpr size_t WS_UG = 112 * MiB;
constexpr size_t WS_Q = 152 * MiB, WS_K = 216 * MiB, WS_V = 280 * MiB;
constexpr size_t WS_GATES = 344 * MiB;
constexpr size_t WS_SLOC = 472 * MiB;
constexpr size_t WS_YACT = 152 * MiB;
constexpr size_t WS_S5O = 184 * MiB;
constexpr size_t WS_TMP = 280 * MiB;
constexpr size_t WS_H = 344 * MiB;
constexpr size_t WS_HDN = 256 * MiB;
constexpr size_t WS_SLOTS = 112 * MiB;
constexpr size_t WS_LIST = 472 * MiB;
constexpr size_t WS_CWL = 476 * MiB;
constexpr size_t WS_END = 512 * MiB;
constexpr int CW_TMO = 0, CW_BAR = 4096, CW_CNT = 16384;

constexpr int NWAVES = 8;
constexpr int RING_OFF = 0, RING_BYTES = 147456;
constexpr int LDSCTL_OFF = RING_BYTES, MISC_OFF = LDSCTL_OFF + 320;
constexpr int GS_OFF = MISC_OFF + 2048;
constexpr int ROWTAB_OFF = LDSCTL_OFF + 4096;
constexpr int LDS_BYTES = RING_BYTES + 8192;
static_assert(attn_body::ATTN_LDS_BYTES <= RING_BYTES, "attention LDS");

#define GAS __attribute__((address_space(1)))
#define LAS __attribute__((address_space(3)))
typedef unsigned short bf16;
typedef unsigned v4u __attribute__((ext_vector_type(4)));
typedef unsigned v2u __attribute__((ext_vector_type(2)));
typedef float f32x4 __attribute__((ext_vector_type(4)));
typedef GAS unsigned gu32;
#define RLX_AGENT __ATOMIC_RELAXED, __HIP_MEMORY_SCOPE_AGENT
#define LDS_WAIT() asm volatile("s_waitcnt lgkmcnt(0)" ::: "memory")
#define VM_WAIT() asm volatile("s_waitcnt vmcnt(0)" ::: "memory")
__device__ __forceinline__ unsigned f2bf(float f) { unsigned u = __builtin_bit_cast(unsigned, f); return (u + 0x7fffu + ((u >> 16) & 1u)) >> 16; }
__device__ __forceinline__ unsigned pk2(float lo, float hi) { return f2bf(lo) | (f2bf(hi) << 16); }
__device__ __forceinline__ float bf2f(unsigned b) { return __uint_as_float(b << 16); }

#define XB_TMO      128
#define XB_XCNT(j)  (256  + 64 * (j))
#define XB_XSUB(j)  (1280 + 64 * (j))
#define XB_XGEN(j)  (2304 + 64 * (j))
#define XB_TOP      3328
#define XB_TOPGEN   3392
#define XCD_BAR_WORDS 3456
#define XB_SPIN_CAP (1u << 18)
__device__ __forceinline__ unsigned xb_ld(unsigned* p)              { return __hip_atomic_load(p, __ATOMIC_RELAXED, __HIP_MEMORY_SCOPE_AGENT); }
__device__ __forceinline__ unsigned xb_add(unsigned* p, unsigned v) { return __hip_atomic_fetch_add(p, v, __ATOMIC_RELAXED, __HIP_MEMORY_SCOPE_AGENT); }
__device__ __forceinline__ unsigned xb_xcc_id() { return (unsigned)__builtin_amdgcn_s_getreg((3 << 11) | 20) & 0xFu; }
#define XB_SPIN(cond, bar) do { unsigned _sp = 0; while (cond) { __builtin_amdgcn_s_sleep(1); \
    if ((++_sp & 255u) == 0u) { if (xb_ld(&(bar)[XB_TMO])) break; if (_sp > XB_SPIN_CAP) { atomicAdd(&(bar)[XB_TMO], 1u); break; } } } } while (0)
struct XcdBarrier { unsigned* bar; unsigned x; volatile LAS unsigned* st; };
__device__ __forceinline__ XcdBarrier xcd_barrier_post(unsigned* bar, volatile LAS unsigned* st) {
    XcdBarrier b; b.bar = bar; b.x = xb_xcc_id(); b.st = st;
    if (threadIdx.x == 0) (void)xb_add(&bar[XB_XCNT(b.x)], 1u);
    return b;
}
__device__ __forceinline__ void xcd_barrier_complete(unsigned* bar, unsigned x, unsigned& nloc, unsigned& nx) {
    const unsigned G = gridDim.x * gridDim.y * gridDim.z;
    unsigned sum, cnt, mine, sp = 0u;
    for (;;) {
        sum = 0u; cnt = 0u; mine = 0u;
#pragma unroll
        for (unsigned j = 0; j < 16; ++j) { const unsigned c = xb_ld(&bar[XB_XCNT(j)]); sum += c; cnt += (c > 0u) ? 1u : 0u; mine = (j == x) ? c : mine; }
        if (sum == G) break;
        __builtin_amdgcn_s_sleep(1);
        if ((++sp & 255u) == 0u) { if (xb_ld(&bar[XB_TMO])) break; if (sp > XB_SPIN_CAP) { atomicAdd(&bar[XB_TMO], 1u); break; } }
    }
    nloc = mine > 0u ? mine : 1u; nx = cnt > 0u ? cnt : 1u;
}
__device__ __forceinline__ void xcd_barrier(const XcdBarrier& b) {
    asm volatile("s_waitcnt vmcnt(0)" ::: "memory");
    __syncthreads();
    if (threadIdx.x == 0) {
        unsigned* bar = b.bar;
        __builtin_amdgcn_s_waitcnt(0);
        unsigned nloc = b.st[0], nx = b.st[1];
        if (nloc == 0u) { xcd_barrier_complete(bar, b.x, nloc, nx); b.st[0] = nloc; b.st[1] = nx; }
        const unsigned old = xb_add(&bar[XB_XSUB(b.x)], 1u);
        const unsigned gen = old / nloc;
        if (old + 1u == (gen + 1u) * nloc) {
            __builtin_amdgcn_fence(__ATOMIC_RELEASE, "agent");
            asm volatile("s_waitcnt vmcnt(0)" ::: "memory");
            const unsigned og = xb_add(&bar[XB_TOP], 1u);
            const unsigned tg = og / nx;
            if (og + 1u == (tg + 1u) * nx) xb_add(&bar[XB_TOPGEN], 1u);
            else XB_SPIN(xb_ld(&bar[XB_TOPGEN]) == tg, bar);
            __builtin_amdgcn_fence(__ATOMIC_ACQUIRE, "agent");
            xb_add(&bar[XB_XGEN(b.x)], 1u);
            asm volatile("s_waitcnt vmcnt(0)" ::: "memory");
        } else {
            XB_SPIN(xb_ld(&bar[XB_XGEN(b.x)]) == gen, bar);
            __builtin_amdgcn_fence(__ATOMIC_ACQUIRE, "agent");
            asm volatile("s_waitcnt vmcnt(0)" ::: "memory");
        }
    }
    __syncthreads();
}

__device__ __forceinline__ float shfl_xor_l(float v, int o, int lane) { return __int_as_float(__builtin_amdgcn_ds_bpermute((lane ^ o) << 2, __float_as_int(v))); }
__device__ __forceinline__ float wave_sum(float v, int lane) {
#pragma unroll
    for (int o = 1; o < 64; o <<= 1) v += shfl_xor_l(v, o, lane);
    return v;
}
__device__ __forceinline__ void transpose_tile(const float* W, int N, int k0, int n0, bf16* WT, int ldo, int orow0, int ocol0, LAS float* scr, int lane) {
#pragma unroll 8
    for (int i = 0; i < 32; ++i) { const int kk = 2 * i + (lane >> 5); scr[kk * 33 + (lane & 31)] = W[(size_t)(k0 + kk) * N + n0 + (lane & 31)]; }
    LDS_WAIT(); asm volatile("" ::: "memory");
    const int c = lane & 7;
#pragma unroll
    for (int j = 0; j < 4; ++j) { const int n = (lane >> 3) + 8 * j; const LAS float* s = scr + (8 * c) * 33 + n;
        v4u o; o.x = pk2(s[0 * 33], s[1 * 33]); o.y = pk2(s[2 * 33], s[3 * 33]); o.z = pk2(s[4 * 33], s[5 * 33]); o.w = pk2(s[6 * 33], s[7 * 33]);
        *(GAS v4u*)(WT + (size_t)(orow0 + n) * ldo + ocol0 + 8 * c) = o; }
    LDS_WAIT(); asm volatile("" ::: "memory");
}
__device__ __forceinline__ void abar_pow(float lr, float li, float dt, float j, float& re, float& im) {
    const float mag = expf(lr * dt * j); float s, c; sincosf(li * dt * j, &s, &c); re = mag * c; im = mag * s;
}

constexpr int ETAB_OFF = MISC_OFF + 256;
__device__ __forceinline__ void build_expert_table(LAS unsigned char* L, const int* CNT, int tid) {
    LAS int* tab = (LAS int*)(L + ETAB_OFF);
    __syncthreads();
    if (tid == 0) { int rt = 0;
#pragma unroll 1
        for (int e = 0; e < NEXP; ++e) { const int nt = (CNT[e] + 255) >> 8;
#pragma unroll 1
            for (int q = 0; q < nt; ++q) tab[rt++] = e | (q << 8); }
#pragma unroll 1
        for (; rt <= XS_ROWS / 256; ++rt) tab[rt] = -1; }
    __syncthreads();
}
struct Args { const float* in[34]; float* out; unsigned char* ws; };
typedef __attribute__((address_space(4))) const char* kconst_ptr;
__device__ __forceinline__ void* karg(int k) { kconst_ptr kp = (kconst_ptr)__builtin_amdgcn_kernarg_segment_ptr(); asm volatile("" : "+s"(kp)); return *(void* const __attribute__((address_space(4)))*)(kp + 8 * k); }

__global__ void __launch_bounds__(NWAVES * 64, 2) fwd_kernel(Args args) {
    extern __shared__ __attribute__((aligned(16))) unsigned char lds[];
    LAS unsigned char* L = (LAS unsigned char*)lds;
    volatile LAS unsigned* MISC = (volatile LAS unsigned*)(L + MISC_OFF);
#define PHASE_IDS() \
    int tid = threadIdx.x; asm volatile("" : "+v"(tid)); \
    const int lane = tid & 63, wave = __builtin_amdgcn_readfirstlane(tid >> 6); \
    int G = gridDim.x, bx = blockIdx.x; asm volatile("" : "+s"(G), "+s"(bx)); \
    const int vcu = (G % 8 == 0) ? (bx % 8) * (G / 8) + bx / 8 : bx; \
    const int gw = vcu * NWAVES + wave, NGW = G * NWAVES; \
    const int gt = bx * (NWAVES * 64) + tid, NGT = G * NWAVES * 64; \
    (void)lane; (void)wave; (void)vcu; (void)gw; (void)NGW; (void)gt; (void)NGT;
    gu32* ctl = (gu32*)(args.ws + WS_CTL);
    for (int u = threadIdx.x; u < (LDS_BYTES - LDSCTL_OFF) / 4; u += NWAVES * 64) ((LAS unsigned*)(L + LDSCTL_OFF))[u] = 0u;
    __syncthreads();
    XcdBarrier bar = xcd_barrier_post((unsigned*)(ctl + CW_BAR), MISC + 8);
#define GRID_BAR() xcd_barrier(bar)

#define KIN(k) ((const float*)karg(k))
#define WSP(T_, off) ((T_*)(((unsigned char*)karg(35)) + (off)))
#define OUTP() ((float*)karg(34))

#if DBG_STAGE != 1
    asm volatile("; PHASE_MARK P0" ::: "memory");
    {
        PHASE_IDS();
        const float* w_in = KIN(5); const float* w_glu = KIN(15); const float* w_br_ssm = KIN(22); const float* w_br_attn = KIN(23); const float* w_out = KIN(24);
        const float* w_eg = KIN(30); const float* w_eu = KIN(31); const float* w_ed = KIN(32);
        bf16* WinT = WSP(bf16, WS_WIN); bf16* WgluT = WSP(bf16, WS_WGLU); bf16* WssmT = WSP(bf16, WS_WSSM); bf16* WattT = WSP(bf16, WS_WATT); bf16* WoutT = WSP(bf16, WS_WOUT);
        bf16* WE1 = WSP(bf16, WS_WE1); bf16* WE2 = WSP(bf16, WS_WE2);
        LAS float* scr = (LAS float*)(L + RING_OFF + wave * 16384);
        constexpr int I_IN = 16 * 176, I_GLU = 8 * 16, I_SSM = 8 * 32, I_ATT = 16 * 32, I_OUT = 16 * 32, I_EG = NEXP * 16 * 8, I_EU = I_EG, I_ED = NEXP * 4 * 32;
        constexpr int NITEMS = I_IN + I_GLU + I_SSM + I_ATT + I_OUT + I_EG + I_EU + I_ED;
        for (int it = gw; it < NITEMS; it += NGW) {
            int r = it;
            if (r < I_IN) { const int kb = r / 176, nb = r % 176; transpose_tile(w_in, INW, 64 * kb, 32 * nb, WinT, D, 32 * nb, 64 * kb, scr, lane); continue; } r -= I_IN;
            if (r < I_GLU) { const int kb = r / 16, nb = r % 16; transpose_tile(w_glu, S5W, 64 * kb, 32 * nb, WgluT, S5W, 32 * nb, 64 * kb, scr, lane); continue; } r -= I_GLU;
            if (r < I_SSM) { const int kb = r / 32, nb = r % 32; transpose_tile(w_br_ssm, D, 64 * kb, 32 * nb, WssmT, S5W, 32 * nb, 64 * kb, scr, lane); continue; } r -= I_SSM;
            if (r < I_ATT) { const int kb = r / 32, nb = r % 32; transpose_tile(w_br_attn, D, 64 * kb, 32 * nb, WattT, D, 32 * nb, 64 * kb, scr, lane); continue; } r -= I_ATT;
            if (r < I_OUT) { const int kb = r / 32, nb = r % 32; transpose_tile(w_out, D, 64 * kb, 32 * nb, WoutT, D, 32 * nb, 64 * kb, scr, lane); continue; } r -= I_OUT;
            if (r < I_EG + I_EU) { const bool up = r >= I_EG; if (up) r -= I_EG; const int e = r / 128, q = r % 128, kb = q / 8, nb = q % 8;
                transpose_tile((up ? w_eu : w_eg) + (size_t)e * D * DEXP, DEXP, 64 * kb, 32 * nb, WE1 + (size_t)e * 512 * D, D, (nb >> 2) * 256 + (up ? 128 : 0) + (nb & 3) * 32, 64 * kb, scr, lane); continue; } r -= I_EG + I_EU;
            { const int e = r / 128, q = r % 128, kb = q / 32, nb = q % 32; transpose_tile(w_ed + (size_t)e * DEXP * D, D, 64 * kb, 32 * nb, WE2 + (size_t)e * D * DEXP, DEXP, 32 * nb, 64 * kb, scr, lane); }
        }
        const float* w_rg = KIN(26); const float* w_re = KIN(28); bf16* WR = WSP(bf16, WS_WR);
        for (int idx = gt; idx < 2 * 64 * 128; idx += NGT) {
            const int k0 = (idx & 127) * 8, n = (idx >> 7) & 63, part = idx >> 13;
            unsigned w[4] = {0u, 0u, 0u, 0u};
            if (n < 36) {
                float hv[8];
#pragma unroll
                for (int i = 0; i < 8; ++i) { const float f = (n < 4) ? w_rg[(size_t)(k0 + i) * 4 + n] : w_re[(size_t)(k0 + i) * NEXP + (n - 4)]; const float h = bf2f(f2bf(f)); hv[i] = part ? (f - h) : h; }
#pragma unroll
                for (int i = 0; i < 4; ++i) w[i] = pk2(hv[2 * i], hv[2 * i + 1]);
            }
            *(GAS v4u*)(WR + (size_t)(part * 64 + n) * D + k0) = (v4u){w[0], w[1], w[2], w[3]};
        }
        const float* log_dt = KIN(14); const float* a_re = KIN(7); const float* a_im = KIN(8); const float* sb_re = KIN(9); const float* sb_im = KIN(10);
        float* Ere = WSP(float, WS_ETAB); float* Eim = Ere + NG * LC * NP * 16;
        for (int idx = gt; idx < NG * LC * NP; idx += NGT) {
            const int p = idx % NP, j = (idx / NP) % LC, g = idx / (NP * LC);
            const float dt = expf(log_dt[g]), lr = a_re[g * NP + p], li = a_im[g * NP + p];
            float ar, ai; abar_pow(lr, li, dt, 1.0f, ar, ai);
            const float den = lr * lr + li * li, nr = ar - 1.0f;
            const float fre = (nr * lr + ai * li) / den, fim = (ai * lr - nr * li) / den;
            float pr, pi; abar_pow(lr, li, dt, (float)j, pr, pi);
            const float gr = pr * fre - pi * fim, gi = pr * fim + pi * fre;
            const float* br = sb_re + (size_t)(g * NP + p) * 16; const float* bi = sb_im + (size_t)(g * NP + p) * 16;
            float* er = Ere + (size_t)((g * LC + j) * NP + p) * 16; float* ei = Eim + (size_t)((g * LC + j) * NP + p) * 16;
#pragma unroll
            for (int ci = 0; ci < 16; ++ci) { er[ci] = gr * br[ci] - gi * bi[ci]; ei[ci] = gr * bi[ci] + gi * br[ci]; }
        }
        {
            const float* cvec = KIN(1); const float* w_ada = KIN(2); const float* b_ada = KIN(3); float* MOD = WSP(float, WS_MOD);
            __syncthreads();
            LAS float* cs = (LAS float*)(L + RING_OFF);
            LAS float* red = (LAS float*)(L + RING_OFF + 32768);
            bool loaded = false;
            for (int it = vcu; it < 6 * D / 32; it += G) {
                if (!loaded) { __syncthreads(); for (int i = tid; i < NB * D; i += NWAVES * 64) { const float c = cvec[i]; cs[i] = c / (1.0f + expf(-c)); } __syncthreads(); loaded = true; }
                const int col = it * 32 + (lane & 31), ksub = (lane >> 5) + 2 * wave;
                float accb[NB];
#pragma unroll
                for (int b = 0; b < NB; ++b) accb[b] = 0.f;
#pragma unroll 8
                for (int i = 0; i < 64; ++i) { const int k = ksub + 16 * i; const float w = w_ada[(size_t)k * (6 * D) + col];
#pragma unroll
                    for (int b = 0; b < NB; ++b) accb[b] += cs[b * D + k] * w; }
#pragma unroll
                for (int b = 0; b < NB; ++b) red[(ksub * NB + b) * 32 + (lane & 31)] = accb[b];
                __syncthreads();
                if (tid < NB * 32) { const int b = tid >> 5, c = tid & 31; float s = 0.f;
#pragma unroll
                    for (int q = 0; q < 16; ++q) s += red[(q * NB + b) * 32 + c];
                    MOD[(size_t)b * 6 * D + it * 32 + c] = s + b_ada[it * 32 + c]; }
                __syncthreads();
            }
            __syncthreads();
        }
    }
    GRID_BAR();
#endif

#if DBG_STAGE != 1
    asm volatile("; PHASE_MARK P0b" ::: "memory");
    {
        PHASE_IDS();
        const float* x = KIN(0); const float* g_mix = KIN(4); const float* MOD = WSP(float, WS_MOD); bf16* UBUF = (bf16*)OUTP();
        const float* Ere = WSP(float, WS_ETAB); const float* Eim = Ere + NG * LC * NP * 16; bf16* BtY = WSP(bf16, WS_BTY); bf16* BtP = WSP(bf16, WS_BTP);
        const float* sc_re = KIN(11); const float* sc_im = KIN(12); const float* log_dt = KIN(14); const float* a_re = KIN(7); const float* a_im = KIN(8);
        for (int blk = gw; blk < T / 16; blk += NGW) {
            const int row0 = blk * 16, b = row0 / SEQ; const float* md = MOD + (size_t)b * 6 * D;
            f32x4 av[4], sv[4];
#pragma unroll
            for (int j = 0; j < 4; ++j) { const int c = 4 * lane + 256 * j; const f32x4 g = *(const f32x4*)(g_mix + c), sc = *(const f32x4*)(md + D + c); av[j] = g * (sc + 1.0f); sv[j] = *(const f32x4*)(md + c); }
            for (int r = 0; r < 16; ++r) {
                const float* xr = x + (size_t)(row0 + r) * D; f32x4 v[4]; float ss = 0.f;
#pragma unroll
                for (int j = 0; j < 4; ++j) { v[j] = *(const f32x4*)(xr + 4 * lane + 256 * j); ss += (v[j][0] * v[j][0] + v[j][1] * v[j][1]) + (v[j][2] * v[j][2] + v[j][3] * v[j][3]); }
                const float rstd = 1.0f / sqrtf(wave_sum(ss, lane) * (1.0f / D) + EPS);
                bf16* ur = UBUF + (size_t)(row0 + r) * D;
#pragma unroll
                for (int j = 0; j < 4; ++j) { const f32x4 o = v[j] * rstd * av[j] + sv[j]; *(GAS v2u*)(ur + 4 * lane + 256 * j) = (v2u){pk2(o[0], o[1]), pk2(o[2], o[3])}; }
            }
        }
        for (int idx = gt; idx < NG * LC * 16 * 2; idx += NGT) {
            const int cih = idx & 1, co = (idx >> 1) & 15, j = (idx >> 5) % LC, g = idx / (32 * LC);
            float kv[8];
#pragma unroll
            for (int i = 0; i < 8; ++i) kv[i] = 0.f;
            const float* er = Ere + (size_t)((g * LC + j) * NP) * 16 + cih * 8; const float* ei = Eim + (size_t)((g * LC + j) * NP) * 16 + cih * 8;
            const float* cr = sc_re + (size_t)(g * 16 + co) * NP; const float* ci_ = sc_im + (size_t)(g * 16 + co) * NP;
            for (int p = 0; p < NP; ++p) { const float c_r = cr[p], c_i = ci_[p]; const f32x4 e0 = *(const f32x4*)(er + p * 16), e1 = *(const f32x4*)(er + p * 16 + 4), f0 = *(const f32x4*)(ei + p * 16), f1 = *(const f32x4*)(ei + p * 16 + 4);
#pragma unroll
                for (int i = 0; i < 4; ++i) { kv[i] += c_r * e0[i] - c_i * f0[i]; kv[4 + i] += c_r * e1[i] - c_i * f1[i]; } }
            const v4u kw = (v4u){pk2(kv[0], kv[1]), pk2(kv[2], kv[3]), pk2(kv[4], kv[5]), pk2(kv[6], kv[7])};
            bf16* base = BtY + (size_t)g * 512 * KY;
            for (int t = j; t < LC; ++t) *(GAS v4u*)(base + (size_t)(t * 16 + co) * KY + (t - j) * 16 + cih * 8) = kw;
            if (j >= 1) for (int t = 0; t + j < LC; ++t) *(GAS v4u*)(base + (size_t)(t * 16 + co) * KY + (t + j) * 16 + cih * 8) = (v4u){0u, 0u, 0u, 0u};
        }
        for (int idx = gt; idx < NG * LC * NP; idx += NGT) {
            const int p = idx % NP, t = (idx / NP) % LC, g = idx / (NP * LC);
            const float dt = expf(log_dt[g]); float ar, ai; abar_pow(a_re[g * NP + p], a_im[g * NP + p], dt, (float)(t + 1), ar, ai);
#pragma unroll
            for (int co = 0; co < 16; ++co) { const float c_r = sc_re[(size_t)(g * 16 + co) * NP + p], c_i = sc_im[(size_t)(g * 16 + co) * NP + p];
                bf16* rowp = BtY + (size_t)(g * 512 + t * 16 + co) * KY;
                rowp[512 + p] = (bf16)f2bf(c_r * ar - c_i * ai); rowp[576 + p] = (bf16)f2bf(-(c_r * ai + c_i * ar)); }
        }
        for (int idx = gt; idx < NG * 128 * LC; idx += NGT) {
            const int s = idx % LC, nn = (idx / LC) % 128, g = idx / (LC * 128); const int p = nn & 63, im = nn >> 6;
            const float* src = (im ? Eim : Ere) + (size_t)((g * LC + (LC - 1 - s)) * NP + p) * 16;
            unsigned hw[8], lw[8];
#pragma unroll
            for (int i = 0; i < 8; ++i) { const float f0 = src[2 * i], f1 = src[2 * i + 1]; const unsigned h0 = f2bf(f0), h1 = f2bf(f1); hw[i] = h0 | (h1 << 16); lw[i] = pk2(f0 - bf2f(h0), f1 - bf2f(h1)); }
            bf16* d0 = BtP + (size_t)(g * 256 + nn) * KS + s * 16; bf16* d1 = BtP + (size_t)(g * 256 + 128 + nn) * KS + s * 16;
            *(GAS v4u*)d0 = (v4u){hw[0], hw[1], hw[2], hw[3]}; *(GAS v4u*)(d0 + 8) = (v4u){hw[4], hw[5], hw[6], hw[7]};
            *(GAS v4u*)d1 = (v4u){lw[0], lw[1], lw[2], lw[3]}; *(GAS v4u*)(d1 + 8) = (v4u){lw[4], lw[5], lw[6], lw[7]};
        }
    }
    GRID_BAR();

    asm volatile("; PHASE_MARK P1" ::: "memory");
    {
        PHASE_IDS();
        pg8::StaticOrder S; S.init(OUTP(), D, WSP(bf16, WS_WIN), D, T, INW, G, bx);
        pg8::EpiProj E{KIN(6), WSP(bf16, WS_UG), WSP(bf16, WS_Q), WSP(bf16, WS_K), WSP(bf16, WS_V), WSP(bf16, WS_GATES), attn_body::C2};
        pg8::gemm_phase<pg8::EpiProj, pg8::StaticOrder, true, true>(L + RING_OFF, D, D, D, S, E);
    }
    GRID_BAR();

    asm volatile("; PHASE_MARK P2" ::: "memory");
    {
        PHASE_IDS();
        pg8::GroupOrder S; S.init(WSP(bf16, WS_UG), KY, (size_t)NRC * KY * 2, WSP(bf16, WS_BTP), KS, (size_t)256 * KS * 2, NRC, 256, NG, G, bx);
        pg8::EpiStates E{WSP(float, WS_SLOC)};
        pg8::gemm_phase<pg8::EpiStates, pg8::GroupOrder, true, true>(L + RING_OFF, KS, KY, KS, S, E);
    }
    GRID_BAR();

    asm volatile("; PHASE_MARK P3" ::: "memory");
    {
        PHASE_IDS();
        const float* log_dt = KIN(14); const float* a_re = KIN(7); const float* a_im = KIN(8); const float* SLOC = WSP(float, WS_SLOC); bf16* UG = WSP(bf16, WS_UG);
        LAS float* seg = (LAS float*)(L + RING_OFF);
        for (int bg = vcu; bg < NB * NG; bg += G) {
            const int b = bg / NG, g = bg % NG, p = lane;
            const float dt = expf(log_dt[g]), lr = a_re[g * NP + p], li = a_im[g * NP + p];
            float alr, ali; abar_pow(lr, li, dt, (float)LC, alr, ali);
            constexpr int SEGC = NCH / NWAVES;
            float locr[SEGC], loci[SEGC]; float cr = 0.f, ci = 0.f;
            const float* sp = SLOC + ((size_t)(g * NRC + b * NCH + wave * SEGC)) * 128;
#pragma unroll
            for (int k = 0; k < SEGC; ++k) { locr[k] = cr; loci[k] = ci; const float sr = sp[k * 128 + p], si = sp[k * 128 + 64 + p]; const float nr = alr * cr - ali * ci + sr, ni = alr * ci + ali * cr + si; cr = nr; ci = ni; }
            __syncthreads();
            seg[(wave * 64 + p) * 2] = cr; seg[(wave * 64 + p) * 2 + 1] = ci;
            __syncthreads();
            float a16r = alr, a16i = ali;
#pragma unroll
            for (int q = 0; q < 4; ++q) { const float nr = a16r * a16r - a16i * a16i, ni = 2.f * a16r * a16i; a16r = nr; a16i = ni; }
            float inr = 0.f, ini = 0.f;
            for (int w = 0; w < wave; ++w) { const float er = seg[(w * 64 + p) * 2], ei = seg[(w * 64 + p) * 2 + 1]; const float nr = a16r * inr - a16i * ini + er, ni = a16r * ini + a16i * inr + ei; inr = nr; ini = ni; }
            bf16* up = UG + ((size_t)(g * NRC + b * NCH + wave * SEGC)) * KY + KS;
#pragma unroll
            for (int k = 0; k < SEGC; ++k) { up[(size_t)k * KY + p] = (bf16)f2bf(inr + locr[k]); up[(size_t)k * KY + 64 + p] = (bf16)f2bf(ini + loci[k]); const float nr = alr * inr - ali * ini, ni = alr * ini + ali * inr; inr = nr; ini = ni; }
        }
        __syncthreads();
        const char* wsb = (const char*)karg(35);
        const float* lq1 = KIN(17); const float* lk1 = KIN(18); const float* lq2 = KIN(19); const float* lk2 = KIN(20); const float* g_subln = KIN(21);
        const float lam = expf(wave_sum(lq1[lane] * lk1[lane], lane)) - expf(wave_sum(lq2[lane] * lk2[lane], lane)) + LAMBDA_INIT;
        LAS float* gsl = (LAS float*)(L + GS_OFF);
        if (tid < 128) gsl[tid] = g_subln[tid] * (1.0f - LAMBDA_INIT);
        __syncthreads();
        for (int un = vcu; un < NB * 8 * 4; un += G) {
            const int s4 = un & 3, h = (un >> 2) & 7, b = un >> 5;
#pragma unroll 1
            for (int i = 0; i < 4; ++i) { const int qb = (i == 0) ? 15 - s4 : (i == 1) ? 8 + s4 : (i == 2) ? 7 - s4 : s4;
                attn_body::attn_unit<8, WS_Q, WS_K, WS_V, GS_OFF - RING_OFF>(b, h, qb, wsb, (attn_body::bf16*)OUTP(), lam, (char*)lds + RING_OFF); }
        }
    }
    GRID_BAR();

    asm volatile("; PHASE_MARK P4" ::: "memory");
    {
        PHASE_IDS();
        pg8::GroupOrder S; S.init(WSP(bf16, WS_UG), KY, (size_t)NRC * KY * 2, WSP(bf16, WS_BTY), KY, (size_t)512 * KY * 2, NRC, 512, NG, G, bx);
        pg8::EpiY E{WSP(bf16, WS_UG), KIN(13), WSP(bf16, WS_YACT)};
        pg8::gemm_phase<pg8::EpiY, pg8::GroupOrder, true, true>(L + RING_OFF, KY, KY, KY, S, E);
    }
    GRID_BAR();

    asm volatile("; PHASE_MARK P5" ::: "memory");
    {
        PHASE_IDS();
        pg8::StaticOrder S; S.init(WSP(bf16, WS_YACT), S5W, WSP(bf16, WS_WGLU), S5W, T, S5W, G, bx);
        pg8::EpiGlu E{WSP(bf16, WS_YACT), KIN(16), WSP(bf16, WS_S5O)};
        pg8::gemm_phase<pg8::EpiGlu, pg8::StaticOrder, true, true>(L + RING_OFF, S5W, S5W, S5W, S, E);
    }
    GRID_BAR();

    asm volatile("; PHASE_MARK P6" ::: "memory");
    {
        PHASE_IDS();
        pg8::StaticOrder S; S.init(WSP(bf16, WS_S5O), S5W, WSP(bf16, WS_WSSM), S5W, T, D, G, bx);
        pg8::EpiBranch<0> E{WSP(bf16, WS_GATES), nullptr, WSP(bf16, WS_TMP)};
        pg8::gemm_phase<pg8::EpiBranch<0>, pg8::StaticOrder, true, true>(L + RING_OFF, S5W, S5W, S5W, S, E);
    }
    VM_WAIT(); __syncthreads();
    {
        PHASE_IDS();
        pg8::StaticOrder S; S.init(OUTP(), D, WSP(bf16, WS_WATT), D, T, D, G, bx);
        pg8::EpiBranch<1> E{WSP(bf16, WS_GATES), WSP(bf16, WS_TMP), (bf16*)OUTP() + (size_t)T * D};
        pg8::gemm_phase<pg8::EpiBranch<1>, pg8::StaticOrder, true, true>(L + RING_OFF, D, D, D, S, E);
    }
    GRID_BAR();

    asm volatile("; PHASE_MARK P8" ::: "memory");
    {
        PHASE_IDS();
        pg8::StaticOrder S; S.init((bf16*)OUTP() + (size_t)T * D, D, WSP(bf16, WS_WOUT), D, T, D, G, bx);
        pg8::EpiOut E{KIN(0), WSP(float, WS_MOD), WSP(bf16, WS_H)};
        pg8::gemm_phase<pg8::EpiOut, pg8::StaticOrder, true, true>(L + RING_OFF, D, D, D, S, E);
    }
    GRID_BAR();
#endif

#if DBG_STAGE == 0
    asm volatile("; PHASE_MARK P9" ::: "memory");
    {
        PHASE_IDS();
        const float* g_ffn = KIN(25); const float* MOD = WSP(float, WS_MOD); const bf16* Hbuf = WSP(bf16, WS_H); bf16* U2 = (bf16*)OUTP();
        const bf16* WRh = WSP(bf16, WS_WR); const bf16* WRl = WRh + 64 * D;
        const float* b_rg = KIN(27); const float* b_re = KIN(29); int* CNT = WSP(int, WS_CTL) + CW_CNT; int* LIST = WSP(int, WS_LIST); float* CWL = WSP(float, WS_CWL);
        constexpr int APITCH = 1032;
        LAS bf16* AH = (LAS bf16*)(L + RING_OFF); LAS bf16* AL = AH + 16 * APITCH;
        LAS float* PART = (LAS float*)(L + RING_OFF + 2 * 16 * APITCH * 2);
        LAS float* LG = PART + 8 * 256;
        LAS int* lcnt = (LAS int*)(LG + 16 * 64); LAS int* lbase = lcnt + NEXP; LAS int* TOK = lbase + NEXP;
        const int per = T / G, t0 = bx * per, b = t0 / SEQ;
        const float* md = MOD + (size_t)b * 6 * D;
        f32x4 av[4], sv[4];
#pragma unroll
        for (int j = 0; j < 4; ++j) { const int c = 4 * lane + 256 * j; const f32x4 g = *(const f32x4*)(g_ffn + c), sc = *(const f32x4*)(md + 4 * D + c); av[j] = g * (sc + 1.0f); sv[j] = *(const f32x4*)(md + 3 * D + c); }
        const int cb = wave & 3, kh = wave >> 2, fr = lane & 15, fq = lane >> 4;
        pg8::bf16x8 bh[16], bl[16];
#pragma unroll
        for (int ks = 0; ks < 16; ++ks) { const size_t o = (size_t)(cb * 16 + fr) * D + kh * 512 + ks * 32 + fq * 8; bh[ks] = *(const pg8::bf16x8*)(WRh + o); bl[ks] = *(const pg8::bf16x8*)(WRl + o); }
        if (tid < NEXP) lcnt[tid] = 0;
        for (int c = 0; c < per / 16; ++c) {
#pragma unroll
            for (int rr = 0; rr < 2; ++rr) {
                const int r = 2 * wave + rr, tok = t0 + c * 16 + r;
                const bf16* hr = Hbuf + (size_t)tok * D; f32x4 v[4]; float ss = 0.f;
#pragma unroll
                for (int j = 0; j < 4; ++j) { const v2u hw = *(const GAS v2u*)(hr + 4 * lane + 256 * j); v[j] = (f32x4){pg8::bf_lo(hw.x), pg8::bf_hi(hw.x), pg8::bf_lo(hw.y), pg8::bf_hi(hw.y)}; ss += (v[j][0] * v[j][0] + v[j][1] * v[j][1]) + (v[j][2] * v[j][2] + v[j][3] * v[j][3]); }
                const float rstd = 1.0f / sqrtf(wave_sum(ss, lane) * (1.0f / D) + EPS);
                bf16* ur = U2 + (size_t)tok * D;
#pragma unroll
                for (int j = 0; j < 4; ++j) { const f32x4 o = v[j] * rstd * av[j] + sv[j];
                    const unsigned h0 = f2bf(o[0]), h1 = f2bf(o[1]), h2 = f2bf(o[2]), h3 = f2bf(o[3]);
                    const v2u hv = (v2u){h0 | (h1 << 16), h2 | (h3 << 16)}, lv = (v2u){pk2(o[0] - bf2f(h0), o[1] - bf2f(h1)), pk2(o[2] - bf2f(h2), o[3] - bf2f(h3))};
                    *(GAS v2u*)(ur + 4 * lane + 256 * j) = hv;
                    *(LAS v2u*)(AH + r * APITCH + 4 * lane + 256 * j) = hv; *(LAS v2u*)(AL + r * APITCH + 4 * lane + 256 * j) = lv; }
            }
            __syncthreads();
            { pg8::f32x4 acc = (pg8::f32x4){0.f, 0.f, 0.f, 0.f};
#pragma unroll
              for (int ks = 0; ks < 16; ++ks) { const int ko = fr * APITCH + kh * 512 + ks * 32 + fq * 8;
                  const pg8::bf16x8 ah = *(const LAS pg8::bf16x8*)(AH + ko), al = *(const LAS pg8::bf16x8*)(AL + ko);
                  acc = __builtin_amdgcn_mfma_f32_16x16x32_bf16(ah, bh[ks], acc, 0, 0, 0);
                  acc = __builtin_amdgcn_mfma_f32_16x16x32_bf16(al, bh[ks], acc, 0, 0, 0);
                  acc = __builtin_amdgcn_mfma_f32_16x16x32_bf16(ah, bl[ks], acc, 0, 0, 0); }
#pragma unroll
              for (int i = 0; i < 4; ++i) PART[wave * 256 + (fq * 4 + i) * 16 + fr] = acc[i]; }
            __syncthreads();
#pragma unroll
            for (int i = 0; i < 2; ++i) { const int o = tid * 2 + i, row = o >> 6, col = o & 63, cbb = col >> 4; LG[o] = PART[cbb * 256 + row * 16 + (col & 15)] + PART[(4 + cbb) * 256 + row * 16 + (col & 15)]; }
            __syncthreads();
            if (tid < 16) {
                const LAS float* lg = LG + tid * 64;
                float gl[4]; int gi = 0;
#pragma unroll
                for (int i = 0; i < 4; ++i) gl[i] = lg[i] + b_rg[i];
#pragma unroll
                for (int i = 1; i < 4; ++i) if (gl[i] > gl[gi]) gi = i;
                float gsum = 0.f;
#pragma unroll
                for (int i = 0; i < 4; ++i) gsum += expf(gl[i] - gl[gi]);
                const float gp = 1.0f / gsum;
                float el[8];
#pragma unroll
                for (int i = 0; i < 8; ++i) el[i] = lg[4 + gi * 8 + i] + b_re[gi * 8 + i];
                int i0 = 0;
#pragma unroll
                for (int i = 1; i < 8; ++i) if (el[i] > el[i0]) i0 = i;
                int i1 = (i0 == 0) ? 1 : 0;
#pragma unroll
                for (int i = 0; i < 8; ++i) if (i != i0 && el[i] > el[i1]) i1 = i;
                const float ex = expf(el[i1] - el[i0]);
                const float w0 = gp / (1.0f + ex), w1 = gp * ex / (1.0f + ex);
                const int e0 = gi * 8 + i0, e1 = gi * 8 + i1;
                const int p0 = atomicAdd((int*)(lds + ((char*)&lcnt[e0] - (char*)L)), 1), p1 = atomicAdd((int*)(lds + ((char*)&lcnt[e1] - (char*)L)), 1);
                LAS int* tk = TOK + (c * 16 + tid) * 6; tk[0] = e0; tk[1] = p0; tk[2] = __float_as_int(w0); tk[3] = e1; tk[4] = p1; tk[5] = __float_as_int(w1);
            }
        }
        __syncthreads();
        if (tid < NEXP) lbase[tid] = atomicAdd(&CNT[tid], lcnt[tid]);
        __syncthreads();
        if (tid < per) { const LAS int* tk = TOK + tid * 6; const int tok = t0 + tid;
            const size_t i0 = (size_t)tk[0] * T + lbase[tk[0]] + tk[1], i1 = (size_t)tk[3] * T + lbase[tk[3]] + tk[4];
            LIST[i0] = tok * 2; CWL[i0] = __int_as_float(tk[2]); LIST[i1] = tok * 2 + 1; CWL[i1] = __int_as_float(tk[5]); }
        __syncthreads();
    }
    GRID_BAR();

    asm volatile("; PHASE_MARK P13" ::: "memory");
    {
        PHASE_IDS();
        const int* CNT = WSP(int, WS_CTL) + CW_CNT; const int* LIST = WSP(int, WS_LIST);
        build_expert_table(L, CNT, tid);
        pg8::ExpertOrder S; S.init((const LAS int*)(L + ETAB_OFF), OUTP(), 0, WSP(bf16, WS_WE1), D, (size_t)512 * D * 2, 512, G, bx);
        LAS int* rowtab = (LAS int*)(L + ROWTAB_OFF);
        { pg8::Unit u;
#pragma unroll 1
          for (int i = 0; i < 4 && S.next(i, u); ++i) { const int n = CNT[u.g];
              for (int r = tid; r < 256; r += NWAVES * 64) { const int pos = u.lt * 256 + r; rowtab[i * 256 + r] = (pos < n) ? (LIST[(size_t)u.g * T + pos] >> 1) : 0; } }
          __syncthreads(); }
        pg8::EpiExp1 E{WSP(bf16, WS_HDN)};
        pg8::gemm_phase<pg8::EpiExp1, pg8::ExpertOrder, true, true, true>(L + RING_OFF, D, D, D, S, E, (const LAS int*)rowtab);
    }
    GRID_BAR();

    asm volatile("; PHASE_MARK P14" ::: "memory");
    {
        PHASE_IDS();
        build_expert_table(L, WSP(int, WS_CTL) + CW_CNT, tid);
        pg8::ExpertOrder S; S.init((const LAS int*)(L + ETAB_OFF), WSP(bf16, WS_HDN), (size_t)256 * DEXP * 2, WSP(bf16, WS_WE2), DEXP, (size_t)D * DEXP * 2, D, G, bx);
        pg8::EpiExp2 E{WSP(int, WS_LIST), WSP(float, WS_CWL), WSP(int, WS_CTL) + CW_CNT, WSP(bf16, WS_SLOTS)};
        pg8::gemm_phase<pg8::EpiExp2, pg8::ExpertOrder, true, true>(L + RING_OFF, DEXP, DEXP, DEXP, S, E);
    }
    GRID_BAR();
#endif

    asm volatile("; PHASE_MARK P15" ::: "memory");
    {
        PHASE_IDS();
        const float* x = KIN(0); const float* g_final = KIN(33); const bf16* Hbuf = WSP(bf16, WS_H); const float* MOD = WSP(float, WS_MOD); const bf16* SLOTS = WSP(bf16, WS_SLOTS); float* out = OUTP();
        (void)x; (void)Hbuf; (void)MOD; (void)SLOTS;
        for (int row = gw; row < T; row += NGW) {
            const int b = row / SEQ; f32x4 v[4]; float ss = 0.f;
#pragma unroll
            for (int j = 0; j < 4; ++j) { const int c = 4 * lane + 256 * j;
#if DBG_STAGE == 1
                v[j] = *(const f32x4*)(x + (size_t)row * D + c);
#else
                { const v2u hw = *(const GAS v2u*)(Hbuf + (size_t)row * D + c); v[j] = (f32x4){pg8::bf_lo(hw.x), pg8::bf_hi(hw.x), pg8::bf_lo(hw.y), pg8::bf_hi(hw.y)}; }
#endif
#if DBG_STAGE == 0
                const f32x4 gt = *(const f32x4*)(MOD + (size_t)b * 6 * D + 5 * D + c);
                const v2u s0 = *(const GAS v2u*)(SLOTS + (size_t)(2 * row) * D + c), s1 = *(const GAS v2u*)(SLOTS + (size_t)(2 * row + 1) * D + c);
                const f32x4 f = (f32x4){pg8::bf_lo(s0.x) + pg8::bf_lo(s1.x), pg8::bf_hi(s0.x) + pg8::bf_hi(s1.x), pg8::bf_lo(s0.y) + pg8::bf_lo(s1.y), pg8::bf_hi(s0.y) + pg8::bf_hi(s1.y)};
                v[j] = v[j] + gt * f;
#endif
                ss += (v[j][0] * v[j][0] + v[j][1] * v[j][1]) + (v[j][2] * v[j][2] + v[j][3] * v[j][3]); }
            (void)b;
            const float rstd = 1.0f / sqrtf(wave_sum(ss, lane) * (1.0f / D) + EPS);
#pragma unroll
            for (int j = 0; j < 4; ++j) { const int c = 4 * lane + 256 * j; const f32x4 g = *(const f32x4*)(g_final + c); *(f32x4*)(out + (size_t)row * D + c) = v[j] * rstd * g; }
        }
    }
}

extern "C" void kernel_launch(void* const* d_in, const int* in_sizes, int n_in, void* d_out, int out_size, void* d_ws, size_t ws_size, hipStream_t stream) {
    static int grid = 0;
    if (grid == 0) {
        if (n_in != 34 || out_size != T * D || ws_size < WS_END) { fprintf(stderr, "kernel_launch: unexpected shapes (n_in %d, out %d, ws %zu)\n", n_in, out_size, ws_size); grid = -1; return; }
        int dev = 0, cus = 0, per_cu = 0;
        if (hipGetDevice(&dev) != hipSuccess || hipDeviceGetAttribute(&cus, hipDeviceAttributeMultiprocessorCount, dev) != hipSuccess) { grid = -1; return; }
        if (hipFuncSetAttribute((const void*)fwd_kernel, hipFuncAttributeMaxDynamicSharedMemorySize, LDS_BYTES) != hipSuccess) { fprintf(stderr, "kernel_launch: hipFuncSetAttribute failed\n"); grid = -1; return; }
        if (hipOccupancyMaxActiveBlocksPerMultiprocessor(&per_cu, (const void*)fwd_kernel, NWAVES * 64, LDS_BYTES) != hipSuccess || per_cu < 1)
            fprintf(stderr, "kernel_launch: note: occupancy query reports %d workgroups per CU\n", per_cu);
        (void)hipGetLastError();
        grid = cus;
    }
    if (grid < 0) return;
    if (hipMemsetAsync((char*)d_ws + WS_CTL, 0, CTL_ZERO_BYTES, stream) != hipSuccess) { fprintf(stderr, "kernel_launch: memset failed\n"); return; }
    Args a{};
    for (int i = 0; i < 34; ++i) a.in[i] = (const float*)d_in[i];
    a.out = (float*)d_out; a.ws = (unsigned char*)d_ws;
    hipLaunchKernelGGL(fwd_kernel, dim3(grid), dim3(NWAVES * 64), LDS_BYTES, stream, a);
    const hipError_t le = hipPeekAtLastError();
    if (le != hipSuccess) fprintf(stderr, "kernel_launch: launch failed: %s\n", hipGetErrorName(le));
}
```

```cpp
#include <hip/hip_runtime.h>
#include <hip/hip_bf16.h>
#include <cstdio>
#include <cstdint>
#include <cmath>

#ifndef DBG_STAGE
#define DBG_STAGE 0
#endif

constexpr int D = 1024, NB = 8, SEQ = 4096, T = NB * SEQ;
constexpr int S5W = 512, NG = 32, NP = 64, INW = 5632;
constexpr int LC = 32, NCH = SEQ / LC, NRC = T / LC, KS = LC * 16, KY = KS + 128;
constexpr int NEXP = 32, DEXP = 256;
constexpr int XS_ROWS = 2 * T + NEXP * 256;
constexpr float EPS = 1e-6f;
constexpr float LAMBDA_INIT = 0.2f;

namespace pg8 {
#define PG8_LAS __attribute__((address_space(3)))
typedef unsigned short bf16_t;
typedef short bf16x8 __attribute__((ext_vector_type(8)));
typedef float f32x4 __attribute__((ext_vector_type(4)));
typedef unsigned u32x4 __attribute__((ext_vector_type(4)));
typedef float f32x2 __attribute__((ext_vector_type(2)));
constexpr int BM = 256, BK = 64, HALF = 128, HTB = HALF * BK * 2, STAGE_BYTES = 8 * HTB, NXCD = 8, WGM = 8;

__host__ __device__ __forceinline__ int lds_byte(int r, int c) { const int st = (r >> 4) * 2 + (c >> 5), rr = r & 15, cc = c & 31, ob = rr * 64 + cc * 2; return st * 1024 + (ob ^ (((ob >> 9) & 1) << 5)); }
__host__ __device__ __forceinline__ void stage_rc(int b, int& R, int& C) { const int st = b / 1024, sb = b % 1024, swz = sb ^ (((sb >> 9) & 1) << 5); R = (st >> 1) * 16 + swz / 64; C = (st & 1) * 32 + (swz % 64) / 2; }
__host__ __device__ __forceinline__ int perm32(int rho) { const int n = rho >> 4, i = rho & 15; return 8 * (i >> 2) + 4 * n + (i & 3); }

struct Unit { int pm, pn, g, lt; const char* a; const char* b; };

struct StaticOrder {
    int nM, nN, nwg, G, c; const char* A; const char* B; size_t tsa, tsb;
    __device__ void init(const void* A_, int lda, const void* B_, int ldb, int M, int N, int G_, int c_) { nM = M / BM; nN = N / BM; nwg = nM * nN; G = G_; c = c_; A = (const char*)A_; B = (const char*)B_; tsa = (size_t)BM * lda * 2; tsb = (size_t)BM * ldb * 2; }
    __device__ bool next(int i, Unit& u) const {
        const long L = (long)i * G + c; if (L >= nwg) return false;
        int wgid = (int)L; { const int q = nwg / NXCD, r = nwg % NXCD, xcd = wgid % NXCD, off = wgid / NXCD; wgid = (xcd < r ? xcd * (q + 1) : r * (q + 1) + (xcd - r) * q) + off; }
        const int nig = WGM * nN, gid = wgid / nig, fm = gid * WGM, gsz = (nM - fm) < WGM ? (nM - fm) : WGM;
        u.pm = fm + ((wgid % nig) % gsz); u.pn = (wgid % nig) / gsz; u.g = 0; u.lt = 0; u.a = A + (size_t)u.pm * tsa; u.b = B + (size_t)u.pn * tsb; return true;
    }
};
struct GroupOrder {
    int nM, nN, ng, G, c; const char* A; const char* B; size_t tsa, tsb, gsa, gsb;
    __device__ void init(const void* A_, int lda, size_t gsa_, const void* B_, int ldb, size_t gsb_, int Mg, int Ng, int ng_, int G_, int c_) {
        nM = Mg / BM; nN = Ng / BM; ng = ng_; G = G_; c = c_; A = (const char*)A_; B = (const char*)B_; tsa = (size_t)BM * lda * 2; tsb = (size_t)BM * ldb * 2; gsa = gsa_; gsb = gsb_; }
    __device__ bool next(int i, Unit& u) const {
        const long L = (long)i * G + c; if (L >= (long)ng * nM * nN) return false;
        const int per = nM * nN, g = (int)(L / per), r = (int)(L % per);
        u.g = g; u.lt = 0; u.pm = r / nN; u.pn = r % nN; u.a = A + (size_t)g * gsa + (size_t)u.pm * tsa; u.b = B + (size_t)g * gsb + (size_t)u.pn * tsb; return true;
    }
};
struct ExpertOrder {
    const PG8_LAS int* tab; int nN, G, c; const char* A; const char* B; size_t tsa, tsb, esb;
    __device__ void init(const PG8_LAS int* tab_, const void* A_, size_t tsa_, const void* B_, int ldb, size_t esb_, int N, int G_, int c_) {
        tab = tab_; nN = N / BM; G = G_; c = c_; A = (const char*)A_; B = (const char*)B_; tsa = tsa_; tsb = (size_t)BM * ldb * 2; esb = esb_; }
    __device__ bool next(int i, Unit& u) const {
        const long L = (long)i * G + c; int rt = (int)(L / nN); const int pn = (int)(L % nN);
        if (rt > XS_ROWS / 256) rt = XS_ROWS / 256;
        const int e = __builtin_amdgcn_readfirstlane(tab[rt]);
        if (e < 0) return false;
        u.g = e & 255; u.lt = e >> 8; u.pm = rt; u.pn = pn; u.a = A + (size_t)rt * tsa; u.b = B + (size_t)u.g * esb + (size_t)pn * tsb; return true;
    }
};

__device__ __forceinline__ unsigned cvt_pk_bf16(float lo, float hi) { unsigned r; asm volatile("v_cvt_pk_bf16_f32 %0, %1, %2" : "=v"(r) : "v"(lo), "v"(hi)); return r; }
__device__ __forceinline__ float bf_lo(unsigned w) { return __uint_as_float(w << 16); }
__device__ __forceinline__ float bf_hi(unsigned w) { return __uint_as_float(w & 0xffff0000u); }
__device__ __forceinline__ float sigmoidf_(float x) { return __builtin_amdgcn_rcpf(1.0f + __builtin_amdgcn_exp2f(-1.4426950408889634f * x)); }
__device__ __forceinline__ void unpack8(const u32x4 w, float (&f)[8]) { f[0] = bf_lo(w.x); f[1] = bf_hi(w.x); f[2] = bf_lo(w.y); f[3] = bf_hi(w.y); f[4] = bf_lo(w.z); f[5] = bf_hi(w.z); f[6] = bf_lo(w.w); f[7] = bf_hi(w.w); }
__device__ __forceinline__ u32x4 pack8(const float (&f)[8]) { u32x4 w; w.x = cvt_pk_bf16(f[0], f[1]); w.y = cvt_pk_bf16(f[2], f[3]); w.z = cvt_pk_bf16(f[4], f[5]); w.w = cvt_pk_bf16(f[6], f[7]); return w; }

#define EPI_LOOP_PERM(...) \
    _Pragma("unroll") for (int ai = 0; ai < 2; ++ai) _Pragma("unroll") for (int m = 0; m < 4; ++m) { const int lrow = ai * HALF + wr * 64 + m * 16 + fr; \
        _Pragma("unroll") for (int bj = 0; bj < 2; ++bj) { const int lcol = bj * HALF + wc * 32 + 8 * fq; \
            float v[8] = {acc[ai][bj][m][0][0], acc[ai][bj][m][0][1], acc[ai][bj][m][0][2], acc[ai][bj][m][0][3], acc[ai][bj][m][1][0], acc[ai][bj][m][1][1], acc[ai][bj][m][1][2], acc[ai][bj][m][1][3]}; __VA_ARGS__ } }

#define EPI_HALF_PRE(...) _Pragma("unroll") for (int m = 0; m < 4; ++m) { const int lrow = ai * HALF + wr * 64 + m * 16 + fr; (void)lrow; \
        _Pragma("unroll") for (int bj = 0; bj < 2; ++bj) { const int lcol = bj * HALF + wc * 32 + 8 * fq; (void)lcol; __VA_ARGS__ } }
#define EPI_HALF_RUN(...) _Pragma("unroll") for (int m = 0; m < 4; ++m) { const int lrow = ai * HALF + wr * 64 + m * 16 + fr; (void)lrow; \
        _Pragma("unroll") for (int bj = 0; bj < 2; ++bj) { const int lcol = bj * HALF + wc * 32 + 8 * fq; (void)lcol; \
            float v[8] = {acc[ai][bj][m][0][0], acc[ai][bj][m][0][1], acc[ai][bj][m][0][2], acc[ai][bj][m][0][3], acc[ai][bj][m][1][0], acc[ai][bj][m][1][1], acc[ai][bj][m][1][2], acc[ai][bj][m][1][3]}; __VA_ARGS__ } }

struct EpiProj {
    static constexpr bool PERM = true, AFTER_DRAIN = false;
    const float* bias; bf16_t* U; bf16_t* Q; bf16_t* Kb; bf16_t* V; bf16_t* Gt; float c2;
    __device__ __forceinline__ void operator()(const f32x4 (&acc)[2][2][4][2], const Unit& u, int wr, int wc, int fr, int fq) const {
        const int ct = u.pn;
        f32x4 bv[2][2];
#pragma unroll
        for (int bj = 0; bj < 2; ++bj) { const int col = ct * BM + bj * HALF + wc * 32 + 8 * fq; bv[bj][0] = *(const f32x4*)(bias + col); bv[bj][1] = *(const f32x4*)(bias + col + 4); }
        EPI_LOOP_PERM({
            const int row = u.pm * BM + lrow, col = ct * BM + lcol;
            v[0] += bv[bj][0][0]; v[1] += bv[bj][0][1]; v[2] += bv[bj][0][2]; v[3] += bv[bj][0][3]; v[4] += bv[bj][1][0]; v[5] += bv[bj][1][1]; v[6] += bv[bj][1][2]; v[7] += bv[bj][1][3];
            bf16_t* dst;
            if (ct < 2) { const int g = col >> 4, ci = col & 15, rc = row / LC, s = row % LC; dst = U + ((size_t)(g * NRC + rc) * KY + s * 16 + ci); }
            else if (ct < 6) { _Pragma("unroll") for (int i = 0; i < 8; ++i) v[i] *= c2; dst = Q + (size_t)row * D + (col - 512); }
            else if (ct < 10) { dst = Kb + (size_t)row * D + (col - 1536); }
            else if (ct < 14) { dst = V + (size_t)row * D + (col - 2560); }
            else { _Pragma("unroll") for (int i = 0; i < 8; ++i) v[i] = sigmoidf_(v[i]); dst = Gt + (size_t)row * 2048 + (col - 3584); }
            *(u32x4*)dst = pack8(v);
        })
    }
};
struct EpiStates {
    static constexpr bool PERM = false, AFTER_DRAIN = false;
    float* S;
    __device__ __forceinline__ void operator()(const f32x4 (&acc)[2][2][4][2], const Unit& u, int wr, int wc, int fr, int fq) const {
#pragma unroll
        for (int ai = 0; ai < 2; ++ai)
#pragma unroll
            for (int m = 0; m < 4; ++m) { const int row = u.pm * BM + ai * HALF + wr * 64 + m * 16 + fr;
#pragma unroll
                for (int n = 0; n < 2; ++n) { const f32x4 v = acc[ai][0][m][n] + acc[ai][1][m][n]; *(f32x4*)(S + ((size_t)(u.g * NRC + row) * 128 + wc * 32 + 16 * n + 4 * fq)) = v; } }
    }
};
struct EpiY {
    static constexpr bool PERM = true, AFTER_DRAIN = false;
    const bf16_t* U; const float* dskip; bf16_t* Y;
    __device__ __forceinline__ void operator()(const f32x4 (&acc)[2][2][4][2], const Unit& u, int wr, int wc, int fr, int fq) const {
        f32x4 dk[2][2];
#pragma unroll
        for (int bj = 0; bj < 2; ++bj) { const int co = (bj * HALF + wc * 32 + 8 * fq) & 15; dk[bj][0] = *(const f32x4*)(dskip + u.g * 16 + co); dk[bj][1] = *(const f32x4*)(dskip + u.g * 16 + co + 4); }
#pragma unroll
        for (int ai = 0; ai < 2; ++ai) {
            u32x4 uw[4][2];
            EPI_HALF_PRE({ const int rc = u.pm * BM + lrow, n = u.pn * BM + lcol; uw[m][bj] = *(const u32x4*)(U + ((size_t)(u.g * NRC + rc) * KY + n)); })
            EPI_HALF_RUN({
                const int rc = u.pm * BM + lrow, n = u.pn * BM + lcol, tt = n >> 4, co = n & 15;
                float uf[8]; unpack8(uw[m][bj], uf);
                const float dd[8] = {dk[bj][0][0], dk[bj][0][1], dk[bj][0][2], dk[bj][0][3], dk[bj][1][0], dk[bj][1][1], dk[bj][1][2], dk[bj][1][3]};
                _Pragma("unroll") for (int i = 0; i < 8; ++i) { const float y = v[i] + dd[i] * uf[i]; const float z = 1.5957691216057308f * (y + 0.044715f * y * y * y); v[i] = y * sigmoidf_(z); }
                *(u32x4*)(Y + ((size_t)(rc * LC + tt) * S5W + u.g * 16 + co)) = pack8(v);
            })
        }
    }
};
struct EpiGlu {
    static constexpr bool PERM = true, AFTER_DRAIN = false;
    const bf16_t* Y; const float* bias; bf16_t* O;
    __device__ __forceinline__ void operator()(const f32x4 (&acc)[2][2][4][2], const Unit& u, int wr, int wc, int fr, int fq) const {
        f32x4 bv[2][2];
#pragma unroll
        for (int bj = 0; bj < 2; ++bj) { const int col = u.pn * BM + bj * HALF + wc * 32 + 8 * fq; bv[bj][0] = *(const f32x4*)(bias + col); bv[bj][1] = *(const f32x4*)(bias + col + 4); }
#pragma unroll
        for (int ai = 0; ai < 2; ++ai) {
            u32x4 yw[4][2];
            EPI_HALF_PRE({ const int row = u.pm * BM + lrow, col = u.pn * BM + lcol; yw[m][bj] = *(const u32x4*)(Y + (size_t)row * S5W + col); })
            EPI_HALF_RUN({
                const int row = u.pm * BM + lrow, col = u.pn * BM + lcol;
                float yf[8]; unpack8(yw[m][bj], yf);
                const float bb[8] = {bv[bj][0][0], bv[bj][0][1], bv[bj][0][2], bv[bj][0][3], bv[bj][1][0], bv[bj][1][1], bv[bj][1][2], bv[bj][1][3]};
                _Pragma("unroll") for (int i = 0; i < 8; ++i) v[i] = yf[i] * sigmoidf_(v[i] + bb[i]);
                *(u32x4*)(O + (size_t)row * S5W + col) = pack8(v);
            })
        }
    }
};
template <int MODE> struct EpiBranch {
    static constexpr bool PERM = true, AFTER_DRAIN = false;
    const bf16_t* Gt; const bf16_t* Tin; bf16_t* O;
    __device__ __forceinline__ void operator()(const f32x4 (&acc)[2][2][4][2], const Unit& u, int wr, int wc, int fr, int fq) const {
#pragma unroll
        for (int ai = 0; ai < 2; ++ai) {
            u32x4 gw[4][2], tw[4][2];
            EPI_HALF_PRE({ const int row = u.pm * BM + lrow, col = u.pn * BM + lcol; gw[m][bj] = *(const u32x4*)(Gt + (size_t)row * 2048 + MODE * D + col);
                           if (MODE == 1) tw[m][bj] = *(const u32x4*)(Tin + (size_t)row * D + col); else tw[m][bj] = gw[m][bj]; })
            EPI_HALF_RUN({
                const int row = u.pm * BM + lrow, col = u.pn * BM + lcol;
                float gf[8]; unpack8(gw[m][bj], gf);
                if (MODE == 1) { float tf[8]; unpack8(tw[m][bj], tf);
                    _Pragma("unroll") for (int i = 0; i < 8; ++i) v[i] = tf[i] + gf[i] * v[i]; }
                else { _Pragma("unroll") for (int i = 0; i < 8; ++i) v[i] = gf[i] * v[i]; }
                *(u32x4*)(O + (size_t)row * D + col) = pack8(v);
            })
        }
    }
};
struct EpiOut {
    static constexpr bool PERM = true, AFTER_DRAIN = false;
    const float* x; const float* mod; bf16_t* H;
    __device__ __forceinline__ void operator()(const f32x4 (&acc)[2][2][4][2], const Unit& u, int wr, int wc, int fr, int fq) const {
        const int b = (u.pm * BM) / SEQ; const float* gt = mod + (size_t)b * 6 * D + 2 * D;
        f32x4 gv[2][2];
#pragma unroll
        for (int bj = 0; bj < 2; ++bj) { const int col = u.pn * BM + bj * HALF + wc * 32 + 8 * fq; gv[bj][0] = *(const f32x4*)(gt + col); gv[bj][1] = *(const f32x4*)(gt + col + 4); }
#pragma unroll
        for (int ai = 0; ai < 2; ++ai) {
            f32x4 xv[4][2][2];
            EPI_HALF_PRE({ const size_t off = (size_t)(u.pm * BM + lrow) * D + u.pn * BM + lcol; xv[m][bj][0] = *(const f32x4*)(x + off); xv[m][bj][1] = *(const f32x4*)(x + off + 4); })
            EPI_HALF_RUN({
                const size_t off = (size_t)(u.pm * BM + lrow) * D + u.pn * BM + lcol;
                _Pragma("unroll") for (int i = 0; i < 4; ++i) { v[i] = xv[m][bj][0][i] + gv[bj][0][i] * v[i]; v[4 + i] = xv[m][bj][1][i] + gv[bj][1][i] * v[4 + i]; }
                *(u32x4*)(H + off) = pack8(v);
            })
        }
    }
};
struct EpiRouter {
    static constexpr bool PERM = false, AFTER_DRAIN = false;
    float* L;
    __device__ __forceinline__ void operator()(const f32x4 (&acc)[2][2][4][2], const Unit& u, int wr, int wc, int fr, int fq) const {
        if (wc < 2) {
#pragma unroll
            for (int ai = 0; ai < 2; ++ai)
#pragma unroll
                for (int m = 0; m < 4; ++m) { const int row = u.pm * BM + ai * HALF + wr * 64 + m * 16 + fr;
#pragma unroll
                    for (int n = 0; n < 2; ++n) { const f32x4 v = acc[ai][0][m][n] + acc[ai][1][m][n]; *(f32x4*)(L + (size_t)row * 64 + wc * 32 + 16 * n + 4 * fq) = v; } }
        }
    }
};
struct EpiExp1 {
    static constexpr bool PERM = true, AFTER_DRAIN = false;
    bf16_t* Hd;
    __device__ __forceinline__ void operator()(const f32x4 (&acc)[2][2][4][2], const Unit& u, int wr, int wc, int fr, int fq) const {
#pragma unroll
        for (int ai = 0; ai < 2; ++ai)
#pragma unroll
            for (int m = 0; m < 4; ++m) { const int row = u.pm * BM + ai * HALF + wr * 64 + m * 16 + fr; float v[8];
#pragma unroll
                for (int n = 0; n < 2; ++n)
#pragma unroll
                    for (int i = 0; i < 4; ++i) { const float g = acc[ai][0][m][n][i], up = acc[ai][1][m][n][i]; v[n * 4 + i] = g * sigmoidf_(g) * up; }
                *(u32x4*)(Hd + (size_t)row * DEXP + u.pn * HALF + wc * 32 + 8 * fq) = pack8(v); }
    }
};
struct EpiExp2 {
    static constexpr bool PERM = true, AFTER_DRAIN = false;
    const int* list; const float* cwl; const int* cnt; bf16_t* Sl;
    __device__ __forceinline__ void operator()(const f32x4 (&acc)[2][2][4][2], const Unit& u, int wr, int wc, int fr, int fq) const {
        const int n = cnt[u.g];
#pragma unroll
        for (int ai = 0; ai < 2; ++ai) {
            int dd[4]; float ww[4];
#pragma unroll
            for (int m = 0; m < 4; ++m) { const int pos = u.lt * BM + ai * HALF + wr * 64 + m * 16 + fr; const bool ok = pos < n; const size_t li = (size_t)u.g * T + (ok ? pos : 0);
                const int d = list[li]; const float w = cwl[li]; dd[m] = ok ? d : -1; ww[m] = w; }
            EPI_HALF_RUN({
                const int col = u.pn * BM + lcol; const int d = dd[m]; const float w = ww[m];
                if (d >= 0) { _Pragma("unroll") for (int i = 0; i < 8; ++i) v[i] *= w; *(u32x4*)(Sl + (size_t)d * D + col) = pack8(v); }
            })
        }
    }
};

template <class Epi, class Sched, bool ALIGN_EPI = false, bool SP2 = false, bool GATHER = false>
__device__ __forceinline__ void gemm_phase(PG8_LAS unsigned char* lds, const int K, const int lda, const int ldb, const Sched& S, const Epi& E, const PG8_LAS int* rowtab = nullptr) {
    int tid = threadIdx.x; asm volatile("" : "+v"(tid));
    const int wid = __builtin_amdgcn_readfirstlane(tid >> 6), lane = tid & 63, wr = wid >> 2, wc = wid & 3, fr = lane & 15, fq = lane >> 4;
    const int nt = K / BK;
    unsigned voffA[2], voffB[2]; int gR[2]; unsigned gC[2];
#pragma unroll
    for (int i = 0; i < 2; ++i) { int R, C; stage_rc(tid * 16 + i * 8192, R, C); const int Rb = Epi::PERM ? ((R & ~31) + perm32(R & 31)) : R;
        voffA[i] = (unsigned)(R * lda + C) * 2u; voffB[i] = (unsigned)(Rb * ldb + C) * 2u; gR[i] = R; gC[i] = (unsigned)C * 2u; }
    unsigned vAc[2][2], vAn[2][2], vA2[2][2];
    (void)gR; (void)gC; (void)vAc; (void)vAn; (void)vA2;
#define PG8_GLOAD(dst, ui_) do { _Pragma("unroll") for (int _h = 0; _h < 2; ++_h) _Pragma("unroll") for (int _i = 0; _i < 2; ++_i) \
        dst[_h][_i] = (unsigned)rowtab[(ui_) * 256 + _h * HALF + gR[_i]] * (unsigned)(lda * 2) + gC[_i]; } while (0)
    const size_t kstep = (size_t)(BK * 2);
    const size_t hstepA = (size_t)HALF * lda * 2, hstepB = (size_t)HALF * ldb * 2;
    const unsigned ldsw = (unsigned)wid * 1024u;
    const int aoff = lds_byte(wr * 64 + fr, fq * 8), boff = lds_byte(wc * 32 + fr, fq * 8);
#define PG8_SA(b, h) (((b) * 2 + (h)) * HTB)
#define PG8_SB(b, h) ((4 + (b) * 2 + (h)) * HTB)
#define PG8_STAGE(bufoff, gbase, voff) do { _Pragma("unroll") for (int _i = 0; _i < 2; ++_i) \
        __builtin_amdgcn_global_load_lds((const unsigned*)((const char*)(gbase) + (voff)[_i]), (PG8_LAS unsigned*)(lds + (bufoff) + ldsw + _i * 8192), 16, 0, 0); } while (0)
#define PG8_STAGE_A(bufoff, gbase, h, vs) do { if constexpr (GATHER) { PG8_STAGE(bufoff, gbase, vs[h]); } else { PG8_STAGE(bufoff, (gbase) + (h) * hstepA, voffA); } } while (0)
#define PG8_LDA(dst, b, h) do { _Pragma("unroll") for (int m = 0; m < 4; ++m) _Pragma("unroll") for (int k = 0; k < 2; ++k) dst[m][k] = *(const PG8_LAS bf16x8*)(lds + PG8_SA(b, h) + aoff + m * 2048 + k * 1024); } while (0)
#define PG8_LDB(dst, b, h) do { _Pragma("unroll") for (int n = 0; n < 2; ++n) _Pragma("unroll") for (int k = 0; k < 2; ++k) dst[n][k] = *(const PG8_LAS bf16x8*)(lds + PG8_SB(b, h) + boff + n * 2048 + k * 1024); } while (0)
#define PG8_MMA(ai, bj, At, Bt) do { __builtin_amdgcn_s_setprio(1); _Pragma("unroll") for (int m = 0; m < 4; ++m) _Pragma("unroll") for (int n = 0; n < 2; ++n) _Pragma("unroll") for (int k = 0; k < 2; ++k) \
        acc[ai][bj][m][n] = __builtin_amdgcn_mfma_f32_16x16x32_bf16(Bt[n][k], At[m][k], acc[ai][bj][m][n], 0, 0, 0); __builtin_amdgcn_s_setprio(0); } while (0)
#define PG8_WAIT_V(n) asm volatile("s_waitcnt vmcnt(" #n ")" ::: "memory")
#define PG8_WAIT_L(n) asm volatile("s_waitcnt lgkmcnt(" #n ")" ::: "memory")
#define PG8_BAR __builtin_amdgcn_s_barrier()
#define PG8_SCHED __builtin_amdgcn_sched_barrier(0)
    Unit cur, nxt; int ui = 0;
    if (!S.next(0, cur)) return;
    f32x4 acc[2][2][4][2];
#pragma unroll
    for (int a = 0; a < 2; ++a)
#pragma unroll
        for (int b = 0; b < 2; ++b)
#pragma unroll
            for (int m = 0; m < 4; ++m)
#pragma unroll
                for (int n = 0; n < 2; ++n) acc[a][b][m][n] = (f32x4){0.f, 0.f, 0.f, 0.f};
    bf16x8 At[4][2], B0[2][2], B1[2][2];
    const char* cA = cur.a; const char* cB = cur.b;
    if constexpr (GATHER) { PG8_GLOAD(vAc, 0); }
    static_assert(SP2 || !GATHER, "GATHER is wired into the SP2 loop only");
    if constexpr (SP2) {
        PG8_STAGE(PG8_SB(0, 0), cB, voffB); PG8_STAGE(PG8_SB(0, 1), cB + hstepB, voffB); PG8_STAGE_A(PG8_SA(0, 0), cA, 0, vAc); PG8_STAGE_A(PG8_SA(0, 1), cA, 1, vAc);
        if (wr == 1) PG8_BAR;
        PG8_WAIT_V(2); PG8_BAR;
        PG8_STAGE(PG8_SB(1, 0), cB + kstep, voffB); PG8_STAGE_A(PG8_SA(1, 0), cA + kstep, 0, vAc); PG8_STAGE(PG8_SB(1, 1), cB + hstepB + kstep, voffB);
        PG8_WAIT_V(6); PG8_BAR;
    } else {
        PG8_STAGE(PG8_SB(0, 0), cB, voffB); PG8_STAGE(PG8_SA(0, 0), cA, voffA); PG8_STAGE(PG8_SB(0, 1), cB + hstepB, voffB); PG8_STAGE(PG8_SA(0, 1), cA + hstepA, voffA);
        if (wr == 1) PG8_BAR;
        PG8_WAIT_V(4); PG8_BAR;
        PG8_STAGE(PG8_SB(1, 0), cB + kstep, voffB); PG8_STAGE(PG8_SA(1, 0), cA + kstep, voffA); PG8_STAGE(PG8_SB(1, 1), cB + hstepB + kstep, voffB);
        PG8_WAIT_V(6); PG8_BAR;
    }
    for (;;) {
        const bool has_next = S.next(ui + 1, nxt);
        const char* nA = has_next ? nxt.a : cA; const char* nB = has_next ? nxt.b : cB;
        if constexpr (GATHER) { if (has_next) { PG8_GLOAD(vAn, ui + 1); } else {
            _Pragma("unroll") for (int _h = 0; _h < 2; ++_h) _Pragma("unroll") for (int _i = 0; _i < 2; ++_i) vAn[_h][_i] = vAc[_h][_i]; } }
        for (int t = 0; t < nt; t += 2) {
            const bool last = (t == nt - 2);
            if constexpr (GATHER) { _Pragma("unroll") for (int _h = 0; _h < 2; ++_h) _Pragma("unroll") for (int _i = 0; _i < 2; ++_i) vA2[_h][_i] = last ? vAn[_h][_i] : vAc[_h][_i]; }
            const char* a1 = cA + (size_t)(t + 1) * kstep;
            const char* a2 = last ? nA : cA + (size_t)(t + 2) * kstep; const char* b2 = last ? nB : cB + (size_t)(t + 2) * kstep;
            const char* a3 = a2 + kstep; const char* b3 = b2 + kstep;
            if constexpr (SP2) {
            PG8_LDB(B0, 0, 0); PG8_LDB(B1, 0, 1); PG8_SCHED; PG8_LDA(At, 0, 0); PG8_STAGE_A(PG8_SA(1, 1), a1, 1, vAc);
            PG8_WAIT_V(8); PG8_WAIT_L(0); PG8_BAR; PG8_MMA(0, 0, At, B0); PG8_MMA(0, 1, At, B1); PG8_BAR; PG8_SCHED;
            PG8_LDA(At, 0, 1); PG8_STAGE(PG8_SB(0, 0), b2, voffB); PG8_STAGE(PG8_SB(0, 1), b2 + hstepB, voffB); PG8_STAGE_A(PG8_SA(0, 0), a2, 0, vA2);
            PG8_WAIT_V(8); PG8_WAIT_L(0); PG8_BAR; PG8_MMA(1, 0, At, B0); PG8_MMA(1, 1, At, B1); PG8_BAR; PG8_SCHED;
            PG8_LDB(B0, 1, 0); PG8_LDB(B1, 1, 1); PG8_SCHED; PG8_LDA(At, 1, 0); PG8_STAGE_A(PG8_SA(0, 1), a2, 1, vA2);
            PG8_WAIT_V(8); PG8_WAIT_L(0); PG8_BAR; PG8_MMA(0, 0, At, B0); PG8_MMA(0, 1, At, B1); PG8_BAR; PG8_SCHED;
            PG8_LDA(At, 1, 1); PG8_STAGE(PG8_SB(1, 0), b3, voffB); PG8_STAGE(PG8_SB(1, 1), b3 + hstepB, voffB); PG8_STAGE_A(PG8_SA(1, 0), a3, 0, vA2);
            PG8_WAIT_V(8); PG8_WAIT_L(0); PG8_BAR; PG8_MMA(1, 0, At, B0); PG8_MMA(1, 1, At, B1); PG8_BAR; PG8_SCHED;
            } else {
            PG8_LDB(B0, 0, 0); PG8_SCHED; PG8_LDA(At, 0, 0); PG8_STAGE(PG8_SA(1, 1), a1 + hstepA, voffA);
            PG8_WAIT_L(8); PG8_BAR; PG8_WAIT_L(0); PG8_MMA(0, 0, At, B0); PG8_BAR; PG8_SCHED;
            PG8_LDB(B1, 0, 1); PG8_STAGE(PG8_SB(0, 0), b2, voffB);
            PG8_BAR; PG8_WAIT_L(0); PG8_MMA(0, 1, At, B1); PG8_BAR;
            PG8_LDA(At, 0, 1); PG8_STAGE(PG8_SA(0, 0), a2, voffA);
            PG8_BAR; PG8_WAIT_L(0); PG8_MMA(1, 0, At, B0); PG8_BAR; PG8_SCHED;
            PG8_STAGE(PG8_SB(0, 1), b2 + hstepB, voffB);
            PG8_WAIT_V(6); PG8_BAR; PG8_MMA(1, 1, At, B1); PG8_BAR;
            PG8_LDB(B0, 1, 0); PG8_SCHED; PG8_LDA(At, 1, 0); PG8_STAGE(PG8_SA(0, 1), a2 + hstepA, voffA);
            PG8_WAIT_L(8); PG8_BAR; PG8_WAIT_L(0); PG8_MMA(0, 0, At, B0); PG8_BAR; PG8_SCHED;
            PG8_LDB(B1, 1, 1); PG8_STAGE(PG8_SB(1, 0), b3, voffB);
            PG8_BAR; PG8_WAIT_L(0); PG8_MMA(0, 1, At, B1); PG8_BAR;
            PG8_LDA(At, 1, 1); PG8_STAGE(PG8_SA(1, 0), a3, voffA);
            PG8_BAR; PG8_WAIT_L(0); PG8_MMA(1, 0, At, B0); PG8_BAR; PG8_SCHED;
            PG8_STAGE(PG8_SB(1, 1), b3 + hstepB, voffB);
            PG8_WAIT_V(6); PG8_BAR; PG8_MMA(1, 1, At, B1); PG8_BAR;
            }
        }
        if constexpr (ALIGN_EPI) { if (wr == 0) PG8_BAR; }
        E(acc, cur, wr, wc, fr, fq);
        if (!has_next) break;
#pragma unroll
        for (int a = 0; a < 2; ++a)
#pragma unroll
            for (int b = 0; b < 2; ++b)
#pragma unroll
                for (int m = 0; m < 4; ++m)
#pragma unroll
                    for (int n = 0; n < 2; ++n) acc[a][b][m][n] = (f32x4){0.f, 0.f, 0.f, 0.f};
        cur = nxt; cA = nA; cB = nB; ++ui;
        if constexpr (GATHER) { _Pragma("unroll") for (int _h = 0; _h < 2; ++_h) _Pragma("unroll") for (int _i = 0; _i < 2; ++_i) vAc[_h][_i] = vAn[_h][_i]; }
        if constexpr (ALIGN_EPI) { if (wr == 1) PG8_BAR; }
    }
    PG8_WAIT_V(0);
    if constexpr (!ALIGN_EPI) { if (wr == 0) PG8_BAR; }
    PG8_BAR;
#undef PG8_SA
#undef PG8_SB
#undef PG8_STAGE
#undef PG8_STAGE_A
#undef PG8_GLOAD
#undef PG8_LDA
#undef PG8_LDB
#undef PG8_MMA
#undef PG8_WAIT_V
#undef PG8_WAIT_L
#undef PG8_BAR
#undef PG8_SCHED
}
}

namespace attn_body {
using bf16=__hip_bfloat16;
using bf16x8=__attribute__((ext_vector_type(8)))short;
using s16x4=__attribute__((ext_vector_type(4)))short;
using f32x16=__attribute__((ext_vector_type(16)))float;
using u32x4=__attribute__((ext_vector_type(4)))unsigned;
constexpr int NHEAD=16,SEQ=4096,D=64,DM=NHEAD*D;
constexpr int NW=8,QBLK=32,QB=QBLK*NW,KVBLK=64,NQB=SEQ/QB;
__device__ __forceinline__ int crow(int r,int hi){return (r&3)+8*(r>>2)+4*hi;}
#define SBAR() __builtin_amdgcn_sched_barrier(0)
__device__ __forceinline__ void cmask(f32x16&p0,f32x16&p1,int jb,int wid){
  const float NEG=-INFINITY;
  if(jb>(wid>>1)){
  #pragma unroll
  for(int r=0;r<16;++r){p0[r]=NEG;p1[r]=NEG;}}
}
constexpr int NSLOT=3, SLOTB=8192, VSLOTB=16384;
constexpr int LDS_K=0, LDS_V=NSLOT*SLOTB, LDS_WS=LDS_V+NSLOT*VSLOTB, LDS_OST=LDS_WS+NW*64*4, LDS_BYTES=LDS_OST+NW*8192;
constexpr float C2=0.125f*1.4426950408889634f;
__device__ __forceinline__ void glds16(const char*sbase,unsigned voff,unsigned lds_dst){unsigned keep;
  asm volatile("s_mov_b32 %0, m0\n\ts_mov_b32 m0, %2\n\ts_nop 0\n\tglobal_load_lds_dwordx4 %1, %3\n\ts_mov_b32 m0, %0":"=&s"(keep):"v"(voff),"s"(lds_dst),"s"(sbase):"memory");}
__device__ __forceinline__ float max3f(float a,float b,float c){float r;asm("v_max3_f32 %0, %1, %2, %3":"=v"(r):"v"(a),"v"(b),"v"(c));return r;}
__device__ __forceinline__ float max2f(float a,float b){float r;asm("v_max_f32_e32 %0, %1, %2":"=v"(r):"v"(a),"v"(b));return r;}
typedef float f32x2_t __attribute__((ext_vector_type(2))); typedef __bf16 bf16x2_t __attribute__((ext_vector_type(2)));
__device__ __forceinline__ unsigned cvtpk_s(float lo,float hi){f32x2_t v={lo,hi};bf16x2_t b=__builtin_convertvector(v,bf16x2_t);return __builtin_bit_cast(unsigned,b);}
#define WAIT_BAR(N) asm volatile("s_waitcnt vmcnt(" #N ") lgkmcnt(0)\n\ts_barrier":::"memory")

__device__ __forceinline__ void qkt(f32x16&p0,f32x16&p1,const char*Kslot,const bf16x8*qr,int r32,int hi){
  const char*kb=Kslot+hi*1024+r32*16; const f32x16 z=f32x16{};
  #pragma unroll
  for(int d0=0;d0<4;++d0){
    const bf16x8 b0=*reinterpret_cast<const bf16x8*>(kb+d0*2048);
    const bf16x8 b1=*reinterpret_cast<const bf16x8*>(kb+d0*2048+512);
    if(d0==0){p0=__builtin_amdgcn_mfma_f32_32x32x16_bf16(b0,qr[0],z,0,0,0);p1=__builtin_amdgcn_mfma_f32_32x32x16_bf16(b1,qr[0],z,0,0,0);}
    else{p0=__builtin_amdgcn_mfma_f32_32x32x16_bf16(b0,qr[d0],p0,0,0,0);p1=__builtin_amdgcn_mfma_f32_32x32x16_bf16(b1,qr[d0],p1,0,0,0);}}
}
typedef __attribute__((address_space(3))) const char* lds_cptr;
typedef short v4i16_t __attribute__((ext_vector_type(4)));
__device__ __forceinline__ void kload8(bf16x8*kf,lds_cptr kp){
  kf[0]=*(const __attribute__((address_space(3))) bf16x8*)(kp);      kf[1]=*(const __attribute__((address_space(3))) bf16x8*)(kp+512);
  kf[2]=*(const __attribute__((address_space(3))) bf16x8*)(kp+2048); kf[3]=*(const __attribute__((address_space(3))) bf16x8*)(kp+2560);
  kf[4]=*(const __attribute__((address_space(3))) bf16x8*)(kp+4096); kf[5]=*(const __attribute__((address_space(3))) bf16x8*)(kp+4608);
  kf[6]=*(const __attribute__((address_space(3))) bf16x8*)(kp+6144); kf[7]=*(const __attribute__((address_space(3))) bf16x8*)(kp+6656);
}
__device__ __forceinline__ void kload2(bf16x8*kf,lds_cptr kp,int j){ kf[2*j]=*(const __attribute__((address_space(3))) bf16x8*)(kp+j*2048); kf[2*j+1]=*(const __attribute__((address_space(3))) bf16x8*)(kp+j*2048+512); }
__device__ __forceinline__ s16x4 vtr(lds_cptr p){ return __builtin_bit_cast(s16x4,__builtin_amdgcn_ds_read_tr16_b64_v4i16((__attribute__((address_space(3))) v4i16_t*)p)); }
__device__ __forceinline__ float rowmax(const f32x16&p0,const f32x16&p1){
  float a=max3f(p0[0],p0[1],p1[0]),b=max3f(p0[2],p0[3],p1[1]);a=max3f(a,p1[2],p1[3]);
  #pragma unroll
  for(int r=4;r<16;r+=4){a=max3f(a,p0[r],p0[r+1]);b=max3f(b,p0[r+2],p0[r+3]);a=max3f(a,p1[r],p1[r+1]);b=max3f(b,p1[r+2],p1[r+3]);}
  const float m=max2f(a,b);
  auto rr=__builtin_amdgcn_permlane32_swap(__float_as_uint(m),__float_as_uint(m),false,false);
  return max2f(__uint_as_float(rr[0]),__uint_as_float(rr[1]));
}
__device__ __forceinline__ void pv(f32x16*o,int vb,bf16x8 pa0,bf16x8 pa1,bf16x8 pa2,bf16x8 pa3){
  #pragma unroll
  for(int d0=0;d0<4;++d0){s16x4 lo[4],hi[4];
    #pragma unroll
    for(int ks=0;ks<4;++ks){
      asm volatile("ds_read_b64_tr_b16 %0,%1 offset:%c2":"=&v"(lo[ks]):"v"(vb),"i"(d0*4096+ks*1024):"memory");
      asm volatile("ds_read_b64_tr_b16 %0,%1 offset:%c2":"=&v"(hi[ks]):"v"(vb),"i"(d0*4096+ks*1024+512):"memory");}
    asm volatile("s_waitcnt lgkmcnt(0)":::"memory");SBAR();
    #define PK(k) (bf16x8){lo[k][0],lo[k][1],lo[k][2],lo[k][3],hi[k][0],hi[k][1],hi[k][2],hi[k][3]}
    o[d0]=__builtin_amdgcn_mfma_f32_32x32x16_bf16(pa0,PK(0),o[d0],0,0,0);
    o[d0]=__builtin_amdgcn_mfma_f32_32x32x16_bf16(pa1,PK(1),o[d0],0,0,0);
    o[d0]=__builtin_amdgcn_mfma_f32_32x32x16_bf16(pa2,PK(2),o[d0],0,0,0);
    o[d0]=__builtin_amdgcn_mfma_f32_32x32x16_bf16(pa3,PK(3),o[d0],0,0,0);
    #undef PK
  }
}
template<int THRL,size_t OFF_Q,size_t OFF_K,size_t OFF_V,int GSO> __device__ __forceinline__ void attn_unit(int b,int h,int qb,const char*ws,bf16*AO,float lam,char*shm){
  const bf16*Q=(const bf16*)(ws+OFF_Q); const float*gs=(const float*)(shm+GSO);
  int tid=threadIdx.x; asm volatile("":"+v"(tid)); const int lane=tid&63,r32=lane&31,hi=lane>>5; const int wid=__builtin_amdgcn_readfirstlane(tid>>6);
  const long rowbase=(long)b*SEQ; const int q0=qb*QB;
  const unsigned lds0=(unsigned)(uintptr_t)shm;
  float*wsf=(float*)(shm+LDS_WS)+wid*64;
  bf16*stg=(bf16*)(shm+LDS_OST)+wid*4096;
  const unsigned kdst=lds0+LDS_K+wid*1024, vdst=lds0+LDS_V+wid*1024;
  const int vb0=(int)(lds0+LDS_V)+((lane>>4)&1)*32+(lane&3)*8+(4*hi+((lane&15)>>2))*64;
  const char*Kbase=shm+LDS_K;
  const lds_cptr shm3=(lds_cptr)shm; const lds_cptr kp0=shm3+LDS_K+hi*1024+r32*16; const lds_cptr vp0=shm3+LDS_V+((lane>>4)&1)*32+(lane&3)*8+(4*hi+((lane&15)>>2))*64;
  const int NT=(q0+QB)/KVBLK;
  const char*Vh=ws+OFF_V+(rowbase*DM+h*128)*2;
  const unsigned vsrc=(unsigned)(((16*(wid&3)+(lane>>2))*DM+(wid>>2)*32+(lane&3)*8)*2);
  #pragma unroll 1
  for(int mp=0;mp<2;++mp){
  const int hq=2*h+mp;
  const bf16*Qw=Q+(rowbase+q0+wid*QBLK)*DM+hq*D;
  const char*Kh=ws+OFF_K+(rowbase*DM+hq*D)*2;
  const unsigned ksrc=(unsigned)((lane*DM+wid*8)*2);
  bf16x8 kf[8];
  #define DMA_K(t,slot) glds16(Kh+(long)(t)*(KVBLK*DM*2),ksrc,(unsigned)__builtin_amdgcn_readfirstlane(kdst+(slot)))
  #define DMA_V(t,slot) do{ glds16(Vh+(long)(t)*(KVBLK*DM*2),vsrc,(unsigned)__builtin_amdgcn_readfirstlane(vdst+2*(slot))); glds16(Vh+(long)(t)*(KVBLK*DM*2)+128,vsrc,(unsigned)__builtin_amdgcn_readfirstlane(vdst+2*(slot)+8192)); }while(0)
  DMA_K(0,0);DMA_V(0,0);DMA_K(1,SLOTB);
  bf16x8 qr[4];
  #pragma unroll
  for(int d0=0;d0<4;++d0)qr[d0]=*reinterpret_cast<const bf16x8*>(&Qw[(long)r32*DM+d0*16+hi*8]);
  float mhat=0.f,l_reg=0.f;f32x16 o[4];o[0]=f32x16{};o[1]=f32x16{};o[2]=f32x16{};o[3]=f32x16{};
  #define CMASK(P0,P1,t) do{int jb_=(t)-(NT-4); if(jb_>=0)cmask(P0,P1,jb_,wid);}while(0)
  bool resc=false;
  #define RESC() do{ if(resc){ asm volatile("s_waitcnt lgkmcnt(0)":::"memory"); \
      _Pragma("unroll") for(int d_=0;d_<4;++d_) _Pragma("unroll") for(int r=0;r<16;++r)o[d_][r]*=wsf[crow(r,hi)]; } }while(0)
  f32x16 pA0,pA1,pB0,pB1;
  int sl_prev=0,sl_cur=0,sl_next=SLOTB;
  #define ROT() do{sl_prev=sl_cur;sl_cur=sl_next;sl_next=(sl_next==(NSLOT-1)*SLOTB)?0:sl_next+SLOTB;}while(0)
  DMA_K(2,2*SLOTB);
  WAIT_BAR(4);
  qkt(pA0,pA1,Kbase,qr,r32,hi);asm volatile("s_nop 15\n\ts_nop 7":"+v"(pA0),"+v"(pA1));CMASK(pA0,pA1,0);
  { const float rm=rowmax(pA0,pA1); mhat=rm; resc=false;
    _Pragma("unroll") for(int r=0;r<16;++r){pA0[r]=__builtin_amdgcn_exp2f(pA0[r]-mhat);pA1[r]=__builtin_amdgcn_exp2f(pA1[r]-mhat);} }
  WAIT_BAR(0);
  DMA_K(3,0);DMA_V(1,SLOTB);
  ROT();
  kload8(kf,kp0+sl_cur);
  WAIT_BAR(3);
  s16x4 vlo[8],vhi[8]; u32x4 pw0,pw1,pw2,pw3;
  #define PKW(P,B) cvtpk_s(P[B],P[B+1])
  #define PAF(k) __builtin_bit_cast(bf16x8,pw##k)
  #define VFR(i) (bf16x8){vlo[i][0],vlo[i][1],vlo[i][2],vlo[i][3],vhi[i][0],vhi[i][1],vhi[i][2],vhi[i][3]}
  #define PIN(x) asm volatile("":"+v"(x))
  #define MX3(a,b,c) __builtin_fmaxf(__builtin_fmaxf((a),(b)),(c))
  #define ZC (f32x16{})
  #define GAPA(MF,A0,A1,A2,A3,W0,W1,PW) do{ MF; sacc+=A0; sacc+=A1; sacc+=A2; sacc+=A3; PIN(sacc); W0; W1; PIN(PW); SBAR(); }while(0)
  #define EX(v) __builtin_amdgcn_exp2f((v)-mhat)
  #define GAPB(MF,X,B) do{ MF; X[B]=EX(X[B]); X[B+1]=EX(X[B+1]); PIN(X); SBAR(); }while(0)
  #define VRD(i) do{ vlo[i]=vtr(vp_+(((i)>>2)*4096+((i)&3)*1024)); vhi[i]=vtr(vp_+(((i)>>2)*4096+((i)&3)*1024+512)); }while(0)
  #define VRD2(i) do{ vlo[i]=vtr(vp_+((2+((i)>>2))*4096+((i)&3)*1024)); vhi[i]=vtr(vp_+((2+((i)>>2))*4096+((i)&3)*1024+512)); SBAR(); }while(0)
  #define KRD(G,j) do{ if(G){ kload2(kf,kp0+sl_next,j); SBAR(); } }while(0)
  #define STEP(C0,C1,P0,P1,t,GK,GV,GL) do{ SBAR(); \
    const lds_cptr vp_=vp0+2*sl_prev; \
    VRD(0); SBAR(); float sacc=(P0[0]+P0[1]); \
    GAPA(C0=__builtin_amdgcn_mfma_f32_32x32x16_bf16(kf[0],qr[0],ZC,0,0,0), P0[2],P0[3],P0[4],P0[5],     pw0[0]=PKW(P0,0), pw0[1]=PKW(P0,2), pw0); \
    VRD(4); SBAR(); GAPA(C1=__builtin_amdgcn_mfma_f32_32x32x16_bf16(kf[1],qr[0],ZC,0,0,0), P0[6],P0[7],P0[8],P0[9],     pw0[2]=PKW(P0,4), pw0[3]=PKW(P0,6), pw0); \
    VRD(1); SBAR(); GAPA(C0=__builtin_amdgcn_mfma_f32_32x32x16_bf16(kf[2],qr[1],C0,0,0,0),   P0[10],P0[11],P0[12],P0[13], pw1[0]=PKW(P0,8), pw1[1]=PKW(P0,10), pw1); \
    VRD(5); SBAR(); GAPA(C1=__builtin_amdgcn_mfma_f32_32x32x16_bf16(kf[3],qr[1],C1,0,0,0),   P0[14],P0[15],P1[0],P1[1],   pw1[2]=PKW(P0,12),pw1[3]=PKW(P0,14), pw1); \
    VRD(2); SBAR(); GAPA(C0=__builtin_amdgcn_mfma_f32_32x32x16_bf16(kf[4],qr[2],C0,0,0,0),   P1[2],P1[3],P1[4],P1[5],     pw2[0]=PKW(P1,0), pw2[1]=PKW(P1,2), pw2); \
    VRD(6); SBAR(); GAPA(C1=__builtin_amdgcn_mfma_f32_32x32x16_bf16(kf[5],qr[2],C1,0,0,0),   P1[6],P1[7],P1[8],P1[9],     pw2[2]=PKW(P1,4), pw2[3]=PKW(P1,6), pw2); \
    VRD(3); SBAR(); GAPA(C0=__builtin_amdgcn_mfma_f32_32x32x16_bf16(kf[6],qr[3],C0,0,0,0),   P1[10],P1[11],P1[12],P1[13], pw3[0]=PKW(P1,8), pw3[1]=PKW(P1,10), pw3); \
    VRD(7); SBAR(); GAPA(C1=__builtin_amdgcn_mfma_f32_32x32x16_bf16(kf[7],qr[3],C1,0,0,0),   P1[14],P1[15],0.f,0.f,       pw3[2]=PKW(P1,12),pw3[3]=PKW(P1,14), pw3); \
    l_reg+=sacc; \
    if(GK){DMA_K((t)+3,sl_cur);} if(GV){DMA_V((t)+1,sl_next);} \
    CMASK(C0,C1,t); \
    { float a=MX3(C0[0],C0[1],C1[0]),b=MX3(C0[2],C0[3],C1[1]); a=MX3(a,C1[2],C1[3]); \
      _Pragma("unroll") for(int r=4;r<16;r+=4){a=MX3(a,C0[r],C0[r+1]);b=MX3(b,C0[r+2],C0[r+3]);a=MX3(a,C1[r],C1[r+1]);b=MX3(b,C1[r+2],C1[r+3]);} \
      float rm=__builtin_fmaxf(a,b); { auto rr=__builtin_amdgcn_permlane32_swap(__float_as_uint(rm),__float_as_uint(rm),false,false); rm=__builtin_fmaxf(__uint_as_float(rr[0]),__uint_as_float(rr[1])); } \
      rm-=mhat; resc=false; \
      if(__builtin_expect(__any(rm>(float)THRL),0)){ const float dl=__builtin_fmaxf(rm,0.f); mhat+=dl; \
        const float f=__builtin_amdgcn_exp2f(-dl); l_reg*=f; if(hi==0)wsf[r32]=f; resc=true; } } \
    SBAR(); \
    GAPB(o[0]=__builtin_amdgcn_mfma_f32_32x32x16_bf16(PAF(0),VFR(0),o[0],0,0,0), C0,0);  VRD2(0); \
    GAPB(o[1]=__builtin_amdgcn_mfma_f32_32x32x16_bf16(PAF(0),VFR(4),o[1],0,0,0), C0,2);  VRD2(4); \
    GAPB(o[0]=__builtin_amdgcn_mfma_f32_32x32x16_bf16(PAF(1),VFR(1),o[0],0,0,0), C0,4);  VRD2(1); \
    GAPB(o[1]=__builtin_amdgcn_mfma_f32_32x32x16_bf16(PAF(1),VFR(5),o[1],0,0,0), C0,6);  VRD2(5); \
    GAPB(o[0]=__builtin_amdgcn_mfma_f32_32x32x16_bf16(PAF(2),VFR(2),o[0],0,0,0), C0,8);  VRD2(2); \
    GAPB(o[1]=__builtin_amdgcn_mfma_f32_32x32x16_bf16(PAF(2),VFR(6),o[1],0,0,0), C0,10); VRD2(6); \
    GAPB(o[0]=__builtin_amdgcn_mfma_f32_32x32x16_bf16(PAF(3),VFR(3),o[0],0,0,0), C0,12); VRD2(3); \
    GAPB(o[1]=__builtin_amdgcn_mfma_f32_32x32x16_bf16(PAF(3),VFR(7),o[1],0,0,0), C0,14); VRD2(7); \
    KRD(GL,0); GAPB(o[2]=__builtin_amdgcn_mfma_f32_32x32x16_bf16(PAF(0),VFR(0),o[2],0,0,0), C1,0); \
    KRD(GL,1); GAPB(o[3]=__builtin_amdgcn_mfma_f32_32x32x16_bf16(PAF(0),VFR(4),o[3],0,0,0), C1,2); \
    KRD(GL,2); GAPB(o[2]=__builtin_amdgcn_mfma_f32_32x32x16_bf16(PAF(1),VFR(1),o[2],0,0,0), C1,4); \
    KRD(GL,3); GAPB(o[3]=__builtin_amdgcn_mfma_f32_32x32x16_bf16(PAF(1),VFR(5),o[3],0,0,0), C1,6); \
    GAPB(o[2]=__builtin_amdgcn_mfma_f32_32x32x16_bf16(PAF(2),VFR(2),o[2],0,0,0), C1,8); \
    GAPB(o[3]=__builtin_amdgcn_mfma_f32_32x32x16_bf16(PAF(2),VFR(6),o[3],0,0,0), C1,10); \
    GAPB(o[2]=__builtin_amdgcn_mfma_f32_32x32x16_bf16(PAF(3),VFR(3),o[2],0,0,0), C1,12); \
    GAPB(o[3]=__builtin_amdgcn_mfma_f32_32x32x16_bf16(PAF(3),VFR(7),o[3],0,0,0), C1,14); \
    }while(0)
  int t=1;
  #undef CMASK
  #define CMASK(P0,P1,t) do{}while(0)
  for(;t+5<NT;t+=2){
    STEP(pB0,pB1,pA0,pA1,t,true,true,true);     WAIT_BAR(3); RESC(); ROT();
    STEP(pA0,pA1,pB0,pB1,t+1,true,true,true);   WAIT_BAR(3); RESC(); ROT();
  }
  #undef CMASK
  #define CMASK(P0,P1,t) do{int jb_=(t)-(NT-4); if(jb_>=0)cmask(P0,P1,jb_,wid);}while(0)
  #define ENDW(tt) do{ if((tt)+3<NT){WAIT_BAR(3);} else if((tt)+2<NT){WAIT_BAR(2);} else {WAIT_BAR(0);} }while(0)
  for(;t+1<NT;t+=2){
    STEP(pB0,pB1,pA0,pA1,t,(t+3<NT),(t+1<NT),(t+1<NT));       ENDW(t);   RESC(); ROT();
    STEP(pA0,pA1,pB0,pB1,t+1,(t+4<NT),(t+2<NT),(t+2<NT));     ENDW(t+1); RESC(); ROT();
  }
  STEP(pB0,pB1,pA0,pA1,NT-1,false,false,false); RESC();
  { float sacc=pB0[0]+pB0[1]; _Pragma("unroll") for(int r=2;r<16;++r)sacc+=pB0[r]; _Pragma("unroll") for(int r=0;r<16;++r)sacc+=pB1[r]; l_reg+=sacc;
    pw0=(u32x4){PKW(pB0,0),PKW(pB0,2),PKW(pB0,4),PKW(pB0,6)};pw1=(u32x4){PKW(pB0,8),PKW(pB0,10),PKW(pB0,12),PKW(pB0,14)};pw2=(u32x4){PKW(pB1,0),PKW(pB1,2),PKW(pB1,4),PKW(pB1,6)};pw3=(u32x4){PKW(pB1,8),PKW(pB1,10),PKW(pB1,12),PKW(pB1,14)};
    SBAR(); pv(o,vb0+2*sl_cur,PAF(0),PAF(1),PAF(2),PAF(3)); }
  #undef PKW
  #undef PAF
  #undef VFR
  #undef PIN
  #undef MX3
  #undef ZC
  #undef GAPA
  #undef GAPB
  #undef EX
  #undef VRD
  #undef VRD2
  #undef KRD
  #undef STEP
  #undef ENDW
  #undef DMA_K
  #undef DMA_V
  #undef CMASK
  #undef RESC
  #undef ROT
  {auto rr=__builtin_amdgcn_permlane32_swap(__float_as_uint(l_reg),__float_as_uint(l_reg),false,false);l_reg=__uint_as_float(rr[0])+__uint_as_float(rr[1]);}
  if(hi==0)wsf[32+r32]=l_reg;asm volatile("s_waitcnt lgkmcnt(0)":::"memory");
  float rli[16];
  #pragma unroll
  for(int r=0;r<16;++r)rli[r]=__builtin_amdgcn_rcpf(wsf[32+crow(r,hi)]);
  if(mp==0){
    #pragma unroll
    for(int r=0;r<16;++r){const int orow=crow(r,hi);
      #pragma unroll
      for(int d0=0;d0<4;++d0)stg[orow*128+d0*32+r32]=__float2bfloat16(o[d0][r]*rli[r]);}
  } else {
    #pragma unroll
    for(int r=0;r<16;++r){const int orow=crow(r,hi);
      #pragma unroll
      for(int d0=0;d0<4;++d0){ const float c=__bfloat162float(stg[orow*128+d0*32+r32])-lam*(o[d0][r]*rli[r]); stg[orow*128+d0*32+r32]=__float2bfloat16(c);} }
    asm volatile("s_waitcnt lgkmcnt(0)":::"memory");
    const int row=lane>>1,hf=lane&1; float cv[64]; float ss=0.f;
    #pragma unroll
    for(int i=0;i<8;++i){ const u32x4 w=*(const u32x4*)(stg+row*128+hf*64+i*8);
      cv[8*i+0]=__uint_as_float(w.x<<16);cv[8*i+1]=__uint_as_float(w.x&0xffff0000u);cv[8*i+2]=__uint_as_float(w.y<<16);cv[8*i+3]=__uint_as_float(w.y&0xffff0000u);
      cv[8*i+4]=__uint_as_float(w.z<<16);cv[8*i+5]=__uint_as_float(w.z&0xffff0000u);cv[8*i+6]=__uint_as_float(w.w<<16);cv[8*i+7]=__uint_as_float(w.w&0xffff0000u); }
    #pragma unroll
    for(int i=0;i<64;++i)ss+=cv[i]*cv[i];
    ss+=__int_as_float(__builtin_amdgcn_ds_bpermute((lane^1)<<2,__float_as_int(ss)));
    const float rstd=1.0f/sqrtf(ss*(1.0f/128.0f)+1e-6f);
    bf16*Ow=AO+(rowbase+q0+wid*QBLK+row)*DM+h*128+hf*64;
    #pragma unroll
    for(int i=0;i<8;++i){ const float4 g0=*(const float4*)(gs+hf*64+i*8),g1=*(const float4*)(gs+hf*64+i*8+4); u32x4 w;
      w.x=cvtpk_s(cv[8*i+0]*rstd*g0.x,cv[8*i+1]*rstd*g0.y); w.y=cvtpk_s(cv[8*i+2]*rstd*g0.z,cv[8*i+3]*rstd*g0.w);
      w.z=cvtpk_s(cv[8*i+4]*rstd*g1.x,cv[8*i+5]*rstd*g1.y); w.w=cvtpk_s(cv[8*i+6]*rstd*g1.z,cv[8*i+7]*rstd*g1.w);
      *(u32x4*)(Ow+i*8)=w; }
  }
  asm volatile("s_waitcnt lgkmcnt(0)\n\ts_barrier":::"memory");
  }
}
constexpr int ATTN_LDS_BYTES=LDS_BYTES;
#undef SBAR
#undef WAIT_BAR
}

constexpr size_t MiB = 1u << 20;
constexpr size_t WS_CTL = 0, CTL_ZERO_BYTES = 1 * MiB;
constexpr size_t WS_WIN = 2 * MiB;
constexpr size_t WS_WGLU = 13 * MiB;
constexpr size_t WS_WSSM = 14 * MiB;
constexpr size_t WS_WATT = 15 * MiB;
constexpr size_t WS_WOUT = 17 * MiB;
constexpr size_t WS_WR = 19 * MiB;
constexpr size_t WS_BTP = 20 * MiB;
constexpr size_t WS_BTY = 28 * MiB;
constexpr size_t WS_WE1 = 48 * MiB;
constexpr size_t WS_WE2 = 80 * MiB;
constexpr size_t WS_ETAB = 96 * MiB;
constexpr size_t WS_MOD = 104 * MiB;
constexpr size_t WS_UG = 112 * MiB;
constexpr size_t WS_Q = 152 * MiB, WS_K = 216 * MiB, WS_V = 280 * MiB;
constexpr size_t WS_GATES = 344 * MiB;
constexpr size_t WS_SLOC = 472 * MiB;
constexpr size_t WS_YACT = 152 * MiB;
constexpr size_t WS_S5O = 184 * MiB;
constexpr size_t WS_TMP = 280 * MiB;
constexpr size_t WS_H = 344 * MiB;
constexpr size_t WS_HDN = 256 * MiB;
constexpr size_t WS_SLOTS = 112 * MiB;
constexpr size_t WS_LIST = 472 * MiB;
constexpr size_t WS_CWL = 476 * MiB;
constexpr size_t WS_END = 512 * MiB;
constexpr int CW_TMO = 0, CW_BAR = 4096, CW_CNT = 16384;

constexpr int NWAVES = 8;
constexpr int RING_OFF = 0, RING_BYTES = 147456;
constexpr int LDSCTL_OFF = RING_BYTES, MISC_OFF = LDSCTL_OFF + 320;
constexpr int GS_OFF = MISC_OFF + 2048;
constexpr int ROWTAB_OFF = LDSCTL_OFF + 4096;
constexpr int LDS_BYTES = RING_BYTES + 8192;
static_assert(attn_body::ATTN_LDS_BYTES <= RING_BYTES, "attention LDS");

#define GAS __attribute__((address_space(1)))
#define LAS __attribute__((address_space(3)))
typedef unsigned short bf16;
typedef unsigned v4u __attribute__((ext_vector_type(4)));
typedef unsigned v2u __attribute__((ext_vector_type(2)));
typedef float f32x4 __attribute__((ext_vector_type(4)));
typedef GAS unsigned gu32;
#define RLX_AGENT __ATOMIC_RELAXED, __HIP_MEMORY_SCOPE_AGENT
#define LDS_WAIT() asm volatile("s_waitcnt lgkmcnt(0)" ::: "memory")
#define VM_WAIT() asm volatile("s_waitcnt vmcnt(0)" ::: "memory")
__device__ __forceinline__ unsigned f2bf(float f) { unsigned u = __builtin_bit_cast(unsigned, f); return (u + 0x7fffu + ((u >> 16) & 1u)) >> 16; }
__device__ __forceinline__ unsigned pk2(float lo, float hi) { return f2bf(lo) | (f2bf(hi) << 16); }
__device__ __forceinline__ float bf2f(unsigned b) { return __uint_as_float(b << 16); }

#define XB_TMO      128
#define XB_XCNT(j)  (256  + 64 * (j))
#define XB_XSUB(j)  (1280 + 64 * (j))
#define XB_XGEN(j)  (2304 + 64 * (j))
#define XB_TOP      3328
#define XB_TOPGEN   3392
#define XCD_BAR_WORDS 3456
#define XB_SPIN_CAP (1u << 18)
__device__ __forceinline__ unsigned xb_ld(unsigned* p)              { return __hip_atomic_load(p, __ATOMIC_RELAXED, __HIP_MEMORY_SCOPE_AGENT); }
__device__ __forceinline__ unsigned xb_add(unsigned* p, unsigned v) { return __hip_atomic_fetch_add(p, v, __ATOMIC_RELAXED, __HIP_MEMORY_SCOPE_AGENT); }
__device__ __forceinline__ unsigned xb_xcc_id() { return (unsigned)__builtin_amdgcn_s_getreg((3 << 11) | 20) & 0xFu; }
#define XB_SPIN(cond, bar) do { unsigned _sp = 0; while (cond) { __builtin_amdgcn_s_sleep(1); \
    if ((++_sp & 255u) == 0u) { if (xb_ld(&(bar)[XB_TMO])) break; if (_sp > XB_SPIN_CAP) { atomicAdd(&(bar)[XB_TMO], 1u); break; } } } } while (0)
struct XcdBarrier { unsigned* bar; unsigned x; volatile LAS unsigned* st; };
__device__ __forceinline__ XcdBarrier xcd_barrier_post(unsigned* bar, volatile LAS unsigned* st) {
    XcdBarrier b; b.bar = bar; b.x = xb_xcc_id(); b.st = st;
    if (threadIdx.x == 0) (void)xb_add(&bar[XB_XCNT(b.x)], 1u);
    return b;
}
__device__ __forceinline__ void xcd_barrier_complete(unsigned* bar, unsigned x, unsigned& nloc, unsigned& nx) {
    const unsigned G = gridDim.x * gridDim.y * gridDim.z;
    unsigned sum, cnt, mine, sp = 0u;
    for (;;) {
        sum = 0u; cnt = 0u; mine = 0u;
#pragma unroll
        for (unsigned j = 0; j < 16; ++j) { const unsigned c = xb_ld(&bar[XB_XCNT(j)]); sum += c; cnt += (c > 0u) ? 1u : 0u; mine = (j == x) ? c : mine; }
        if (sum == G) break;
        __builtin_amdgcn_s_sleep(1);
        if ((++sp & 255u) == 0u) { if (xb_ld(&bar[XB_TMO])) break; if (sp > XB_SPIN_CAP) { atomicAdd(&bar[XB_TMO], 1u); break; } }
    }
    nloc = mine > 0u ? mine : 1u; nx = cnt > 0u ? cnt : 1u;
}
__device__ __forceinline__ void xcd_barrier(const XcdBarrier& b) {
    asm volatile("s_waitcnt vmcnt(0)" ::: "memory");
    __syncthreads();
    if (threadIdx.x == 0) {
        unsigned* bar = b.bar;
        __builtin_amdgcn_s_waitcnt(0);
        unsigned nloc = b.st[0], nx = b.st[1];
        if (nloc == 0u) { xcd_barrier_complete(bar, b.x, nloc, nx); b.st[0] = nloc; b.st[1] = nx; }
        const unsigned old = xb_add(&bar[XB_XSUB(b.x)], 1u);
        const unsigned gen = old / nloc;
        if (old + 1u == (gen + 1u) * nloc) {
            __builtin_amdgcn_fence(__ATOMIC_RELEASE, "agent");
            asm volatile("s_waitcnt vmcnt(0)" ::: "memory");
            const unsigned og = xb_add(&bar[XB_TOP], 1u);
            const unsigned tg = og / nx;
            if (og + 1u == (tg + 1u) * nx) xb_add(&bar[XB_TOPGEN], 1u);
            else XB_SPIN(xb_ld(&bar[XB_TOPGEN]) == tg, bar);
            __builtin_amdgcn_fence(__ATOMIC_ACQUIRE, "agent");
            xb_add(&bar[XB_XGEN(b.x)], 1u);
            asm volatile("s_waitcnt vmcnt(0)" ::: "memory");
        } else {
            XB_SPIN(xb_ld(&bar[XB_XGEN(b.x)]) == gen, bar);
            __builtin_amdgcn_fence(__ATOMIC_ACQUIRE, "agent");
            asm volatile("s_waitcnt vmcnt(0)" ::: "memory");
        }
    }
    __syncthreads();
}

__device__ __forceinline__ float shfl_xor_l(float v, int o, int lane) { return __int_as_float(__builtin_amdgcn_ds_bpermute((lane ^ o) << 2, __float_as_int(v))); }
__device__ __forceinline__ float wave_sum(float v, int lane) {
#pragma unroll
    for (int o = 1; o < 64; o <<= 1) v += shfl_xor_l(v, o, lane);
    return v;
}
__device__ __forceinline__ void transpose_tile(const float* W, int N, int k0, int n0, bf16* WT, int ldo, int orow0, int ocol0, LAS float* scr, int lane) {
#pragma unroll 8
    for (int i = 0; i < 32; ++i) { const int kk = 2 * i + (lane >> 5); scr[kk * 33 + (lane & 31)] = W[(size_t)(k0 + kk) * N + n0 + (lane & 31)]; }
    LDS_WAIT(); asm volatile("" ::: "memory");
    const int c = lane & 7;
#pragma unroll
    for (int j = 0; j < 4; ++j) { const int n = (lane >> 3) + 8 * j; const LAS float* s = scr + (8 * c) * 33 + n;
        v4u o; o.x = pk2(s[0 * 33], s[1 * 33]); o.y = pk2(s[2 * 33], s[3 * 33]); o.z = pk2(s[4 * 33], s[5 * 33]); o.w = pk2(s[6 * 33], s[7 * 33]);
        *(GAS v4u*)(WT + (size_t)(orow0 + n) * ldo + ocol0 + 8 * c) = o; }
    LDS_WAIT(); asm volatile("" ::: "memory");
}
__device__ __forceinline__ void abar_pow(float lr, float li, float dt, float j, float& re, float& im) {
    const float mag = expf(lr * dt * j); float s, c; sincosf(li * dt * j, &s, &c); re = mag * c; im = mag * s;
}

constexpr int ETAB_OFF = MISC_OFF + 256;
__device__ __forceinline__ void build_expert_table(LAS unsigned char* L, const int* CNT, int tid) {
    LAS int* tab = (LAS int*)(L + ETAB_OFF);
    __syncthreads();
    if (tid == 0) { int rt = 0;
#pragma unroll 1
        for (int e = 0; e < NEXP; ++e) { const int nt = (CNT[e] + 255) >> 8;
#pragma unroll 1
            for (int q = 0; q < nt; ++q) tab[rt++] = e | (q << 8); }
#pragma unroll 1
        for (; rt <= XS_ROWS / 256; ++rt) tab[rt] = -1; }
    __syncthreads();
}
struct Args { const float* in[34]; float* out; unsigned char* ws; };
typedef __attribute__((address_space(4))) const char* kconst_ptr;
__device__ __forceinline__ void* karg(int k) { kconst_ptr kp = (kconst_ptr)__builtin_amdgcn_kernarg_segment_ptr(); asm volatile("" : "+s"(kp)); return *(void* const __attribute__((address_space(4)))*)(kp + 8 * k); }

__global__ void __launch_bounds__(NWAVES * 64, 2) fwd_kernel(Args args) {
    extern __shared__ __attribute__((aligned(16))) unsigned char lds[];
    LAS unsigned char* L = (LAS unsigned char*)lds;
    volatile LAS unsigned* MISC = (volatile LAS unsigned*)(L + MISC_OFF);
#define PHASE_IDS() \
    int tid = threadIdx.x; asm volatile("" : "+v"(tid)); \
    const int lane = tid & 63, wave = __builtin_amdgcn_readfirstlane(tid >> 6); \
    int G = gridDim.x, bx = blockIdx.x; asm volatile("" : "+s"(G), "+s"(bx)); \
    const int vcu = (G % 8 == 0) ? (bx % 8) * (G / 8) + bx / 8 : bx; \
    const int gw = vcu * NWAVES + wave, NGW = G * NWAVES; \
    const int gt = bx * (NWAVES * 64) + tid, NGT = G * NWAVES * 64; \
    (void)lane; (void)wave; (void)vcu; (void)gw; (void)NGW; (void)gt; (void)NGT;
    gu32* ctl = (gu32*)(args.ws + WS_CTL);
    for (int u = threadIdx.x; u < (LDS_BYTES - LDSCTL_OFF) / 4; u += NWAVES * 64) ((LAS unsigned*)(L + LDSCTL_OFF))[u] = 0u;
    __syncthreads();
    XcdBarrier bar = xcd_barrier_post((unsigned*)(ctl + CW_BAR), MISC + 8);
#define GRID_BAR() xcd_barrier(bar)

#define KIN(k) ((const float*)karg(k))
#define WSP(T_, off) ((T_*)(((unsigned char*)karg(35)) + (off)))
#define OUTP() ((float*)karg(34))

#if DBG_STAGE != 1
    asm volatile("; PHASE_MARK P0" ::: "memory");
    {
        PHASE_IDS();
        const float* w_in = KIN(5); const float* w_glu = KIN(15); const float* w_br_ssm = KIN(22); const float* w_br_attn = KIN(23); const float* w_out = KIN(24);
        const float* w_eg = KIN(30); const float* w_eu = KIN(31); const float* w_ed = KIN(32);
        bf16* WinT = WSP(bf16, WS_WIN); bf16* WgluT = WSP(bf16, WS_WGLU); bf16* WssmT = WSP(bf16, WS_WSSM); bf16* WattT = WSP(bf16, WS_WATT); bf16* WoutT = WSP(bf16, WS_WOUT);
        bf16* WE1 = WSP(bf16, WS_WE1); bf16* WE2 = WSP(bf16, WS_WE2);
        LAS float* scr = (LAS float*)(L + RING_OFF + wave * 16384);
        constexpr int I_IN = 16 * 176, I_GLU = 8 * 16, I_SSM = 8 * 32, I_ATT = 16 * 32, I_OUT = 16 * 32, I_EG = NEXP * 16 * 8, I_EU = I_EG, I_ED = NEXP * 4 * 32;
        constexpr int NITEMS = I_IN + I_GLU + I_SSM + I_ATT + I_OUT + I_EG + I_EU + I_ED;
        for (int it = gw; it < NITEMS; it += NGW) {
            int r = it;
            if (r < I_IN) { const int kb = r / 176, nb = r % 176; transpose_tile(w_in, INW, 64 * kb, 32 * nb, WinT, D, 32 * nb, 64 * kb, scr, lane); continue; } r -= I_IN;
            if (r < I_GLU) { const int kb = r / 16, nb = r % 16; transpose_tile(w_glu, S5W, 64 * kb, 32 * nb, WgluT, S5W, 32 * nb, 64 * kb, scr, lane); continue; } r -= I_GLU;
            if (r < I_SSM) { const int kb = r / 32, nb = r % 32; transpose_tile(w_br_ssm, D, 64 * kb, 32 * nb, WssmT, S5W, 32 * nb, 64 * kb, scr, lane); continue; } r -= I_SSM;
            if (r < I_ATT) { const int kb = r / 32, nb = r % 32; transpose_tile(w_br_attn, D, 64 * kb, 32 * nb, WattT, D, 32 * nb, 64 * kb, scr, lane); continue; } r -= I_ATT;
            if (r < I_OUT) { const int kb = r / 32, nb = r % 32; transpose_tile(w_out, D, 64 * kb, 32 * nb, WoutT, D, 32 * nb, 64 * kb, scr, lane); continue; } r -= I_OUT;
            if (r < I_EG + I_EU) { const bool up = r >= I_EG; if (up) r -= I_EG; const int e = r / 128, q = r % 128, kb = q / 8, nb = q % 8;
                transpose_tile((up ? w_eu : w_eg) + (size_t)e * D * DEXP, DEXP, 64 * kb, 32 * nb, WE1 + (size_t)e * 512 * D, D, (nb >> 2) * 256 + (up ? 128 : 0) + (nb & 3) * 32, 64 * kb, scr, lane); continue; } r -= I_EG + I_EU;
            { const int e = r / 128, q = r % 128, kb = q / 32, nb = q % 32; transpose_tile(w_ed + (size_t)e * DEXP * D, D, 64 * kb, 32 * nb, WE2 + (size_t)e * D * DEXP, DEXP, 32 * nb, 64 * kb, scr, lane); }
        }
        const float* w_rg = KIN(26); const float* w_re = KIN(28); bf16* WR = WSP(bf16, WS_WR);
        for (int idx = gt; idx < 2 * 64 * 128; idx += NGT) {
            const int k0 = (idx & 127) * 8, n = (idx >> 7) & 63, part = idx >> 13;
            unsigned w[4] = {0u, 0u, 0u, 0u};
            if (n < 36) {
                float hv[8];
#pragma unroll
                for (int i = 0; i < 8; ++i) { const float f = (n < 4) ? w_rg[(size_t)(k0 + i) * 4 + n] : w_re[(size_t)(k0 + i) * NEXP + (n - 4)]; const float h = bf2f(f2bf(f)); hv[i] = part ? (f - h) : h; }
#pragma unroll
                for (int i = 0; i < 4; ++i) w[i] = pk2(hv[2 * i], hv[2 * i + 1]);
            }
            *(GAS v4u*)(WR + (size_t)(part * 64 + n) * D + k0) = (v4u){w[0], w[1], w[2], w[3]};
        }
        const float* log_dt = KIN(14); const float* a_re = KIN(7); const float* a_im = KIN(8); const float* sb_re = KIN(9); const float* sb_im = KIN(10);
        float* Ere = WSP(float, WS_ETAB); float* Eim = Ere + NG * LC * NP * 16;
        for (int idx = gt; idx < NG * LC * NP; idx += NGT) {
            const int p = idx % NP, j = (idx / NP) % LC, g = idx / (NP * LC);
            const float dt = expf(log_dt[g]), lr = a_re[g * NP + p], li = a_im[g * NP + p];
            float ar, ai; abar_pow(lr, li, dt, 1.0f, ar, ai);
            const float den = lr * lr + li * li, nr = ar - 1.0f;
            const float fre = (nr * lr + ai * li) / den, fim = (ai * lr - nr * li) / den;
            float pr, pi; abar_pow(lr, li, dt, (float)j, pr, pi);
            const float gr = pr * fre - pi * fim, gi = pr * fim + pi * fre;
            const float* br = sb_re + (size_t)(g * NP + p) * 16; const float* bi = sb_im + (size_t)(g * NP + p) * 16;
            float* er = Ere + (size_t)((g * LC + j) * NP + p) * 16; float* ei = Eim + (size_t)((g * LC + j) * NP + p) * 16;
#pragma unroll
            for (int ci = 0; ci < 16; ++ci) { er[ci] = gr * br[ci] - gi * bi[ci]; ei[ci] = gr * bi[ci] + gi * br[ci]; }
        }
        {
            const float* cvec = KIN(1); const float* w_ada = KIN(2); const float* b_ada = KIN(3); float* MOD = WSP(float, WS_MOD);
            __syncthreads();
            LAS float* cs = (LAS float*)(L + RING_OFF);
            LAS float* red = (LAS float*)(L + RING_OFF + 32768);
            bool loaded = false;
            for (int it = vcu; it < 6 * D / 32; it += G) {
                if (!loaded) { __syncthreads(); for (int i = tid; i < NB * D; i += NWAVES * 64) { const float c = cvec[i]; cs[i] = c / (1.0f + expf(-c)); } __syncthreads(); loaded = true; }
                const int col = it * 32 + (lane & 31), ksub = (lane >> 5) + 2 * wave;
                float accb[NB];
#pragma unroll
                for (int b = 0; b < NB; ++b) accb[b] = 0.f;
#pragma unroll 8
                for (int i = 0; i < 64; ++i) { const int k = ksub + 16 * i; const float w = w_ada[(size_t)k * (6 * D) + col];
#pragma unroll
                    for (int b = 0; b < NB; ++b) accb[b] += cs[b * D + k] * w; }
#pragma unroll
                for (int b = 0; b < NB; ++b) red[(ksub * NB + b) * 32 + (lane & 31)] = accb[b];
                __syncthreads();
                if (tid < NB * 32) { const int b = tid >> 5, c = tid & 31; float s = 0.f;
#pragma unroll
                    for (int q = 0; q < 16; ++q) s += red[(q * NB + b) * 32 + c];
                    MOD[(size_t)b * 6 * D + it * 32 + c] = s + b_ada[it * 32 + c]; }
                __syncthreads();
            }
            __syncthreads();
        }
    }
    GRID_BAR();
#endif

#if DBG_STAGE != 1
    asm volatile("; PHASE_MARK P0b" ::: "memory");
    {
        PHASE_IDS();
        const float* x = KIN(0); const float* g_mix = KIN(4); const float* MOD = WSP(float, WS_MOD); bf16* UBUF = (bf16*)OUTP();
        const float* Ere = WSP(float, WS_ETAB); const float* Eim = Ere + NG * LC * NP * 16; bf16* BtY = WSP(bf16, WS_BTY); bf16* BtP = WSP(bf16, WS_BTP);
        const float* sc_re = KIN(11); const float* sc_im = KIN(12); const float* log_dt = KIN(14); const float* a_re = KIN(7); const float* a_im = KIN(8);
        for (int blk = gw; blk < T / 16; blk += NGW) {
            const int row0 = blk * 16, b = row0 / SEQ; const float* md = MOD + (size_t)b * 6 * D;
            f32x4 av[4], sv[4];
#pragma unroll
            for (int j = 0; j < 4; ++j) { const int c = 4 * lane + 256 * j; const f32x4 g = *(const f32x4*)(g_mix + c), sc = *(const f32x4*)(md + D + c); av[j] = g * (sc + 1.0f); sv[j] = *(const f32x4*)(md + c); }
            for (int r = 0; r < 16; ++r) {
                const float* xr = x + (size_t)(row0 + r) * D; f32x4 v[4]; float ss = 0.f;
#pragma unroll
                for (int j = 0; j < 4; ++j) { v[j] = *(const f32x4*)(xr + 4 * lane + 256 * j); ss += (v[j][0] * v[j][0] + v[j][1] * v[j][1]) + (v[j][2] * v[j][2] + v[j][3] * v[j][3]); }
                const float rstd = 1.0f / sqrtf(wave_sum(ss, lane) * (1.0f / D) + EPS);
                bf16* ur = UBUF + (size_t)(row0 + r) * D;
#pragma unroll
                for (int j = 0; j < 4; ++j) { const f32x4 o = v[j] * rstd * av[j] + sv[j]; *(GAS v2u*)(ur + 4 * lane + 256 * j) = (v2u){pk2(o[0], o[1]), pk2(o[2], o[3])}; }
            }
        }
        for (int idx = gt; idx < NG * LC * 16 * 2; idx += NGT) {
            const int cih = idx & 1, co = (idx >> 1) & 15, j = (idx >> 5) % LC, g = idx / (32 * LC);
            float kv[8];
#pragma unroll
            for (int i = 0; i < 8; ++i) kv[i] = 0.f;
            const float* er = Ere + (size_t)((g * LC + j) * NP) * 16 + cih * 8; const float* ei = Eim + (size_t)((g * LC + j) * NP) * 16 + cih * 8;
            const float* cr = sc_re + (size_t)(g * 16 + co) * NP; const float* ci_ = sc_im + (size_t)(g * 16 + co) * NP;
            for (int p = 0; p < NP; ++p) { const float c_r = cr[p], c_i = ci_[p]; const f32x4 e0 = *(const f32x4*)(er + p * 16), e1 = *(const f32x4*)(er + p * 16 + 4), f0 = *(const f32x4*)(ei + p * 16), f1 = *(const f32x4*)(ei + p * 16 + 4);
#pragma unroll
                for (int i = 0; i < 4; ++i) { kv[i] += c_r * e0[i] - c_i * f0[i]; kv[4 + i] += c_r * e1[i] - c_i * f1[i]; } }
            const v4u kw = (v4u){pk2(kv[0], kv[1]), pk2(kv[2], kv[3]), pk2(kv[4], kv[5]), pk2(kv[6], kv[7])};
            bf16* base = BtY + (size_t)g * 512 * KY;
            for (int t = j; t < LC; ++t) *(GAS v4u*)(base + (size_t)(t * 16 + co) * KY + (t - j) * 16 + cih * 8) = kw;
            if (j >= 1) for (int t = 0; t + j < LC; ++t) *(GAS v4u*)(base + (size_t)(t * 16 + co) * KY + (t + j) * 16 + cih * 8) = (v4u){0u, 0u, 0u, 0u};
        }
        for (int idx = gt; idx < NG * LC * NP; idx += NGT) {
            const int p = idx % NP, t = (idx / NP) % LC, g = idx / (NP * LC);
            const float dt = expf(log_dt[g]); float ar, ai; abar_pow(a_re[g * NP + p], a_im[g * NP + p], dt, (float)(t + 1), ar, ai);
#pragma unroll
            for (int co = 0; co < 16; ++co) { const float c_r = sc_re[(size_t)(g * 16 + co) * NP + p], c_i = sc_im[(size_t)(g * 16 + co) * NP + p];
                bf16* rowp = BtY + (size_t)(g * 512 + t * 16 + co) * KY;
                rowp[512 + p] = (bf16)f2bf(c_r * ar - c_i * ai); rowp[576 + p] = (bf16)f2bf(-(c_r * ai + c_i * ar)); }
        }
        for (int idx = gt; idx < NG * 128 * LC; idx += NGT) {
            const int s = idx % LC, nn = (idx / LC) % 128, g = idx / (LC * 128); const int p = nn & 63, im = nn >> 6;
            const float* src = (im ? Eim : Ere) + (size_t)((g * LC + (LC - 1 - s)) * NP + p) * 16;
            unsigned hw[8], lw[8];
#pragma unroll
            for (int i = 0; i < 8; ++i) { const float f0 = src[2 * i], f1 = src[2 * i + 1]; const unsigned h0 = f2bf(f0), h1 = f2bf(f1); hw[i] = h0 | (h1 << 16); lw[i] = pk2(f0 - bf2f(h0), f1 - bf2f(h1)); }
            bf16* d0 = BtP + (size_t)(g * 256 + nn) * KS + s * 16; bf16* d1 = BtP + (size_t)(g * 256 + 128 + nn) * KS + s * 16;
            *(GAS v4u*)d0 = (v4u){hw[0], hw[1], hw[2], hw[3]}; *(GAS v4u*)(d0 + 8) = (v4u){hw[4], hw[5], hw[6], hw[7]};
            *(GAS v4u*)d1 = (v4u){lw[0], lw[1], lw[2], lw[3]}; *(GAS v4u*)(d1 + 8) = (v4u){lw[4], lw[5], lw[6], lw[7]};
        }
    }
    GRID_BAR();

    asm volatile("; PHASE_MARK P1" ::: "memory");
    {
        PHASE_IDS();
        pg8::StaticOrder S; S.init(OUTP(), D, WSP(bf16, WS_WIN), D, T, INW, G, bx);
        pg8::EpiProj E{KIN(6), WSP(bf16, WS_UG), WSP(bf16, WS_Q), WSP(bf16, WS_K), WSP(bf16, WS_V), WSP(bf16, WS_GATES), attn_body::C2};
        pg8::gemm_phase<pg8::EpiProj, pg8::StaticOrder, true, true>(L + RING_OFF, D, D, D, S, E);
    }
    GRID_BAR();

    asm volatile("; PHASE_MARK P2" ::: "memory");
    {
        PHASE_IDS();
        pg8::GroupOrder S; S.init(WSP(bf16, WS_UG), KY, (size_t)NRC * KY * 2, WSP(bf16, WS_BTP), KS, (size_t)256 * KS * 2, NRC, 256, NG, G, bx);
        pg8::EpiStates E{WSP(float, WS_SLOC)};
        pg8::gemm_phase<pg8::EpiStates, pg8::GroupOrder, true, true>(L + RING_OFF, KS, KY, KS, S, E);
    }
    GRID_BAR();

    asm volatile("; PHASE_MARK P3" ::: "memory");
    {
        PHASE_IDS();
        const float* log_dt = KIN(14); const float* a_re = KIN(7); const float* a_im = KIN(8); const float* SLOC = WSP(float, WS_SLOC); bf16* UG = WSP(bf16, WS_UG);
        LAS float* seg = (LAS float*)(L + RING_OFF);
        for (int bg = vcu; bg < NB * NG; bg += G) {
            const int b = bg / NG, g = bg % NG, p = lane;
            const float dt = expf(log_dt[g]), lr = a_re[g * NP + p], li = a_im[g * NP + p];
            float alr, ali; abar_pow(lr, li, dt, (float)LC, alr, ali);
            constexpr int SEGC = NCH / NWAVES;
            float locr[SEGC], loci[SEGC]; float cr = 0.f, ci = 0.f;
            const float* sp = SLOC + ((size_t)(g * NRC + b * NCH + wave * SEGC)) * 128;
#pragma unroll
            for (int k = 0; k < SEGC; ++k) { locr[k] = cr; loci[k] = ci; const float sr = sp[k * 128 + p], si = sp[k * 128 + 64 + p]; const float nr = alr * cr - ali * ci + sr, ni = alr * ci + ali * cr + si; cr = nr; ci = ni; }
            __syncthreads();
            seg[(wave * 64 + p) * 2] = cr; seg[(wave * 64 + p) * 2 + 1] = ci;
            __syncthreads();
            float a16r = alr, a16i = ali;
#pragma unroll
            for (int q = 0; q < 4; ++q) { const float nr = a16r * a16r - a16i * a16i, ni = 2.f * a16r * a16i; a16r = nr; a16i = ni; }
            float inr = 0.f, ini = 0.f;
            for (int w = 0; w < wave; ++w) { const float er = seg[(w * 64 + p) * 2], ei = seg[(w * 64 + p) * 2 + 1]; const float nr = a16r * inr - a16i * ini + er, ni = a16r * ini + a16i * inr + ei; inr = nr; ini = ni; }
            bf16* up = UG + ((size_t)(g * NRC + b * NCH + wave * SEGC)) * KY + KS;
#pragma unroll
            for (int k = 0; k < SEGC; ++k) { up[(size_t)k * KY + p] = (bf16)f2bf(inr + locr[k]); up[(size_t)k * KY + 64 + p] = (bf16)f2bf(ini + loci[k]); const float nr = alr * inr - ali * ini, ni = alr * ini + ali * inr; inr = nr; ini = ni; }
        }
        __syncthreads();
        const char* wsb = (const char*)karg(35);
        const float* lq1 = KIN(17); const float* lk1 = KIN(18); const float* lq2 = KIN(19); const float* lk2 = KIN(20); const float* g_subln = KIN(21);
        const float lam = expf(wave_sum(lq1[lane] * lk1[lane], lane)) - expf(wave_sum(lq2[lane] * lk2[lane], lane)) + LAMBDA_INIT;
        LAS float* gsl = (LAS float*)(L + GS_OFF);
        if (tid < 128) gsl[tid] = g_subln[tid] * (1.0f - LAMBDA_INIT);
        __syncthreads();
        for (int un = vcu; un < NB * 8 * 4; un += G) {
            const int s4 = un & 3, h = (un >> 2) & 7, b = un >> 5;
#pragma unroll 1
            for (int i = 0; i < 4; ++i) { const int qb = (i == 0) ? 15 - s4 : (i == 1) ? 8 + s4 : (i == 2) ? 7 - s4 : s4;
                attn_body::attn_unit<8, WS_Q, WS_K, WS_V, GS_OFF - RING_OFF>(b, h, qb, wsb, (attn_body::bf16*)OUTP(), lam, (char*)lds + RING_OFF); }
        }
    }
    GRID_BAR();

    asm volatile("; PHASE_MARK P4" ::: "memory");
    {
        PHASE_IDS();
        pg8::GroupOrder S; S.init(WSP(bf16, WS_UG), KY, (size_t)NRC * KY * 2, WSP(bf16, WS_BTY), KY, (size_t)512 * KY * 2, NRC, 512, NG, G, bx);
        pg8::EpiY E{WSP(bf16, WS_UG), KIN(13), WSP(bf16, WS_YACT)};
        pg8::gemm_phase<pg8::EpiY, pg8::GroupOrder, true, true>(L + RING_OFF, KY, KY, KY, S, E);
    }
    GRID_BAR();

    asm volatile("; PHASE_MARK P5" ::: "memory");
    {
        PHASE_IDS();
        pg8::StaticOrder S; S.init(WSP(bf16, WS_YACT), S5W, WSP(bf16, WS_WGLU), S5W, T, S5W, G, bx);
        pg8::EpiGlu E{WSP(bf16, WS_YACT), KIN(16), WSP(bf16, WS_S5O)};
        pg8::gemm_phase<pg8::EpiGlu, pg8::StaticOrder, true, true>(L + RING_OFF, S5W, S5W, S5W, S, E);
    }
    GRID_BAR();

    asm volatile("; PHASE_MARK P6" ::: "memory");
    {
        PHASE_IDS();
        pg8::StaticOrder S; S.init(WSP(bf16, WS_S5O), S5W, WSP(bf16, WS_WSSM), S5W, T, D, G, bx);
        pg8::EpiBranch<0> E{WSP(bf16, WS_GATES), nullptr, WSP(bf16, WS_TMP)};
        pg8::gemm_phase<pg8::EpiBranch<0>, pg8::StaticOrder, true, true>(L + RING_OFF, S5W, S5W, S5W, S, E);
    }
    VM_WAIT(); __syncthreads();
    {
        PHASE_IDS();
        pg8::StaticOrder S; S.init(OUTP(), D, WSP(bf16, WS_WATT), D, T, D, G, bx);
        pg8::EpiBranch<1> E{WSP(bf16, WS_GATES), WSP(bf16, WS_TMP), (bf16*)OUTP() + (size_t)T * D};
        pg8::gemm_phase<pg8::EpiBranch<1>, pg8::StaticOrder, true, true>(L + RING_OFF, D, D, D, S, E);
    }
    GRID_BAR();

    asm volatile("; PHASE_MARK P8" ::: "memory");
    {
        PHASE_IDS();
        pg8::StaticOrder S; S.init((bf16*)OUTP() + (size_t)T * D, D, WSP(bf16, WS_WOUT), D, T, D, G, bx);
        pg8::EpiOut E{KIN(0), WSP(float, WS_MOD), WSP(bf16, WS_H)};
        pg8::gemm_phase<pg8::EpiOut, pg8::StaticOrder, true, true>(L + RING_OFF, D, D, D, S, E);
    }
    GRID_BAR();
#endif

#if DBG_STAGE == 0
    asm volatile("; PHASE_MARK P9" ::: "memory");
    {
        PHASE_IDS();
        const float* g_ffn = KIN(25); const float* MOD = WSP(float, WS_MOD); const bf16* Hbuf = WSP(bf16, WS_H); bf16* U2 = (bf16*)OUTP();
        const bf16* WRh = WSP(bf16, WS_WR); const bf16* WRl = WRh + 64 * D;
        const float* b_rg = KIN(27); const float* b_re = KIN(29); int* CNT = WSP(int, WS_CTL) + CW_CNT; int* LIST = WSP(int, WS_LIST); float* CWL = WSP(float, WS_CWL);
        constexpr int APITCH = 1032;
        LAS bf16* AH = (LAS bf16*)(L + RING_OFF); LAS bf16* AL = AH + 16 * APITCH;
        LAS float* PART = (LAS float*)(L + RING_OFF + 2 * 16 * APITCH * 2);
        LAS float* LG = PART + 8 * 256;
        LAS int* lcnt = (LAS int*)(LG + 16 * 64); LAS int* lbase = lcnt + NEXP; LAS int* TOK = lbase + NEXP;
        const int per = T / G, t0 = bx * per, b = t0 / SEQ;
        const float* md = MOD + (size_t)b * 6 * D;
        f32x4 av[4], sv[4];
#pragma unroll
        for (int j = 0; j < 4; ++j) { const int c = 4 * lane + 256 * j; const f32x4 g = *(const f32x4*)(g_ffn + c), sc = *(const f32x4*)(md + 4 * D + c); av[j] = g * (sc + 1.0f); sv[j] = *(const f32x4*)(md + 3 * D + c); }
        const int cb = wave & 3, kh = wave >> 2, fr = lane & 15, fq = lane >> 4;
        pg8::bf16x8 bh[16], bl[16];
#pragma unroll
        for (int ks = 0; ks < 16; ++ks) { const size_t o = (size_t)(cb * 16 + fr) * D + kh * 512 + ks * 32 + fq * 8; bh[ks] = *(const pg8::bf16x8*)(WRh + o); bl[ks] = *(const pg8::bf16x8*)(WRl + o); }
        if (tid < NEXP) lcnt[tid] = 0;
        for (int c = 0; c < per / 16; ++c) {
#pragma unroll
            for (int rr = 0; rr < 2; ++rr) {
                const int r = 2 * wave + rr, tok = t0 + c * 16 + r;
                const bf16* hr = Hbuf + (size_t)tok * D; f32x4 v[4]; float ss = 0.f;
#pragma unroll
                for (int j = 0; j < 4; ++j) { const v2u hw = *(const GAS v2u*)(hr + 4 * lane + 256 * j); v[j] = (f32x4){pg8::bf_lo(hw.x), pg8::bf_hi(hw.x), pg8::bf_lo(hw.y), pg8::bf_hi(hw.y)}; ss += (v[j][0] * v[j][0] + v[j][1] * v[j][1]) + (v[j][2] * v[j][2] + v[j][3] * v[j][3]); }
                const float rstd = 1.0f / sqrtf(wave_sum(ss, lane) * (1.0f / D) + EPS);
                bf16* ur = U2 + (size_t)tok * D;
#pragma unroll
                for (int j = 0; j < 4; ++j) { const f32x4 o = v[j] * rstd * av[j] + sv[j];
                    const unsigned h0 = f2bf(o[0]), h1 = f2bf(o[1]), h2 = f2bf(o[2]), h3 = f2bf(o[3]);
                    const v2u hv = (v2u){h0 | (h1 << 16), h2 | (h3 << 16)}, lv = (v2u){pk2(o[0] - bf2f(h0), o[1] - bf2f(h1)), pk2(o[2] - bf2f(h2), o[3] - bf2f(h3))};
                    *(GAS v2u*)(ur + 4 * lane + 256 * j) = hv;
                    *(LAS v2u*)(AH + r * APITCH + 4 * lane + 256 * j) = hv; *(LAS v2u*)(AL + r * APITCH + 4 * lane + 256 * j) = lv; }
            }
            __syncthreads();
            { pg8::f32x4 acc = (pg8::f32x4){0.f, 0.f, 0.f, 0.f};
#pragma unroll
              for (int ks = 0; ks < 16; ++ks) { const int ko = fr * APITCH + kh * 512 + ks * 32 + fq * 8;
                  const pg8::bf16x8 ah = *(const LAS pg8::bf16x8*)(AH + ko), al = *(const LAS pg8::bf16x8*)(AL + ko);
                  acc = __builtin_amdgcn_mfma_f32_16x16x32_bf16(ah, bh[ks], acc, 0, 0, 0);
                  acc = __builtin_amdgcn_mfma_f32_16x16x32_bf16(al, bh[ks], acc, 0, 0, 0);
                  acc = __builtin_amdgcn_mfma_f32_16x16x32_bf16(ah, bl[ks], acc, 0, 0, 0); }
#pragma unroll
              for (int i = 0; i < 4; ++i) PART[wave * 256 + (fq * 4 + i) * 16 + fr] = acc[i]; }
            __syncthreads();
#pragma unroll
            for (int i = 0; i < 2; ++i) { const int o = tid * 2 + i, row = o >> 6, col = o & 63, cbb = col >> 4; LG[o] = PART[cbb * 256 + row * 16 + (col & 15)] + PART[(4 + cbb) * 256 + row * 16 + (col & 15)]; }
            __syncthreads();
            if (tid < 16) {
                const LAS float* lg = LG + tid * 64;
                float gl[4]; int gi = 0;
#pragma unroll
                for (int i = 0; i < 4; ++i) gl[i] = lg[i] + b_rg[i];
#pragma unroll
                for (int i = 1; i < 4; ++i) if (gl[i] > gl[gi]) gi = i;
                float gsum = 0.f;
#pragma unroll
                for (int i = 0; i < 4; ++i) gsum += expf(gl[i] - gl[gi]);
                const float gp = 1.0f / gsum;
                float el[8];
#pragma unroll
                for (int i = 0; i < 8; ++i) el[i] = lg[4 + gi * 8 + i] + b_re[gi * 8 + i];
                int i0 = 0;
#pragma unroll
                for (int i = 1; i < 8; ++i) if (el[i] > el[i0]) i0 = i;
                int i1 = (i0 == 0) ? 1 : 0;
#pragma unroll
                for (int i = 0; i < 8; ++i) if (i != i0 && el[i] > el[i1]) i1 = i;
                const float ex = expf(el[i1] - el[i0]);
                const float w0 = gp / (1.0f + ex), w1 = gp * ex / (1.0f + ex);
                const int e0 = gi * 8 + i0, e1 = gi * 8 + i1;
                const int p0 = atomicAdd((int*)(lds + ((char*)&lcnt[e0] - (char*)L)), 1), p1 = atomicAdd((int*)(lds + ((char*)&lcnt[e1] - (char*)L)), 1);
                LAS int* tk = TOK + (c * 16 + tid) * 6; tk[0] = e0; tk[1] = p0; tk[2] = __float_as_int(w0); tk[3] = e1; tk[4] = p1; tk[5] = __float_as_int(w1);
            }
        }
        __syncthreads();
        if (tid < NEXP) lbase[tid] = atomicAdd(&CNT[tid], lcnt[tid]);
        __syncthreads();
        if (tid < per) { const LAS int* tk = TOK + tid * 6; const int tok = t0 + tid;
            const size_t i0 = (size_t)tk[0] * T + lbase[tk[0]] + tk[1], i1 = (size_t)tk[3] * T + lbase[tk[3]] + tk[4];
            LIST[i0] = tok * 2; CWL[i0] = __int_as_float(tk[2]); LIST[i1] = tok * 2 + 1; CWL[i1] = __int_as_float(tk[5]); }
        __syncthreads();
    }
    GRID_BAR();

    asm volatile("; PHASE_MARK P13" ::: "memory");
    {
        PHASE_IDS();
        const int* CNT = WSP(int, WS_CTL) + CW_CNT; const int* LIST = WSP(int, WS_LIST);
        build_expert_table(L, CNT, tid);
        pg8::ExpertOrder S; S.init((const LAS int*)(L + ETAB_OFF), OUTP(), 0, WSP(bf16, WS_WE1), D, (size_t)512 * D * 2, 512, G, bx);
        LAS int* rowtab = (LAS int*)(L + ROWTAB_OFF);
        { pg8::Unit u;
#pragma unroll 1
          for (int i = 0; i < 4 && S.next(i, u); ++i) { const int n = CNT[u.g];
              for (int r = tid; r < 256; r += NWAVES * 64) { const int pos = u.lt * 256 + r; rowtab[i * 256 + r] = (pos < n) ? (LIST[(size_t)u.g * T + pos] >> 1) : 0; } }
          __syncthreads(); }
        pg8::EpiExp1 E{WSP(bf16, WS_HDN)};
        pg8::gemm_phase<pg8::EpiExp1, pg8::ExpertOrder, true, true, true>(L + RING_OFF, D, D, D, S, E, (const LAS int*)rowtab);
    }
    GRID_BAR();

    asm volatile("; PHASE_MARK P14" ::: "memory");
    {
        PHASE_IDS();
        build_expert_table(L, WSP(int, WS_CTL) + CW_CNT, tid);
        pg8::ExpertOrder S; S.init((const LAS int*)(L + ETAB_OFF), WSP(bf16, WS_HDN), (size_t)256 * DEXP * 2, WSP(bf16, WS_WE2), DEXP, (size_t)D * DEXP * 2, D, G, bx);
        pg8::EpiExp2 E{WSP(int, WS_LIST), WSP(float, WS_CWL), WSP(int, WS_CTL) + CW_CNT, WSP(bf16, WS_SLOTS)};
        pg8::gemm_phase<pg8::EpiExp2, pg8::ExpertOrder, true, true>(L + RING_OFF, DEXP, DEXP, DEXP, S, E);
    }
    GRID_BAR();
#endif

    asm volatile("; PHASE_MARK P15" ::: "memory");
    {
        PHASE_IDS();
        const float* x = KIN(0); const float* g_final = KIN(33); const bf16* Hbuf = WSP(bf16, WS_H); const float* MOD = WSP(float, WS_MOD); const bf16* SLOTS = WSP(bf16, WS_SLOTS); float* out = OUTP();
        (void)x; (void)Hbuf; (void)MOD; (void)SLOTS;
        for (int row = gw; row < T; row += NGW) {
            const int b = row / SEQ; f32x4 v[4]; float ss = 0.f;
#pragma unroll
            for (int j = 0; j < 4; ++j) { const int c = 4 * lane + 256 * j;
#if DBG_STAGE == 1
                v[j] = *(const f32x4*)(x + (size_t)row * D + c);
#else
                { const v2u hw = *(const GAS v2u*)(Hbuf + (size_t)row * D + c); v[j] = (f32x4){pg8::bf_lo(hw.x), pg8::bf_hi(hw.x), pg8::bf_lo(hw.y), pg8::bf_hi(hw.y)}; }
#endif
#if DBG_STAGE == 0
                const f32x4 gt = *(const f32x4*)(MOD + (size_t)b * 6 * D + 5 * D + c);
                const v2u s0 = *(const GAS v2u*)(SLOTS + (size_t)(2 * row) * D + c), s1 = *(const GAS v2u*)(SLOTS + (size_t)(2 * row + 1) * D + c);
                const f32x4 f = (f32x4){pg8::bf_lo(s0.x) + pg8::bf_lo(s1.x), pg8::bf_hi(s0.x) + pg8::bf_hi(s1.x), pg8::bf_lo(s0.y) + pg8::bf_lo(s1.y), pg8::bf_hi(s0.y) + pg8::bf_hi(s1.y)};
                v[j] = v[j] + gt * f;
#endif
                ss += (v[j][0] * v[j][0] + v[j][1] * v[j][1]) + (v[j][2] * v[j][2] + v[j][3] * v[j][3]); }
            (void)b;
            const float rstd = 1.0f / sqrtf(wave_sum(ss, lane) * (1.0f / D) + EPS);
#pragma unroll
            for (int j = 0; j < 4; ++j) { const int c = 4 * lane + 256 * j; const f32x4 g = *(const f32x4*)(g_final + c); *(f32x4*)(out + (size_t)row * D + c) = v[j] * rstd * g; }
        }
    }
}

extern "C" void kernel_launch(void* const* d_in, const int* in_sizes, int n_in, void* d_out, int out_size, void* d_ws, size_t ws_size, hipStream_t stream) {
    static int grid = 0;
    if (grid == 0) {
        if (n_in != 34 || out_size != T * D || ws_size < WS_END) { fprintf(stderr, "kernel_launch: unexpected shapes (n_in %d, out %d, ws %zu)\n", n_in, out_size, ws_size); grid = -1; return; }
        int dev = 0, cus = 0, per_cu = 0;
        if (hipGetDevice(&dev) != hipSuccess || hipDeviceGetAttribute(&cus, hipDeviceAttributeMultiprocessorCount, dev) != hipSuccess) { grid = -1; return; }
        if (hipFuncSetAttribute((const void*)fwd_kernel, hipFuncAttributeMaxDynamicSharedMemorySize, LDS_BYTES) != hipSuccess) { fprintf(stderr, "kernel_launch: hipFuncSetAttribute failed\n"); grid = -1; return; }
        if (hipOccupancyMaxActiveBlocksPerMultiprocessor(&per_cu, (const void*)fwd_kernel, NWAVES * 64, LDS_BYTES) != hipSuccess || per_cu < 1)
            fprintf(stderr, "kernel_launch: note: occupancy query reports %d workgroups per CU\n", per_cu);
        (void)hipGetLastError();
        grid = cus;
    }
    if (grid < 0) return;
    if (hipMemsetAsync((char*)d_ws + WS_CTL, 0, CTL_ZERO_BYTES, stream) != hipSuccess) { fprintf(stderr, "kernel_launch: memset failed\n"); return; }
    Args a{};
    for (int i = 0; i < 34; ++i) a.in[i] = (const float*)d_in[i];
    a.out = (float*)d_out; a.ws = (unsigned char*)d_ws;
    hipLaunchKernelGGL(fwd_kernel, dim3(grid), dim3(NWAVES * 64), LDS_BYTES, stream, a);
    const hipError_t le = hipPeekAtLastError();
    if (le != hipSuccess) fprintf(stderr, "kernel_launch: launch failed: %s\n", hipGetErrorName(le));
}
```

```cpp
#include <hip/hip_runtime.h>
#include <hip/hip_bf16.h>
#include <cstdio>
#include <cstdint>
#include <cmath>

#ifndef DBG_STAGE
#define DBG_STAGE 0
#endif

constexpr int D = 1024, NB = 8, SEQ = 4096, T = NB * SEQ;
constexpr int S5W = 512, NG = 32, NP = 64, INW = 5632;
constexpr int LC = 32, NCH = SEQ / LC, NRC = T / LC, KS = LC * 16, KY = KS + 128;
constexpr int NEXP = 32, DEXP = 256;
constexpr int XS_ROWS = 2 * T + NEXP * 256;
constexpr float EPS = 1e-6f;
constexpr float LAMBDA_INIT = 0.2f;

namespace pg8 {
#define PG8_LAS __attribute__((address_space(3)))
typedef unsigned short bf16_t;
typedef short bf16x8 __attribute__((ext_vector_type(8)));
typedef float f32x4 __attribute__((ext_vector_type(4)));
typedef unsigned u32x4 __attribute__((ext_vector_type(4)));
typedef float f32x2 __attribute__((ext_vector_type(2)));
constexpr int BM = 256, BK = 64, HALF = 128, HTB = HALF * BK * 2, STAGE_BYTES = 8 * HTB, NXCD = 8, WGM = 8;

__host__ __device__ __forceinline__ int lds_byte(int r, int c) { const int st = (r >> 4) * 2 + (c >> 5), rr = r & 15, cc = c & 31, ob = rr * 64 + cc * 2; return st * 1024 + (ob ^ (((ob >> 9) & 1) << 5)); }
__host__ __device__ __forceinline__ void stage_rc(int b, int& R, int& C) { const int st = b / 1024, sb = b % 1024, swz = sb ^ (((sb >> 9) & 1) << 5); R = (st >> 1) * 16 + swz / 64; C = (st & 1) * 32 + (swz % 64) / 2; }
__host__ __device__ __forceinline__ int perm32(int rho) { const int n = rho >> 4, i = rho & 15; return 8 * (i >> 2) + 4 * n + (i & 3); }

struct Unit { int pm, pn, g, lt; const char* a; const char* b; };

struct StaticOrder {
    int nM, nN, nwg, G, c; const char* A; const char* B; size_t tsa, tsb;
    __device__ void init(const void* A_, int lda, const void* B_, int ldb, int M, int N, int G_, int c_) { nM = M / BM; nN = N / BM; nwg = nM * nN; G = G_; c = c_; A = (const char*)A_; B = (const char*)B_; tsa = (size_t)BM * lda * 2; tsb = (size_t)BM * ldb * 2; }
    __device__ bool next(int i, Unit& u) const {
        const long L = (long)i * G + c; if (L >= nwg) return false;
        int wgid = (int)L; { const int q = nwg / NXCD, r = nwg % NXCD, xcd = wgid % NXCD, off = wgid / NXCD; wgid = (xcd < r ? xcd * (q + 1) : r * (q + 1) + (xcd - r) * q) + off; }
        const int nig = WGM * nN, gid = wgid / nig, fm = gid * WGM, gsz = (nM - fm) < WGM ? (nM - fm) : WGM;
        u.pm = fm + ((wgid % nig) % gsz); u.pn = (wgid % nig) / gsz; u.g = 0; u.lt = 0; u.a = A + (size_t)u.pm * tsa; u.b = B + (size_t)u.pn * tsb; return true;
    }
};
struct GroupOrder {
    int nM, nN, ng, G, c; const char* A; const char* B; size_t tsa, tsb, gsa, gsb;
    __device__ void init(const void* A_, int lda, size_t gsa_, const void* B_, int ldb, size_t gsb_, int Mg, int Ng, int ng_, int G_, int c_) {
        nM = Mg / BM; nN = Ng / BM; ng = ng_; G = G_; c = c_; A = (const char*)A_; B = (const char*)B_; tsa = (size_t)BM * lda * 2; tsb = (size_t)BM * ldb * 2; gsa = gsa_; gsb = gsb_; }
    __device__ bool next(int i, Unit& u) const {
        const int per = nM * nN, x = c % NXCD, j = c / NXCD + (G / NXCD) * i; if (j >= (ng / NXCD) * per) return false;
        const int g = x + NXCD * (j / per), r = j % per;
        u.g = g; u.lt = 0; u.pm = r / nN; u.pn = r % nN; u.a = A + (size_t)g * gsa + (size_t)u.pm * tsa; u.b = B + (size_t)g * gsb + (size_t)u.pn * tsb; return true;
    }
};
struct ExpertOrder {
    const PG8_LAS int* tab; int nN, G, c; const char* A; const char* B; size_t tsa, tsb, esb;
    __device__ void init(const PG8_LAS int* tab_, const void* A_, size_t tsa_, const void* B_, int ldb, size_t esb_, int N, int G_, int c_) {
        tab = tab_; nN = N / BM; G = G_; c = c_; A = (const char*)A_; B = (const char*)B_; tsa = tsa_; tsb = (size_t)BM * ldb * 2; esb = esb_; }
    __device__ bool next(int i, Unit& u) const {
        const int NT = __builtin_amdgcn_readfirstlane(tab[XS_ROWS / 256 + 1]);
        const int x = c % NXCD, j = c / NXCD + (G / NXCD) * i, lo = (x * NT) / NXCD, hi = ((x + 1) * NT) / NXCD;
        const int rt = lo + j / nN, pn = j % nN;
        if (rt >= hi) return false;
        const int e = __builtin_amdgcn_readfirstlane(tab[rt]);
        u.g = e & 255; u.lt = e >> 8; u.pm = rt; u.pn = pn; u.a = A + (size_t)rt * tsa; u.b = B + (size_t)u.g * esb + (size_t)pn * tsb; return true;
    }
};

__device__ __forceinline__ unsigned cvt_pk_bf16(float lo, float hi) { unsigned r; asm volatile("v_cvt_pk_bf16_f32 %0, %1, %2" : "=v"(r) : "v"(lo), "v"(hi)); return r; }
__device__ __forceinline__ float bf_lo(unsigned w) { return __uint_as_float(w << 16); }
__device__ __forceinline__ float bf_hi(unsigned w) { return __uint_as_float(w & 0xffff0000u); }
__device__ __forceinline__ float sigmoidf_(float x) { return __builtin_amdgcn_rcpf(1.0f + __builtin_amdgcn_exp2f(-1.4426950408889634f * x)); }
__device__ __forceinline__ void unpack8(const u32x4 w, float (&f)[8]) { f[0] = bf_lo(w.x); f[1] = bf_hi(w.x); f[2] = bf_lo(w.y); f[3] = bf_hi(w.y); f[4] = bf_lo(w.z); f[5] = bf_hi(w.z); f[6] = bf_lo(w.w); f[7] = bf_hi(w.w); }
__device__ __forceinline__ u32x4 pack8(const float (&f)[8]) { u32x4 w; w.x = cvt_pk_bf16(f[0], f[1]); w.y = cvt_pk_bf16(f[2], f[3]); w.z = cvt_pk_bf16(f[4], f[5]); w.w = cvt_pk_bf16(f[6], f[7]); return w; }

#define EPI_LOOP_PERM(...) \
    _Pragma("unroll") for (int ai = 0; ai < 2; ++ai) _Pragma("unroll") for (int m = 0; m < 4; ++m) { const int lrow = ai * HALF + wr * 64 + m * 16 + fr; \
        _Pragma("unroll") for (int bj = 0; bj < 2; ++bj) { const int lcol = bj * HALF + wc * 32 + 8 * fq; \
            float v[8] = {acc[ai][bj][m][0][0], acc[ai][bj][m][0][1], acc[ai][bj][m][0][2], acc[ai][bj][m][0][3], acc[ai][bj][m][1][0], acc[ai][bj][m][1][1], acc[ai][bj][m][1][2], acc[ai][bj][m][1][3]}; __VA_ARGS__ } }

#define EPI_HALF_PRE(...) _Pragma("unroll") for (int m = 0; m < 4; ++m) { const int lrow = ai * HALF + wr * 64 + m * 16 + fr; (void)lrow; \
        _Pragma("unroll") for (int bj = 0; bj < 2; ++bj) { const int lcol = bj * HALF + wc * 32 + 8 * fq; (void)lcol; __VA_ARGS__ } }
#define EPI_HALF_RUN(...) _Pragma("unroll") for (int m = 0; m < 4; ++m) { const int lrow = ai * HALF + wr * 64 + m * 16 + fr; (void)lrow; \
        _Pragma("unroll") for (int bj = 0; bj < 2; ++bj) { const int lcol = bj * HALF + wc * 32 + 8 * fq; (void)lcol; \
            float v[8] = {acc[ai][bj][m][0][0], acc[ai][bj][m][0][1], acc[ai][bj][m][0][2], acc[ai][bj][m][0][3], acc[ai][bj][m][1][0], acc[ai][bj][m][1][1], acc[ai][bj][m][1][2], acc[ai][bj][m][1][3]}; __VA_ARGS__ } }

struct EpiProj {
    static constexpr bool PERM = true, AFTER_DRAIN = false;
    const float* bias; bf16_t* U; bf16_t* Q; bf16_t* Kb; bf16_t* V; bf16_t* Gt; float c2;
    __device__ __forceinline__ void operator()(const f32x4 (&acc)[2][2][4][2], const Unit& u, int wr, int wc, int fr, int fq) const {
        const int ct = u.pn;
        f32x4 bv[2][2];
#pragma unroll
        for (int bj = 0; bj < 2; ++bj) { const int col = ct * BM + bj * HALF + wc * 32 + 8 * fq; bv[bj][0] = *(const f32x4*)(bias + col); bv[bj][1] = *(const f32x4*)(bias + col + 4); }
        EPI_LOOP_PERM({
            const int row = u.pm * BM + lrow, col = ct * BM + lcol;
            v[0] += bv[bj][0][0]; v[1] += bv[bj][0][1]; v[2] += bv[bj][0][2]; v[3] += bv[bj][0][3]; v[4] += bv[bj][1][0]; v[5] += bv[bj][1][1]; v[6] += bv[bj][1][2]; v[7] += bv[bj][1][3];
            bf16_t* dst;
            if (ct < 2) { const int g = col >> 4, ci = col & 15, rc = row / LC, s = row % LC; dst = U + ((size_t)(g * NRC + rc) * KY + s * 16 + ci); }
            else if (ct < 6) { _Pragma("unroll") for (int i = 0; i < 8; ++i) v[i] *= c2; dst = Q + (size_t)row * D + (col - 512); }
            else if (ct < 10) { dst = Kb + (size_t)row * D + (col - 1536); }
            else if (ct < 14) { dst = V + (size_t)row * D + (col - 2560); }
            else { _Pragma("unroll") for (int i = 0; i < 8; ++i) v[i] = sigmoidf_(v[i]); dst = Gt + (size_t)row * 2048 + (col - 3584); }
            *(u32x4*)dst = pack8(v);
        })
    }
};
struct EpiStates {
    static constexpr bool PERM = false, AFTER_DRAIN = false;
    float* S;
    __device__ __forceinline__ void operator()(const f32x4 (&acc)[2][2][4][2], const Unit& u, int wr, int wc, int fr, int fq) const {
#pragma unroll
        for (int ai = 0; ai < 2; ++ai)
#pragma unroll
            for (int m = 0; m < 4; ++m) { const int row = u.pm * BM + ai * HALF + wr * 64 + m * 16 + fr;
#pragma unroll
                for (int n = 0; n < 2; ++n) { const f32x4 v = acc[ai][0][m][n] + acc[ai][1][m][n]; *(f32x4*)(S + ((size_t)(u.g * NRC + row) * 128 + wc * 32 + 16 * n + 4 * fq)) = v; } }
    }
};
struct EpiY {
    static constexpr bool PERM = true, AFTER_DRAIN = false;
    const bf16_t* U; const float* dskip; bf16_t* Y;
    __device__ __forceinline__ void operator()(const f32x4 (&acc)[2][2][4][2], const Unit& u, int wr, int wc, int fr, int fq) const {
        f32x4 dk[2][2];
#pragma unroll
        for (int bj = 0; bj < 2; ++bj) { const int co = (bj * HALF + wc * 32 + 8 * fq) & 15; dk[bj][0] = *(const f32x4*)(dskip + u.g * 16 + co); dk[bj][1] = *(const f32x4*)(dskip + u.g * 16 + co + 4); }
#pragma unroll
        for (int ai = 0; ai < 2; ++ai) {
            u32x4 uw[4][2];
            EPI_HALF_PRE({ const int rc = u.pm * BM + lrow, n = u.pn * BM + lcol; uw[m][bj] = *(const u32x4*)(U + ((size_t)(u.g * NRC + rc) * KY + n)); })
            EPI_HALF_RUN({
                const int rc = u.pm * BM + lrow, n = u.pn * BM + lcol, tt = n >> 4, co = n & 15;
                float uf[8]; unpack8(uw[m][bj], uf);
                const float dd[8] = {dk[bj][0][0], dk[bj][0][1], dk[bj][0][2], dk[bj][0][3], dk[bj][1][0], dk[bj][1][1], dk[bj][1][2], dk[bj][1][3]};
                _Pragma("unroll") for (int i = 0; i < 8; ++i) { const float y = v[i] + dd[i] * uf[i]; const float z = 1.5957691216057308f * (y + 0.044715f * y * y * y); v[i] = y * sigmoidf_(z); }
                *(u32x4*)(Y + ((size_t)(rc * LC + tt) * S5W + u.g * 16 + co)) = pack8(v);
            })
        }
    }
};
struct EpiGlu {
    static constexpr bool PERM = true, AFTER_DRAIN = false;
    const bf16_t* Y; const float* bias; bf16_t* O;
    __device__ __forceinline__ void operator()(const f32x4 (&acc)[2][2][4][2], const Unit& u, int wr, int wc, int fr, int fq) const {
        f32x4 bv[2][2];
#pragma unroll
        for (int bj = 0; bj < 2; ++bj) { const int col = u.pn * BM + bj * HALF + wc * 32 + 8 * fq; bv[bj][0] = *(const f32x4*)(bias + col); bv[bj][1] = *(const f32x4*)(bias + col + 4); }
#pragma unroll
        for (int ai = 0; ai < 2; ++ai) {
            u32x4 yw[4][2];
            EPI_HALF_PRE({ const int row = u.pm * BM + lrow, col = u.pn * BM + lcol; yw[m][bj] = *(const u32x4*)(Y + (size_t)row * S5W + col); })
            EPI_HALF_RUN({
                const int row = u.pm * BM + lrow, col = u.pn * BM + lcol;
                float yf[8]; unpack8(yw[m][bj], yf);
                const float bb[8] = {bv[bj][0][0], bv[bj][0][1], bv[bj][0][2], bv[bj][0][3], bv[bj][1][0], bv[bj][1][1], bv[bj][1][2], bv[bj][1][3]};
                _Pragma("unroll") for (int i = 0; i < 8; ++i) v[i] = yf[i] * sigmoidf_(v[i] + bb[i]);
                *(u32x4*)(O + (size_t)row * S5W + col) = pack8(v);
            })
        }
    }
};
template <int MODE> struct EpiBranch {
    static constexpr bool PERM = true, AFTER_DRAIN = false;
    const bf16_t* Gt; const bf16_t* Tin; bf16_t* O;
    __device__ __forceinline__ void operator()(const f32x4 (&acc)[2][2][4][2], const Unit& u, int wr, int wc, int fr, int fq) const {
#pragma unroll
        for (int ai = 0; ai < 2; ++ai) {
            u32x4 gw[4][2], tw[4][2];
            EPI_HALF_PRE({ const int row = u.pm * BM + lrow, col = u.pn * BM + lcol; gw[m][bj] = *(const u32x4*)(Gt + (size_t)row * 2048 + MODE * D + col);
                           if (MODE == 1) tw[m][bj] = *(const u32x4*)(Tin + (size_t)row * D + col); else tw[m][bj] = gw[m][bj]; })
            EPI_HALF_RUN({
                const int row = u.pm * BM + lrow, col = u.pn * BM + lcol;
                float gf[8]; unpack8(gw[m][bj], gf);
                if (MODE == 1) { float tf[8]; unpack8(tw[m][bj], tf);
                    _Pragma("unroll") for (int i = 0; i < 8; ++i) v[i] = tf[i] + gf[i] * v[i]; }
                else { _Pragma("unroll") for (int i = 0; i < 8; ++i) v[i] = gf[i] * v[i]; }
                *(u32x4*)(O + (size_t)row * D + col) = pack8(v);
            })
        }
    }
};
struct EpiOut {
    static constexpr bool PERM = true, AFTER_DRAIN = false;
    const float* x; const float* mod; bf16_t* H;
    __device__ __forceinline__ void operator()(const f32x4 (&acc)[2][2][4][2], const Unit& u, int wr, int wc, int fr, int fq) const {
        const int b = (u.pm * BM) / SEQ; const float* gt = mod + (size_t)b * 6 * D + 2 * D;
        f32x4 gv[2][2];
#pragma unroll
        for (int bj = 0; bj < 2; ++bj) { const int col = u.pn * BM + bj * HALF + wc * 32 + 8 * fq; gv[bj][0] = *(const f32x4*)(gt + col); gv[bj][1] = *(const f32x4*)(gt + col + 4); }
#pragma unroll
        for (int ai = 0; ai < 2; ++ai) {
            f32x4 xv[4][2][2];
            EPI_HALF_PRE({ const size_t off = (size_t)(u.pm * BM + lrow) * D + u.pn * BM + lcol; xv[m][bj][0] = *(const f32x4*)(x + off); xv[m][bj][1] = *(const f32x4*)(x + off + 4); })
            EPI_HALF_RUN({
                const size_t off = (size_t)(u.pm * BM + lrow) * D + u.pn * BM + lcol;
                _Pragma("unroll") for (int i = 0; i < 4; ++i) { v[i] = xv[m][bj][0][i] + gv[bj][0][i] * v[i]; v[4 + i] = xv[m][bj][1][i] + gv[bj][1][i] * v[4 + i]; }
                *(u32x4*)(H + off) = pack8(v);
            })
        }
    }
};
struct EpiRouter {
    static constexpr bool PERM = false, AFTER_DRAIN = false;
    float* L;
    __device__ __forceinline__ void operator()(const f32x4 (&acc)[2][2][4][2], const Unit& u, int wr, int wc, int fr, int fq) const {
        if (wc < 2) {
#pragma unroll
            for (int ai = 0; ai < 2; ++ai)
#pragma unroll
                for (int m = 0; m < 4; ++m) { const int row = u.pm * BM + ai * HALF + wr * 64 + m * 16 + fr;
#pragma unroll
                    for (int n = 0; n < 2; ++n) { const f32x4 v = acc[ai][0][m][n] + acc[ai][1][m][n]; *(f32x4*)(L + (size_t)row * 64 + wc * 32 + 16 * n + 4 * fq) = v; } }
        }
    }
};
struct EpiExp1 {
    static constexpr bool PERM = true, AFTER_DRAIN = false;
    bf16_t* Hd;
    __device__ __forceinline__ void operator()(const f32x4 (&acc)[2][2][4][2], const Unit& u, int wr, int wc, int fr, int fq) const {
#pragma unroll
        for (int ai = 0; ai < 2; ++ai)
#pragma unroll
            for (int m = 0; m < 4; ++m) { const int row = u.pm * BM + ai * HALF + wr * 64 + m * 16 + fr; float v[8];
#pragma unroll
                for (int n = 0; n < 2; ++n)
#pragma unroll
                    for (int i = 0; i < 4; ++i) { const float g = acc[ai][0][m][n][i], up = acc[ai][1][m][n][i]; v[n * 4 + i] = g * sigmoidf_(g) * up; }
                *(u32x4*)(Hd + (size_t)row * DEXP + u.pn * HALF + wc * 32 + 8 * fq) = pack8(v); }
    }
};
struct EpiExp2 {
    static constexpr bool PERM = true, AFTER_DRAIN = false;
    const int* list; const float* cwl; const int* cnt; bf16_t* Sl;
    __device__ __forceinline__ void operator()(const f32x4 (&acc)[2][2][4][2], const Unit& u, int wr, int wc, int fr, int fq) const {
        const int n = cnt[u.g];
#pragma unroll
        for (int ai = 0; ai < 2; ++ai) {
            int dd[4]; float ww[4];
#pragma unroll
            for (int m = 0; m < 4; ++m) { const int pos = u.lt * BM + ai * HALF + wr * 64 + m * 16 + fr; const bool ok = pos < n; const size_t li = (size_t)u.g * T + (ok ? pos : 0);
                const int d = list[li]; const float w = cwl[li]; dd[m] = ok ? d : -1; ww[m] = w; }
            EPI_HALF_RUN({
                const int col = u.pn * BM + lcol; const int d = dd[m]; const float w = ww[m];
                if (d >= 0) { _Pragma("unroll") for (int i = 0; i < 8; ++i) v[i] *= w; *(u32x4*)(Sl + (size_t)d * D + col) = pack8(v); }
            })
        }
    }
};

template <class Epi, class Sched, bool ALIGN_EPI = false, bool SP2 = false, bool GATHER = false>
__device__ __forceinline__ void gemm_phase(PG8_LAS unsigned char* lds, const int K, const int lda, const int ldb, const Sched& S, const Epi& E, const PG8_LAS int* rowtab = nullptr) {
    int tid = threadIdx.x; asm volatile("" : "+v"(tid));
    const int wid = __builtin_amdgcn_readfirstlane(tid >> 6), lane = tid & 63, wr = wid >> 2, wc = wid & 3, fr = lane & 15, fq = lane >> 4;
    const int nt = K / BK;
    unsigned voffA[2], voffB[2]; int gR[2]; unsigned gC[2];
#pragma unroll
    for (int i = 0; i < 2; ++i) { int R, C; stage_rc(tid * 16 + i * 8192, R, C); const int Rb = Epi::PERM ? ((R & ~31) + perm32(R & 31)) : R;
        voffA[i] = (unsigned)(R * lda + C) * 2u; voffB[i] = (unsigned)(Rb * ldb + C) * 2u; gR[i] = R; gC[i] = (unsigned)C * 2u; }
    unsigned vAc[2][2], vAn[2][2], vA2[2][2];
    (void)gR; (void)gC; (void)vAc; (void)vAn; (void)vA2;
#define PG8_GLOAD(dst, ui_) do { _Pragma("unroll") for (int _h = 0; _h < 2; ++_h) _Pragma("unroll") for (int _i = 0; _i < 2; ++_i) \
        dst[_h][_i] = (unsigned)rowtab[(ui_) * 256 + _h * HALF + gR[_i]] * (unsigned)(lda * 2) + gC[_i]; } while (0)
    const size_t kstep = (size_t)(BK * 2);
    const size_t hstepA = (size_t)HALF * lda * 2, hstepB = (size_t)HALF * ldb * 2;
    const unsigned ldsw = (unsigned)wid * 1024u;
    const int aoff = lds_byte(wr * 64 + fr, fq * 8), boff = lds_byte(wc * 32 + fr, fq * 8);
#define PG8_SA(b, h) (((b) * 2 + (h)) * HTB)
#define PG8_SB(b, h) ((4 + (b) * 2 + (h)) * HTB)
#define PG8_STAGE(bufoff, gbase, voff) do { _Pragma("unroll") for (int _i = 0; _i < 2; ++_i) \
        __builtin_amdgcn_global_load_lds((const unsigned*)((const char*)(gbase) + (voff)[_i]), (PG8_LAS unsigned*)(lds + (bufoff) + ldsw + _i * 8192), 16, 0, 0); } while (0)
#define PG8_STAGE_A(bufoff, gbase, h, vs) do { if constexpr (GATHER) { PG8_STAGE(bufoff, gbase, vs[h]); } else { PG8_STAGE(bufoff, (gbase) + (h) * hstepA, voffA); } } while (0)
#define PG8_LDA(dst, b, h) do { _Pragma("unroll") for (int m = 0; m < 4; ++m) _Pragma("unroll") for (int k = 0; k < 2; ++k) dst[m][k] = *(const PG8_LAS bf16x8*)(lds + PG8_SA(b, h) + aoff + m * 2048 + k * 1024); } while (0)
#define PG8_LDB(dst, b, h) do { _Pragma("unroll") for (int n = 0; n < 2; ++n) _Pragma("unroll") for (int k = 0; k < 2; ++k) dst[n][k] = *(const PG8_LAS bf16x8*)(lds + PG8_SB(b, h) + boff + n * 2048 + k * 1024); } while (0)
#define PG8_MMA(ai, bj, At, Bt) do { __builtin_amdgcn_s_setprio(1); _Pragma("unroll") for (int m = 0; m < 4; ++m) _Pragma("unroll") for (int n = 0; n < 2; ++n) _Pragma("unroll") for (int k = 0; k < 2; ++k) \
        acc[ai][bj][m][n] = __builtin_amdgcn_mfma_f32_16x16x32_bf16(Bt[n][k], At[m][k], acc[ai][bj][m][n], 0, 0, 0); __builtin_amdgcn_s_setprio(0); } while (0)
#define PG8_WAIT_V(n) asm volatile("s_waitcnt vmcnt(" #n ")" ::: "memory")
#define PG8_WAIT_L(n) asm volatile("s_waitcnt lgkmcnt(" #n ")" ::: "memory")
#define PG8_BAR __builtin_amdgcn_s_barrier()
#define PG8_SCHED __builtin_amdgcn_sched_barrier(0)
    Unit cur, nxt; int ui = 0;
    if (!S.next(0, cur)) return;
    f32x4 acc[2][2][4][2];
#pragma unroll
    for (int a = 0; a < 2; ++a)
#pragma unroll
        for (int b = 0; b < 2; ++b)
#pragma unroll
            for (int m = 0; m < 4; ++m)
#pragma unroll
                for (int n = 0; n < 2; ++n) acc[a][b][m][n] = (f32x4){0.f, 0.f, 0.f, 0.f};
    bf16x8 At[4][2], B0[2][2], B1[2][2];
    const char* cA = cur.a; const char* cB = cur.b;
    if constexpr (GATHER) { PG8_GLOAD(vAc, 0); }
    static_assert(SP2 || !GATHER, "GATHER is wired into the SP2 loop only");
    if constexpr (SP2) {
        PG8_STAGE(PG8_SB(0, 0), cB, voffB); PG8_STAGE(PG8_SB(0, 1), cB + hstepB, voffB); PG8_STAGE_A(PG8_SA(0, 0), cA, 0, vAc); PG8_STAGE_A(PG8_SA(0, 1), cA, 1, vAc);
        if (wr == 1) PG8_BAR;
        PG8_WAIT_V(2); PG8_BAR;
        PG8_STAGE(PG8_SB(1, 0), cB + kstep, voffB); PG8_STAGE_A(PG8_SA(1, 0), cA + kstep, 0, vAc); PG8_STAGE(PG8_SB(1, 1), cB + hstepB + kstep, voffB);
        PG8_WAIT_V(6); PG8_BAR;
    } else {
        PG8_STAGE(PG8_SB(0, 0), cB, voffB); PG8_STAGE(PG8_SA(0, 0), cA, voffA); PG8_STAGE(PG8_SB(0, 1), cB + hstepB, voffB); PG8_STAGE(PG8_SA(0, 1), cA + hstepA, voffA);
        if (wr == 1) PG8_BAR;
        PG8_WAIT_V(4); PG8_BAR;
        PG8_STAGE(PG8_SB(1, 0), cB + kstep, voffB); PG8_STAGE(PG8_SA(1, 0), cA + kstep, voffA); PG8_STAGE(PG8_SB(1, 1), cB + hstepB + kstep, voffB);
        PG8_WAIT_V(6); PG8_BAR;
    }
    for (;;) {
        const bool has_next = S.next(ui + 1, nxt);
        const char* nA = has_next ? nxt.a : cA; const char* nB = has_next ? nxt.b : cB;
        if constexpr (GATHER) { if (has_next) { PG8_GLOAD(vAn, ui + 1); } else {
            _Pragma("unroll") for (int _h = 0; _h < 2; ++_h) _Pragma("unroll") for (int _i = 0; _i < 2; ++_i) vAn[_h][_i] = vAc[_h][_i]; } }
        for (int t = 0; t < nt; t += 2) {
            const bool last = (t == nt - 2);
            if constexpr (GATHER) { _Pragma("unroll") for (int _h = 0; _h < 2; ++_h) _Pragma("unroll") for (int _i = 0; _i < 2; ++_i) vA2[_h][_i] = last ? vAn[_h][_i] : vAc[_h][_i]; }
            const char* a1 = cA + (size_t)(t + 1) * kstep;
            const char* a2 = last ? nA : cA + (size_t)(t + 2) * kstep; const char* b2 = last ? nB : cB + (size_t)(t + 2) * kstep;
            const char* a3 = a2 + kstep; const char* b3 = b2 + kstep;
            if constexpr (SP2) {
            PG8_LDB(B0, 0, 0); PG8_LDB(B1, 0, 1); PG8_SCHED; PG8_LDA(At, 0, 0); PG8_STAGE_A(PG8_SA(1, 1), a1, 1, vAc);
            PG8_WAIT_V(8); PG8_WAIT_L(0); PG8_BAR; PG8_MMA(0, 0, At, B0); PG8_MMA(0, 1, At, B1); PG8_BAR; PG8_SCHED;
            PG8_LDA(At, 0, 1); PG8_STAGE(PG8_SB(0, 0), b2, voffB); PG8_STAGE(PG8_SB(0, 1), b2 + hstepB, voffB); PG8_STAGE_A(PG8_SA(0, 0), a2, 0, vA2);
            PG8_WAIT_V(8); PG8_WAIT_L(0); PG8_BAR; PG8_MMA(1, 0, At, B0); PG8_MMA(1, 1, At, B1); PG8_BAR; PG8_SCHED;
            PG8_LDB(B0, 1, 0); PG8_LDB(B1, 1, 1); PG8_SCHED; PG8_LDA(At, 1, 0); PG8_STAGE_A(PG8_SA(0, 1), a2, 1, vA2);
            PG8_WAIT_V(8); PG8_WAIT_L(0); PG8_BAR; PG8_MMA(0, 0, At, B0); PG8_MMA(0, 1, At, B1); PG8_BAR; PG8_SCHED;
            PG8_LDA(At, 1, 1); PG8_STAGE(PG8_SB(1, 0), b3, voffB); PG8_STAGE(PG8_SB(1, 1), b3 + hstepB, voffB); PG8_STAGE_A(PG8_SA(1, 0), a3, 0, vA2);
            PG8_WAIT_V(8); PG8_WAIT_L(0); PG8_BAR; PG8_MMA(1, 0, At, B0); PG8_MMA(1, 1, At, B1); PG8_BAR; PG8_SCHED;
            } else {
            PG8_LDB(B0, 0, 0); PG8_SCHED; PG8_LDA(At, 0, 0); PG8_STAGE(PG8_SA(1, 1), a1 + hstepA, voffA);
            PG8_WAIT_L(8); PG8_BAR; PG8_WAIT_L(0); PG8_MMA(0, 0, At, B0); PG8_BAR; PG8_SCHED;
            PG8_LDB(B1, 0, 1); PG8_STAGE(PG8_SB(0, 0), b2, voffB);
            PG8_BAR; PG8_WAIT_L(0); PG8_MMA(0, 1, At, B1); PG8_BAR;
            PG8_LDA(At, 0, 1); PG8_STAGE(PG8_SA(0, 0), a2, voffA);
            PG8_BAR; PG8_WAIT_L(0); PG8_MMA(1, 0, At, B0); PG8_BAR; PG8_SCHED;
            PG8_STAGE(PG8_SB(0, 1), b2 + hstepB, voffB);
            PG8_WAIT_V(6); PG8_BAR; PG8_MMA(1, 1, At, B1); PG8_BAR;
            PG8_LDB(B0, 1, 0); PG8_SCHED; PG8_LDA(At, 1, 0); PG8_STAGE(PG8_SA(0, 1), a2 + hstepA, voffA);
            PG8_WAIT_L(8); PG8_BAR; PG8_WAIT_L(0); PG8_MMA(0, 0, At, B0); PG8_BAR; PG8_SCHED;
            PG8_LDB(B1, 1, 1); PG8_STAGE(PG8_SB(1, 0), b3, voffB);
            PG8_BAR; PG8_WAIT_L(0); PG8_MMA(0, 1, At, B1); PG8_BAR;
            PG8_LDA(At, 1, 1); PG8_STAGE(PG8_SA(1, 0), a3, voffA);
            PG8_BAR; PG8_WAIT_L(0); PG8_MMA(1, 0, At, B0); PG8_BAR; PG8_SCHED;
            PG8_STAGE(PG8_SB(1, 1), b3 + hstepB, voffB);
            PG8_WAIT_V(6); PG8_BAR; PG8_MMA(1, 1, At, B1); PG8_BAR;
            }
        }
        if constexpr (ALIGN_EPI) { if (wr == 0) PG8_BAR; }
        E(acc, cur, wr, wc, fr, fq);
        if (!has_next) break;
#pragma unroll
        for (int a = 0; a < 2; ++a)
#pragma unroll
            for (int b = 0; b < 2; ++b)
#pragma unroll
                for (int m = 0; m < 4; ++m)
#pragma unroll
                    for (int n = 0; n < 2; ++n) acc[a][b][m][n] = (f32x4){0.f, 0.f, 0.f, 0.f};
        cur = nxt; cA = nA; cB = nB; ++ui;
        if constexpr (GATHER) { _Pragma("unroll") for (int _h = 0; _h < 2; ++_h) _Pragma("unroll") for (int _i = 0; _i < 2; ++_i) vAc[_h][_i] = vAn[_h][_i]; }
        if constexpr (ALIGN_EPI) { if (wr == 1) PG8_BAR; }
    }
    PG8_WAIT_V(0);
    if constexpr (!ALIGN_EPI) { if (wr == 0) PG8_BAR; }
    PG8_BAR;
#undef PG8_SA
#undef PG8_SB
#undef PG8_STAGE
#undef PG8_STAGE_A
#undef PG8_GLOAD
#undef PG8_LDA
#undef PG8_LDB
#undef PG8_MMA
#undef PG8_WAIT_V
#undef PG8_WAIT_L
#undef PG8_BAR
#undef PG8_SCHED
}
}

namespace attn_body {
using bf16=__hip_bfloat16;
using bf16x8=__attribute__((ext_vector_type(8)))short;
using s16x4=__attribute__((ext_vector_type(4)))short;
using f32x16=__attribute__((ext_vector_type(16)))float;
using u32x4=__attribute__((ext_vector_type(4)))unsigned;
constexpr int NHEAD=16,SEQ=4096,D=64,DM=NHEAD*D;
constexpr int NW=8,QBLK=32,QB=QBLK*NW,KVBLK=64,NQB=SEQ/QB;
__device__ __forceinline__ int crow(int r,int hi){return (r&3)+8*(r>>2)+4*hi;}
#define SBAR() __builtin_amdgcn_sched_barrier(0)
__device__ __forceinline__ void cmask(f32x16&p0,f32x16&p1,int jb,int wid){
  const float NEG=-INFINITY;
  if(jb>(wid>>1)){
  #pragma unroll
  for(int r=0;r<16;++r){p0[r]=NEG;p1[r]=NEG;}}
}
constexpr int NSLOT=3, SLOTB=8192, VSLOTB=16384;
constexpr int LDS_K=0, LDS_V=NSLOT*SLOTB, LDS_WS=LDS_V+NSLOT*VSLOTB, LDS_OST=LDS_WS+NW*64*4, LDS_BYTES=LDS_OST+NW*8192;
constexpr float C2=0.125f*1.4426950408889634f;
__device__ __forceinline__ void glds16(const char*sbase,unsigned voff,unsigned lds_dst){unsigned keep;
  asm volatile("s_mov_b32 %0, m0\n\ts_mov_b32 m0, %2\n\ts_nop 0\n\tglobal_load_lds_dwordx4 %1, %3\n\ts_mov_b32 m0, %0":"=&s"(keep):"v"(voff),"s"(lds_dst),"s"(sbase):"memory");}
__device__ __forceinline__ float max3f(float a,float b,float c){float r;asm("v_max3_f32 %0, %1, %2, %3":"=v"(r):"v"(a),"v"(b),"v"(c));return r;}
__device__ __forceinline__ float max2f(float a,float b){float r;asm("v_max_f32_e32 %0, %1, %2":"=v"(r):"v"(a),"v"(b));return r;}
typedef float f32x2_t __attribute__((ext_vector_type(2))); typedef __bf16 bf16x2_t __attribute__((ext_vector_type(2)));
__device__ __forceinline__ unsigned cvtpk_s(float lo,float hi){f32x2_t v={lo,hi};bf16x2_t b=__builtin_convertvector(v,bf16x2_t);return __builtin_bit_cast(unsigned,b);}
#define WAIT_BAR(N) asm volatile("s_waitcnt vmcnt(" #N ") lgkmcnt(0)\n\ts_barrier":::"memory")

__device__ __forceinline__ void qkt(f32x16&p0,f32x16&p1,const char*Kslot,const bf16x8*qr,int r32,int hi){
  const char*kb=Kslot+hi*1024+r32*16; const f32x16 z=f32x16{};
  #pragma unroll
  for(int d0=0;d0<4;++d0){
    const bf16x8 b0=*reinterpret_cast<const bf16x8*>(kb+d0*2048);
    const bf16x8 b1=*reinterpret_cast<const bf16x8*>(kb+d0*2048+512);
    if(d0==0){p0=__builtin_amdgcn_mfma_f32_32x32x16_bf16(b0,qr[0],z,0,0,0);p1=__builtin_amdgcn_mfma_f32_32x32x16_bf16(b1,qr[0],z,0,0,0);}
    else{p0=__builtin_amdgcn_mfma_f32_32x32x16_bf16(b0,qr[d0],p0,0,0,0);p1=__builtin_amdgcn_mfma_f32_32x32x16_bf16(b1,qr[d0],p1,0,0,0);}}
}
typedef __attribute__((address_space(3))) const char* lds_cptr;
typedef short v4i16_t __attribute__((ext_vector_type(4)));
__device__ __forceinline__ void kload8(bf16x8*kf,lds_cptr kp){
  kf[0]=*(const __attribute__((address_space(3))) bf16x8*)(kp);      kf[1]=*(const __attribute__((address_space(3))) bf16x8*)(kp+512);
  kf[2]=*(const __attribute__((address_space(3))) bf16x8*)(kp+2048); kf[3]=*(const __attribute__((address_space(3))) bf16x8*)(kp+2560);
  kf[4]=*(const __attribute__((address_space(3))) bf16x8*)(kp+4096); kf[5]=*(const __attribute__((address_space(3))) bf16x8*)(kp+4608);
  kf[6]=*(const __attribute__((address_space(3))) bf16x8*)(kp+6144); kf[7]=*(const __attribute__((address_space(3))) bf16x8*)(kp+6656);
}
__device__ __forceinline__ void kload2(bf16x8*kf,lds_cptr kp,int j){ kf[2*j]=*(const __attribute__((address_space(3))) bf16x8*)(kp+j*2048); kf[2*j+1]=*(const __attribute__((address_space(3))) bf16x8*)(kp+j*2048+512); }
__device__ __forceinline__ s16x4 vtr(lds_cptr p){ return __builtin_bit_cast(s16x4,__builtin_amdgcn_ds_read_tr16_b64_v4i16((__attribute__((address_space(3))) v4i16_t*)p)); }
__device__ __forceinline__ float rowmax(const f32x16&p0,const f32x16&p1){
  float a=max3f(p0[0],p0[1],p1[0]),b=max3f(p0[2],p0[3],p1[1]);a=max3f(a,p1[2],p1[3]);
  #pragma unroll
  for(int r=4;r<16;r+=4){a=max3f(a,p0[r],p0[r+1]);b=max3f(b,p0[r+2],p0[r+3]);a=max3f(a,p1[r],p1[r+1]);b=max3f(b,p1[r+2],p1[r+3]);}
  const float m=max2f(a,b);
  auto rr=__builtin_amdgcn_permlane32_swap(__float_as_uint(m),__float_as_uint(m),false,false);
  return max2f(__uint_as_float(rr[0]),__uint_as_float(rr[1]));
}
__device__ __forceinline__ void pv(f32x16*o,int vb,bf16x8 pa0,bf16x8 pa1,bf16x8 pa2,bf16x8 pa3){
  #pragma unroll
  for(int d0=0;d0<4;++d0){s16x4 lo[4],hi[4];
    #pragma unroll
    for(int ks=0;ks<4;++ks){
      asm volatile("ds_read_b64_tr_b16 %0,%1 offset:%c2":"=&v"(lo[ks]):"v"(vb),"i"(d0*4096+ks*1024):"memory");
      asm volatile("ds_read_b64_tr_b16 %0,%1 offset:%c2":"=&v"(hi[ks]):"v"(vb),"i"(d0*4096+ks*1024+512):"memory");}
    asm volatile("s_waitcnt lgkmcnt(0)":::"memory");SBAR();
    #define PK(k) (bf16x8){lo[k][0],lo[k][1],lo[k][2],lo[k][3],hi[k][0],hi[k][1],hi[k][2],hi[k][3]}
    o[d0]=__builtin_amdgcn_mfma_f32_32x32x16_bf16(pa0,PK(0),o[d0],0,0,0);
    o[d0]=__builtin_amdgcn_mfma_f32_32x32x16_bf16(pa1,PK(1),o[d0],0,0,0);
    o[d0]=__builtin_amdgcn_mfma_f32_32x32x16_bf16(pa2,PK(2),o[d0],0,0,0);
    o[d0]=__builtin_amdgcn_mfma_f32_32x32x16_bf16(pa3,PK(3),o[d0],0,0,0);
    #undef PK
  }
}
template<int THRL,size_t OFF_Q,size_t OFF_K,size_t OFF_V,int GSO> __device__ __forceinline__ void attn_unit(int b,int h,int qb,const char*ws,bf16*AO,float lam,char*shm){
  const bf16*Q=(const bf16*)(ws+OFF_Q); const float*gs=(const float*)(shm+GSO);
  int tid=threadIdx.x; asm volatile("":"+v"(tid)); const int lane=tid&63,r32=lane&31,hi=lane>>5; const int wid=__builtin_amdgcn_readfirstlane(tid>>6);
  const long rowbase=(long)b*SEQ; const int q0=qb*QB;
  const unsigned lds0=(unsigned)(uintptr_t)shm;
  float*wsf=(float*)(shm+LDS_WS)+wid*64;
  bf16*stg=(bf16*)(shm+LDS_OST)+wid*4096;
  const unsigned kdst=lds0+LDS_K+wid*1024, vdst=lds0+LDS_V+wid*1024;
  const int vb0=(int)(lds0+LDS_V)+((lane>>4)&1)*32+(lane&3)*8+(4*hi+((lane&15)>>2))*64;
  const char*Kbase=shm+LDS_K;
  const lds_cptr shm3=(lds_cptr)shm; const lds_cptr kp0=shm3+LDS_K+hi*1024+r32*16; const lds_cptr vp0=shm3+LDS_V+((lane>>4)&1)*32+(lane&3)*8+(4*hi+((lane&15)>>2))*64;
  const int NT=(q0+QB)/KVBLK;
  const char*Vh=ws+OFF_V+(rowbase*DM+h*128)*2;
  const unsigned vsrc=(unsigned)(((16*(wid&3)+(lane>>2))*DM+(wid>>2)*32+(lane&3)*8)*2);
  #pragma unroll 1
  for(int mp=0;mp<2;++mp){
  const int hq=2*h+mp;
  const bf16*Qw=Q+(rowbase+q0+wid*QBLK)*DM+hq*D;
  const char*Kh=ws+OFF_K+(rowbase*DM+hq*D)*2;
  const unsigned ksrc=(unsigned)((lane*DM+wid*8)*2);
  bf16x8 kf[8];
  #define DMA_K(t,slot) glds16(Kh+(long)(t)*(KVBLK*DM*2),ksrc,(unsigned)__builtin_amdgcn_readfirstlane(kdst+(slot)))
  #define DMA_V(t,slot) do{ glds16(Vh+(long)(t)*(KVBLK*DM*2),vsrc,(unsigned)__builtin_amdgcn_readfirstlane(vdst+2*(slot))); glds16(Vh+(long)(t)*(KVBLK*DM*2)+128,vsrc,(unsigned)__builtin_amdgcn_readfirstlane(vdst+2*(slot)+8192)); }while(0)
  DMA_K(0,0);DMA_V(0,0);DMA_K(1,SLOTB);
  bf16x8 qr[4];
  #pragma unroll
  for(int d0=0;d0<4;++d0)qr[d0]=*reinterpret_cast<const bf16x8*>(&Qw[(long)r32*DM+d0*16+hi*8]);
  float mhat=0.f,l_reg=0.f;f32x16 o[4];o[0]=f32x16{};o[1]=f32x16{};o[2]=f32x16{};o[3]=f32x16{};
  #define CMASK(P0,P1,t) do{int jb_=(t)-(NT-4); if(jb_>=0)cmask(P0,P1,jb_,wid);}while(0)
  bool resc=false;
  #define RESC() do{ if(resc){ asm volatile("s_waitcnt lgkmcnt(0)":::"memory"); \
      _Pragma("unroll") for(int d_=0;d_<4;++d_) _Pragma("unroll") for(int r=0;r<16;++r)o[d_][r]*=wsf[crow(r,hi)]; } }while(0)
  f32x16 pA0,pA1,pB0,pB1;
  int sl_prev=0,sl_cur=0,sl_next=SLOTB;
  #define ROT() do{sl_prev=sl_cur;sl_cur=sl_next;sl_next=(sl_next==(NSLOT-1)*SLOTB)?0:sl_next+SLOTB;}while(0)
  DMA_K(2,2*SLOTB);
  WAIT_BAR(4);
  qkt(pA0,pA1,Kbase,qr,r32,hi);asm volatile("s_nop 15\n\ts_nop 7":"+v"(pA0),"+v"(pA1));CMASK(pA0,pA1,0);
  { const float rm=rowmax(pA0,pA1); mhat=rm; resc=false;
    _Pragma("unroll") for(int r=0;r<16;++r){pA0[r]=__builtin_amdgcn_exp2f(pA0[r]-mhat);pA1[r]=__builtin_amdgcn_exp2f(pA1[r]-mhat);} }
  WAIT_BAR(0);
  DMA_K(3,0);DMA_V(1,SLOTB);
  ROT();
  kload8(kf,kp0+sl_cur);
  WAIT_BAR(3);
  s16x4 vlo[8],vhi[8]; u32x4 pw0,pw1,pw2,pw3;
  #define PKW(P,B) cvtpk_s(P[B],P[B+1])
  #define PAF(k) __builtin_bit_cast(bf16x8,pw##k)
  #define VFR(i) (bf16x8){vlo[i][0],vlo[i][1],vlo[i][2],vlo[i][3],vhi[i][0],vhi[i][1],vhi[i][2],vhi[i][3]}
  #define PIN(x) asm volatile("":"+v"(x))
  #define MX3(a,b,c) __builtin_fmaxf(__builtin_fmaxf((a),(b)),(c))
  #define ZC (f32x16{})
  #define GAPA(MF,A0,A1,A2,A3,W0,W1,PW) do{ MF; sacc+=A0; sacc+=A1; sacc+=A2; sacc+=A3; PIN(sacc); W0; W1; PIN(PW); SBAR(); }while(0)
  #define EX(v) __builtin_amdgcn_exp2f((v)-mhat)
  #define GAPB(MF,X,B) do{ MF; X[B]=EX(X[B]); X[B+1]=EX(X[B+1]); PIN(X); SBAR(); }while(0)
  #define VRD(i) do{ vlo[i]=vtr(vp_+(((i)>>2)*4096+((i)&3)*1024)); vhi[i]=vtr(vp_+(((i)>>2)*4096+((i)&3)*1024+512)); }while(0)
  #define VRD2(i) do{ vlo[i]=vtr(vp_+((2+((i)>>2))*4096+((i)&3)*1024)); vhi[i]=vtr(vp_+((2+((i)>>2))*4096+((i)&3)*1024+512)); SBAR(); }while(0)
  #define KRD(G,j) do{ if(G){ kload2(kf,kp0+sl_next,j); SBAR(); } }while(0)
  #define STEP(C0,C1,P0,P1,t,GK,GV,GL) do{ SBAR(); \
    const lds_cptr vp_=vp0+2*sl_prev; \
    VRD(0); SBAR(); float sacc=(P0[0]+P0[1]); \
    GAPA(C0=__builtin_amdgcn_mfma_f32_32x32x16_bf16(kf[0],qr[0],ZC,0,0,0), P0[2],P0[3],P0[4],P0[5],     pw0[0]=PKW(P0,0), pw0[1]=PKW(P0,2), pw0); \
    VRD(4); SBAR(); GAPA(C1=__builtin_amdgcn_mfma_f32_32x32x16_bf16(kf[1],qr[0],ZC,0,0,0), P0[6],P0[7],P0[8],P0[9],     pw0[2]=PKW(P0,4), pw0[3]=PKW(P0,6), pw0); \
    VRD(1); SBAR(); GAPA(C0=__builtin_amdgcn_mfma_f32_32x32x16_bf16(kf[2],qr[1],C0,0,0,0),   P0[10],P0[11],P0[12],P0[13], pw1[0]=PKW(P0,8), pw1[1]=PKW(P0,10), pw1); \
    VRD(5); SBAR(); GAPA(C1=__builtin_amdgcn_mfma_f32_32x32x16_bf16(kf[3],qr[1],C1,0,0,0),   P0[14],P0[15],P1[0],P1[1],   pw1[2]=PKW(P0,12),pw1[3]=PKW(P0,14), pw1); \
    VRD(2); SBAR(); GAPA(C0=__builtin_amdgcn_mfma_f32_32x32x16_bf16(kf[4],qr[2],C0,0,0,0),   P1[2],P1[3],P1[4],P1[5],     pw2[0]=PKW(P1,0), pw2[1]=PKW(P1,2), pw2); \
    VRD(6); SBAR(); GAPA(C1=__builtin_amdgcn_mfma_f32_32x32x16_bf16(kf[5],qr[2],C1,0,0,0),   P1[6],P1[7],P1[8],P1[9],     pw2[2]=PKW(P1,4), pw2[3]=PKW(P1,6), pw2); \
    VRD(3); SBAR(); GAPA(C0=__builtin_amdgcn_mfma_f32_32x32x16_bf16(kf[6],qr[3],C0,0,0,0),   P1[10],P1[11],P1[12],P1[13], pw3[0]=PKW(P1,8), pw3[1]=PKW(P1,10), pw3); \
    VRD(7); SBAR(); GAPA(C1=__builtin_amdgcn_mfma_f32_32x32x16_bf16(kf[7],qr[3],C1,0,0,0),   P1[14],P1[15],0.f,0.f,       pw3[2]=PKW(P1,12),pw3[3]=PKW(P1,14), pw3); \
    l_reg+=sacc; \
    if(GK){DMA_K((t)+3,sl_cur);} if(GV){DMA_V((t)+1,sl_next);} \
    CMASK(C0,C1,t); \
    { float a=MX3(C0[0],C0[1],C1[0]),b=MX3(C0[2],C0[3],C1[1]); a=MX3(a,C1[2],C1[3]); \
      _Pragma("unroll") for(int r=4;r<16;r+=4){a=MX3(a,C0[r],C0[r+1]);b=MX3(b,C0[r+2],C0[r+3]);a=MX3(a,C1[r],C1[r+1]);b=MX3(b,C1[r+2],C1[r+3]);} \
      float rm=__builtin_fmaxf(a,b); { auto rr=__builtin_amdgcn_permlane32_swap(__float_as_uint(rm),__float_as_uint(rm),false,false); rm=__builtin_fmaxf(__uint_as_float(rr[0]),__uint_as_float(rr[1])); } \
      rm-=mhat; resc=false; \
      if(__builtin_expect(__any(rm>(float)THRL),0)){ const float dl=__builtin_fmaxf(rm,0.f); mhat+=dl; \
        const float f=__builtin_amdgcn_exp2f(-dl); l_reg*=f; if(hi==0)wsf[r32]=f; resc=true; } } \
    SBAR(); \
    GAPB(o[0]=__builtin_amdgcn_mfma_f32_32x32x16_bf16(PAF(0),VFR(0),o[0],0,0,0), C0,0);  VRD2(0); \
    GAPB(o[1]=__builtin_amdgcn_mfma_f32_32x32x16_bf16(PAF(0),VFR(4),o[1],0,0,0), C0,2);  VRD2(4); \
    GAPB(o[0]=__builtin_amdgcn_mfma_f32_32x32x16_bf16(PAF(1),VFR(1),o[0],0,0,0), C0,4);  VRD2(1); \
    GAPB(o[1]=__builtin_amdgcn_mfma_f32_32x32x16_bf16(PAF(1),VFR(5),o[1],0,0,0), C0,6);  VRD2(5); \
    GAPB(o[0]=__builtin_amdgcn_mfma_f32_32x32x16_bf16(PAF(2),VFR(2),o[0],0,0,0), C0,8);  VRD2(2); \
    GAPB(o[1]=__builtin_amdgcn_mfma_f32_32x32x16_bf16(PAF(2),VFR(6),o[1],0,0,0), C0,10); VRD2(6); \
    GAPB(o[0]=__builtin_amdgcn_mfma_f32_32x32x16_bf16(PAF(3),VFR(3),o[0],0,0,0), C0,12); VRD2(3); \
    GAPB(o[1]=__builtin_amdgcn_mfma_f32_32x32x16_bf16(PAF(3),VFR(7),o[1],0,0,0), C0,14); VRD2(7); \
    KRD(GL,0); GAPB(o[2]=__builtin_amdgcn_mfma_f32_32x32x16_bf16(PAF(0),VFR(0),o[2],0,0,0), C1,0); \
    KRD(GL,1); GAPB(o[3]=__builtin_amdgcn_mfma_f32_32x32x16_bf16(PAF(0),VFR(4),o[3],0,0,0), C1,2); \
    KRD(GL,2); GAPB(o[2]=__builtin_amdgcn_mfma_f32_32x32x16_bf16(PAF(1),VFR(1),o[2],0,0,0), C1,4); \
    KRD(GL,3); GAPB(o[3]=__builtin_amdgcn_mfma_f32_32x32x16_bf16(PAF(1),VFR(5),o[3],0,0,0), C1,6); \
    GAPB(o[2]=__builtin_amdgcn_mfma_f32_32x32x16_bf16(PAF(2),VFR(2),o[2],0,0,0), C1,8); \
    GAPB(o[3]=__builtin_amdgcn_mfma_f32_32x32x16_bf16(PAF(2),VFR(6),o[3],0,0,0), C1,10); \
    GAPB(o[2]=__builtin_amdgcn_mfma_f32_32x32x16_bf16(PAF(3),VFR(3),o[2],0,0,0), C1,12); \
    GAPB(o[3]=__builtin_amdgcn_mfma_f32_32x32x16_bf16(PAF(3),VFR(7),o[3],0,0,0), C1,14); \
    }while(0)
  int t=1;
  #undef CMASK
  #define CMASK(P0,P1,t) do{}while(0)
  for(;t+5<NT;t+=2){
    STEP(pB0,pB1,pA0,pA1,t,true,true,true);     WAIT_BAR(3); RESC(); ROT();
    STEP(pA0,pA1,pB0,pB1,t+1,true,true,true);   WAIT_BAR(3); RESC(); ROT();
  }
  #undef CMASK
  #define CMASK(P0,P1,t) do{int jb_=(t)-(NT-4); if(jb_>=0)cmask(P0,P1,jb_,wid);}while(0)
  #define ENDW(tt) do{ if((tt)+3<NT){WAIT_BAR(3);} else if((tt)+2<NT){WAIT_BAR(2);} else {WAIT_BAR(0);} }while(0)
  for(;t+1<NT;t+=2){
    STEP(pB0,pB1,pA0,pA1,t,(t+3<NT),(t+1<NT),(t+1<NT));       ENDW(t);   RESC(); ROT();
    STEP(pA0,pA1,pB0,pB1,t+1,(t+4<NT),(t+2<NT),(t+2<NT));     ENDW(t+1); RESC(); ROT();
  }
  STEP(pB0,pB1,pA0,pA1,NT-1,false,false,false); RESC();
  { float sacc=pB0[0]+pB0[1]; _Pragma("unroll") for(int r=2;r<16;++r)sacc+=pB0[r]; _Pragma("unroll") for(int r=0;r<16;++r)sacc+=pB1[r]; l_reg+=sacc;
    pw0=(u32x4){PKW(pB0,0),PKW(pB0,2),PKW(pB0,4),PKW(pB0,6)};pw1=(u32x4){PKW(pB0,8),PKW(pB0,10),PKW(pB0,12),PKW(pB0,14)};pw2=(u32x4){PKW(pB1,0),PKW(pB1,2),PKW(pB1,4),PKW(pB1,6)};pw3=(u32x4){PKW(pB1,8),PKW(pB1,10),PKW(pB1,12),PKW(pB1,14)};
    SBAR(); pv(o,vb0+2*sl_cur,PAF(0),PAF(1),PAF(2),PAF(3)); }
  #undef PKW
  #undef PAF
  #undef VFR
  #undef PIN
  #undef MX3
  #undef ZC
  #undef GAPA
  #undef GAPB
  #undef EX
  #undef VRD
  #undef VRD2
  #undef KRD
  #undef STEP
  #undef ENDW
  #undef DMA_K
  #undef DMA_V
  #undef CMASK
  #undef RESC
  #undef ROT
  {auto rr=__builtin_amdgcn_permlane32_swap(__float_as_uint(l_reg),__float_as_uint(l_reg),false,false);l_reg=__uint_as_float(rr[0])+__uint_as_float(rr[1]);}
  if(hi==0)wsf[32+r32]=l_reg;asm volatile("s_waitcnt lgkmcnt(0)":::"memory");
  float rli[16];
  #pragma unroll
  for(int r=0;r<16;++r)rli[r]=__builtin_amdgcn_rcpf(wsf[32+crow(r,hi)]);
  if(mp==0){
    #pragma unroll
    for(int r=0;r<16;++r){const int orow=crow(r,hi);
      #pragma unroll
      for(int d0=0;d0<4;++d0)stg[orow*128+d0*32+r32]=__float2bfloat16(o[d0][r]*rli[r]);}
  } else {
    #pragma unroll
    for(int r=0;r<16;++r){const int orow=crow(r,hi);
      #pragma unroll
      for(int d0=0;d0<4;++d0){ const float c=__bfloat162float(stg[orow*128+d0*32+r32])-lam*(o[d0][r]*rli[r]); stg[orow*128+d0*32+r32]=__float2bfloat16(c);} }
    asm volatile("s_waitcnt lgkmcnt(0)":::"memory");
    const int row=lane>>1,hf=lane&1; float cv[64]; float ss=0.f;
    #pragma unroll
    for(int i=0;i<8;++i){ const u32x4 w=*(const u32x4*)(stg+row*128+hf*64+i*8);
      cv[8*i+0]=__uint_as_float(w.x<<16);cv[8*i+1]=__uint_as_float(w.x&0xffff0000u);cv[8*i+2]=__uint_as_float(w.y<<16);cv[8*i+3]=__uint_as_float(w.y&0xffff0000u);
      cv[8*i+4]=__uint_as_float(w.z<<16);cv[8*i+5]=__uint_as_float(w.z&0xffff0000u);cv[8*i+6]=__uint_as_float(w.w<<16);cv[8*i+7]=__uint_as_float(w.w&0xffff0000u); }
    #pragma unroll
    for(int i=0;i<64;++i)ss+=cv[i]*cv[i];
    ss+=__int_as_float(__builtin_amdgcn_ds_bpermute((lane^1)<<2,__float_as_int(ss)));
    const float rstd=1.0f/sqrtf(ss*(1.0f/128.0f)+1e-6f);
    bf16*Ow=AO+(rowbase+q0+wid*QBLK+row)*DM+h*128+hf*64;
    #pragma unroll
    for(int i=0;i<8;++i){ const float4 g0=*(const float4*)(gs+hf*64+i*8),g1=*(const float4*)(gs+hf*64+i*8+4); u32x4 w;
      w.x=cvtpk_s(cv[8*i+0]*rstd*g0.x,cv[8*i+1]*rstd*g0.y); w.y=cvtpk_s(cv[8*i+2]*rstd*g0.z,cv[8*i+3]*rstd*g0.w);
      w.z=cvtpk_s(cv[8*i+4]*rstd*g1.x,cv[8*i+5]*rstd*g1.y); w.w=cvtpk_s(cv[8*i+6]*rstd*g1.z,cv[8*i+7]*rstd*g1.w);
      *(u32x4*)(Ow+i*8)=w; }
  }
  asm volatile("s_waitcnt lgkmcnt(0)\n\ts_barrier":::"memory");
  }
}
constexpr int ATTN_LDS_BYTES=LDS_BYTES;
#undef SBAR
#undef WAIT_BAR
}

constexpr size_t MiB = 1u << 20;
constexpr size_t WS_CTL = 0, CTL_ZERO_BYTES = 1 * MiB;
constexpr size_t WS_WIN = 2 * MiB;
constexpr size_t WS_WGLU = 13 * MiB;
constexpr size_t WS_WSSM = 14 * MiB;
constexpr size_t WS_WATT = 15 * MiB;
constexpr size_t WS_WOUT = 17 * MiB;
constexpr size_t WS_WR = 19 * MiB;
constexpr size_t WS_BTP = 20 * MiB;
constexpr size_t WS_BTY = 28 * MiB;
constexpr size_t WS_WE1 = 48 * MiB;
constexpr size_t WS_WE2 = 80 * MiB;
constexpr size_t WS_ETAB = 96 * MiB;
constexpr size_t WS_MOD = 104 * MiB;
constexpr size_t WS_UG = 112 * MiB;
constexpr size_t WS_Q = 152 * MiB, WS_K = 216 * MiB, WS_V = 280 * MiB;
constexpr size_t WS_GATES = 344 * MiB;
constexpr size_t WS_SLOC = 472 * MiB;
constexpr size_t WS_YACT = 152 * MiB;
constexpr size_t WS_S5O = 184 * MiB;
constexpr size_t WS_TMP = 280 * MiB;
constexpr size_t WS_H = 344 * MiB;
constexpr size_t WS_HDN = 256 * MiB;
constexpr size_t WS_SLOTS = 112 * MiB;
constexpr size_t WS_LIST = 472 * MiB;
constexpr size_t WS_CWL = 476 * MiB;
constexpr size_t WS_END = 512 * MiB;
constexpr int CW_TMO = 0, CW_BAR = 4096, CW_CNT = 16384;

constexpr int NWAVES = 8;
constexpr int RING_OFF = 0, RING_BYTES = 147456;
constexpr int LDSCTL_OFF = RING_BYTES, MISC_OFF = LDSCTL_OFF + 320;
constexpr int GS_OFF = MISC_OFF + 2048;
constexpr int ROWTAB_OFF = LDSCTL_OFF + 4096;
constexpr int LDS_BYTES = RING_BYTES + 8192;
static_assert(attn_body::ATTN_LDS_BYTES <= RING_BYTES, "attention LDS");

#define GAS __attribute__((address_space(1)))
#define LAS __attribute__((address_space(3)))
typedef unsigned short bf16;
typedef unsigned v4u __attribute__((ext_vector_type(4)));
typedef unsigned v2u __attribute__((ext_vector_type(2)));
typedef float f32x4 __attribute__((ext_vector_type(4)));
typedef GAS unsigned gu32;
#define RLX_AGENT __ATOMIC_RELAXED, __HIP_MEMORY_SCOPE_AGENT
#define LDS_WAIT() asm volatile("s_waitcnt lgkmcnt(0)" ::: "memory")
#define VM_WAIT() asm volatile("s_waitcnt vmcnt(0)" ::: "memory")
__device__ __forceinline__ unsigned f2bf(float f) { unsigned u = __builtin_bit_cast(unsigned, f); return (u + 0x7fffu + ((u >> 16) & 1u)) >> 16; }
__device__ __forceinline__ unsigned pk2(float lo, float hi) { return f2bf(lo) | (f2bf(hi) << 16); }
__device__ __forceinline__ float bf2f(unsigned b) { return __uint_as_float(b << 16); }

#define XB_TMO      128
#define XB_XCNT(j)  (256  + 64 * (j))
#define XB_XSUB(j)  (1280 + 64 * (j))
#define XB_XGEN(j)  (2304 + 64 * (j))
#define XB_TOP      3328
#define XB_TOPGEN   3392
#define XCD_BAR_WORDS 3456
#define XB_SPIN_CAP (1u << 18)
__device__ __forceinline__ unsigned xb_ld(unsigned* p)              { return __hip_atomic_load(p, __ATOMIC_RELAXED, __HIP_MEMORY_SCOPE_AGENT); }
__device__ __forceinline__ unsigned xb_add(unsigned* p, unsigned v) { return __hip_atomic_fetch_add(p, v, __ATOMIC_RELAXED, __HIP_MEMORY_SCOPE_AGENT); }
__device__ __forceinline__ unsigned xb_xcc_id() { return (unsigned)__builtin_amdgcn_s_getreg((3 << 11) | 20) & 0xFu; }
#define XB_SPIN(cond, bar) do { unsigned _sp = 0; while (cond) { __builtin_amdgcn_s_sleep(1); \
    if ((++_sp & 255u) == 0u) { if (xb_ld(&(bar)[XB_TMO])) break; if (_sp > XB_SPIN_CAP) { atomicAdd(&(bar)[XB_TMO], 1u); break; } } } } while (0)
struct XcdBarrier { unsigned* bar; unsigned x; volatile LAS unsigned* st; };
__device__ __forceinline__ XcdBarrier xcd_barrier_post(unsigned* bar, volatile LAS unsigned* st) {
    XcdBarrier b; b.bar = bar; b.x = xb_xcc_id(); b.st = st;
    if (threadIdx.x == 0) (void)xb_add(&bar[XB_XCNT(b.x)], 1u);
    return b;
}
__device__ __forceinline__ void xcd_barrier_complete(unsigned* bar, unsigned x, unsigned& nloc, unsigned& nx) {
    const unsigned G = gridDim.x * gridDim.y * gridDim.z;
    unsigned sum, cnt, mine, sp = 0u;
    for (;;) {
        sum = 0u; cnt = 0u; mine = 0u;
#pragma unroll
        for (unsigned j = 0; j < 16; ++j) { const unsigned c = xb_ld(&bar[XB_XCNT(j)]); sum += c; cnt += (c > 0u) ? 1u : 0u; mine = (j == x) ? c : mine; }
        if (sum == G) break;
        __builtin_amdgcn_s_sleep(1);
        if ((++sp & 255u) == 0u) { if (xb_ld(&bar[XB_TMO])) break; if (sp > XB_SPIN_CAP) { atomicAdd(&bar[XB_TMO], 1u); break; } }
    }
    nloc = mine > 0u ? mine : 1u; nx = cnt > 0u ? cnt : 1u;
}
__device__ __forceinline__ void xcd_barrier(const XcdBarrier& b) {
    asm volatile("s_waitcnt vmcnt(0)" ::: "memory");
    __syncthreads();
    if (threadIdx.x == 0) {
        unsigned* bar = b.bar;
        __builtin_amdgcn_s_waitcnt(0);
        unsigned nloc = b.st[0], nx = b.st[1];
        if (nloc == 0u) { xcd_barrier_complete(bar, b.x, nloc, nx); b.st[0] = nloc; b.st[1] = nx; }
        const unsigned old = xb_add(&bar[XB_XSUB(b.x)], 1u);
        const unsigned gen = old / nloc;
        if (old + 1u == (gen + 1u) * nloc) {
            __builtin_amdgcn_fence(__ATOMIC_RELEASE, "agent");
            asm volatile("s_waitcnt vmcnt(0)" ::: "memory");
            const unsigned og = xb_add(&bar[XB_TOP], 1u);
            const unsigned tg = og / nx;
            if (og + 1u == (tg + 1u) * nx) xb_add(&bar[XB_TOPGEN], 1u);
            else XB_SPIN(xb_ld(&bar[XB_TOPGEN]) == tg, bar);
            __builtin_amdgcn_fence(__ATOMIC_ACQUIRE, "agent");
            xb_add(&bar[XB_XGEN(b.x)], 1u);
            asm volatile("s_waitcnt vmcnt(0)" ::: "memory");
        } else {
            XB_SPIN(xb_ld(&bar[XB_XGEN(b.x)]) == gen, bar);
            __builtin_amdgcn_fence(__ATOMIC_ACQUIRE, "agent");
            asm volatile("s_waitcnt vmcnt(0)" ::: "memory");
        }
    }
    __syncthreads();
}

__device__ __forceinline__ float shfl_xor_l(float v, int o, int lane) { return __int_as_float(__builtin_amdgcn_ds_bpermute((lane ^ o) << 2, __float_as_int(v))); }
__device__ __forceinline__ float wave_sum(float v, int lane) {
#pragma unroll
    for (int o = 1; o < 64; o <<= 1) v += shfl_xor_l(v, o, lane);
    return v;
}
__device__ __forceinline__ void transpose_tile(const float* W, int N, int k0, int n0, bf16* WT, int ldo, int orow0, int ocol0, LAS float* scr, int lane) {
#pragma unroll 8
    for (int i = 0; i < 32; ++i) { const int kk = 2 * i + (lane >> 5); scr[kk * 33 + (lane & 31)] = W[(size_t)(k0 + kk) * N + n0 + (lane & 31)]; }
    LDS_WAIT(); asm volatile("" ::: "memory");
    const int c = lane & 7;
#pragma unroll
    for (int j = 0; j < 4; ++j) { const int n = (lane >> 3) + 8 * j; const LAS float* s = scr + (8 * c) * 33 + n;
        v4u o; o.x = pk2(s[0 * 33], s[1 * 33]); o.y = pk2(s[2 * 33], s[3 * 33]); o.z = pk2(s[4 * 33], s[5 * 33]); o.w = pk2(s[6 * 33], s[7 * 33]);
        *(GAS v4u*)(WT + (size_t)(orow0 + n) * ldo + ocol0 + 8 * c) = o; }
    LDS_WAIT(); asm volatile("" ::: "memory");
}
__device__ __forceinline__ void abar_pow(float lr, float li, float dt, float j, float& re, float& im) {
    const float mag = expf(lr * dt * j); float s, c; sincosf(li * dt * j, &s, &c); re = mag * c; im = mag * s;
}

constexpr int ETAB_OFF = MISC_OFF + 256;
__device__ __forceinline__ void build_expert_table(LAS unsigned char* L, const int* CNT, int tid) {
    LAS int* tab = (LAS int*)(L + ETAB_OFF);
    __syncthreads();
    if (tid == 0) { int rt = 0;
#pragma unroll 1
        for (int e = 0; e < NEXP; ++e) { const int nt = (CNT[e] + 255) >> 8;
#pragma unroll 1
            for (int q = 0; q < nt; ++q) tab[rt++] = e | (q << 8); }
        tab[XS_ROWS / 256 + 1] = rt;
#pragma unroll 1
        for (; rt <= XS_ROWS / 256; ++rt) tab[rt] = -1; }
    __syncthreads();
}
struct Args { const float* in[34]; float* out; unsigned char* ws; };
typedef __attribute__((address_space(4))) const char* kconst_ptr;
__device__ __forceinline__ void* karg(int k) { kconst_ptr kp = (kconst_ptr)__builtin_amdgcn_kernarg_segment_ptr(); asm volatile("" : "+s"(kp)); return *(void* const __attribute__((address_space(4)))*)(kp + 8 * k); }

__global__ void __launch_bounds__(NWAVES * 64, 2) fwd_kernel(Args args) {
    extern __shared__ __attribute__((aligned(16))) unsigned char lds[];
    LAS unsigned char* L = (LAS unsigned char*)lds;
    volatile LAS unsigned* MISC = (volatile LAS unsigned*)(L + MISC_OFF);
#define PHASE_IDS() \
    int tid = threadIdx.x; asm volatile("" : "+v"(tid)); \
    const int lane = tid & 63, wave = __builtin_amdgcn_readfirstlane(tid >> 6); \
    int G = gridDim.x, bx = blockIdx.x; asm volatile("" : "+s"(G), "+s"(bx)); \
    const int vcu = (G % 8 == 0) ? (bx % 8) * (G / 8) + bx / 8 : bx; \
    const int gw = vcu * NWAVES + wave, NGW = G * NWAVES; \
    const int gt = bx * (NWAVES * 64) + tid, NGT = G * NWAVES * 64; \
    (void)lane; (void)wave; (void)vcu; (void)gw; (void)NGW; (void)gt; (void)NGT;
    gu32* ctl = (gu32*)(args.ws + WS_CTL);
    for (int u = threadIdx.x; u < (LDS_BYTES - LDSCTL_OFF) / 4; u += NWAVES * 64) ((LAS unsigned*)(L + LDSCTL_OFF))[u] = 0u;
    __syncthreads();
    XcdBarrier bar = xcd_barrier_post((unsigned*)(ctl + CW_BAR), MISC + 8);
#define GRID_BAR() xcd_barrier(bar)

#define KIN(k) ((const float*)karg(k))
#define WSP(T_, off) ((T_*)(((unsigned char*)karg(35)) + (off)))
#define OUTP() ((float*)karg(34))

#if DBG_STAGE != 1
    asm volatile("; PHASE_MARK P0" ::: "memory");
    {
        PHASE_IDS();
        const float* w_in = KIN(5); const float* w_glu = KIN(15); const float* w_br_ssm = KIN(22); const float* w_br_attn = KIN(23); const float* w_out = KIN(24);
        const float* w_eg = KIN(30); const float* w_eu = KIN(31); const float* w_ed = KIN(32);
        bf16* WinT = WSP(bf16, WS_WIN); bf16* WgluT = WSP(bf16, WS_WGLU); bf16* WssmT = WSP(bf16, WS_WSSM); bf16* WattT = WSP(bf16, WS_WATT); bf16* WoutT = WSP(bf16, WS_WOUT);
        bf16* WE1 = WSP(bf16, WS_WE1); bf16* WE2 = WSP(bf16, WS_WE2);
        LAS float* scr = (LAS float*)(L + RING_OFF + wave * 16384);
        constexpr int I_IN = 16 * 176, I_GLU = 8 * 16, I_SSM = 8 * 32, I_ATT = 16 * 32, I_OUT = 16 * 32, I_EG = NEXP * 16 * 8, I_EU = I_EG, I_ED = NEXP * 4 * 32;
        constexpr int NITEMS = I_IN + I_GLU + I_SSM + I_ATT + I_OUT + I_EG + I_EU + I_ED;
        for (int it = gw; it < NITEMS; it += NGW) {
            int r = it;
            if (r < I_IN) { const int kb = r / 176, nb = r % 176; transpose_tile(w_in, INW, 64 * kb, 32 * nb, WinT, D, 32 * nb, 64 * kb, scr, lane); continue; } r -= I_IN;
            if (r < I_GLU) { const int kb = r / 16, nb = r % 16; transpose_tile(w_glu, S5W, 64 * kb, 32 * nb, WgluT, S5W, 32 * nb, 64 * kb, scr, lane); continue; } r -= I_GLU;
            if (r < I_SSM) { const int kb = r / 32, nb = r % 32; transpose_tile(w_br_ssm, D, 64 * kb, 32 * nb, WssmT, S5W, 32 * nb, 64 * kb, scr, lane); continue; } r -= I_SSM;
            if (r < I_ATT) { const int kb = r / 32, nb = r % 32; transpose_tile(w_br_attn, D, 64 * kb, 32 * nb, WattT, D, 32 * nb, 64 * kb, scr, lane); continue; } r -= I_ATT;
            if (r < I_OUT) { const int kb = r / 32, nb = r % 32; transpose_tile(w_out, D, 64 * kb, 32 * nb, WoutT, D, 32 * nb, 64 * kb, scr, lane); continue; } r -= I_OUT;
            if (r < I_EG + I_EU) { const bool up = r >= I_EG; if (up) r -= I_EG; const int e = r / 128, q = r % 128, kb = q / 8, nb = q % 8;
                transpose_tile((up ? w_eu : w_eg) + (size_t)e * D * DEXP, DEXP, 64 * kb, 32 * nb, WE1 + (size_t)e * 512 * D, D, (nb >> 2) * 256 + (up ? 128 : 0) + (nb & 3) * 32, 64 * kb, scr, lane); continue; } r -= I_EG + I_EU;
            { const int e = r / 128, q = r % 128, kb = q / 32, nb = q % 32; transpose_tile(w_ed + (size_t)e * DEXP * D, D, 64 * kb, 32 * nb, WE2 + (size_t)e * D * DEXP, DEXP, 32 * nb, 64 * kb, scr, lane); }
        }
        const float* w_rg = KIN(26); const float* w_re = KIN(28); bf16* WR = WSP(bf16, WS_WR);
        for (int idx = gt; idx < 2 * 64 * 128; idx += NGT) {
            const int k0 = (idx & 127) * 8, n = (idx >> 7) & 63, part = idx >> 13;
            unsigned w[4] = {0u, 0u, 0u, 0u};
            if (n < 36) {
                float hv[8];
#pragma unroll
                for (int i = 0; i < 8; ++i) { const float f = (n < 4) ? w_rg[(size_t)(k0 + i) * 4 + n] : w_re[(size_t)(k0 + i) * NEXP + (n - 4)]; const float h = bf2f(f2bf(f)); hv[i] = part ? (f - h) : h; }
#pragma unroll
                for (int i = 0; i < 4; ++i) w[i] = pk2(hv[2 * i], hv[2 * i + 1]);
            }
            *(GAS v4u*)(WR + (size_t)(part * 64 + n) * D + k0) = (v4u){w[0], w[1], w[2], w[3]};
        }
        const float* log_dt = KIN(14); const float* a_re = KIN(7); const float* a_im = KIN(8); const float* sb_re = KIN(9); const float* sb_im = KIN(10);
        float* Ere = WSP(float, WS_ETAB); float* Eim = Ere + NG * LC * NP * 16;
        for (int idx = gt; idx < NG * LC * NP; idx += NGT) {
            const int p = idx % NP, j = (idx / NP) % LC, g = idx / (NP * LC);
            const float dt = expf(log_dt[g]), lr = a_re[g * NP + p], li = a_im[g * NP + p];
            float ar, ai; abar_pow(lr, li, dt, 1.0f, ar, ai);
            const float den = lr * lr + li * li, nr = ar - 1.0f;
            const float fre = (nr * lr + ai * li) / den, fim = (ai * lr - nr * li) / den;
            float pr, pi; abar_pow(lr, li, dt, (float)j, pr, pi);
            const float gr = pr * fre - pi * fim, gi = pr * fim + pi * fre;
            const float* br = sb_re + (size_t)(g * NP + p) * 16; const float* bi = sb_im + (size_t)(g * NP + p) * 16;
            float* er = Ere + (size_t)((g * LC + j) * NP + p) * 16; float* ei = Eim + (size_t)((g * LC + j) * NP + p) * 16;
#pragma unroll
            for (int ci = 0; ci < 16; ++ci) { er[ci] = gr * br[ci] - gi * bi[ci]; ei[ci] = gr * bi[ci] + gi * br[ci]; }
        }
        {
            const float* cvec = KIN(1); const float* w_ada = KIN(2); const float* b_ada = KIN(3); float* MOD = WSP(float, WS_MOD);
            __syncthreads();
            LAS float* cs = (LAS float*)(L + RING_OFF);
            LAS float* red = (LAS float*)(L + RING_OFF + 32768);
            bool loaded = false;
            for (int it = vcu; it < 6 * D / 32; it += G) {
                if (!loaded) { __syncthreads(); for (int i = tid; i < NB * D; i += NWAVES * 64) { const float c = cvec[i]; cs[i] = c / (1.0f + expf(-c)); } __syncthreads(); loaded = true; }
                const int col = it * 32 + (lane & 31), ksub = (lane >> 5) + 2 * wave;
                float accb[NB];
#pragma unroll
                for (int b = 0; b < NB; ++b) accb[b] = 0.f;
#pragma unroll 8
                for (int i = 0; i < 64; ++i) { const int k = ksub + 16 * i; const float w = w_ada[(size_t)k * (6 * D) + col];
#pragma unroll
                    for (int b = 0; b < NB; ++b) accb[b] += cs[b * D + k] * w; }
#pragma unroll
                for (int b = 0; b < NB; ++b) red[(ksub * NB + b) * 32 + (lane & 31)] = accb[b];
                __syncthreads();
                if (tid < NB * 32) { const int b = tid >> 5, c = tid & 31; float s = 0.f;
#pragma unroll
                    for (int q = 0; q < 16; ++q) s += red[(q * NB + b) * 32 + c];
                    MOD[(size_t)b * 6 * D + it * 32 + c] = s + b_ada[it * 32 + c]; }
                __syncthreads();
            }
            __syncthreads();
        }
    }
    GRID_BAR();
#endif

#if DBG_STAGE != 1
    asm volatile("; PHASE_MARK P0b" ::: "memory");
    {
        PHASE_IDS();
        const float* x = KIN(0); const float* g_mix = KIN(4); const float* MOD = WSP(float, WS_MOD); bf16* UBUF = (bf16*)OUTP();
        const float* Ere = WSP(float, WS_ETAB); const float* Eim = Ere + NG * LC * NP * 16; bf16* BtY = WSP(bf16, WS_BTY); bf16* BtP = WSP(bf16, WS_BTP);
        const float* sc_re = KIN(11); const float* sc_im = KIN(12); const float* log_dt = KIN(14); const float* a_re = KIN(7); const float* a_im = KIN(8);
        for (int blk = gw; blk < T / 16; blk += NGW) {
            const int row0 = blk * 16, b = row0 / SEQ; const float* md = MOD + (size_t)b * 6 * D;
            f32x4 av[4], sv[4];
#pragma unroll
            for (int j = 0; j < 4; ++j) { const int c = 4 * lane + 256 * j; const f32x4 g = *(const f32x4*)(g_mix + c), sc = *(const f32x4*)(md + D + c); av[j] = g * (sc + 1.0f); sv[j] = *(const f32x4*)(md + c); }
            for (int r = 0; r < 16; ++r) {
                const float* xr = x + (size_t)(row0 + r) * D; f32x4 v[4]; float ss = 0.f;
#pragma unroll
                for (int j = 0; j < 4; ++j) { v[j] = *(const f32x4*)(xr + 4 * lane + 256 * j); ss += (v[j][0] * v[j][0] + v[j][1] * v[j][1]) + (v[j][2] * v[j][2] + v[j][3] * v[j][3]); }
                const float rstd = 1.0f / sqrtf(wave_sum(ss, lane) * (1.0f / D) + EPS);
                bf16* ur = UBUF + (size_t)(row0 + r) * D;
#pragma unroll
                for (int j = 0; j < 4; ++j) { const f32x4 o = v[j] * rstd * av[j] + sv[j]; *(GAS v2u*)(ur + 4 * lane + 256 * j) = (v2u){pk2(o[0], o[1]), pk2(o[2], o[3])}; }
            }
        }
        for (int idx = gt; idx < NG * LC * 16 * 2; idx += NGT) {
            const int cih = idx & 1, co = (idx >> 1) & 15, j = (idx >> 5) % LC, g = idx / (32 * LC);
            float kv[8];
#pragma unroll
            for (int i = 0; i < 8; ++i) kv[i] = 0.f;
            const float* er = Ere + (size_t)((g * LC + j) * NP) * 16 + cih * 8; const float* ei = Eim + (size_t)((g * LC + j) * NP) * 16 + cih * 8;
            const float* cr = sc_re + (size_t)(g * 16 + co) * NP; const float* ci_ = sc_im + (size_t)(g * 16 + co) * NP;
            for (int p = 0; p < NP; ++p) { const float c_r = cr[p], c_i = ci_[p]; const f32x4 e0 = *(const f32x4*)(er + p * 16), e1 = *(const f32x4*)(er + p * 16 + 4), f0 = *(const f32x4*)(ei + p * 16), f1 = *(const f32x4*)(ei + p * 16 + 4);
#pragma unroll
                for (int i = 0; i < 4; ++i) { kv[i] += c_r * e0[i] - c_i * f0[i]; kv[4 + i] += c_r * e1[i] - c_i * f1[i]; } }
            const v4u kw = (v4u){pk2(kv[0], kv[1]), pk2(kv[2], kv[3]), pk2(kv[4], kv[5]), pk2(kv[6], kv[7])};
            bf16* base = BtY + (size_t)g * 512 * KY;
            for (int t = j; t < LC; ++t) *(GAS v4u*)(base + (size_t)(t * 16 + co) * KY + (t - j) * 16 + cih * 8) = kw;
            if (j >= 1) for (int t = 0; t + j < LC; ++t) *(GAS v4u*)(base + (size_t)(t * 16 + co) * KY + (t + j) * 16 + cih * 8) = (v4u){0u, 0u, 0u, 0u};
        }
        for (int idx = gt; idx < NG * LC * NP; idx += NGT) {
            const int p = idx % NP, t = (idx / NP) % LC, g = idx / (NP * LC);
            const float dt = expf(log_dt[g]); float ar, ai; abar_pow(a_re[g * NP + p], a_im[g * NP + p], dt, (float)(t + 1), ar, ai);
#pragma unroll
            for (int co = 0; co < 16; ++co) { const float c_r = sc_re[(size_t)(g * 16 + co) * NP + p], c_i = sc_im[(size_t)(g * 16 + co) * NP + p];
                bf16* rowp = BtY + (size_t)(g * 512 + t * 16 + co) * KY;
                rowp[512 + p] = (bf16)f2bf(c_r * ar - c_i * ai); rowp[576 + p] = (bf16)f2bf(-(c_r * ai + c_i * ar)); }
        }
        for (int idx = gt; idx < NG * 128 * LC; idx += NGT) {
            const int s = idx % LC, nn = (idx / LC) % 128, g = idx / (LC * 128); const int p = nn & 63, im = nn >> 6;
            const float* src = (im ? Eim : Ere) + (size_t)((g * LC + (LC - 1 - s)) * NP + p) * 16;
            unsigned hw[8], lw[8];
#pragma unroll
            for (int i = 0; i < 8; ++i) { const float f0 = src[2 * i], f1 = src[2 * i + 1]; const unsigned h0 = f2bf(f0), h1 = f2bf(f1); hw[i] = h0 | (h1 << 16); lw[i] = pk2(f0 - bf2f(h0), f1 - bf2f(h1)); }
            bf16* d0 = BtP + (size_t)(g * 256 + nn) * KS + s * 16; bf16* d1 = BtP + (size_t)(g * 256 + 128 + nn) * KS + s * 16;
            *(GAS v4u*)d0 = (v4u){hw[0], hw[1], hw[2], hw[3]}; *(GAS v4u*)(d0 + 8) = (v4u){hw[4], hw[5], hw[6], hw[7]};
            *(GAS v4u*)d1 = (v4u){lw[0], lw[1], lw[2], lw[3]}; *(GAS v4u*)(d1 + 8) = (v4u){lw[4], lw[5], lw[6], lw[7]};
        }
    }
    GRID_BAR();

    asm volatile("; PHASE_MARK P1" ::: "memory");
    {
        PHASE_IDS();
        pg8::StaticOrder S; S.init(OUTP(), D, WSP(bf16, WS_WIN), D, T, INW, G, bx);
        pg8::EpiProj E{KIN(6), WSP(bf16, WS_UG), WSP(bf16, WS_Q), WSP(bf16, WS_K), WSP(bf16, WS_V), WSP(bf16, WS_GATES), attn_body::C2};
        pg8::gemm_phase<pg8::EpiProj, pg8::StaticOrder, true, true>(L + RING_OFF, D, D, D, S, E);
    }
    GRID_BAR();

    asm volatile("; PHASE_MARK P2" ::: "memory");
    {
        PHASE_IDS();
        pg8::GroupOrder S; S.init(WSP(bf16, WS_UG), KY, (size_t)NRC * KY * 2, WSP(bf16, WS_BTP), KS, (size_t)256 * KS * 2, NRC, 256, NG, G, bx);
        pg8::EpiStates E{WSP(float, WS_SLOC)};
        pg8::gemm_phase<pg8::EpiStates, pg8::GroupOrder, true, true>(L + RING_OFF, KS, KY, KS, S, E);
    }
    GRID_BAR();

    asm volatile("; PHASE_MARK P3" ::: "memory");
    {
        PHASE_IDS();
        const float* log_dt = KIN(14); const float* a_re = KIN(7); const float* a_im = KIN(8); const float* SLOC = WSP(float, WS_SLOC); bf16* UG = WSP(bf16, WS_UG);
        LAS float* seg = (LAS float*)(L + RING_OFF);
        for (int bg = vcu; bg < NB * NG; bg += G) {
            const int b = bg / NG, g = bg % NG, p = lane;
            const float dt = expf(log_dt[g]), lr = a_re[g * NP + p], li = a_im[g * NP + p];
            float alr, ali; abar_pow(lr, li, dt, (float)LC, alr, ali);
            constexpr int SEGC = NCH / NWAVES;
            float locr[SEGC], loci[SEGC]; float cr = 0.f, ci = 0.f;
            const float* sp = SLOC + ((size_t)(g * NRC + b * NCH + wave * SEGC)) * 128;
#pragma unroll
            for (int k = 0; k < SEGC; ++k) { locr[k] = cr; loci[k] = ci; const float sr = sp[k * 128 + p], si = sp[k * 128 + 64 + p]; const float nr = alr * cr - ali * ci + sr, ni = alr * ci + ali * cr + si; cr = nr; ci = ni; }
            __syncthreads();
            seg[(wave * 64 + p) * 2] = cr; seg[(wave * 64 + p) * 2 + 1] = ci;
            __syncthreads();
            float a16r = alr, a16i = ali;
#pragma unroll
            for (int q = 0; q < 4; ++q) { const float nr = a16r * a16r - a16i * a16i, ni = 2.f * a16r * a16i; a16r = nr; a16i = ni; }
            float inr = 0.f, ini = 0.f;
            for (int w = 0; w < wave; ++w) { const float er = seg[(w * 64 + p) * 2], ei = seg[(w * 64 + p) * 2 + 1]; const float nr = a16r * inr - a16i * ini + er, ni = a16r * ini + a16i * inr + ei; inr = nr; ini = ni; }
            bf16* up = UG + ((size_t)(g * NRC + b * NCH + wave * SEGC)) * KY + KS;
#pragma unroll
            for (int k = 0; k < SEGC; ++k) { up[(size_t)k * KY + p] = (bf16)f2bf(inr + locr[k]); up[(size_t)k * KY + 64 + p] = (bf16)f2bf(ini + loci[k]); const float nr = alr * inr - ali * ini, ni = alr * ini + ali * inr; inr = nr; ini = ni; }
        }
        __syncthreads();
        const char* wsb = (const char*)karg(35);
        const float* lq1 = KIN(17); const float* lk1 = KIN(18); const float* lq2 = KIN(19); const float* lk2 = KIN(20); const float* g_subln = KIN(21);
        const float lam = expf(wave_sum(lq1[lane] * lk1[lane], lane)) - expf(wave_sum(lq2[lane] * lk2[lane], lane)) + LAMBDA_INIT;
        LAS float* gsl = (LAS float*)(L + GS_OFF);
        if (tid < 128) gsl[tid] = g_subln[tid] * (1.0f - LAMBDA_INIT);
        __syncthreads();
        for (int un = vcu; un < NB * 8 * 4; un += G) {
            const int s4 = un & 3, h = (un >> 2) & 7, b = un >> 5;
#pragma unroll 1
            for (int i = 0; i < 4; ++i) { const int qb = (i == 0) ? 15 - s4 : (i == 1) ? 8 + s4 : (i == 2) ? 7 - s4 : s4;
                attn_body::attn_unit<8, WS_Q, WS_K, WS_V, GS_OFF - RING_OFF>(b, h, qb, wsb, (attn_body::bf16*)OUTP(), lam, (char*)lds + RING_OFF); }
        }
    }
    GRID_BAR();

    asm volatile("; PHASE_MARK P4" ::: "memory");
    {
        PHASE_IDS();
        pg8::GroupOrder S; S.init(WSP(bf16, WS_UG), KY, (size_t)NRC * KY * 2, WSP(bf16, WS_BTY), KY, (size_t)512 * KY * 2, NRC, 512, NG, G, bx);
        pg8::EpiY E{WSP(bf16, WS_UG), KIN(13), WSP(bf16, WS_YACT)};
        pg8::gemm_phase<pg8::EpiY, pg8::GroupOrder, true, true>(L + RING_OFF, KY, KY, KY, S, E);
    }
    GRID_BAR();

    asm volatile("; PHASE_MARK P5" ::: "memory");
    {
        PHASE_IDS();
        pg8::StaticOrder S; S.init(WSP(bf16, WS_YACT), S5W, WSP(bf16, WS_WGLU), S5W, T, S5W, G, bx);
        pg8::EpiGlu E{WSP(bf16, WS_YACT), KIN(16), WSP(bf16, WS_S5O)};
        pg8::gemm_phase<pg8::EpiGlu, pg8::StaticOrder, true, true>(L + RING_OFF, S5W, S5W, S5W, S, E);
    }
    GRID_BAR();

    asm volatile("; PHASE_MARK P6" ::: "memory");
    {
        PHASE_IDS();
        pg8::StaticOrder S; S.init(WSP(bf16, WS_S5O), S5W, WSP(bf16, WS_WSSM), S5W, T, D, G, bx);
        pg8::EpiBranch<0> E{WSP(bf16, WS_GATES), nullptr, WSP(bf16, WS_TMP)};
        pg8::gemm_phase<pg8::EpiBranch<0>, pg8::StaticOrder, true, true>(L + RING_OFF, S5W, S5W, S5W, S, E);
    }
    VM_WAIT(); __syncthreads();
    {
        PHASE_IDS();
        pg8::StaticOrder S; S.init(OUTP(), D, WSP(bf16, WS_WATT), D, T, D, G, bx);
        pg8::EpiBranch<1> E{WSP(bf16, WS_GATES), WSP(bf16, WS_TMP), (bf16*)OUTP() + (size_t)T * D};
        pg8::gemm_phase<pg8::EpiBranch<1>, pg8::StaticOrder, true, true>(L + RING_OFF, D, D, D, S, E);
    }
    GRID_BAR();

    asm volatile("; PHASE_MARK P8" ::: "memory");
    {
        PHASE_IDS();
        pg8::StaticOrder S; S.init((bf16*)OUTP() + (size_t)T * D, D, WSP(bf16, WS_WOUT), D, T, D, G, bx);
        pg8::EpiOut E{KIN(0), WSP(float, WS_MOD), WSP(bf16, WS_H)};
        pg8::gemm_phase<pg8::EpiOut, pg8::StaticOrder, true, true>(L + RING_OFF, D, D, D, S, E);
    }
    GRID_BAR();
#endif

#if DBG_STAGE == 0
    asm volatile("; PHASE_MARK P9" ::: "memory");
    {
        PHASE_IDS();
        const float* g_ffn = KIN(25); const float* MOD = WSP(float, WS_MOD); const bf16* Hbuf = WSP(bf16, WS_H); bf16* U2 = (bf16*)OUTP();
        const bf16* WRh = WSP(bf16, WS_WR); const bf16* WRl = WRh + 64 * D;
        const float* b_rg = KIN(27); const float* b_re = KIN(29); int* CNT = WSP(int, WS_CTL) + CW_CNT; int* LIST = WSP(int, WS_LIST); float* CWL = WSP(float, WS_CWL);
        constexpr int APITCH = 1032;
        LAS bf16* AH = (LAS bf16*)(L + RING_OFF); LAS bf16* AL = AH + 16 * APITCH;
        LAS float* PART = (LAS float*)(L + RING_OFF + 2 * 16 * APITCH * 2);
        LAS float* LG = PART + 8 * 256;
        LAS int* lcnt = (LAS int*)(LG + 16 * 64); LAS int* lbase = lcnt + NEXP; LAS int* TOK = lbase + NEXP;
        const int per = T / G, t0 = bx * per, b = t0 / SEQ;
        const float* md = MOD + (size_t)b * 6 * D;
        f32x4 av[4], sv[4];
#pragma unroll
        for (int j = 0; j < 4; ++j) { const int c = 4 * lane + 256 * j; const f32x4 g = *(const f32x4*)(g_ffn + c), sc = *(const f32x4*)(md + 4 * D + c); av[j] = g * (sc + 1.0f); sv[j] = *(const f32x4*)(md + 3 * D + c); }
        const int cb = wave & 3, kh = wave >> 2, fr = lane & 15, fq = lane >> 4;
        pg8::bf16x8 bh[16], bl[16];
#pragma unroll
        for (int ks = 0; ks < 16; ++ks) { const size_t o = (size_t)(cb * 16 + fr) * D + kh * 512 + ks * 32 + fq * 8; bh[ks] = *(const pg8::bf16x8*)(WRh + o); bl[ks] = *(const pg8::bf16x8*)(WRl + o); }
        if (tid < NEXP) lcnt[tid] = 0;
        for (int c = 0; c < per / 16; ++c) {
#pragma unroll
            for (int rr = 0; rr < 2; ++rr) {
                const int r = 2 * wave + rr, tok = t0 + c * 16 + r;
                const bf16* hr = Hbuf + (size_t)tok * D; f32x4 v[4]; float ss = 0.f;
#pragma unroll
                for (int j = 0; j < 4; ++j) { const v2u hw = *(const GAS v2u*)(hr + 4 * lane + 256 * j); v[j] = (f32x4){pg8::bf_lo(hw.x), pg8::bf_hi(hw.x), pg8::bf_lo(hw.y), pg8::bf_hi(hw.y)}; ss += (v[j][0] * v[j][0] + v[j][1] * v[j][1]) + (v[j][2] * v[j][2] + v[j][3] * v[j][3]); }
                const float rstd = 1.0f / sqrtf(wave_sum(ss, lane) * (1.0f / D) + EPS);
                bf16* ur = U2 + (size_t)tok * D;
#pragma unroll
                for (int j = 0; j < 4; ++j) { const f32x4 o = v[j] * rstd * av[j] + sv[j];
                    const unsigned h0 = f2bf(o[0]), h1 = f2bf(o[1]), h2 = f2bf(o[2]), h3 = f2bf(o[3]);
                    const v2u hv = (v2u){h0 | (h1 << 16), h2 | (h3 << 16)}, lv = (v2u){pk2(o[0] - bf2f(h0), o[1] - bf2f(h1)), pk2(o[2] - bf2f(h2), o[3] - bf2f(h3))};
                    *(GAS v2u*)(ur + 4 * lane + 256 * j) = hv;
                    *(LAS v2u*)(AH + r * APITCH + 4 * lane + 256 * j) = hv; *(LAS v2u*)(AL + r * APITCH + 4 * lane + 256 * j) = lv; }
            }
            __syncthreads();
            { pg8::f32x4 acc = (pg8::f32x4){0.f, 0.f, 0.f, 0.f};
#pragma unroll
              for (int ks = 0; ks < 16; ++ks) { const int ko = fr * APITCH + kh * 512 + ks * 32 + fq * 8;
                  const pg8::bf16x8 ah = *(const LAS pg8::bf16x8*)(AH + ko), al = *(const LAS pg8::bf16x8*)(AL + ko);
                  acc = __builtin_amdgcn_mfma_f32_16x16x32_bf16(ah, bh[ks], acc, 0, 0, 0);
                  acc = __builtin_amdgcn_mfma_f32_16x16x32_bf16(al, bh[ks], acc, 0, 0, 0);
                  acc = __builtin_amdgcn_mfma_f32_16x16x32_bf16(ah, bl[ks], acc, 0, 0, 0); }
#pragma unroll
              for (int i = 0; i < 4; ++i) PART[wave * 256 + (fq * 4 + i) * 16 + fr] = acc[i]; }
            __syncthreads();
#pragma unroll
            for (int i = 0; i < 2; ++i) { const int o = tid * 2 + i, row = o >> 6, col = o & 63, cbb = col >> 4; LG[o] = PART[cbb * 256 + row * 16 + (col & 15)] + PART[(4 + cbb) * 256 + row * 16 + (col & 15)]; }
            __syncthreads();
            if (tid < 16) {
                const LAS float* lg = LG + tid * 64;
                float gl[4]; int gi = 0;
#pragma unroll
                for (int i = 0; i < 4; ++i) gl[i] = lg[i] + b_rg[i];
#pragma unroll
                for (int i = 1; i < 4; ++i) if (gl[i] > gl[gi]) gi = i;
                float gsum = 0.f;
#pragma unroll
                for (int i = 0; i < 4; ++i) gsum += expf(gl[i] - gl[gi]);
                const float gp = 1.0f / gsum;
                float el[8];
#pragma unroll
                for (int i = 0; i < 8; ++i) el[i] = lg[4 + gi * 8 + i] + b_re[gi * 8 + i];
                int i0 = 0;
#pragma unroll
                for (int i = 1; i < 8; ++i) if (el[i] > el[i0]) i0 = i;
                int i1 = (i0 == 0) ? 1 : 0;
#pragma unroll
                for (int i = 0; i < 8; ++i) if (i != i0 && el[i] > el[i1]) i1 = i;
                const float ex = expf(el[i1] - el[i0]);
                const float w0 = gp / (1.0f + ex), w1 = gp * ex / (1.0f + ex);
                const int e0 = gi * 8 + i0, e1 = gi * 8 + i1;
                const int p0 = atomicAdd((int*)(lds + ((char*)&lcnt[e0] - (char*)L)), 1), p1 = atomicAdd((int*)(lds + ((char*)&lcnt[e1] - (char*)L)), 1);
                LAS int* tk = TOK + (c * 16 + tid) * 6; tk[0] = e0; tk[1] = p0; tk[2] = __float_as_int(w0); tk[3] = e1; tk[4] = p1; tk[5] = __float_as_int(w1);
            }
        }
        __syncthreads();
        if (tid < NEXP) lbase[tid] = atomicAdd(&CNT[tid], lcnt[tid]);
        __syncthreads();
        if (tid < per) { const LAS int* tk = TOK + tid * 6; const int tok = t0 + tid;
            const size_t i0 = (size_t)tk[0] * T + lbase[tk[0]] + tk[1], i1 = (size_t)tk[3] * T + lbase[tk[3]] + tk[4];
            LIST[i0] = tok * 2; CWL[i0] = __int_as_float(tk[2]); LIST[i1] = tok * 2 + 1; CWL[i1] = __int_as_float(tk[5]); }
        __syncthreads();
    }
    GRID_BAR();

    asm volatile("; PHASE_MARK P13" ::: "memory");
    {
        PHASE_IDS();
        const int* CNT = WSP(int, WS_CTL) + CW_CNT; const int* LIST = WSP(int, WS_LIST);
        build_expert_table(L, CNT, tid);
        pg8::ExpertOrder S; S.init((const LAS int*)(L + ETAB_OFF), OUTP(), 0, WSP(bf16, WS_WE1), D, (size_t)512 * D * 2, 512, G, bx);
        LAS int* rowtab = (LAS int*)(L + ROWTAB_OFF);
        { pg8::Unit u;
#pragma unroll 1
          for (int i = 0; i < 4 && S.next(i, u); ++i) { const int n = CNT[u.g];
              for (int r = tid; r < 256; r += NWAVES * 64) { const int pos = u.lt * 256 + r; rowtab[i * 256 + r] = (pos < n) ? (LIST[(size_t)u.g * T + pos] >> 1) : 0; } }
          __syncthreads(); }
        pg8::EpiExp1 E{WSP(bf16, WS_HDN)};
        pg8::gemm_phase<pg8::EpiExp1, pg8::ExpertOrder, true, true, true>(L + RING_OFF, D, D, D, S, E, (const LAS int*)rowtab);
    }
    GRID_BAR();

    asm volatile("; PHASE_MARK P14" ::: "memory");
    {
        PHASE_IDS();
        build_expert_table(L, WSP(int, WS_CTL) + CW_CNT, tid);
        pg8::ExpertOrder S; S.init((const LAS int*)(L + ETAB_OFF), WSP(bf16, WS_HDN), (size_t)256 * DEXP * 2, WSP(bf16, WS_WE2), DEXP, (size_t)D * DEXP * 2, D, G, bx);
        pg8::EpiExp2 E{WSP(int, WS_LIST), WSP(float, WS_CWL), WSP(int, WS_CTL) + CW_CNT, WSP(bf16, WS_SLOTS)};
        pg8::gemm_phase<pg8::EpiExp2, pg8::ExpertOrder, true, true>(L + RING_OFF, DEXP, DEXP, DEXP, S, E);
    }
    GRID_BAR();
#endif

    asm volatile("; PHASE_MARK P15" ::: "memory");
    {
        PHASE_IDS();
        const float* x = KIN(0); const float* g_final = KIN(33); const bf16* Hbuf = WSP(bf16, WS_H); const float* MOD = WSP(float, WS_MOD); const bf16* SLOTS = WSP(bf16, WS_SLOTS); float* out = OUTP();
        (void)x; (void)Hbuf; (void)MOD; (void)SLOTS;
        for (int row = gw; row < T; row += NGW) {
            const int b = row / SEQ; f32x4 v[4]; float ss = 0.f;
#pragma unroll
            for (int j = 0; j < 4; ++j) { const int c = 4 * lane + 256 * j;
#if DBG_STAGE == 1
                v[j] = *(const f32x4*)(x + (size_t)row * D + c);
#else
                { const v2u hw = *(const GAS v2u*)(Hbuf + (size_t)row * D + c); v[j] = (f32x4){pg8::bf_lo(hw.x), pg8::bf_hi(hw.x), pg8::bf_lo(hw.y), pg8::bf_hi(hw.y)}; }
#endif
#if DBG_STAGE == 0
                const f32x4 gt = *(const f32x4*)(MOD + (size_t)b * 6 * D + 5 * D + c);
                const v2u s0 = *(const GAS v2u*)(SLOTS + (size_t)(2 * row) * D + c), s1 = *(const GAS v2u*)(SLOTS + (size_t)(2 * row + 1) * D + c);
                const f32x4 f = (f32x4){pg8::bf_lo(s0.x) + pg8::bf_lo(s1.x), pg8::bf_hi(s0.x) + pg8::bf_hi(s1.x), pg8::bf_lo(s0.y) + pg8::bf_lo(s1.y), pg8::bf_hi(s0.y) + pg8::bf_hi(s1.y)};
                v[j] = v[j] + gt * f;
#endif
                ss += (v[j][0] * v[j][0] + v[j][1] * v[j][1]) + (v[j][2] * v[j][2] + v[j][3] * v[j][3]); }
            (void)b;
            const float rstd = 1.0f / sqrtf(wave_sum(ss, lane) * (1.0f / D) + EPS);
#pragma unroll
            for (int j = 0; j < 4; ++j) { const int c = 4 * lane + 256 * j; const f32x4 g = *(const f32x4*)(g_final + c); *(f32x4*)(out + (size_t)row * D + c) = v[j] * rstd * g; }
        }
    }
}

extern "C" void kernel_launch(void* const* d_in, const int* in_sizes, int n_in, void* d_out, int out_size, void* d_ws, size_t ws_size, hipStream_t stream) {
    static int grid = 0;
    if (grid == 0) {
        if (n_in != 34 || out_size != T * D || ws_size < WS_END) { fprintf(stderr, "kernel_launch: unexpected shapes (n_in %d, out %d, ws %zu)\n", n_in, out_size, ws_size); grid = -1; return; }
        int dev = 0, cus = 0, per_cu = 0;
        if (hipGetDevice(&dev) != hipSuccess || hipDeviceGetAttribute(&cus, hipDeviceAttributeMultiprocessorCount, dev) != hipSuccess) { grid = -1; return; }
        if (hipFuncSetAttribute((const void*)fwd_kernel, hipFuncAttributeMaxDynamicSharedMemorySize, LDS_BYTES) != hipSuccess) { fprintf(stderr, "kernel_launch: hipFuncSetAttribute failed\n"); grid = -1; return; }
        if (hipOccupancyMaxActiveBlocksPerMultiprocessor(&per_cu, (const void*)fwd_kernel, NWAVES * 64, LDS_BYTES) != hipSuccess || per_cu < 1)
            fprintf(stderr, "kernel_launch: note: occupancy query reports %d workgroups per CU\n", per_cu);
        (void)hipGetLastError();
        grid = cus;
    }
    if (grid < 0) return;
    if (hipMemsetAsync((char*)d_ws + WS_CTL, 0, CTL_ZERO_BYTES, stream) != hipSuccess) { fprintf(stderr, "kernel_launch: memset failed\n"); return; }
    Args a{};
    for (int i = 0; i < 34; ++i) a.in[i] = (const float*)d_in[i];
    a.out = (float*)d_out; a.ws = (unsigned char*)d_ws;
    hipLaunchKernelGGL(fwd_kernel, dim3(grid), dim3(NWAVES * 64), LDS_BYTES, stream, a);
    const hipError_t le = hipPeekAtLastError();
    if (le != hipSuccess) fprintf(stderr, "kernel_launch: launch failed: %s\n", hipGetErrorName(le));
}
```

```cpp
#include <hip/hip_runtime.h>
#include <hip/hip_bf16.h>
#include <cstdio>
#include <cstdint>
#include <cmath>

#ifndef DBG_STAGE
#define DBG_STAGE 0
#endif

constexpr int D = 1024, NB = 8, SEQ = 4096, T = NB * SEQ;
constexpr int S5W = 512, NG = 32, NP = 64, INW = 5632;
constexpr int LC = 32, NCH = SEQ / LC, NRC = T / LC, KS = LC * 16, KY = KS + 128;
constexpr int NEXP = 32, DEXP = 256;
constexpr int XS_ROWS = 2 * T + NEXP * 256;
constexpr float EPS = 1e-6f;
constexpr float LAMBDA_INIT = 0.2f;

namespace pg8 {
#define PG8_LAS __attribute__((address_space(3)))
typedef unsigned short bf16_t;
typedef short bf16x8 __attribute__((ext_vector_type(8)));
typedef float f32x4 __attribute__((ext_vector_type(4)));
typedef unsigned u32x4 __attribute__((ext_vector_type(4)));
typedef float f32x2 __attribute__((ext_vector_type(2)));
constexpr int BM = 256, BK = 64, HALF = 128, HTB = HALF * BK * 2, STAGE_BYTES = 8 * HTB, NXCD = 8, WGM = 8;

__host__ __device__ __forceinline__ int lds_byte(int r, int c) { const int st = (r >> 4) * 2 + (c >> 5), rr = r & 15, cc = c & 31, ob = rr * 64 + cc * 2; return st * 1024 + (ob ^ (((ob >> 9) & 1) << 5)); }
__host__ __device__ __forceinline__ void stage_rc(int b, int& R, int& C) { const int st = b / 1024, sb = b % 1024, swz = sb ^ (((sb >> 9) & 1) << 5); R = (st >> 1) * 16 + swz / 64; C = (st & 1) * 32 + (swz % 64) / 2; }
__host__ __device__ __forceinline__ int perm32(int rho) { const int n = rho >> 4, i = rho & 15; return 8 * (i >> 2) + 4 * n + (i & 3); }

struct Unit { int pm, pn, g, lt; const char* a; const char* b; };

struct StaticOrder {
    int nM, nN, nwg, G, c; const char* A; const char* B; size_t tsa, tsb;
    __device__ void init(const void* A_, int lda, const void* B_, int ldb, int M, int N, int G_, int c_) { nM = M / BM; nN = N / BM; nwg = nM * nN; G = G_; c = c_; A = (const char*)A_; B = (const char*)B_; tsa = (size_t)BM * lda * 2; tsb = (size_t)BM * ldb * 2; }
    __device__ bool next(int i, Unit& u) const {
        const long L = (long)i * G + c; if (L >= nwg) return false;
        int wgid = (int)L; { const int q = nwg / NXCD, r = nwg % NXCD, xcd = wgid % NXCD, off = wgid / NXCD; wgid = (xcd < r ? xcd * (q + 1) : r * (q + 1) + (xcd - r) * q) + off; }
        const int nig = WGM * nN, gid = wgid / nig, fm = gid * WGM, gsz = (nM - fm) < WGM ? (nM - fm) : WGM;
        u.pm = fm + ((wgid % nig) % gsz); u.pn = (wgid % nig) / gsz; u.g = 0; u.lt = 0; u.a = A + (size_t)u.pm * tsa; u.b = B + (size_t)u.pn * tsb; return true;
    }
};
struct GroupOrder {
    int nM, nN, ng, G, c; const char* A; const char* B; size_t tsa, tsb, gsa, gsb;
    __device__ void init(const void* A_, int lda, size_t gsa_, const void* B_, int ldb, size_t gsb_, int Mg, int Ng, int ng_, int G_, int c_) {
        nM = Mg / BM; nN = Ng / BM; ng = ng_; G = G_; c = c_; A = (const char*)A_; B = (const char*)B_; tsa = (size_t)BM * lda * 2; tsb = (size_t)BM * ldb * 2; gsa = gsa_; gsb = gsb_; }
    __device__ bool next(int i, Unit& u) const {
        const int per = nM * nN, x = c % NXCD, j = c / NXCD + (G / NXCD) * i; if (j >= (ng / NXCD) * per) return false;
        const int g = x + NXCD * (j / per), r = j % per;
        u.g = g; u.lt = 0; u.pm = r / nN; u.pn = r % nN; u.a = A + (size_t)g * gsa + (size_t)u.pm * tsa; u.b = B + (size_t)g * gsb + (size_t)u.pn * tsb; return true;
    }
};
struct ExpertOrder {
    const PG8_LAS int* tab; int nN, G, c; const char* A; const char* B; size_t tsa, tsb, esb;
    __device__ void init(const PG8_LAS int* tab_, const void* A_, size_t tsa_, const void* B_, int ldb, size_t esb_, int N, int G_, int c_) {
        tab = tab_; nN = N / BM; G = G_; c = c_; A = (const char*)A_; B = (const char*)B_; tsa = tsa_; tsb = (size_t)BM * ldb * 2; esb = esb_; }
    __device__ bool next(int i, Unit& u) const {
        const int NT = __builtin_amdgcn_readfirstlane(tab[XS_ROWS / 256 + 1]);
        const int x = c % NXCD, j = c / NXCD + (G / NXCD) * i, lo = (x * NT) / NXCD, hi = ((x + 1) * NT) / NXCD;
        const int rt = lo + j / nN, pn = j % nN;
        if (rt >= hi) return false;
        const int e = __builtin_amdgcn_readfirstlane(tab[rt]);
        u.g = e & 255; u.lt = e >> 8; u.pm = rt; u.pn = pn; u.a = A + (size_t)rt * tsa; u.b = B + (size_t)u.g * esb + (size_t)pn * tsb; return true;
    }
};

__device__ __forceinline__ unsigned cvt_pk_bf16(float lo, float hi) { unsigned r; asm volatile("v_cvt_pk_bf16_f32 %0, %1, %2" : "=v"(r) : "v"(lo), "v"(hi)); return r; }
__device__ __forceinline__ float bf_lo(unsigned w) { return __uint_as_float(w << 16); }
__device__ __forceinline__ float bf_hi(unsigned w) { return __uint_as_float(w & 0xffff0000u); }
__device__ __forceinline__ float sigmoidf_(float x) { return __builtin_amdgcn_rcpf(1.0f + __builtin_amdgcn_exp2f(-1.4426950408889634f * x)); }
__device__ __forceinline__ void unpack8(const u32x4 w, float (&f)[8]) { f[0] = bf_lo(w.x); f[1] = bf_hi(w.x); f[2] = bf_lo(w.y); f[3] = bf_hi(w.y); f[4] = bf_lo(w.z); f[5] = bf_hi(w.z); f[6] = bf_lo(w.w); f[7] = bf_hi(w.w); }
__device__ __forceinline__ u32x4 pack8(const float (&f)[8]) { u32x4 w; w.x = cvt_pk_bf16(f[0], f[1]); w.y = cvt_pk_bf16(f[2], f[3]); w.z = cvt_pk_bf16(f[4], f[5]); w.w = cvt_pk_bf16(f[6], f[7]); return w; }

#define EPI_LOOP_PERM(...) \
    _Pragma("unroll") for (int ai = 0; ai < 2; ++ai) _Pragma("unroll") for (int m = 0; m < 4; ++m) { const int lrow = ai * HALF + wr * 64 + m * 16 + fr; \
        _Pragma("unroll") for (int bj = 0; bj < 2; ++bj) { const int lcol = bj * HALF + wc * 32 + 8 * fq; \
            float v[8] = {acc[ai][bj][m][0][0], acc[ai][bj][m][0][1], acc[ai][bj][m][0][2], acc[ai][bj][m][0][3], acc[ai][bj][m][1][0], acc[ai][bj][m][1][1], acc[ai][bj][m][1][2], acc[ai][bj][m][1][3]}; __VA_ARGS__ } }

#define EPI_HALF_PRE(...) _Pragma("unroll") for (int m = 0; m < 4; ++m) { const int lrow = ai * HALF + wr * 64 + m * 16 + fr; (void)lrow; \
        _Pragma("unroll") for (int bj = 0; bj < 2; ++bj) { const int lcol = bj * HALF + wc * 32 + 8 * fq; (void)lcol; __VA_ARGS__ } }
#define EPI_HALF_RUN(...) _Pragma("unroll") for (int m = 0; m < 4; ++m) { const int lrow = ai * HALF + wr * 64 + m * 16 + fr; (void)lrow; \
        _Pragma("unroll") for (int bj = 0; bj < 2; ++bj) { const int lcol = bj * HALF + wc * 32 + 8 * fq; (void)lcol; \
            float v[8] = {acc[ai][bj][m][0][0], acc[ai][bj][m][0][1], acc[ai][bj][m][0][2], acc[ai][bj][m][0][3], acc[ai][bj][m][1][0], acc[ai][bj][m][1][1], acc[ai][bj][m][1][2], acc[ai][bj][m][1][3]}; __VA_ARGS__ } }

struct EpiProj {
    static constexpr bool PERM = true, AFTER_DRAIN = false;
    const float* bias; bf16_t* U; bf16_t* Q; bf16_t* Kb; bf16_t* V; bf16_t* Gt; float c2;
    __device__ __forceinline__ void operator()(const f32x4 (&acc)[2][2][4][2], const Unit& u, int wr, int wc, int fr, int fq) const {
        const int ct = u.pn;
        f32x4 bv[2][2];
#pragma unroll
        for (int bj = 0; bj < 2; ++bj) { const int col = ct * BM + bj * HALF + wc * 32 + 8 * fq; bv[bj][0] = *(const f32x4*)(bias + col); bv[bj][1] = *(const f32x4*)(bias + col + 4); }
        EPI_LOOP_PERM({
            const int row = u.pm * BM + lrow, col = ct * BM + lcol;
            v[0] += bv[bj][0][0]; v[1] += bv[bj][0][1]; v[2] += bv[bj][0][2]; v[3] += bv[bj][0][3]; v[4] += bv[bj][1][0]; v[5] += bv[bj][1][1]; v[6] += bv[bj][1][2]; v[7] += bv[bj][1][3];
            bf16_t* dst;
            if (ct < 2) { const int g = col >> 4, ci = col & 15, rc = row / LC, s = row % LC; dst = U + ((size_t)(g * NRC + rc) * KY + s * 16 + ci); }
            else if (ct < 6) { _Pragma("unroll") for (int i = 0; i < 8; ++i) v[i] *= c2; dst = Q + (size_t)row * D + (col - 512); }
            else if (ct < 10) { dst = Kb + (size_t)row * D + (col - 1536); }
            else if (ct < 14) { dst = V + (size_t)row * D + (col - 2560); }
            else { _Pragma("unroll") for (int i = 0; i < 8; ++i) v[i] = sigmoidf_(v[i]); dst = Gt + (size_t)row * 2048 + (col - 3584); }
            *(u32x4*)dst = pack8(v);
        })
    }
};
struct EpiStates {
    static constexpr bool PERM = false, AFTER_DRAIN = false;
    float* S;
    __device__ __forceinline__ void operator()(const f32x4 (&acc)[2][2][4][2], const Unit& u, int wr, int wc, int fr, int fq) const {
#pragma unroll
        for (int ai = 0; ai < 2; ++ai)
#pragma unroll
            for (int m = 0; m < 4; ++m) { const int row = u.pm * BM + ai * HALF + wr * 64 + m * 16 + fr;
#pragma unroll
                for (int n = 0; n < 2; ++n) { const f32x4 v = acc[ai][0][m][n] + acc[ai][1][m][n]; *(f32x4*)(S + ((size_t)(u.g * NRC + row) * 128 + wc * 32 + 16 * n + 4 * fq)) = v; } }
    }
};
struct EpiY {
    static constexpr bool PERM = true, AFTER_DRAIN = false;
    const bf16_t* U; const float* dskip; bf16_t* Y;
    __device__ __forceinline__ void operator()(const f32x4 (&acc)[2][2][4][2], const Unit& u, int wr, int wc, int fr, int fq) const {
        f32x4 dk[2][2];
#pragma unroll
        for (int bj = 0; bj < 2; ++bj) { const int co = (bj * HALF + wc * 32 + 8 * fq) & 15; dk[bj][0] = *(const f32x4*)(dskip + u.g * 16 + co); dk[bj][1] = *(const f32x4*)(dskip + u.g * 16 + co + 4); }
#pragma unroll
        for (int ai = 0; ai < 2; ++ai) {
            u32x4 uw[4][2];
            EPI_HALF_PRE({ const int rc = u.pm * BM + lrow, n = u.pn * BM + lcol; uw[m][bj] = *(const u32x4*)(U + ((size_t)(u.g * NRC + rc) * KY + n)); })
            EPI_HALF_RUN({
                const int rc = u.pm * BM + lrow, n = u.pn * BM + lcol, tt = n >> 4, co = n & 15;
                float uf[8]; unpack8(uw[m][bj], uf);
                const float dd[8] = {dk[bj][0][0], dk[bj][0][1], dk[bj][0][2], dk[bj][0][3], dk[bj][1][0], dk[bj][1][1], dk[bj][1][2], dk[bj][1][3]};
                _Pragma("unroll") for (int i = 0; i < 8; ++i) { const float y = v[i] + dd[i] * uf[i]; const float z = 1.5957691216057308f * (y + 0.044715f * y * y * y); v[i] = y * sigmoidf_(z); }
                *(u32x4*)(Y + ((size_t)(rc * LC + tt) * S5W + u.g * 16 + co)) = pack8(v);
            })
        }
    }
};
struct EpiGlu {
    static constexpr bool PERM = true, AFTER_DRAIN = false;
    const bf16_t* Y; const float* bias; bf16_t* O;
    __device__ __forceinline__ void operator()(const f32x4 (&acc)[2][2][4][2], const Unit& u, int wr, int wc, int fr, int fq) const {
        f32x4 bv[2][2];
#pragma unroll
        for (int bj = 0; bj < 2; ++bj) { const int col = u.pn * BM + bj * HALF + wc * 32 + 8 * fq; bv[bj][0] = *(const f32x4*)(bias + col); bv[bj][1] = *(const f32x4*)(bias + col + 4); }
#pragma unroll
        for (int ai = 0; ai < 2; ++ai) {
            u32x4 yw[4][2];
            EPI_HALF_PRE({ const int row = u.pm * BM + lrow, col = u.pn * BM + lcol; yw[m][bj] = *(const u32x4*)(Y + (size_t)row * S5W + col); })
            EPI_HALF_RUN({
                const int row = u.pm * BM + lrow, col = u.pn * BM + lcol;
                float yf[8]; unpack8(yw[m][bj], yf);
                const float bb[8] = {bv[bj][0][0], bv[bj][0][1], bv[bj][0][2], bv[bj][0][3], bv[bj][1][0], bv[bj][1][1], bv[bj][1][2], bv[bj][1][3]};
                _Pragma("unroll") for (int i = 0; i < 8; ++i) v[i] = yf[i] * sigmoidf_(v[i] + bb[i]);
                *(u32x4*)(O + (size_t)row * S5W + col) = pack8(v);
            })
        }
    }
};
template <int MODE> struct EpiBranch {
    static constexpr bool PERM = true, AFTER_DRAIN = false;
    const bf16_t* Gt; const bf16_t* Tin; bf16_t* O;
    __device__ __forceinline__ void operator()(const f32x4 (&acc)[2][2][4][2], const Unit& u, int wr, int wc, int fr, int fq) const {
#pragma unroll
        for (int ai = 0; ai < 2; ++ai) {
            u32x4 gw[4][2], tw[4][2];
            EPI_HALF_PRE({ const int row = u.pm * BM + lrow, col = u.pn * BM + lcol; gw[m][bj] = *(const u32x4*)(Gt + (size_t)row * 2048 + MODE * D + col);
                           if (MODE == 1) tw[m][bj] = *(const u32x4*)(Tin + (size_t)row * D + col); else tw[m][bj] = gw[m][bj]; })
            EPI_HALF_RUN({
                const int row = u.pm * BM + lrow, col = u.pn * BM + lcol;
                float gf[8]; unpack8(gw[m][bj], gf);
                if (MODE == 1) { float tf[8]; unpack8(tw[m][bj], tf);
                    _Pragma("unroll") for (int i = 0; i < 8; ++i) v[i] = tf[i] + gf[i] * v[i]; }
                else { _Pragma("unroll") for (int i = 0; i < 8; ++i) v[i] = gf[i] * v[i]; }
                *(u32x4*)(O + (size_t)row * D + col) = pack8(v);
            })
        }
    }
};
struct EpiOut {
    static constexpr bool PERM = true, AFTER_DRAIN = false;
    const float* x; const float* mod; bf16_t* H;
    __device__ __forceinline__ void operator()(const f32x4 (&acc)[2][2][4][2], const Unit& u, int wr, int wc, int fr, int fq) const {
        const int b = (u.pm * BM) / SEQ; const float* gt = mod + (size_t)b * 6 * D + 2 * D;
        f32x4 gv[2][2];
#pragma unroll
        for (int bj = 0; bj < 2; ++bj) { const int col = u.pn * BM + bj * HALF + wc * 32 + 8 * fq; gv[bj][0] = *(const f32x4*)(gt + col); gv[bj][1] = *(const f32x4*)(gt + col + 4); }
#pragma unroll
        for (int ai = 0; ai < 2; ++ai) {
            f32x4 xv[4][2][2];
            EPI_HALF_PRE({ const size_t off = (size_t)(u.pm * BM + lrow) * D + u.pn * BM + lcol; xv[m][bj][0] = *(const f32x4*)(x + off); xv[m][bj][1] = *(const f32x4*)(x + off + 4); })
            EPI_HALF_RUN({
                const size_t off = (size_t)(u.pm * BM + lrow) * D + u.pn * BM + lcol;
                _Pragma("unroll") for (int i = 0; i < 4; ++i) { v[i] = xv[m][bj][0][i] + gv[bj][0][i] * v[i]; v[4 + i] = xv[m][bj][1][i] + gv[bj][1][i] * v[4 + i]; }
                *(u32x4*)(H + off) = pack8(v);
            })
        }
    }
};
struct EpiRouter {
    static constexpr bool PERM = false, AFTER_DRAIN = false;
    float* L;
    __device__ __forceinline__ void operator()(const f32x4 (&acc)[2][2][4][2], const Unit& u, int wr, int wc, int fr, int fq) const {
        if (wc < 2) {
#pragma unroll
            for (int ai = 0; ai < 2; ++ai)
#pragma unroll
                for (int m = 0; m < 4; ++m) { const int row = u.pm * BM + ai * HALF + wr * 64 + m * 16 + fr;
#pragma unroll
                    for (int n = 0; n < 2; ++n) { const f32x4 v = acc[ai][0][m][n] + acc[ai][1][m][n]; *(f32x4*)(L + (size_t)row * 64 + wc * 32 + 16 * n + 4 * fq) = v; } }
        }
    }
};
struct EpiExp1 {
    static constexpr bool PERM = true, AFTER_DRAIN = false;
    bf16_t* Hd;
    __device__ __forceinline__ void operator()(const f32x4 (&acc)[2][2][4][2], const Unit& u, int wr, int wc, int fr, int fq) const {
#pragma unroll
        for (int ai = 0; ai < 2; ++ai)
#pragma unroll
            for (int m = 0; m < 4; ++m) { const int row = u.pm * BM + ai * HALF + wr * 64 + m * 16 + fr; float v[8];
#pragma unroll
                for (int n = 0; n < 2; ++n)
#pragma unroll
                    for (int i = 0; i < 4; ++i) { const float g = acc[ai][0][m][n][i], up = acc[ai][1][m][n][i]; v[n * 4 + i] = g * sigmoidf_(g) * up; }
                *(u32x4*)(Hd + (size_t)row * DEXP + u.pn * HALF + wc * 32 + 8 * fq) = pack8(v); }
    }
};
struct EpiExp2 {
    static constexpr bool PERM = true, AFTER_DRAIN = false;
    const int* list; const float* cwl; const int* cnt; bf16_t* Sl;
    __device__ __forceinline__ void operator()(const f32x4 (&acc)[2][2][4][2], const Unit& u, int wr, int wc, int fr, int fq) const {
        const int n = cnt[u.g];
#pragma unroll
        for (int ai = 0; ai < 2; ++ai) {
            int dd[4]; float ww[4];
#pragma unroll
            for (int m = 0; m < 4; ++m) { const int pos = u.lt * BM + ai * HALF + wr * 64 + m * 16 + fr; const bool ok = pos < n; const size_t li = (size_t)u.g * T + (ok ? pos : 0);
                const int d = list[li]; const float w = cwl[li]; dd[m] = ok ? d : -1; ww[m] = w; }
            EPI_HALF_RUN({
                const int col = u.pn * BM + lcol; const int d = dd[m]; const float w = ww[m];
                if (d >= 0) { _Pragma("unroll") for (int i = 0; i < 8; ++i) v[i] *= w; *(u32x4*)(Sl + (size_t)d * D + col) = pack8(v); }
            })
        }
    }
};

template <class Epi, class Sched, bool ALIGN_EPI = false, bool SP2 = false, bool GATHER = false>
__device__ __forceinline__ void gemm_phase(PG8_LAS unsigned char* lds, const int K, const int lda, const int ldb, const Sched& S, const Epi& E, const PG8_LAS int* rowtab = nullptr) {
    int tid = threadIdx.x; asm volatile("" : "+v"(tid));
    const int wid = __builtin_amdgcn_readfirstlane(tid >> 6), lane = tid & 63, wr = wid >> 2, wc = wid & 3, fr = lane & 15, fq = lane >> 4;
    const int nt = K / BK;
    unsigned voffA[2], voffB[2]; int gR[2]; unsigned gC[2];
#pragma unroll
    for (int i = 0; i < 2; ++i) { int R, C; stage_rc(tid * 16 + i * 8192, R, C); const int Rb = Epi::PERM ? ((R & ~31) + perm32(R & 31)) : R;
        voffA[i] = (unsigned)(R * lda + C) * 2u; voffB[i] = (unsigned)(Rb * ldb + C) * 2u; gR[i] = R; gC[i] = (unsigned)C * 2u; }
    unsigned vAc[2][2], vAn[2][2], vA2[2][2];
    (void)gR; (void)gC; (void)vAc; (void)vAn; (void)vA2;
#define PG8_GLOAD(dst, ui_) do { _Pragma("unroll") for (int _h = 0; _h < 2; ++_h) _Pragma("unroll") for (int _i = 0; _i < 2; ++_i) \
        dst[_h][_i] = (unsigned)rowtab[(ui_) * 256 + _h * HALF + gR[_i]] * (unsigned)(lda * 2) + gC[_i]; } while (0)
    const size_t kstep = (size_t)(BK * 2);
    const size_t hstepA = (size_t)HALF * lda * 2, hstepB = (size_t)HALF * ldb * 2;
    const unsigned ldsw = (unsigned)wid * 1024u;
    const int aoff = lds_byte(wr * 64 + fr, fq * 8), boff = lds_byte(wc * 32 + fr, fq * 8);
#define PG8_SA(b, h) (((b) * 2 + (h)) * HTB)
#define PG8_SB(b, h) ((4 + (b) * 2 + (h)) * HTB)
#define PG8_STAGE(bufoff, gbase, voff) do { _Pragma("unroll") for (int _i = 0; _i < 2; ++_i) \
        __builtin_amdgcn_global_load_lds((const unsigned*)((const char*)(gbase) + (voff)[_i]), (PG8_LAS unsigned*)(lds + (bufoff) + ldsw + _i * 8192), 16, 0, 0); } while (0)
#define PG8_STAGE_A(bufoff, gbase, h, vs) do { if constexpr (GATHER) { PG8_STAGE(bufoff, gbase, vs[h]); } else { PG8_STAGE(bufoff, (gbase) + (h) * hstepA, voffA); } } while (0)
#define PG8_LDA(dst, b, h) do { _Pragma("unroll") for (int m = 0; m < 4; ++m) _Pragma("unroll") for (int k = 0; k < 2; ++k) dst[m][k] = *(const PG8_LAS bf16x8*)(lds + PG8_SA(b, h) + aoff + m * 2048 + k * 1024); } while (0)
#define PG8_LDB(dst, b, h) do { _Pragma("unroll") for (int n = 0; n < 2; ++n) _Pragma("unroll") for (int k = 0; k < 2; ++k) dst[n][k] = *(const PG8_LAS bf16x8*)(lds + PG8_SB(b, h) + boff + n * 2048 + k * 1024); } while (0)
#define PG8_MMA(ai, bj, At, Bt) do { __builtin_amdgcn_s_setprio(1); _Pragma("unroll") for (int m = 0; m < 4; ++m) _Pragma("unroll") for (int n = 0; n < 2; ++n) _Pragma("unroll") for (int k = 0; k < 2; ++k) \
        acc[ai][bj][m][n] = __builtin_amdgcn_mfma_f32_16x16x32_bf16(Bt[n][k], At[m][k], acc[ai][bj][m][n], 0, 0, 0); __builtin_amdgcn_s_setprio(0); } while (0)
#define PG8_WAIT_V(n) asm volatile("s_waitcnt vmcnt(" #n ")" ::: "memory")
#define PG8_WAIT_L(n) asm volatile("s_waitcnt lgkmcnt(" #n ")" ::: "memory")
#define PG8_BAR __builtin_amdgcn_s_barrier()
#define PG8_SCHED __builtin_amdgcn_sched_barrier(0)
    Unit cur, nxt; int ui = 0;
    if (!S.next(0, cur)) return;
    f32x4 acc[2][2][4][2];
#pragma unroll
    for (int a = 0; a < 2; ++a)
#pragma unroll
        for (int b = 0; b < 2; ++b)
#pragma unroll
            for (int m = 0; m < 4; ++m)
#pragma unroll
                for (int n = 0; n < 2; ++n) acc[a][b][m][n] = (f32x4){0.f, 0.f, 0.f, 0.f};
    bf16x8 At[4][2], B0[2][2], B1[2][2];
    const char* cA = cur.a; const char* cB = cur.b;
    if constexpr (GATHER) { PG8_GLOAD(vAc, 0); }
    static_assert(SP2 || !GATHER, "GATHER is wired into the SP2 loop only");
    if constexpr (SP2) {
        PG8_STAGE(PG8_SB(0, 0), cB, voffB); PG8_STAGE(PG8_SB(0, 1), cB + hstepB, voffB); PG8_STAGE_A(PG8_SA(0, 0), cA, 0, vAc); PG8_STAGE_A(PG8_SA(0, 1), cA, 1, vAc);
        if (wr == 1) PG8_BAR;
        PG8_WAIT_V(2); PG8_BAR;
        PG8_STAGE(PG8_SB(1, 0), cB + kstep, voffB); PG8_STAGE_A(PG8_SA(1, 0), cA + kstep, 0, vAc); PG8_STAGE(PG8_SB(1, 1), cB + hstepB + kstep, voffB);
        PG8_WAIT_V(6); PG8_BAR;
    } else {
        PG8_STAGE(PG8_SB(0, 0), cB, voffB); PG8_STAGE(PG8_SA(0, 0), cA, voffA); PG8_STAGE(PG8_SB(0, 1), cB + hstepB, voffB); PG8_STAGE(PG8_SA(0, 1), cA + hstepA, voffA);
        if (wr == 1) PG8_BAR;
        PG8_WAIT_V(4); PG8_BAR;
        PG8_STAGE(PG8_SB(1, 0), cB + kstep, voffB); PG8_STAGE(PG8_SA(1, 0), cA + kstep, voffA); PG8_STAGE(PG8_SB(1, 1), cB + hstepB + kstep, voffB);
        PG8_WAIT_V(6); PG8_BAR;
    }
    for (;;) {
        const bool has_next = S.next(ui + 1, nxt);
        const char* nA = has_next ? nxt.a : cA; const char* nB = has_next ? nxt.b : cB;
        if constexpr (GATHER) { if (has_next) { PG8_GLOAD(vAn, ui + 1); } else {
            _Pragma("unroll") for (int _h = 0; _h < 2; ++_h) _Pragma("unroll") for (int _i = 0; _i < 2; ++_i) vAn[_h][_i] = vAc[_h][_i]; } }
        for (int t = 0; t < nt; t += 2) {
            const bool last = (t == nt - 2);
            if constexpr (GATHER) { _Pragma("unroll") for (int _h = 0; _h < 2; ++_h) _Pragma("unroll") for (int _i = 0; _i < 2; ++_i) vA2[_h][_i] = last ? vAn[_h][_i] : vAc[_h][_i]; }
            const char* a1 = cA + (size_t)(t + 1) * kstep;
            const char* a2 = last ? nA : cA + (size_t)(t + 2) * kstep; const char* b2 = last ? nB : cB + (size_t)(t + 2) * kstep;
            const char* a3 = a2 + kstep; const char* b3 = b2 + kstep;
            if constexpr (SP2) {
            PG8_LDB(B0, 0, 0); PG8_LDB(B1, 0, 1); PG8_SCHED; PG8_LDA(At, 0, 0); PG8_STAGE_A(PG8_SA(1, 1), a1, 1, vAc);
            PG8_WAIT_V(8); PG8_WAIT_L(0); PG8_BAR; PG8_MMA(0, 0, At, B0); PG8_MMA(0, 1, At, B1); PG8_BAR; PG8_SCHED;
            PG8_LDA(At, 0, 1); PG8_STAGE(PG8_SB(0, 0), b2, voffB); PG8_STAGE(PG8_SB(0, 1), b2 + hstepB, voffB); PG8_STAGE_A(PG8_SA(0, 0), a2, 0, vA2);
            PG8_WAIT_V(8); PG8_WAIT_L(0); PG8_BAR; PG8_MMA(1, 0, At, B0); PG8_MMA(1, 1, At, B1); PG8_BAR; PG8_SCHED;
            PG8_LDB(B0, 1, 0); PG8_LDB(B1, 1, 1); PG8_SCHED; PG8_LDA(At, 1, 0); PG8_STAGE_A(PG8_SA(0, 1), a2, 1, vA2);
            PG8_WAIT_V(8); PG8_WAIT_L(0); PG8_BAR; PG8_MMA(0, 0, At, B0); PG8_MMA(0, 1, At, B1); PG8_BAR; PG8_SCHED;
            PG8_LDA(At, 1, 1); PG8_STAGE(PG8_SB(1, 0), b3, voffB); PG8_STAGE(PG8_SB(1, 1), b3 + hstepB, voffB); PG8_STAGE_A(PG8_SA(1, 0), a3, 0, vA2);
            PG8_WAIT_V(8); PG8_WAIT_L(0); PG8_BAR; PG8_MMA(1, 0, At, B0); PG8_MMA(1, 1, At, B1); PG8_BAR; PG8_SCHED;
            } else {
            PG8_LDB(B0, 0, 0); PG8_SCHED; PG8_LDA(At, 0, 0); PG8_STAGE(PG8_SA(1, 1), a1 + hstepA, voffA);
            PG8_WAIT_L(8); PG8_BAR; PG8_WAIT_L(0); PG8_MMA(0, 0, At, B0); PG8_BAR; PG8_SCHED;
            PG8_LDB(B1, 0, 1); PG8_STAGE(PG8_SB(0, 0), b2, voffB);
            PG8_BAR; PG8_WAIT_L(0); PG8_MMA(0, 1, At, B1); PG8_BAR;
            PG8_LDA(At, 0, 1); PG8_STAGE(PG8_SA(0, 0), a2, voffA);
            PG8_BAR; PG8_WAIT_L(0); PG8_MMA(1, 0, At, B0); PG8_BAR; PG8_SCHED;
            PG8_STAGE(PG8_SB(0, 1), b2 + hstepB, voffB);
            PG8_WAIT_V(6); PG8_BAR; PG8_MMA(1, 1, At, B1); PG8_BAR;
            PG8_LDB(B0, 1, 0); PG8_SCHED; PG8_LDA(At, 1, 0); PG8_STAGE(PG8_SA(0, 1), a2 + hstepA, voffA);
            PG8_WAIT_L(8); PG8_BAR; PG8_WAIT_L(0); PG8_MMA(0, 0, At, B0); PG8_BAR; PG8_SCHED;
            PG8_LDB(B1, 1, 1); PG8_STAGE(PG8_SB(1, 0), b3, voffB);
            PG8_BAR; PG8_WAIT_L(0); PG8_MMA(0, 1, At, B1); PG8_BAR;
            PG8_LDA(At, 1, 1); PG8_STAGE(PG8_SA(1, 0), a3, voffA);
            PG8_BAR; PG8_WAIT_L(0); PG8_MMA(1, 0, At, B0); PG8_BAR; PG8_SCHED;
            PG8_STAGE(PG8_SB(1, 1), b3 + hstepB, voffB);
            PG8_WAIT_V(6); PG8_BAR; PG8_MMA(1, 1, At, B1); PG8_BAR;
            }
        }
        if constexpr (ALIGN_EPI) { if (wr == 0) PG8_BAR; }
        E(acc, cur, wr, wc, fr, fq);
        if (!has_next) break;
#pragma unroll
        for (int a = 0; a < 2; ++a)
#pragma unroll
            for (int b = 0; b < 2; ++b)
#pragma unroll
                for (int m = 0; m < 4; ++m)
#pragma unroll
                    for (int n = 0; n < 2; ++n) acc[a][b][m][n] = (f32x4){0.f, 0.f, 0.f, 0.f};
        cur = nxt; cA = nA; cB = nB; ++ui;
        if constexpr (GATHER) { _Pragma("unroll") for (int _h = 0; _h < 2; ++_h) _Pragma("unroll") for (int _i = 0; _i < 2; ++_i) vAc[_h][_i] = vAn[_h][_i]; }
        if constexpr (ALIGN_EPI) { if (wr == 1) PG8_BAR; }
    }
    PG8_WAIT_V(0);
    if constexpr (!ALIGN_EPI) { if (wr == 0) PG8_BAR; }
    PG8_BAR;
#undef PG8_SA
#undef PG8_SB
#undef PG8_STAGE
#undef PG8_STAGE_A
#undef PG8_GLOAD
#undef PG8_LDA
#undef PG8_LDB
#undef PG8_MMA
#undef PG8_WAIT_V
#undef PG8_WAIT_L
#undef PG8_BAR
#undef PG8_SCHED
}
}

namespace attn_body {
using bf16=__hip_bfloat16;
using bf16x8=__attribute__((ext_vector_type(8)))short;
using s16x4=__attribute__((ext_vector_type(4)))short;
using f32x16=__attribute__((ext_vector_type(16)))float;
using u32x4=__attribute__((ext_vector_type(4)))unsigned;
constexpr int NHEAD=16,SEQ=4096,D=64,DM=NHEAD*D;
constexpr int NW=8,QBLK=32,QB=QBLK*NW,KVBLK=64,NQB=SEQ/QB;
__device__ __forceinline__ int crow(int r,int hi){return (r&3)+8*(r>>2)+4*hi;}
#define SBAR() __builtin_amdgcn_sched_barrier(0)
__device__ __forceinline__ void cmask(f32x16&p0,f32x16&p1,int jb,int wid){
  const float NEG=-INFINITY;
  if(jb>(wid>>1)){
  #pragma unroll
  for(int r=0;r<16;++r){p0[r]=NEG;p1[r]=NEG;}}
}
constexpr int NSLOT=3, SLOTB=8192, VSLOTB=16384;
constexpr int LDS_K=0, LDS_V=NSLOT*SLOTB, LDS_WS=LDS_V+NSLOT*VSLOTB, LDS_OST=LDS_WS+NW*64*4, LDS_BYTES=LDS_OST+NW*8192;
constexpr float C2=0.125f*1.4426950408889634f;
__device__ __forceinline__ void glds16(const char*sbase,unsigned voff,unsigned lds_dst){unsigned keep;
  asm volatile("s_mov_b32 %0, m0\n\ts_mov_b32 m0, %2\n\ts_nop 0\n\tglobal_load_lds_dwordx4 %1, %3\n\ts_mov_b32 m0, %0":"=&s"(keep):"v"(voff),"s"(lds_dst),"s"(sbase):"memory");}
__device__ __forceinline__ float max3f(float a,float b,float c){float r;asm("v_max3_f32 %0, %1, %2, %3":"=v"(r):"v"(a),"v"(b),"v"(c));return r;}
__device__ __forceinline__ float max2f(float a,float b){float r;asm("v_max_f32_e32 %0, %1, %2":"=v"(r):"v"(a),"v"(b));return r;}
typedef float f32x2_t __attribute__((ext_vector_type(2))); typedef __bf16 bf16x2_t __attribute__((ext_vector_type(2)));
__device__ __forceinline__ unsigned cvtpk_s(float lo,float hi){f32x2_t v={lo,hi};bf16x2_t b=__builtin_convertvector(v,bf16x2_t);return __builtin_bit_cast(unsigned,b);}
#define WAIT_BAR(N) asm volatile("s_waitcnt vmcnt(" #N ") lgkmcnt(0)\n\ts_barrier":::"memory")

__device__ __forceinline__ void qkt(f32x16&p0,f32x16&p1,const char*Kslot,const bf16x8*qr,int r32,int hi){
  const char*kb=Kslot+hi*1024+r32*16; const f32x16 z=f32x16{};
  #pragma unroll
  for(int d0=0;d0<4;++d0){
    const bf16x8 b0=*reinterpret_cast<const bf16x8*>(kb+d0*2048);
    const bf16x8 b1=*reinterpret_cast<const bf16x8*>(kb+d0*2048+512);
    if(d0==0){p0=__builtin_amdgcn_mfma_f32_32x32x16_bf16(b0,qr[0],z,0,0,0);p1=__builtin_amdgcn_mfma_f32_32x32x16_bf16(b1,qr[0],z,0,0,0);}
    else{p0=__builtin_amdgcn_mfma_f32_32x32x16_bf16(b0,qr[d0],p0,0,0,0);p1=__builtin_amdgcn_mfma_f32_32x32x16_bf16(b1,qr[d0],p1,0,0,0);}}
}
typedef __attribute__((address_space(3))) const char* lds_cptr;
typedef short v4i16_t __attribute__((ext_vector_type(4)));
__device__ __forceinline__ void kload8(bf16x8*kf,lds_cptr kp){
  kf[0]=*(const __attribute__((address_space(3))) bf16x8*)(kp);      kf[1]=*(const __attribute__((address_space(3))) bf16x8*)(kp+512);
  kf[2]=*(const __attribute__((address_space(3))) bf16x8*)(kp+2048); kf[3]=*(const __attribute__((address_space(3))) bf16x8*)(kp+2560);
  kf[4]=*(const __attribute__((address_space(3))) bf16x8*)(kp+4096); kf[5]=*(const __attribute__((address_space(3))) bf16x8*)(kp+4608);
  kf[6]=*(const __attribute__((address_space(3))) bf16x8*)(kp+6144); kf[7]=*(const __attribute__((address_space(3))) bf16x8*)(kp+6656);
}
__device__ __forceinline__ void kload2(bf16x8*kf,lds_cptr kp,int j){ kf[2*j]=*(const __attribute__((address_space(3))) bf16x8*)(kp+j*2048); kf[2*j+1]=*(const __attribute__((address_space(3))) bf16x8*)(kp+j*2048+512); }
__device__ __forceinline__ s16x4 vtr(lds_cptr p){ return __builtin_bit_cast(s16x4,__builtin_amdgcn_ds_read_tr16_b64_v4i16((__attribute__((address_space(3))) v4i16_t*)p)); }
__device__ __forceinline__ float rowmax(const f32x16&p0,const f32x16&p1){
  float a=max3f(p0[0],p0[1],p1[0]),b=max3f(p0[2],p0[3],p1[1]);a=max3f(a,p1[2],p1[3]);
  #pragma unroll
  for(int r=4;r<16;r+=4){a=max3f(a,p0[r],p0[r+1]);b=max3f(b,p0[r+2],p0[r+3]);a=max3f(a,p1[r],p1[r+1]);b=max3f(b,p1[r+2],p1[r+3]);}
  const float m=max2f(a,b);
  auto rr=__builtin_amdgcn_permlane32_swap(__float_as_uint(m),__float_as_uint(m),false,false);
  return max2f(__uint_as_float(rr[0]),__uint_as_float(rr[1]));
}
__device__ __forceinline__ void pv(f32x16*o,int vb,bf16x8 pa0,bf16x8 pa1,bf16x8 pa2,bf16x8 pa3){
  #pragma unroll
  for(int d0=0;d0<4;++d0){s16x4 lo[4],hi[4];
    #pragma unroll
    for(int ks=0;ks<4;++ks){
      asm volatile("ds_read_b64_tr_b16 %0,%1 offset:%c2":"=&v"(lo[ks]):"v"(vb),"i"(d0*4096+ks*1024):"memory");
      asm volatile("ds_read_b64_tr_b16 %0,%1 offset:%c2":"=&v"(hi[ks]):"v"(vb),"i"(d0*4096+ks*1024+512):"memory");}
    asm volatile("s_waitcnt lgkmcnt(0)":::"memory");SBAR();
    #define PK(k) (bf16x8){lo[k][0],lo[k][1],lo[k][2],lo[k][3],hi[k][0],hi[k][1],hi[k][2],hi[k][3]}
    o[d0]=__builtin_amdgcn_mfma_f32_32x32x16_bf16(pa0,PK(0),o[d0],0,0,0);
    o[d0]=__builtin_amdgcn_mfma_f32_32x32x16_bf16(pa1,PK(1),o[d0],0,0,0);
    o[d0]=__builtin_amdgcn_mfma_f32_32x32x16_bf16(pa2,PK(2),o[d0],0,0,0);
    o[d0]=__builtin_amdgcn_mfma_f32_32x32x16_bf16(pa3,PK(3),o[d0],0,0,0);
    #undef PK
  }
}
template<int THRL,size_t OFF_Q,size_t OFF_K,size_t OFF_V,int GSO> __device__ __forceinline__ void attn_unit(int b,int h,int qb,const char*ws,bf16*AO,float lam,char*shm){
  const bf16*Q=(const bf16*)(ws+OFF_Q); const float*gs=(const float*)(shm+GSO);
  int tid=threadIdx.x; asm volatile("":"+v"(tid)); const int lane=tid&63,r32=lane&31,hi=lane>>5; const int wid=__builtin_amdgcn_readfirstlane(tid>>6);
  const long rowbase=(long)b*SEQ; const int q0=qb*QB;
  const unsigned lds0=(unsigned)(uintptr_t)shm;
  float*wsf=(float*)(shm+LDS_WS)+wid*64;
  bf16*stg=(bf16*)(shm+LDS_OST)+wid*4096;
  const unsigned kdst=lds0+LDS_K+wid*1024, vdst=lds0+LDS_V+wid*1024;
  const int vb0=(int)(lds0+LDS_V)+((lane>>4)&1)*32+(lane&3)*8+(4*hi+((lane&15)>>2))*64;
  const char*Kbase=shm+LDS_K;
  const lds_cptr shm3=(lds_cptr)shm; const lds_cptr kp0=shm3+LDS_K+hi*1024+r32*16; const lds_cptr vp0=shm3+LDS_V+((lane>>4)&1)*32+(lane&3)*8+(4*hi+((lane&15)>>2))*64;
  const int NT=(q0+QB)/KVBLK;
  const char*Vh=ws+OFF_V+(rowbase*DM+h*128)*2;
  const unsigned vsrc=(unsigned)(((16*(wid&3)+(lane>>2))*DM+(wid>>2)*32+(lane&3)*8)*2);
  #pragma unroll 1
  for(int mp=0;mp<2;++mp){
  const int hq=2*h+mp;
  const bf16*Qw=Q+(rowbase+q0+wid*QBLK)*DM+hq*D;
  const char*Kh=ws+OFF_K+(rowbase*DM+hq*D)*2;
  const unsigned ksrc=(unsigned)((lane*DM+wid*8)*2);
  bf16x8 kf[8];
  #define DMA_K(t,slot) glds16(Kh+(long)(t)*(KVBLK*DM*2),ksrc,(unsigned)__builtin_amdgcn_readfirstlane(kdst+(slot)))
  #define DMA_V(t,slot) do{ glds16(Vh+(long)(t)*(KVBLK*DM*2),vsrc,(unsigned)__builtin_amdgcn_readfirstlane(vdst+2*(slot))); glds16(Vh+(long)(t)*(KVBLK*DM*2)+128,vsrc,(unsigned)__builtin_amdgcn_readfirstlane(vdst+2*(slot)+8192)); }while(0)
  DMA_K(0,0);DMA_V(0,0);DMA_K(1,SLOTB);
  bf16x8 qr[4];
  #pragma unroll
  for(int d0=0;d0<4;++d0)qr[d0]=*reinterpret_cast<const bf16x8*>(&Qw[(long)r32*DM+d0*16+hi*8]);
  float mhat=0.f,l_reg=0.f;f32x16 o[4];o[0]=f32x16{};o[1]=f32x16{};o[2]=f32x16{};o[3]=f32x16{};
  #define CMASK(P0,P1,t) do{int jb_=(t)-(NT-4); if(jb_>=0)cmask(P0,P1,jb_,wid);}while(0)
  bool resc=false;
  #define RESC() do{ if(resc){ asm volatile("s_waitcnt lgkmcnt(0)":::"memory"); \
      _Pragma("unroll") for(int d_=0;d_<4;++d_) _Pragma("unroll") for(int r=0;r<16;++r)o[d_][r]*=wsf[crow(r,hi)]; } }while(0)
  f32x16 pA0,pA1,pB0,pB1;
  int sl_prev=0,sl_cur=0,sl_next=SLOTB;
  #define ROT() do{sl_prev=sl_cur;sl_cur=sl_next;sl_next=(sl_next==(NSLOT-1)*SLOTB)?0:sl_next+SLOTB;}while(0)
  DMA_K(2,2*SLOTB);
  WAIT_BAR(4);
  qkt(pA0,pA1,Kbase,qr,r32,hi);asm volatile("s_nop 15\n\ts_nop 7":"+v"(pA0),"+v"(pA1));CMASK(pA0,pA1,0);
  { const float rm=rowmax(pA0,pA1); mhat=rm; resc=false;
    _Pragma("unroll") for(int r=0;r<16;++r){pA0[r]=__builtin_amdgcn_exp2f(pA0[r]-mhat);pA1[r]=__builtin_amdgcn_exp2f(pA1[r]-mhat);} }
  WAIT_BAR(0);
  DMA_K(3,0);DMA_V(1,SLOTB);
  ROT();
  kload8(kf,kp0+sl_cur);
  WAIT_BAR(3);
  s16x4 vlo[8],vhi[8]; u32x4 pw0,pw1,pw2,pw3;
  #define PKW(P,B) cvtpk_s(P[B],P[B+1])
  #define PAF(k) __builtin_bit_cast(bf16x8,pw##k)
  #define VFR(i) (bf16x8){vlo[i][0],vlo[i][1],vlo[i][2],vlo[i][3],vhi[i][0],vhi[i][1],vhi[i][2],vhi[i][3]}
  #define PIN(x) asm volatile("":"+v"(x))
  #define MX3(a,b,c) __builtin_fmaxf(__builtin_fmaxf((a),(b)),(c))
  #define ZC (f32x16{})
  #define GAPA(MF,A0,A1,A2,A3,W0,W1,PW) do{ MF; sacc+=A0; sacc+=A1; sacc+=A2; sacc+=A3; PIN(sacc); W0; W1; PIN(PW); SBAR(); }while(0)
  #define EX(v) __builtin_amdgcn_exp2f((v)-mhat)
  #define GAPB(MF,X,B) do{ MF; X[B]=EX(X[B]); X[B+1]=EX(X[B+1]); PIN(X); SBAR(); }while(0)
  #define VRD(i) do{ vlo[i]=vtr(vp_+(((i)>>2)*4096+((i)&3)*1024)); vhi[i]=vtr(vp_+(((i)>>2)*4096+((i)&3)*1024+512)); }while(0)
  #define VRD2(i) do{ vlo[i]=vtr(vp_+((2+((i)>>2))*4096+((i)&3)*1024)); vhi[i]=vtr(vp_+((2+((i)>>2))*4096+((i)&3)*1024+512)); SBAR(); }while(0)
  #define KRD(G,j) do{ if(G){ kload2(kf,kp0+sl_next,j); SBAR(); } }while(0)
  #define STEP(C0,C1,P0,P1,t,GK,GV,GL) do{ SBAR(); \
    const lds_cptr vp_=vp0+2*sl_prev; \
    VRD(0); SBAR(); float sacc=(P0[0]+P0[1]); \
    GAPA(C0=__builtin_amdgcn_mfma_f32_32x32x16_bf16(kf[0],qr[0],ZC,0,0,0), P0[2],P0[3],P0[4],P0[5],     pw0[0]=PKW(P0,0), pw0[1]=PKW(P0,2), pw0); \
    VRD(4); SBAR(); GAPA(C1=__builtin_amdgcn_mfma_f32_32x32x16_bf16(kf[1],qr[0],ZC,0,0,0), P0[6],P0[7],P0[8],P0[9],     pw0[2]=PKW(P0,4), pw0[3]=PKW(P0,6), pw0); \
    VRD(1); SBAR(); GAPA(C0=__builtin_amdgcn_mfma_f32_32x32x16_bf16(kf[2],qr[1],C0,0,0,0),   P0[10],P0[11],P0[12],P0[13], pw1[0]=PKW(P0,8), pw1[1]=PKW(P0,10), pw1); \
    VRD(5); SBAR(); GAPA(C1=__builtin_amdgcn_mfma_f32_32x32x16_bf16(kf[3],qr[1],C1,0,0,0),   P0[14],P0[15],P1[0],P1[1],   pw1[2]=PKW(P0,12),pw1[3]=PKW(P0,14), pw1); \
    VRD(2); SBAR(); GAPA(C0=__builtin_amdgcn_mfma_f32_32x32x16_bf16(kf[4],qr[2],C0,0,0,0),   P1[2],P1[3],P1[4],P1[5],     pw2[0]=PKW(P1,0), pw2[1]=PKW(P1,2), pw2); \
    VRD(6); SBAR(); GAPA(C1=__builtin_amdgcn_mfma_f32_32x32x16_bf16(kf[5],qr[2],C1,0,0,0),   P1[6],P1[7],P1[8],P1[9],     pw2[2]=PKW(P1,4), pw2[3]=PKW(P1,6), pw2); \
    VRD(3); SBAR(); GAPA(C0=__builtin_amdgcn_mfma_f32_32x32x16_bf16(kf[6],qr[3],C0,0,0,0),   P1[10],P1[11],P1[12],P1[13], pw3[0]=PKW(P1,8), pw3[1]=PKW(P1,10), pw3); \
    VRD(7); SBAR(); GAPA(C1=__builtin_amdgcn_mfma_f32_32x32x16_bf16(kf[7],qr[3],C1,0,0,0),   P1[14],P1[15],0.f,0.f,       pw3[2]=PKW(P1,12),pw3[3]=PKW(P1,14), pw3); \
    l_reg+=sacc; \
    if(GK){DMA_K((t)+3,sl_cur);} if(GV){DMA_V((t)+1,sl_next);} \
    CMASK(C0,C1,t); \
    { float a=MX3(C0[0],C0[1],C1[0]),b=MX3(C0[2],C0[3],C1[1]); a=MX3(a,C1[2],C1[3]); \
      _Pragma("unroll") for(int r=4;r<16;r+=4){a=MX3(a,C0[r],C0[r+1]);b=MX3(b,C0[r+2],C0[r+3]);a=MX3(a,C1[r],C1[r+1]);b=MX3(b,C1[r+2],C1[r+3]);} \
      float rm=__builtin_fmaxf(a,b); { auto rr=__builtin_amdgcn_permlane32_swap(__float_as_uint(rm),__float_as_uint(rm),false,false); rm=__builtin_fmaxf(__uint_as_float(rr[0]),__uint_as_float(rr[1])); } \
      rm-=mhat; resc=false; \
      if(__builtin_expect(__any(rm>(float)THRL),0)){ const float dl=__builtin_fmaxf(rm,0.f); mhat+=dl; \
        const float f=__builtin_amdgcn_exp2f(-dl); l_reg*=f; if(hi==0)wsf[r32]=f; resc=true; } } \
    SBAR(); \
    GAPB(o[0]=__builtin_amdgcn_mfma_f32_32x32x16_bf16(PAF(0),VFR(0),o[0],0,0,0), C0,0);  VRD2(0); \
    GAPB(o[1]=__builtin_amdgcn_mfma_f32_32x32x16_bf16(PAF(0),VFR(4),o[1],0,0,0), C0,2);  VRD2(4); \
    GAPB(o[0]=__builtin_amdgcn_mfma_f32_32x32x16_bf16(PAF(1),VFR(1),o[0],0,0,0), C0,4);  VRD2(1); \
    GAPB(o[1]=__builtin_amdgcn_mfma_f32_32x32x16_bf16(PAF(1),VFR(5),o[1],0,0,0), C0,6);  VRD2(5); \
    GAPB(o[0]=__builtin_amdgcn_mfma_f32_32x32x16_bf16(PAF(2),VFR(2),o[0],0,0,0), C0,8);  VRD2(2); \
    GAPB(o[1]=__builtin_amdgcn_mfma_f32_32x32x16_bf16(PAF(2),VFR(6),o[1],0,0,0), C0,10); VRD2(6); \
    GAPB(o[0]=__builtin_amdgcn_mfma_f32_32x32x16_bf16(PAF(3),VFR(3),o[0],0,0,0), C0,12); VRD2(3); \
    GAPB(o[1]=__builtin_amdgcn_mfma_f32_32x32x16_bf16(PAF(3),VFR(7),o[1],0,0,0), C0,14); VRD2(7); \
    KRD(GL,0); GAPB(o[2]=__builtin_amdgcn_mfma_f32_32x32x16_bf16(PAF(0),VFR(0),o[2],0,0,0), C1,0); \
    KRD(GL,1); GAPB(o[3]=__builtin_amdgcn_mfma_f32_32x32x16_bf16(PAF(0),VFR(4),o[3],0,0,0), C1,2); \
    KRD(GL,2); GAPB(o[2]=__builtin_amdgcn_mfma_f32_32x32x16_bf16(PAF(1),VFR(1),o[2],0,0,0), C1,4); \
    KRD(GL,3); GAPB(o[3]=__builtin_amdgcn_mfma_f32_32x32x16_bf16(PAF(1),VFR(5),o[3],0,0,0), C1,6); \
    GAPB(o[2]=__builtin_amdgcn_mfma_f32_32x32x16_bf16(PAF(2),VFR(2),o[2],0,0,0), C1,8); \
    GAPB(o[3]=__builtin_amdgcn_mfma_f32_32x32x16_bf16(PAF(2),VFR(6),o[3],0,0,0), C1,10); \
    GAPB(o[2]=__builtin_amdgcn_mfma_f32_32x32x16_bf16(PAF(3),VFR(3),o[2],0,0,0), C1,12); \
    GAPB(o[3]=__builtin_amdgcn_mfma_f32_32x32x16_bf16(PAF(3),VFR(7),o[3],0,0,0), C1,14); \
    }while(0)
  int t=1;
  #undef CMASK
  #define CMASK(P0,P1,t) do{}while(0)
  for(;t+5<NT;t+=2){
    STEP(pB0,pB1,pA0,pA1,t,true,true,true);     WAIT_BAR(3); RESC(); ROT();
    STEP(pA0,pA1,pB0,pB1,t+1,true,true,true);   WAIT_BAR(3); RESC(); ROT();
  }
  #undef CMASK
  #define CMASK(P0,P1,t) do{int jb_=(t)-(NT-4); if(jb_>=0)cmask(P0,P1,jb_,wid);}while(0)
  #define ENDW(tt) do{ if((tt)+3<NT){WAIT_BAR(3);} else if((tt)+2<NT){WAIT_BAR(2);} else {WAIT_BAR(0);} }while(0)
  for(;t+1<NT;t+=2){
    STEP(pB0,pB1,pA0,pA1,t,(t+3<NT),(t+1<NT),(t+1<NT));       ENDW(t);   RESC(); ROT();
    STEP(pA0,pA1,pB0,pB1,t+1,(t+4<NT),(t+2<NT),(t+2<NT));     ENDW(t+1); RESC(); ROT();
  }
  STEP(pB0,pB1,pA0,pA1,NT-1,false,false,false); RESC();
  { float sacc=pB0[0]+pB0[1]; _Pragma("unroll") for(int r=2;r<16;++r)sacc+=pB0[r]; _Pragma("unroll") for(int r=0;r<16;++r)sacc+=pB1[r]; l_reg+=sacc;
    pw0=(u32x4){PKW(pB0,0),PKW(pB0,2),PKW(pB0,4),PKW(pB0,6)};pw1=(u32x4){PKW(pB0,8),PKW(pB0,10),PKW(pB0,12),PKW(pB0,14)};pw2=(u32x4){PKW(pB1,0),PKW(pB1,2),PKW(pB1,4),PKW(pB1,6)};pw3=(u32x4){PKW(pB1,8),PKW(pB1,10),PKW(pB1,12),PKW(pB1,14)};
    SBAR(); pv(o,vb0+2*sl_cur,PAF(0),PAF(1),PAF(2),PAF(3)); }
  #undef PKW
  #undef PAF
  #undef VFR
  #undef PIN
  #undef MX3
  #undef ZC
  #undef GAPA
  #undef GAPB
  #undef EX
  #undef VRD
  #undef VRD2
  #undef KRD
  #undef STEP
  #undef ENDW
  #undef DMA_K
  #undef DMA_V
  #undef CMASK
  #undef RESC
  #undef ROT
  {auto rr=__builtin_amdgcn_permlane32_swap(__float_as_uint(l_reg),__float_as_uint(l_reg),false,false);l_reg=__uint_as_float(rr[0])+__uint_as_float(rr[1]);}
  if(hi==0)wsf[32+r32]=l_reg;asm volatile("s_waitcnt lgkmcnt(0)":::"memory");
  float rli[16];
  #pragma unroll
  for(int r=0;r<16;++r)rli[r]=__builtin_amdgcn_rcpf(wsf[32+crow(r,hi)]);
  if(mp==0){
    #pragma unroll
    for(int r=0;r<16;++r){const int orow=crow(r,hi);
      #pragma unroll
      for(int d0=0;d0<4;++d0)stg[orow*128+d0*32+r32]=__float2bfloat16(o[d0][r]*rli[r]);}
  } else {
    #pragma unroll
    for(int r=0;r<16;++r){const int orow=crow(r,hi);
      #pragma unroll
      for(int d0=0;d0<4;++d0){ const float c=__bfloat162float(stg[orow*128+d0*32+r32])-lam*(o[d0][r]*rli[r]); stg[orow*128+d0*32+r32]=__float2bfloat16(c);} }
    asm volatile("s_waitcnt lgkmcnt(0)":::"memory");
    const int row=lane>>1,hf=lane&1; float cv[64]; float ss=0.f;
    #pragma unroll
    for(int i=0;i<8;++i){ const u32x4 w=*(const u32x4*)(stg+row*128+hf*64+i*8);
      cv[8*i+0]=__uint_as_float(w.x<<16);cv[8*i+1]=__uint_as_float(w.x&0xffff0000u);cv[8*i+2]=__uint_as_float(w.y<<16);cv[8*i+3]=__uint_as_float(w.y&0xffff0000u);
      cv[8*i+4]=__uint_as_float(w.z<<16);cv[8*i+5]=__uint_as_float(w.z&0xffff0000u);cv[8*i+6]=__uint_as_float(w.w<<16);cv[8*i+7]=__uint_as_float(w.w&0xffff0000u); }
    #pragma unroll
    for(int i=0;i<64;++i)ss+=cv[i]*cv[i];
    ss+=__int_as_float(__builtin_amdgcn_ds_bpermute((lane^1)<<2,__float_as_int(ss)));
    const float rstd=1.0f/sqrtf(ss*(1.0f/128.0f)+1e-6f);
    bf16*Ow=AO+(rowbase+q0+wid*QBLK+row)*DM+h*128+hf*64;
    #pragma unroll
    for(int i=0;i<8;++i){ const float4 g0=*(const float4*)(gs+hf*64+i*8),g1=*(const float4*)(gs+hf*64+i*8+4); u32x4 w;
      w.x=cvtpk_s(cv[8*i+0]*rstd*g0.x,cv[8*i+1]*rstd*g0.y); w.y=cvtpk_s(cv[8*i+2]*rstd*g0.z,cv[8*i+3]*rstd*g0.w);
      w.z=cvtpk_s(cv[8*i+4]*rstd*g1.x,cv[8*i+5]*rstd*g1.y); w.w=cvtpk_s(cv[8*i+6]*rstd*g1.z,cv[8*i+7]*rstd*g1.w);
      *(u32x4*)(Ow+i*8)=w; }
  }
  asm volatile("s_waitcnt lgkmcnt(0)\n\ts_barrier":::"memory");
  }
}
constexpr int ATTN_LDS_BYTES=LDS_BYTES;
#undef SBAR
#undef WAIT_BAR
}

constexpr size_t MiB = 1u << 20;
constexpr size_t WS_CTL = 0, CTL_ZERO_BYTES = 1 * MiB;
constexpr size_t WS_WIN = 2 * MiB;
constexpr size_t WS_WGLU = 13 * MiB;
constexpr size_t WS_WSSM = 14 * MiB;
constexpr size_t WS_WATT = 15 * MiB;
constexpr size_t WS_WOUT = 17 * MiB;
constexpr size_t WS_WR = 19 * MiB;
constexpr size_t WS_BTP = 20 * MiB;
constexpr size_t WS_BTY = 28 * MiB;
constexpr size_t WS_WE1 = 48 * MiB;
constexpr size_t WS_WE2 = 80 * MiB;
constexpr size_t WS_ETAB = 96 * MiB;
constexpr size_t WS_MOD = 104 * MiB;
constexpr size_t WS_UG = 112 * MiB;
constexpr size_t WS_Q = 152 * MiB, WS_K = 216 * MiB, WS_V = 280 * MiB;
constexpr size_t WS_GATES = 344 * MiB;
constexpr size_t WS_SLOC = 472 * MiB;
constexpr size_t WS_YACT = 152 * MiB;
constexpr size_t WS_S5O = 184 * MiB;
constexpr size_t WS_TMP = 280 * MiB;
constexpr size_t WS_H = 344 * MiB;
constexpr size_t WS_HDN = 256 * MiB;
constexpr size_t WS_SLOTS = 112 * MiB;
constexpr size_t WS_LIST = 472 * MiB;
constexpr size_t WS_CWL = 476 * MiB;
constexpr size_t WS_END = 512 * MiB;
constexpr int CW_TMO = 0, CW_BAR = 4096, CW_CNT = 16384;

constexpr int NWAVES = 8;
constexpr int RING_OFF = 0, RING_BYTES = 147456;
constexpr int LDSCTL_OFF = RING_BYTES, MISC_OFF = LDSCTL_OFF + 320;
constexpr int GS_OFF = MISC_OFF + 2048;
constexpr int ROWTAB_OFF = LDSCTL_OFF + 4096;
constexpr int LDS_BYTES = RING_BYTES + 8192;
static_assert(attn_body::ATTN_LDS_BYTES <= RING_BYTES, "attention LDS");

#define GAS __attribute__((address_space(1)))
#define LAS __attribute__((address_space(3)))
typedef unsigned short bf16;
typedef unsigned v4u __attribute__((ext_vector_type(4)));
typedef unsigned v2u __attribute__((ext_vector_type(2)));
typedef float f32x4 __attribute__((ext_vector_type(4)));
typedef GAS unsigned gu32;
#define RLX_AGENT __ATOMIC_RELAXED, __HIP_MEMORY_SCOPE_AGENT
#define LDS_WAIT() asm volatile("s_waitcnt lgkmcnt(0)" ::: "memory")
#define VM_WAIT() asm volatile("s_waitcnt vmcnt(0)" ::: "memory")
__device__ __forceinline__ unsigned f2bf(float f) { unsigned u = __builtin_bit_cast(unsigned, f); return (u + 0x7fffu + ((u >> 16) & 1u)) >> 16; }
__device__ __forceinline__ unsigned pk2(float lo, float hi) { return f2bf(lo) | (f2bf(hi) << 16); }
__device__ __forceinline__ float bf2f(unsigned b) { return __uint_as_float(b << 16); }

#define XB_TMO      128
#define XB_XCNT(j)  (256  + 64 * (j))
#define XB_XSUB(j)  (1280 + 64 * (j))
#define XB_XGEN(j)  (2304 + 64 * (j))
#define XB_TOP      3328
#define XB_TOPGEN   3392
#define XCD_BAR_WORDS 3456
#define XB_SPIN_CAP (1u << 18)
__device__ __forceinline__ unsigned xb_ld(unsigned* p)              { return __hip_atomic_load(p, __ATOMIC_RELAXED, __HIP_MEMORY_SCOPE_AGENT); }
__device__ __forceinline__ unsigned xb_add(unsigned* p, unsigned v) { return __hip_atomic_fetch_add(p, v, __ATOMIC_RELAXED, __HIP_MEMORY_SCOPE_AGENT); }
__device__ __forceinline__ unsigned xb_xcc_id() { return (unsigned)__builtin_amdgcn_s_getreg((3 << 11) | 20) & 0xFu; }
#define XB_SPIN(cond, bar) do { unsigned _sp = 0; while (cond) { __builtin_amdgcn_s_sleep(1); \
    if ((++_sp & 255u) == 0u) { if (xb_ld(&(bar)[XB_TMO])) break; if (_sp > XB_SPIN_CAP) { atomicAdd(&(bar)[XB_TMO], 1u); break; } } } } while (0)
struct XcdBarrier { unsigned* bar; unsigned x; volatile LAS unsigned* st; };
__device__ __forceinline__ XcdBarrier xcd_barrier_post(unsigned* bar, volatile LAS unsigned* st) {
    XcdBarrier b; b.bar = bar; b.x = xb_xcc_id(); b.st = st;
    if (threadIdx.x == 0) (void)xb_add(&bar[XB_XCNT(b.x)], 1u);
    return b;
}
__device__ __forceinline__ void xcd_barrier_complete(unsigned* bar, unsigned x, unsigned& nloc, unsigned& nx) {
    const unsigned G = gridDim.x * gridDim.y * gridDim.z;
    unsigned sum, cnt, mine, sp = 0u;
    for (;;) {
        sum = 0u; cnt = 0u; mine = 0u;
#pragma unroll
        for (unsigned j = 0; j < 16; ++j) { const unsigned c = xb_ld(&bar[XB_XCNT(j)]); sum += c; cnt += (c > 0u) ? 1u : 0u; mine = (j == x) ? c : mine; }
        if (sum == G) break;
        __builtin_amdgcn_s_sleep(1);
        if ((++sp & 255u) == 0u) { if (xb_ld(&bar[XB_TMO])) break; if (sp > XB_SPIN_CAP) { atomicAdd(&bar[XB_TMO], 1u); break; } }
    }
    nloc = mine > 0u ? mine : 1u; nx = cnt > 0u ? cnt : 1u;
}
__device__ __forceinline__ void xcd_barrier(const XcdBarrier& b) {
    asm volatile("s_waitcnt vmcnt(0)" ::: "memory");
    __syncthreads();
    if (threadIdx.x == 0) {
        unsigned* bar = b.bar;
        __builtin_amdgcn_s_waitcnt(0);
        unsigned nloc = b.st[0], nx = b.st[1];
        if (nloc == 0u) { xcd_barrier_complete(bar, b.x, nloc, nx); b.st[0] = nloc; b.st[1] = nx; }
        const unsigned old = xb_add(&bar[XB_XSUB(b.x)], 1u);
        const unsigned gen = old / nloc;
        if (old + 1u == (gen + 1u) * nloc) {
            __builtin_amdgcn_fence(__ATOMIC_RELEASE, "agent");
            asm volatile("s_waitcnt vmcnt(0)" ::: "memory");
            const unsigned og = xb_add(&bar[XB_TOP], 1u);
            const unsigned tg = og / nx;
            if (og + 1u == (tg + 1u) * nx) xb_add(&bar[XB_TOPGEN], 1u);
            else XB_SPIN(xb_ld(&bar[XB_TOPGEN]) == tg, bar);
            __builtin_amdgcn_fence(__ATOMIC_ACQUIRE, "agent");
            xb_add(&bar[XB_XGEN(b.x)], 1u);
            asm volatile("s_waitcnt vmcnt(0)" ::: "memory");
        } else {
            XB_SPIN(xb_ld(&bar[XB_XGEN(b.x)]) == gen, bar);
            __builtin_amdgcn_fence(__ATOMIC_ACQUIRE, "agent");
            asm volatile("s_waitcnt vmcnt(0)" ::: "memory");
        }
    }
    __syncthreads();
}

__device__ __forceinline__ float shfl_xor_l(float v, int o, int lane) { return __int_as_float(__builtin_amdgcn_ds_bpermute((lane ^ o) << 2, __float_as_int(v))); }
__device__ __forceinline__ float wave_sum(float v, int lane) {
#pragma unroll
    for (int o = 1; o < 64; o <<= 1) v += shfl_xor_l(v, o, lane);
    return v;
}
__device__ __forceinline__ void transpose_tile(const float* W, int N, int k0, int n0, bf16* WT, int ldo, int orow0, int ocol0, LAS float* scr, int lane) {
#pragma unroll 8
    for (int i = 0; i < 32; ++i) { const int kk = 2 * i + (lane >> 5); scr[kk * 33 + (lane & 31)] = W[(size_t)(k0 + kk) * N + n0 + (lane & 31)]; }
    LDS_WAIT(); asm volatile("" ::: "memory");
    const int c = lane & 7;
#pragma unroll
    for (int j = 0; j < 4; ++j) { const int n = (lane >> 3) + 8 * j; const LAS float* s = scr + (8 * c) * 33 + n;
        v4u o; o.x = pk2(s[0 * 33], s[1 * 33]); o.y = pk2(s[2 * 33], s[3 * 33]); o.z = pk2(s[4 * 33], s[5 * 33]); o.w = pk2(s[6 * 33], s[7 * 33]);
        *(GAS v4u*)(WT + (size_t)(orow0 + n) * ldo + ocol0 + 8 * c) = o; }
    LDS_WAIT(); asm volatile("" ::: "memory");
}
__device__ __forceinline__ void abar_pow(float lr, float li, float dt, float j, float& re, float& im) {
    const float mag = expf(lr * dt * j); float s, c; sincosf(li * dt * j, &s, &c); re = mag * c; im = mag * s;
}

constexpr int ETAB_OFF = MISC_OFF + 256;
__device__ __forceinline__ void build_expert_table(LAS unsigned char* L, const int* CNT, int tid) {
    LAS int* tab = (LAS int*)(L + ETAB_OFF); LAS int* cl = tab + (XS_ROWS / 256 + 2);
    __syncthreads();
    if (tid < NEXP) cl[tid] = CNT[tid];
    __syncthreads();
    if (tid == 0) { int rt = 0;
#pragma unroll 1
        for (int e = 0; e < NEXP; ++e) { const int nt = (cl[e] + 255) >> 8;
#pragma unroll 1
            for (int q = 0; q < nt; ++q) tab[rt++] = e | (q << 8); }
        tab[XS_ROWS / 256 + 1] = rt;
#pragma unroll 1
        for (; rt <= XS_ROWS / 256; ++rt) tab[rt] = -1; }
    __syncthreads();
}
struct Args { const float* in[34]; float* out; unsigned char* ws; };
typedef __attribute__((address_space(4))) const char* kconst_ptr;
__device__ __forceinline__ void* karg(int k) { kconst_ptr kp = (kconst_ptr)__builtin_amdgcn_kernarg_segment_ptr(); asm volatile("" : "+s"(kp)); return *(void* const __attribute__((address_space(4)))*)(kp + 8 * k); }

__global__ void __launch_bounds__(NWAVES * 64, 2) fwd_kernel(Args args) {
    extern __shared__ __attribute__((aligned(16))) unsigned char lds[];
    LAS unsigned char* L = (LAS unsigned char*)lds;
    volatile LAS unsigned* MISC = (volatile LAS unsigned*)(L + MISC_OFF);
#define PHASE_IDS() \
    int tid = threadIdx.x; asm volatile("" : "+v"(tid)); \
    const int lane = tid & 63, wave = __builtin_amdgcn_readfirstlane(tid >> 6); \
    int G = gridDim.x, bx = blockIdx.x; asm volatile("" : "+s"(G), "+s"(bx)); \
    const int vcu = (G % 8 == 0) ? (bx % 8) * (G / 8) + bx / 8 : bx; \
    const int gw = vcu * NWAVES + wave, NGW = G * NWAVES; \
    const int gt = bx * (NWAVES * 64) + tid, NGT = G * NWAVES * 64; \
    (void)lane; (void)wave; (void)vcu; (void)gw; (void)NGW; (void)gt; (void)NGT;
    gu32* ctl = (gu32*)(args.ws + WS_CTL);
    for (int u = threadIdx.x; u < (LDS_BYTES - LDSCTL_OFF) / 4; u += NWAVES * 64) ((LAS unsigned*)(L + LDSCTL_OFF))[u] = 0u;
    __syncthreads();
    XcdBarrier bar = xcd_barrier_post((unsigned*)(ctl + CW_BAR), MISC + 8);
#define GRID_BAR() xcd_barrier(bar)

#define KIN(k) ((const float*)karg(k))
#define WSP(T_, off) ((T_*)(((unsigned char*)karg(35)) + (off)))
#define OUTP() ((float*)karg(34))

#if DBG_STAGE != 1
    asm volatile("; PHASE_MARK P0" ::: "memory");
    {
        PHASE_IDS();
        const float* w_in = KIN(5); const float* w_glu = KIN(15); const float* w_br_ssm = KIN(22); const float* w_br_attn = KIN(23); const float* w_out = KIN(24);
        const float* w_eg = KIN(30); const float* w_eu = KIN(31); const float* w_ed = KIN(32);
        bf16* WinT = WSP(bf16, WS_WIN); bf16* WgluT = WSP(bf16, WS_WGLU); bf16* WssmT = WSP(bf16, WS_WSSM); bf16* WattT = WSP(bf16, WS_WATT); bf16* WoutT = WSP(bf16, WS_WOUT);
        bf16* WE1 = WSP(bf16, WS_WE1); bf16* WE2 = WSP(bf16, WS_WE2);
        LAS float* scr = (LAS float*)(L + RING_OFF + wave * 16384);
        constexpr int I_IN = 16 * 176, I_GLU = 8 * 16, I_SSM = 8 * 32, I_ATT = 16 * 32, I_OUT = 16 * 32, I_EG = NEXP * 16 * 8, I_EU = I_EG, I_ED = NEXP * 4 * 32;
        constexpr int NITEMS = I_IN + I_GLU + I_SSM + I_ATT + I_OUT + I_EG + I_EU + I_ED;
        for (int it = gw; it < NITEMS; it += NGW) {
            int r = it;
            if (r < I_IN) { const int kb = r / 176, nb = r % 176; transpose_tile(w_in, INW, 64 * kb, 32 * nb, WinT, D, 32 * nb, 64 * kb, scr, lane); continue; } r -= I_IN;
            if (r < I_GLU) { const int kb = r / 16, nb = r % 16; transpose_tile(w_glu, S5W, 64 * kb, 32 * nb, WgluT, S5W, 32 * nb, 64 * kb, scr, lane); continue; } r -= I_GLU;
            if (r < I_SSM) { const int kb = r / 32, nb = r % 32; transpose_tile(w_br_ssm, D, 64 * kb, 32 * nb, WssmT, S5W, 32 * nb, 64 * kb, scr, lane); continue; } r -= I_SSM;
            if (r < I_ATT) { const int kb = r / 32, nb = r % 32; transpose_tile(w_br_attn, D, 64 * kb, 32 * nb, WattT, D, 32 * nb, 64 * kb, scr, lane); continue; } r -= I_ATT;
            if (r < I_OUT) { const int kb = r / 32, nb = r % 32; transpose_tile(w_out, D, 64 * kb, 32 * nb, WoutT, D, 32 * nb, 64 * kb, scr, lane); continue; } r -= I_OUT;
            if (r < I_EG + I_EU) { const bool up = r >= I_EG; if (up) r -= I_EG; const int e = r / 128, q = r % 128, kb = q / 8, nb = q % 8;
                transpose_tile((up ? w_eu : w_eg) + (size_t)e * D * DEXP, DEXP, 64 * kb, 32 * nb, WE1 + (size_t)e * 512 * D, D, (nb >> 2) * 256 + (up ? 128 : 0) + (nb & 3) * 32, 64 * kb, scr, lane); continue; } r -= I_EG + I_EU;
            { const int e = r / 128, q = r % 128, kb = q / 32, nb = q % 32; transpose_tile(w_ed + (size_t)e * DEXP * D, D, 64 * kb, 32 * nb, WE2 + (size_t)e * D * DEXP, DEXP, 32 * nb, 64 * kb, scr, lane); }
        }
        const float* w_rg = KIN(26); const float* w_re = KIN(28); bf16* WR = WSP(bf16, WS_WR);
        for (int idx = gt; idx < 2 * 64 * 128; idx += NGT) {
            const int k0 = (idx & 127) * 8, n = (idx >> 7) & 63, part = idx >> 13;
            unsigned w[4] = {0u, 0u, 0u, 0u};
            if (n < 36) {
                float hv[8];
#pragma unroll
                for (int i = 0; i < 8; ++i) { const float f = (n < 4) ? w_rg[(size_t)(k0 + i) * 4 + n] : w_re[(size_t)(k0 + i) * NEXP + (n - 4)]; const float h = bf2f(f2bf(f)); hv[i] = part ? (f - h) : h; }
#pragma unroll
                for (int i = 0; i < 4; ++i) w[i] = pk2(hv[2 * i], hv[2 * i + 1]);
            }
            *(GAS v4u*)(WR + (size_t)(part * 64 + n) * D + k0) = (v4u){w[0], w[1], w[2], w[3]};
        }
        const float* log_dt = KIN(14); const float* a_re = KIN(7); const float* a_im = KIN(8); const float* sb_re = KIN(9); const float* sb_im = KIN(10);
        float* Ere = WSP(float, WS_ETAB); float* Eim = Ere + NG * LC * NP * 16;
        for (int idx = gt; idx < NG * LC * NP; idx += NGT) {
            const int p = idx % NP, j = (idx / NP) % LC, g = idx / (NP * LC);
            const float dt = expf(log_dt[g]), lr = a_re[g * NP + p], li = a_im[g * NP + p];
            float ar, ai; abar_pow(lr, li, dt, 1.0f, ar, ai);
            const float den = lr * lr + li * li, nr = ar - 1.0f;
            const float fre = (nr * lr + ai * li) / den, fim = (ai * lr - nr * li) / den;
            float pr, pi; abar_pow(lr, li, dt, (float)j, pr, pi);
            const float gr = pr * fre - pi * fim, gi = pr * fim + pi * fre;
            const float* br = sb_re + (size_t)(g * NP + p) * 16; const float* bi = sb_im + (size_t)(g * NP + p) * 16;
            float* er = Ere + (size_t)((g * LC + j) * NP + p) * 16; float* ei = Eim + (size_t)((g * LC + j) * NP + p) * 16;
#pragma unroll
            for (int ci = 0; ci < 16; ++ci) { er[ci] = gr * br[ci] - gi * bi[ci]; ei[ci] = gr * bi[ci] + gi * br[ci]; }
        }
        {
            const float* cvec = KIN(1); const float* w_ada = KIN(2); const float* b_ada = KIN(3); float* MOD = WSP(float, WS_MOD);
            __syncthreads();
            LAS float* cs = (LAS float*)(L + RING_OFF);
            LAS float* red = (LAS float*)(L + RING_OFF + 32768);
            bool loaded = false;
            for (int it = vcu; it < 6 * D / 32; it += G) {
                if (!loaded) { __syncthreads(); for (int i = tid; i < NB * D; i += NWAVES * 64) { const float c = cvec[i]; cs[i] = c / (1.0f + expf(-c)); } __syncthreads(); loaded = true; }
                const int col = it * 32 + (lane & 31), ksub = (lane >> 5) + 2 * wave;
                float accb[NB];
#pragma unroll
                for (int b = 0; b < NB; ++b) accb[b] = 0.f;
#pragma unroll 8
                for (int i = 0; i < 64; ++i) { const int k = ksub + 16 * i; const float w = w_ada[(size_t)k * (6 * D) + col];
#pragma unroll
                    for (int b = 0; b < NB; ++b) accb[b] += cs[b * D + k] * w; }
#pragma unroll
                for (int b = 0; b < NB; ++b) red[(ksub * NB + b) * 32 + (lane & 31)] = accb[b];
                __syncthreads();
                if (tid < NB * 32) { const int b = tid >> 5, c = tid & 31; float s = 0.f;
#pragma unroll
                    for (int q = 0; q < 16; ++q) s += red[(q * NB + b) * 32 + c];
                    MOD[(size_t)b * 6 * D + it * 32 + c] = s + b_ada[it * 32 + c]; }
                __syncthreads();
            }
            __syncthreads();
        }
    }
    GRID_BAR();
#endif

#if DBG_STAGE != 1
    asm volatile("; PHASE_MARK P0b" ::: "memory");
    {
        PHASE_IDS();
        const float* x = KIN(0); const float* g_mix = KIN(4); const float* MOD = WSP(float, WS_MOD); bf16* UBUF = (bf16*)OUTP();
        const float* Ere = WSP(float, WS_ETAB); const float* Eim = Ere + NG * LC * NP * 16; bf16* BtY = WSP(bf16, WS_BTY); bf16* BtP = WSP(bf16, WS_BTP);
        const float* sc_re = KIN(11); const float* sc_im = KIN(12); const float* log_dt = KIN(14); const float* a_re = KIN(7); const float* a_im = KIN(8);
        for (int blk = gw; blk < T / 16; blk += NGW) {
            const int row0 = blk * 16, b = row0 / SEQ; const float* md = MOD + (size_t)b * 6 * D;
            f32x4 av[4], sv[4];
#pragma unroll
            for (int j = 0; j < 4; ++j) { const int c = 4 * lane + 256 * j; const f32x4 g = *(const f32x4*)(g_mix + c), sc = *(const f32x4*)(md + D + c); av[j] = g * (sc + 1.0f); sv[j] = *(const f32x4*)(md + c); }
            for (int r = 0; r < 16; ++r) {
                const float* xr = x + (size_t)(row0 + r) * D; f32x4 v[4]; float ss = 0.f;
#pragma unroll
                for (int j = 0; j < 4; ++j) { v[j] = *(const f32x4*)(xr + 4 * lane + 256 * j); ss += (v[j][0] * v[j][0] + v[j][1] * v[j][1]) + (v[j][2] * v[j][2] + v[j][3] * v[j][3]); }
                const float rstd = 1.0f / sqrtf(wave_sum(ss, lane) * (1.0f / D) + EPS);
                bf16* ur = UBUF + (size_t)(row0 + r) * D;
#pragma unroll
                for (int j = 0; j < 4; ++j) { const f32x4 o = v[j] * rstd * av[j] + sv[j]; *(GAS v2u*)(ur + 4 * lane + 256 * j) = (v2u){pk2(o[0], o[1]), pk2(o[2], o[3])}; }
            }
        }
        for (int idx = gt; idx < NG * LC * 16 * 2; idx += NGT) {
            const int cih = idx & 1, co = (idx >> 1) & 15, j = (idx >> 5) % LC, g = idx / (32 * LC);
            float kv[8];
#pragma unroll
            for (int i = 0; i < 8; ++i) kv[i] = 0.f;
            const float* er = Ere + (size_t)((g * LC + j) * NP) * 16 + cih * 8; const float* ei = Eim + (size_t)((g * LC + j) * NP) * 16 + cih * 8;
            const float* cr = sc_re + (size_t)(g * 16 + co) * NP; const float* ci_ = sc_im + (size_t)(g * 16 + co) * NP;
            for (int p = 0; p < NP; ++p) { const float c_r = cr[p], c_i = ci_[p]; const f32x4 e0 = *(const f32x4*)(er + p * 16), e1 = *(const f32x4*)(er + p * 16 + 4), f0 = *(const f32x4*)(ei + p * 16), f1 = *(const f32x4*)(ei + p * 16 + 4);
#pragma unroll
                for (int i = 0; i < 4; ++i) { kv[i] += c_r * e0[i] - c_i * f0[i]; kv[4 + i] += c_r * e1[i] - c_i * f1[i]; } }
            const v4u kw = (v4u){pk2(kv[0], kv[1]), pk2(kv[2], kv[3]), pk2(kv[4], kv[5]), pk2(kv[6], kv[7])};
            bf16* base = BtY + (size_t)g * 512 * KY;
            for (int t = j; t < LC; ++t) *(GAS v4u*)(base + (size_t)(t * 16 + co) * KY + (t - j) * 16 + cih * 8) = kw;
            if (j >= 1) for (int t = 0; t + j < LC; ++t) *(GAS v4u*)(base + (size_t)(t * 16 + co) * KY + (t + j) * 16 + cih * 8) = (v4u){0u, 0u, 0u, 0u};
        }
        for (int idx = gt; idx < NG * LC * NP; idx += NGT) {
            const int p = idx % NP, t = (idx / NP) % LC, g = idx / (NP * LC);
            const float dt = expf(log_dt[g]); float ar, ai; abar_pow(a_re[g * NP + p], a_im[g * NP + p], dt, (float)(t + 1), ar, ai);
#pragma unroll
            for (int co = 0; co < 16; ++co) { const float c_r = sc_re[(size_t)(g * 16 + co) * NP + p], c_i = sc_im[(size_t)(g * 16 + co) * NP + p];
                bf16* rowp = BtY + (size_t)(g * 512 + t * 16 + co) * KY;
                rowp[512 + p] = (bf16)f2bf(c_r * ar - c_i * ai); rowp[576 + p] = (bf16)f2bf(-(c_r * ai + c_i * ar)); }
        }
        for (int idx = gt; idx < NG * 128 * LC; idx += NGT) {
            const int s = idx % LC, nn = (idx / LC) % 128, g = idx / (LC * 128); const int p = nn & 63, im = nn >> 6;
            const float* src = (im ? Eim : Ere) + (size_t)((g * LC + (LC - 1 - s)) * NP + p) * 16;
            unsigned hw[8], lw[8];
#pragma unroll
            for (int i = 0; i < 8; ++i) { const float f0 = src[2 * i], f1 = src[2 * i + 1]; const unsigned h0 = f2bf(f0), h1 = f2bf(f1); hw[i] = h0 | (h1 << 16); lw[i] = pk2(f0 - bf2f(h0), f1 - bf2f(h1)); }
            bf16* d0 = BtP + (size_t)(g * 256 + nn) * KS + s * 16; bf16* d1 = BtP + (size_t)(g * 256 + 128 + nn) * KS + s * 16;
            *(GAS v4u*)d0 = (v4u){hw[0], hw[1], hw[2], hw[3]}; *(GAS v4u*)(d0 + 8) = (v4u){hw[4], hw[5], hw[6], hw[7]};
            *(GAS v4u*)d1 = (v4u){lw[0], lw[1], lw[2], lw[3]}; *(GAS v4u*)(d1 + 8) = (v4u){lw[4], lw[5], lw[6], lw[7]};
        }
    }
    GRID_BAR();

    asm volatile("; PHASE_MARK P1" ::: "memory");
    {
        PHASE_IDS();
        pg8::StaticOrder S; S.init(OUTP(), D, WSP(bf16, WS_WIN), D, T, INW, G, bx);
        pg8::EpiProj E{KIN(6), WSP(bf16, WS_UG), WSP(bf16, WS_Q), WSP(bf16, WS_K), WSP(bf16, WS_V), WSP(bf16, WS_GATES), attn_body::C2};
        pg8::gemm_phase<pg8::EpiProj, pg8::StaticOrder, true, true>(L + RING_OFF, D, D, D, S, E);
    }
    GRID_BAR();

    asm volatile("; PHASE_MARK P2" ::: "memory");
    {
        PHASE_IDS();
        pg8::GroupOrder S; S.init(WSP(bf16, WS_UG), KY, (size_t)NRC * KY * 2, WSP(bf16, WS_BTP), KS, (size_t)256 * KS * 2, NRC, 256, NG, G, bx);
        pg8::EpiStates E{WSP(float, WS_SLOC)};
        pg8::gemm_phase<pg8::EpiStates, pg8::GroupOrder, true, true>(L + RING_OFF, KS, KY, KS, S, E);
    }
    GRID_BAR();

    asm volatile("; PHASE_MARK P3" ::: "memory");
    {
        PHASE_IDS();
        const float* log_dt = KIN(14); const float* a_re = KIN(7); const float* a_im = KIN(8); const float* SLOC = WSP(float, WS_SLOC); bf16* UG = WSP(bf16, WS_UG);
        LAS float* seg = (LAS float*)(L + RING_OFF);
        for (int bg = vcu; bg < NB * NG; bg += G) {
            const int b = bg / NG, g = bg % NG, p = lane;
            const float dt = expf(log_dt[g]), lr = a_re[g * NP + p], li = a_im[g * NP + p];
            float alr, ali; abar_pow(lr, li, dt, (float)LC, alr, ali);
            constexpr int SEGC = NCH / NWAVES;
            float locr[SEGC], loci[SEGC]; float cr = 0.f, ci = 0.f;
            const float* sp = SLOC + ((size_t)(g * NRC + b * NCH + wave * SEGC)) * 128;
#pragma unroll
            for (int k = 0; k < SEGC; ++k) { locr[k] = cr; loci[k] = ci; const float sr = sp[k * 128 + p], si = sp[k * 128 + 64 + p]; const float nr = alr * cr - ali * ci + sr, ni = alr * ci + ali * cr + si; cr = nr; ci = ni; }
            __syncthreads();
            seg[(wave * 64 + p) * 2] = cr; seg[(wave * 64 + p) * 2 + 1] = ci;
            __syncthreads();
            float a16r = alr, a16i = ali;
#pragma unroll
            for (int q = 0; q < 4; ++q) { const float nr = a16r * a16r - a16i * a16i, ni = 2.f * a16r * a16i; a16r = nr; a16i = ni; }
            float inr = 0.f, ini = 0.f;
            for (int w = 0; w < wave; ++w) { const float er = seg[(w * 64 + p) * 2], ei = seg[(w * 64 + p) * 2 + 1]; const float nr = a16r * inr - a16i * ini + er, ni = a16r * ini + a16i * inr + ei; inr = nr; ini = ni; }
            bf16* up = UG + ((size_t)(g * NRC + b * NCH + wave * SEGC)) * KY + KS;
#pragma unroll
            for (int k = 0; k < SEGC; ++k) { up[(size_t)k * KY + p] = (bf16)f2bf(inr + locr[k]); up[(size_t)k * KY + 64 + p] = (bf16)f2bf(ini + loci[k]); const float nr = alr * inr - ali * ini, ni = alr * ini + ali * inr; inr = nr; ini = ni; }
        }
        __syncthreads();
        const char* wsb = (const char*)karg(35);
        const float* lq1 = KIN(17); const float* lk1 = KIN(18); const float* lq2 = KIN(19); const float* lk2 = KIN(20); const float* g_subln = KIN(21);
        const float lam = expf(wave_sum(lq1[lane] * lk1[lane], lane)) - expf(wave_sum(lq2[lane] * lk2[lane], lane)) + LAMBDA_INIT;
        LAS float* gsl = (LAS float*)(L + GS_OFF);
        if (tid < 128) gsl[tid] = g_subln[tid] * (1.0f - LAMBDA_INIT);
        __syncthreads();
        for (int un = vcu; un < NB * 8 * 4; un += G) {
            const int s4 = un & 3, h = (un >> 2) & 7, b = un >> 5;
#pragma unroll 1
            for (int i = 0; i < 4; ++i) { const int qb = (i == 0) ? 15 - s4 : (i == 1) ? 8 + s4 : (i == 2) ? 7 - s4 : s4;
                attn_body::attn_unit<8, WS_Q, WS_K, WS_V, GS_OFF - RING_OFF>(b, h, qb, wsb, (attn_body::bf16*)OUTP(), lam, (char*)lds + RING_OFF); }
        }
    }
    GRID_BAR();

    asm volatile("; PHASE_MARK P4" ::: "memory");
    {
        PHASE_IDS();
        pg8::GroupOrder S; S.init(WSP(bf16, WS_UG), KY, (size_t)NRC * KY * 2, WSP(bf16, WS_BTY), KY, (size_t)512 * KY * 2, NRC, 512, NG, G, bx);
        pg8::EpiY E{WSP(bf16, WS_UG), KIN(13), WSP(bf16, WS_YACT)};
        pg8::gemm_phase<pg8::EpiY, pg8::GroupOrder, true, true>(L + RING_OFF, KY, KY, KY, S, E);
    }
    GRID_BAR();

    asm volatile("; PHASE_MARK P5" ::: "memory");
    {
        PHASE_IDS();
        pg8::StaticOrder S; S.init(WSP(bf16, WS_YACT), S5W, WSP(bf16, WS_WGLU), S5W, T, S5W, G, bx);
        pg8::EpiGlu E{WSP(bf16, WS_YACT), KIN(16), WSP(bf16, WS_S5O)};
        pg8::gemm_phase<pg8::EpiGlu, pg8::StaticOrder, true, true>(L + RING_OFF, S5W, S5W, S5W, S, E);
    }
    GRID_BAR();

    asm volatile("; PHASE_MARK P6" ::: "memory");
    {
        PHASE_IDS();
        pg8::StaticOrder S; S.init(WSP(bf16, WS_S5O), S5W, WSP(bf16, WS_WSSM), S5W, T, D, G, bx);
        pg8::EpiBranch<0> E{WSP(bf16, WS_GATES), nullptr, WSP(bf16, WS_TMP)};
        pg8::gemm_phase<pg8::EpiBranch<0>, pg8::StaticOrder, true, true>(L + RING_OFF, S5W, S5W, S5W, S, E);
    }
    VM_WAIT(); __syncthreads();
    {
        PHASE_IDS();
        pg8::StaticOrder S; S.init(OUTP(), D, WSP(bf16, WS_WATT), D, T, D, G, bx);
        pg8::EpiBranch<1> E{WSP(bf16, WS_GATES), WSP(bf16, WS_TMP), (bf16*)OUTP() + (size_t)T * D};
        pg8::gemm_phase<pg8::EpiBranch<1>, pg8::StaticOrder, true, true>(L + RING_OFF, D, D, D, S, E);
    }
    GRID_BAR();

    asm volatile("; PHASE_MARK P8" ::: "memory");
    {
        PHASE_IDS();
        pg8::StaticOrder S; S.init((bf16*)OUTP() + (size_t)T * D, D, WSP(bf16, WS_WOUT), D, T, D, G, bx);
        pg8::EpiOut E{KIN(0), WSP(float, WS_MOD), WSP(bf16, WS_H)};
        pg8::gemm_phase<pg8::EpiOut, pg8::StaticOrder, true, true>(L + RING_OFF, D, D, D, S, E);
    }
    GRID_BAR();
#endif

#if DBG_STAGE == 0
    asm volatile("; PHASE_MARK P9" ::: "memory");
    {
        PHASE_IDS();
        const float* g_ffn = KIN(25); const float* MOD = WSP(float, WS_MOD); const bf16* Hbuf = WSP(bf16, WS_H); bf16* U2 = (bf16*)OUTP();
        const bf16* WRh = WSP(bf16, WS_WR); const bf16* WRl = WRh + 64 * D;
        const float* b_rg = KIN(27); const float* b_re = KIN(29); int* CNT = WSP(int, WS_CTL) + CW_CNT; int* LIST = WSP(int, WS_LIST); float* CWL = WSP(float, WS_CWL);
        constexpr int APITCH = 1032;
        LAS bf16* AH = (LAS bf16*)(L + RING_OFF); LAS bf16* AL = AH + 16 * APITCH;
        LAS float* PART = (LAS float*)(L + RING_OFF + 2 * 16 * APITCH * 2);
        LAS float* LG = PART + 8 * 256;
        LAS int* lcnt = (LAS int*)(LG + 16 * 64); LAS int* lbase = lcnt + NEXP; LAS int* TOK = lbase + NEXP;
        const int per = T / G, t0 = bx * per, b = t0 / SEQ;
        const float* md = MOD + (size_t)b * 6 * D;
        f32x4 av[4], sv[4];
#pragma unroll
        for (int j = 0; j < 4; ++j) { const int c = 4 * lane + 256 * j; const f32x4 g = *(const f32x4*)(g_ffn + c), sc = *(const f32x4*)(md + 4 * D + c); av[j] = g * (sc + 1.0f); sv[j] = *(const f32x4*)(md + 3 * D + c); }
        const int cb = wave & 3, kh = wave >> 2, fr = lane & 15, fq = lane >> 4;
        pg8::bf16x8 bh[16], bl[16];
#pragma unroll
        for (int ks = 0; ks < 16; ++ks) { const size_t o = (size_t)(cb * 16 + fr) * D + kh * 512 + ks * 32 + fq * 8; bh[ks] = *(const pg8::bf16x8*)(WRh + o); bl[ks] = *(const pg8::bf16x8*)(WRl + o); }
        if (tid < NEXP) lcnt[tid] = 0;
        for (int c = 0; c < per / 16; ++c) {
#pragma unroll
            for (int rr = 0; rr < 2; ++rr) {
                const int r = 2 * wave + rr, tok = t0 + c * 16 + r;
                const bf16* hr = Hbuf + (size_t)tok * D; f32x4 v[4]; float ss = 0.f;
#pragma unroll
                for (int j = 0; j < 4; ++j) { const v2u hw = *(const GAS v2u*)(hr + 4 * lane + 256 * j); v[j] = (f32x4){pg8::bf_lo(hw.x), pg8::bf_hi(hw.x), pg8::bf_lo(hw.y), pg8::bf_hi(hw.y)}; ss += (v[j][0] * v[j][0] + v[j][1] * v[j][1]) + (v[j][2] * v[j][2] + v[j][3] * v[j][3]); }
                const float rstd = 1.0f / sqrtf(wave_sum(ss, lane) * (1.0f / D) + EPS);
                bf16* ur = U2 + (size_t)tok * D;
#pragma unroll
                for (int j = 0; j < 4; ++j) { const f32x4 o = v[j] * rstd * av[j] + sv[j];
                    const unsigned h0 = f2bf(o[0]), h1 = f2bf(o[1]), h2 = f2bf(o[2]), h3 = f2bf(o[3]);
                    const v2u hv = (v2u){h0 | (h1 << 16), h2 | (h3 << 16)}, lv = (v2u){pk2(o[0] - bf2f(h0), o[1] - bf2f(h1)), pk2(o[2] - bf2f(h2), o[3] - bf2f(h3))};
                    *(GAS v2u*)(ur + 4 * lane + 256 * j) = hv;
                    *(LAS v2u*)(AH + r * APITCH + 4 * lane + 256 * j) = hv; *(LAS v2u*)(AL + r * APITCH + 4 * lane + 256 * j) = lv; }
            }
            __syncthreads();
            { pg8::f32x4 acc = (pg8::f32x4){0.f, 0.f, 0.f, 0.f};
#pragma unroll
              for (int ks = 0; ks < 16; ++ks) { const int ko = fr * APITCH + kh * 512 + ks * 32 + fq * 8;
                  const pg8::bf16x8 ah = *(const LAS pg8::bf16x8*)(AH + ko), al = *(const LAS pg8::bf16x8*)(AL + ko);
                  acc = __builtin_amdgcn_mfma_f32_16x16x32_bf16(ah, bh[ks], acc, 0, 0, 0);
                  acc = __builtin_amdgcn_mfma_f32_16x16x32_bf16(al, bh[ks], acc, 0, 0, 0);
                  acc = __builtin_amdgcn_mfma_f32_16x16x32_bf16(ah, bl[ks], acc, 0, 0, 0); }
#pragma unroll
              for (int i = 0; i < 4; ++i) PART[wave * 256 + (fq * 4 + i) * 16 + fr] = acc[i]; }
            __syncthreads();
#pragma unroll
            for (int i = 0; i < 2; ++i) { const int o = tid * 2 + i, row = o >> 6, col = o & 63, cbb = col >> 4; LG[o] = PART[cbb * 256 + row * 16 + (col & 15)] + PART[(4 + cbb) * 256 + row * 16 + (col & 15)]; }
            __syncthreads();
            if (tid < 16) {
                const LAS float* lg = LG + tid * 64;
                float gl[4]; int gi = 0;
#pragma unroll
                for (int i = 0; i < 4; ++i) gl[i] = lg[i] + b_rg[i];
#pragma unroll
                for (int i = 1; i < 4; ++i) if (gl[i] > gl[gi]) gi = i;
                float gsum = 0.f;
#pragma unroll
                for (int i = 0; i < 4; ++i) gsum += expf(gl[i] - gl[gi]);
                const float gp = 1.0f / gsum;
                float el[8];
#pragma unroll
                for (int i = 0; i < 8; ++i) el[i] = lg[4 + gi * 8 + i] + b_re[gi * 8 + i];
                int i0 = 0;
#pragma unroll
                for (int i = 1; i < 8; ++i) if (el[i] > el[i0]) i0 = i;
                int i1 = (i0 == 0) ? 1 : 0;
#pragma unroll
                for (int i = 0; i < 8; ++i) if (i != i0 && el[i] > el[i1]) i1 = i;
                const float ex = expf(el[i1] - el[i0]);
                const float w0 = gp / (1.0f + ex), w1 = gp * ex / (1.0f + ex);
                const int e0 = gi * 8 + i0, e1 = gi * 8 + i1;
                const int p0 = atomicAdd((int*)(lds + ((char*)&lcnt[e0] - (char*)L)), 1), p1 = atomicAdd((int*)(lds + ((char*)&lcnt[e1] - (char*)L)), 1);
                LAS int* tk = TOK + (c * 16 + tid) * 6; tk[0] = e0; tk[1] = p0; tk[2] = __float_as_int(w0); tk[3] = e1; tk[4] = p1; tk[5] = __float_as_int(w1);
            }
        }
        __syncthreads();
        if (tid < NEXP) lbase[tid] = atomicAdd(&CNT[tid], lcnt[tid]);
        __syncthreads();
        if (tid < per) { const LAS int* tk = TOK + tid * 6; const int tok = t0 + tid;
            const size_t i0 = (size_t)tk[0] * T + lbase[tk[0]] + tk[1], i1 = (size_t)tk[3] * T + lbase[tk[3]] + tk[4];
            LIST[i0] = tok * 2; CWL[i0] = __int_as_float(tk[2]); LIST[i1] = tok * 2 + 1; CWL[i1] = __int_as_float(tk[5]); }
        __syncthreads();
    }
    GRID_BAR();

    asm volatile("; PHASE_MARK P13" ::: "memory");
    {
        PHASE_IDS();
        const int* CNT = WSP(int, WS_CTL) + CW_CNT; const int* LIST = WSP(int, WS_LIST);
        build_expert_table(L, CNT, tid);
        pg8::ExpertOrder S; S.init((const LAS int*)(L + ETAB_OFF), OUTP(), 0, WSP(bf16, WS_WE1), D, (size_t)512 * D * 2, 512, G, bx);
        LAS int* rowtab = (LAS int*)(L + ROWTAB_OFF);
        { pg8::Unit u;
#pragma unroll 1
          for (int i = 0; i < 4 && S.next(i, u); ++i) { const int n = CNT[u.g];
              for (int r = tid; r < 256; r += NWAVES * 64) { const int pos = u.lt * 256 + r; rowtab[i * 256 + r] = (pos < n) ? (LIST[(size_t)u.g * T + pos] >> 1) : 0; } }
          __syncthreads(); }
        pg8::EpiExp1 E{WSP(bf16, WS_HDN)};
        pg8::gemm_phase<pg8::EpiExp1, pg8::ExpertOrder, true, true, true>(L + RING_OFF, D, D, D, S, E, (const LAS int*)rowtab);
    }
    GRID_BAR();

    asm volatile("; PHASE_MARK P14" ::: "memory");
    {
        PHASE_IDS();
        build_expert_table(L, WSP(int, WS_CTL) + CW_CNT, tid);
        pg8::ExpertOrder S; S.init((const LAS int*)(L + ETAB_OFF), WSP(bf16, WS_HDN), (size_t)256 * DEXP * 2, WSP(bf16, WS_WE2), DEXP, (size_t)D * DEXP * 2, D, G, bx);
        pg8::EpiExp2 E{WSP(int, WS_LIST), WSP(float, WS_CWL), WSP(int, WS_CTL) + CW_CNT, WSP(bf16, WS_SLOTS)};
        pg8::gemm_phase<pg8::EpiExp2, pg8::ExpertOrder, true, true>(L + RING_OFF, DEXP, DEXP, DEXP, S, E);
    }
    GRID_BAR();
#endif

    asm volatile("; PHASE_MARK P15" ::: "memory");
    {
        PHASE_IDS();
        const float* x = KIN(0); const float* g_final = KIN(33); const bf16* Hbuf = WSP(bf16, WS_H); const float* MOD = WSP(float, WS_MOD); const bf16* SLOTS = WSP(bf16, WS_SLOTS); float* out = OUTP();
        (void)x; (void)Hbuf; (void)MOD; (void)SLOTS;
        for (int row = gw; row < T; row += NGW) {
            const int b = row / SEQ; f32x4 v[4]; float ss = 0.f;
#pragma unroll
            for (int j = 0; j < 4; ++j) { const int c = 4 * lane + 256 * j;
#if DBG_STAGE == 1
                v[j] = *(const f32x4*)(x + (size_t)row * D + c);
#else
                { const v2u hw = *(const GAS v2u*)(Hbuf + (size_t)row * D + c); v[j] = (f32x4){pg8::bf_lo(hw.x), pg8::bf_hi(hw.x), pg8::bf_lo(hw.y), pg8::bf_hi(hw.y)}; }
#endif
#if DBG_STAGE == 0
                const f32x4 gt = *(const f32x4*)(MOD + (size_t)b * 6 * D + 5 * D + c);
                const v2u s0 = *(const GAS v2u*)(SLOTS + (size_t)(2 * row) * D + c), s1 = *(const GAS v2u*)(SLOTS + (size_t)(2 * row + 1) * D + c);
                const f32x4 f = (f32x4){pg8::bf_lo(s0.x) + pg8::bf_lo(s1.x), pg8::bf_hi(s0.x) + pg8::bf_hi(s1.x), pg8::bf_lo(s0.y) + pg8::bf_lo(s1.y), pg8::bf_hi(s0.y) + pg8::bf_hi(s1.y)};
                v[j] = v[j] + gt * f;
#endif
                ss += (v[j][0] * v[j][0] + v[j][1] * v[j][1]) + (v[j][2] * v[j][2] + v[j][3] * v[j][3]); }
            (void)b;
            const float rstd = 1.0f / sqrtf(wave_sum(ss, lane) * (1.0f / D) + EPS);
#pragma unroll
            for (int j = 0; j < 4; ++j) { const int c = 4 * lane + 256 * j; const f32x4 g = *(const f32x4*)(g_final + c); *(f32x4*)(out + (size_t)row * D + c) = v[j] * rstd * g; }
        }
    }
}

extern "C" void kernel_launch(void* const* d_in, const int* in_sizes, int n_in, void* d_out, int out_size, void* d_ws, size_t ws_size, hipStream_t stream) {
    static int grid = 0;
    if (grid == 0) {
        if (n_in != 34 || out_size != T * D || ws_size < WS_END) { fprintf(stderr, "kernel_launch: unexpected shapes (n_in %d, out %d, ws %zu)\n", n_in, out_size, ws_size); grid = -1; return; }
        int dev = 0, cus = 0, per_cu = 0;
        if (hipGetDevice(&dev) != hipSuccess || hipDeviceGetAttribute(&cus, hipDeviceAttributeMultiprocessorCount, dev) != hipSuccess) { grid = -1; return; }
        if (hipFuncSetAttribute((const void*)fwd_kernel, hipFuncAttributeMaxDynamicSharedMemorySize, LDS_BYTES) != hipSuccess) { fprintf(stderr, "kernel_launch: hipFuncSetAttribute failed\n"); grid = -1; return; }
        if (hipOccupancyMaxActiveBlocksPerMultiprocessor(&per_cu, (const void*)fwd_kernel, NWAVES * 64, LDS_BYTES) != hipSuccess || per_cu < 1)
            fprintf(stderr, "kernel_launch: note: occupancy query reports %d workgroups per CU\n", per_cu);
        (void)hipGetLastError();
        grid = cus;
    }
    if (grid < 0) return;
    if (hipMemsetAsync((char*)d_ws + WS_CTL, 0, CTL_ZERO_BYTES, stream) != hipSuccess) { fprintf(stderr, "kernel_launch: memset failed\n"); return; }
    Args a{};
    for (int i = 0; i < 34; ++i) a.in[i] = (const float*)d_in[i];
    a.out = (float*)d_out; a.ws = (unsigned char*)d_ws;
    hipLaunchKernelGGL(fwd_kernel, dim3(grid), dim3(NWAVES * 64), LDS_BYTES, stream, a);
    const hipError_t le = hipPeekAtLastError();
    if (le != hipSuccess) fprintf(stderr, "kernel_launch: launch failed: %s\n", hipGetErrorName(le));
}
```

```cpp
#include <hip/hip_runtime.h>
#include <hip/hip_bf16.h>
#include <cstdio>
#include <cstdint>
#include <cmath>

#ifndef DBG_STAGE
#define DBG_STAGE 0
#endif

constexpr int D = 1024, NB = 8, SEQ = 4096, T = NB * SEQ;
constexpr int S5W = 512, NG = 32, NP = 64, INW = 5632;
constexpr int LC = 32, NCH = SEQ / LC, NRC = T / LC, KS = LC * 16, KY = KS + 128;
constexpr int NEXP = 32, DEXP = 256;
constexpr int XS_ROWS = 2 * T + NEXP * 256;
constexpr float EPS = 1e-6f;
constexpr float LAMBDA_INIT = 0.2f;

namespace pg8 {
#define PG8_LAS __attribute__((address_space(3)))
typedef unsigned short bf16_t;
typedef short bf16x8 __attribute__((ext_vector_type(8)));
typedef float f32x4 __attribute__((ext_vector_type(4)));
typedef unsigned u32x4 __attribute__((ext_vector_type(4)));
typedef float f32x2 __attribute__((ext_vector_type(2)));
constexpr int BM = 256, BK = 64, HALF = 128, HTB = HALF * BK * 2, STAGE_BYTES = 8 * HTB, NXCD = 8, WGM = 8;

__host__ __device__ __forceinline__ int lds_byte(int r, int c) { const int st = (r >> 4) * 2 + (c >> 5), rr = r & 15, cc = c & 31, ob = rr * 64 + cc * 2; return st * 1024 + (ob ^ (((ob >> 9) & 1) << 5)); }
__host__ __device__ __forceinline__ void stage_rc(int b, int& R, int& C) { const int st = b / 1024, sb = b % 1024, swz = sb ^ (((sb >> 9) & 1) << 5); R = (st >> 1) * 16 + swz / 64; C = (st & 1) * 32 + (swz % 64) / 2; }
__host__ __device__ __forceinline__ int perm32(int rho) { const int n = rho >> 4, i = rho & 15; return 8 * (i >> 2) + 4 * n + (i & 3); }

struct Unit { int pm, pn, g, lt; const char* a; const char* b; };

struct StaticOrder {
    int nM, nN, nwg, G, c; const char* A; const char* B; size_t tsa, tsb;
    __device__ void init(const void* A_, int lda, const void* B_, int ldb, int M, int N, int G_, int c_) { nM = M / BM; nN = N / BM; nwg = nM * nN; G = G_; c = c_; A = (const char*)A_; B = (const char*)B_; tsa = (size_t)BM * lda * 2; tsb = (size_t)BM * ldb * 2; }
    __device__ bool next(int i, Unit& u) const {
        const long L = (long)i * G + c; if (L >= nwg) return false;
        int wgid = (int)L; { const int q = nwg / NXCD, r = nwg % NXCD, xcd = wgid % NXCD, off = wgid / NXCD; wgid = (xcd < r ? xcd * (q + 1) : r * (q + 1) + (xcd - r) * q) + off; }
        const int nig = WGM * nN, gid = wgid / nig, fm = gid * WGM, gsz = (nM - fm) < WGM ? (nM - fm) : WGM;
        u.pm = fm + ((wgid % nig) % gsz); u.pn = (wgid % nig) / gsz; u.g = 0; u.lt = 0; u.a = A + (size_t)u.pm * tsa; u.b = B + (size_t)u.pn * tsb; return true;
    }
};
struct GroupOrder {
    int nM, nN, ng, G, c; const char* A; const char* B; size_t tsa, tsb, gsa, gsb;
    __device__ void init(const void* A_, int lda, size_t gsa_, const void* B_, int ldb, size_t gsb_, int Mg, int Ng, int ng_, int G_, int c_) {
        nM = Mg / BM; nN = Ng / BM; ng = ng_; G = G_; c = c_; A = (const char*)A_; B = (const char*)B_; tsa = (size_t)BM * lda * 2; tsb = (size_t)BM * ldb * 2; gsa = gsa_; gsb = gsb_; }
    __device__ bool next(int i, Unit& u) const {
        const int per = nM * nN, x = c % NXCD, j = c / NXCD + (G / NXCD) * i; if (j >= (ng / NXCD) * per) return false;
        const int g = x + NXCD * (j / per), r = j % per;
        u.g = g; u.lt = 0; u.pm = r / nN; u.pn = r % nN; u.a = A + (size_t)g * gsa + (size_t)u.pm * tsa; u.b = B + (size_t)g * gsb + (size_t)u.pn * tsb; return true;
    }
};
struct ExpertOrder {
    const PG8_LAS int* tab; int nN, G, c; const char* A; const char* B; size_t tsa, tsb, esb;
    __device__ void init(const PG8_LAS int* tab_, const void* A_, size_t tsa_, const void* B_, int ldb, size_t esb_, int N, int G_, int c_) {
        tab = tab_; nN = N / BM; G = G_; c = c_; A = (const char*)A_; B = (const char*)B_; tsa = tsa_; tsb = (size_t)BM * ldb * 2; esb = esb_; }
    __device__ bool next(int i, Unit& u) const {
        const int NT = __builtin_amdgcn_readfirstlane(tab[XS_ROWS / 256 + 1]);
        const int x = c % NXCD, j = c / NXCD + (G / NXCD) * i, lo = (x * NT) / NXCD, hi = ((x + 1) * NT) / NXCD;
        const int rt = lo + j / nN, pn = j % nN;
        if (rt >= hi) return false;
        const int e = __builtin_amdgcn_readfirstlane(tab[rt]);
        u.g = e & 255; u.lt = e >> 8; u.pm = rt; u.pn = pn; u.a = A + (size_t)rt * tsa; u.b = B + (size_t)u.g * esb + (size_t)pn * tsb; return true;
    }
};

__device__ __forceinline__ unsigned cvt_pk_bf16(float lo, float hi) { unsigned r; asm volatile("v_cvt_pk_bf16_f32 %0, %1, %2" : "=v"(r) : "v"(lo), "v"(hi)); return r; }
__device__ __forceinline__ float bf_lo(unsigned w) { return __uint_as_float(w << 16); }
__device__ __forceinline__ float bf_hi(unsigned w) { return __uint_as_float(w & 0xffff0000u); }
__device__ __forceinline__ float sigmoidf_(float x) { return __builtin_amdgcn_rcpf(1.0f + __builtin_amdgcn_exp2f(-1.4426950408889634f * x)); }
__device__ __forceinline__ void unpack8(const u32x4 w, float (&f)[8]) { f[0] = bf_lo(w.x); f[1] = bf_hi(w.x); f[2] = bf_lo(w.y); f[3] = bf_hi(w.y); f[4] = bf_lo(w.z); f[5] = bf_hi(w.z); f[6] = bf_lo(w.w); f[7] = bf_hi(w.w); }
__device__ __forceinline__ u32x4 pack8(const float (&f)[8]) { u32x4 w; w.x = cvt_pk_bf16(f[0], f[1]); w.y = cvt_pk_bf16(f[2], f[3]); w.z = cvt_pk_bf16(f[4], f[5]); w.w = cvt_pk_bf16(f[6], f[7]); return w; }

#define EPI_LOOP_PERM(...) \
    _Pragma("unroll") for (int ai = 0; ai < 2; ++ai) _Pragma("unroll") for (int m = 0; m < 4; ++m) { const int lrow = ai * HALF + wr * 64 + m * 16 + fr; \
        _Pragma("unroll") for (int bj = 0; bj < 2; ++bj) { const int lcol = bj * HALF + wc * 32 + 8 * fq; \
            float v[8] = {acc[ai][bj][m][0][0], acc[ai][bj][m][0][1], acc[ai][bj][m][0][2], acc[ai][bj][m][0][3], acc[ai][bj][m][1][0], acc[ai][bj][m][1][1], acc[ai][bj][m][1][2], acc[ai][bj][m][1][3]}; __VA_ARGS__ } }

#define EPI_HALF_PRE(...) _Pragma("unroll") for (int m = 0; m < 4; ++m) { const int lrow = ai * HALF + wr * 64 + m * 16 + fr; (void)lrow; \
        _Pragma("unroll") for (int bj = 0; bj < 2; ++bj) { const int lcol = bj * HALF + wc * 32 + 8 * fq; (void)lcol; __VA_ARGS__ } }
#define EPI_HALF_RUN(...) _Pragma("unroll") for (int m = 0; m < 4; ++m) { const int lrow = ai * HALF + wr * 64 + m * 16 + fr; (void)lrow; \
        _Pragma("unroll") for (int bj = 0; bj < 2; ++bj) { const int lcol = bj * HALF + wc * 32 + 8 * fq; (void)lcol; \
            float v[8] = {acc[ai][bj][m][0][0], acc[ai][bj][m][0][1], acc[ai][bj][m][0][2], acc[ai][bj][m][0][3], acc[ai][bj][m][1][0], acc[ai][bj][m][1][1], acc[ai][bj][m][1][2], acc[ai][bj][m][1][3]}; __VA_ARGS__ } }

struct EpiProj {
    static constexpr bool PERM = true, AFTER_DRAIN = false;
    const float* bias; bf16_t* U; bf16_t* Q; bf16_t* Kb; bf16_t* V; bf16_t* Gt; float c2;
    __device__ __forceinline__ void operator()(const f32x4 (&acc)[2][2][4][2], const Unit& u, int wr, int wc, int fr, int fq) const {
        const int ct = u.pn;
        f32x4 bv[2][2];
#pragma unroll
        for (int bj = 0; bj < 2; ++bj) { const int col = ct * BM + bj * HALF + wc * 32 + 8 * fq; bv[bj][0] = *(const f32x4*)(bias + col); bv[bj][1] = *(const f32x4*)(bias + col + 4); }
        EPI_LOOP_PERM({
            const int row = u.pm * BM + lrow, col = ct * BM + lcol;
            v[0] += bv[bj][0][0]; v[1] += bv[bj][0][1]; v[2] += bv[bj][0][2]; v[3] += bv[bj][0][3]; v[4] += bv[bj][1][0]; v[5] += bv[bj][1][1]; v[6] += bv[bj][1][2]; v[7] += bv[bj][1][3];
            bf16_t* dst;
            if (ct < 2) { const int g = col >> 4, ci = col & 15, rc = row / LC, s = row % LC; dst = U + ((size_t)(g * NRC + rc) * KY + s * 16 + ci); }
            else if (ct < 6) { _Pragma("unroll") for (int i = 0; i < 8; ++i) v[i] *= c2; dst = Q + (size_t)row * D + (col - 512); }
            else if (ct < 10) { dst = Kb + (size_t)row * D + (col - 1536); }
            else if (ct < 14) { dst = V + (size_t)row * D + (col - 2560); }
            else { _Pragma("unroll") for (int i = 0; i < 8; ++i) v[i] = sigmoidf_(v[i]); dst = Gt + (size_t)row * 2048 + (col - 3584); }
            *(u32x4*)dst = pack8(v);
        })
    }
};
struct EpiStates {
    static constexpr bool PERM = false, AFTER_DRAIN = false;
    float* S;
    __device__ __forceinline__ void operator()(const f32x4 (&acc)[2][2][4][2], const Unit& u, int wr, int wc, int fr, int fq) const {
#pragma unroll
        for (int ai = 0; ai < 2; ++ai)
#pragma unroll
            for (int m = 0; m < 4; ++m) { const int row = u.pm * BM + ai * HALF + wr * 64 + m * 16 + fr;
#pragma unroll
                for (int n = 0; n < 2; ++n) { const f32x4 v = acc[ai][0][m][n] + acc[ai][1][m][n]; *(f32x4*)(S + ((size_t)(u.g * NRC + row) * 128 + wc * 32 + 16 * n + 4 * fq)) = v; } }
    }
};
struct EpiY {
    static constexpr bool PERM = true, AFTER_DRAIN = false;
    const bf16_t* U; const float* dskip; bf16_t* Y;
    __device__ __forceinline__ void operator()(const f32x4 (&acc)[2][2][4][2], const Unit& u, int wr, int wc, int fr, int fq) const {
        f32x4 dk[2][2];
#pragma unroll
        for (int bj = 0; bj < 2; ++bj) { const int co = (bj * HALF + wc * 32 + 8 * fq) & 15; dk[bj][0] = *(const f32x4*)(dskip + u.g * 16 + co); dk[bj][1] = *(const f32x4*)(dskip + u.g * 16 + co + 4); }
#pragma unroll
        for (int ai = 0; ai < 2; ++ai) {
            u32x4 uw[4][2];
            EPI_HALF_PRE({ const int rc = u.pm * BM + lrow, n = u.pn * BM + lcol; uw[m][bj] = *(const u32x4*)(U + ((size_t)(u.g * NRC + rc) * KY + n)); })
            EPI_HALF_RUN({
                const int rc = u.pm * BM + lrow, n = u.pn * BM + lcol, tt = n >> 4, co = n & 15;
                float uf[8]; unpack8(uw[m][bj], uf);
                const float dd[8] = {dk[bj][0][0], dk[bj][0][1], dk[bj][0][2], dk[bj][0][3], dk[bj][1][0], dk[bj][1][1], dk[bj][1][2], dk[bj][1][3]};
                _Pragma("unroll") for (int i = 0; i < 8; ++i) { const float y = v[i] + dd[i] * uf[i]; const float z = 1.5957691216057308f * (y + 0.044715f * y * y * y); v[i] = y * sigmoidf_(z); }
                *(u32x4*)(Y + ((size_t)(rc * LC + tt) * S5W + u.g * 16 + co)) = pack8(v);
            })
        }
    }
};
struct EpiGlu {
    static constexpr bool PERM = true, AFTER_DRAIN = false;
    const bf16_t* Y; const float* bias; bf16_t* O;
    __device__ __forceinline__ void operator()(const f32x4 (&acc)[2][2][4][2], const Unit& u, int wr, int wc, int fr, int fq) const {
        f32x4 bv[2][2];
#pragma unroll
        for (int bj = 0; bj < 2; ++bj) { const int col = u.pn * BM + bj * HALF + wc * 32 + 8 * fq; bv[bj][0] = *(const f32x4*)(bias + col); bv[bj][1] = *(const f32x4*)(bias + col + 4); }
#pragma unroll
        for (int ai = 0; ai < 2; ++ai) {
            u32x4 yw[4][2];
            EPI_HALF_PRE({ const int row = u.pm * BM + lrow, col = u.pn * BM + lcol; yw[m][bj] = *(const u32x4*)(Y + (size_t)row * S5W + col); })
            EPI_HALF_RUN({
                const int row = u.pm * BM + lrow, col = u.pn * BM + lcol;
                float yf[8]; unpack8(yw[m][bj], yf);
                const float bb[8] = {bv[bj][0][0], bv[bj][0][1], bv[bj][0][2], bv[bj][0][3], bv[bj][1][0], bv[bj][1][1], bv[bj][1][2], bv[bj][1][3]};
                _Pragma("unroll") for (int i = 0; i < 8; ++i) v[i] = yf[i] * sigmoidf_(v[i] + bb[i]);
                *(u32x4*)(O + (size_t)row * S5W + col) = pack8(v);
            })
        }
    }
};
template <int MODE> struct EpiBranch {
    static constexpr bool PERM = true, AFTER_DRAIN = false;
    const bf16_t* Gt; const bf16_t* Tin; bf16_t* O;
    __device__ __forceinline__ void operator()(const f32x4 (&acc)[2][2][4][2], const Unit& u, int wr, int wc, int fr, int fq) const {
#pragma unroll
        for (int ai = 0; ai < 2; ++ai) {
            u32x4 gw[4][2], tw[4][2];
            EPI_HALF_PRE({ const int row = u.pm * BM + lrow, col = u.pn * BM + lcol; gw[m][bj] = *(const u32x4*)(Gt + (size_t)row * 2048 + MODE * D + col);
                           if (MODE == 1) tw[m][bj] = *(const u32x4*)(Tin + (size_t)row * D + col); else tw[m][bj] = gw[m][bj]; })
            EPI_HALF_RUN({
                const int row = u.pm * BM + lrow, col = u.pn * BM + lcol;
                float gf[8]; unpack8(gw[m][bj], gf);
                if (MODE == 1) { float tf[8]; unpack8(tw[m][bj], tf);
                    _Pragma("unroll") for (int i = 0; i < 8; ++i) v[i] = tf[i] + gf[i] * v[i]; }
                else { _Pragma("unroll") for (int i = 0; i < 8; ++i) v[i] = gf[i] * v[i]; }
                *(u32x4*)(O + (size_t)row * D + col) = pack8(v);
            })
        }
    }
};
struct EpiOut {
    static constexpr bool PERM = true, AFTER_DRAIN = false;
    const float* x; const float* mod; bf16_t* H;
    __device__ __forceinline__ void operator()(const f32x4 (&acc)[2][2][4][2], const Unit& u, int wr, int wc, int fr, int fq) const {
        const int b = (u.pm * BM) / SEQ; const float* gt = mod + (size_t)b * 6 * D + 2 * D;
        f32x4 gv[2][2];
#pragma unroll
        for (int bj = 0; bj < 2; ++bj) { const int col = u.pn * BM + bj * HALF + wc * 32 + 8 * fq; gv[bj][0] = *(const f32x4*)(gt + col); gv[bj][1] = *(const f32x4*)(gt + col + 4); }
#pragma unroll
        for (int ai = 0; ai < 2; ++ai) {
            f32x4 xv[4][2][2];
            EPI_HALF_PRE({ const size_t off = (size_t)(u.pm * BM + lrow) * D + u.pn * BM + lcol; xv[m][bj][0] = *(const f32x4*)(x + off); xv[m][bj][1] = *(const f32x4*)(x + off + 4); })
            EPI_HALF_RUN({
                const size_t off = (size_t)(u.pm * BM + lrow) * D + u.pn * BM + lcol;
                _Pragma("unroll") for (int i = 0; i < 4; ++i) { v[i] = xv[m][bj][0][i] + gv[bj][0][i] * v[i]; v[4 + i] = xv[m][bj][1][i] + gv[bj][1][i] * v[4 + i]; }
                *(u32x4*)(H + off) = pack8(v);
            })
        }
    }
};
struct EpiRouter {
    static constexpr bool PERM = false, AFTER_DRAIN = false;
    float* L;
    __device__ __forceinline__ void operator()(const f32x4 (&acc)[2][2][4][2], const Unit& u, int wr, int wc, int fr, int fq) const {
        if (wc < 2) {
#pragma unroll
            for (int ai = 0; ai < 2; ++ai)
#pragma unroll
                for (int m = 0; m < 4; ++m) { const int row = u.pm * BM + ai * HALF + wr * 64 + m * 16 + fr;
#pragma unroll
                    for (int n = 0; n < 2; ++n) { const f32x4 v = acc[ai][0][m][n] + acc[ai][1][m][n]; *(f32x4*)(L + (size_t)row * 64 + wc * 32 + 16 * n + 4 * fq) = v; } }
        }
    }
};
struct EpiExp1 {
    static constexpr bool PERM = true, AFTER_DRAIN = false;
    bf16_t* Hd;
    __device__ __forceinline__ void operator()(const f32x4 (&acc)[2][2][4][2], const Unit& u, int wr, int wc, int fr, int fq) const {
#pragma unroll
        for (int ai = 0; ai < 2; ++ai)
#pragma unroll
            for (int m = 0; m < 4; ++m) { const int row = u.pm * BM + ai * HALF + wr * 64 + m * 16 + fr; float v[8];
#pragma unroll
                for (int n = 0; n < 2; ++n)
#pragma unroll
                    for (int i = 0; i < 4; ++i) { const float g = acc[ai][0][m][n][i], up = acc[ai][1][m][n][i]; v[n * 4 + i] = g * sigmoidf_(g) * up; }
                *(u32x4*)(Hd + (size_t)row * DEXP + u.pn * HALF + wc * 32 + 8 * fq) = pack8(v); }
    }
};
struct EpiExp2 {
    static constexpr bool PERM = true, AFTER_DRAIN = false;
    const int* list; const float* cwl; const int* cnt; bf16_t* Sl;
    __device__ __forceinline__ void operator()(const f32x4 (&acc)[2][2][4][2], const Unit& u, int wr, int wc, int fr, int fq) const {
        const int n = cnt[u.g];
#pragma unroll
        for (int ai = 0; ai < 2; ++ai) {
            int dd[4]; float ww[4];
#pragma unroll
            for (int m = 0; m < 4; ++m) { const int pos = u.lt * BM + ai * HALF + wr * 64 + m * 16 + fr; const bool ok = pos < n; const size_t li = (size_t)u.g * T + (ok ? pos : 0);
                const int d = list[li]; const float w = cwl[li]; dd[m] = ok ? d : -1; ww[m] = w; }
            EPI_HALF_RUN({
                const int col = u.pn * BM + lcol; const int d = dd[m]; const float w = ww[m];
                if (d >= 0) { _Pragma("unroll") for (int i = 0; i < 8; ++i) v[i] *= w; *(u32x4*)(Sl + (size_t)d * D + col) = pack8(v); }
            })
        }
    }
};

template <class Epi, class Sched, bool ALIGN_EPI = false, bool SP2 = false, bool GATHER = false>
__device__ __forceinline__ void gemm_phase(PG8_LAS unsigned char* lds, const int K, const int lda, const int ldb, const Sched& S, const Epi& E, const PG8_LAS int* rowtab = nullptr) {
    int tid = threadIdx.x; asm volatile("" : "+v"(tid));
    const int wid = __builtin_amdgcn_readfirstlane(tid >> 6), lane = tid & 63, wr = wid >> 2, wc = wid & 3, fr = lane & 15, fq = lane >> 4;
    const int nt = K / BK;
    unsigned voffA[2], voffB[2]; int gR[2]; unsigned gC[2];
#pragma unroll
    for (int i = 0; i < 2; ++i) { int R, C; stage_rc(tid * 16 + i * 8192, R, C); const int Rb = Epi::PERM ? ((R & ~31) + perm32(R & 31)) : R;
        voffA[i] = (unsigned)(R * lda + C) * 2u; voffB[i] = (unsigned)(Rb * ldb + C) * 2u; gR[i] = R; gC[i] = (unsigned)C * 2u; }
    unsigned vAc[2][2], vAn[2][2], vA2[2][2];
    (void)gR; (void)gC; (void)vAc; (void)vAn; (void)vA2;
#define PG8_GLOAD(dst, ui_) do { _Pragma("unroll") for (int _h = 0; _h < 2; ++_h) _Pragma("unroll") for (int _i = 0; _i < 2; ++_i) \
        dst[_h][_i] = (unsigned)rowtab[(ui_) * 256 + _h * HALF + gR[_i]] * (unsigned)(lda * 2) + gC[_i]; } while (0)
    const size_t kstep = (size_t)(BK * 2);
    const size_t hstepA = (size_t)HALF * lda * 2, hstepB = (size_t)HALF * ldb * 2;
    const unsigned ldsw = (unsigned)wid * 1024u;
    const int aoff = lds_byte(wr * 64 + fr, fq * 8), boff = lds_byte(wc * 32 + fr, fq * 8);
#define PG8_SA(b, h) (((b) * 2 + (h)) * HTB)
#define PG8_SB(b, h) ((4 + (b) * 2 + (h)) * HTB)
#define PG8_STAGE(bufoff, gbase, voff) do { _Pragma("unroll") for (int _i = 0; _i < 2; ++_i) \
        __builtin_amdgcn_global_load_lds((const unsigned*)((const char*)(gbase) + (voff)[_i]), (PG8_LAS unsigned*)(lds + (bufoff) + ldsw + _i * 8192), 16, 0, 0); } while (0)
#define PG8_STAGE_A(bufoff, gbase, h, vs) do { if constexpr (GATHER) { PG8_STAGE(bufoff, gbase, vs[h]); } else { PG8_STAGE(bufoff, (gbase) + (h) * hstepA, voffA); } } while (0)
#define PG8_LDA(dst, b, h) do { _Pragma("unroll") for (int m = 0; m < 4; ++m) _Pragma("unroll") for (int k = 0; k < 2; ++k) dst[m][k] = *(const PG8_LAS bf16x8*)(lds + PG8_SA(b, h) + aoff + m * 2048 + k * 1024); } while (0)
#define PG8_LDB(dst, b, h) do { _Pragma("unroll") for (int n = 0; n < 2; ++n) _Pragma("unroll") for (int k = 0; k < 2; ++k) dst[n][k] = *(const PG8_LAS bf16x8*)(lds + PG8_SB(b, h) + boff + n * 2048 + k * 1024); } while (0)
#define PG8_MMA(ai, bj, At, Bt) do { __builtin_amdgcn_s_setprio(1); _Pragma("unroll") for (int m = 0; m < 4; ++m) _Pragma("unroll") for (int n = 0; n < 2; ++n) _Pragma("unroll") for (int k = 0; k < 2; ++k) \
        acc[ai][bj][m][n] = __builtin_amdgcn_mfma_f32_16x16x32_bf16(Bt[n][k], At[m][k], acc[ai][bj][m][n], 0, 0, 0); __builtin_amdgcn_s_setprio(0); } while (0)
#define PG8_WAIT_V(n) asm volatile("s_waitcnt vmcnt(" #n ")" ::: "memory")
#define PG8_WAIT_L(n) asm volatile("s_waitcnt lgkmcnt(" #n ")" ::: "memory")
#define PG8_BAR __builtin_amdgcn_s_barrier()
#define PG8_SCHED __builtin_amdgcn_sched_barrier(0)
    Unit cur, nxt; int ui = 0;
    if (!S.next(0, cur)) return;
    f32x4 acc[2][2][4][2];
#pragma unroll
    for (int a = 0; a < 2; ++a)
#pragma unroll
        for (int b = 0; b < 2; ++b)
#pragma unroll
            for (int m = 0; m < 4; ++m)
#pragma unroll
                for (int n = 0; n < 2; ++n) acc[a][b][m][n] = (f32x4){0.f, 0.f, 0.f, 0.f};
    bf16x8 At[4][2], B0[2][2], B1[2][2];
    const char* cA = cur.a; const char* cB = cur.b;
    if constexpr (GATHER) { PG8_GLOAD(vAc, 0); }
    static_assert(SP2 || !GATHER, "GATHER is wired into the SP2 loop only");
    if constexpr (SP2) {
        PG8_STAGE(PG8_SB(0, 0), cB, voffB); PG8_STAGE(PG8_SB(0, 1), cB + hstepB, voffB); PG8_STAGE_A(PG8_SA(0, 0), cA, 0, vAc); PG8_STAGE_A(PG8_SA(0, 1), cA, 1, vAc);
        if (wr == 1) PG8_BAR;
        PG8_WAIT_V(2); PG8_BAR;
        PG8_STAGE(PG8_SB(1, 0), cB + kstep, voffB); PG8_STAGE_A(PG8_SA(1, 0), cA + kstep, 0, vAc); PG8_STAGE(PG8_SB(1, 1), cB + hstepB + kstep, voffB);
        PG8_WAIT_V(6); PG8_BAR;
    } else {
        PG8_STAGE(PG8_SB(0, 0), cB, voffB); PG8_STAGE(PG8_SA(0, 0), cA, voffA); PG8_STAGE(PG8_SB(0, 1), cB + hstepB, voffB); PG8_STAGE(PG8_SA(0, 1), cA + hstepA, voffA);
        if (wr == 1) PG8_BAR;
        PG8_WAIT_V(4); PG8_BAR;
        PG8_STAGE(PG8_SB(1, 0), cB + kstep, voffB); PG8_STAGE(PG8_SA(1, 0), cA + kstep, voffA); PG8_STAGE(PG8_SB(1, 1), cB + hstepB + kstep, voffB);
        PG8_WAIT_V(6); PG8_BAR;
    }
    for (;;) {
        const bool has_next = S.next(ui + 1, nxt);
        const char* nA = has_next ? nxt.a : cA; const char* nB = has_next ? nxt.b : cB;
        if constexpr (GATHER) { if (has_next) { PG8_GLOAD(vAn, ui + 1); } else {
            _Pragma("unroll") for (int _h = 0; _h < 2; ++_h) _Pragma("unroll") for (int _i = 0; _i < 2; ++_i) vAn[_h][_i] = vAc[_h][_i]; } }
        for (int t = 0; t < nt; t += 2) {
            const bool last = (t == nt - 2);
            if constexpr (GATHER) { _Pragma("unroll") for (int _h = 0; _h < 2; ++_h) _Pragma("unroll") for (int _i = 0; _i < 2; ++_i) vA2[_h][_i] = last ? vAn[_h][_i] : vAc[_h][_i]; }
            const char* a1 = cA + (size_t)(t + 1) * kstep;
            const char* a2 = last ? nA : cA + (size_t)(t + 2) * kstep; const char* b2 = last ? nB : cB + (size_t)(t + 2) * kstep;
            const char* a3 = a2 + kstep; const char* b3 = b2 + kstep;
            if constexpr (SP2) {
            PG8_LDB(B0, 0, 0); PG8_LDB(B1, 0, 1); PG8_SCHED; PG8_LDA(At, 0, 0); PG8_STAGE_A(PG8_SA(1, 1), a1, 1, vAc);
            PG8_WAIT_V(8); PG8_WAIT_L(0); PG8_BAR; PG8_MMA(0, 0, At, B0); PG8_MMA(0, 1, At, B1); PG8_BAR; PG8_SCHED;
            PG8_LDA(At, 0, 1); PG8_STAGE(PG8_SB(0, 0), b2, voffB); PG8_STAGE(PG8_SB(0, 1), b2 + hstepB, voffB); PG8_STAGE_A(PG8_SA(0, 0), a2, 0, vA2);
            PG8_WAIT_V(8); PG8_WAIT_L(0); PG8_BAR; PG8_MMA(1, 0, At, B0); PG8_MMA(1, 1, At, B1); PG8_BAR; PG8_SCHED;
            PG8_LDB(B0, 1, 0); PG8_LDB(B1, 1, 1); PG8_SCHED; PG8_LDA(At, 1, 0); PG8_STAGE_A(PG8_SA(0, 1), a2, 1, vA2);
            PG8_WAIT_V(8); PG8_WAIT_L(0); PG8_BAR; PG8_MMA(0, 0, At, B0); PG8_MMA(0, 1, At, B1); PG8_BAR; PG8_SCHED;
            PG8_LDA(At, 1, 1); PG8_STAGE(PG8_SB(1, 0), b3, voffB); PG8_STAGE(PG8_SB(1, 1), b3 + hstepB, voffB); PG8_STAGE_A(PG8_SA(1, 0), a3, 0, vA2);
            PG8_WAIT_V(8); PG8_WAIT_L(0); PG8_BAR; PG8_MMA(1, 0, At, B0); PG8_MMA(1, 1, At, B1); PG8_BAR; PG8_SCHED;
            } else {
            PG8_LDB(B0, 0, 0); PG8_SCHED; PG8_LDA(At, 0, 0); PG8_STAGE(PG8_SA(1, 1), a1 + hstepA, voffA);
            PG8_WAIT_L(8); PG8_BAR; PG8_WAIT_L(0); PG8_MMA(0, 0, At, B0); PG8_BAR; PG8_SCHED;
            PG8_LDB(B1, 0, 1); PG8_STAGE(PG8_SB(0, 0), b2, voffB);
            PG8_BAR; PG8_WAIT_L(0); PG8_MMA(0, 1, At, B1); PG8_BAR;
            PG8_LDA(At, 0, 1); PG8_STAGE(PG8_SA(0, 0), a2, voffA);
            PG8_BAR; PG8_WAIT_L(0); PG8_MMA(1, 0, At, B0); PG8_BAR; PG8_SCHED;
            PG8_STAGE(PG8_SB(0, 1), b2 + hstepB, voffB);
            PG8_WAIT_V(6); PG8_BAR; PG8_MMA(1, 1, At, B1); PG8_BAR;
            PG8_LDB(B0, 1, 0); PG8_SCHED; PG8_LDA(At, 1, 0); PG8_STAGE(PG8_SA(0, 1), a2 + hstepA, voffA);
            PG8_WAIT_L(8); PG8_BAR; PG8_WAIT_L(0); PG8_MMA(0, 0, At, B0); PG8_BAR; PG8_SCHED;
            PG8_LDB(B1, 1, 1); PG8_STAGE(PG8_SB(1, 0), b3, voffB);
            PG8_BAR; PG8_WAIT_L(0); PG8_MMA(0, 1, At, B1); PG8_BAR;
            PG8_LDA(At, 1, 1); PG8_STAGE(PG8_SA(1, 0), a3, voffA);
            PG8_BAR; PG8_WAIT_L(0); PG8_MMA(1, 0, At, B0); PG8_BAR; PG8_SCHED;
            PG8_STAGE(PG8_SB(1, 1), b3 + hstepB, voffB);
            PG8_WAIT_V(6); PG8_BAR; PG8_MMA(1, 1, At, B1); PG8_BAR;
            }
        }
        if constexpr (ALIGN_EPI) { if (wr == 0) PG8_BAR; }
        E(acc, cur, wr, wc, fr, fq);
        if (!has_next) break;
#pragma unroll
        for (int a = 0; a < 2; ++a)
#pragma unroll
            for (int b = 0; b < 2; ++b)
#pragma unroll
                for (int m = 0; m < 4; ++m)
#pragma unroll
                    for (int n = 0; n < 2; ++n) acc[a][b][m][n] = (f32x4){0.f, 0.f, 0.f, 0.f};
        cur = nxt; cA = nA; cB = nB; ++ui;
        if constexpr (GATHER) { _Pragma("unroll") for (int _h = 0; _h < 2; ++_h) _Pragma("unroll") for (int _i = 0; _i < 2; ++_i) vAc[_h][_i] = vAn[_h][_i]; }
        if constexpr (ALIGN_EPI) { if (wr == 1) PG8_BAR; }
    }
    PG8_WAIT_V(0);
    if constexpr (!ALIGN_EPI) { if (wr == 0) PG8_BAR; }
    PG8_BAR;
#undef PG8_SA
#undef PG8_SB
#undef PG8_STAGE
#undef PG8_STAGE_A
#undef PG8_GLOAD
#undef PG8_LDA
#undef PG8_LDB
#undef PG8_MMA
#undef PG8_WAIT_V
#undef PG8_WAIT_L
#undef PG8_BAR
#undef PG8_SCHED
}
}

namespace attn_body {
using bf16=__hip_bfloat16;
using bf16x8=__attribute__((ext_vector_type(8)))short;
using s16x4=__attribute__((ext_vector_type(4)))short;
using f32x16=__attribute__((ext_vector_type(16)))float;
using u32x4=__attribute__((ext_vector_type(4)))unsigned;
constexpr int NHEAD=16,SEQ=4096,D=64,DM=NHEAD*D;
constexpr int NW=8,QBLK=32,QB=QBLK*NW,KVBLK=64,NQB=SEQ/QB;
__device__ __forceinline__ int crow(int r,int hi){return (r&3)+8*(r>>2)+4*hi;}
#define SBAR() __builtin_amdgcn_sched_barrier(0)
__device__ __forceinline__ void cmask(f32x16&p0,f32x16&p1,int jb,int wid){
  const float NEG=-INFINITY;
  if(jb>(wid>>1)){
  #pragma unroll
  for(int r=0;r<16;++r){p0[r]=NEG;p1[r]=NEG;}}
}
constexpr int NSLOT=3, SLOTB=8192, VSLOTB=16384;
constexpr int LDS_K=0, LDS_V=NSLOT*SLOTB, LDS_WS=LDS_V+NSLOT*VSLOTB, LDS_OST=LDS_WS+NW*64*4, LDS_BYTES=LDS_OST+NW*8192;
constexpr float C2=0.125f*1.4426950408889634f;
__device__ __forceinline__ void glds16(const char*sbase,unsigned voff,unsigned lds_dst){unsigned keep;
  asm volatile("s_mov_b32 %0, m0\n\ts_mov_b32 m0, %2\n\ts_nop 0\n\tglobal_load_lds_dwordx4 %1, %3\n\ts_mov_b32 m0, %0":"=&s"(keep):"v"(voff),"s"(lds_dst),"s"(sbase):"memory");}
__device__ __forceinline__ float max3f(float a,float b,float c){float r;asm("v_max3_f32 %0, %1, %2, %3":"=v"(r):"v"(a),"v"(b),"v"(c));return r;}
__device__ __forceinline__ float max2f(float a,float b){float r;asm("v_max_f32_e32 %0, %1, %2":"=v"(r):"v"(a),"v"(b));return r;}
typedef float f32x2_t __attribute__((ext_vector_type(2))); typedef __bf16 bf16x2_t __attribute__((ext_vector_type(2)));
__device__ __forceinline__ unsigned cvtpk_s(float lo,float hi){f32x2_t v={lo,hi};bf16x2_t b=__builtin_convertvector(v,bf16x2_t);return __builtin_bit_cast(unsigned,b);}
#define WAIT_BAR(N) asm volatile("s_waitcnt vmcnt(" #N ") lgkmcnt(0)\n\ts_barrier":::"memory")

__device__ __forceinline__ void qkt(f32x16&p0,f32x16&p1,const char*Kslot,const bf16x8*qr,int r32,int hi){
  const char*kb=Kslot+hi*1024+r32*16; const f32x16 z=f32x16{};
  #pragma unroll
  for(int d0=0;d0<4;++d0){
    const bf16x8 b0=*reinterpret_cast<const bf16x8*>(kb+d0*2048);
    const bf16x8 b1=*reinterpret_cast<const bf16x8*>(kb+d0*2048+512);
    if(d0==0){p0=__builtin_amdgcn_mfma_f32_32x32x16_bf16(b0,qr[0],z,0,0,0);p1=__builtin_amdgcn_mfma_f32_32x32x16_bf16(b1,qr[0],z,0,0,0);}
    else{p0=__builtin_amdgcn_mfma_f32_32x32x16_bf16(b0,qr[d0],p0,0,0,0);p1=__builtin_amdgcn_mfma_f32_32x32x16_bf16(b1,qr[d0],p1,0,0,0);}}
}
typedef __attribute__((address_space(3))) const char* lds_cptr;
typedef short v4i16_t __attribute__((ext_vector_type(4)));
__device__ __forceinline__ void kload8(bf16x8*kf,lds_cptr kp){
  kf[0]=*(const __attribute__((address_space(3))) bf16x8*)(kp);      kf[1]=*(const __attribute__((address_space(3))) bf16x8*)(kp+512);
  kf[2]=*(const __attribute__((address_space(3))) bf16x8*)(kp+2048); kf[3]=*(const __attribute__((address_space(3))) bf16x8*)(kp+2560);
  kf[4]=*(const __attribute__((address_space(3))) bf16x8*)(kp+4096); kf[5]=*(const __attribute__((address_space(3))) bf16x8*)(kp+4608);
  kf[6]=*(const __attribute__((address_space(3))) bf16x8*)(kp+6144); kf[7]=*(const __attribute__((address_space(3))) bf16x8*)(kp+6656);
}
__device__ __forceinline__ void kload2(bf16x8*kf,lds_cptr kp,int j){ kf[2*j]=*(const __attribute__((address_space(3))) bf16x8*)(kp+j*2048); kf[2*j+1]=*(const __attribute__((address_space(3))) bf16x8*)(kp+j*2048+512); }
__device__ __forceinline__ s16x4 vtr(lds_cptr p){ return __builtin_bit_cast(s16x4,__builtin_amdgcn_ds_read_tr16_b64_v4i16((__attribute__((address_space(3))) v4i16_t*)p)); }
__device__ __forceinline__ float rowmax(const f32x16&p0,const f32x16&p1){
  float a=max3f(p0[0],p0[1],p1[0]),b=max3f(p0[2],p0[3],p1[1]);a=max3f(a,p1[2],p1[3]);
  #pragma unroll
  for(int r=4;r<16;r+=4){a=max3f(a,p0[r],p0[r+1]);b=max3f(b,p0[r+2],p0[r+3]);a=max3f(a,p1[r],p1[r+1]);b=max3f(b,p1[r+2],p1[r+3]);}
  const float m=max2f(a,b);
  auto rr=__builtin_amdgcn_permlane32_swap(__float_as_uint(m),__float_as_uint(m),false,false);
  return max2f(__uint_as_float(rr[0]),__uint_as_float(rr[1]));
}
__device__ __forceinline__ void pv(f32x16*o,int vb,bf16x8 pa0,bf16x8 pa1,bf16x8 pa2,bf16x8 pa3){
  #pragma unroll
  for(int d0=0;d0<4;++d0){s16x4 lo[4],hi[4];
    #pragma unroll
    for(int ks=0;ks<4;++ks){
      asm volatile("ds_read_b64_tr_b16 %0,%1 offset:%c2":"=&v"(lo[ks]):"v"(vb),"i"(d0*4096+ks*1024):"memory");
      asm volatile("ds_read_b64_tr_b16 %0,%1 offset:%c2":"=&v"(hi[ks]):"v"(vb),"i"(d0*4096+ks*1024+512):"memory");}
    asm volatile("s_waitcnt lgkmcnt(0)":::"memory");SBAR();
    #define PK(k) (bf16x8){lo[k][0],lo[k][1],lo[k][2],lo[k][3],hi[k][0],hi[k][1],hi[k][2],hi[k][3]}
    o[d0]=__builtin_amdgcn_mfma_f32_32x32x16_bf16(pa0,PK(0),o[d0],0,0,0);
    o[d0]=__builtin_amdgcn_mfma_f32_32x32x16_bf16(pa1,PK(1),o[d0],0,0,0);
    o[d0]=__builtin_amdgcn_mfma_f32_32x32x16_bf16(pa2,PK(2),o[d0],0,0,0);
    o[d0]=__builtin_amdgcn_mfma_f32_32x32x16_bf16(pa3,PK(3),o[d0],0,0,0);
    #undef PK
  }
}
template<int THRL,int FTHR,size_t OFF_Q,size_t OFF_K,size_t OFF_V,int GSO> __device__ __forceinline__ void attn_unit(int b,int h,int qb,const char*ws,bf16*AO,float lam,char*shm){
  const bf16*Q=(const bf16*)(ws+OFF_Q); const float*gs=(const float*)(shm+GSO);
  int tid=threadIdx.x; asm volatile("":"+v"(tid)); const int lane=tid&63,r32=lane&31,hi=lane>>5; const int wid=__builtin_amdgcn_readfirstlane(tid>>6);
  const long rowbase=(long)b*SEQ; const int q0=qb*QB;
  const unsigned lds0=(unsigned)(uintptr_t)shm;
  float*wsf=(float*)(shm+LDS_WS)+wid*64;
  bf16*stg=(bf16*)(shm+LDS_OST)+wid*4096;
  const unsigned kdst=lds0+LDS_K+wid*1024, vdst=lds0+LDS_V+wid*1024;
  const int vb0=(int)(lds0+LDS_V)+((lane>>4)&1)*32+(lane&3)*8+(4*hi+((lane&15)>>2))*64;
  const char*Kbase=shm+LDS_K;
  const lds_cptr shm3=(lds_cptr)shm; const lds_cptr kp0=shm3+LDS_K+hi*1024+r32*16; const lds_cptr vp0=shm3+LDS_V+((lane>>4)&1)*32+(lane&3)*8+(4*hi+((lane&15)>>2))*64;
  const int NT=(q0+QB)/KVBLK;
  const char*Vh=ws+OFF_V+(rowbase*DM+h*128)*2;
  const unsigned vsrc=(unsigned)(((16*(wid&3)+(lane>>2))*DM+(wid>>2)*32+(lane&3)*8)*2);
  #pragma unroll 1
  for(int mp=0;mp<2;++mp){
  const int hq=2*h+mp;
  const bf16*Qw=Q+(rowbase+q0+wid*QBLK)*DM+hq*D;
  const char*Kh=ws+OFF_K+(rowbase*DM+hq*D)*2;
  const unsigned ksrc=(unsigned)((lane*DM+wid*8)*2);
  bf16x8 kf[8];
  #define DMA_K(t,slot) glds16(Kh+(long)(t)*(KVBLK*DM*2),ksrc,(unsigned)__builtin_amdgcn_readfirstlane(kdst+(slot)))
  #define DMA_V(t,slot) do{ glds16(Vh+(long)(t)*(KVBLK*DM*2),vsrc,(unsigned)__builtin_amdgcn_readfirstlane(vdst+2*(slot))); glds16(Vh+(long)(t)*(KVBLK*DM*2)+128,vsrc,(unsigned)__builtin_amdgcn_readfirstlane(vdst+2*(slot)+8192)); }while(0)
  DMA_K(0,0);DMA_V(0,0);DMA_K(1,SLOTB);
  bf16x8 qr[4];
  #pragma unroll
  for(int d0=0;d0<4;++d0)qr[d0]=*reinterpret_cast<const bf16x8*>(&Qw[(long)r32*DM+d0*16+hi*8]);
  float mhat=0.f,l_reg=0.f;f32x16 o[4];o[0]=f32x16{};o[1]=f32x16{};o[2]=f32x16{};o[3]=f32x16{};
  #define CMASK(P0,P1,t) do{int jb_=(t)-(NT-4); if(jb_>=0)cmask(P0,P1,jb_,wid);}while(0)
  bool resc=false;
  #define RESC() do{ if(resc){ asm volatile("s_waitcnt lgkmcnt(0)":::"memory"); \
      _Pragma("unroll") for(int d_=0;d_<4;++d_) _Pragma("unroll") for(int r=0;r<16;++r)o[d_][r]*=wsf[crow(r,hi)]; } }while(0)
  f32x16 pA0,pA1,pB0,pB1;
  int sl_prev=0,sl_cur=0,sl_next=SLOTB;
  #define ROT() do{sl_prev=sl_cur;sl_cur=sl_next;sl_next=(sl_next==(NSLOT-1)*SLOTB)?0:sl_next+SLOTB;}while(0)
  DMA_K(2,2*SLOTB);
  WAIT_BAR(4);
  qkt(pA0,pA1,Kbase,qr,r32,hi);asm volatile("s_nop 15\n\ts_nop 7":"+v"(pA0),"+v"(pA1));CMASK(pA0,pA1,0);
  bool fastp;
  { const float rm=rowmax(pA0,pA1); fastp=!__any(__builtin_fabsf(rm)>(float)FTHR); mhat=fastp?0.f:rm; resc=false;
    _Pragma("unroll") for(int r=0;r<16;++r){pA0[r]=__builtin_amdgcn_exp2f(pA0[r]-mhat);pA1[r]=__builtin_amdgcn_exp2f(pA1[r]-mhat);} }
  WAIT_BAR(0);
  DMA_K(3,0);DMA_V(1,SLOTB);
  ROT();
  kload8(kf,kp0+sl_cur);
  WAIT_BAR(3);
  s16x4 vlo[8],vhi[8]; u32x4 pw0,pw1,pw2,pw3;
  #define PKW(P,B) cvtpk_s(P[B],P[B+1])
  #define PAF(k) __builtin_bit_cast(bf16x8,pw##k)
  #define VFR(i) (bf16x8){vlo[i][0],vlo[i][1],vlo[i][2],vlo[i][3],vhi[i][0],vhi[i][1],vhi[i][2],vhi[i][3]}
  #define PIN(x) asm volatile("":"+v"(x))
  #define MX3(a,b,c) __builtin_fmaxf(__builtin_fmaxf((a),(b)),(c))
  #define ZC (f32x16{})
  #define GAPA(MF,A0,A1,A2,A3,W0,W1,PW) do{ MF; sacc+=A0; sacc+=A1; sacc+=A2; sacc+=A3; PIN(sacc); W0; W1; PIN(PW); SBAR(); }while(0)
  #define EX0(v) __builtin_amdgcn_exp2f((v)-mhat)
  #define EX1(v) __builtin_amdgcn_exp2f(v)
  #define GAPB(F,MF,X,B) do{ MF; X[B]=EX##F(X[B]); X[B+1]=EX##F(X[B+1]); PIN(X); SBAR(); }while(0)
  #define VRD(i) do{ vlo[i]=vtr(vp_+(((i)>>2)*4096+((i)&3)*1024)); vhi[i]=vtr(vp_+(((i)>>2)*4096+((i)&3)*1024+512)); }while(0)
  #define VRD2(i) do{ vlo[i]=vtr(vp_+((2+((i)>>2))*4096+((i)&3)*1024)); vhi[i]=vtr(vp_+((2+((i)>>2))*4096+((i)&3)*1024+512)); SBAR(); }while(0)
  #define KRD(G,j) do{ if(G){ kload2(kf,kp0+sl_next,j); SBAR(); } }while(0)
  #define STEP(F,C0,C1,P0,P1,t,GK,GV,GL) do{ SBAR(); \
    const lds_cptr vp_=vp0+2*sl_prev; \
    VRD(0); SBAR(); float sacc=(P0[0]+P0[1]); \
    GAPA(C0=__builtin_amdgcn_mfma_f32_32x32x16_bf16(kf[0],qr[0],ZC,0,0,0), P0[2],P0[3],P0[4],P0[5],     pw0[0]=PKW(P0,0), pw0[1]=PKW(P0,2), pw0); \
    VRD(4); SBAR(); GAPA(C1=__builtin_amdgcn_mfma_f32_32x32x16_bf16(kf[1],qr[0],ZC,0,0,0), P0[6],P0[7],P0[8],P0[9],     pw0[2]=PKW(P0,4), pw0[3]=PKW(P0,6), pw0); \
    VRD(1); SBAR(); GAPA(C0=__builtin_amdgcn_mfma_f32_32x32x16_bf16(kf[2],qr[1],C0,0,0,0),   P0[10],P0[11],P0[12],P0[13], pw1[0]=PKW(P0,8), pw1[1]=PKW(P0,10), pw1); \
    VRD(5); SBAR(); GAPA(C1=__builtin_amdgcn_mfma_f32_32x32x16_bf16(kf[3],qr[1],C1,0,0,0),   P0[14],P0[15],P1[0],P1[1],   pw1[2]=PKW(P0,12),pw1[3]=PKW(P0,14), pw1); \
    VRD(2); SBAR(); GAPA(C0=__builtin_amdgcn_mfma_f32_32x32x16_bf16(kf[4],qr[2],C0,0,0,0),   P1[2],P1[3],P1[4],P1[5],     pw2[0]=PKW(P1,0), pw2[1]=PKW(P1,2), pw2); \
    VRD(6); SBAR(); GAPA(C1=__builtin_amdgcn_mfma_f32_32x32x16_bf16(kf[5],qr[2],C1,0,0,0),   P1[6],P1[7],P1[8],P1[9],     pw2[2]=PKW(P1,4), pw2[3]=PKW(P1,6), pw2); \
    VRD(3); SBAR(); GAPA(C0=__builtin_amdgcn_mfma_f32_32x32x16_bf16(kf[6],qr[3],C0,0,0,0),   P1[10],P1[11],P1[12],P1[13], pw3[0]=PKW(P1,8), pw3[1]=PKW(P1,10), pw3); \
    VRD(7); SBAR(); GAPA(C1=__builtin_amdgcn_mfma_f32_32x32x16_bf16(kf[7],qr[3],C1,0,0,0),   P1[14],P1[15],0.f,0.f,       pw3[2]=PKW(P1,12),pw3[3]=PKW(P1,14), pw3); \
    l_reg+=sacc; \
    if(GK){DMA_K((t)+3,sl_cur);} if(GV){DMA_V((t)+1,sl_next);} \
    CMASK(C0,C1,t); \
    { float a=MX3(C0[0],C0[1],C1[0]),b=MX3(C0[2],C0[3],C1[1]); a=MX3(a,C1[2],C1[3]); \
      _Pragma("unroll") for(int r=4;r<16;r+=4){a=MX3(a,C0[r],C0[r+1]);b=MX3(b,C0[r+2],C0[r+3]);a=MX3(a,C1[r],C1[r+1]);b=MX3(b,C1[r+2],C1[r+3]);} \
      float rm=__builtin_fmaxf(a,b); { auto rr=__builtin_amdgcn_permlane32_swap(__float_as_uint(rm),__float_as_uint(rm),false,false); rm=__builtin_fmaxf(__uint_as_float(rr[0]),__uint_as_float(rr[1])); } \
      rm-=mhat; resc=false; \
      if(__builtin_expect(__any(rm>(float)((F)?FTHR:THRL)),0)){ const float dl=__builtin_fmaxf(rm,0.f); mhat+=dl; \
        if(F){ fastp=false; _Pragma("unroll") for(int r=0;r<16;++r){C0[r]-=dl;C1[r]-=dl;} } \
        const float f=__builtin_amdgcn_exp2f(-dl); l_reg*=f; if(hi==0)wsf[r32]=f; resc=true; } } \
    SBAR(); \
    GAPB(F,o[0]=__builtin_amdgcn_mfma_f32_32x32x16_bf16(PAF(0),VFR(0),o[0],0,0,0), C0,0);  VRD2(0); \
    GAPB(F,o[1]=__builtin_amdgcn_mfma_f32_32x32x16_bf16(PAF(0),VFR(4),o[1],0,0,0), C0,2);  VRD2(4); \
    GAPB(F,o[0]=__builtin_amdgcn_mfma_f32_32x32x16_bf16(PAF(1),VFR(1),o[0],0,0,0), C0,4);  VRD2(1); \
    GAPB(F,o[1]=__builtin_amdgcn_mfma_f32_32x32x16_bf16(PAF(1),VFR(5),o[1],0,0,0), C0,6);  VRD2(5); \
    GAPB(F,o[0]=__builtin_amdgcn_mfma_f32_32x32x16_bf16(PAF(2),VFR(2),o[0],0,0,0), C0,8);  VRD2(2); \
    GAPB(F,o[1]=__builtin_amdgcn_mfma_f32_32x32x16_bf16(PAF(2),VFR(6),o[1],0,0,0), C0,10); VRD2(6); \
    GAPB(F,o[0]=__builtin_amdgcn_mfma_f32_32x32x16_bf16(PAF(3),VFR(3),o[0],0,0,0), C0,12); VRD2(3); \
    GAPB(F,o[1]=__builtin_amdgcn_mfma_f32_32x32x16_bf16(PAF(3),VFR(7),o[1],0,0,0), C0,14); VRD2(7); \
    KRD(GL,0); GAPB(F,o[2]=__builtin_amdgcn_mfma_f32_32x32x16_bf16(PAF(0),VFR(0),o[2],0,0,0), C1,0); \
    KRD(GL,1); GAPB(F,o[3]=__builtin_amdgcn_mfma_f32_32x32x16_bf16(PAF(0),VFR(4),o[3],0,0,0), C1,2); \
    KRD(GL,2); GAPB(F,o[2]=__builtin_amdgcn_mfma_f32_32x32x16_bf16(PAF(1),VFR(1),o[2],0,0,0), C1,4); \
    KRD(GL,3); GAPB(F,o[3]=__builtin_amdgcn_mfma_f32_32x32x16_bf16(PAF(1),VFR(5),o[3],0,0,0), C1,6); \
    GAPB(F,o[2]=__builtin_amdgcn_mfma_f32_32x32x16_bf16(PAF(2),VFR(2),o[2],0,0,0), C1,8); \
    GAPB(F,o[3]=__builtin_amdgcn_mfma_f32_32x32x16_bf16(PAF(2),VFR(6),o[3],0,0,0), C1,10); \
    GAPB(F,o[2]=__builtin_amdgcn_mfma_f32_32x32x16_bf16(PAF(3),VFR(3),o[2],0,0,0), C1,12); \
    GAPB(F,o[3]=__builtin_amdgcn_mfma_f32_32x32x16_bf16(PAF(3),VFR(7),o[3],0,0,0), C1,14); \
    }while(0)
  int t=1;
  #undef CMASK
  #define CMASK(P0,P1,t) do{}while(0)
  for(;fastp&&t+5<NT;t+=2){
    STEP(1,pB0,pB1,pA0,pA1,t,true,true,true);     WAIT_BAR(3); RESC(); ROT();
    STEP(1,pA0,pA1,pB0,pB1,t+1,true,true,true);   WAIT_BAR(3); RESC(); ROT();
  }
  for(;t+5<NT;t+=2){
    STEP(0,pB0,pB1,pA0,pA1,t,true,true,true);     WAIT_BAR(3); RESC(); ROT();
    STEP(0,pA0,pA1,pB0,pB1,t+1,true,true,true);   WAIT_BAR(3); RESC(); ROT();
  }
  #undef CMASK
  #define CMASK(P0,P1,t) do{int jb_=(t)-(NT-4); if(jb_>=0)cmask(P0,P1,jb_,wid);}while(0)
  #define ENDW(tt) do{ if((tt)+3<NT){WAIT_BAR(3);} else if((tt)+2<NT){WAIT_BAR(2);} else {WAIT_BAR(0);} }while(0)
  for(;t+1<NT;t+=2){
    STEP(0,pB0,pB1,pA0,pA1,t,(t+3<NT),(t+1<NT),(t+1<NT));       ENDW(t);   RESC(); ROT();
    STEP(0,pA0,pA1,pB0,pB1,t+1,(t+4<NT),(t+2<NT),(t+2<NT));     ENDW(t+1); RESC(); ROT();
  }
  STEP(0,pB0,pB1,pA0,pA1,NT-1,false,false,false); RESC();
  { float sacc=pB0[0]+pB0[1]; _Pragma("unroll") for(int r=2;r<16;++r)sacc+=pB0[r]; _Pragma("unroll") for(int r=0;r<16;++r)sacc+=pB1[r]; l_reg+=sacc;
    pw0=(u32x4){PKW(pB0,0),PKW(pB0,2),PKW(pB0,4),PKW(pB0,6)};pw1=(u32x4){PKW(pB0,8),PKW(pB0,10),PKW(pB0,12),PKW(pB0,14)};pw2=(u32x4){PKW(pB1,0),PKW(pB1,2),PKW(pB1,4),PKW(pB1,6)};pw3=(u32x4){PKW(pB1,8),PKW(pB1,10),PKW(pB1,12),PKW(pB1,14)};
    SBAR(); pv(o,vb0+2*sl_cur,PAF(0),PAF(1),PAF(2),PAF(3)); }
  #undef PKW
  #undef PAF
  #undef VFR
  #undef PIN
  #undef MX3
  #undef ZC
  #undef GAPA
  #undef GAPB
  #undef EX0
  #undef EX1
  #undef VRD
  #undef VRD2
  #undef KRD
  #undef STEP
  #undef ENDW
  #undef DMA_K
  #undef DMA_V
  #undef CMASK
  #undef RESC
  #undef ROT
  {auto rr=__builtin_amdgcn_permlane32_swap(__float_as_uint(l_reg),__float_as_uint(l_reg),false,false);l_reg=__uint_as_float(rr[0])+__uint_as_float(rr[1]);}
  if(hi==0)wsf[32+r32]=l_reg;asm volatile("s_waitcnt lgkmcnt(0)":::"memory");
  float rli[16];
  #pragma unroll
  for(int r=0;r<16;++r)rli[r]=__builtin_amdgcn_rcpf(wsf[32+crow(r,hi)]);
  if(mp==0){
    #pragma unroll
    for(int r=0;r<16;++r){const int orow=crow(r,hi);
      #pragma unroll
      for(int d0=0;d0<4;++d0)stg[orow*128+d0*32+r32]=__float2bfloat16(o[d0][r]*rli[r]);}
  } else {
    #pragma unroll
    for(int r=0;r<16;++r){const int orow=crow(r,hi);
      #pragma unroll
      for(int d0=0;d0<4;++d0){ const float c=__bfloat162float(stg[orow*128+d0*32+r32])-lam*(o[d0][r]*rli[r]); stg[orow*128+d0*32+r32]=__float2bfloat16(c);} }
    asm volatile("s_waitcnt lgkmcnt(0)":::"memory");
    const int row=lane>>1,hf=lane&1; float cv[64]; float ss=0.f;
    #pragma unroll
    for(int i=0;i<8;++i){ const u32x4 w=*(const u32x4*)(stg+row*128+hf*64+i*8);
      cv[8*i+0]=__uint_as_float(w.x<<16);cv[8*i+1]=__uint_as_float(w.x&0xffff0000u);cv[8*i+2]=__uint_as_float(w.y<<16);cv[8*i+3]=__uint_as_float(w.y&0xffff0000u);
      cv[8*i+4]=__uint_as_float(w.z<<16);cv[8*i+5]=__uint_as_float(w.z&0xffff0000u);cv[8*i+6]=__uint_as_float(w.w<<16);cv[8*i+7]=__uint_as_float(w.w&0xffff0000u); }
    #pragma unroll
    for(int i=0;i<64;++i)ss+=cv[i]*cv[i];
    ss+=__int_as_float(__builtin_amdgcn_ds_bpermute((lane^1)<<2,__float_as_int(ss)));
    const float rstd=1.0f/sqrtf(ss*(1.0f/128.0f)+1e-6f);
    bf16*Ow=AO+(rowbase+q0+wid*QBLK+row)*DM+h*128+hf*64;
    #pragma unroll
    for(int i=0;i<8;++i){ const float4 g0=*(const float4*)(gs+hf*64+i*8),g1=*(const float4*)(gs+hf*64+i*8+4); u32x4 w;
      w.x=cvtpk_s(cv[8*i+0]*rstd*g0.x,cv[8*i+1]*rstd*g0.y); w.y=cvtpk_s(cv[8*i+2]*rstd*g0.z,cv[8*i+3]*rstd*g0.w);
      w.z=cvtpk_s(cv[8*i+4]*rstd*g1.x,cv[8*i+5]*rstd*g1.y); w.w=cvtpk_s(cv[8*i+6]*rstd*g1.z,cv[8*i+7]*rstd*g1.w);
      *(u32x4*)(Ow+i*8)=w; }
  }
  asm volatile("s_waitcnt lgkmcnt(0)\n\ts_barrier":::"memory");
  }
}
constexpr int ATTN_LDS_BYTES=LDS_BYTES;
#undef SBAR
#undef WAIT_BAR
}

constexpr size_t MiB = 1u << 20;
constexpr size_t WS_CTL = 0, CTL_ZERO_BYTES = 1 * MiB;
constexpr size_t WS_WIN = 2 * MiB;
constexpr size_t WS_WGLU = 13 * MiB;
constexpr size_t WS_WSSM = 14 * MiB;
constexpr size_t WS_WATT = 15 * MiB;
constexpr size_t WS_WOUT = 17 * MiB;
constexpr size_t WS_WR = 19 * MiB;
constexpr size_t WS_BTP = 20 * MiB;
constexpr size_t WS_BTY = 28 * MiB;
constexpr size_t WS_WE1 = 48 * MiB;
constexpr size_t WS_WE2 = 80 * MiB;
constexpr size_t WS_ETAB = 96 * MiB;
constexpr size_t WS_MOD = 104 * MiB;
constexpr size_t WS_UG = 112 * MiB;
constexpr size_t WS_Q = 152 * MiB, WS_K = 216 * MiB, WS_V = 280 * MiB;
constexpr size_t WS_GATES = 344 * MiB;
constexpr size_t WS_SLOC = 472 * MiB;
constexpr size_t WS_YACT = 152 * MiB;
constexpr size_t WS_S5O = 184 * MiB;
constexpr size_t WS_TMP = 280 * MiB;
constexpr size_t WS_H = 344 * MiB;
constexpr size_t WS_HDN = 256 * MiB;
constexpr size_t WS_SLOTS = 112 * MiB;
constexpr size_t WS_LIST = 472 * MiB;
constexpr size_t WS_CWL = 476 * MiB;
constexpr size_t WS_END = 512 * MiB;
constexpr int CW_TMO = 0, CW_BAR = 4096, CW_CNT = 16384;

constexpr int NWAVES = 8;
constexpr int RING_OFF = 0, RING_BYTES = 147456;
constexpr int LDSCTL_OFF = RING_BYTES, MISC_OFF = LDSCTL_OFF + 320;
constexpr int GS_OFF = MISC_OFF + 2048;
constexpr int ROWTAB_OFF = LDSCTL_OFF + 4096;
constexpr int LDS_BYTES = RING_BYTES + 8192;
static_assert(attn_body::ATTN_LDS_BYTES <= RING_BYTES, "attention LDS");

#define GAS __attribute__((address_space(1)))
#define LAS __attribute__((address_space(3)))
typedef unsigned short bf16;
typedef unsigned v4u __attribute__((ext_vector_type(4)));
typedef unsigned v2u __attribute__((ext_vector_type(2)));
typedef float f32x4 __attribute__((ext_vector_type(4)));
typedef GAS unsigned gu32;
#define RLX_AGENT __ATOMIC_RELAXED, __HIP_MEMORY_SCOPE_AGENT
#define LDS_WAIT() asm volatile("s_waitcnt lgkmcnt(0)" ::: "memory")
#define VM_WAIT() asm volatile("s_waitcnt vmcnt(0)" ::: "memory")
__device__ __forceinline__ unsigned f2bf(float f) { unsigned u = __builtin_bit_cast(unsigned, f); return (u + 0x7fffu + ((u >> 16) & 1u)) >> 16; }
__device__ __forceinline__ unsigned pk2(float lo, float hi) { return f2bf(lo) | (f2bf(hi) << 16); }
__device__ __forceinline__ float bf2f(unsigned b) { return __uint_as_float(b << 16); }

#define XB_TMO      128
#define XB_XCNT(j)  (256  + 64 * (j))
#define XB_XSUB(j)  (1280 + 64 * (j))
#define XB_XGEN(j)  (2304 + 64 * (j))
#define XB_TOP      3328
#define XB_TOPGEN   3392
#define XCD_BAR_WORDS 3456
#define XB_SPIN_CAP (1u << 18)
__device__ __forceinline__ unsigned xb_ld(unsigned* p)              { return __hip_atomic_load(p, __ATOMIC_RELAXED, __HIP_MEMORY_SCOPE_AGENT); }
__device__ __forceinline__ unsigned xb_add(unsigned* p, unsigned v) { return __hip_atomic_fetch_add(p, v, __ATOMIC_RELAXED, __HIP_MEMORY_SCOPE_AGENT); }
__device__ __forceinline__ unsigned xb_xcc_id() { return (unsigned)__builtin_amdgcn_s_getreg((3 << 11) | 20) & 0xFu; }
#define XB_SPIN(cond, bar) do { unsigned _sp = 0; while (cond) { __builtin_amdgcn_s_sleep(1); \
    if ((++_sp & 255u) == 0u) { if (xb_ld(&(bar)[XB_TMO])) break; if (_sp > XB_SPIN_CAP) { atomicAdd(&(bar)[XB_TMO], 1u); break; } } } } while (0)
struct XcdBarrier { unsigned* bar; unsigned x; volatile LAS unsigned* st; };
__device__ __forceinline__ XcdBarrier xcd_barrier_post(unsigned* bar, volatile LAS unsigned* st) {
    XcdBarrier b; b.bar = bar; b.x = xb_xcc_id(); b.st = st;
    if (threadIdx.x == 0) (void)xb_add(&bar[XB_XCNT(b.x)], 1u);
    return b;
}
__device__ __forceinline__ void xcd_barrier_complete(unsigned* bar, unsigned x, unsigned& nloc, unsigned& nx) {
    const unsigned G = gridDim.x * gridDim.y * gridDim.z;
    unsigned sum, cnt, mine, sp = 0u;
    for (;;) {
        sum = 0u; cnt = 0u; mine = 0u;
#pragma unroll
        for (unsigned j = 0; j < 16; ++j) { const unsigned c = xb_ld(&bar[XB_XCNT(j)]); sum += c; cnt += (c > 0u) ? 1u : 0u; mine = (j == x) ? c : mine; }
        if (sum == G) break;
        __builtin_amdgcn_s_sleep(1);
        if ((++sp & 255u) == 0u) { if (xb_ld(&bar[XB_TMO])) break; if (sp > XB_SPIN_CAP) { atomicAdd(&bar[XB_TMO], 1u); break; } }
    }
    nloc = mine > 0u ? mine : 1u; nx = cnt > 0u ? cnt : 1u;
}
__device__ __forceinline__ void xcd_barrier(const XcdBarrier& b) {
    asm volatile("s_waitcnt vmcnt(0)" ::: "memory");
    __syncthreads();
    if (threadIdx.x == 0) {
        unsigned* bar = b.bar;
        __builtin_amdgcn_s_waitcnt(0);
        unsigned nloc = b.st[0], nx = b.st[1];
        if (nloc == 0u) { xcd_barrier_complete(bar, b.x, nloc, nx); b.st[0] = nloc; b.st[1] = nx; }
        const unsigned old = xb_add(&bar[XB_XSUB(b.x)], 1u);
        const unsigned gen = old / nloc;
        if (old + 1u == (gen + 1u) * nloc) {
            __builtin_amdgcn_fence(__ATOMIC_RELEASE, "agent");
            asm volatile("s_waitcnt vmcnt(0)" ::: "memory");
            const unsigned og = xb_add(&bar[XB_TOP], 1u);
            const unsigned tg = og / nx;
            if (og + 1u == (tg + 1u) * nx) xb_add(&bar[XB_TOPGEN], 1u);
            else XB_SPIN(xb_ld(&bar[XB_TOPGEN]) == tg, bar);
            __builtin_amdgcn_fence(__ATOMIC_ACQUIRE, "agent");
            xb_add(&bar[XB_XGEN(b.x)], 1u);
            asm volatile("s_waitcnt vmcnt(0)" ::: "memory");
        } else {
            XB_SPIN(xb_ld(&bar[XB_XGEN(b.x)]) == gen, bar);
            __builtin_amdgcn_fence(__ATOMIC_ACQUIRE, "agent");
            asm volatile("s_waitcnt vmcnt(0)" ::: "memory");
        }
    }
    __syncthreads();
}

__device__ __forceinline__ float shfl_xor_l(float v, int o, int lane) { return __int_as_float(__builtin_amdgcn_ds_bpermute((lane ^ o) << 2, __float_as_int(v))); }
__device__ __forceinline__ float wave_sum(float v, int lane) {
#pragma unroll
    for (int o = 1; o < 64; o <<= 1) v += shfl_xor_l(v, o, lane);
    return v;
}
__device__ __forceinline__ void transpose_tile(const float* W, int N, int k0, int n0, bf16* WT, int ldo, int orow0, int ocol0, LAS float* scr, int lane) {
#pragma unroll 8
    for (int i = 0; i < 32; ++i) { const int kk = 2 * i + (lane >> 5); scr[kk * 33 + (lane & 31)] = W[(size_t)(k0 + kk) * N + n0 + (lane & 31)]; }
    LDS_WAIT(); asm volatile("" ::: "memory");
    const int c = lane & 7;
#pragma unroll
    for (int j = 0; j < 4; ++j) { const int n = (lane >> 3) + 8 * j; const LAS float* s = scr + (8 * c) * 33 + n;
        v4u o; o.x = pk2(s[0 * 33], s[1 * 33]); o.y = pk2(s[2 * 33], s[3 * 33]); o.z = pk2(s[4 * 33], s[5 * 33]); o.w = pk2(s[6 * 33], s[7 * 33]);
        *(GAS v4u*)(WT + (size_t)(orow0 + n) * ldo + ocol0 + 8 * c) = o; }
    LDS_WAIT(); asm volatile("" ::: "memory");
}
__device__ __forceinline__ void abar_pow(float lr, float li, float dt, float j, float& re, float& im) {
    const float mag = expf(lr * dt * j); float s, c; sincosf(li * dt * j, &s, &c); re = mag * c; im = mag * s;
}

constexpr int ETAB_OFF = MISC_OFF + 256;
__device__ __forceinline__ void build_expert_table(LAS unsigned char* L, const int* CNT, int tid) {
    LAS int* tab = (LAS int*)(L + ETAB_OFF); LAS int* cl = tab + (XS_ROWS / 256 + 2);
    __syncthreads();
    if (tid < NEXP) cl[tid] = CNT[tid];
    __syncthreads();
    if (tid == 0) { int rt = 0;
#pragma unroll 1
        for (int e = 0; e < NEXP; ++e) { const int nt = (cl[e] + 255) >> 8;
#pragma unroll 1
            for (int q = 0; q < nt; ++q) tab[rt++] = e | (q << 8); }
        tab[XS_ROWS / 256 + 1] = rt;
#pragma unroll 1
        for (; rt <= XS_ROWS / 256; ++rt) tab[rt] = -1; }
    __syncthreads();
}
struct Args { const float* in[34]; float* out; unsigned char* ws; };
typedef __attribute__((address_space(4))) const char* kconst_ptr;
__device__ __forceinline__ void* karg(int k) { kconst_ptr kp = (kconst_ptr)__builtin_amdgcn_kernarg_segment_ptr(); asm volatile("" : "+s"(kp)); return *(void* const __attribute__((address_space(4)))*)(kp + 8 * k); }

__global__ void __launch_bounds__(NWAVES * 64, 2) fwd_kernel(Args args) {
    extern __shared__ __attribute__((aligned(16))) unsigned char lds[];
    LAS unsigned char* L = (LAS unsigned char*)lds;
    volatile LAS unsigned* MISC = (volatile LAS unsigned*)(L + MISC_OFF);
#define PHASE_IDS() \
    int tid = threadIdx.x; asm volatile("" : "+v"(tid)); \
    const int lane = tid & 63, wave = __builtin_amdgcn_readfirstlane(tid >> 6); \
    int G = gridDim.x, bx = blockIdx.x; asm volatile("" : "+s"(G), "+s"(bx)); \
    const int vcu = (G % 8 == 0) ? (bx % 8) * (G / 8) + bx / 8 : bx; \
    const int gw = vcu * NWAVES + wave, NGW = G * NWAVES; \
    const int gt = bx * (NWAVES * 64) + tid, NGT = G * NWAVES * 64; \
    (void)lane; (void)wave; (void)vcu; (void)gw; (void)NGW; (void)gt; (void)NGT;
    gu32* ctl = (gu32*)(args.ws + WS_CTL);
    for (int u = threadIdx.x; u < (LDS_BYTES - LDSCTL_OFF) / 4; u += NWAVES * 64) ((LAS unsigned*)(L + LDSCTL_OFF))[u] = 0u;
    __syncthreads();
    XcdBarrier bar = xcd_barrier_post((unsigned*)(ctl + CW_BAR), MISC + 8);
#define GRID_BAR() xcd_barrier(bar)

#define KIN(k) ((const float*)karg(k))
#define WSP(T_, off) ((T_*)(((unsigned char*)karg(35)) + (off)))
#define OUTP() ((float*)karg(34))

#if DBG_STAGE != 1
    asm volatile("; PHASE_MARK P0" ::: "memory");
    {
        PHASE_IDS();
        const float* w_in = KIN(5); const float* w_glu = KIN(15); const float* w_br_ssm = KIN(22); const float* w_br_attn = KIN(23); const float* w_out = KIN(24);
        const float* w_eg = KIN(30); const float* w_eu = KIN(31); const float* w_ed = KIN(32);
        bf16* WinT = WSP(bf16, WS_WIN); bf16* WgluT = WSP(bf16, WS_WGLU); bf16* WssmT = WSP(bf16, WS_WSSM); bf16* WattT = WSP(bf16, WS_WATT); bf16* WoutT = WSP(bf16, WS_WOUT);
        bf16* WE1 = WSP(bf16, WS_WE1); bf16* WE2 = WSP(bf16, WS_WE2);
        LAS float* scr = (LAS float*)(L + RING_OFF + wave * 16384);
        constexpr int I_IN = 16 * 176, I_GLU = 8 * 16, I_SSM = 8 * 32, I_ATT = 16 * 32, I_OUT = 16 * 32, I_EG = NEXP * 16 * 8, I_EU = I_EG, I_ED = NEXP * 4 * 32;
        constexpr int NITEMS = I_IN + I_GLU + I_SSM + I_ATT + I_OUT + I_EG + I_EU + I_ED;
        for (int it = gw; it < NITEMS; it += NGW) {
            int r = it;
            if (r < I_IN) { const int kb = r / 176, nb = r % 176; transpose_tile(w_in, INW, 64 * kb, 32 * nb, WinT, D, 32 * nb, 64 * kb, scr, lane); continue; } r -= I_IN;
            if (r < I_GLU) { const int kb = r / 16, nb = r % 16; transpose_tile(w_glu, S5W, 64 * kb, 32 * nb, WgluT, S5W, 32 * nb, 64 * kb, scr, lane); continue; } r -= I_GLU;
            if (r < I_SSM) { const int kb = r / 32, nb = r % 32; transpose_tile(w_br_ssm, D, 64 * kb, 32 * nb, WssmT, S5W, 32 * nb, 64 * kb, scr, lane); continue; } r -= I_SSM;
            if (r < I_ATT) { const int kb = r / 32, nb = r % 32; transpose_tile(w_br_attn, D, 64 * kb, 32 * nb, WattT, D, 32 * nb, 64 * kb, scr, lane); continue; } r -= I_ATT;
            if (r < I_OUT) { const int kb = r / 32, nb = r % 32; transpose_tile(w_out, D, 64 * kb, 32 * nb, WoutT, D, 32 * nb, 64 * kb, scr, lane); continue; } r -= I_OUT;
            if (r < I_EG + I_EU) { const bool up = r >= I_EG; if (up) r -= I_EG; const int e = r / 128, q = r % 128, kb = q / 8, nb = q % 8;
                transpose_tile((up ? w_eu : w_eg) + (size_t)e * D * DEXP, DEXP, 64 * kb, 32 * nb, WE1 + (size_t)e * 512 * D, D, (nb >> 2) * 256 + (up ? 128 : 0) + (nb & 3) * 32, 64 * kb, scr, lane); continue; } r -= I_EG + I_EU;
            { const int e = r / 128, q = r % 128, kb = q / 32, nb = q % 32; transpose_tile(w_ed + (size_t)e * DEXP * D, D, 64 * kb, 32 * nb, WE2 + (size_t)e * D * DEXP, DEXP, 32 * nb, 64 * kb, scr, lane); }
        }
        const float* w_rg = KIN(26); const float* w_re = KIN(28); bf16* WR = WSP(bf16, WS_WR);
        for (int idx = gt; idx < 2 * 64 * 128; idx += NGT) {
            const int k0 = (idx & 127) * 8, n = (idx >> 7) & 63, part = idx >> 13;
            unsigned w[4] = {0u, 0u, 0u, 0u};
            if (n < 36) {
                float hv[8];
#pragma unroll
                for (int i = 0; i < 8; ++i) { const float f = (n < 4) ? w_rg[(size_t)(k0 + i) * 4 + n] : w_re[(size_t)(k0 + i) * NEXP + (n - 4)]; const float h = bf2f(f2bf(f)); hv[i] = part ? (f - h) : h; }
#pragma unroll
                for (int i = 0; i < 4; ++i) w[i] = pk2(hv[2 * i], hv[2 * i + 1]);
            }
            *(GAS v4u*)(WR + (size_t)(part * 64 + n) * D + k0) = (v4u){w[0], w[1], w[2], w[3]};
        }
        const float* log_dt = KIN(14); const float* a_re = KIN(7); const float* a_im = KIN(8); const float* sb_re = KIN(9); const float* sb_im = KIN(10);
        float* Ere = WSP(float, WS_ETAB); float* Eim = Ere + NG * LC * NP * 16;
        for (int idx = gt; idx < NG * LC * NP; idx += NGT) {
            const int p = idx % NP, j = (idx / NP) % LC, g = idx / (NP * LC);
            const float dt = expf(log_dt[g]), lr = a_re[g * NP + p], li = a_im[g * NP + p];
            float ar, ai; abar_pow(lr, li, dt, 1.0f, ar, ai);
            const float den = lr * lr + li * li, nr = ar - 1.0f;
            const float fre = (nr * lr + ai * li) / den, fim = (ai * lr - nr * li) / den;
            float pr, pi; abar_pow(lr, li, dt, (float)j, pr, pi);
            const float gr = pr * fre - pi * fim, gi = pr * fim + pi * fre;
            const float* br = sb_re + (size_t)(g * NP + p) * 16; const float* bi = sb_im + (size_t)(g * NP + p) * 16;
            float* er = Ere + (size_t)((g * LC + j) * NP + p) * 16; float* ei = Eim + (size_t)((g * LC + j) * NP + p) * 16;
#pragma unroll
            for (int ci = 0; ci < 16; ++ci) { er[ci] = gr * br[ci] - gi * bi[ci]; ei[ci] = gr * bi[ci] + gi * br[ci]; }
        }
        {
            const float* cvec = KIN(1); const float* w_ada = KIN(2); const float* b_ada = KIN(3); float* MOD = WSP(float, WS_MOD);
            __syncthreads();
            LAS float* cs = (LAS float*)(L + RING_OFF);
            LAS float* red = (LAS float*)(L + RING_OFF + 32768);
            bool loaded = false;
            for (int it = vcu; it < 6 * D / 32; it += G) {
                if (!loaded) { __syncthreads(); for (int i = tid; i < NB * D; i += NWAVES * 64) { const float c = cvec[i]; cs[i] = c / (1.0f + expf(-c)); } __syncthreads(); loaded = true; }
                const int col = it * 32 + (lane & 31), ksub = (lane >> 5) + 2 * wave;
                float accb[NB];
#pragma unroll
                for (int b = 0; b < NB; ++b) accb[b] = 0.f;
#pragma unroll 8
                for (int i = 0; i < 64; ++i) { const int k = ksub + 16 * i; const float w = w_ada[(size_t)k * (6 * D) + col];
#pragma unroll
                    for (int b = 0; b < NB; ++b) accb[b] += cs[b * D + k] * w; }
#pragma unroll
                for (int b = 0; b < NB; ++b) red[(ksub * NB + b) * 32 + (lane & 31)] = accb[b];
                __syncthreads();
                if (tid < NB * 32) { const int b = tid >> 5, c = tid & 31; float s = 0.f;
#pragma unroll
                    for (int q = 0; q < 16; ++q) s += red[(q * NB + b) * 32 + c];
                    MOD[(size_t)b * 6 * D + it * 32 + c] = s + b_ada[it * 32 + c]; }
                __syncthreads();
            }
            __syncthreads();
        }
    }
    GRID_BAR();
#endif

#if DBG_STAGE != 1
    asm volatile("; PHASE_MARK P0b" ::: "memory");
    {
        PHASE_IDS();
        const float* x = KIN(0); const float* g_mix = KIN(4); const float* MOD = WSP(float, WS_MOD); bf16* UBUF = (bf16*)OUTP();
        const float* Ere = WSP(float, WS_ETAB); const float* Eim = Ere + NG * LC * NP * 16; bf16* BtY = WSP(bf16, WS_BTY); bf16* BtP = WSP(bf16, WS_BTP);
        const float* sc_re = KIN(11); const float* sc_im = KIN(12); const float* log_dt = KIN(14); const float* a_re = KIN(7); const float* a_im = KIN(8);
        for (int blk = gw; blk < T / 16; blk += NGW) {
            const int row0 = blk * 16, b = row0 / SEQ; const float* md = MOD + (size_t)b * 6 * D;
            f32x4 av[4], sv[4];
#pragma unroll
            for (int j = 0; j < 4; ++j) { const int c = 4 * lane + 256 * j; const f32x4 g = *(const f32x4*)(g_mix + c), sc = *(const f32x4*)(md + D + c); av[j] = g * (sc + 1.0f); sv[j] = *(const f32x4*)(md + c); }
            for (int r = 0; r < 16; ++r) {
                const float* xr = x + (size_t)(row0 + r) * D; f32x4 v[4]; float ss = 0.f;
#pragma unroll
                for (int j = 0; j < 4; ++j) { v[j] = *(const f32x4*)(xr + 4 * lane + 256 * j); ss += (v[j][0] * v[j][0] + v[j][1] * v[j][1]) + (v[j][2] * v[j][2] + v[j][3] * v[j][3]); }
                const float rstd = 1.0f / sqrtf(wave_sum(ss, lane) * (1.0f / D) + EPS);
                bf16* ur = UBUF + (size_t)(row0 + r) * D;
#pragma unroll
                for (int j = 0; j < 4; ++j) { const f32x4 o = v[j] * rstd * av[j] + sv[j]; *(GAS v2u*)(ur + 4 * lane + 256 * j) = (v2u){pk2(o[0], o[1]), pk2(o[2], o[3])}; }
            }
        }
        for (int idx = gt; idx < NG * LC * 16 * 2; idx += NGT) {
            const int cih = idx & 1, co = (idx >> 1) & 15, j = (idx >> 5) % LC, g = idx / (32 * LC);
            float kv[8];
#pragma unroll
            for (int i = 0; i < 8; ++i) kv[i] = 0.f;
            const float* er = Ere + (size_t)((g * LC + j) * NP) * 16 + cih * 8; const float* ei = Eim + (size_t)((g * LC + j) * NP) * 16 + cih * 8;
            const float* cr = sc_re + (size_t)(g * 16 + co) * NP; const float* ci_ = sc_im + (size_t)(g * 16 + co) * NP;
            for (int p = 0; p < NP; ++p) { const float c_r = cr[p], c_i = ci_[p]; const f32x4 e0 = *(const f32x4*)(er + p * 16), e1 = *(const f32x4*)(er + p * 16 + 4), f0 = *(const f32x4*)(ei + p * 16), f1 = *(const f32x4*)(ei + p * 16 + 4);
#pragma unroll
                for (int i = 0; i < 4; ++i) { kv[i] += c_r * e0[i] - c_i * f0[i]; kv[4 + i] += c_r * e1[i] - c_i * f1[i]; } }
            const v4u kw = (v4u){pk2(kv[0], kv[1]), pk2(kv[2], kv[3]), pk2(kv[4], kv[5]), pk2(kv[6], kv[7])};
            bf16* base = BtY + (size_t)g * 512 * KY;
            for (int t = j; t < LC; ++t) *(GAS v4u*)(base + (size_t)(t * 16 + co) * KY + (t - j) * 16 + cih * 8) = kw;
            if (j >= 1) for (int t = 0; t + j < LC; ++t) *(GAS v4u*)(base + (size_t)(t * 16 + co) * KY + (t + j) * 16 + cih * 8) = (v4u){0u, 0u, 0u, 0u};
        }
        for (int idx = gt; idx < NG * LC * NP; idx += NGT) {
            const int p = idx % NP, t = (idx / NP) % LC, g = idx / (NP * LC);
            const float dt = expf(log_dt[g]); float ar, ai; abar_pow(a_re[g * NP + p], a_im[g * NP + p], dt, (float)(t + 1), ar, ai);
#pragma unroll
            for (int co = 0; co < 16; ++co) { const float c_r = sc_re[(size_t)(g * 16 + co) * NP + p], c_i = sc_im[(size_t)(g * 16 + co) * NP + p];
                bf16* rowp = BtY + (size_t)(g * 512 + t * 16 + co) * KY;
                rowp[512 + p] = (bf16)f2bf(c_r * ar - c_i * ai); rowp[576 + p] = (bf16)f2bf(-(c_r * ai + c_i * ar)); }
        }
        for (int idx = gt; idx < NG * 128 * LC; idx += NGT) {
            const int s = idx % LC, nn = (idx / LC) % 128, g = idx / (LC * 128); const int p = nn & 63, im = nn >> 6;
            const float* src = (im ? Eim : Ere) + (size_t)((g * LC + (LC - 1 - s)) * NP + p) * 16;
            unsigned hw[8], lw[8];
#pragma unroll
            for (int i = 0; i < 8; ++i) { const float f0 = src[2 * i], f1 = src[2 * i + 1]; const unsigned h0 = f2bf(f0), h1 = f2bf(f1); hw[i] = h0 | (h1 << 16); lw[i] = pk2(f0 - bf2f(h0), f1 - bf2f(h1)); }
            bf16* d0 = BtP + (size_t)(g * 256 + nn) * KS + s * 16; bf16* d1 = BtP + (size_t)(g * 256 + 128 + nn) * KS + s * 16;
            *(GAS v4u*)d0 = (v4u){hw[0], hw[1], hw[2], hw[3]}; *(GAS v4u*)(d0 + 8) = (v4u){hw[4], hw[5], hw[6], hw[7]};
            *(GAS v4u*)d1 = (v4u){lw[0], lw[1], lw[2], lw[3]}; *(GAS v4u*)(d1 + 8) = (v4u){lw[4], lw[5], lw[6], lw[7]};
        }
    }
    GRID_BAR();

    asm volatile("; PHASE_MARK P1" ::: "memory");
    {
        PHASE_IDS();
        pg8::StaticOrder S; S.init(OUTP(), D, WSP(bf16, WS_WIN), D, T, INW, G, bx);
        pg8::EpiProj E{KIN(6), WSP(bf16, WS_UG), WSP(bf16, WS_Q), WSP(bf16, WS_K), WSP(bf16, WS_V), WSP(bf16, WS_GATES), attn_body::C2};
        pg8::gemm_phase<pg8::EpiProj, pg8::StaticOrder, true, true>(L + RING_OFF, D, D, D, S, E);
    }
    GRID_BAR();

    asm volatile("; PHASE_MARK P2" ::: "memory");
    {
        PHASE_IDS();
        pg8::GroupOrder S; S.init(WSP(bf16, WS_UG), KY, (size_t)NRC * KY * 2, WSP(bf16, WS_BTP), KS, (size_t)256 * KS * 2, NRC, 256, NG, G, bx);
        pg8::EpiStates E{WSP(float, WS_SLOC)};
        pg8::gemm_phase<pg8::EpiStates, pg8::GroupOrder, true, true>(L + RING_OFF, KS, KY, KS, S, E);
    }
    GRID_BAR();

    asm volatile("; PHASE_MARK P3" ::: "memory");
    {
        PHASE_IDS();
        const float* log_dt = KIN(14); const float* a_re = KIN(7); const float* a_im = KIN(8); const float* SLOC = WSP(float, WS_SLOC); bf16* UG = WSP(bf16, WS_UG);
        LAS float* seg = (LAS float*)(L + RING_OFF);
        for (int bg = vcu; bg < NB * NG; bg += G) {
            const int b = bg / NG, g = bg % NG, p = lane;
            const float dt = expf(log_dt[g]), lr = a_re[g * NP + p], li = a_im[g * NP + p];
            float alr, ali; abar_pow(lr, li, dt, (float)LC, alr, ali);
            constexpr int SEGC = NCH / NWAVES;
            float locr[SEGC], loci[SEGC]; float cr = 0.f, ci = 0.f;
            const float* sp = SLOC + ((size_t)(g * NRC + b * NCH + wave * SEGC)) * 128;
#pragma unroll
            for (int k = 0; k < SEGC; ++k) { locr[k] = cr; loci[k] = ci; const float sr = sp[k * 128 + p], si = sp[k * 128 + 64 + p]; const float nr = alr * cr - ali * ci + sr, ni = alr * ci + ali * cr + si; cr = nr; ci = ni; }
            __syncthreads();
            seg[(wave * 64 + p) * 2] = cr; seg[(wave * 64 + p) * 2 + 1] = ci;
            __syncthreads();
            float a16r = alr, a16i = ali;
#pragma unroll
            for (int q = 0; q < 4; ++q) { const float nr = a16r * a16r - a16i * a16i, ni = 2.f * a16r * a16i; a16r = nr; a16i = ni; }
            float inr = 0.f, ini = 0.f;
            for (int w = 0; w < wave; ++w) { const float er = seg[(w * 64 + p) * 2], ei = seg[(w * 64 + p) * 2 + 1]; const float nr = a16r * inr - a16i * ini + er, ni = a16r * ini + a16i * inr + ei; inr = nr; ini = ni; }
            bf16* up = UG + ((size_t)(g * NRC + b * NCH + wave * SEGC)) * KY + KS;
#pragma unroll
            for (int k = 0; k < SEGC; ++k) { up[(size_t)k * KY + p] = (bf16)f2bf(inr + locr[k]); up[(size_t)k * KY + 64 + p] = (bf16)f2bf(ini + loci[k]); const float nr = alr * inr - ali * ini, ni = alr * ini + ali * inr; inr = nr; ini = ni; }
        }
        __syncthreads();
        const char* wsb = (const char*)karg(35);
        const float* lq1 = KIN(17); const float* lk1 = KIN(18); const float* lq2 = KIN(19); const float* lk2 = KIN(20); const float* g_subln = KIN(21);
        const float lam = expf(wave_sum(lq1[lane] * lk1[lane], lane)) - expf(wave_sum(lq2[lane] * lk2[lane], lane)) + LAMBDA_INIT;
        LAS float* gsl = (LAS float*)(L + GS_OFF);
        if (tid < 128) gsl[tid] = g_subln[tid] * (1.0f - LAMBDA_INIT);
        __syncthreads();
        for (int un = vcu; un < NB * 8 * 4; un += G) {
            const int s4 = un & 3, h = (un >> 2) & 7, b = un >> 5;
#pragma unroll 1
            for (int i = 0; i < 4; ++i) { const int qb = (i == 0) ? 15 - s4 : (i == 1) ? 8 + s4 : (i == 2) ? 7 - s4 : s4;
                attn_body::attn_unit<8, 40, WS_Q, WS_K, WS_V, GS_OFF - RING_OFF>(b, h, qb, wsb, (attn_body::bf16*)OUTP(), lam, (char*)lds + RING_OFF); }
        }
    }
    GRID_BAR();

    asm volatile("; PHASE_MARK P4" ::: "memory");
    {
        PHASE_IDS();
        pg8::GroupOrder S; S.init(WSP(bf16, WS_UG), KY, (size_t)NRC * KY * 2, WSP(bf16, WS_BTY), KY, (size_t)512 * KY * 2, NRC, 512, NG, G, bx);
        pg8::EpiY E{WSP(bf16, WS_UG), KIN(13), WSP(bf16, WS_YACT)};
        pg8::gemm_phase<pg8::EpiY, pg8::GroupOrder, true, true>(L + RING_OFF, KY, KY, KY, S, E);
    }
    GRID_BAR();

    asm volatile("; PHASE_MARK P5" ::: "memory");
    {
        PHASE_IDS();
        pg8::StaticOrder S; S.init(WSP(bf16, WS_YACT), S5W, WSP(bf16, WS_WGLU), S5W, T, S5W, G, bx);
        pg8::EpiGlu E{WSP(bf16, WS_YACT), KIN(16), WSP(bf16, WS_S5O)};
        pg8::gemm_phase<pg8::EpiGlu, pg8::StaticOrder, true, true>(L + RING_OFF, S5W, S5W, S5W, S, E);
    }
    GRID_BAR();

    asm volatile("; PHASE_MARK P6" ::: "memory");
    {
        PHASE_IDS();
        pg8::StaticOrder S; S.init(WSP(bf16, WS_S5O), S5W, WSP(bf16, WS_WSSM), S5W, T, D, G, bx);
        pg8::EpiBranch<0> E{WSP(bf16, WS_GATES), nullptr, WSP(bf16, WS_TMP)};
        pg8::gemm_phase<pg8::EpiBranch<0>, pg8::StaticOrder, true, true>(L + RING_OFF, S5W, S5W, S5W, S, E);
    }
    VM_WAIT(); __syncthreads();
    {
        PHASE_IDS();
        pg8::StaticOrder S; S.init(OUTP(), D, WSP(bf16, WS_WATT), D, T, D, G, bx);
        pg8::EpiBranch<1> E{WSP(bf16, WS_GATES), WSP(bf16, WS_TMP), (bf16*)OUTP() + (size_t)T * D};
        pg8::gemm_phase<pg8::EpiBranch<1>, pg8::StaticOrder, true, true>(L + RING_OFF, D, D, D, S, E);
    }
    GRID_BAR();

    asm volatile("; PHASE_MARK P8" ::: "memory");
    {
        PHASE_IDS();
        pg8::StaticOrder S; S.init((bf16*)OUTP() + (size_t)T * D, D, WSP(bf16, WS_WOUT), D, T, D, G, bx);
        pg8::EpiOut E{KIN(0), WSP(float, WS_MOD), WSP(bf16, WS_H)};
        pg8::gemm_phase<pg8::EpiOut, pg8::StaticOrder, true, true>(L + RING_OFF, D, D, D, S, E);
    }
    GRID_BAR();
#endif

#if DBG_STAGE == 0
    asm volatile("; PHASE_MARK P9" ::: "memory");
    {
        PHASE_IDS();
        const float* g_ffn = KIN(25); const float* MOD = WSP(float, WS_MOD); const bf16* Hbuf = WSP(bf16, WS_H); bf16* U2 = (bf16*)OUTP();
        const bf16* WRh = WSP(bf16, WS_WR); const bf16* WRl = WRh + 64 * D;
        const float* b_rg = KIN(27); const float* b_re = KIN(29); int* CNT = WSP(int, WS_CTL) + CW_CNT; int* LIST = WSP(int, WS_LIST); float* CWL = WSP(float, WS_CWL);
        constexpr int APITCH = 1032;
        LAS bf16* AH = (LAS bf16*)(L + RING_OFF); LAS bf16* AL = AH + 16 * APITCH;
        LAS float* PART = (LAS float*)(L + RING_OFF + 2 * 16 * APITCH * 2);
        LAS float* LG = PART + 8 * 256;
        LAS int* lcnt = (LAS int*)(LG + 16 * 64); LAS int* lbase = lcnt + NEXP; LAS int* TOK = lbase + NEXP;
        const int per = T / G, t0 = bx * per, b = t0 / SEQ;
        const float* md = MOD + (size_t)b * 6 * D;
        f32x4 av[4], sv[4];
#pragma unroll
        for (int j = 0; j < 4; ++j) { const int c = 4 * lane + 256 * j; const f32x4 g = *(const f32x4*)(g_ffn + c), sc = *(const f32x4*)(md + 4 * D + c); av[j] = g * (sc + 1.0f); sv[j] = *(const f32x4*)(md + 3 * D + c); }
        const int cb = wave & 3, kh = wave >> 2, fr = lane & 15, fq = lane >> 4;
        pg8::bf16x8 bh[16], bl[16];
#pragma unroll
        for (int ks = 0; ks < 16; ++ks) { const size_t o = (size_t)(cb * 16 + fr) * D + kh * 512 + ks * 32 + fq * 8; bh[ks] = *(const pg8::bf16x8*)(WRh + o); bl[ks] = *(const pg8::bf16x8*)(WRl + o); }
        if (tid < NEXP) lcnt[tid] = 0;
        for (int c = 0; c < per / 16; ++c) {
#pragma unroll
            for (int rr = 0; rr < 2; ++rr) {
                const int r = 2 * wave + rr, tok = t0 + c * 16 + r;
                const bf16* hr = Hbuf + (size_t)tok * D; f32x4 v[4]; float ss = 0.f;
#pragma unroll
                for (int j = 0; j < 4; ++j) { const v2u hw = *(const GAS v2u*)(hr + 4 * lane + 256 * j); v[j] = (f32x4){pg8::bf_lo(hw.x), pg8::bf_hi(hw.x), pg8::bf_lo(hw.y), pg8::bf_hi(hw.y)}; ss += (v[j][0] * v[j][0] + v[j][1] * v[j][1]) + (v[j][2] * v[j][2] + v[j][3] * v[j][3]); }
                const float rstd = 1.0f / sqrtf(wave_sum(ss, lane) * (1.0f / D) + EPS);
                bf16* ur = U2 + (size_t)tok * D;
#pragma unroll
                for (int j = 0; j < 4; ++j) { const f32x4 o = v[j] * rstd * av[j] + sv[j];
                    const unsigned h0 = f2bf(o[0]), h1 = f2bf(o[1]), h2 = f2bf(o[2]), h3 = f2bf(o[3]);
                    const v2u hv = (v2u){h0 | (h1 << 16), h2 | (h3 << 16)}, lv = (v2u){pk2(o[0] - bf2f(h0), o[1] - bf2f(h1)), pk2(o[2] - bf2f(h2), o[3] - bf2f(h3))};
                    *(GAS v2u*)(ur + 4 * lane + 256 * j) = hv;
                    *(LAS v2u*)(AH + r * APITCH + 4 * lane + 256 * j) = hv; *(LAS v2u*)(AL + r * APITCH + 4 * lane + 256 * j) = lv; }
            }
            __syncthreads();
            { pg8::f32x4 acc = (pg8::f32x4){0.f, 0.f, 0.f, 0.f};
#pragma unroll
              for (int ks = 0; ks < 16; ++ks) { const int ko = fr * APITCH + kh * 512 + ks * 32 + fq * 8;
                  const pg8::bf16x8 ah = *(const LAS pg8::bf16x8*)(AH + ko), al = *(const LAS pg8::bf16x8*)(AL + ko);
                  acc = __builtin_amdgcn_mfma_f32_16x16x32_bf16(ah, bh[ks], acc, 0, 0, 0);
                  acc = __builtin_amdgcn_mfma_f32_16x16x32_bf16(al, bh[ks], acc, 0, 0, 0);
                  acc = __builtin_amdgcn_mfma_f32_16x16x32_bf16(ah, bl[ks], acc, 0, 0, 0); }
#pragma unroll
              for (int i = 0; i < 4; ++i) PART[wave * 256 + (fq * 4 + i) * 16 + fr] = acc[i]; }
            __syncthreads();
#pragma unroll
            for (int i = 0; i < 2; ++i) { const int o = tid * 2 + i, row = o >> 6, col = o & 63, cbb = col >> 4; LG[o] = PART[cbb * 256 + row * 16 + (col & 15)] + PART[(4 + cbb) * 256 + row * 16 + (col & 15)]; }
            __syncthreads();
            if (tid < 16) {
                const LAS float* lg = LG + tid * 64;
                float gl[4]; int gi = 0;
#pragma unroll
                for (int i = 0; i < 4; ++i) gl[i] = lg[i] + b_rg[i];
#pragma unroll
                for (int i = 1; i < 4; ++i) if (gl[i] > gl[gi]) gi = i;
                float gsum = 0.f;
#pragma unroll
                for (int i = 0; i < 4; ++i) gsum += expf(gl[i] - gl[gi]);
                const float gp = 1.0f / gsum;
                float el[8];
#pragma unroll
                for (int i = 0; i < 8; ++i) el[i] = lg[4 + gi * 8 + i] + b_re[gi * 8 + i];
                int i0 = 0;
#pragma unroll
                for (int i = 1; i < 8; ++i) if (el[i] > el[i0]) i0 = i;
                int i1 = (i0 == 0) ? 1 : 0;
#pragma unroll
                for (int i = 0; i < 8; ++i) if (i != i0 && el[i] > el[i1]) i1 = i;
                const float ex = expf(el[i1] - el[i0]);
                const float w0 = gp / (1.0f + ex), w1 = gp * ex / (1.0f + ex);
                const int e0 = gi * 8 + i0, e1 = gi * 8 + i1;
                const int p0 = atomicAdd((int*)(lds + ((char*)&lcnt[e0] - (char*)L)), 1), p1 = atomicAdd((int*)(lds + ((char*)&lcnt[e1] - (char*)L)), 1);
                LAS int* tk = TOK + (c * 16 + tid) * 6; tk[0] = e0; tk[1] = p0; tk[2] = __float_as_int(w0); tk[3] = e1; tk[4] = p1; tk[5] = __float_as_int(w1);
            }
        }
        __syncthreads();
        if (tid < NEXP) lbase[tid] = atomicAdd(&CNT[tid], lcnt[tid]);
        __syncthreads();
        if (tid < per) { const LAS int* tk = TOK + tid * 6; const int tok = t0 + tid;
            const size_t i0 = (size_t)tk[0] * T + lbase[tk[0]] + tk[1], i1 = (size_t)tk[3] * T + lbase[tk[3]] + tk[4];
            LIST[i0] = tok * 2; CWL[i0] = __int_as_float(tk[2]); LIST[i1] = tok * 2 + 1; CWL[i1] = __int_as_float(tk[5]); }
        __syncthreads();
    }
    GRID_BAR();

    asm volatile("; PHASE_MARK P13" ::: "memory");
    {
        PHASE_IDS();
        const int* CNT = WSP(int, WS_CTL) + CW_CNT; const int* LIST = WSP(int, WS_LIST);
        build_expert_table(L, CNT, tid);
        pg8::ExpertOrder S; S.init((const LAS int*)(L + ETAB_OFF), OUTP(), 0, WSP(bf16, WS_WE1), D, (size_t)512 * D * 2, 512, G, bx);
        LAS int* rowtab = (LAS int*)(L + ROWTAB_OFF);
        { pg8::Unit u;
#pragma unroll 1
          for (int i = 0; i < 4 && S.next(i, u); ++i) { const int n = CNT[u.g];
              for (int r = tid; r < 256; r += NWAVES * 64) { const int pos = u.lt * 256 + r; rowtab[i * 256 + r] = (pos < n) ? (LIST[(size_t)u.g * T + pos] >> 1) : 0; } }
          __syncthreads(); }
        pg8::EpiExp1 E{WSP(bf16, WS_HDN)};
        pg8::gemm_phase<pg8::EpiExp1, pg8::ExpertOrder, true, true, true>(L + RING_OFF, D, D, D, S, E, (const LAS int*)rowtab);
    }
    GRID_BAR();

    asm volatile("; PHASE_MARK P14" ::: "memory");
    {
        PHASE_IDS();
        build_expert_table(L, WSP(int, WS_CTL) + CW_CNT, tid);
        pg8::ExpertOrder S; S.init((const LAS int*)(L + ETAB_OFF), WSP(bf16, WS_HDN), (size_t)256 * DEXP * 2, WSP(bf16, WS_WE2), DEXP, (size_t)D * DEXP * 2, D, G, bx);
        pg8::EpiExp2 E{WSP(int, WS_LIST), WSP(float, WS_CWL), WSP(int, WS_CTL) + CW_CNT, WSP(bf16, WS_SLOTS)};
        pg8::gemm_phase<pg8::EpiExp2, pg8::ExpertOrder, true, true>(L + RING_OFF, DEXP, DEXP, DEXP, S, E);
    }
    GRID_BAR();
#endif

    asm volatile("; PHASE_MARK P15" ::: "memory");
    {
        PHASE_IDS();
        const float* x = KIN(0); const float* g_final = KIN(33); const bf16* Hbuf = WSP(bf16, WS_H); const float* MOD = WSP(float, WS_MOD); const bf16* SLOTS = WSP(bf16, WS_SLOTS); float* out = OUTP();
        (void)x; (void)Hbuf; (void)MOD; (void)SLOTS;
        for (int row = gw; row < T; row += NGW) {
            const int b = row / SEQ; f32x4 v[4]; float ss = 0.f;
#pragma unroll
            for (int j = 0; j < 4; ++j) { const int c = 4 * lane + 256 * j;
#if DBG_STAGE == 1
                v[j] = *(const f32x4*)(x + (size_t)row * D + c);
#else
                { const v2u hw = *(const GAS v2u*)(Hbuf + (size_t)row * D + c); v[j] = (f32x4){pg8::bf_lo(hw.x), pg8::bf_hi(hw.x), pg8::bf_lo(hw.y), pg8::bf_hi(hw.y)}; }
#endif
#if DBG_STAGE == 0
                const f32x4 gt = *(const f32x4*)(MOD + (size_t)b * 6 * D + 5 * D + c);
                const v2u s0 = *(const GAS v2u*)(SLOTS + (size_t)(2 * row) * D + c), s1 = *(const GAS v2u*)(SLOTS + (size_t)(2 * row + 1) * D + c);
                const f32x4 f = (f32x4){pg8::bf_lo(s0.x) + pg8::bf_lo(s1.x), pg8::bf_hi(s0.x) + pg8::bf_hi(s1.x), pg8::bf_lo(s0.y) + pg8::bf_lo(s1.y), pg8::bf_hi(s0.y) + pg8::bf_hi(s1.y)};
                v[j] = v[j] + gt * f;
#endif
                ss += (v[j][0] * v[j][0] + v[j][1] * v[j][1]) + (v[j][2] * v[j][2] + v[j][3] * v[j][3]); }
            (void)b;
            const float rstd = 1.0f / sqrtf(wave_sum(ss, lane) * (1.0f / D) + EPS);
#pragma unroll
            for (int j = 0; j < 4; ++j) { const int c = 4 * lane + 256 * j; const f32x4 g = *(const f32x4*)(g_final + c); *(f32x4*)(out + (size_t)row * D + c) = v[j] * rstd * g; }
        }
    }
}

extern "C" void kernel_launch(void* const* d_in, const int* in_sizes, int n_in, void* d_out, int out_size, void* d_ws, size_t ws_size, hipStream_t stream) {
    static int grid = 0;
    if (grid == 0) {
        if (n_in != 34 || out_size != T * D || ws_size < WS_END) { fprintf(stderr, "kernel_launch: unexpected shapes (n_in %d, out %d, ws %zu)\n", n_in, out_size, ws_size); grid = -1; return; }
        int dev = 0, cus = 0, per_cu = 0;
        if (hipGetDevice(&dev) != hipSuccess || hipDeviceGetAttribute(&cus, hipDeviceAttributeMultiprocessorCount, dev) != hipSuccess) { grid = -1; return; }
        if (hipFuncSetAttribute((const void*)fwd_kernel, hipFuncAttributeMaxDynamicSharedMemorySize, LDS_BYTES) != hipSuccess) { fprintf(stderr, "kernel_launch: hipFuncSetAttribute failed\n"); grid = -1; return; }
        if (hipOccupancyMaxActiveBlocksPerMultiprocessor(&per_cu, (const void*)fwd_kernel, NWAVES * 64, LDS_BYTES) != hipSuccess || per_cu < 1)
            fprintf(stderr, "kernel_launch: note: occupancy query reports %d workgroups per CU\n", per_cu);
        (void)hipGetLastError();
        grid = cus;
    }
    if (grid < 0) return;
    if (hipMemsetAsync((char*)d_ws + WS_CTL, 0, CTL_ZERO_BYTES, stream) != hipSuccess) { fprintf(stderr, "kernel_launch: memset failed\n"); return; }
    Args a{};
    for (int i = 0; i < 34; ++i) a.in[i] = (const float*)d_in[i];
    a.out = (float*)d_out; a.ws = (unsigned char*)d_ws;
    hipLaunchKernelGGL(fwd_kernel, dim3(grid), dim3(NWAVES * 64), LDS_BYTES, stream, a);
    const hipError_t le = hipPeekAtLastError();
    if (le != hipSuccess) fprintf(stderr, "kernel_launch: launch failed: %s\n", hipGetErrorName(le));
}
```

```cpp
#include <hip/hip_runtime.h>
#include <hip/hip_bf16.h>
#include <cstdio>
#include <cstdint>
#include <cmath>

#ifndef DBG_STAGE
#define DBG_STAGE 0
#endif

constexpr int D = 1024, NB = 8, SEQ = 4096, T = NB * SEQ;
constexpr int S5W = 512, NG = 32, NP = 64, INW = 5632;
constexpr int LC = 32, NCH = SEQ / LC, NRC = T / LC, KS = LC * 16, KY = KS + 128;
constexpr int NEXP = 32, DEXP = 256;
constexpr int XS_ROWS = 2 * T + NEXP * 256;
constexpr float EPS = 1e-6f;
constexpr float LAMBDA_INIT = 0.2f;

namespace pg8 {
#define PG8_LAS __attribute__((address_space(3)))
typedef unsigned short bf16_t;
typedef short bf16x8 __attribute__((ext_vector_type(8)));
typedef float f32x4 __attribute__((ext_vector_type(4)));
typedef unsigned u32x4 __attribute__((ext_vector_type(4)));
typedef float f32x2 __attribute__((ext_vector_type(2)));
constexpr int BM = 256, BK = 64, HALF = 128, HTB = HALF * BK * 2, STAGE_BYTES = 8 * HTB, NXCD = 8, WGM = 8;

__host__ __device__ __forceinline__ int lds_byte(int r, int c) { const int st = (r >> 4) * 2 + (c >> 5), rr = r & 15, cc = c & 31, ob = rr * 64 + cc * 2; return st * 1024 + (ob ^ (((ob >> 9) & 1) << 5)); }
__host__ __device__ __forceinline__ void stage_rc(int b, int& R, int& C) { const int st = b / 1024, sb = b % 1024, swz = sb ^ (((sb >> 9) & 1) << 5); R = (st >> 1) * 16 + swz / 64; C = (st & 1) * 32 + (swz % 64) / 2; }
__host__ __device__ __forceinline__ int perm32(int rho) { const int n = rho >> 4, i = rho & 15; return 8 * (i >> 2) + 4 * n + (i & 3); }

struct Unit { int pm, pn, g, lt; const char* a; const char* b; };

struct StaticOrder {
    int nM, nN, nwg, G, c; const char* A; const char* B; size_t tsa, tsb;
    __device__ void init(const void* A_, int lda, const void* B_, int ldb, int M, int N, int G_, int c_) { nM = M / BM; nN = N / BM; nwg = nM * nN; G = G_; c = c_; A = (const char*)A_; B = (const char*)B_; tsa = (size_t)BM * lda * 2; tsb = (size_t)BM * ldb * 2; }
    __device__ bool next(int i, Unit& u) const {
        const long L = (long)i * G + c; if (L >= nwg) return false;
        int wgid = (int)L; { const int q = nwg / NXCD, r = nwg % NXCD, xcd = wgid % NXCD, off = wgid / NXCD; wgid = (xcd < r ? xcd * (q + 1) : r * (q + 1) + (xcd - r) * q) + off; }
        const int nig = WGM * nN, gid = wgid / nig, fm = gid * WGM, gsz = (nM - fm) < WGM ? (nM - fm) : WGM;
        u.pm = fm + ((wgid % nig) % gsz); u.pn = (wgid % nig) / gsz; u.g = 0; u.lt = 0; u.a = A + (size_t)u.pm * tsa; u.b = B + (size_t)u.pn * tsb; return true;
    }
};
struct GroupOrder {
    int nM, nN, ng, G, c; const char* A; const char* B; size_t tsa, tsb, gsa, gsb;
    __device__ void init(const void* A_, int lda, size_t gsa_, const void* B_, int ldb, size_t gsb_, int Mg, int Ng, int ng_, int G_, int c_) {
        nM = Mg / BM; nN = Ng / BM; ng = ng_; G = G_; c = c_; A = (const char*)A_; B = (const char*)B_; tsa = (size_t)BM * lda * 2; tsb = (size_t)BM * ldb * 2; gsa = gsa_; gsb = gsb_; }
    __device__ bool next(int i, Unit& u) const {
        const int per = nM * nN, x = c % NXCD, j = c / NXCD + (G / NXCD) * i; if (j >= (ng / NXCD) * per) return false;
        const int g = x + NXCD * (j / per), r = j % per;
        u.g = g; u.lt = 0; u.pm = r / nN; u.pn = r % nN; u.a = A + (size_t)g * gsa + (size_t)u.pm * tsa; u.b = B + (size_t)g * gsb + (size_t)u.pn * tsb; return true;
    }
};
struct ExpertOrder {
    const PG8_LAS int* tab; int nN, G, c; const char* A; const char* B; size_t tsa, tsb, esb;
    __device__ void init(const PG8_LAS int* tab_, const void* A_, size_t tsa_, const void* B_, int ldb, size_t esb_, int N, int G_, int c_) {
        tab = tab_; nN = N / BM; G = G_; c = c_; A = (const char*)A_; B = (const char*)B_; tsa = tsa_; tsb = (size_t)BM * ldb * 2; esb = esb_; }
    __device__ bool next(int i, Unit& u) const {
        const int NT = __builtin_amdgcn_readfirstlane(tab[XS_ROWS / 256 + 1]);
        const int x = c % NXCD, j = c / NXCD + (G / NXCD) * i, lo = (x * NT) / NXCD, hi = ((x + 1) * NT) / NXCD;
        const int rt = lo + j / nN, pn = j % nN;
        if (rt >= hi) return false;
        const int e = __builtin_amdgcn_readfirstlane(tab[rt]);
        u.g = e & 255; u.lt = e >> 8; u.pm = rt; u.pn = pn; u.a = A + (size_t)rt * tsa; u.b = B + (size_t)u.g * esb + (size_t)pn * tsb; return true;
    }
};

__device__ __forceinline__ unsigned cvt_pk_bf16(float lo, float hi) { unsigned r; asm volatile("v_cvt_pk_bf16_f32 %0, %1, %2" : "=v"(r) : "v"(lo), "v"(hi)); return r; }
__device__ __forceinline__ float bf_lo(unsigned w) { return __uint_as_float(w << 16); }
__device__ __forceinline__ float bf_hi(unsigned w) { return __uint_as_float(w & 0xffff0000u); }
__device__ __forceinline__ float sigmoidf_(float x) { return __builtin_amdgcn_rcpf(1.0f + __builtin_amdgcn_exp2f(-1.4426950408889634f * x)); }
__device__ __forceinline__ void unpack8(const u32x4 w, float (&f)[8]) { f[0] = bf_lo(w.x); f[1] = bf_hi(w.x); f[2] = bf_lo(w.y); f[3] = bf_hi(w.y); f[4] = bf_lo(w.z); f[5] = bf_hi(w.z); f[6] = bf_lo(w.w); f[7] = bf_hi(w.w); }
__device__ __forceinline__ u32x4 pack8(const float (&f)[8]) { u32x4 w; w.x = cvt_pk_bf16(f[0], f[1]); w.y = cvt_pk_bf16(f[2], f[3]); w.z = cvt_pk_bf16(f[4], f[5]); w.w = cvt_pk_bf16(f[6], f[7]); return w; }

#define EPI_LOOP_PERM(...) \
    _Pragma("unroll") for (int ai = 0; ai < 2; ++ai) _Pragma("unroll") for (int m = 0; m < 4; ++m) { const int lrow = ai * HALF + wr * 64 + m * 16 + fr; \
        _Pragma("unroll") for (int bj = 0; bj < 2; ++bj) { const int lcol = bj * HALF + wc * 32 + 8 * fq; \
            float v[8] = {acc[ai][bj][m][0][0], acc[ai][bj][m][0][1], acc[ai][bj][m][0][2], acc[ai][bj][m][0][3], acc[ai][bj][m][1][0], acc[ai][bj][m][1][1], acc[ai][bj][m][1][2], acc[ai][bj][m][1][3]}; __VA_ARGS__ } }

#define EPI_HALF_PRE(...) _Pragma("unroll") for (int m = 0; m < 4; ++m) { const int lrow = ai * HALF + wr * 64 + m * 16 + fr; (void)lrow; \
        _Pragma("unroll") for (int bj = 0; bj < 2; ++bj) { const int lcol = bj * HALF + wc * 32 + 8 * fq; (void)lcol; __VA_ARGS__ } }
#define EPI_HALF_RUN(...) _Pragma("unroll") for (int m = 0; m < 4; ++m) { const int lrow = ai * HALF + wr * 64 + m * 16 + fr; (void)lrow; \
        _Pragma("unroll") for (int bj = 0; bj < 2; ++bj) { const int lcol = bj * HALF + wc * 32 + 8 * fq; (void)lcol; \
            float v[8] = {acc[ai][bj][m][0][0], acc[ai][bj][m][0][1], acc[ai][bj][m][0][2], acc[ai][bj][m][0][3], acc[ai][bj][m][1][0], acc[ai][bj][m][1][1], acc[ai][bj][m][1][2], acc[ai][bj][m][1][3]}; __VA_ARGS__ } }

struct EpiProj {
    static constexpr bool PERM = true, AFTER_DRAIN = false;
    const float* bias; bf16_t* U; bf16_t* Q; bf16_t* Kb; bf16_t* V; bf16_t* Gt; float c2;
    __device__ __forceinline__ void operator()(const f32x4 (&acc)[2][2][4][2], const Unit& u, int wr, int wc, int fr, int fq) const {
        const int ct = u.pn;
        f32x4 bv[2][2];
#pragma unroll
        for (int bj = 0; bj < 2; ++bj) { const int col = ct * BM + bj * HALF + wc * 32 + 8 * fq; bv[bj][0] = *(const f32x4*)(bias + col); bv[bj][1] = *(const f32x4*)(bias + col + 4); }
        EPI_LOOP_PERM({
            const int row = u.pm * BM + lrow, col = ct * BM + lcol;
            v[0] += bv[bj][0][0]; v[1] += bv[bj][0][1]; v[2] += bv[bj][0][2]; v[3] += bv[bj][0][3]; v[4] += bv[bj][1][0]; v[5] += bv[bj][1][1]; v[6] += bv[bj][1][2]; v[7] += bv[bj][1][3];
            bf16_t* dst;
            if (ct < 2) { const int g = col >> 4, ci = col & 15, rc = row / LC, s = row % LC; dst = U + ((size_t)(g * NRC + rc) * KY + s * 16 + ci); }
            else if (ct < 6) { _Pragma("unroll") for (int i = 0; i < 8; ++i) v[i] *= c2; dst = Q + (size_t)row * D + (col - 512); }
            else if (ct < 10) { dst = Kb + (size_t)row * D + (col - 1536); }
            else if (ct < 14) { dst = V + (size_t)row * D + (col - 2560); }
            else { _Pragma("unroll") for (int i = 0; i < 8; ++i) v[i] = sigmoidf_(v[i]); dst = Gt + (size_t)row * 2048 + (col - 3584); }
            *(u32x4*)dst = pack8(v);
        })
    }
};
struct EpiStates {
    static constexpr bool PERM = false, AFTER_DRAIN = false;
    float* S;
    __device__ __forceinline__ void operator()(const f32x4 (&acc)[2][2][4][2], const Unit& u, int wr, int wc, int fr, int fq) const {
#pragma unroll
        for (int ai = 0; ai < 2; ++ai)
#pragma unroll
            for (int m = 0; m < 4; ++m) { const int row = u.pm * BM + ai * HALF + wr * 64 + m * 16 + fr;
#pragma unroll
                for (int n = 0; n < 2; ++n) { const f32x4 v = acc[ai][0][m][n] + acc[ai][1][m][n]; *(f32x4*)(S + ((size_t)(u.g * NRC + row) * 128 + wc * 32 + 16 * n + 4 * fq)) = v; } }
    }
};
struct EpiY {
    static constexpr bool PERM = true, AFTER_DRAIN = false;
    const bf16_t* U; const float* dskip; bf16_t* Y;
    __device__ __forceinline__ void operator()(const f32x4 (&acc)[2][2][4][2], const Unit& u, int wr, int wc, int fr, int fq) const {
        f32x4 dk[2][2];
#pragma unroll
        for (int bj = 0; bj < 2; ++bj) { const int co = (bj * HALF + wc * 32 + 8 * fq) & 15; dk[bj][0] = *(const f32x4*)(dskip + u.g * 16 + co); dk[bj][1] = *(const f32x4*)(dskip + u.g * 16 + co + 4); }
#pragma unroll
        for (int ai = 0; ai < 2; ++ai) {
            u32x4 uw[4][2];
            EPI_HALF_PRE({ const int rc = u.pm * BM + lrow, n = u.pn * BM + lcol; uw[m][bj] = *(const u32x4*)(U + ((size_t)(u.g * NRC + rc) * KY + n)); })
            EPI_HALF_RUN({
                const int rc = u.pm * BM + lrow, n = u.pn * BM + lcol, tt = n >> 4, co = n & 15;
                float uf[8]; unpack8(uw[m][bj], uf);
                const float dd[8] = {dk[bj][0][0], dk[bj][0][1], dk[bj][0][2], dk[bj][0][3], dk[bj][1][0], dk[bj][1][1], dk[bj][1][2], dk[bj][1][3]};
                _Pragma("unroll") for (int i = 0; i < 8; ++i) { const float y = v[i] + dd[i] * uf[i]; const float z = 1.5957691216057308f * (y + 0.044715f * y * y * y); v[i] = y * sigmoidf_(z); }
                *(u32x4*)(Y + ((size_t)(rc * LC + tt) * S5W + u.g * 16 + co)) = pack8(v);
            })
        }
    }
};
struct EpiGlu {
    static constexpr bool PERM = true, AFTER_DRAIN = false;
    const bf16_t* Y; const float* bias; bf16_t* O;
    __device__ __forceinline__ void operator()(const f32x4 (&acc)[2][2][4][2], const Unit& u, int wr, int wc, int fr, int fq) const {
        f32x4 bv[2][2];
#pragma unroll
        for (int bj = 0; bj < 2; ++bj) { const int col = u.pn * BM + bj * HALF + wc * 32 + 8 * fq; bv[bj][0] = *(const f32x4*)(bias + col); bv[bj][1] = *(const f32x4*)(bias + col + 4); }
#pragma unroll
        for (int ai = 0; ai < 2; ++ai) {
            u32x4 yw[4][2];
            EPI_HALF_PRE({ const int row = u.pm * BM + lrow, col = u.pn * BM + lcol; yw[m][bj] = *(const u32x4*)(Y + (size_t)row * S5W + col); })
            EPI_HALF_RUN({
                const int row = u.pm * BM + lrow, col = u.pn * BM + lcol;
                float yf[8]; unpack8(yw[m][bj], yf);
                const float bb[8] = {bv[bj][0][0], bv[bj][0][1], bv[bj][0][2], bv[bj][0][3], bv[bj][1][0], bv[bj][1][1], bv[bj][1][2], bv[bj][1][3]};
                _Pragma("unroll") for (int i = 0; i < 8; ++i) v[i] = yf[i] * sigmoidf_(v[i] + bb[i]);
                *(u32x4*)(O + (size_t)row * S5W + col) = pack8(v);
            })
        }
    }
};
template <int MODE> struct EpiBranch {
    static constexpr bool PERM = true, AFTER_DRAIN = false;
    const bf16_t* Gt; const bf16_t* Tin; bf16_t* O;
    __device__ __forceinline__ void operator()(const f32x4 (&acc)[2][2][4][2], const Unit& u, int wr, int wc, int fr, int fq) const {
#pragma unroll
        for (int ai = 0; ai < 2; ++ai) {
            u32x4 gw[4][2], tw[4][2];
            EPI_HALF_PRE({ const int row = u.pm * BM + lrow, col = u.pn * BM + lcol; gw[m][bj] = *(const u32x4*)(Gt + (size_t)row * 2048 + MODE * D + col);
                           if (MODE == 1) tw[m][bj] = *(const u32x4*)(Tin + (size_t)row * D + col); else tw[m][bj] = gw[m][bj]; })
            EPI_HALF_RUN({
                const int row = u.pm * BM + lrow, col = u.pn * BM + lcol;
                float gf[8]; unpack8(gw[m][bj], gf);
                if (MODE == 1) { float tf[8]; unpack8(tw[m][bj], tf);
                    _Pragma("unroll") for (int i = 0; i < 8; ++i) v[i] = tf[i] + gf[i] * v[i]; }
                else { _Pragma("unroll") for (int i = 0; i < 8; ++i) v[i] = gf[i] * v[i]; }
                *(u32x4*)(O + (size_t)row * D + col) = pack8(v);
            })
        }
    }
};
struct EpiOut {
    static constexpr bool PERM = true, AFTER_DRAIN = false;
    const float* x; const float* mod; bf16_t* H;
    __device__ __forceinline__ void operator()(const f32x4 (&acc)[2][2][4][2], const Unit& u, int wr, int wc, int fr, int fq) const {
        const int b = (u.pm * BM) / SEQ; const float* gt = mod + (size_t)b * 6 * D + 2 * D;
        f32x4 gv[2][2];
#pragma unroll
        for (int bj = 0; bj < 2; ++bj) { const int col = u.pn * BM + bj * HALF + wc * 32 + 8 * fq; gv[bj][0] = *(const f32x4*)(gt + col); gv[bj][1] = *(const f32x4*)(gt + col + 4); }
#pragma unroll
        for (int ai = 0; ai < 2; ++ai) {
            f32x4 xv[4][2][2];
            EPI_HALF_PRE({ const size_t off = (size_t)(u.pm * BM + lrow) * D + u.pn * BM + lcol; xv[m][bj][0] = *(const f32x4*)(x + off); xv[m][bj][1] = *(const f32x4*)(x + off + 4); })
            EPI_HALF_RUN({
                const size_t off = (size_t)(u.pm * BM + lrow) * D + u.pn * BM + lcol;
                _Pragma("unroll") for (int i = 0; i < 4; ++i) { v[i] = xv[m][bj][0][i] + gv[bj][0][i] * v[i]; v[4 + i] = xv[m][bj][1][i] + gv[bj][1][i] * v[4 + i]; }
                *(u32x4*)(H + off) = pack8(v);
            })
        }
    }
};
struct EpiRouter {
    static constexpr bool PERM = false, AFTER_DRAIN = false;
    float* L;
    __device__ __forceinline__ void operator()(const f32x4 (&acc)[2][2][4][2], const Unit& u, int wr, int wc, int fr, int fq) const {
        if (wc < 2) {
#pragma unroll
            for (int ai = 0; ai < 2; ++ai)
#pragma unroll
                for (int m = 0; m < 4; ++m) { const int row = u.pm * BM + ai * HALF + wr * 64 + m * 16 + fr;
#pragma unroll
                    for (int n = 0; n < 2; ++n) { const f32x4 v = acc[ai][0][m][n] + acc[ai][1][m][n]; *(f32x4*)(L + (size_t)row * 64 + wc * 32 + 16 * n + 4 * fq) = v; } }
        }
    }
};
struct EpiExp1 {
    static constexpr bool PERM = true, AFTER_DRAIN = false;
    bf16_t* Hd;
    __device__ __forceinline__ void operator()(const f32x4 (&acc)[2][2][4][2], const Unit& u, int wr, int wc, int fr, int fq) const {
#pragma unroll
        for (int ai = 0; ai < 2; ++ai)
#pragma unroll
            for (int m = 0; m < 4; ++m) { const int row = u.pm * BM + ai * HALF + wr * 64 + m * 16 + fr; float v[8];
#pragma unroll
                for (int n = 0; n < 2; ++n)
#pragma unroll
                    for (int i = 0; i < 4; ++i) { const float g = acc[ai][0][m][n][i], up = acc[ai][1][m][n][i]; v[n * 4 + i] = g * sigmoidf_(g) * up; }
                *(u32x4*)(Hd + (size_t)row * DEXP + u.pn * HALF + wc * 32 + 8 * fq) = pack8(v); }
    }
};
struct EpiExp2 {
    static constexpr bool PERM = true, AFTER_DRAIN = false;
    const int* list; const float* cwl; const int* cnt; bf16_t* Sl;
    __device__ __forceinline__ void operator()(const f32x4 (&acc)[2][2][4][2], const Unit& u, int wr, int wc, int fr, int fq) const {
        const int n = cnt[u.g];
#pragma unroll
        for (int ai = 0; ai < 2; ++ai) {
            int dd[4]; float ww[4];
#pragma unroll
            for (int m = 0; m < 4; ++m) { const int pos = u.lt * BM + ai * HALF + wr * 64 + m * 16 + fr; const bool ok = pos < n; const size_t li = (size_t)u.g * T + (ok ? pos : 0);
                const int d = list[li]; const float w = cwl[li]; dd[m] = ok ? d : -1; ww[m] = w; }
            EPI_HALF_RUN({
                const int col = u.pn * BM + lcol; const int d = dd[m]; const float w = ww[m];
                if (d >= 0) { _Pragma("unroll") for (int i = 0; i < 8; ++i) v[i] *= w; *(u32x4*)(Sl + (size_t)d * D + col) = pack8(v); }
            })
        }
    }
};

template <class Epi, class Sched, bool ALIGN_EPI = false, bool SP2 = false, bool GATHER = false>
__device__ __forceinline__ void gemm_phase(PG8_LAS unsigned char* lds, const int K, const int lda, const int ldb, const Sched& S, const Epi& E, const PG8_LAS int* rowtab = nullptr) {
    int tid = threadIdx.x; asm volatile("" : "+v"(tid));
    const int wid = __builtin_amdgcn_readfirstlane(tid >> 6), lane = tid & 63, wr = wid >> 2, wc = wid & 3, fr = lane & 15, fq = lane >> 4;
    const int nt = K / BK;
    unsigned voffA[2], voffB[2]; int gR[2]; unsigned gC[2];
#pragma unroll
    for (int i = 0; i < 2; ++i) { int R, C; stage_rc(tid * 16 + i * 8192, R, C); const int Rb = Epi::PERM ? ((R & ~31) + perm32(R & 31)) : R;
        voffA[i] = (unsigned)(R * lda + C) * 2u; voffB[i] = (unsigned)(Rb * ldb + C) * 2u; gR[i] = R; gC[i] = (unsigned)C * 2u; }
    unsigned vAc[2][2], vAn[2][2], vA2[2][2];
    (void)gR; (void)gC; (void)vAc; (void)vAn; (void)vA2;
#define PG8_GLOAD(dst, ui_) do { _Pragma("unroll") for (int _h = 0; _h < 2; ++_h) _Pragma("unroll") for (int _i = 0; _i < 2; ++_i) \
        dst[_h][_i] = (unsigned)rowtab[(ui_) * 256 + _h * HALF + gR[_i]] * (unsigned)(lda * 2) + gC[_i]; } while (0)
    const size_t kstep = (size_t)(BK * 2);
    const size_t hstepA = (size_t)HALF * lda * 2, hstepB = (size_t)HALF * ldb * 2;
    const unsigned ldsw = (unsigned)wid * 1024u;
    const int aoff = lds_byte(wr * 64 + fr, fq * 8), boff = lds_byte(wc * 32 + fr, fq * 8);
#define PG8_SA(b, h) (((b) * 2 + (h)) * HTB)
#define PG8_SB(b, h) ((4 + (b) * 2 + (h)) * HTB)
#define PG8_STAGE(bufoff, gbase, voff) do { _Pragma("unroll") for (int _i = 0; _i < 2; ++_i) \
        __builtin_amdgcn_global_load_lds((const unsigned*)((const char*)(gbase) + (voff)[_i]), (PG8_LAS unsigned*)(lds + (bufoff) + ldsw + _i * 8192), 16, 0, 0); } while (0)
#define PG8_STAGE_A(bufoff, gbase, h, vs) do { if constexpr (GATHER) { PG8_STAGE(bufoff, gbase, vs[h]); } else { PG8_STAGE(bufoff, (gbase) + (h) * hstepA, voffA); } } while (0)
#define PG8_LDA(dst, b, h) do { _Pragma("unroll") for (int m = 0; m < 4; ++m) _Pragma("unroll") for (int k = 0; k < 2; ++k) dst[m][k] = *(const PG8_LAS bf16x8*)(lds + PG8_SA(b, h) + aoff + m * 2048 + k * 1024); } while (0)
#define PG8_LDB(dst, b, h) do { _Pragma("unroll") for (int n = 0; n < 2; ++n) _Pragma("unroll") for (int k = 0; k < 2; ++k) dst[n][k] = *(const PG8_LAS bf16x8*)(lds + PG8_SB(b, h) + boff + n * 2048 + k * 1024); } while (0)
#define PG8_MMA(ai, bj, At, Bt) do { __builtin_amdgcn_s_setprio(1); _Pragma("unroll") for (int m = 0; m < 4; ++m) _Pragma("unroll") for (int n = 0; n < 2; ++n) _Pragma("unroll") for (int k = 0; k < 2; ++k) \
        acc[ai][bj][m][n] = __builtin_amdgcn_mfma_f32_16x16x32_bf16(Bt[n][k], At[m][k], acc[ai][bj][m][n], 0, 0, 0); __builtin_amdgcn_s_setprio(0); } while (0)
#define PG8_WAIT_V(n) asm volatile("s_waitcnt vmcnt(" #n ")" ::: "memory")
#define PG8_WAIT_L(n) asm volatile("s_waitcnt lgkmcnt(" #n ")" ::: "memory")
#define PG8_BAR __builtin_amdgcn_s_barrier()
#define PG8_SCHED __builtin_amdgcn_sched_barrier(0)
    Unit cur, nxt; int ui = 0;
    if (!S.next(0, cur)) return;
    f32x4 acc[2][2][4][2];
#pragma unroll
    for (int a = 0; a < 2; ++a)
#pragma unroll
        for (int b = 0; b < 2; ++b)
#pragma unroll
            for (int m = 0; m < 4; ++m)
#pragma unroll
                for (int n = 0; n < 2; ++n) acc[a][b][m][n] = (f32x4){0.f, 0.f, 0.f, 0.f};
    bf16x8 At[4][2], B0[2][2], B1[2][2];
    const char* cA = cur.a; const char* cB = cur.b;
    if constexpr (GATHER) { PG8_GLOAD(vAc, 0); }
    static_assert(SP2 || !GATHER, "GATHER is wired into the SP2 loop only");
    if constexpr (SP2) {
        PG8_STAGE(PG8_SB(0, 0), cB, voffB); PG8_STAGE(PG8_SB(0, 1), cB + hstepB, voffB); PG8_STAGE_A(PG8_SA(0, 0), cA, 0, vAc); PG8_STAGE_A(PG8_SA(0, 1), cA, 1, vAc);
        if (wr == 1) PG8_BAR;
        PG8_WAIT_V(2); PG8_BAR;
        PG8_STAGE(PG8_SB(1, 0), cB + kstep, voffB); PG8_STAGE_A(PG8_SA(1, 0), cA + kstep, 0, vAc); PG8_STAGE(PG8_SB(1, 1), cB + hstepB + kstep, voffB);
        PG8_WAIT_V(6); PG8_BAR;
    } else {
        PG8_STAGE(PG8_SB(0, 0), cB, voffB); PG8_STAGE(PG8_SA(0, 0), cA, voffA); PG8_STAGE(PG8_SB(0, 1), cB + hstepB, voffB); PG8_STAGE(PG8_SA(0, 1), cA + hstepA, voffA);
        if (wr == 1) PG8_BAR;
        PG8_WAIT_V(4); PG8_BAR;
        PG8_STAGE(PG8_SB(1, 0), cB + kstep, voffB); PG8_STAGE(PG8_SA(1, 0), cA + kstep, voffA); PG8_STAGE(PG8_SB(1, 1), cB + hstepB + kstep, voffB);
        PG8_WAIT_V(6); PG8_BAR;
    }
    for (;;) {
        const bool has_next = S.next(ui + 1, nxt);
        const char* nA = has_next ? nxt.a : cA; const char* nB = has_next ? nxt.b : cB;
        if constexpr (GATHER) { if (has_next) { PG8_GLOAD(vAn, ui + 1); } else {
            _Pragma("unroll") for (int _h = 0; _h < 2; ++_h) _Pragma("unroll") for (int _i = 0; _i < 2; ++_i) vAn[_h][_i] = vAc[_h][_i]; } }
        for (int t = 0; t < nt; t += 2) {
            const bool last = (t == nt - 2);
            if constexpr (GATHER) { _Pragma("unroll") for (int _h = 0; _h < 2; ++_h) _Pragma("unroll") for (int _i = 0; _i < 2; ++_i) vA2[_h][_i] = last ? vAn[_h][_i] : vAc[_h][_i]; }
            const char* a1 = cA + (size_t)(t + 1) * kstep;
            const char* a2 = last ? nA : cA + (size_t)(t + 2) * kstep; const char* b2 = last ? nB : cB + (size_t)(t + 2) * kstep;
            const char* a3 = a2 + kstep; const char* b3 = b2 + kstep;
            if constexpr (SP2) {
            PG8_LDB(B0, 0, 0); PG8_LDB(B1, 0, 1); PG8_SCHED; PG8_LDA(At, 0, 0); PG8_STAGE_A(PG8_SA(1, 1), a1, 1, vAc);
            PG8_WAIT_V(8); PG8_WAIT_L(0); PG8_BAR; PG8_MMA(0, 0, At, B0); PG8_MMA(0, 1, At, B1); PG8_BAR; PG8_SCHED;
            PG8_LDA(At, 0, 1); PG8_STAGE(PG8_SB(0, 0), b2, voffB); PG8_STAGE(PG8_SB(0, 1), b2 + hstepB, voffB); PG8_STAGE_A(PG8_SA(0, 0), a2, 0, vA2);
            PG8_WAIT_V(8); PG8_WAIT_L(0); PG8_BAR; PG8_MMA(1, 0, At, B0); PG8_MMA(1, 1, At, B1); PG8_BAR; PG8_SCHED;
            PG8_LDB(B0, 1, 0); PG8_LDB(B1, 1, 1); PG8_SCHED; PG8_LDA(At, 1, 0); PG8_STAGE_A(PG8_SA(0, 1), a2, 1, vA2);
            PG8_WAIT_V(8); PG8_WAIT_L(0); PG8_BAR; PG8_MMA(0, 0, At, B0); PG8_MMA(0, 1, At, B1); PG8_BAR; PG8_SCHED;
            PG8_LDA(At, 1, 1); PG8_STAGE(PG8_SB(1, 0), b3, voffB); PG8_STAGE(PG8_SB(1, 1), b3 + hstepB, voffB); PG8_STAGE_A(PG8_SA(1, 0), a3, 0, vA2);
            PG8_WAIT_V(8); PG8_WAIT_L(0); PG8_BAR; PG8_MMA(1, 0, At, B0); PG8_MMA(1, 1, At, B1); PG8_BAR; PG8_SCHED;
            } else {
            PG8_LDB(B0, 0, 0); PG8_SCHED; PG8_LDA(At, 0, 0); PG8_STAGE(PG8_SA(1, 1), a1 + hstepA, voffA);
            PG8_WAIT_L(8); PG8_BAR; PG8_WAIT_L(0); PG8_MMA(0, 0, At, B0); PG8_BAR; PG8_SCHED;
            PG8_LDB(B1, 0, 1); PG8_STAGE(PG8_SB(0, 0), b2, voffB);
            PG8_BAR; PG8_WAIT_L(0); PG8_MMA(0, 1, At, B1); PG8_BAR;
            PG8_LDA(At, 0, 1); PG8_STAGE(PG8_SA(0, 0), a2, voffA);
            PG8_BAR; PG8_WAIT_L(0); PG8_MMA(1, 0, At, B0); PG8_BAR; PG8_SCHED;
            PG8_STAGE(PG8_SB(0, 1), b2 + hstepB, voffB);
            PG8_WAIT_V(6); PG8_BAR; PG8_MMA(1, 1, At, B1); PG8_BAR;
            PG8_LDB(B0, 1, 0); PG8_SCHED; PG8_LDA(At, 1, 0); PG8_STAGE(PG8_SA(0, 1), a2 + hstepA, voffA);
            PG8_WAIT_L(8); PG8_BAR; PG8_WAIT_L(0); PG8_MMA(0, 0, At, B0); PG8_BAR; PG8_SCHED;
            PG8_LDB(B1, 1, 1); PG8_STAGE(PG8_SB(1, 0), b3, voffB);
            PG8_BAR; PG8_WAIT_L(0); PG8_MMA(0, 1, At, B1); PG8_BAR;
            PG8_LDA(At, 1, 1); PG8_STAGE(PG8_SA(1, 0), a3, voffA);
            PG8_BAR; PG8_WAIT_L(0); PG8_MMA(1, 0, At, B0); PG8_BAR; PG8_SCHED;
            PG8_STAGE(PG8_SB(1, 1), b3 + hstepB, voffB);
            PG8_WAIT_V(6); PG8_BAR; PG8_MMA(1, 1, At, B1); PG8_BAR;
            }
        }
        if constexpr (ALIGN_EPI) { if (wr == 0) PG8_BAR; }
        E(acc, cur, wr, wc, fr, fq);
        if (!has_next) break;
#pragma unroll
        for (int a = 0; a < 2; ++a)
#pragma unroll
            for (int b = 0; b < 2; ++b)
#pragma unroll
                for (int m = 0; m < 4; ++m)
#pragma unroll
                    for (int n = 0; n < 2; ++n) acc[a][b][m][n] = (f32x4){0.f, 0.f, 0.f, 0.f};
        cur = nxt; cA = nA; cB = nB; ++ui;
        if constexpr (GATHER) { _Pragma("unroll") for (int _h = 0; _h < 2; ++_h) _Pragma("unroll") for (int _i = 0; _i < 2; ++_i) vAc[_h][_i] = vAn[_h][_i]; }
        if constexpr (ALIGN_EPI) { if (wr == 1) PG8_BAR; }
    }
    PG8_WAIT_V(0);
    if constexpr (!ALIGN_EPI) { if (wr == 0) PG8_BAR; }
    PG8_BAR;
#undef PG8_SA
#undef PG8_SB
#undef PG8_STAGE
#undef PG8_STAGE_A
#undef PG8_GLOAD
#undef PG8_LDA
#undef PG8_LDB
#undef PG8_MMA
#undef PG8_WAIT_V
#undef PG8_WAIT_L
#undef PG8_BAR
#undef PG8_SCHED
}
}

namespace attn_body {
using bf16=__hip_bfloat16;
using bf16x8=__attribute__((ext_vector_type(8)))short;
using s16x4=__attribute__((ext_vector_type(4)))short;
using f32x16=__attribute__((ext_vector_type(16)))float;
using u32x4=__attribute__((ext_vector_type(4)))unsigned;
constexpr int NHEAD=16,SEQ=4096,D=64,DM=NHEAD*D;
constexpr int NW=8,QBLK=32,QB=QBLK*NW,KVBLK=64,NQB=SEQ/QB;
__device__ __forceinline__ int crow(int r,int hi){return (r&3)+8*(r>>2)+4*hi;}
#define SBAR() __builtin_amdgcn_sched_barrier(0)
__device__ __forceinline__ void cmask(f32x16&p0,f32x16&p1,int jb,int wid){
  const float NEG=-INFINITY;
  if(jb>(wid>>1)){
  #pragma unroll
  for(int r=0;r<16;++r){p0[r]=NEG;p1[r]=NEG;}}
}
constexpr int NSLOT=3, SLOTB=8192, VSLOTB=16384;
constexpr int LDS_K=0, LDS_V=NSLOT*SLOTB, LDS_WS=LDS_V+NSLOT*VSLOTB, LDS_OST=LDS_WS+NW*64*4, LDS_BYTES=LDS_OST+NW*8192;
constexpr float C2=0.125f*1.4426950408889634f;
__device__ __forceinline__ void glds16(const char*sbase,unsigned voff,unsigned lds_dst){unsigned keep;
  asm volatile("s_mov_b32 %0, m0\n\ts_mov_b32 m0, %2\n\ts_nop 0\n\tglobal_load_lds_dwordx4 %1, %3\n\ts_mov_b32 m0, %0":"=&s"(keep):"v"(voff),"s"(lds_dst),"s"(sbase):"memory");}
__device__ __forceinline__ float max3f(float a,float b,float c){float r;asm("v_max3_f32 %0, %1, %2, %3":"=v"(r):"v"(a),"v"(b),"v"(c));return r;}
__device__ __forceinline__ float max2f(float a,float b){float r;asm("v_max_f32_e32 %0, %1, %2":"=v"(r):"v"(a),"v"(b));return r;}
typedef float f32x2_t __attribute__((ext_vector_type(2))); typedef __bf16 bf16x2_t __attribute__((ext_vector_type(2)));
__device__ __forceinline__ unsigned cvtpk_s(float lo,float hi){f32x2_t v={lo,hi};bf16x2_t b=__builtin_convertvector(v,bf16x2_t);return __builtin_bit_cast(unsigned,b);}
#define WAIT_BAR(N) asm volatile("s_waitcnt vmcnt(" #N ") lgkmcnt(0)\n\ts_barrier":::"memory")

__device__ __forceinline__ void qkt(f32x16&p0,f32x16&p1,const char*Kslot,const bf16x8*qr,int r32,int hi){
  const char*kb=Kslot+hi*1024+r32*16; const f32x16 z=f32x16{};
  #pragma unroll
  for(int d0=0;d0<4;++d0){
    const bf16x8 b0=*reinterpret_cast<const bf16x8*>(kb+d0*2048);
    const bf16x8 b1=*reinterpret_cast<const bf16x8*>(kb+d0*2048+512);
    if(d0==0){p0=__builtin_amdgcn_mfma_f32_32x32x16_bf16(b0,qr[0],z,0,0,0);p1=__builtin_amdgcn_mfma_f32_32x32x16_bf16(b1,qr[0],z,0,0,0);}
    else{p0=__builtin_amdgcn_mfma_f32_32x32x16_bf16(b0,qr[d0],p0,0,0,0);p1=__builtin_amdgcn_mfma_f32_32x32x16_bf16(b1,qr[d0],p1,0,0,0);}}
}
typedef __attribute__((address_space(3))) const char* lds_cptr;
typedef short v4i16_t __attribute__((ext_vector_type(4)));
__device__ __forceinline__ void kload8(bf16x8*kf,lds_cptr kp){
  kf[0]=*(const __attribute__((address_space(3))) bf16x8*)(kp);      kf[1]=*(const __attribute__((address_space(3))) bf16x8*)(kp+512);
  kf[2]=*(const __attribute__((address_space(3))) bf16x8*)(kp+2048); kf[3]=*(const __attribute__((address_space(3))) bf16x8*)(kp+2560);
  kf[4]=*(const __attribute__((address_space(3))) bf16x8*)(kp+4096); kf[5]=*(const __attribute__((address_space(3))) bf16x8*)(kp+4608);
  kf[6]=*(const __attribute__((address_space(3))) bf16x8*)(kp+6144); kf[7]=*(const __attribute__((address_space(3))) bf16x8*)(kp+6656);
}
__device__ __forceinline__ void kload2(bf16x8*kf,lds_cptr kp,int j){ kf[2*j]=*(const __attribute__((address_space(3))) bf16x8*)(kp+j*2048); kf[2*j+1]=*(const __attribute__((address_space(3))) bf16x8*)(kp+j*2048+512); }
__device__ __forceinline__ s16x4 vtr(lds_cptr p){ return __builtin_bit_cast(s16x4,__builtin_amdgcn_ds_read_tr16_b64_v4i16((__attribute__((address_space(3))) v4i16_t*)p)); }
__device__ __forceinline__ float rowmax(const f32x16&p0,const f32x16&p1){
  float a=max3f(p0[0],p0[1],p1[0]),b=max3f(p0[2],p0[3],p1[1]);a=max3f(a,p1[2],p1[3]);
  #pragma unroll
  for(int r=4;r<16;r+=4){a=max3f(a,p0[r],p0[r+1]);b=max3f(b,p0[r+2],p0[r+3]);a=max3f(a,p1[r],p1[r+1]);b=max3f(b,p1[r+2],p1[r+3]);}
  const float m=max2f(a,b);
  auto rr=__builtin_amdgcn_permlane32_swap(__float_as_uint(m),__float_as_uint(m),false,false);
  return max2f(__uint_as_float(rr[0]),__uint_as_float(rr[1]));
}
__device__ __forceinline__ void pv(f32x16*o,int vb,bf16x8 pa0,bf16x8 pa1,bf16x8 pa2,bf16x8 pa3){
  #pragma unroll
  for(int d0=0;d0<4;++d0){s16x4 lo[4],hi[4];
    #pragma unroll
    for(int ks=0;ks<4;++ks){
      asm volatile("ds_read_b64_tr_b16 %0,%1 offset:%c2":"=&v"(lo[ks]):"v"(vb),"i"(d0*4096+ks*1024):"memory");
      asm volatile("ds_read_b64_tr_b16 %0,%1 offset:%c2":"=&v"(hi[ks]):"v"(vb),"i"(d0*4096+ks*1024+512):"memory");}
    asm volatile("s_waitcnt lgkmcnt(0)":::"memory");SBAR();
    #define PK(k) (bf16x8){lo[k][0],lo[k][1],lo[k][2],lo[k][3],hi[k][0],hi[k][1],hi[k][2],hi[k][3]}
    o[d0]=__builtin_amdgcn_mfma_f32_32x32x16_bf16(pa0,PK(0),o[d0],0,0,0);
    o[d0]=__builtin_amdgcn_mfma_f32_32x32x16_bf16(pa1,PK(1),o[d0],0,0,0);
    o[d0]=__builtin_amdgcn_mfma_f32_32x32x16_bf16(pa2,PK(2),o[d0],0,0,0);
    o[d0]=__builtin_amdgcn_mfma_f32_32x32x16_bf16(pa3,PK(3),o[d0],0,0,0);
    #undef PK
  }
}
template<int THRL,int FTHR,size_t OFF_Q,size_t OFF_K,size_t OFF_V,int GSO> __device__ __forceinline__ void attn_unit(int b,int h,int qb,const char*ws,bf16*AO,float lam,char*shm){
  const bf16*Q=(const bf16*)(ws+OFF_Q); const float*gs=(const float*)(shm+GSO);
  int tid=threadIdx.x; asm volatile("":"+v"(tid)); const int lane=tid&63,r32=lane&31,hi=lane>>5; const int wid=__builtin_amdgcn_readfirstlane(tid>>6);
  const long rowbase=(long)b*SEQ; const int q0=qb*QB;
  const unsigned lds0=(unsigned)(uintptr_t)shm;
  float*wsf=(float*)(shm+LDS_WS)+wid*64;
  bf16*stg=(bf16*)(shm+LDS_OST)+wid*4096;
  const unsigned kdst=lds0+LDS_K+wid*1024, vdst=lds0+LDS_V+wid*1024;
  const int vb0=(int)(lds0+LDS_V)+((lane>>4)&1)*32+(lane&3)*8+(4*hi+((lane&15)>>2))*64;
  const char*Kbase=shm+LDS_K;
  const lds_cptr shm3=(lds_cptr)shm; const lds_cptr kp0=shm3+LDS_K+hi*1024+r32*16; const lds_cptr vp0=shm3+LDS_V+((lane>>4)&1)*32+(lane&3)*8+(4*hi+((lane&15)>>2))*64;
  const int NT=(q0+QB)/KVBLK;
  const char*Vh=ws+OFF_V+(rowbase*DM+h*128)*2;
  const unsigned vsrc=(unsigned)(((16*(wid&3)+(lane>>2))*DM+(wid>>2)*32+(lane&3)*8)*2);
  #pragma unroll 1
  for(int mp=0;mp<2;++mp){
  const int hq=2*h+mp;
  const bf16*Qw=Q+(rowbase+q0+wid*QBLK)*DM+hq*D;
  const char*Kh=ws+OFF_K+(rowbase*DM+hq*D)*2;
  const unsigned ksrc=(unsigned)((lane*DM+wid*8)*2);
  bf16x8 kf[8];
  #define DMA_K(t,slot) glds16(Kh+(long)(t)*(KVBLK*DM*2),ksrc,(unsigned)__builtin_amdgcn_readfirstlane(kdst+(slot)))
  #define DMA_V(t,slot) do{ glds16(Vh+(long)(t)*(KVBLK*DM*2),vsrc,(unsigned)__builtin_amdgcn_readfirstlane(vdst+2*(slot))); glds16(Vh+(long)(t)*(KVBLK*DM*2)+128,vsrc,(unsigned)__builtin_amdgcn_readfirstlane(vdst+2*(slot)+8192)); }while(0)
  DMA_K(0,0);DMA_V(0,0);DMA_K(1,SLOTB);
  bf16x8 qr[4];
  #pragma unroll
  for(int d0=0;d0<4;++d0)qr[d0]=*reinterpret_cast<const bf16x8*>(&Qw[(long)r32*DM+d0*16+hi*8]);
  float mhat=0.f,l_reg=0.f;f32x16 o[4];o[0]=f32x16{};o[1]=f32x16{};o[2]=f32x16{};o[3]=f32x16{};
  #define CMASK(P0,P1,t) do{int jb_=(t)-(NT-4); if(jb_>=0)cmask(P0,P1,jb_,wid);}while(0)
  bool resc=false;
  #define RESC() do{ if(resc){ asm volatile("s_waitcnt lgkmcnt(0)":::"memory"); \
      _Pragma("unroll") for(int d_=0;d_<4;++d_) _Pragma("unroll") for(int r=0;r<16;++r)o[d_][r]*=wsf[crow(r,hi)]; } }while(0)
  f32x16 pA0,pA1,pB0,pB1;
  int sl_prev=0,sl_cur=0,sl_next=SLOTB;
  #define ROT() do{sl_prev=sl_cur;sl_cur=sl_next;sl_next=(sl_next==(NSLOT-1)*SLOTB)?0:sl_next+SLOTB;}while(0)
  DMA_K(2,2*SLOTB);
  WAIT_BAR(4);
  qkt(pA0,pA1,Kbase,qr,r32,hi);asm volatile("s_nop 15\n\ts_nop 7":"+v"(pA0),"+v"(pA1));CMASK(pA0,pA1,0);
  bool fastp;
  { const float rm=rowmax(pA0,pA1); fastp=!__any(__builtin_fabsf(rm)>(float)FTHR); mhat=fastp?0.f:rm; resc=false;
    _Pragma("unroll") for(int r=0;r<16;++r){pA0[r]=__builtin_amdgcn_exp2f(pA0[r]-mhat);pA1[r]=__builtin_amdgcn_exp2f(pA1[r]-mhat);} }
  WAIT_BAR(0);
  DMA_K(3,0);DMA_V(1,SLOTB);
  ROT();
  kload8(kf,kp0+sl_cur);
  WAIT_BAR(3);
  s16x4 vlo[8],vhi[8]; u32x4 pw0,pw1,pw2,pw3;
  #define PKW(P,B) cvtpk_s(P[B],P[B+1])
  #define PAF(k) __builtin_bit_cast(bf16x8,pw##k)
  #define VFR(i) (bf16x8){vlo[i][0],vlo[i][1],vlo[i][2],vlo[i][3],vhi[i][0],vhi[i][1],vhi[i][2],vhi[i][3]}
  #define PIN(x) asm volatile("":"+v"(x))
  #define MX3(a,b,c) __builtin_fmaxf(__builtin_fmaxf((a),(b)),(c))
  #define ZC (f32x16{})
  #define GAPA(MF,A0,A1,A2,A3,W0,W1,PW) do{ MF; sacc+=A0; sacc+=A1; sacc+=A2; sacc+=A3; PIN(sacc); W0; W1; PIN(PW); SBAR(); }while(0)
  #define EX0(v) __builtin_amdgcn_exp2f((v)-mhat)
  #define EX1(v) __builtin_amdgcn_exp2f(v)
  #define GAPB(F,MF,X,B) do{ MF; X[B]=EX##F(X[B]); X[B+1]=EX##F(X[B+1]); PIN(X); SBAR(); }while(0)
  #define VRD(i) do{ vlo[i]=vtr(vp_+(((i)>>2)*4096+((i)&3)*1024)); vhi[i]=vtr(vp_+(((i)>>2)*4096+((i)&3)*1024+512)); }while(0)
  #define VRD2(i) do{ vlo[i]=vtr(vp_+((2+((i)>>2))*4096+((i)&3)*1024)); vhi[i]=vtr(vp_+((2+((i)>>2))*4096+((i)&3)*1024+512)); SBAR(); }while(0)
  #define KRD(G,j) do{ if(G){ kload2(kf,kp0+sl_next,j); SBAR(); } }while(0)
  #define STEP(F,C0,C1,P0,P1,t,GK,GV,GL) do{ SBAR(); \
    const lds_cptr vp_=vp0+2*sl_prev; \
    VRD(0); SBAR(); float sacc=(P0[0]+P0[1]); \
    GAPA(C0=__builtin_amdgcn_mfma_f32_32x32x16_bf16(kf[0],qr[0],ZC,0,0,0), P0[2],P0[3],P0[4],P0[5],     pw0[0]=PKW(P0,0), pw0[1]=PKW(P0,2), pw0); \
    VRD(4); SBAR(); GAPA(C1=__builtin_amdgcn_mfma_f32_32x32x16_bf16(kf[1],qr[0],ZC,0,0,0), P0[6],P0[7],P0[8],P0[9],     pw0[2]=PKW(P0,4), pw0[3]=PKW(P0,6), pw0); \
    VRD(1); SBAR(); GAPA(C0=__builtin_amdgcn_mfma_f32_32x32x16_bf16(kf[2],qr[1],C0,0,0,0),   P0[10],P0[11],P0[12],P0[13], pw1[0]=PKW(P0,8), pw1[1]=PKW(P0,10), pw1); \
    VRD(5); SBAR(); GAPA(C1=__builtin_amdgcn_mfma_f32_32x32x16_bf16(kf[3],qr[1],C1,0,0,0),   P0[14],P0[15],P1[0],P1[1],   pw1[2]=PKW(P0,12),pw1[3]=PKW(P0,14), pw1); \
    VRD(2); SBAR(); GAPA(C0=__builtin_amdgcn_mfma_f32_32x32x16_bf16(kf[4],qr[2],C0,0,0,0),   P1[2],P1[3],P1[4],P1[5],     pw2[0]=PKW(P1,0), pw2[1]=PKW(P1,2), pw2); \
    VRD(6); SBAR(); GAPA(C1=__builtin_amdgcn_mfma_f32_32x32x16_bf16(kf[5],qr[2],C1,0,0,0),   P1[6],P1[7],P1[8],P1[9],     pw2[2]=PKW(P1,4), pw2[3]=PKW(P1,6), pw2); \
    VRD(3); SBAR(); GAPA(C0=__builtin_amdgcn_mfma_f32_32x32x16_bf16(kf[6],qr[3],C0,0,0,0),   P1[10],P1[11],P1[12],P1[13], pw3[0]=PKW(P1,8), pw3[1]=PKW(P1,10), pw3); \
    VRD(7); SBAR(); GAPA(C1=__builtin_amdgcn_mfma_f32_32x32x16_bf16(kf[7],qr[3],C1,0,0,0),   P1[14],P1[15],0.f,0.f,       pw3[2]=PKW(P1,12),pw3[3]=PKW(P1,14), pw3); \
    l_reg+=sacc; \
    if(GK){DMA_K((t)+3,sl_cur);} if(GV){DMA_V((t)+1,sl_next);} \
    CMASK(C0,C1,t); \
    { float a=MX3(C0[0],C0[1],C1[0]),b=MX3(C0[2],C0[3],C1[1]); a=MX3(a,C1[2],C1[3]); \
      _Pragma("unroll") for(int r=4;r<16;r+=4){a=MX3(a,C0[r],C0[r+1]);b=MX3(b,C0[r+2],C0[r+3]);a=MX3(a,C1[r],C1[r+1]);b=MX3(b,C1[r+2],C1[r+3]);} \
      float rm=__builtin_fmaxf(a,b); { auto rr=__builtin_amdgcn_permlane32_swap(__float_as_uint(rm),__float_as_uint(rm),false,false); rm=__builtin_fmaxf(__uint_as_float(rr[0]),__uint_as_float(rr[1])); } \
      rm-=mhat; resc=false; \
      if(__builtin_expect(__any(rm>(float)((F)?FTHR:THRL)),0)){ const float dl=__builtin_fmaxf(rm,0.f); mhat+=dl; \
        if(F){ fastp=false; _Pragma("unroll") for(int r=0;r<16;++r){C0[r]-=dl;C1[r]-=dl;} } \
        const float f=__builtin_amdgcn_exp2f(-dl); l_reg*=f; if(hi==0)wsf[r32]=f; resc=true; } } \
    SBAR(); \
    GAPB(F,o[0]=__builtin_amdgcn_mfma_f32_32x32x16_bf16(PAF(0),VFR(0),o[0],0,0,0), C0,0);  VRD2(0); \
    GAPB(F,o[1]=__builtin_amdgcn_mfma_f32_32x32x16_bf16(PAF(0),VFR(4),o[1],0,0,0), C0,2);  VRD2(4); \
    GAPB(F,o[0]=__builtin_amdgcn_mfma_f32_32x32x16_bf16(PAF(1),VFR(1),o[0],0,0,0), C0,4);  VRD2(1); \
    GAPB(F,o[1]=__builtin_amdgcn_mfma_f32_32x32x16_bf16(PAF(1),VFR(5),o[1],0,0,0), C0,6);  VRD2(5); \
    GAPB(F,o[0]=__builtin_amdgcn_mfma_f32_32x32x16_bf16(PAF(2),VFR(2),o[0],0,0,0), C0,8);  VRD2(2); \
    GAPB(F,o[1]=__builtin_amdgcn_mfma_f32_32x32x16_bf16(PAF(2),VFR(6),o[1],0,0,0), C0,10); VRD2(6); \
    GAPB(F,o[0]=__builtin_amdgcn_mfma_f32_32x32x16_bf16(PAF(3),VFR(3),o[0],0,0,0), C0,12); VRD2(3); \
    GAPB(F,o[1]=__builtin_amdgcn_mfma_f32_32x32x16_bf16(PAF(3),VFR(7),o[1],0,0,0), C0,14); VRD2(7); \
    KRD(GL,0); GAPB(F,o[2]=__builtin_amdgcn_mfma_f32_32x32x16_bf16(PAF(0),VFR(0),o[2],0,0,0), C1,0); \
    KRD(GL,1); GAPB(F,o[3]=__builtin_amdgcn_mfma_f32_32x32x16_bf16(PAF(0),VFR(4),o[3],0,0,0), C1,2); \
    KRD(GL,2); GAPB(F,o[2]=__builtin_amdgcn_mfma_f32_32x32x16_bf16(PAF(1),VFR(1),o[2],0,0,0), C1,4); \
    KRD(GL,3); GAPB(F,o[3]=__builtin_amdgcn_mfma_f32_32x32x16_bf16(PAF(1),VFR(5),o[3],0,0,0), C1,6); \
    GAPB(F,o[2]=__builtin_amdgcn_mfma_f32_32x32x16_bf16(PAF(2),VFR(2),o[2],0,0,0), C1,8); \
    GAPB(F,o[3]=__builtin_amdgcn_mfma_f32_32x32x16_bf16(PAF(2),VFR(6),o[3],0,0,0), C1,10); \
    GAPB(F,o[2]=__builtin_amdgcn_mfma_f32_32x32x16_bf16(PAF(3),VFR(3),o[2],0,0,0), C1,12); \
    GAPB(F,o[3]=__builtin_amdgcn_mfma_f32_32x32x16_bf16(PAF(3),VFR(7),o[3],0,0,0), C1,14); \
    }while(0)
  int t=1;
  #undef CMASK
  #define CMASK(P0,P1,t) do{}while(0)
  for(;fastp&&t+5<NT;t+=2){
    STEP(1,pB0,pB1,pA0,pA1,t,true,true,true);     WAIT_BAR(3); RESC(); ROT();
    STEP(1,pA0,pA1,pB0,pB1,t+1,true,true,true);   WAIT_BAR(3); RESC(); ROT();
  }
  for(;t+5<NT;t+=2){
    STEP(0,pB0,pB1,pA0,pA1,t,true,true,true);     WAIT_BAR(3); RESC(); ROT();
    STEP(0,pA0,pA1,pB0,pB1,t+1,true,true,true);   WAIT_BAR(3); RESC(); ROT();
  }
  #undef CMASK
  #define CMASK(P0,P1,t) do{int jb_=(t)-(NT-4); if(jb_>=0)cmask(P0,P1,jb_,wid);}while(0)
  #define ENDW(tt) do{ if((tt)+3<NT){WAIT_BAR(3);} else if((tt)+2<NT){WAIT_BAR(2);} else {WAIT_BAR(0);} }while(0)
  for(;t+1<NT;t+=2){
    STEP(0,pB0,pB1,pA0,pA1,t,(t+3<NT),(t+1<NT),(t+1<NT));       ENDW(t);   RESC(); ROT();
    STEP(0,pA0,pA1,pB0,pB1,t+1,(t+4<NT),(t+2<NT),(t+2<NT));     ENDW(t+1); RESC(); ROT();
  }
  STEP(0,pB0,pB1,pA0,pA1,NT-1,false,false,false); RESC();
  { float sacc=pB0[0]+pB0[1]; _Pragma("unroll") for(int r=2;r<16;++r)sacc+=pB0[r]; _Pragma("unroll") for(int r=0;r<16;++r)sacc+=pB1[r]; l_reg+=sacc;
    pw0=(u32x4){PKW(pB0,0),PKW(pB0,2),PKW(pB0,4),PKW(pB0,6)};pw1=(u32x4){PKW(pB0,8),PKW(pB0,10),PKW(pB0,12),PKW(pB0,14)};pw2=(u32x4){PKW(pB1,0),PKW(pB1,2),PKW(pB1,4),PKW(pB1,6)};pw3=(u32x4){PKW(pB1,8),PKW(pB1,10),PKW(pB1,12),PKW(pB1,14)};
    SBAR(); pv(o,vb0+2*sl_cur,PAF(0),PAF(1),PAF(2),PAF(3)); }
  #undef PKW
  #undef PAF
  #undef VFR
  #undef PIN
  #undef MX3
  #undef ZC
  #undef GAPA
  #undef GAPB
  #undef EX0
  #undef EX1
  #undef VRD
  #undef VRD2
  #undef KRD
  #undef STEP
  #undef ENDW
  #undef DMA_K
  #undef DMA_V
  #undef CMASK
  #undef RESC
  #undef ROT
  {auto rr=__builtin_amdgcn_permlane32_swap(__float_as_uint(l_reg),__float_as_uint(l_reg),false,false);l_reg=__uint_as_float(rr[0])+__uint_as_float(rr[1]);}
  if(hi==0)wsf[32+r32]=l_reg;asm volatile("s_waitcnt lgkmcnt(0)":::"memory");
  float rli[16];
  #pragma unroll
  for(int r=0;r<16;++r)rli[r]=__builtin_amdgcn_rcpf(wsf[32+crow(r,hi)]);
  if(mp==0){
    #pragma unroll
    for(int r=0;r<16;++r){const int orow=crow(r,hi);
      #pragma unroll
      for(int d0=0;d0<4;++d0)stg[orow*128+d0*32+r32]=__float2bfloat16(o[d0][r]*rli[r]);}
  } else {
    #pragma unroll
    for(int r=0;r<16;++r){const int orow=crow(r,hi);
      #pragma unroll
      for(int d0=0;d0<4;++d0){ const float c=__bfloat162float(stg[orow*128+d0*32+r32])-lam*(o[d0][r]*rli[r]); stg[orow*128+d0*32+r32]=__float2bfloat16(c);} }
    asm volatile("s_waitcnt lgkmcnt(0)":::"memory");
    const int row=lane>>1,hf=lane&1; float cv[64]; float ss=0.f;
    #pragma unroll
    for(int i=0;i<8;++i){ const u32x4 w=*(const u32x4*)(stg+row*128+hf*64+i*8);
      cv[8*i+0]=__uint_as_float(w.x<<16);cv[8*i+1]=__uint_as_float(w.x&0xffff0000u);cv[8*i+2]=__uint_as_float(w.y<<16);cv[8*i+3]=__uint_as_float(w.y&0xffff0000u);
      cv[8*i+4]=__uint_as_float(w.z<<16);cv[8*i+5]=__uint_as_float(w.z&0xffff0000u);cv[8*i+6]=__uint_as_float(w.w<<16);cv[8*i+7]=__uint_as_float(w.w&0xffff0000u); }
    #pragma unroll
    for(int i=0;i<64;++i)ss+=cv[i]*cv[i];
    ss+=__int_as_float(__builtin_amdgcn_ds_bpermute((lane^1)<<2,__float_as_int(ss)));
    const float rstd=1.0f/sqrtf(ss*(1.0f/128.0f)+1e-6f);
    bf16*Ow=AO+(rowbase+q0+wid*QBLK+row)*DM+h*128+hf*64;
    #pragma unroll
    for(int i=0;i<8;++i){ const float4 g0=*(const float4*)(gs+hf*64+i*8),g1=*(const float4*)(gs+hf*64+i*8+4); u32x4 w;
      w.x=cvtpk_s(cv[8*i+0]*rstd*g0.x,cv[8*i+1]*rstd*g0.y); w.y=cvtpk_s(cv[8*i+2]*rstd*g0.z,cv[8*i+3]*rstd*g0.w);
      w.z=cvtpk_s(cv[8*i+4]*rstd*g1.x,cv[8*i+5]*rstd*g1.y); w.w=cvtpk_s(cv[8*i+6]*rstd*g1.z,cv[8*i+7]*rstd*g1.w);
      *(u32x4*)(Ow+i*8)=w; }
  }
  asm volatile("s_waitcnt lgkmcnt(0)\n\ts_barrier":::"memory");
  }
}
constexpr int ATTN_LDS_BYTES=LDS_BYTES;
#undef SBAR
#undef WAIT_BAR
}

constexpr size_t MiB = 1u << 20;
constexpr size_t WS_CTL = 0, CTL_ZERO_BYTES = 1 * MiB;
constexpr size_t WS_WIN = 2 * MiB;
constexpr size_t WS_WGLU = 13 * MiB;
constexpr size_t WS_WSSM = 14 * MiB;
constexpr size_t WS_WATT = 15 * MiB;
constexpr size_t WS_WOUT = 17 * MiB;
constexpr size_t WS_WR = 19 * MiB;
constexpr size_t WS_BTP = 20 * MiB;
constexpr size_t WS_BTY = 28 * MiB;
constexpr size_t WS_WE1 = 48 * MiB;
constexpr size_t WS_WE2 = 80 * MiB;
constexpr size_t WS_ETAB = 96 * MiB;
constexpr size_t WS_MOD = 104 * MiB;
constexpr size_t WS_UG = 112 * MiB;
constexpr size_t WS_Q = 152 * MiB, WS_K = 216 * MiB, WS_V = 280 * MiB;
constexpr size_t WS_GATES = 344 * MiB;
constexpr size_t WS_SLOC = 472 * MiB;
constexpr size_t WS_YACT = 152 * MiB;
constexpr size_t WS_S5O = 184 * MiB;
constexpr size_t WS_TMP = 280 * MiB;
constexpr size_t WS_H = 344 * MiB;
constexpr size_t WS_HDN = 256 * MiB;
constexpr size_t WS_SLOTS = 112 * MiB;
constexpr size_t WS_LIST = 472 * MiB;
constexpr size_t WS_CWL = 476 * MiB;
constexpr size_t WS_END = 512 * MiB;
constexpr int CW_TMO = 0, CW_BAR = 4096, CW_CNT = 16384;

constexpr int NWAVES = 8;
constexpr int RING_OFF = 0, RING_BYTES = 147456;
constexpr int LDSCTL_OFF = RING_BYTES, MISC_OFF = LDSCTL_OFF + 320;
constexpr int GS_OFF = MISC_OFF + 2048;
constexpr int ROWTAB_OFF = LDSCTL_OFF + 4096;
constexpr int LDS_BYTES = RING_BYTES + 8192;
static_assert(attn_body::ATTN_LDS_BYTES <= RING_BYTES, "attention LDS");

#define GAS __attribute__((address_space(1)))
#define LAS __attribute__((address_space(3)))
typedef unsigned short bf16;
typedef unsigned v4u __attribute__((ext_vector_type(4)));
typedef unsigned v2u __attribute__((ext_vector_type(2)));
typedef float f32x4 __attribute__((ext_vector_type(4)));
typedef GAS unsigned gu32;
#define RLX_AGENT __ATOMIC_RELAXED, __HIP_MEMORY_SCOPE_AGENT
#define LDS_WAIT() asm volatile("s_waitcnt lgkmcnt(0)" ::: "memory")
#define VM_WAIT() asm volatile("s_waitcnt vmcnt(0)" ::: "memory")
__device__ __forceinline__ unsigned f2bf(float f) { unsigned u = __builtin_bit_cast(unsigned, f); return (u + 0x7fffu + ((u >> 16) & 1u)) >> 16; }
__device__ __forceinline__ unsigned pk2(float lo, float hi) { return f2bf(lo) | (f2bf(hi) << 16); }
__device__ __forceinline__ float bf2f(unsigned b) { return __uint_as_float(b << 16); }

#define XB_TMO      128
#define XB_XCNT(j)  (256  + 64 * (j))
#define XB_XSUB(j)  (1280 + 64 * (j))
#define XB_XGEN(j)  (2304 + 64 * (j))
#define XB_TOP      3328
#define XB_TOPGEN   3392
#define XCD_BAR_WORDS 3456
#define XB_SPIN_CAP (1u << 18)
__device__ __forceinline__ unsigned xb_ld(unsigned* p)              { return __hip_atomic_load(p, __ATOMIC_RELAXED, __HIP_MEMORY_SCOPE_AGENT); }
__device__ __forceinline__ unsigned xb_add(unsigned* p, unsigned v) { return __hip_atomic_fetch_add(p, v, __ATOMIC_RELAXED, __HIP_MEMORY_SCOPE_AGENT); }
__device__ __forceinline__ unsigned xb_xcc_id() { return (unsigned)__builtin_amdgcn_s_getreg((3 << 11) | 20) & 0xFu; }
#define XB_SPIN(cond, bar) do { unsigned _sp = 0; while (cond) { __builtin_amdgcn_s_sleep(1); \
    if ((++_sp & 255u) == 0u) { if (xb_ld(&(bar)[XB_TMO])) break; if (_sp > XB_SPIN_CAP) { atomicAdd(&(bar)[XB_TMO], 1u); break; } } } } while (0)
struct XcdBarrier { unsigned* bar; unsigned x; volatile LAS unsigned* st; };
__device__ __forceinline__ XcdBarrier xcd_barrier_post(unsigned* bar, volatile LAS unsigned* st) {
    XcdBarrier b; b.bar = bar; b.x = xb_xcc_id(); b.st = st;
    if (threadIdx.x == 0) (void)xb_add(&bar[XB_XCNT(b.x)], 1u);
    return b;
}
__device__ __forceinline__ void xcd_barrier_complete(unsigned* bar, unsigned x, unsigned& nloc, unsigned& nx) {
    const unsigned G = gridDim.x * gridDim.y * gridDim.z;
    unsigned sum, cnt, mine, sp = 0u;
    for (;;) {
        sum = 0u; cnt = 0u; mine = 0u;
#pragma unroll
        for (unsigned j = 0; j < 16; ++j) { const unsigned c = xb_ld(&bar[XB_XCNT(j)]); sum += c; cnt += (c > 0u) ? 1u : 0u; mine = (j == x) ? c : mine; }
        if (sum == G) break;
        __builtin_amdgcn_s_sleep(1);
        if ((++sp & 255u) == 0u) { if (xb_ld(&bar[XB_TMO])) break; if (sp > XB_SPIN_CAP) { atomicAdd(&bar[XB_TMO], 1u); break; } }
    }
    nloc = mine > 0u ? mine : 1u; nx = cnt > 0u ? cnt : 1u;
}
__device__ __forceinline__ void xcd_barrier(const XcdBarrier& b) {
    asm volatile("s_waitcnt vmcnt(0)" ::: "memory");
    __syncthreads();
    if (threadIdx.x == 0) {
        unsigned* bar = b.bar;
        __builtin_amdgcn_s_waitcnt(0);
        unsigned nloc = b.st[0], nx = b.st[1];
        if (nloc == 0u) { xcd_barrier_complete(bar, b.x, nloc, nx); b.st[0] = nloc; b.st[1] = nx; }
        const unsigned old = xb_add(&bar[XB_XSUB(b.x)], 1u);
        const unsigned gen = old / nloc;
        if (old + 1u == (gen + 1u) * nloc) {
            __builtin_amdgcn_fence(__ATOMIC_RELEASE, "agent");
            asm volatile("s_waitcnt vmcnt(0)" ::: "memory");
            const unsigned og = xb_add(&bar[XB_TOP], 1u);
            const unsigned tg = og / nx;
            if (og + 1u == (tg + 1u) * nx) xb_add(&bar[XB_TOPGEN], 1u);
            else XB_SPIN(xb_ld(&bar[XB_TOPGEN]) == tg, bar);
            __builtin_amdgcn_fence(__ATOMIC_ACQUIRE, "agent");
            xb_add(&bar[XB_XGEN(b.x)], 1u);
            asm volatile("s_waitcnt vmcnt(0)" ::: "memory");
        } else {
            XB_SPIN(xb_ld(&bar[XB_XGEN(b.x)]) == gen, bar);
            __builtin_amdgcn_fence(__ATOMIC_ACQUIRE, "agent");
            asm volatile("s_waitcnt vmcnt(0)" ::: "memory");
        }
    }
    __syncthreads();
}

__device__ __forceinline__ float shfl_xor_l(float v, int o, int lane) { return __int_as_float(__builtin_amdgcn_ds_bpermute((lane ^ o) << 2, __float_as_int(v))); }
__device__ __forceinline__ float wave_sum(float v, int lane) {
#pragma unroll
    for (int o = 1; o < 64; o <<= 1) v += shfl_xor_l(v, o, lane);
    return v;
}
__device__ __forceinline__ void transpose_tile(const float* W, int N, int k0, int n0, bf16* WT, int ldo, int orow0, int ocol0, LAS float* scr, int lane) {
#pragma unroll 8
    for (int i = 0; i < 32; ++i) { const int kk = 2 * i + (lane >> 5); scr[kk * 33 + (lane & 31)] = W[(size_t)(k0 + kk) * N + n0 + (lane & 31)]; }
    LDS_WAIT(); asm volatile("" ::: "memory");
    const int c = lane & 7;
#pragma unroll
    for (int j = 0; j < 4; ++j) { const int n = (lane >> 3) + 8 * j; const LAS float* s = scr + (8 * c) * 33 + n;
        v4u o; o.x = pk2(s[0 * 33], s[1 * 33]); o.y = pk2(s[2 * 33], s[3 * 33]); o.z = pk2(s[4 * 33], s[5 * 33]); o.w = pk2(s[6 * 33], s[7 * 33]);
        *(GAS v4u*)(WT + (size_t)(orow0 + n) * ldo + ocol0 + 8 * c) = o; }
    LDS_WAIT(); asm volatile("" ::: "memory");
}
__device__ __forceinline__ void abar_pow(float lr, float li, float dt, float j, float& re, float& im) {
    const float mag = expf(lr * dt * j); float s, c; sincosf(li * dt * j, &s, &c); re = mag * c; im = mag * s;
}

constexpr int ETAB_OFF = MISC_OFF + 256;
__device__ __forceinline__ void build_expert_table(LAS unsigned char* L, const int* CNT, int tid) {
    LAS int* tab = (LAS int*)(L + ETAB_OFF); LAS int* cl = tab + (XS_ROWS / 256 + 2);
    __syncthreads();
    if (tid < NEXP) cl[tid] = CNT[tid];
    __syncthreads();
    if (tid == 0) { int rt = 0;
#pragma unroll 1
        for (int e = 0; e < NEXP; ++e) { const int nt = (cl[e] + 255) >> 8;
#pragma unroll 1
            for (int q = 0; q < nt; ++q) tab[rt++] = e | (q << 8); }
        tab[XS_ROWS / 256 + 1] = rt;
#pragma unroll 1
        for (; rt <= XS_ROWS / 256; ++rt) tab[rt] = -1; }
    __syncthreads();
}
struct Args { const float* in[34]; float* out; unsigned char* ws; };
typedef __attribute__((address_space(4))) const char* kconst_ptr;
__device__ __forceinline__ void* karg(int k) { kconst_ptr kp = (kconst_ptr)__builtin_amdgcn_kernarg_segment_ptr(); asm volatile("" : "+s"(kp)); return *(void* const __attribute__((address_space(4)))*)(kp + 8 * k); }

__global__ void __launch_bounds__(NWAVES * 64, 2) fwd_kernel(Args args) {
    extern __shared__ __attribute__((aligned(16))) unsigned char lds[];
    LAS unsigned char* L = (LAS unsigned char*)lds;
    volatile LAS unsigned* MISC = (volatile LAS unsigned*)(L + MISC_OFF);
#define PHASE_IDS() \
    int tid = threadIdx.x; asm volatile("" : "+v"(tid)); \
    const int lane = tid & 63, wave = __builtin_amdgcn_readfirstlane(tid >> 6); \
    int G = gridDim.x, bx = blockIdx.x; asm volatile("" : "+s"(G), "+s"(bx)); \
    const int vcu = (G % 8 == 0) ? (bx % 8) * (G / 8) + bx / 8 : bx; \
    const int gw = vcu * NWAVES + wave, NGW = G * NWAVES; \
    const int gt = bx * (NWAVES * 64) + tid, NGT = G * NWAVES * 64; \
    (void)lane; (void)wave; (void)vcu; (void)gw; (void)NGW; (void)gt; (void)NGT;
    gu32* ctl = (gu32*)(args.ws + WS_CTL);
    for (int u = threadIdx.x; u < (LDS_BYTES - LDSCTL_OFF) / 4; u += NWAVES * 64) ((LAS unsigned*)(L + LDSCTL_OFF))[u] = 0u;
    __syncthreads();
    XcdBarrier bar = xcd_barrier_post((unsigned*)(ctl + CW_BAR), MISC + 8);
#define GRID_BAR() xcd_barrier(bar)

#define KIN(k) ((const float*)karg(k))
#define WSP(T_, off) ((T_*)(((unsigned char*)karg(35)) + (off)))
#define OUTP() ((float*)karg(34))

#if DBG_STAGE != 1
    asm volatile("; PHASE_MARK P0" ::: "memory");
    {
        PHASE_IDS();
        const float* w_in = KIN(5); const float* w_glu = KIN(15); const float* w_br_ssm = KIN(22); const float* w_br_attn = KIN(23); const float* w_out = KIN(24);
        const float* w_eg = KIN(30); const float* w_eu = KIN(31); const float* w_ed = KIN(32);
        bf16* WinT = WSP(bf16, WS_WIN); bf16* WgluT = WSP(bf16, WS_WGLU); bf16* WssmT = WSP(bf16, WS_WSSM); bf16* WattT = WSP(bf16, WS_WATT); bf16* WoutT = WSP(bf16, WS_WOUT);
        bf16* WE1 = WSP(bf16, WS_WE1); bf16* WE2 = WSP(bf16, WS_WE2);
        LAS float* scr = (LAS float*)(L + RING_OFF + wave * 16384);
        constexpr int I_IN = 16 * 176, I_GLU = 8 * 16, I_SSM = 8 * 32, I_ATT = 16 * 32, I_OUT = 16 * 32, I_EG = NEXP * 16 * 8, I_EU = I_EG, I_ED = NEXP * 4 * 32;
        constexpr int NITEMS = I_IN + I_GLU + I_SSM + I_ATT + I_OUT + I_EG + I_EU + I_ED;
        for (int it = gw; it < NITEMS; it += NGW) {
            int r = it;
            if (r < I_IN) { const int kb = r / 176, nb = r % 176; transpose_tile(w_in, INW, 64 * kb, 32 * nb, WinT, D, 32 * nb, 64 * kb, scr, lane); continue; } r -= I_IN;
            if (r < I_GLU) { const int kb = r / 16, nb = r % 16; transpose_tile(w_glu, S5W, 64 * kb, 32 * nb, WgluT, S5W, 32 * nb, 64 * kb, scr, lane); continue; } r -= I_GLU;
            if (r < I_SSM) { const int kb = r / 32, nb = r % 32; transpose_tile(w_br_ssm, D, 64 * kb, 32 * nb, WssmT, S5W, 32 * nb, 64 * kb, scr, lane); continue; } r -= I_SSM;
            if (r < I_ATT) { const int kb = r / 32, nb = r % 32; transpose_tile(w_br_attn, D, 64 * kb, 32 * nb, WattT, D, 32 * nb, 64 * kb, scr, lane); continue; } r -= I_ATT;
            if (r < I_OUT) { const int kb = r / 32, nb = r % 32; transpose_tile(w_out, D, 64 * kb, 32 * nb, WoutT, D, 32 * nb, 64 * kb, scr, lane); continue; } r -= I_OUT;
            if (r < I_EG + I_EU) { const bool up = r >= I_EG; if (up) r -= I_EG; const int e = r / 128, q = r % 128, kb = q / 8, nb = q % 8;
                transpose_tile((up ? w_eu : w_eg) + (size_t)e * D * DEXP, DEXP, 64 * kb, 32 * nb, WE1 + (size_t)e * 512 * D, D, (nb >> 2) * 256 + (up ? 128 : 0) + (nb & 3) * 32, 64 * kb, scr, lane); continue; } r -= I_EG + I_EU;
            { const int e = r / 128, q = r % 128, kb = q / 32, nb = q % 32; transpose_tile(w_ed + (size_t)e * DEXP * D, D, 64 * kb, 32 * nb, WE2 + (size_t)e * D * DEXP, DEXP, 32 * nb, 64 * kb, scr, lane); }
        }
        const float* w_rg = KIN(26); const float* w_re = KIN(28); bf16* WR = WSP(bf16, WS_WR);
        for (int idx = gt; idx < 2 * 64 * 128; idx += NGT) {
            const int k0 = (idx & 127) * 8, n = (idx >> 7) & 63, part = idx >> 13;
            unsigned w[4] = {0u, 0u, 0u, 0u};
            if (n < 36) {
                float hv[8];
#pragma unroll
                for (int i = 0; i < 8; ++i) { const float f = (n < 4) ? w_rg[(size_t)(k0 + i) * 4 + n] : w_re[(size_t)(k0 + i) * NEXP + (n - 4)]; const float h = bf2f(f2bf(f)); hv[i] = part ? (f - h) : h; }
#pragma unroll
                for (int i = 0; i < 4; ++i) w[i] = pk2(hv[2 * i], hv[2 * i + 1]);
            }
            *(GAS v4u*)(WR + (size_t)(part * 64 + n) * D + k0) = (v4u){w[0], w[1], w[2], w[3]};
        }
        const float* log_dt = KIN(14); const float* a_re = KIN(7); const float* a_im = KIN(8); const float* sb_re = KIN(9); const float* sb_im = KIN(10);
        float* Ere = WSP(float, WS_ETAB); float* Eim = Ere + NG * LC * NP * 16;
        for (int idx = gt; idx < NG * LC * NP; idx += NGT) {
            const int p = idx % NP, j = (idx / NP) % LC, g = idx / (NP * LC);
            const float dt = expf(log_dt[g]), lr = a_re[g * NP + p], li = a_im[g * NP + p];
            float ar, ai; abar_pow(lr, li, dt, 1.0f, ar, ai);
            const float den = lr * lr + li * li, nr = ar - 1.0f;
            const float fre = (nr * lr + ai * li) / den, fim = (ai * lr - nr * li) / den;
            float pr, pi; abar_pow(lr, li, dt, (float)j, pr, pi);
            const float gr = pr * fre - pi * fim, gi = pr * fim + pi * fre;
            const float* br = sb_re + (size_t)(g * NP + p) * 16; const float* bi = sb_im + (size_t)(g * NP + p) * 16;
            float* er = Ere + (size_t)((g * LC + j) * NP + p) * 16; float* ei = Eim + (size_t)((g * LC + j) * NP + p) * 16;
#pragma unroll
            for (int ci = 0; ci < 16; ++ci) { er[ci] = gr * br[ci] - gi * bi[ci]; ei[ci] = gr * bi[ci] + gi * br[ci]; }
        }
        {
            const float* cvec = KIN(1); const float* w_ada = KIN(2); const float* b_ada = KIN(3); float* MOD = WSP(float, WS_MOD);
            __syncthreads();
            LAS float* cs = (LAS float*)(L + RING_OFF);
            LAS float* red = (LAS float*)(L + RING_OFF + 32768);
            bool loaded = false;
            for (int it = vcu; it < 6 * D / 32; it += G) {
                if (!loaded) { __syncthreads(); for (int i = tid; i < NB * D; i += NWAVES * 64) { const float c = cvec[i]; cs[i] = c / (1.0f + expf(-c)); } __syncthreads(); loaded = true; }
                const int col = it * 32 + (lane & 31), ksub = (lane >> 5) + 2 * wave;
                float accb[NB];
#pragma unroll
                for (int b = 0; b < NB; ++b) accb[b] = 0.f;
#pragma unroll 8
                for (int i = 0; i < 64; ++i) { const int k = ksub + 16 * i; const float w = w_ada[(size_t)k * (6 * D) + col];
#pragma unroll
                    for (int b = 0; b < NB; ++b) accb[b] += cs[b * D + k] * w; }
#pragma unroll
                for (int b = 0; b < NB; ++b) red[(ksub * NB + b) * 32 + (lane & 31)] = accb[b];
                __syncthreads();
                if (tid < NB * 32) { const int b = tid >> 5, c = tid & 31; float s = 0.f;
#pragma unroll
                    for (int q = 0; q < 16; ++q) s += red[(q * NB + b) * 32 + c];
                    MOD[(size_t)b * 6 * D + it * 32 + c] = s + b_ada[it * 32 + c]; }
                __syncthreads();
            }
            __syncthreads();
        }
    }
    GRID_BAR();
#endif

#if DBG_STAGE != 1
    asm volatile("; PHASE_MARK P0b" ::: "memory");
    {
        PHASE_IDS();
        const float* x = KIN(0); const float* g_mix = KIN(4); const float* MOD = WSP(float, WS_MOD); bf16* UBUF = (bf16*)OUTP();
        const float* Ere = WSP(float, WS_ETAB); const float* Eim = Ere + NG * LC * NP * 16; bf16* BtY = WSP(bf16, WS_BTY); bf16* BtP = WSP(bf16, WS_BTP);
        const float* sc_re = KIN(11); const float* sc_im = KIN(12); const float* log_dt = KIN(14); const float* a_re = KIN(7); const float* a_im = KIN(8);
        for (int blk = gw; blk < T / 16; blk += NGW) {
            const int row0 = blk * 16, b = row0 / SEQ; const float* md = MOD + (size_t)b * 6 * D;
            f32x4 av[4], sv[4];
#pragma unroll
            for (int j = 0; j < 4; ++j) { const int c = 4 * lane + 256 * j; const f32x4 g = *(const f32x4*)(g_mix + c), sc = *(const f32x4*)(md + D + c); av[j] = g * (sc + 1.0f); sv[j] = *(const f32x4*)(md + c); }
            f32x4 nx[4];
#pragma unroll
            for (int j = 0; j < 4; ++j) nx[j] = *(const f32x4*)(x + (size_t)row0 * D + 4 * lane + 256 * j);
#pragma unroll 2
            for (int r = 0; r < 16; ++r) {
                f32x4 v[4]; float ss = 0.f;
#pragma unroll
                for (int j = 0; j < 4; ++j) v[j] = nx[j];
                const float* xn = x + (size_t)(row0 + (r < 15 ? r + 1 : r)) * D;
#pragma unroll
                for (int j = 0; j < 4; ++j) nx[j] = *(const f32x4*)(xn + 4 * lane + 256 * j);
#pragma unroll
                for (int j = 0; j < 4; ++j) ss += (v[j][0] * v[j][0] + v[j][1] * v[j][1]) + (v[j][2] * v[j][2] + v[j][3] * v[j][3]);
                const float rstd = 1.0f / sqrtf(wave_sum(ss, lane) * (1.0f / D) + EPS);
                bf16* ur = UBUF + (size_t)(row0 + r) * D;
#pragma unroll
                for (int j = 0; j < 4; ++j) { const f32x4 o = v[j] * rstd * av[j] + sv[j]; *(GAS v2u*)(ur + 4 * lane + 256 * j) = (v2u){pk2(o[0], o[1]), pk2(o[2], o[3])}; }
            }
        }
        for (int idx = gt; idx < NG * LC * 16 * 2; idx += NGT) {
            const int cih = idx & 1, co = (idx >> 1) & 15, j = (idx >> 5) % LC, g = idx / (32 * LC);
            float kv[8];
#pragma unroll
            for (int i = 0; i < 8; ++i) kv[i] = 0.f;
            const float* er = Ere + (size_t)((g * LC + j) * NP) * 16 + cih * 8; const float* ei = Eim + (size_t)((g * LC + j) * NP) * 16 + cih * 8;
            const float* cr = sc_re + (size_t)(g * 16 + co) * NP; const float* ci_ = sc_im + (size_t)(g * 16 + co) * NP;
            for (int p = 0; p < NP; ++p) { const float c_r = cr[p], c_i = ci_[p]; const f32x4 e0 = *(const f32x4*)(er + p * 16), e1 = *(const f32x4*)(er + p * 16 + 4), f0 = *(const f32x4*)(ei + p * 16), f1 = *(const f32x4*)(ei + p * 16 + 4);
#pragma unroll
                for (int i = 0; i < 4; ++i) { kv[i] += c_r * e0[i] - c_i * f0[i]; kv[4 + i] += c_r * e1[i] - c_i * f1[i]; } }
            const v4u kw = (v4u){pk2(kv[0], kv[1]), pk2(kv[2], kv[3]), pk2(kv[4], kv[5]), pk2(kv[6], kv[7])};
            bf16* base = BtY + (size_t)g * 512 * KY;
            for (int t = j; t < LC; ++t) *(GAS v4u*)(base + (size_t)(t * 16 + co) * KY + (t - j) * 16 + cih * 8) = kw;
            if (j >= 1) for (int t = 0; t + j < LC; ++t) *(GAS v4u*)(base + (size_t)(t * 16 + co) * KY + (t + j) * 16 + cih * 8) = (v4u){0u, 0u, 0u, 0u};
        }
        for (int idx = gt; idx < NG * LC * NP; idx += NGT) {
            const int p = idx % NP, t = (idx / NP) % LC, g = idx / (NP * LC);
            const float dt = expf(log_dt[g]); float ar, ai; abar_pow(a_re[g * NP + p], a_im[g * NP + p], dt, (float)(t + 1), ar, ai);
#pragma unroll
            for (int co = 0; co < 16; ++co) { const float c_r = sc_re[(size_t)(g * 16 + co) * NP + p], c_i = sc_im[(size_t)(g * 16 + co) * NP + p];
                bf16* rowp = BtY + (size_t)(g * 512 + t * 16 + co) * KY;
                rowp[512 + p] = (bf16)f2bf(c_r * ar - c_i * ai); rowp[576 + p] = (bf16)f2bf(-(c_r * ai + c_i * ar)); }
        }
        for (int idx = gt; idx < NG * 128 * LC; idx += NGT) {
            const int s = idx % LC, nn = (idx / LC) % 128, g = idx / (LC * 128); const int p = nn & 63, im = nn >> 6;
            const float* src = (im ? Eim : Ere) + (size_t)((g * LC + (LC - 1 - s)) * NP + p) * 16;
            unsigned hw[8], lw[8];
#pragma unroll
            for (int i = 0; i < 8; ++i) { const float f0 = src[2 * i], f1 = src[2 * i + 1]; const unsigned h0 = f2bf(f0), h1 = f2bf(f1); hw[i] = h0 | (h1 << 16); lw[i] = pk2(f0 - bf2f(h0), f1 - bf2f(h1)); }
            bf16* d0 = BtP + (size_t)(g * 256 + nn) * KS + s * 16; bf16* d1 = BtP + (size_t)(g * 256 + 128 + nn) * KS + s * 16;
            *(GAS v4u*)d0 = (v4u){hw[0], hw[1], hw[2], hw[3]}; *(GAS v4u*)(d0 + 8) = (v4u){hw[4], hw[5], hw[6], hw[7]};
            *(GAS v4u*)d1 = (v4u){lw[0], lw[1], lw[2], lw[3]}; *(GAS v4u*)(d1 + 8) = (v4u){lw[4], lw[5], lw[6], lw[7]};
        }
    }
    GRID_BAR();

    asm volatile("; PHASE_MARK P1" ::: "memory");
    {
        PHASE_IDS();
        pg8::StaticOrder S; S.init(OUTP(), D, WSP(bf16, WS_WIN), D, T, INW, G, bx);
        pg8::EpiProj E{KIN(6), WSP(bf16, WS_UG), WSP(bf16, WS_Q), WSP(bf16, WS_K), WSP(bf16, WS_V), WSP(bf16, WS_GATES), attn_body::C2};
        pg8::gemm_phase<pg8::EpiProj, pg8::StaticOrder, true, true>(L + RING_OFF, D, D, D, S, E);
    }
    GRID_BAR();

    asm volatile("; PHASE_MARK P2" ::: "memory");
    {
        PHASE_IDS();
        pg8::GroupOrder S; S.init(WSP(bf16, WS_UG), KY, (size_t)NRC * KY * 2, WSP(bf16, WS_BTP), KS, (size_t)256 * KS * 2, NRC, 256, NG, G, bx);
        pg8::EpiStates E{WSP(float, WS_SLOC)};
        pg8::gemm_phase<pg8::EpiStates, pg8::GroupOrder, true, true>(L + RING_OFF, KS, KY, KS, S, E);
    }
    GRID_BAR();

    asm volatile("; PHASE_MARK P3" ::: "memory");
    {
        PHASE_IDS();
        const float* log_dt = KIN(14); const float* a_re = KIN(7); const float* a_im = KIN(8); const float* SLOC = WSP(float, WS_SLOC); bf16* UG = WSP(bf16, WS_UG);
        LAS float* seg = (LAS float*)(L + RING_OFF);
        for (int bg = vcu; bg < NB * NG; bg += G) {
            const int b = bg / NG, g = bg % NG, p = lane;
            const float dt = expf(log_dt[g]), lr = a_re[g * NP + p], li = a_im[g * NP + p];
            float alr, ali; abar_pow(lr, li, dt, (float)LC, alr, ali);
            constexpr int SEGC = NCH / NWAVES;
            float locr[SEGC], loci[SEGC]; float cr = 0.f, ci = 0.f;
            const float* sp = SLOC + ((size_t)(g * NRC + b * NCH + wave * SEGC)) * 128;
#pragma unroll
            for (int k = 0; k < SEGC; ++k) { locr[k] = cr; loci[k] = ci; const float sr = sp[k * 128 + p], si = sp[k * 128 + 64 + p]; const float nr = alr * cr - ali * ci + sr, ni = alr * ci + ali * cr + si; cr = nr; ci = ni; }
            __syncthreads();
            seg[(wave * 64 + p) * 2] = cr; seg[(wave * 64 + p) * 2 + 1] = ci;
            __syncthreads();
            float a16r = alr, a16i = ali;
#pragma unroll
            for (int q = 0; q < 4; ++q) { const float nr = a16r * a16r - a16i * a16i, ni = 2.f * a16r * a16i; a16r = nr; a16i = ni; }
            float inr = 0.f, ini = 0.f;
            for (int w = 0; w < wave; ++w) { const float er = seg[(w * 64 + p) * 2], ei = seg[(w * 64 + p) * 2 + 1]; const float nr = a16r * inr - a16i * ini + er, ni = a16r * ini + a16i * inr + ei; inr = nr; ini = ni; }
            bf16* up = UG + ((size_t)(g * NRC + b * NCH + wave * SEGC)) * KY + KS;
#pragma unroll
            for (int k = 0; k < SEGC; ++k) { up[(size_t)k * KY + p] = (bf16)f2bf(inr + locr[k]); up[(size_t)k * KY + 64 + p] = (bf16)f2bf(ini + loci[k]); const float nr = alr * inr - ali * ini, ni = alr * ini + ali * inr; inr = nr; ini = ni; }
        }
        __syncthreads();
        const char* wsb = (const char*)karg(35);
        const float* lq1 = KIN(17); const float* lk1 = KIN(18); const float* lq2 = KIN(19); const float* lk2 = KIN(20); const float* g_subln = KIN(21);
        const float lam = expf(wave_sum(lq1[lane] * lk1[lane], lane)) - expf(wave_sum(lq2[lane] * lk2[lane], lane)) + LAMBDA_INIT;
        LAS float* gsl = (LAS float*)(L + GS_OFF);
        if (tid < 128) gsl[tid] = g_subln[tid] * (1.0f - LAMBDA_INIT);
        __syncthreads();
        for (int un = vcu; un < NB * 8 * 4; un += G) {
            const int s4 = un & 3, h = (un >> 2) & 7, b = un >> 5;
#pragma unroll 1
            for (int i = 0; i < 4; ++i) { const int qb = (i == 0) ? 15 - s4 : (i == 1) ? 8 + s4 : (i == 2) ? 7 - s4 : s4;
                attn_body::attn_unit<8, 40, WS_Q, WS_K, WS_V, GS_OFF - RING_OFF>(b, h, qb, wsb, (attn_body::bf16*)OUTP(), lam, (char*)lds + RING_OFF); }
        }
    }
    GRID_BAR();

    asm volatile("; PHASE_MARK P4" ::: "memory");
    {
        PHASE_IDS();
        pg8::GroupOrder S; S.init(WSP(bf16, WS_UG), KY, (size_t)NRC * KY * 2, WSP(bf16, WS_BTY), KY, (size_t)512 * KY * 2, NRC, 512, NG, G, bx);
        pg8::EpiY E{WSP(bf16, WS_UG), KIN(13), WSP(bf16, WS_YACT)};
        pg8::gemm_phase<pg8::EpiY, pg8::GroupOrder, true, true>(L + RING_OFF, KY, KY, KY, S, E);
    }
    GRID_BAR();

    asm volatile("; PHASE_MARK P5" ::: "memory");
    {
        PHASE_IDS();
        pg8::StaticOrder S; S.init(WSP(bf16, WS_YACT), S5W, WSP(bf16, WS_WGLU), S5W, T, S5W, G, bx);
        pg8::EpiGlu E{WSP(bf16, WS_YACT), KIN(16), WSP(bf16, WS_S5O)};
        pg8::gemm_phase<pg8::EpiGlu, pg8::StaticOrder, true, true>(L + RING_OFF, S5W, S5W, S5W, S, E);
    }
    GRID_BAR();

    asm volatile("; PHASE_MARK P6" ::: "memory");
    {
        PHASE_IDS();
        pg8::StaticOrder S; S.init(WSP(bf16, WS_S5O), S5W, WSP(bf16, WS_WSSM), S5W, T, D, G, bx);
        pg8::EpiBranch<0> E{WSP(bf16, WS_GATES), nullptr, WSP(bf16, WS_TMP)};
        pg8::gemm_phase<pg8::EpiBranch<0>, pg8::StaticOrder, true, true>(L + RING_OFF, S5W, S5W, S5W, S, E);
    }
    VM_WAIT(); __syncthreads();
    {
        PHASE_IDS();
        pg8::StaticOrder S; S.init(OUTP(), D, WSP(bf16, WS_WATT), D, T, D, G, bx);
        pg8::EpiBranch<1> E{WSP(bf16, WS_GATES), WSP(bf16, WS_TMP), (bf16*)OUTP() + (size_t)T * D};
        pg8::gemm_phase<pg8::EpiBranch<1>, pg8::StaticOrder, true, true>(L + RING_OFF, D, D, D, S, E);
    }
    GRID_BAR();

    asm volatile("; PHASE_MARK P8" ::: "memory");
    {
        PHASE_IDS();
        pg8::StaticOrder S; S.init((bf16*)OUTP() + (size_t)T * D, D, WSP(bf16, WS_WOUT), D, T, D, G, bx);
        pg8::EpiOut E{KIN(0), WSP(float, WS_MOD), WSP(bf16, WS_H)};
        pg8::gemm_phase<pg8::EpiOut, pg8::StaticOrder, true, true>(L + RING_OFF, D, D, D, S, E);
    }
    GRID_BAR();
#endif

#if DBG_STAGE == 0
    asm volatile("; PHASE_MARK P9" ::: "memory");
    {
        PHASE_IDS();
        const float* g_ffn = KIN(25); const float* MOD = WSP(float, WS_MOD); const bf16* Hbuf = WSP(bf16, WS_H); bf16* U2 = (bf16*)OUTP();
        const bf16* WRh = WSP(bf16, WS_WR); const bf16* WRl = WRh + 64 * D;
        const float* b_rg = KIN(27); const float* b_re = KIN(29); int* CNT = WSP(int, WS_CTL) + CW_CNT; int* LIST = WSP(int, WS_LIST); float* CWL = WSP(float, WS_CWL);
        constexpr int APITCH = 1032;
        LAS bf16* AH = (LAS bf16*)(L + RING_OFF); LAS bf16* AL = AH + 16 * APITCH;
        LAS float* PART = (LAS float*)(L + RING_OFF + 2 * 16 * APITCH * 2);
        LAS float* LG = PART + 8 * 256;
        LAS int* lcnt = (LAS int*)(LG + 16 * 64); LAS int* lbase = lcnt + NEXP; LAS int* TOK = lbase + NEXP;
        const int per = T / G, t0 = bx * per, b = t0 / SEQ;
        const float* md = MOD + (size_t)b * 6 * D;
        f32x4 av[4], sv[4];
#pragma unroll
        for (int j = 0; j < 4; ++j) { const int c = 4 * lane + 256 * j; const f32x4 g = *(const f32x4*)(g_ffn + c), sc = *(const f32x4*)(md + 4 * D + c); av[j] = g * (sc + 1.0f); sv[j] = *(const f32x4*)(md + 3 * D + c); }
        const int cb = wave & 3, kh = wave >> 2, fr = lane & 15, fq = lane >> 4;
        pg8::bf16x8 bh[16], bl[16];
#pragma unroll
        for (int ks = 0; ks < 16; ++ks) { const size_t o = (size_t)(cb * 16 + fr) * D + kh * 512 + ks * 32 + fq * 8; bh[ks] = *(const pg8::bf16x8*)(WRh + o); bl[ks] = *(const pg8::bf16x8*)(WRl + o); }
        if (tid < NEXP) lcnt[tid] = 0;
        for (int c = 0; c < per / 16; ++c) {
#pragma unroll
            for (int rr = 0; rr < 2; ++rr) {
                const int r = 2 * wave + rr, tok = t0 + c * 16 + r;
                const bf16* hr = Hbuf + (size_t)tok * D; f32x4 v[4]; float ss = 0.f;
#pragma unroll
                for (int j = 0; j < 4; ++j) { const v2u hw = *(const GAS v2u*)(hr + 4 * lane + 256 * j); v[j] = (f32x4){pg8::bf_lo(hw.x), pg8::bf_hi(hw.x), pg8::bf_lo(hw.y), pg8::bf_hi(hw.y)}; ss += (v[j][0] * v[j][0] + v[j][1] * v[j][1]) + (v[j][2] * v[j][2] + v[j][3] * v[j][3]); }
                const float rstd = 1.0f / sqrtf(wave_sum(ss, lane) * (1.0f / D) + EPS);
                bf16* ur = U2 + (size_t)tok * D;
#pragma unroll
                for (int j = 0; j < 4; ++j) { const f32x4 o = v[j] * rstd * av[j] + sv[j];
                    const unsigned h0 = f2bf(o[0]), h1 = f2bf(o[1]), h2 = f2bf(o[2]), h3 = f2bf(o[3]);
                    const v2u hv = (v2u){h0 | (h1 << 16), h2 | (h3 << 16)}, lv = (v2u){pk2(o[0] - bf2f(h0), o[1] - bf2f(h1)), pk2(o[2] - bf2f(h2), o[3] - bf2f(h3))};
                    *(GAS v2u*)(ur + 4 * lane + 256 * j) = hv;
                    *(LAS v2u*)(AH + r * APITCH + 4 * lane + 256 * j) = hv; *(LAS v2u*)(AL + r * APITCH + 4 * lane + 256 * j) = lv; }
            }
            __syncthreads();
            { pg8::f32x4 acc = (pg8::f32x4){0.f, 0.f, 0.f, 0.f};
#pragma unroll
              for (int ks = 0; ks < 16; ++ks) { const int ko = fr * APITCH + kh * 512 + ks * 32 + fq * 8;
                  const pg8::bf16x8 ah = *(const LAS pg8::bf16x8*)(AH + ko), al = *(const LAS pg8::bf16x8*)(AL + ko);
                  acc = __builtin_amdgcn_mfma_f32_16x16x32_bf16(ah, bh[ks], acc, 0, 0, 0);
                  acc = __builtin_amdgcn_mfma_f32_16x16x32_bf16(al, bh[ks], acc, 0, 0, 0);
                  acc = __builtin_amdgcn_mfma_f32_16x16x32_bf16(ah, bl[ks], acc, 0, 0, 0); }
#pragma unroll
              for (int i = 0; i < 4; ++i) PART[wave * 256 + (fq * 4 + i) * 16 + fr] = acc[i]; }
            __syncthreads();
#pragma unroll
            for (int i = 0; i < 2; ++i) { const int o = tid * 2 + i, row = o >> 6, col = o & 63, cbb = col >> 4; LG[o] = PART[cbb * 256 + row * 16 + (col & 15)] + PART[(4 + cbb) * 256 + row * 16 + (col & 15)]; }
            __syncthreads();
            if (tid < 16) {
                const LAS float* lg = LG + tid * 64;
                float gl[4]; int gi = 0;
#pragma unroll
                for (int i = 0; i < 4; ++i) gl[i] = lg[i] + b_rg[i];
#pragma unroll
                for (int i = 1; i < 4; ++i) if (gl[i] > gl[gi]) gi = i;
                float gsum = 0.f;
#pragma unroll
                for (int i = 0; i < 4; ++i) gsum += expf(gl[i] - gl[gi]);
                const float gp = 1.0f / gsum;
                float el[8];
#pragma unroll
                for (int i = 0; i < 8; ++i) el[i] = lg[4 + gi * 8 + i] + b_re[gi * 8 + i];
                int i0 = 0;
#pragma unroll
                for (int i = 1; i < 8; ++i) if (el[i] > el[i0]) i0 = i;
                int i1 = (i0 == 0) ? 1 : 0;
#pragma unroll
                for (int i = 0; i < 8; ++i) if (i != i0 && el[i] > el[i1]) i1 = i;
                const float ex = expf(el[i1] - el[i0]);
                const float w0 = gp / (1.0f + ex), w1 = gp * ex / (1.0f + ex);
                const int e0 = gi * 8 + i0, e1 = gi * 8 + i1;
                const int p0 = atomicAdd((int*)(lds + ((char*)&lcnt[e0] - (char*)L)), 1), p1 = atomicAdd((int*)(lds + ((char*)&lcnt[e1] - (char*)L)), 1);
                LAS int* tk = TOK + (c * 16 + tid) * 6; tk[0] = e0; tk[1] = p0; tk[2] = __float_as_int(w0); tk[3] = e1; tk[4] = p1; tk[5] = __float_as_int(w1);
            }
        }
        __syncthreads();
        if (tid < NEXP) lbase[tid] = atomicAdd(&CNT[tid], lcnt[tid]);
        __syncthreads();
        if (tid < per) { const LAS int* tk = TOK + tid * 6; const int tok = t0 + tid;
            const size_t i0 = (size_t)tk[0] * T + lbase[tk[0]] + tk[1], i1 = (size_t)tk[3] * T + lbase[tk[3]] + tk[4];
            LIST[i0] = tok * 2; CWL[i0] = __int_as_float(tk[2]); LIST[i1] = tok * 2 + 1; CWL[i1] = __int_as_float(tk[5]); }
        __syncthreads();
    }
    GRID_BAR();

    asm volatile("; PHASE_MARK P13" ::: "memory");
    {
        PHASE_IDS();
        const int* CNT = WSP(int, WS_CTL) + CW_CNT; const int* LIST = WSP(int, WS_LIST);
        build_expert_table(L, CNT, tid);
        pg8::ExpertOrder S; S.init((const LAS int*)(L + ETAB_OFF), OUTP(), 0, WSP(bf16, WS_WE1), D, (size_t)512 * D * 2, 512, G, bx);
        LAS int* rowtab = (LAS int*)(L + ROWTAB_OFF);
        { pg8::Unit u;
#pragma unroll 1
          for (int i = 0; i < 4 && S.next(i, u); ++i) { const int n = CNT[u.g];
              for (int r = tid; r < 256; r += NWAVES * 64) { const int pos = u.lt * 256 + r; rowtab[i * 256 + r] = (pos < n) ? (LIST[(size_t)u.g * T + pos] >> 1) : 0; } }
          __syncthreads(); }
        pg8::EpiExp1 E{WSP(bf16, WS_HDN)};
        pg8::gemm_phase<pg8::EpiExp1, pg8::ExpertOrder, true, true, true>(L + RING_OFF, D, D, D, S, E, (const LAS int*)rowtab);
    }
    GRID_BAR();

    asm volatile("; PHASE_MARK P14" ::: "memory");
    {
        PHASE_IDS();
        build_expert_table(L, WSP(int, WS_CTL) + CW_CNT, tid);
        pg8::ExpertOrder S; S.init((const LAS int*)(L + ETAB_OFF), WSP(bf16, WS_HDN), (size_t)256 * DEXP * 2, WSP(bf16, WS_WE2), DEXP, (size_t)D * DEXP * 2, D, G, bx);
        pg8::EpiExp2 E{WSP(int, WS_LIST), WSP(float, WS_CWL), WSP(int, WS_CTL) + CW_CNT, WSP(bf16, WS_SLOTS)};
        pg8::gemm_phase<pg8::EpiExp2, pg8::ExpertOrder, true, true>(L + RING_OFF, DEXP, DEXP, DEXP, S, E);
    }
    GRID_BAR();
#endif

    asm volatile("; PHASE_MARK P15" ::: "memory");
    {
        PHASE_IDS();
        const float* x = KIN(0); const float* g_final = KIN(33); const bf16* Hbuf = WSP(bf16, WS_H); const float* MOD = WSP(float, WS_MOD); const bf16* SLOTS = WSP(bf16, WS_SLOTS); float* out = OUTP();
        (void)x; (void)Hbuf; (void)MOD; (void)SLOTS;
#if DBG_STAGE == 0
        v2u nh[4], n0[4], n1[4];
#pragma unroll
        for (int j = 0; j < 4; ++j) { const int c = 4 * lane + 256 * j; nh[j] = *(const GAS v2u*)(Hbuf + (size_t)gw * D + c); n0[j] = *(const GAS v2u*)(SLOTS + (size_t)(2 * gw) * D + c); n1[j] = *(const GAS v2u*)(SLOTS + (size_t)(2 * gw + 1) * D + c); }
#pragma unroll 2
        for (int row = gw; row < T; row += NGW) {
            const int b = row / SEQ; f32x4 v[4]; float ss = 0.f; v2u ch[4], c0[4], c1[4];
#pragma unroll
            for (int j = 0; j < 4; ++j) { ch[j] = nh[j]; c0[j] = n0[j]; c1[j] = n1[j]; }
            const int rn = (row + NGW < T) ? row + NGW : row;
#pragma unroll
            for (int j = 0; j < 4; ++j) { const int c = 4 * lane + 256 * j; nh[j] = *(const GAS v2u*)(Hbuf + (size_t)rn * D + c); n0[j] = *(const GAS v2u*)(SLOTS + (size_t)(2 * rn) * D + c); n1[j] = *(const GAS v2u*)(SLOTS + (size_t)(2 * rn + 1) * D + c); }
#pragma unroll
            for (int j = 0; j < 4; ++j) { const int c = 4 * lane + 256 * j;
                v[j] = (f32x4){pg8::bf_lo(ch[j].x), pg8::bf_hi(ch[j].x), pg8::bf_lo(ch[j].y), pg8::bf_hi(ch[j].y)};
                const f32x4 gt = *(const f32x4*)(MOD + (size_t)b * 6 * D + 5 * D + c);
                const f32x4 f = (f32x4){pg8::bf_lo(c0[j].x) + pg8::bf_lo(c1[j].x), pg8::bf_hi(c0[j].x) + pg8::bf_hi(c1[j].x), pg8::bf_lo(c0[j].y) + pg8::bf_lo(c1[j].y), pg8::bf_hi(c0[j].y) + pg8::bf_hi(c1[j].y)};
                v[j] = v[j] + gt * f;
                ss += (v[j][0] * v[j][0] + v[j][1] * v[j][1]) + (v[j][2] * v[j][2] + v[j][3] * v[j][3]); }
            const float rstd = 1.0f / sqrtf(wave_sum(ss, lane) * (1.0f / D) + EPS);
#pragma unroll
            for (int j = 0; j < 4; ++j) { const int c = 4 * lane + 256 * j; const f32x4 g = *(const f32x4*)(g_final + c); *(f32x4*)(out + (size_t)row * D + c) = v[j] * rstd * g; }
        }
#else
        for (int row = gw; row < T; row += NGW) {
            f32x4 v[4]; float ss = 0.f;
#pragma unroll
            for (int j = 0; j < 4; ++j) { const int c = 4 * lane + 256 * j;
#if DBG_STAGE == 1
                v[j] = *(const f32x4*)(x + (size_t)row * D + c);
#else
                { const v2u hw = *(const GAS v2u*)(Hbuf + (size_t)row * D + c); v[j] = (f32x4){pg8::bf_lo(hw.x), pg8::bf_hi(hw.x), pg8::bf_lo(hw.y), pg8::bf_hi(hw.y)}; }
#endif
                ss += (v[j][0] * v[j][0] + v[j][1] * v[j][1]) + (v[j][2] * v[j][2] + v[j][3] * v[j][3]); }
            const float rstd = 1.0f / sqrtf(wave_sum(ss, lane) * (1.0f / D) + EPS);
#pragma unroll
            for (int j = 0; j < 4; ++j) { const int c = 4 * lane + 256 * j; const f32x4 g = *(const f32x4*)(g_final + c); *(f32x4*)(out + (size_t)row * D + c) = v[j] * rstd * g; }
        }
#endif
    }
}

extern "C" void kernel_launch(void* const* d_in, const int* in_sizes, int n_in, void* d_out, int out_size, void* d_ws, size_t ws_size, hipStream_t stream) {
    static int grid = 0;
    if (grid == 0) {
        if (n_in != 34 || out_size != T * D || ws_size < WS_END) { fprintf(stderr, "kernel_launch: unexpected shapes (n_in %d, out %d, ws %zu)\n", n_in, out_size, ws_size); grid = -1; return; }
        int dev = 0, cus = 0, per_cu = 0;
        if (hipGetDevice(&dev) != hipSuccess || hipDeviceGetAttribute(&cus, hipDeviceAttributeMultiprocessorCount, dev) != hipSuccess) { grid = -1; return; }
        if (hipFuncSetAttribute((const void*)fwd_kernel, hipFuncAttributeMaxDynamicSharedMemorySize, LDS_BYTES) != hipSuccess) { fprintf(stderr, "kernel_launch: hipFuncSetAttribute failed\n"); grid = -1; return; }
        if (hipOccupancyMaxActiveBlocksPerMultiprocessor(&per_cu, (const void*)fwd_kernel, NWAVES * 64, LDS_BYTES) != hipSuccess || per_cu < 1)
            fprintf(stderr, "kernel_launch: note: occupancy query reports %d workgroups per CU\n", per_cu);
        (void)hipGetLastError();
        grid = cus;
    }
    if (grid < 0) return;
    if (hipMemsetAsync((char*)d_ws + WS_CTL, 0, CTL_ZERO_BYTES, stream) != hipSuccess) { fprintf(stderr, "kernel_launch: memset failed\n"); return; }
    Args a{};
    for (int i = 0; i < 34; ++i) a.in[i] = (const float*)d_in[i];
    a.out = (float*)d_out; a.ws = (unsigned char*)d_ws;
    hipLaunchKernelGGL(fwd_kernel, dim3(grid), dim3(NWAVES * 64), LDS_BYTES, stream, a);
    const hipError_t le = hipPeekAtLastError();
    if (le != hipSuccess) fprintf(stderr, "kernel_launch: launch failed: %s\n", hipGetErrorName(le));
}
```

```cpp
#include <hip/hip_runtime.h>
#include <hip/hip_bf16.h>
#include <cstdio>
#include <cstdint>
#include <cmath>

#ifndef DBG_STAGE
#define DBG_STAGE 0
#endif

constexpr int D = 1024, NB = 8, SEQ = 4096, T = NB * SEQ;
constexpr int S5W = 512, NG = 32, NP = 64, INW = 5632;
constexpr int LC = 32, NCH = SEQ / LC, NRC = T / LC, KS = LC * 16, KY = KS + 128;
constexpr int NEXP = 32, DEXP = 256;
constexpr int KCAT = D + S5W;
constexpr int XS_ROWS = 2 * T + NEXP * 256;
constexpr float EPS = 1e-6f;
constexpr float LAMBDA_INIT = 0.2f;

namespace pg8 {
#define PG8_LAS __attribute__((address_space(3)))
typedef unsigned short bf16_t;
typedef short bf16x8 __attribute__((ext_vector_type(8)));
typedef float f32x4 __attribute__((ext_vector_type(4)));
typedef unsigned u32x4 __attribute__((ext_vector_type(4)));
typedef float f32x2 __attribute__((ext_vector_type(2)));
constexpr int BM = 256, BK = 64, HALF = 128, HTB = HALF * BK * 2, STAGE_BYTES = 8 * HTB, NXCD = 8, WGM = 8;

__host__ __device__ __forceinline__ int lds_byte(int r, int c) { const int st = (r >> 4) * 2 + (c >> 5), rr = r & 15, cc = c & 31, ob = rr * 64 + cc * 2; return st * 1024 + (ob ^ (((ob >> 9) & 1) << 5)); }
__host__ __device__ __forceinline__ void stage_rc(int b, int& R, int& C) { const int st = b / 1024, sb = b % 1024, swz = sb ^ (((sb >> 9) & 1) << 5); R = (st >> 1) * 16 + swz / 64; C = (st & 1) * 32 + (swz % 64) / 2; }
__host__ __device__ __forceinline__ int perm32(int rho) { const int n = rho >> 4, i = rho & 15; return 8 * (i >> 2) + 4 * n + (i & 3); }

struct Unit { int pm, pn, g, lt; const char* a; const char* b; };

struct StaticOrder {
    int nM, nN, nwg, G, c; const char* A; const char* B; size_t tsa, tsb;
    __device__ void init(const void* A_, int lda, const void* B_, int ldb, int M, int N, int G_, int c_) { nM = M / BM; nN = N / BM; nwg = nM * nN; G = G_; c = c_; A = (const char*)A_; B = (const char*)B_; tsa = (size_t)BM * lda * 2; tsb = (size_t)BM * ldb * 2; }
    __device__ bool next(int i, Unit& u) const {
        const long L = (long)i * G + c; if (L >= nwg) return false;
        int wgid = (int)L; { const int q = nwg / NXCD, r = nwg % NXCD, xcd = wgid % NXCD, off = wgid / NXCD; wgid = (xcd < r ? xcd * (q + 1) : r * (q + 1) + (xcd - r) * q) + off; }
        const int nig = WGM * nN, gid = wgid / nig, fm = gid * WGM, gsz = (nM - fm) < WGM ? (nM - fm) : WGM;
        u.pm = fm + ((wgid % nig) % gsz); u.pn = (wgid % nig) / gsz; u.g = 0; u.lt = 0; u.a = A + (size_t)u.pm * tsa; u.b = B + (size_t)u.pn * tsb; return true;
    }
};
struct GroupOrder {
    int nM, nN, ng, G, c; const char* A; const char* B; size_t tsa, tsb, gsa, gsb;
    __device__ void init(const void* A_, int lda, size_t gsa_, const void* B_, int ldb, size_t gsb_, int Mg, int Ng, int ng_, int G_, int c_) {
        nM = Mg / BM; nN = Ng / BM; ng = ng_; G = G_; c = c_; A = (const char*)A_; B = (const char*)B_; tsa = (size_t)BM * lda * 2; tsb = (size_t)BM * ldb * 2; gsa = gsa_; gsb = gsb_; }
    __device__ bool next(int i, Unit& u) const {
        const int per = nM * nN, x = c % NXCD, j = c / NXCD + (G / NXCD) * i; if (j >= (ng / NXCD) * per) return false;
        const int g = x + NXCD * (j / per), r = j % per;
        u.g = g; u.lt = 0; u.pm = r / nN; u.pn = r % nN; u.a = A + (size_t)g * gsa + (size_t)u.pm * tsa; u.b = B + (size_t)g * gsb + (size_t)u.pn * tsb; return true;
    }
};
struct ExpertOrder {
    const PG8_LAS int* tab; int nN, G, c; const char* A; const char* B; size_t tsa, tsb, esb;
    __device__ void init(const PG8_LAS int* tab_, const void* A_, size_t tsa_, const void* B_, int ldb, size_t esb_, int N, int G_, int c_) {
        tab = tab_; nN = N / BM; G = G_; c = c_; A = (const char*)A_; B = (const char*)B_; tsa = tsa_; tsb = (size_t)BM * ldb * 2; esb = esb_; }
    __device__ bool next(int i, Unit& u) const {
        const int NT = __builtin_amdgcn_readfirstlane(tab[XS_ROWS / 256 + 1]);
        const int x = c % NXCD, j = c / NXCD + (G / NXCD) * i, lo = (x * NT) / NXCD, hi = ((x + 1) * NT) / NXCD;
        const int rt = lo + j / nN, pn = j % nN;
        if (rt >= hi) return false;
        const int e = __builtin_amdgcn_readfirstlane(tab[rt]);
        u.g = e & 255; u.lt = e >> 8; u.pm = rt; u.pn = pn; u.a = A + (size_t)rt * tsa; u.b = B + (size_t)u.g * esb + (size_t)pn * tsb; return true;
    }
};

__device__ __forceinline__ unsigned cvt_pk_bf16(float lo, float hi) { unsigned r; asm volatile("v_cvt_pk_bf16_f32 %0, %1, %2" : "=v"(r) : "v"(lo), "v"(hi)); return r; }
__device__ __forceinline__ float bf_lo(unsigned w) { return __uint_as_float(w << 16); }
__device__ __forceinline__ float bf_hi(unsigned w) { return __uint_as_float(w & 0xffff0000u); }
__device__ __forceinline__ float sigmoidf_(float x) { return __builtin_amdgcn_rcpf(1.0f + __builtin_amdgcn_exp2f(-1.4426950408889634f * x)); }
__device__ __forceinline__ void unpack8(const u32x4 w, float (&f)[8]) { f[0] = bf_lo(w.x); f[1] = bf_hi(w.x); f[2] = bf_lo(w.y); f[3] = bf_hi(w.y); f[4] = bf_lo(w.z); f[5] = bf_hi(w.z); f[6] = bf_lo(w.w); f[7] = bf_hi(w.w); }
__device__ __forceinline__ u32x4 pack8(const float (&f)[8]) { u32x4 w; w.x = cvt_pk_bf16(f[0], f[1]); w.y = cvt_pk_bf16(f[2], f[3]); w.z = cvt_pk_bf16(f[4], f[5]); w.w = cvt_pk_bf16(f[6], f[7]); return w; }

#define EPI_LOOP_PERM(...) \
    _Pragma("unroll") for (int ai = 0; ai < 2; ++ai) _Pragma("unroll") for (int m = 0; m < 4; ++m) { const int lrow = ai * HALF + wr * 64 + m * 16 + fr; \
        _Pragma("unroll") for (int bj = 0; bj < 2; ++bj) { const int lcol = bj * HALF + wc * 32 + 8 * fq; \
            float v[8] = {acc[ai][bj][m][0][0], acc[ai][bj][m][0][1], acc[ai][bj][m][0][2], acc[ai][bj][m][0][3], acc[ai][bj][m][1][0], acc[ai][bj][m][1][1], acc[ai][bj][m][1][2], acc[ai][bj][m][1][3]}; __VA_ARGS__ } }

#define EPI_HALF_PRE(...) _Pragma("unroll") for (int m = 0; m < 4; ++m) { const int lrow = ai * HALF + wr * 64 + m * 16 + fr; (void)lrow; \
        _Pragma("unroll") for (int bj = 0; bj < 2; ++bj) { const int lcol = bj * HALF + wc * 32 + 8 * fq; (void)lcol; __VA_ARGS__ } }
#define EPI_HALF_RUN(...) _Pragma("unroll") for (int m = 0; m < 4; ++m) { const int lrow = ai * HALF + wr * 64 + m * 16 + fr; (void)lrow; \
        _Pragma("unroll") for (int bj = 0; bj < 2; ++bj) { const int lcol = bj * HALF + wc * 32 + 8 * fq; (void)lcol; \
            float v[8] = {acc[ai][bj][m][0][0], acc[ai][bj][m][0][1], acc[ai][bj][m][0][2], acc[ai][bj][m][0][3], acc[ai][bj][m][1][0], acc[ai][bj][m][1][1], acc[ai][bj][m][1][2], acc[ai][bj][m][1][3]}; __VA_ARGS__ } }

struct EpiProj {
    static constexpr bool PERM = true, AFTER_DRAIN = false;
    const float* bias; bf16_t* U; bf16_t* Q; bf16_t* Kb; bf16_t* V; bf16_t* Gt; float c2;
    __device__ __forceinline__ void operator()(const f32x4 (&acc)[2][2][4][2], const Unit& u, int wr, int wc, int fr, int fq) const {
        const int ct = u.pn;
        f32x4 bv[2][2];
#pragma unroll
        for (int bj = 0; bj < 2; ++bj) { const int col = ct * BM + bj * HALF + wc * 32 + 8 * fq; bv[bj][0] = *(const f32x4*)(bias + col); bv[bj][1] = *(const f32x4*)(bias + col + 4); }
        EPI_LOOP_PERM({
            const int row = u.pm * BM + lrow, col = ct * BM + lcol;
            v[0] += bv[bj][0][0]; v[1] += bv[bj][0][1]; v[2] += bv[bj][0][2]; v[3] += bv[bj][0][3]; v[4] += bv[bj][1][0]; v[5] += bv[bj][1][1]; v[6] += bv[bj][1][2]; v[7] += bv[bj][1][3];
            bf16_t* dst;
            if (ct < 2) { const int g = col >> 4, ci = col & 15, rc = row / LC, s = row % LC; dst = U + ((size_t)(g * NRC + rc) * KY + s * 16 + ci); }
            else if (ct < 6) { _Pragma("unroll") for (int i = 0; i < 8; ++i) v[i] *= c2; dst = Q + (size_t)row * D + (col - 512); }
            else if (ct < 10) { dst = Kb + (size_t)row * D + (col - 1536); }
            else if (ct < 14) { dst = V + (size_t)row * D + (col - 2560); }
            else { _Pragma("unroll") for (int i = 0; i < 8; ++i) v[i] = sigmoidf_(v[i]); dst = Gt + (size_t)row * 2048 + (col - 3584); }
            *(u32x4*)dst = pack8(v);
        })
    }
};
struct EpiStates {
    static constexpr bool PERM = false, AFTER_DRAIN = false;
    float* S;
    __device__ __forceinline__ void operator()(const f32x4 (&acc)[2][2][4][2], const Unit& u, int wr, int wc, int fr, int fq) const {
#pragma unroll
        for (int ai = 0; ai < 2; ++ai)
#pragma unroll
            for (int m = 0; m < 4; ++m) { const int row = u.pm * BM + ai * HALF + wr * 64 + m * 16 + fr;
#pragma unroll
                for (int n = 0; n < 2; ++n) { const f32x4 v = acc[ai][0][m][n] + acc[ai][1][m][n]; *(f32x4*)(S + ((size_t)(u.g * NRC + row) * 128 + wc * 32 + 16 * n + 4 * fq)) = v; } }
    }
};
struct EpiY {
    static constexpr bool PERM = true, AFTER_DRAIN = false;
    const bf16_t* U; const float* dskip; bf16_t* Y;
    __device__ __forceinline__ void operator()(const f32x4 (&acc)[2][2][4][2], const Unit& u, int wr, int wc, int fr, int fq) const {
        f32x4 dk[2][2];
#pragma unroll
        for (int bj = 0; bj < 2; ++bj) { const int co = (bj * HALF + wc * 32 + 8 * fq) & 15; dk[bj][0] = *(const f32x4*)(dskip + u.g * 16 + co); dk[bj][1] = *(const f32x4*)(dskip + u.g * 16 + co + 4); }
#pragma unroll
        for (int ai = 0; ai < 2; ++ai) {
            u32x4 uw[4][2];
            EPI_HALF_PRE({ const int rc = u.pm * BM + lrow, n = u.pn * BM + lcol; uw[m][bj] = *(const u32x4*)(U + ((size_t)(u.g * NRC + rc) * KY + n)); })
            EPI_HALF_RUN({
                const int rc = u.pm * BM + lrow, n = u.pn * BM + lcol, tt = n >> 4, co = n & 15;
                float uf[8]; unpack8(uw[m][bj], uf);
                const float dd[8] = {dk[bj][0][0], dk[bj][0][1], dk[bj][0][2], dk[bj][0][3], dk[bj][1][0], dk[bj][1][1], dk[bj][1][2], dk[bj][1][3]};
                _Pragma("unroll") for (int i = 0; i < 8; ++i) { const float y = v[i] + dd[i] * uf[i]; const float z = 1.5957691216057308f * (y + 0.044715f * y * y * y); v[i] = y * sigmoidf_(z); }
                *(u32x4*)(Y + ((size_t)(rc * LC + tt) * S5W + u.g * 16 + co)) = pack8(v);
            })
        }
    }
};
struct EpiGlu {
    static constexpr bool PERM = true, AFTER_DRAIN = false;
    const bf16_t* Y; const float* bias; bf16_t* O; int ldo;
    __device__ __forceinline__ void operator()(const f32x4 (&acc)[2][2][4][2], const Unit& u, int wr, int wc, int fr, int fq) const {
        f32x4 bv[2][2];
#pragma unroll
        for (int bj = 0; bj < 2; ++bj) { const int col = u.pn * BM + bj * HALF + wc * 32 + 8 * fq; bv[bj][0] = *(const f32x4*)(bias + col); bv[bj][1] = *(const f32x4*)(bias + col + 4); }
#pragma unroll
        for (int ai = 0; ai < 2; ++ai) {
            u32x4 yw[4][2];
            EPI_HALF_PRE({ const int row = u.pm * BM + lrow, col = u.pn * BM + lcol; yw[m][bj] = *(const u32x4*)(Y + (size_t)row * S5W + col); })
            EPI_HALF_RUN({
                const int row = u.pm * BM + lrow, col = u.pn * BM + lcol;
                float yf[8]; unpack8(yw[m][bj], yf);
                const float bb[8] = {bv[bj][0][0], bv[bj][0][1], bv[bj][0][2], bv[bj][0][3], bv[bj][1][0], bv[bj][1][1], bv[bj][1][2], bv[bj][1][3]};
                _Pragma("unroll") for (int i = 0; i < 8; ++i) v[i] = yf[i] * sigmoidf_(v[i] + bb[i]);
                *(u32x4*)(O + (size_t)row * ldo + col) = pack8(v);
            })
        }
    }
};
struct NoHook { static constexpr int AT = -1; __device__ __forceinline__ void operator()(f32x4 (&)[2][2][4][2], const Unit&, int, int, int, int) const {} };
struct HookGate {
    static constexpr int AT = D / BK;
    const bf16_t* Gt;
    __device__ __forceinline__ void operator()(f32x4 (&acc)[2][2][4][2], const Unit& u, int wr, int wc, int fr, int fq) const {
#pragma unroll
        for (int ai = 0; ai < 2; ++ai)
#pragma unroll
            for (int mh = 0; mh < 2; ++mh) {
                u32x4 gs[2][2], ga[2][2];
#pragma unroll
                for (int mm = 0; mm < 2; ++mm)
#pragma unroll
                    for (int bj = 0; bj < 2; ++bj) { const int lrow = ai * HALF + wr * 64 + (2 * mh + mm) * 16 + fr, lcol = bj * HALF + wc * 32 + 8 * fq;
                        const bf16_t* p = Gt + (size_t)(u.pm * BM + lrow) * 2048 + u.pn * BM + lcol; gs[mm][bj] = *(const u32x4*)p; ga[mm][bj] = *(const u32x4*)(p + D); }
#pragma unroll
                for (int mm = 0; mm < 2; ++mm)
#pragma unroll
                    for (int bj = 0; bj < 2; ++bj) { float fs[8], fa[8]; unpack8(gs[mm][bj], fs); unpack8(ga[mm][bj], fa);
#pragma unroll
                        for (int i = 0; i < 8; ++i) acc[ai][bj][2 * mh + mm][i >> 2][i & 3] *= fa[i] * __builtin_amdgcn_rcpf(__builtin_fmaxf(fs[i], 1e-20f)); }
            }
    }
};
struct EpiMerge {
    static constexpr bool PERM = true, AFTER_DRAIN = false;
    const bf16_t* Gt; bf16_t* O;
    __device__ __forceinline__ void operator()(const f32x4 (&acc)[2][2][4][2], const Unit& u, int wr, int wc, int fr, int fq) const {
#pragma unroll
        for (int ai = 0; ai < 2; ++ai) {
            u32x4 gw[4][2];
            EPI_HALF_PRE({ const int row = u.pm * BM + lrow, col = u.pn * BM + lcol; gw[m][bj] = *(const u32x4*)(Gt + (size_t)row * 2048 + col); })
            EPI_HALF_RUN({
                const int row = u.pm * BM + lrow, col = u.pn * BM + lcol;
                float gf[8]; unpack8(gw[m][bj], gf);
                _Pragma("unroll") for (int i = 0; i < 8; ++i) v[i] = gf[i] * v[i];
                *(u32x4*)(O + (size_t)row * D + col) = pack8(v);
            })
        }
    }
};
struct EpiOut {
    static constexpr bool PERM = true, AFTER_DRAIN = false;
    const float* x; const float* mod; bf16_t* H;
    __device__ __forceinline__ void operator()(const f32x4 (&acc)[2][2][4][2], const Unit& u, int wr, int wc, int fr, int fq) const {
        const int b = (u.pm * BM) / SEQ; const float* gt = mod + (size_t)b * 6 * D + 2 * D;
        f32x4 gv[2][2];
#pragma unroll
        for (int bj = 0; bj < 2; ++bj) { const int col = u.pn * BM + bj * HALF + wc * 32 + 8 * fq; gv[bj][0] = *(const f32x4*)(gt + col); gv[bj][1] = *(const f32x4*)(gt + col + 4); }
#pragma unroll
        for (int ai = 0; ai < 2; ++ai) {
            f32x4 xv[4][2][2];
            EPI_HALF_PRE({ const size_t off = (size_t)(u.pm * BM + lrow) * D + u.pn * BM + lcol; xv[m][bj][0] = *(const f32x4*)(x + off); xv[m][bj][1] = *(const f32x4*)(x + off + 4); })
            EPI_HALF_RUN({
                const size_t off = (size_t)(u.pm * BM + lrow) * D + u.pn * BM + lcol;
                _Pragma("unroll") for (int i = 0; i < 4; ++i) { v[i] = xv[m][bj][0][i] + gv[bj][0][i] * v[i]; v[4 + i] = xv[m][bj][1][i] + gv[bj][1][i] * v[4 + i]; }
                *(u32x4*)(H + off) = pack8(v);
            })
        }
    }
};
struct EpiRouter {
    static constexpr bool PERM = false, AFTER_DRAIN = false;
    float* L;
    __device__ __forceinline__ void operator()(const f32x4 (&acc)[2][2][4][2], const Unit& u, int wr, int wc, int fr, int fq) const {
        if (wc < 2) {
#pragma unroll
            for (int ai = 0; ai < 2; ++ai)
#pragma unroll
                for (int m = 0; m < 4; ++m) { const int row = u.pm * BM + ai * HALF + wr * 64 + m * 16 + fr;
#pragma unroll
                    for (int n = 0; n < 2; ++n) { const f32x4 v = acc[ai][0][m][n] + acc[ai][1][m][n]; *(f32x4*)(L + (size_t)row * 64 + wc * 32 + 16 * n + 4 * fq) = v; } }
        }
    }
};
struct EpiExp1 {
    static constexpr bool PERM = true, AFTER_DRAIN = false;
    bf16_t* Hd;
    __device__ __forceinline__ void operator()(const f32x4 (&acc)[2][2][4][2], const Unit& u, int wr, int wc, int fr, int fq) const {
#pragma unroll
        for (int ai = 0; ai < 2; ++ai)
#pragma unroll
            for (int m = 0; m < 4; ++m) { const int row = u.pm * BM + ai * HALF + wr * 64 + m * 16 + fr; float v[8];
#pragma unroll
                for (int n = 0; n < 2; ++n)
#pragma unroll
                    for (int i = 0; i < 4; ++i) { const float g = acc[ai][0][m][n][i], up = acc[ai][1][m][n][i]; v[n * 4 + i] = g * sigmoidf_(g) * up; }
                *(u32x4*)(Hd + (size_t)row * DEXP + u.pn * HALF + wc * 32 + 8 * fq) = pack8(v); }
    }
};
struct EpiExp2 {
    static constexpr bool PERM = true, AFTER_DRAIN = false;
    const int* list; const float* cwl; const int* cnt; bf16_t* Sl;
    __device__ __forceinline__ void operator()(const f32x4 (&acc)[2][2][4][2], const Unit& u, int wr, int wc, int fr, int fq) const {
        const int n = cnt[u.g];
#pragma unroll
        for (int ai = 0; ai < 2; ++ai) {
            int dd[4]; float ww[4];
#pragma unroll
            for (int m = 0; m < 4; ++m) { const int pos = u.lt * BM + ai * HALF + wr * 64 + m * 16 + fr; const bool ok = pos < n; const size_t li = (size_t)u.g * T + (ok ? pos : 0);
                const int d = list[li]; const float w = cwl[li]; dd[m] = ok ? d : -1; ww[m] = w; }
            EPI_HALF_RUN({
                const int col = u.pn * BM + lcol; const int d = dd[m]; const float w = ww[m];
                if (d >= 0) { _Pragma("unroll") for (int i = 0; i < 8; ++i) v[i] *= w; *(u32x4*)(Sl + (size_t)d * D + col) = pack8(v); }
            })
        }
    }
};

template <class Epi, class Sched, bool ALIGN_EPI = false, bool SP2 = false, bool GATHER = false, class Hook = NoHook>
__device__ __forceinline__ void gemm_phase(PG8_LAS unsigned char* lds, const int K, const int lda, const int ldb, const Sched& S, const Epi& E, const PG8_LAS int* rowtab = nullptr, const Hook& HK = Hook()) {
    int tid = threadIdx.x; asm volatile("" : "+v"(tid));
    const int wid = __builtin_amdgcn_readfirstlane(tid >> 6), lane = tid & 63, wr = wid >> 2, wc = wid & 3, fr = lane & 15, fq = lane >> 4;
    const int nt = K / BK;
    unsigned voffA[2], voffB[2]; int gR[2]; unsigned gC[2];
#pragma unroll
    for (int i = 0; i < 2; ++i) { int R, C; stage_rc(tid * 16 + i * 8192, R, C); const int Rb = Epi::PERM ? ((R & ~31) + perm32(R & 31)) : R;
        voffA[i] = (unsigned)(R * lda + C) * 2u; voffB[i] = (unsigned)(Rb * ldb + C) * 2u; gR[i] = R; gC[i] = (unsigned)C * 2u; }
    unsigned vAc[2][2], vAn[2][2], vA2[2][2];
    (void)gR; (void)gC; (void)vAc; (void)vAn; (void)vA2;
#define PG8_GLOAD(dst, ui_) do { _Pragma("unroll") for (int _h = 0; _h < 2; ++_h) _Pragma("unroll") for (int _i = 0; _i < 2; ++_i) \
        dst[_h][_i] = (unsigned)rowtab[(ui_) * 256 + _h * HALF + gR[_i]] * (unsigned)(lda * 2) + gC[_i]; } while (0)
    const size_t kstep = (size_t)(BK * 2);
    const size_t hstepA = (size_t)HALF * lda * 2, hstepB = (size_t)HALF * ldb * 2;
    const unsigned ldsw = (unsigned)wid * 1024u;
    const int aoff = lds_byte(wr * 64 + fr, fq * 8), boff = lds_byte(wc * 32 + fr, fq * 8);
#define PG8_SA(b, h) (((b) * 2 + (h)) * HTB)
#define PG8_SB(b, h) ((4 + (b) * 2 + (h)) * HTB)
#define PG8_STAGE(bufoff, gbase, voff) do { _Pragma("unroll") for (int _i = 0; _i < 2; ++_i) \
        __builtin_amdgcn_global_load_lds((const unsigned*)((const char*)(gbase) + (voff)[_i]), (PG8_LAS unsigned*)(lds + (bufoff) + ldsw + _i * 8192), 16, 0, 0); } while (0)
#define PG8_STAGE_A(bufoff, gbase, h, vs) do { if constexpr (GATHER) { PG8_STAGE(bufoff, gbase, vs[h]); } else { PG8_STAGE(bufoff, (gbase) + (h) * hstepA, voffA); } } while (0)
#define PG8_LDA(dst, b, h) do { _Pragma("unroll") for (int m = 0; m < 4; ++m) _Pragma("unroll") for (int k = 0; k < 2; ++k) dst[m][k] = *(const PG8_LAS bf16x8*)(lds + PG8_SA(b, h) + aoff + m * 2048 + k * 1024); } while (0)
#define PG8_LDB(dst, b, h) do { _Pragma("unroll") for (int n = 0; n < 2; ++n) _Pragma("unroll") for (int k = 0; k < 2; ++k) dst[n][k] = *(const PG8_LAS bf16x8*)(lds + PG8_SB(b, h) + boff + n * 2048 + k * 1024); } while (0)
#define PG8_MMA(ai, bj, At, Bt) do { __builtin_amdgcn_s_setprio(1); _Pragma("unroll") for (int m = 0; m < 4; ++m) _Pragma("unroll") for (int n = 0; n < 2; ++n) _Pragma("unroll") for (int k = 0; k < 2; ++k) \
        acc[ai][bj][m][n] = __builtin_amdgcn_mfma_f32_16x16x32_bf16(Bt[n][k], At[m][k], acc[ai][bj][m][n], 0, 0, 0); __builtin_amdgcn_s_setprio(0); } while (0)
#define PG8_WAIT_V(n) asm volatile("s_waitcnt vmcnt(" #n ")" ::: "memory")
#define PG8_WAIT_L(n) asm volatile("s_waitcnt lgkmcnt(" #n ")" ::: "memory")
#define PG8_BAR __builtin_amdgcn_s_barrier()
#define PG8_SCHED __builtin_amdgcn_sched_barrier(0)
    Unit cur, nxt; int ui = 0;
    if (!S.next(0, cur)) return;
    f32x4 acc[2][2][4][2];
#pragma unroll
    for (int a = 0; a < 2; ++a)
#pragma unroll
        for (int b = 0; b < 2; ++b)
#pragma unroll
            for (int m = 0; m < 4; ++m)
#pragma unroll
                for (int n = 0; n < 2; ++n) acc[a][b][m][n] = (f32x4){0.f, 0.f, 0.f, 0.f};
    bf16x8 At[4][2], B0[2][2], B1[2][2];
    const char* cA = cur.a; const char* cB = cur.b;
    if constexpr (GATHER) { PG8_GLOAD(vAc, 0); }
    static_assert(SP2 || !GATHER, "GATHER is wired into the SP2 loop only");
    if constexpr (SP2) {
        PG8_STAGE(PG8_SB(0, 0), cB, voffB); PG8_STAGE(PG8_SB(0, 1), cB + hstepB, voffB); PG8_STAGE_A(PG8_SA(0, 0), cA, 0, vAc); PG8_STAGE_A(PG8_SA(0, 1), cA, 1, vAc);
        if (wr == 1) PG8_BAR;
        PG8_WAIT_V(2); PG8_BAR;
        PG8_STAGE(PG8_SB(1, 0), cB + kstep, voffB); PG8_STAGE_A(PG8_SA(1, 0), cA + kstep, 0, vAc); PG8_STAGE(PG8_SB(1, 1), cB + hstepB + kstep, voffB);
        PG8_WAIT_V(6); PG8_BAR;
    } else {
        PG8_STAGE(PG8_SB(0, 0), cB, voffB); PG8_STAGE(PG8_SA(0, 0), cA, voffA); PG8_STAGE(PG8_SB(0, 1), cB + hstepB, voffB); PG8_STAGE(PG8_SA(0, 1), cA + hstepA, voffA);
        if (wr == 1) PG8_BAR;
        PG8_WAIT_V(4); PG8_BAR;
        PG8_STAGE(PG8_SB(1, 0), cB + kstep, voffB); PG8_STAGE(PG8_SA(1, 0), cA + kstep, voffA); PG8_STAGE(PG8_SB(1, 1), cB + hstepB + kstep, voffB);
        PG8_WAIT_V(6); PG8_BAR;
    }
    for (;;) {
        const bool has_next = S.next(ui + 1, nxt);
        const char* nA = has_next ? nxt.a : cA; const char* nB = has_next ? nxt.b : cB;
        if constexpr (GATHER) { if (has_next) { PG8_GLOAD(vAn, ui + 1); } else {
            _Pragma("unroll") for (int _h = 0; _h < 2; ++_h) _Pragma("unroll") for (int _i = 0; _i < 2; ++_i) vAn[_h][_i] = vAc[_h][_i]; } }
        for (int t = 0; t < nt; t += 2) {
            const bool last = (t == nt - 2);
            if constexpr (GATHER) { _Pragma("unroll") for (int _h = 0; _h < 2; ++_h) _Pragma("unroll") for (int _i = 0; _i < 2; ++_i) vA2[_h][_i] = last ? vAn[_h][_i] : vAc[_h][_i]; }
            if constexpr (Hook::AT >= 0) { if (t == Hook::AT) HK(acc, cur, wr, wc, fr, fq); }
            const char* a1 = cA + (size_t)(t + 1) * kstep;
            const char* a2 = last ? nA : cA + (size_t)(t + 2) * kstep; const char* b2 = last ? nB : cB + (size_t)(t + 2) * kstep;
            const char* a3 = a2 + kstep; const char* b3 = b2 + kstep;
            if constexpr (SP2) {
            PG8_LDB(B0, 0, 0); PG8_LDB(B1, 0, 1); PG8_SCHED; PG8_LDA(At, 0, 0); PG8_STAGE_A(PG8_SA(1, 1), a1, 1, vAc);
            PG8_WAIT_V(8); PG8_WAIT_L(0); PG8_BAR; PG8_MMA(0, 0, At, B0); PG8_MMA(0, 1, At, B1); PG8_BAR; PG8_SCHED;
            PG8_LDA(At, 0, 1); PG8_STAGE(PG8_SB(0, 0), b2, voffB); PG8_STAGE(PG8_SB(0, 1), b2 + hstepB, voffB); PG8_STAGE_A(PG8_SA(0, 0), a2, 0, vA2);
            PG8_WAIT_V(8); PG8_WAIT_L(0); PG8_BAR; PG8_MMA(1, 0, At, B0); PG8_MMA(1, 1, At, B1); PG8_BAR; PG8_SCHED;
            PG8_LDB(B0, 1, 0); PG8_LDB(B1, 1, 1); PG8_SCHED; PG8_LDA(At, 1, 0); PG8_STAGE_A(PG8_SA(0, 1), a2, 1, vA2);
            PG8_WAIT_V(8); PG8_WAIT_L(0); PG8_BAR; PG8_MMA(0, 0, At, B0); PG8_MMA(0, 1, At, B1); PG8_BAR; PG8_SCHED;
            PG8_LDA(At, 1, 1); PG8_STAGE(PG8_SB(1, 0), b3, voffB); PG8_STAGE(PG8_SB(1, 1), b3 + hstepB, voffB); PG8_STAGE_A(PG8_SA(1, 0), a3, 0, vA2);
            PG8_WAIT_V(8); PG8_WAIT_L(0); PG8_BAR; PG8_MMA(1, 0, At, B0); PG8_MMA(1, 1, At, B1); PG8_BAR; PG8_SCHED;
            } else {
            PG8_LDB(B0, 0, 0); PG8_SCHED; PG8_LDA(At, 0, 0); PG8_STAGE(PG8_SA(1, 1), a1 + hstepA, voffA);
            PG8_WAIT_L(8); PG8_BAR; PG8_WAIT_L(0); PG8_MMA(0, 0, At, B0); PG8_BAR; PG8_SCHED;
            PG8_LDB(B1, 0, 1); PG8_STAGE(PG8_SB(0, 0), b2, voffB);
            PG8_BAR; PG8_WAIT_L(0); PG8_MMA(0, 1, At, B1); PG8_BAR;
            PG8_LDA(At, 0, 1); PG8_STAGE(PG8_SA(0, 0), a2, voffA);
            PG8_BAR; PG8_WAIT_L(0); PG8_MMA(1, 0, At, B0); PG8_BAR; PG8_SCHED;
            PG8_STAGE(PG8_SB(0, 1), b2 + hstepB, voffB);
            PG8_WAIT_V(6); PG8_BAR; PG8_MMA(1, 1, At, B1); PG8_BAR;
            PG8_LDB(B0, 1, 0); PG8_SCHED; PG8_LDA(At, 1, 0); PG8_STAGE(PG8_SA(0, 1), a2 + hstepA, voffA);
            PG8_WAIT_L(8); PG8_BAR; PG8_WAIT_L(0); PG8_MMA(0, 0, At, B0); PG8_BAR; PG8_SCHED;
            PG8_LDB(B1, 1, 1); PG8_STAGE(PG8_SB(1, 0), b3, voffB);
            PG8_BAR; PG8_WAIT_L(0); PG8_MMA(0, 1, At, B1); PG8_BAR;
            PG8_LDA(At, 1, 1); PG8_STAGE(PG8_SA(1, 0), a3, voffA);
            PG8_BAR; PG8_WAIT_L(0); PG8_MMA(1, 0, At, B0); PG8_BAR; PG8_SCHED;
            PG8_STAGE(PG8_SB(1, 1), b3 + hstepB, voffB);
            PG8_WAIT_V(6); PG8_BAR; PG8_MMA(1, 1, At, B1); PG8_BAR;
            }
        }
        if constexpr (ALIGN_EPI) { if (wr == 0) PG8_BAR; }
        E(acc, cur, wr, wc, fr, fq);
        if (!has_next) break;
#pragma unroll
        for (int a = 0; a < 2; ++a)
#pragma unroll
            for (int b = 0; b < 2; ++b)
#pragma unroll
                for (int m = 0; m < 4; ++m)
#pragma unroll
                    for (int n = 0; n < 2; ++n) acc[a][b][m][n] = (f32x4){0.f, 0.f, 0.f, 0.f};
        cur = nxt; cA = nA; cB = nB; ++ui;
        if constexpr (GATHER) { _Pragma("unroll") for (int _h = 0; _h < 2; ++_h) _Pragma("unroll") for (int _i = 0; _i < 2; ++_i) vAc[_h][_i] = vAn[_h][_i]; }
        if constexpr (ALIGN_EPI) { if (wr == 1) PG8_BAR; }
    }
    PG8_WAIT_V(0);
    if constexpr (!ALIGN_EPI) { if (wr == 0) PG8_BAR; }
    PG8_BAR;
#undef PG8_SA
#undef PG8_SB
#undef PG8_STAGE
#undef PG8_STAGE_A
#undef PG8_GLOAD
#undef PG8_LDA
#undef PG8_LDB
#undef PG8_MMA
#undef PG8_WAIT_V
#undef PG8_WAIT_L
#undef PG8_BAR
#undef PG8_SCHED
}
}

namespace attn_body {
using bf16=__hip_bfloat16;
using bf16x8=__attribute__((ext_vector_type(8)))short;
using s16x4=__attribute__((ext_vector_type(4)))short;
using f32x16=__attribute__((ext_vector_type(16)))float;
using u32x4=__attribute__((ext_vector_type(4)))unsigned;
constexpr int NHEAD=16,SEQ=4096,D=64,DM=NHEAD*D;
constexpr int NW=8,QBLK=32,QB=QBLK*NW,KVBLK=64,NQB=SEQ/QB;
__device__ __forceinline__ int crow(int r,int hi){return (r&3)+8*(r>>2)+4*hi;}
#define SBAR() __builtin_amdgcn_sched_barrier(0)
__device__ __forceinline__ void cmask(f32x16&p0,f32x16&p1,int jb,int wid){
  const float NEG=-INFINITY;
  if(jb>(wid>>1)){
  #pragma unroll
  for(int r=0;r<16;++r){p0[r]=NEG;p1[r]=NEG;}}
}
constexpr int NSLOT=3, SLOTB=8192, VSLOTB=16384;
constexpr int LDS_K=0, LDS_V=NSLOT*SLOTB, LDS_WS=LDS_V+NSLOT*VSLOTB, LDS_OST=LDS_WS+NW*64*4, LDS_BYTES=LDS_OST+NW*8192;
constexpr float C2=0.125f*1.4426950408889634f;
__device__ __forceinline__ void glds16(const char*sbase,unsigned voff,unsigned lds_dst){unsigned keep;
  asm volatile("s_mov_b32 %0, m0\n\ts_mov_b32 m0, %2\n\ts_nop 0\n\tglobal_load_lds_dwordx4 %1, %3\n\ts_mov_b32 m0, %0":"=&s"(keep):"v"(voff),"s"(lds_dst),"s"(sbase):"memory");}
__device__ __forceinline__ float max3f(float a,float b,float c){float r;asm("v_max3_f32 %0, %1, %2, %3":"=v"(r):"v"(a),"v"(b),"v"(c));return r;}
__device__ __forceinline__ float max2f(float a,float b){float r;asm("v_max_f32_e32 %0, %1, %2":"=v"(r):"v"(a),"v"(b));return r;}
typedef float f32x2_t __attribute__((ext_vector_type(2))); typedef __bf16 bf16x2_t __attribute__((ext_vector_type(2)));
__device__ __forceinline__ unsigned cvtpk_s(float lo,float hi){f32x2_t v={lo,hi};bf16x2_t b=__builtin_convertvector(v,bf16x2_t);return __builtin_bit_cast(unsigned,b);}
#define WAIT_BAR(N) asm volatile("s_waitcnt vmcnt(" #N ") lgkmcnt(0)\n\ts_barrier":::"memory")

__device__ __forceinline__ void qkt(f32x16&p0,f32x16&p1,const char*Kslot,const bf16x8*qr,int r32,int hi){
  const char*kb=Kslot+hi*1024+r32*16; const f32x16 z=f32x16{};
  #pragma unroll
  for(int d0=0;d0<4;++d0){
    const bf16x8 b0=*reinterpret_cast<const bf16x8*>(kb+d0*2048);
    const bf16x8 b1=*reinterpret_cast<const bf16x8*>(kb+d0*2048+512);
    if(d0==0){p0=__builtin_amdgcn_mfma_f32_32x32x16_bf16(b0,qr[0],z,0,0,0);p1=__builtin_amdgcn_mfma_f32_32x32x16_bf16(b1,qr[0],z,0,0,0);}
    else{p0=__builtin_amdgcn_mfma_f32_32x32x16_bf16(b0,qr[d0],p0,0,0,0);p1=__builtin_amdgcn_mfma_f32_32x32x16_bf16(b1,qr[d0],p1,0,0,0);}}
}
typedef __attribute__((address_space(3))) const char* lds_cptr;
typedef short v4i16_t __attribute__((ext_vector_type(4)));
__device__ __forceinline__ void kload8(bf16x8*kf,lds_cptr kp){
  kf[0]=*(const __attribute__((address_space(3))) bf16x8*)(kp);      kf[1]=*(const __attribute__((address_space(3))) bf16x8*)(kp+512);
  kf[2]=*(const __attribute__((address_space(3))) bf16x8*)(kp+2048); kf[3]=*(const __attribute__((address_space(3))) bf16x8*)(kp+2560);
  kf[4]=*(const __attribute__((address_space(3))) bf16x8*)(kp+4096); kf[5]=*(const __attribute__((address_space(3))) bf16x8*)(kp+4608);
  kf[6]=*(const __attribute__((address_space(3))) bf16x8*)(kp+6144); kf[7]=*(const __attribute__((address_space(3))) bf16x8*)(kp+6656);
}
__device__ __forceinline__ void kload2(bf16x8*kf,lds_cptr kp,int j){ kf[2*j]=*(const __attribute__((address_space(3))) bf16x8*)(kp+j*2048); kf[2*j+1]=*(const __attribute__((address_space(3))) bf16x8*)(kp+j*2048+512); }
__device__ __forceinline__ s16x4 vtr(lds_cptr p){ return __builtin_bit_cast(s16x4,__builtin_amdgcn_ds_read_tr16_b64_v4i16((__attribute__((address_space(3))) v4i16_t*)p)); }
__device__ __forceinline__ float rowmax(const f32x16&p0,const f32x16&p1){
  float a=max3f(p0[0],p0[1],p1[0]),b=max3f(p0[2],p0[3],p1[1]);a=max3f(a,p1[2],p1[3]);
  #pragma unroll
  for(int r=4;r<16;r+=4){a=max3f(a,p0[r],p0[r+1]);b=max3f(b,p0[r+2],p0[r+3]);a=max3f(a,p1[r],p1[r+1]);b=max3f(b,p1[r+2],p1[r+3]);}
  const float m=max2f(a,b);
  auto rr=__builtin_amdgcn_permlane32_swap(__float_as_uint(m),__float_as_uint(m),false,false);
  return max2f(__uint_as_float(rr[0]),__uint_as_float(rr[1]));
}
__device__ __forceinline__ void pv(f32x16*o,int vb,bf16x8 pa0,bf16x8 pa1,bf16x8 pa2,bf16x8 pa3){
  #pragma unroll
  for(int d0=0;d0<4;++d0){s16x4 lo[4],hi[4];
    #pragma unroll
    for(int ks=0;ks<4;++ks){
      asm volatile("ds_read_b64_tr_b16 %0,%1 offset:%c2":"=&v"(lo[ks]):"v"(vb),"i"(d0*4096+ks*1024):"memory");
      asm volatile("ds_read_b64_tr_b16 %0,%1 offset:%c2":"=&v"(hi[ks]):"v"(vb),"i"(d0*4096+ks*1024+512):"memory");}
    asm volatile("s_waitcnt lgkmcnt(0)":::"memory");SBAR();
    #define PK(k) (bf16x8){lo[k][0],lo[k][1],lo[k][2],lo[k][3],hi[k][0],hi[k][1],hi[k][2],hi[k][3]}
    o[d0]=__builtin_amdgcn_mfma_f32_32x32x16_bf16(pa0,PK(0),o[d0],0,0,0);
    o[d0]=__builtin_amdgcn_mfma_f32_32x32x16_bf16(pa1,PK(1),o[d0],0,0,0);
    o[d0]=__builtin_amdgcn_mfma_f32_32x32x16_bf16(pa2,PK(2),o[d0],0,0,0);
    o[d0]=__builtin_amdgcn_mfma_f32_32x32x16_bf16(pa3,PK(3),o[d0],0,0,0);
    #undef PK
  }
}
template<int THRL,int FTHR,size_t OFF_Q,size_t OFF_K,size_t OFF_V,int GSO,int AOP> __device__ __forceinline__ void attn_unit(int b,int h,int qb,const char*ws,bf16*AO,float lam,char*shm){
  const bf16*Q=(const bf16*)(ws+OFF_Q); const float*gs=(const float*)(shm+GSO);
  int tid=threadIdx.x; asm volatile("":"+v"(tid)); const int lane=tid&63,r32=lane&31,hi=lane>>5; const int wid=__builtin_amdgcn_readfirstlane(tid>>6);
  const long rowbase=(long)b*SEQ; const int q0=qb*QB;
  const unsigned lds0=(unsigned)(uintptr_t)shm;
  float*wsf=(float*)(shm+LDS_WS)+wid*64;
  bf16*stg=(bf16*)(shm+LDS_OST)+wid*4096;
  const unsigned kdst=lds0+LDS_K+wid*1024, vdst=lds0+LDS_V+wid*1024;
  const int vb0=(int)(lds0+LDS_V)+((lane>>4)&1)*32+(lane&3)*8+(4*hi+((lane&15)>>2))*64;
  const char*Kbase=shm+LDS_K;
  const lds_cptr shm3=(lds_cptr)shm; const lds_cptr kp0=shm3+LDS_K+hi*1024+r32*16; const lds_cptr vp0=shm3+LDS_V+((lane>>4)&1)*32+(lane&3)*8+(4*hi+((lane&15)>>2))*64;
  const int NT=(q0+QB)/KVBLK;
  const char*Vh=ws+OFF_V+(rowbase*DM+h*128)*2;
  const unsigned vsrc=(unsigned)(((16*(wid&3)+(lane>>2))*DM+(wid>>2)*32+(lane&3)*8)*2);
  #pragma unroll 1
  for(int mp=0;mp<2;++mp){
  const int hq=2*h+mp;
  const bf16*Qw=Q+(rowbase+q0+wid*QBLK)*DM+hq*D;
  const char*Kh=ws+OFF_K+(rowbase*DM+hq*D)*2;
  const unsigned ksrc=(unsigned)((lane*DM+wid*8)*2);
  bf16x8 kf[8];
  #define DMA_K(t,slot) glds16(Kh+(long)(t)*(KVBLK*DM*2),ksrc,(unsigned)__builtin_amdgcn_readfirstlane(kdst+(slot)))
  #define DMA_V(t,slot) do{ glds16(Vh+(long)(t)*(KVBLK*DM*2),vsrc,(unsigned)__builtin_amdgcn_readfirstlane(vdst+2*(slot))); glds16(Vh+(long)(t)*(KVBLK*DM*2)+128,vsrc,(unsigned)__builtin_amdgcn_readfirstlane(vdst+2*(slot)+8192)); }while(0)
  DMA_K(0,0);DMA_V(0,0);DMA_K(1,SLOTB);
  bf16x8 qr[4];
  #pragma unroll
  for(int d0=0;d0<4;++d0)qr[d0]=*reinterpret_cast<const bf16x8*>(&Qw[(long)r32*DM+d0*16+hi*8]);
  float mhat=0.f,l_reg=0.f;f32x16 o[4];o[0]=f32x16{};o[1]=f32x16{};o[2]=f32x16{};o[3]=f32x16{};
  #define CMASK(P0,P1,t) do{int jb_=(t)-(NT-4); if(jb_>=0)cmask(P0,P1,jb_,wid);}while(0)
  bool resc=false;
  #define RESC() do{ if(resc){ asm volatile("s_waitcnt lgkmcnt(0)":::"memory"); \
      _Pragma("unroll") for(int d_=0;d_<4;++d_) _Pragma("unroll") for(int r=0;r<16;++r)o[d_][r]*=wsf[crow(r,hi)]; } }while(0)
  f32x16 pA0,pA1,pB0,pB1;
  int sl_prev=0,sl_cur=0,sl_next=SLOTB;
  #define ROT() do{sl_prev=sl_cur;sl_cur=sl_next;sl_next=(sl_next==(NSLOT-1)*SLOTB)?0:sl_next+SLOTB;}while(0)
  DMA_K(2,2*SLOTB);
  WAIT_BAR(4);
  qkt(pA0,pA1,Kbase,qr,r32,hi);asm volatile("s_nop 15\n\ts_nop 7":"+v"(pA0),"+v"(pA1));CMASK(pA0,pA1,0);
  bool fastp;
  { const float rm=rowmax(pA0,pA1); fastp=!__any(__builtin_fabsf(rm)>(float)FTHR); mhat=fastp?0.f:rm; resc=false;
    _Pragma("unroll") for(int r=0;r<16;++r){pA0[r]=__builtin_amdgcn_exp2f(pA0[r]-mhat);pA1[r]=__builtin_amdgcn_exp2f(pA1[r]-mhat);} }
  WAIT_BAR(0);
  DMA_K(3,0);DMA_V(1,SLOTB);
  ROT();
  kload8(kf,kp0+sl_cur);
  WAIT_BAR(3);
  s16x4 vlo[8],vhi[8]; u32x4 pw0,pw1,pw2,pw3;
  #define PKW(P,B) cvtpk_s(P[B],P[B+1])
  #define PAF(k) __builtin_bit_cast(bf16x8,pw##k)
  #define VFR(i) (bf16x8){vlo[i][0],vlo[i][1],vlo[i][2],vlo[i][3],vhi[i][0],vhi[i][1],vhi[i][2],vhi[i][3]}
  #define PIN(x) asm volatile("":"+v"(x))
  #define MX3(a,b,c) __builtin_fmaxf(__builtin_fmaxf((a),(b)),(c))
  #define ZC (f32x16{})
  #define GAPA(MF,A0,A1,A2,A3,W0,W1,PW) do{ MF; sacc+=A0; sacc+=A1; sacc+=A2; sacc+=A3; PIN(sacc); W0; W1; PIN(PW); SBAR(); }while(0)
  #define EX0(v) __builtin_amdgcn_exp2f((v)-mhat)
  #define EX1(v) __builtin_amdgcn_exp2f(v)
  #define GAPB(F,MF,X,B) do{ MF; X[B]=EX##F(X[B]); X[B+1]=EX##F(X[B+1]); PIN(X); SBAR(); }while(0)
  #define VRD(i) do{ vlo[i]=vtr(vp_+(((i)>>2)*4096+((i)&3)*1024)); vhi[i]=vtr(vp_+(((i)>>2)*4096+((i)&3)*1024+512)); }while(0)
  #define VRD2(i) do{ vlo[i]=vtr(vp_+((2+((i)>>2))*4096+((i)&3)*1024)); vhi[i]=vtr(vp_+((2+((i)>>2))*4096+((i)&3)*1024+512)); SBAR(); }while(0)
  #define KRD(G,j) do{ if(G){ kload2(kf,kp0+sl_next,j); SBAR(); } }while(0)
  #define STEP(F,C0,C1,P0,P1,t,GK,GV,GL) do{ SBAR(); \
    const lds_cptr vp_=vp0+2*sl_prev; \
    VRD(0); SBAR(); float sacc=(P0[0]+P0[1]); \
    GAPA(C0=__builtin_amdgcn_mfma_f32_32x32x16_bf16(kf[0],qr[0],ZC,0,0,0), P0[2],P0[3],P0[4],P0[5],     pw0[0]=PKW(P0,0), pw0[1]=PKW(P0,2), pw0); \
    VRD(4); SBAR(); GAPA(C1=__builtin_amdgcn_mfma_f32_32x32x16_bf16(kf[1],qr[0],ZC,0,0,0), P0[6],P0[7],P0[8],P0[9],     pw0[2]=PKW(P0,4), pw0[3]=PKW(P0,6), pw0); \
    VRD(1); SBAR(); GAPA(C0=__builtin_amdgcn_mfma_f32_32x32x16_bf16(kf[2],qr[1],C0,0,0,0),   P0[10],P0[11],P0[12],P0[13], pw1[0]=PKW(P0,8), pw1[1]=PKW(P0,10), pw1); \
    VRD(5); SBAR(); GAPA(C1=__builtin_amdgcn_mfma_f32_32x32x16_bf16(kf[3],qr[1],C1,0,0,0),   P0[14],P0[15],P1[0],P1[1],   pw1[2]=PKW(P0,12),pw1[3]=PKW(P0,14), pw1); \
    VRD(2); SBAR(); GAPA(C0=__builtin_amdgcn_mfma_f32_32x32x16_bf16(kf[4],qr[2],C0,0,0,0),   P1[2],P1[3],P1[4],P1[5],     pw2[0]=PKW(P1,0), pw2[1]=PKW(P1,2), pw2); \
    VRD(6); SBAR(); GAPA(C1=__builtin_amdgcn_mfma_f32_32x32x16_bf16(kf[5],qr[2],C1,0,0,0),   P1[6],P1[7],P1[8],P1[9],     pw2[2]=PKW(P1,4), pw2[3]=PKW(P1,6), pw2); \
    VRD(3); SBAR(); GAPA(C0=__builtin_amdgcn_mfma_f32_32x32x16_bf16(kf[6],qr[3],C0,0,0,0),   P1[10],P1[11],P1[12],P1[13], pw3[0]=PKW(P1,8), pw3[1]=PKW(P1,10), pw3); \
    VRD(7); SBAR(); GAPA(C1=__builtin_amdgcn_mfma_f32_32x32x16_bf16(kf[7],qr[3],C1,0,0,0),   P1[14],P1[15],0.f,0.f,       pw3[2]=PKW(P1,12),pw3[3]=PKW(P1,14), pw3); \
    l_reg+=sacc; \
    if(GK){DMA_K((t)+3,sl_cur);} if(GV){DMA_V((t)+1,sl_next);} \
    CMASK(C0,C1,t); \
    { float a=MX3(C0[0],C0[1],C1[0]),b=MX3(C0[2],C0[3],C1[1]); a=MX3(a,C1[2],C1[3]); \
      _Pragma("unroll") for(int r=4;r<16;r+=4){a=MX3(a,C0[r],C0[r+1]);b=MX3(b,C0[r+2],C0[r+3]);a=MX3(a,C1[r],C1[r+1]);b=MX3(b,C1[r+2],C1[r+3]);} \
      float rm=__builtin_fmaxf(a,b); { auto rr=__builtin_amdgcn_permlane32_swap(__float_as_uint(rm),__float_as_uint(rm),false,false); rm=__builtin_fmaxf(__uint_as_float(rr[0]),__uint_as_float(rr[1])); } \
      rm-=mhat; resc=false; \
      if(__builtin_expect(__any(rm>(float)((F)?FTHR:THRL)),0)){ const float dl=__builtin_fmaxf(rm,0.f); mhat+=dl; \
        if(F){ fastp=false; _Pragma("unroll") for(int r=0;r<16;++r){C0[r]-=dl;C1[r]-=dl;} } \
        const float f=__builtin_amdgcn_exp2f(-dl); l_reg*=f; if(hi==0)wsf[r32]=f; resc=true; } } \
    SBAR(); \
    GAPB(F,o[0]=__builtin_amdgcn_mfma_f32_32x32x16_bf16(PAF(0),VFR(0),o[0],0,0,0), C0,0);  VRD2(0); \
    GAPB(F,o[1]=__builtin_amdgcn_mfma_f32_32x32x16_bf16(PAF(0),VFR(4),o[1],0,0,0), C0,2);  VRD2(4); \
    GAPB(F,o[0]=__builtin_amdgcn_mfma_f32_32x32x16_bf16(PAF(1),VFR(1),o[0],0,0,0), C0,4);  VRD2(1); \
    GAPB(F,o[1]=__builtin_amdgcn_mfma_f32_32x32x16_bf16(PAF(1),VFR(5),o[1],0,0,0), C0,6);  VRD2(5); \
    GAPB(F,o[0]=__builtin_amdgcn_mfma_f32_32x32x16_bf16(PAF(2),VFR(2),o[0],0,0,0), C0,8);  VRD2(2); \
    GAPB(F,o[1]=__builtin_amdgcn_mfma_f32_32x32x16_bf16(PAF(2),VFR(6),o[1],0,0,0), C0,10); VRD2(6); \
    GAPB(F,o[0]=__builtin_amdgcn_mfma_f32_32x32x16_bf16(PAF(3),VFR(3),o[0],0,0,0), C0,12); VRD2(3); \
    GAPB(F,o[1]=__builtin_amdgcn_mfma_f32_32x32x16_bf16(PAF(3),VFR(7),o[1],0,0,0), C0,14); VRD2(7); \
    KRD(GL,0); GAPB(F,o[2]=__builtin_amdgcn_mfma_f32_32x32x16_bf16(PAF(0),VFR(0),o[2],0,0,0), C1,0); \
    KRD(GL,1); GAPB(F,o[3]=__builtin_amdgcn_mfma_f32_32x32x16_bf16(PAF(0),VFR(4),o[3],0,0,0), C1,2); \
    KRD(GL,2); GAPB(F,o[2]=__builtin_amdgcn_mfma_f32_32x32x16_bf16(PAF(1),VFR(1),o[2],0,0,0), C1,4); \
    KRD(GL,3); GAPB(F,o[3]=__builtin_amdgcn_mfma_f32_32x32x16_bf16(PAF(1),VFR(5),o[3],0,0,0), C1,6); \
    GAPB(F,o[2]=__builtin_amdgcn_mfma_f32_32x32x16_bf16(PAF(2),VFR(2),o[2],0,0,0), C1,8); \
    GAPB(F,o[3]=__builtin_amdgcn_mfma_f32_32x32x16_bf16(PAF(2),VFR(6),o[3],0,0,0), C1,10); \
    GAPB(F,o[2]=__builtin_amdgcn_mfma_f32_32x32x16_bf16(PAF(3),VFR(3),o[2],0,0,0), C1,12); \
    GAPB(F,o[3]=__builtin_amdgcn_mfma_f32_32x32x16_bf16(PAF(3),VFR(7),o[3],0,0,0), C1,14); \
    }while(0)
  int t=1;
  #undef CMASK
  #define CMASK(P0,P1,t) do{}while(0)
  for(;fastp&&t+5<NT;t+=2){
    STEP(1,pB0,pB1,pA0,pA1,t,true,true,true);     WAIT_BAR(3); RESC(); ROT();
    STEP(1,pA0,pA1,pB0,pB1,t+1,true,true,true);   WAIT_BAR(3); RESC(); ROT();
  }
  for(;t+5<NT;t+=2){
    STEP(0,pB0,pB1,pA0,pA1,t,true,true,true);     WAIT_BAR(3); RESC(); ROT();
    STEP(0,pA0,pA1,pB0,pB1,t+1,true,true,true);   WAIT_BAR(3); RESC(); ROT();
  }
  #undef CMASK
  #define CMASK(P0,P1,t) do{int jb_=(t)-(NT-4); if(jb_>=0)cmask(P0,P1,jb_,wid);}while(0)
  #define ENDW(tt) do{ if((tt)+3<NT){WAIT_BAR(3);} else if((tt)+2<NT){WAIT_BAR(2);} else {WAIT_BAR(0);} }while(0)
  for(;t+1<NT;t+=2){
    STEP(0,pB0,pB1,pA0,pA1,t,(t+3<NT),(t+1<NT),(t+1<NT));       ENDW(t);   RESC(); ROT();
    STEP(0,pA0,pA1,pB0,pB1,t+1,(t+4<NT),(t+2<NT),(t+2<NT));     ENDW(t+1); RESC(); ROT();
  }
  STEP(0,pB0,pB1,pA0,pA1,NT-1,false,false,false); RESC();
  { float sacc=pB0[0]+pB0[1]; _Pragma("unroll") for(int r=2;r<16;++r)sacc+=pB0[r]; _Pragma("unroll") for(int r=0;r<16;++r)sacc+=pB1[r]; l_reg+=sacc;
    pw0=(u32x4){PKW(pB0,0),PKW(pB0,2),PKW(pB0,4),PKW(pB0,6)};pw1=(u32x4){PKW(pB0,8),PKW(pB0,10),PKW(pB0,12),PKW(pB0,14)};pw2=(u32x4){PKW(pB1,0),PKW(pB1,2),PKW(pB1,4),PKW(pB1,6)};pw3=(u32x4){PKW(pB1,8),PKW(pB1,10),PKW(pB1,12),PKW(pB1,14)};
    SBAR(); pv(o,vb0+2*sl_cur,PAF(0),PAF(1),PAF(2),PAF(3)); }
  #undef PKW
  #undef PAF
  #undef VFR
  #undef PIN
  #undef MX3
  #undef ZC
  #undef GAPA
  #undef GAPB
  #undef EX0
  #undef EX1
  #undef VRD
  #undef VRD2
  #undef KRD
  #undef STEP
  #undef ENDW
  #undef DMA_K
  #undef DMA_V
  #undef CMASK
  #undef RESC
  #undef ROT
  {auto rr=__builtin_amdgcn_permlane32_swap(__float_as_uint(l_reg),__float_as_uint(l_reg),false,false);l_reg=__uint_as_float(rr[0])+__uint_as_float(rr[1]);}
  if(hi==0)wsf[32+r32]=l_reg;asm volatile("s_waitcnt lgkmcnt(0)":::"memory");
  float rli[16];
  #pragma unroll
  for(int r=0;r<16;++r)rli[r]=__builtin_amdgcn_rcpf(wsf[32+crow(r,hi)]);
  if(mp==0){
    #pragma unroll
    for(int r=0;r<16;++r){const int orow=crow(r,hi);
      #pragma unroll
      for(int d0=0;d0<4;++d0)stg[orow*128+d0*32+r32]=__float2bfloat16(o[d0][r]*rli[r]);}
  } else {
    #pragma unroll
    for(int r=0;r<16;++r){const int orow=crow(r,hi);
      #pragma unroll
      for(int d0=0;d0<4;++d0){ const float c=__bfloat162float(stg[orow*128+d0*32+r32])-lam*(o[d0][r]*rli[r]); stg[orow*128+d0*32+r32]=__float2bfloat16(c);} }
    asm volatile("s_waitcnt lgkmcnt(0)":::"memory");
    const int row=lane>>1,hf=lane&1; float cv[64]; float ss=0.f;
    #pragma unroll
    for(int i=0;i<8;++i){ const u32x4 w=*(const u32x4*)(stg+row*128+hf*64+i*8);
      cv[8*i+0]=__uint_as_float(w.x<<16);cv[8*i+1]=__uint_as_float(w.x&0xffff0000u);cv[8*i+2]=__uint_as_float(w.y<<16);cv[8*i+3]=__uint_as_float(w.y&0xffff0000u);
      cv[8*i+4]=__uint_as_float(w.z<<16);cv[8*i+5]=__uint_as_float(w.z&0xffff0000u);cv[8*i+6]=__uint_as_float(w.w<<16);cv[8*i+7]=__uint_as_float(w.w&0xffff0000u); }
    #pragma unroll
    for(int i=0;i<64;++i)ss+=cv[i]*cv[i];
    ss+=__int_as_float(__builtin_amdgcn_ds_bpermute((lane^1)<<2,__float_as_int(ss)));
    const float rstd=1.0f/sqrtf(ss*(1.0f/128.0f)+1e-6f);
    bf16*Ow=AO+(rowbase+q0+wid*QBLK+row)*AOP+h*128+hf*64;
    #pragma unroll
    for(int i=0;i<8;++i){ const float4 g0=*(const float4*)(gs+hf*64+i*8),g1=*(const float4*)(gs+hf*64+i*8+4); u32x4 w;
      w.x=cvtpk_s(cv[8*i+0]*rstd*g0.x,cv[8*i+1]*rstd*g0.y); w.y=cvtpk_s(cv[8*i+2]*rstd*g0.z,cv[8*i+3]*rstd*g0.w);
      w.z=cvtpk_s(cv[8*i+4]*rstd*g1.x,cv[8*i+5]*rstd*g1.y); w.w=cvtpk_s(cv[8*i+6]*rstd*g1.z,cv[8*i+7]*rstd*g1.w);
      *(u32x4*)(Ow+i*8)=w; }
  }
  asm volatile("s_waitcnt lgkmcnt(0)\n\ts_barrier":::"memory");
  }
}
constexpr int ATTN_LDS_BYTES=LDS_BYTES;
#undef SBAR
#undef WAIT_BAR
}

constexpr size_t MiB = 1u << 20;
constexpr size_t WS_CTL = 0, CTL_ZERO_BYTES = 1 * MiB;
constexpr size_t WS_WIN = 2 * MiB;
constexpr size_t WS_WGLU = 13 * MiB;
constexpr size_t WS_WCAT = 14 * MiB;
constexpr size_t WS_WOUT = 17 * MiB;
constexpr size_t WS_WR = 19 * MiB;
constexpr size_t WS_BTP = 20 * MiB;
constexpr size_t WS_BTY = 28 * MiB;
constexpr size_t WS_WE1 = 48 * MiB;
constexpr size_t WS_WE2 = 80 * MiB;
constexpr size_t WS_ETAB = 96 * MiB;
constexpr size_t WS_MOD = 104 * MiB;
constexpr size_t WS_UG = 112 * MiB;
constexpr size_t WS_Q = 152 * MiB, WS_K = 216 * MiB, WS_V = 280 * MiB;
constexpr size_t WS_GATES = 344 * MiB;
constexpr size_t WS_SLOC = 472 * MiB;
constexpr size_t WS_YACT = 152 * MiB;
constexpr size_t WS_MERGED = 216 * MiB;
constexpr size_t WS_H = 344 * MiB;
constexpr size_t WS_HDN = 256 * MiB;
constexpr size_t WS_SLOTS = 112 * MiB;
constexpr size_t WS_LIST = 472 * MiB;
constexpr size_t WS_CWL = 476 * MiB;
constexpr size_t WS_END = 512 * MiB;
constexpr int CW_TMO = 0, CW_BAR = 4096, CW_CNT = 16384;

constexpr int NWAVES = 8;
constexpr int RING_OFF = 0, RING_BYTES = 147456;
constexpr int LDSCTL_OFF = RING_BYTES, MISC_OFF = LDSCTL_OFF + 320;
constexpr int GS_OFF = MISC_OFF + 2048;
constexpr int ROWTAB_OFF = LDSCTL_OFF + 4096;
constexpr int LDS_BYTES = RING_BYTES + 8192;
static_assert(attn_body::ATTN_LDS_BYTES <= RING_BYTES, "attention LDS");

#define GAS __attribute__((address_space(1)))
#define LAS __attribute__((address_space(3)))
typedef unsigned short bf16;
typedef unsigned v4u __attribute__((ext_vector_type(4)));
typedef unsigned v2u __attribute__((ext_vector_type(2)));
typedef float f32x4 __attribute__((ext_vector_type(4)));
typedef GAS unsigned gu32;
#define RLX_AGENT __ATOMIC_RELAXED, __HIP_MEMORY_SCOPE_AGENT
#define LDS_WAIT() asm volatile("s_waitcnt lgkmcnt(0)" ::: "memory")
#define VM_WAIT() asm volatile("s_waitcnt vmcnt(0)" ::: "memory")
__device__ __forceinline__ unsigned f2bf(float f) { unsigned u = __builtin_bit_cast(unsigned, f); return (u + 0x7fffu + ((u >> 16) & 1u)) >> 16; }
__device__ __forceinline__ unsigned pk2(float lo, float hi) { return f2bf(lo) | (f2bf(hi) << 16); }
__device__ __forceinline__ float bf2f(unsigned b) { return __uint_as_float(b << 16); }

#define XB_TMO      128
#define XB_XCNT(j)  (256  + 64 * (j))
#define XB_XSUB(j)  (1280 + 64 * (j))
#define XB_XGEN(j)  (2304 + 64 * (j))
#define XB_TOP      3328
#define XB_TOPGEN   3392
#define XCD_BAR_WORDS 3456
#define XB_SPIN_CAP (1u << 18)
__device__ __forceinline__ unsigned xb_ld(unsigned* p)              { return __hip_atomic_load(p, __ATOMIC_RELAXED, __HIP_MEMORY_SCOPE_AGENT); }
__device__ __forceinline__ unsigned xb_add(unsigned* p, unsigned v) { return __hip_atomic_fetch_add(p, v, __ATOMIC_RELAXED, __HIP_MEMORY_SCOPE_AGENT); }
__device__ __forceinline__ unsigned xb_xcc_id() { return (unsigned)__builtin_amdgcn_s_getreg((3 << 11) | 20) & 0xFu; }
#define XB_SPIN(cond, bar) do { unsigned _sp = 0; while (cond) { __builtin_amdgcn_s_sleep(1); \
    if ((++_sp & 255u) == 0u) { if (xb_ld(&(bar)[XB_TMO])) break; if (_sp > XB_SPIN_CAP) { atomicAdd(&(bar)[XB_TMO], 1u); break; } } } } while (0)
struct XcdBarrier { unsigned* bar; unsigned x; volatile LAS unsigned* st; };
__device__ __forceinline__ XcdBarrier xcd_barrier_post(unsigned* bar, volatile LAS unsigned* st) {
    XcdBarrier b; b.bar = bar; b.x = xb_xcc_id(); b.st = st;
    if (threadIdx.x == 0) (void)xb_add(&bar[XB_XCNT(b.x)], 1u);
    return b;
}
__device__ __forceinline__ void xcd_barrier_complete(unsigned* bar, unsigned x, unsigned& nloc, unsigned& nx) {
    const unsigned G = gridDim.x * gridDim.y * gridDim.z;
    unsigned sum, cnt, mine, sp = 0u;
    for (;;) {
        sum = 0u; cnt = 0u; mine = 0u;
#pragma unroll
        for (unsigned j = 0; j < 16; ++j) { const unsigned c = xb_ld(&bar[XB_XCNT(j)]); sum += c; cnt += (c > 0u) ? 1u : 0u; mine = (j == x) ? c : mine; }
        if (sum == G) break;
        __builtin_amdgcn_s_sleep(1);
        if ((++sp & 255u) == 0u) { if (xb_ld(&bar[XB_TMO])) break; if (sp > XB_SPIN_CAP) { atomicAdd(&bar[XB_TMO], 1u); break; } }
    }
    nloc = mine > 0u ? mine : 1u; nx = cnt > 0u ? cnt : 1u;
}
__device__ __forceinline__ void xcd_barrier(const XcdBarrier& b) {
    asm volatile("s_waitcnt vmcnt(0)" ::: "memory");
    __syncthreads();
    if (threadIdx.x == 0) {
        unsigned* bar = b.bar;
        __builtin_amdgcn_s_waitcnt(0);
        unsigned nloc = b.st[0], nx = b.st[1];
        if (nloc == 0u) { xcd_barrier_complete(bar, b.x, nloc, nx); b.st[0] = nloc; b.st[1] = nx; }
        const unsigned old = xb_add(&bar[XB_XSUB(b.x)], 1u);
        const unsigned gen = old / nloc;
        if (old + 1u == (gen + 1u) * nloc) {
            __builtin_amdgcn_fence(__ATOMIC_RELEASE, "agent");
            asm volatile("s_waitcnt vmcnt(0)" ::: "memory");
            const unsigned og = xb_add(&bar[XB_TOP], 1u);
            const unsigned tg = og / nx;
            if (og + 1u == (tg + 1u) * nx) xb_add(&bar[XB_TOPGEN], 1u);
            else XB_SPIN(xb_ld(&bar[XB_TOPGEN]) == tg, bar);
            __builtin_amdgcn_fence(__ATOMIC_ACQUIRE, "agent");
            xb_add(&bar[XB_XGEN(b.x)], 1u);
            asm volatile("s_waitcnt vmcnt(0)" ::: "memory");
        } else {
            XB_SPIN(xb_ld(&bar[XB_XGEN(b.x)]) == gen, bar);
            __builtin_amdgcn_fence(__ATOMIC_ACQUIRE, "agent");
            asm volatile("s_waitcnt vmcnt(0)" ::: "memory");
        }
    }
    __syncthreads();
}

__device__ __forceinline__ float shfl_xor_l(float v, int o, int lane) { return __int_as_float(__builtin_amdgcn_ds_bpermute((lane ^ o) << 2, __float_as_int(v))); }
__device__ __forceinline__ float wave_sum(float v, int lane) {
#pragma unroll
    for (int o = 1; o < 64; o <<= 1) v += shfl_xor_l(v, o, lane);
    return v;
}
__device__ __forceinline__ void transpose_tile(const float* W, int N, int k0, int n0, bf16* WT, int ldo, int orow0, int ocol0, LAS float* scr, int lane) {
#pragma unroll 8
    for (int i = 0; i < 32; ++i) { const int kk = 2 * i + (lane >> 5); scr[kk * 33 + (lane & 31)] = W[(size_t)(k0 + kk) * N + n0 + (lane & 31)]; }
    LDS_WAIT(); asm volatile("" ::: "memory");
    const int c = lane & 7;
#pragma unroll
    for (int j = 0; j < 4; ++j) { const int n = (lane >> 3) + 8 * j; const LAS float* s = scr + (8 * c) * 33 + n;
        v4u o; o.x = pk2(s[0 * 33], s[1 * 33]); o.y = pk2(s[2 * 33], s[3 * 33]); o.z = pk2(s[4 * 33], s[5 * 33]); o.w = pk2(s[6 * 33], s[7 * 33]);
        *(GAS v4u*)(WT + (size_t)(orow0 + n) * ldo + ocol0 + 8 * c) = o; }
    LDS_WAIT(); asm volatile("" ::: "memory");
}
__device__ __forceinline__ void abar_pow(float lr, float li, float dt, float j, float& re, float& im) {
    const float mag = expf(lr * dt * j); float s, c; sincosf(li * dt * j, &s, &c); re = mag * c; im = mag * s;
}

constexpr int ETAB_OFF = MISC_OFF + 256;
__device__ __forceinline__ void build_expert_table(LAS unsigned char* L, const int* CNT, int tid) {
    LAS int* tab = (LAS int*)(L + ETAB_OFF); LAS int* cl = tab + (XS_ROWS / 256 + 2);
    __syncthreads();
    if (tid < NEXP) cl[tid] = CNT[tid];
    __syncthreads();
    if (tid == 0) { int rt = 0;
#pragma unroll 1
        for (int e = 0; e < NEXP; ++e) { const int nt = (cl[e] + 255) >> 8;
#pragma unroll 1
            for (int q = 0; q < nt; ++q) tab[rt++] = e | (q << 8); }
        tab[XS_ROWS / 256 + 1] = rt;
#pragma unroll 1
        for (; rt <= XS_ROWS / 256; ++rt) tab[rt] = -1; }
    __syncthreads();
}
struct Args { const float* in[34]; float* out; unsigned char* ws; };
typedef __attribute__((address_space(4))) const char* kconst_ptr;
__device__ __forceinline__ void* karg(int k) { kconst_ptr kp = (kconst_ptr)__builtin_amdgcn_kernarg_segment_ptr(); asm volatile("" : "+s"(kp)); return *(void* const __attribute__((address_space(4)))*)(kp + 8 * k); }

__global__ void __launch_bounds__(NWAVES * 64, 2) fwd_kernel(Args args) {
    extern __shared__ __attribute__((aligned(16))) unsigned char lds[];
    LAS unsigned char* L = (LAS unsigned char*)lds;
    volatile LAS unsigned* MISC = (volatile LAS unsigned*)(L + MISC_OFF);
#define PHASE_IDS() \
    int tid = threadIdx.x; asm volatile("" : "+v"(tid)); \
    const int lane = tid & 63, wave = __builtin_amdgcn_readfirstlane(tid >> 6); \
    int G = gridDim.x, bx = blockIdx.x; asm volatile("" : "+s"(G), "+s"(bx)); \
    const int vcu = (G % 8 == 0) ? (bx % 8) * (G / 8) + bx / 8 : bx; \
    const int gw = vcu * NWAVES + wave, NGW = G * NWAVES; \
    const int gt = bx * (NWAVES * 64) + tid, NGT = G * NWAVES * 64; \
    (void)lane; (void)wave; (void)vcu; (void)gw; (void)NGW; (void)gt; (void)NGT;
    gu32* ctl = (gu32*)(args.ws + WS_CTL);
    for (int u = threadIdx.x; u < (LDS_BYTES - LDSCTL_OFF) / 4; u += NWAVES * 64) ((LAS unsigned*)(L + LDSCTL_OFF))[u] = 0u;
    __syncthreads();
    XcdBarrier bar = xcd_barrier_post((unsigned*)(ctl + CW_BAR), MISC + 8);
#define GRID_BAR() xcd_barrier(bar)

#define KIN(k) ((const float*)karg(k))
#define WSP(T_, off) ((T_*)(((unsigned char*)karg(35)) + (off)))
#define OUTP() ((float*)karg(34))

#if DBG_STAGE != 1
    asm volatile("; PHASE_MARK P0" ::: "memory");
    {
        PHASE_IDS();
        const float* w_in = KIN(5); const float* w_glu = KIN(15); const float* w_br_ssm = KIN(22); const float* w_br_attn = KIN(23); const float* w_out = KIN(24);
        const float* w_eg = KIN(30); const float* w_eu = KIN(31); const float* w_ed = KIN(32);
        bf16* WinT = WSP(bf16, WS_WIN); bf16* WgluT = WSP(bf16, WS_WGLU); bf16* WcatT = WSP(bf16, WS_WCAT); bf16* WoutT = WSP(bf16, WS_WOUT);
        bf16* WE1 = WSP(bf16, WS_WE1); bf16* WE2 = WSP(bf16, WS_WE2);
        LAS float* scr = (LAS float*)(L + RING_OFF + wave * 16384);
        constexpr int I_IN = 16 * 176, I_GLU = 8 * 16, I_SSM = 8 * 32, I_ATT = 16 * 32, I_OUT = 16 * 32, I_EG = NEXP * 16 * 8, I_EU = I_EG, I_ED = NEXP * 4 * 32;
        constexpr int NITEMS = I_IN + I_GLU + I_SSM + I_ATT + I_OUT + I_EG + I_EU + I_ED;
        for (int it = gw; it < NITEMS; it += NGW) {
            int r = it;
            if (r < I_IN) { const int kb = r / 176, nb = r % 176; transpose_tile(w_in, INW, 64 * kb, 32 * nb, WinT, D, 32 * nb, 64 * kb, scr, lane); continue; } r -= I_IN;
            if (r < I_GLU) { const int kb = r / 16, nb = r % 16; transpose_tile(w_glu, S5W, 64 * kb, 32 * nb, WgluT, S5W, 32 * nb, 64 * kb, scr, lane); continue; } r -= I_GLU;
            if (r < I_SSM) { const int kb = r / 32, nb = r % 32; transpose_tile(w_br_ssm, D, 64 * kb, 32 * nb, WcatT, KCAT, 32 * nb, D + 64 * kb, scr, lane); continue; } r -= I_SSM;
            if (r < I_ATT) { const int kb = r / 32, nb = r % 32; transpose_tile(w_br_attn, D, 64 * kb, 32 * nb, WcatT, KCAT, 32 * nb, 64 * kb, scr, lane); continue; } r -= I_ATT;
            if (r < I_OUT) { const int kb = r / 32, nb = r % 32; transpose_tile(w_out, D, 64 * kb, 32 * nb, WoutT, D, 32 * nb, 64 * kb, scr, lane); continue; } r -= I_OUT;
            if (r < I_EG + I_EU) { const bool up = r >= I_EG; if (up) r -= I_EG; const int e = r / 128, q = r % 128, kb = q / 8, nb = q % 8;
                transpose_tile((up ? w_eu : w_eg) + (size_t)e * D * DEXP, DEXP, 64 * kb, 32 * nb, WE1 + (size_t)e * 512 * D, D, (nb >> 2) * 256 + (up ? 128 : 0) + (nb & 3) * 32, 64 * kb, scr, lane); continue; } r -= I_EG + I_EU;
            { const int e = r / 128, q = r % 128, kb = q / 32, nb = q % 32; transpose_tile(w_ed + (size_t)e * DEXP * D, D, 64 * kb, 32 * nb, WE2 + (size_t)e * D * DEXP, DEXP, 32 * nb, 64 * kb, scr, lane); }
        }
        const float* w_rg = KIN(26); const float* w_re = KIN(28); bf16* WR = WSP(bf16, WS_WR);
        for (int idx = gt; idx < 2 * 64 * 128; idx += NGT) {
            const int k0 = (idx & 127) * 8, n = (idx >> 7) & 63, part = idx >> 13;
            unsigned w[4] = {0u, 0u, 0u, 0u};
            if (n < 36) {
                float hv[8];
#pragma unroll
                for (int i = 0; i < 8; ++i) { const float f = (n < 4) ? w_rg[(size_t)(k0 + i) * 4 + n] : w_re[(size_t)(k0 + i) * NEXP + (n - 4)]; const float h = bf2f(f2bf(f)); hv[i] = part ? (f - h) : h; }
#pragma unroll
                for (int i = 0; i < 4; ++i) w[i] = pk2(hv[2 * i], hv[2 * i + 1]);
            }
            *(GAS v4u*)(WR + (size_t)(part * 64 + n) * D + k0) = (v4u){w[0], w[1], w[2], w[3]};
        }
        const float* log_dt = KIN(14); const float* a_re = KIN(7); const float* a_im = KIN(8); const float* sb_re = KIN(9); const float* sb_im = KIN(10);
        float* Ere = WSP(float, WS_ETAB); float* Eim = Ere + NG * LC * NP * 16;
        for (int idx = gt; idx < NG * LC * NP; idx += NGT) {
            const int p = idx % NP, j = (idx / NP) % LC, g = idx / (NP * LC);
            const float dt = expf(log_dt[g]), lr = a_re[g * NP + p], li = a_im[g * NP + p];
            float ar, ai; abar_pow(lr, li, dt, 1.0f, ar, ai);
            const float den = lr * lr + li * li, nr = ar - 1.0f;
            const float fre = (nr * lr + ai * li) / den, fim = (ai * lr - nr * li) / den;
            float pr, pi; abar_pow(lr, li, dt, (float)j, pr, pi);
            const float gr = pr * fre - pi * fim, gi = pr * fim + pi * fre;
            const float* br = sb_re + (size_t)(g * NP + p) * 16; const float* bi = sb_im + (size_t)(g * NP + p) * 16;
            float* er = Ere + (size_t)((g * LC + j) * NP + p) * 16; float* ei = Eim + (size_t)((g * LC + j) * NP + p) * 16;
#pragma unroll
            for (int ci = 0; ci < 16; ++ci) { er[ci] = gr * br[ci] - gi * bi[ci]; ei[ci] = gr * bi[ci] + gi * br[ci]; }
        }
        {
            const float* cvec = KIN(1); const float* w_ada = KIN(2); const float* b_ada = KIN(3); float* MOD = WSP(float, WS_MOD);
            __syncthreads();
            LAS float* cs = (LAS float*)(L + RING_OFF);
            LAS float* red = (LAS float*)(L + RING_OFF + 32768);
            bool loaded = false;
            for (int it = vcu; it < 6 * D / 32; it += G) {
                if (!loaded) { __syncthreads(); for (int i = tid; i < NB * D; i += NWAVES * 64) { const float c = cvec[i]; cs[i] = c / (1.0f + expf(-c)); } __syncthreads(); loaded = true; }
                const int col = it * 32 + (lane & 31), ksub = (lane >> 5) + 2 * wave;
                float accb[NB];
#pragma unroll
                for (int b = 0; b < NB; ++b) accb[b] = 0.f;
#pragma unroll 8
                for (int i = 0; i < 64; ++i) { const int k = ksub + 16 * i; const float w = w_ada[(size_t)k * (6 * D) + col];
#pragma unroll
                    for (int b = 0; b < NB; ++b) accb[b] += cs[b * D + k] * w; }
#pragma unroll
                for (int b = 0; b < NB; ++b) red[(ksub * NB + b) * 32 + (lane & 31)] = accb[b];
                __syncthreads();
                if (tid < NB * 32) { const int b = tid >> 5, c = tid & 31; float s = 0.f;
#pragma unroll
                    for (int q = 0; q < 16; ++q) s += red[(q * NB + b) * 32 + c];
                    MOD[(size_t)b * 6 * D + it * 32 + c] = s + b_ada[it * 32 + c]; }
                __syncthreads();
            }
            __syncthreads();
        }
    }
    GRID_BAR();
#endif

#if DBG_STAGE != 1
    asm volatile("; PHASE_MARK P0b" ::: "memory");
    {
        PHASE_IDS();
        const float* x = KIN(0); const float* g_mix = KIN(4); const float* MOD = WSP(float, WS_MOD); bf16* UBUF = (bf16*)OUTP();
        const float* Ere = WSP(float, WS_ETAB); const float* Eim = Ere + NG * LC * NP * 16; bf16* BtY = WSP(bf16, WS_BTY); bf16* BtP = WSP(bf16, WS_BTP);
        const float* sc_re = KIN(11); const float* sc_im = KIN(12); const float* log_dt = KIN(14); const float* a_re = KIN(7); const float* a_im = KIN(8);
        for (int blk = gw; blk < T / 16; blk += NGW) {
            const int row0 = blk * 16, b = row0 / SEQ; const float* md = MOD + (size_t)b * 6 * D;
            f32x4 av[4], sv[4];
#pragma unroll
            for (int j = 0; j < 4; ++j) { const int c = 4 * lane + 256 * j; const f32x4 g = *(const f32x4*)(g_mix + c), sc = *(const f32x4*)(md + D + c); av[j] = g * (sc + 1.0f); sv[j] = *(const f32x4*)(md + c); }
            f32x4 nx[4];
#pragma unroll
            for (int j = 0; j < 4; ++j) nx[j] = *(const f32x4*)(x + (size_t)row0 * D + 4 * lane + 256 * j);
#pragma unroll 2
            for (int r = 0; r < 16; ++r) {
                f32x4 v[4]; float ss = 0.f;
#pragma unroll
                for (int j = 0; j < 4; ++j) v[j] = nx[j];
                const float* xn = x + (size_t)(row0 + (r < 15 ? r + 1 : r)) * D;
#pragma unroll
                for (int j = 0; j < 4; ++j) nx[j] = *(const f32x4*)(xn + 4 * lane + 256 * j);
#pragma unroll
                for (int j = 0; j < 4; ++j) ss += (v[j][0] * v[j][0] + v[j][1] * v[j][1]) + (v[j][2] * v[j][2] + v[j][3] * v[j][3]);
                const float rstd = 1.0f / sqrtf(wave_sum(ss, lane) * (1.0f / D) + EPS);
                bf16* ur = UBUF + (size_t)(row0 + r) * D;
#pragma unroll
                for (int j = 0; j < 4; ++j) { const f32x4 o = v[j] * rstd * av[j] + sv[j]; *(GAS v2u*)(ur + 4 * lane + 256 * j) = (v2u){pk2(o[0], o[1]), pk2(o[2], o[3])}; }
            }
        }
        for (int idx = gt; idx < NG * LC * 16 * 2; idx += NGT) {
            const int cih = idx & 1, co = (idx >> 1) & 15, j = (idx >> 5) % LC, g = idx / (32 * LC);
            float kv[8];
#pragma unroll
            for (int i = 0; i < 8; ++i) kv[i] = 0.f;
            const float* er = Ere + (size_t)((g * LC + j) * NP) * 16 + cih * 8; const float* ei = Eim + (size_t)((g * LC + j) * NP) * 16 + cih * 8;
            const float* cr = sc_re + (size_t)(g * 16 + co) * NP; const float* ci_ = sc_im + (size_t)(g * 16 + co) * NP;
            for (int p = 0; p < NP; ++p) { const float c_r = cr[p], c_i = ci_[p]; const f32x4 e0 = *(const f32x4*)(er + p * 16), e1 = *(const f32x4*)(er + p * 16 + 4), f0 = *(const f32x4*)(ei + p * 16), f1 = *(const f32x4*)(ei + p * 16 + 4);
#pragma unroll
                for (int i = 0; i < 4; ++i) { kv[i] += c_r * e0[i] - c_i * f0[i]; kv[4 + i] += c_r * e1[i] - c_i * f1[i]; } }
            const v4u kw = (v4u){pk2(kv[0], kv[1]), pk2(kv[2], kv[3]), pk2(kv[4], kv[5]), pk2(kv[6], kv[7])};
            bf16* base = BtY + (size_t)g * 512 * KY;
            for (int t = j; t < LC; ++t) *(GAS v4u*)(base + (size_t)(t * 16 + co) * KY + (t - j) * 16 + cih * 8) = kw;
            if (j >= 1) for (int t = 0; t + j < LC; ++t) *(GAS v4u*)(base + (size_t)(t * 16 + co) * KY + (t + j) * 16 + cih * 8) = (v4u){0u, 0u, 0u, 0u};
        }
        for (int idx = gt; idx < NG * LC * NP; idx += NGT) {
            const int p = idx % NP, t = (idx / NP) % LC, g = idx / (NP * LC);
            const float dt = expf(log_dt[g]); float ar, ai; abar_pow(a_re[g * NP + p], a_im[g * NP + p], dt, (float)(t + 1), ar, ai);
#pragma unroll
            for (int co = 0; co < 16; ++co) { const float c_r = sc_re[(size_t)(g * 16 + co) * NP + p], c_i = sc_im[(size_t)(g * 16 + co) * NP + p];
                bf16* rowp = BtY + (size_t)(g * 512 + t * 16 + co) * KY;
                rowp[512 + p] = (bf16)f2bf(c_r * ar - c_i * ai); rowp[576 + p] = (bf16)f2bf(-(c_r * ai + c_i * ar)); }
        }
        for (int idx = gt; idx < NG * 128 * LC; idx += NGT) {
            const int s = idx % LC, nn = (idx / LC) % 128, g = idx / (LC * 128); const int p = nn & 63, im = nn >> 6;
            const float* src = (im ? Eim : Ere) + (size_t)((g * LC + (LC - 1 - s)) * NP + p) * 16;
            unsigned hw[8], lw[8];
#pragma unroll
            for (int i = 0; i < 8; ++i) { const float f0 = src[2 * i], f1 = src[2 * i + 1]; const unsigned h0 = f2bf(f0), h1 = f2bf(f1); hw[i] = h0 | (h1 << 16); lw[i] = pk2(f0 - bf2f(h0), f1 - bf2f(h1)); }
            bf16* d0 = BtP + (size_t)(g * 256 + nn) * KS + s * 16; bf16* d1 = BtP + (size_t)(g * 256 + 128 + nn) * KS + s * 16;
            *(GAS v4u*)d0 = (v4u){hw[0], hw[1], hw[2], hw[3]}; *(GAS v4u*)(d0 + 8) = (v4u){hw[4], hw[5], hw[6], hw[7]};
            *(GAS v4u*)d1 = (v4u){lw[0], lw[1], lw[2], lw[3]}; *(GAS v4u*)(d1 + 8) = (v4u){lw[4], lw[5], lw[6], lw[7]};
        }
    }
    GRID_BAR();

    asm volatile("; PHASE_MARK P1" ::: "memory");
    {
        PHASE_IDS();
        pg8::StaticOrder S; S.init(OUTP(), D, WSP(bf16, WS_WIN), D, T, INW, G, bx);
        pg8::EpiProj E{KIN(6), WSP(bf16, WS_UG), WSP(bf16, WS_Q), WSP(bf16, WS_K), WSP(bf16, WS_V), WSP(bf16, WS_GATES), attn_body::C2};
        pg8::gemm_phase<pg8::EpiProj, pg8::StaticOrder, true, true>(L + RING_OFF, D, D, D, S, E);
    }
    GRID_BAR();

    asm volatile("; PHASE_MARK P2" ::: "memory");
    {
        PHASE_IDS();
        pg8::GroupOrder S; S.init(WSP(bf16, WS_UG), KY, (size_t)NRC * KY * 2, WSP(bf16, WS_BTP), KS, (size_t)256 * KS * 2, NRC, 256, NG, G, bx);
        pg8::EpiStates E{WSP(float, WS_SLOC)};
        pg8::gemm_phase<pg8::EpiStates, pg8::GroupOrder, true, true>(L + RING_OFF, KS, KY, KS, S, E);
    }
    GRID_BAR();

    asm volatile("; PHASE_MARK P3" ::: "memory");
    {
        PHASE_IDS();
        const float* log_dt = KIN(14); const float* a_re = KIN(7); const float* a_im = KIN(8); const float* SLOC = WSP(float, WS_SLOC); bf16* UG = WSP(bf16, WS_UG);
        LAS float* seg = (LAS float*)(L + RING_OFF);
        for (int bg = vcu; bg < NB * NG; bg += G) {
            const int b = bg / NG, g = bg % NG, p = lane;
            const float dt = expf(log_dt[g]), lr = a_re[g * NP + p], li = a_im[g * NP + p];
            float alr, ali; abar_pow(lr, li, dt, (float)LC, alr, ali);
            constexpr int SEGC = NCH / NWAVES;
            float locr[SEGC], loci[SEGC]; float cr = 0.f, ci = 0.f;
            const float* sp = SLOC + ((size_t)(g * NRC + b * NCH + wave * SEGC)) * 128;
#pragma unroll
            for (int k = 0; k < SEGC; ++k) { locr[k] = cr; loci[k] = ci; const float sr = sp[k * 128 + p], si = sp[k * 128 + 64 + p]; const float nr = alr * cr - ali * ci + sr, ni = alr * ci + ali * cr + si; cr = nr; ci = ni; }
            __syncthreads();
            seg[(wave * 64 + p) * 2] = cr; seg[(wave * 64 + p) * 2 + 1] = ci;
            __syncthreads();
            float a16r = alr, a16i = ali;
#pragma unroll
            for (int q = 0; q < 4; ++q) { const float nr = a16r * a16r - a16i * a16i, ni = 2.f * a16r * a16i; a16r = nr; a16i = ni; }
            float inr = 0.f, ini = 0.f;
            for (int w = 0; w < wave; ++w) { const float er = seg[(w * 64 + p) * 2], ei = seg[(w * 64 + p) * 2 + 1]; const float nr = a16r * inr - a16i * ini + er, ni = a16r * ini + a16i * inr + ei; inr = nr; ini = ni; }
            bf16* up = UG + ((size_t)(g * NRC + b * NCH + wave * SEGC)) * KY + KS;
#pragma unroll
            for (int k = 0; k < SEGC; ++k) { up[(size_t)k * KY + p] = (bf16)f2bf(inr + locr[k]); up[(size_t)k * KY + 64 + p] = (bf16)f2bf(ini + loci[k]); const float nr = alr * inr - ali * ini, ni = alr * ini + ali * inr; inr = nr; ini = ni; }
        }
        __syncthreads();
        const char* wsb = (const char*)karg(35);
        const float* lq1 = KIN(17); const float* lk1 = KIN(18); const float* lq2 = KIN(19); const float* lk2 = KIN(20); const float* g_subln = KIN(21);
        const float lam = expf(wave_sum(lq1[lane] * lk1[lane], lane)) - expf(wave_sum(lq2[lane] * lk2[lane], lane)) + LAMBDA_INIT;
        LAS float* gsl = (LAS float*)(L + GS_OFF);
        if (tid < 128) gsl[tid] = g_subln[tid] * (1.0f - LAMBDA_INIT);
        __syncthreads();
        for (int un = vcu; un < NB * 8 * 4; un += G) {
            const int s4 = un & 3, h = (un >> 2) & 7, b = un >> 5;
#pragma unroll 1
            for (int i = 0; i < 4; ++i) { const int qb = (i == 0) ? 15 - s4 : (i == 1) ? 8 + s4 : (i == 2) ? 7 - s4 : s4;
                attn_body::attn_unit<8, 40, WS_Q, WS_K, WS_V, GS_OFF - RING_OFF, KCAT>(b, h, qb, wsb, (attn_body::bf16*)OUTP(), lam, (char*)lds + RING_OFF); }
        }
    }
    GRID_BAR();

    asm volatile("; PHASE_MARK P4" ::: "memory");
    {
        PHASE_IDS();
        pg8::GroupOrder S; S.init(WSP(bf16, WS_UG), KY, (size_t)NRC * KY * 2, WSP(bf16, WS_BTY), KY, (size_t)512 * KY * 2, NRC, 512, NG, G, bx);
        pg8::EpiY E{WSP(bf16, WS_UG), KIN(13), WSP(bf16, WS_YACT)};
        pg8::gemm_phase<pg8::EpiY, pg8::GroupOrder, true, true>(L + RING_OFF, KY, KY, KY, S, E);
    }
    GRID_BAR();

    asm volatile("; PHASE_MARK P5" ::: "memory");
    {
        PHASE_IDS();
        pg8::StaticOrder S; S.init(WSP(bf16, WS_YACT), S5W, WSP(bf16, WS_WGLU), S5W, T, S5W, G, bx);
        pg8::EpiGlu E{WSP(bf16, WS_YACT), KIN(16), (bf16*)OUTP() + D, KCAT};
        pg8::gemm_phase<pg8::EpiGlu, pg8::StaticOrder, true, true>(L + RING_OFF, S5W, S5W, S5W, S, E);
    }
    GRID_BAR();

    asm volatile("; PHASE_MARK P6" ::: "memory");
    {
        PHASE_IDS();
        pg8::StaticOrder S; S.init(OUTP(), KCAT, WSP(bf16, WS_WCAT), KCAT, T, D, G, bx);
        pg8::EpiMerge E{WSP(bf16, WS_GATES), WSP(bf16, WS_MERGED)};
        pg8::HookGate HK{WSP(bf16, WS_GATES)};
        pg8::gemm_phase<pg8::EpiMerge, pg8::StaticOrder, true, true, false, pg8::HookGate>(L + RING_OFF, KCAT, KCAT, KCAT, S, E, nullptr, HK);
    }
    GRID_BAR();

    asm volatile("; PHASE_MARK P8" ::: "memory");
    {
        PHASE_IDS();
        pg8::StaticOrder S; S.init(WSP(bf16, WS_MERGED), D, WSP(bf16, WS_WOUT), D, T, D, G, bx);
        pg8::EpiOut E{KIN(0), WSP(float, WS_MOD), WSP(bf16, WS_H)};
        pg8::gemm_phase<pg8::EpiOut, pg8::StaticOrder, true, true>(L + RING_OFF, D, D, D, S, E);
    }
    GRID_BAR();
#endif

#if DBG_STAGE == 0
    asm volatile("; PHASE_MARK P9" ::: "memory");
    {
        PHASE_IDS();
        const float* g_ffn = KIN(25); const float* MOD = WSP(float, WS_MOD); const bf16* Hbuf = WSP(bf16, WS_H); bf16* U2 = (bf16*)OUTP();
        const bf16* WRh = WSP(bf16, WS_WR); const bf16* WRl = WRh + 64 * D;
        const float* b_rg = KIN(27); const float* b_re = KIN(29); int* CNT = WSP(int, WS_CTL) + CW_CNT; int* LIST = WSP(int, WS_LIST); float* CWL = WSP(float, WS_CWL);
        constexpr int APITCH = 1032;
        LAS bf16* AH = (LAS bf16*)(L + RING_OFF); LAS bf16* AL = AH + 16 * APITCH;
        LAS float* PART = (LAS float*)(L + RING_OFF + 2 * 16 * APITCH * 2);
        LAS float* LG = PART + 8 * 256;
        LAS int* lcnt = (LAS int*)(LG + 16 * 64); LAS int* lbase = lcnt + NEXP; LAS int* TOK = lbase + NEXP;
        const int per = T / G, t0 = bx * per, b = t0 / SEQ;
        const float* md = MOD + (size_t)b * 6 * D;
        f32x4 av[4], sv[4];
#pragma unroll
        for (int j = 0; j < 4; ++j) { const int c = 4 * lane + 256 * j; const f32x4 g = *(const f32x4*)(g_ffn + c), sc = *(const f32x4*)(md + 4 * D + c); av[j] = g * (sc + 1.0f); sv[j] = *(const f32x4*)(md + 3 * D + c); }
        const int cb = wave & 3, kh = wave >> 2, fr = lane & 15, fq = lane >> 4;
        pg8::bf16x8 bh[16], bl[16];
#pragma unroll
        for (int ks = 0; ks < 16; ++ks) { const size_t o = (size_t)(cb * 16 + fr) * D + kh * 512 + ks * 32 + fq * 8; bh[ks] = *(const pg8::bf16x8*)(WRh + o); bl[ks] = *(const pg8::bf16x8*)(WRl + o); }
        if (tid < NEXP) lcnt[tid] = 0;
        for (int c = 0; c < per / 16; ++c) {
#pragma unroll
            for (int rr = 0; rr < 2; ++rr) {
                const int r = 2 * wave + rr, tok = t0 + c * 16 + r;
                const bf16* hr = Hbuf + (size_t)tok * D; f32x4 v[4]; float ss = 0.f;
#pragma unroll
                for (int j = 0; j < 4; ++j) { const v2u hw = *(const GAS v2u*)(hr + 4 * lane + 256 * j); v[j] = (f32x4){pg8::bf_lo(hw.x), pg8::bf_hi(hw.x), pg8::bf_lo(hw.y), pg8::bf_hi(hw.y)}; ss += (v[j][0] * v[j][0] + v[j][1] * v[j][1]) + (v[j][2] * v[j][2] + v[j][3] * v[j][3]); }
                const float rstd = 1.0f / sqrtf(wave_sum(ss, lane) * (1.0f / D) + EPS);
                bf16* ur = U2 + (size_t)tok * D;
#pragma unroll
                for (int j = 0; j < 4; ++j) { const f32x4 o = v[j] * rstd * av[j] + sv[j];
                    const unsigned h0 = f2bf(o[0]), h1 = f2bf(o[1]), h2 = f2bf(o[2]), h3 = f2bf(o[3]);
                    const v2u hv = (v2u){h0 | (h1 << 16), h2 | (h3 << 16)}, lv = (v2u){pk2(o[0] - bf2f(h0), o[1] - bf2f(h1)), pk2(o[2] - bf2f(h2), o[3] - bf2f(h3))};
                    *(GAS v2u*)(ur + 4 * lane + 256 * j) = hv;
                    *(LAS v2u*)(AH + r * APITCH + 4 * lane + 256 * j) = hv; *(LAS v2u*)(AL + r * APITCH + 4 * lane + 256 * j) = lv; }
            }
            __syncthreads();
            { pg8::f32x4 acc = (pg8::f32x4){0.f, 0.f, 0.f, 0.f};
#pragma unroll
              for (int ks = 0; ks < 16; ++ks) { const int ko = fr * APITCH + kh * 512 + ks * 32 + fq * 8;
                  const pg8::bf16x8 ah = *(const LAS pg8::bf16x8*)(AH + ko), al = *(const LAS pg8::bf16x8*)(AL + ko);
                  acc = __builtin_amdgcn_mfma_f32_16x16x32_bf16(ah, bh[ks], acc, 0, 0, 0);
                  acc = __builtin_amdgcn_mfma_f32_16x16x32_bf16(al, bh[ks], acc, 0, 0, 0);
                  acc = __builtin_amdgcn_mfma_f32_16x16x32_bf16(ah, bl[ks], acc, 0, 0, 0); }
#pragma unroll
              for (int i = 0; i < 4; ++i) PART[wave * 256 + (fq * 4 + i) * 16 + fr] = acc[i]; }
            __syncthreads();
#pragma unroll
            for (int i = 0; i < 2; ++i) { const int o = tid * 2 + i, row = o >> 6, col = o & 63, cbb = col >> 4; LG[o] = PART[cbb * 256 + row * 16 + (col & 15)] + PART[(4 + cbb) * 256 + row * 16 + (col & 15)]; }
            __syncthreads();
            if (tid < 16) {
                const LAS float* lg = LG + tid * 64;
                float gl[4]; int gi = 0;
#pragma unroll
                for (int i = 0; i < 4; ++i) gl[i] = lg[i] + b_rg[i];
#pragma unroll
                for (int i = 1; i < 4; ++i) if (gl[i] > gl[gi]) gi = i;
                float gsum = 0.f;
#pragma unroll
                for (int i = 0; i < 4; ++i) gsum += expf(gl[i] - gl[gi]);
                const float gp = 1.0f / gsum;
                float el[8];
#pragma unroll
                for (int i = 0; i < 8; ++i) el[i] = lg[4 + gi * 8 + i] + b_re[gi * 8 + i];
                int i0 = 0;
#pragma unroll
                for (int i = 1; i < 8; ++i) if (el[i] > el[i0]) i0 = i;
                int i1 = (i0 == 0) ? 1 : 0;
#pragma unroll
                for (int i = 0; i < 8; ++i) if (i != i0 && el[i] > el[i1]) i1 = i;
                const float ex = expf(el[i1] - el[i0]);
                const float w0 = gp / (1.0f + ex), w1 = gp * ex / (1.0f + ex);
                const int e0 = gi * 8 + i0, e1 = gi * 8 + i1;
                const int p0 = atomicAdd((int*)(lds + ((char*)&lcnt[e0] - (char*)L)), 1), p1 = atomicAdd((int*)(lds + ((char*)&lcnt[e1] - (char*)L)), 1);
                LAS int* tk = TOK + (c * 16 + tid) * 6; tk[0] = e0; tk[1] = p0; tk[2] = __float_as_int(w0); tk[3] = e1; tk[4] = p1; tk[5] = __float_as_int(w1);
            }
        }
        __syncthreads();
        if (tid < NEXP) lbase[tid] = atomicAdd(&CNT[tid], lcnt[tid]);
        __syncthreads();
        if (tid < per) { const LAS int* tk = TOK + tid * 6; const int tok = t0 + tid;
            const size_t i0 = (size_t)tk[0] * T + lbase[tk[0]] + tk[1], i1 = (size_t)tk[3] * T + lbase[tk[3]] + tk[4];
            LIST[i0] = tok * 2; CWL[i0] = __int_as_float(tk[2]); LIST[i1] = tok * 2 + 1; CWL[i1] = __int_as_float(tk[5]); }
        __syncthreads();
    }
    GRID_BAR();

    asm volatile("; PHASE_MARK P13" ::: "memory");
    {
        PHASE_IDS();
        const int* CNT = WSP(int, WS_CTL) + CW_CNT; const int* LIST = WSP(int, WS_LIST);
        build_expert_table(L, CNT, tid);
        pg8::ExpertOrder S; S.init((const LAS int*)(L + ETAB_OFF), OUTP(), 0, WSP(bf16, WS_WE1), D, (size_t)512 * D * 2, 512, G, bx);
        LAS int* rowtab = (LAS int*)(L + ROWTAB_OFF);
        { pg8::Unit u;
#pragma unroll 1
          for (int i = 0; i < 4 && S.next(i, u); ++i) { const int n = CNT[u.g];
              for (int r = tid; r < 256; r += NWAVES * 64) { const int pos = u.lt * 256 + r; rowtab[i * 256 + r] = (pos < n) ? (LIST[(size_t)u.g * T + pos] >> 1) : 0; } }
          __syncthreads(); }
        pg8::EpiExp1 E{WSP(bf16, WS_HDN)};
        pg8::gemm_phase<pg8::EpiExp1, pg8::ExpertOrder, true, true, true>(L + RING_OFF, D, D, D, S, E, (const LAS int*)rowtab);
    }
    GRID_BAR();

    asm volatile("; PHASE_MARK P14" ::: "memory");
    {
        PHASE_IDS();
        build_expert_table(L, WSP(int, WS_CTL) + CW_CNT, tid);
        pg8::ExpertOrder S; S.init((const LAS int*)(L + ETAB_OFF), WSP(bf16, WS_HDN), (size_t)256 * DEXP * 2, WSP(bf16, WS_WE2), DEXP, (size_t)D * DEXP * 2, D, G, bx);
        pg8::EpiExp2 E{WSP(int, WS_LIST), WSP(float, WS_CWL), WSP(int, WS_CTL) + CW_CNT, WSP(bf16, WS_SLOTS)};
        pg8::gemm_phase<pg8::EpiExp2, pg8::ExpertOrder, true, true>(L + RING_OFF, DEXP, DEXP, DEXP, S, E);
    }
    GRID_BAR();
#endif

    asm volatile("; PHASE_MARK P15" ::: "memory");
    {
        PHASE_IDS();
        const float* x = KIN(0); const float* g_final = KIN(33); const bf16* Hbuf = WSP(bf16, WS_H); const float* MOD = WSP(float, WS_MOD); const bf16* SLOTS = WSP(bf16, WS_SLOTS); float* out = OUTP();
        (void)x; (void)Hbuf; (void)MOD; (void)SLOTS;
#if DBG_STAGE == 0
        v2u nh[4], n0[4], n1[4];
#pragma unroll
        for (int j = 0; j < 4; ++j) { const int c = 4 * lane + 256 * j; nh[j] = *(const GAS v2u*)(Hbuf + (size_t)gw * D + c); n0[j] = *(const GAS v2u*)(SLOTS + (size_t)(2 * gw) * D + c); n1[j] = *(const GAS v2u*)(SLOTS + (size_t)(2 * gw + 1) * D + c); }
#pragma unroll 2
        for (int row = gw; row < T; row += NGW) {
            const int b = row / SEQ; f32x4 v[4]; float ss = 0.f; v2u ch[4], c0[4], c1[4];
#pragma unroll
            for (int j = 0; j < 4; ++j) { ch[j] = nh[j]; c0[j] = n0[j]; c1[j] = n1[j]; }
            const int rn = (row + NGW < T) ? row + NGW : row;
#pragma unroll
            for (int j = 0; j < 4; ++j) { const int c = 4 * lane + 256 * j; nh[j] = *(const GAS v2u*)(Hbuf + (size_t)rn * D + c); n0[j] = *(const GAS v2u*)(SLOTS + (size_t)(2 * rn) * D + c); n1[j] = *(const GAS v2u*)(SLOTS + (size_t)(2 * rn + 1) * D + c); }
#pragma unroll
            for (int j = 0; j < 4; ++j) { const int c = 4 * lane + 256 * j;
                v[j] = (f32x4){pg8::bf_lo(ch[j].x), pg8::bf_hi(ch[j].x), pg8::bf_lo(ch[j].y), pg8::bf_hi(ch[j].y)};
                const f32x4 gt = *(const f32x4*)(MOD + (size_t)b * 6 * D + 5 * D + c);
                const f32x4 f = (f32x4){pg8::bf_lo(c0[j].x) + pg8::bf_lo(c1[j].x), pg8::bf_hi(c0[j].x) + pg8::bf_hi(c1[j].x), pg8::bf_lo(c0[j].y) + pg8::bf_lo(c1[j].y), pg8::bf_hi(c0[j].y) + pg8::bf_hi(c1[j].y)};
                v[j] = v[j] + gt * f;
                ss += (v[j][0] * v[j][0] + v[j][1] * v[j][1]) + (v[j][2] * v[j][2] + v[j][3] * v[j][3]); }
            const float rstd = 1.0f / sqrtf(wave_sum(ss, lane) * (1.0f / D) + EPS);
#pragma unroll
            for (int j = 0; j < 4; ++j) { const int c = 4 * lane + 256 * j; const f32x4 g = *(const f32x4*)(g_final + c); *(f32x4*)(out + (size_t)row * D + c) = v[j] * rstd * g; }
        }
#else
        for (int row = gw; row < T; row += NGW) {
            f32x4 v[4]; float ss = 0.f;
#pragma unroll
            for (int j = 0; j < 4; ++j) { const int c = 4 * lane + 256 * j;
#if DBG_STAGE == 1
                v[j] = *(const f32x4*)(x + (size_t)row * D + c);
#else
                { const v2u hw = *(const GAS v2u*)(Hbuf + (size_t)row * D + c); v[j] = (f32x4){pg8::bf_lo(hw.x), pg8::bf_hi(hw.x), pg8::bf_lo(hw.y), pg8::bf_hi(hw.y)}; }
#endif
                ss += (v[j][0] * v[j][0] + v[j][1] * v[j][1]) + (v[j][2] * v[j][2] + v[j][3] * v[j][3]); }
            const float rstd = 1.0f / sqrtf(wave_sum(ss, lane) * (1.0f / D) + EPS);
#pragma unroll
            for (int j = 0; j < 4; ++j) { const int c = 4 * lane + 256 * j; const f32x4 g = *(const f32x4*)(g_final + c); *(f32x4*)(out + (size_t)row * D + c) = v[j] * rstd * g; }
        }
#endif
    }
}

extern "C" void kernel_launch(void* const* d_in, const int* in_sizes, int n_in, void* d_out, int out_size, void* d_ws, size_t ws_size, hipStream_t stream) {
    static int grid = 0;
    if (grid == 0) {
        if (n_in != 34 || out_size != T * D || ws_size < WS_END) { fprintf(stderr, "kernel_launch: unexpected shapes (n_in %d, out %d, ws %zu)\n", n_in, out_size, ws_size); grid = -1; return; }
        int dev = 0, cus = 0, per_cu = 0;
        if (hipGetDevice(&dev) != hipSuccess || hipDeviceGetAttribute(&cus, hipDeviceAttributeMultiprocessorCount, dev) != hipSuccess) { grid = -1; return; }
        if (hipFuncSetAttribute((const void*)fwd_kernel, hipFuncAttributeMaxDynamicSharedMemorySize, LDS_BYTES) != hipSuccess) { fprintf(stderr, "kernel_launch: hipFuncSetAttribute failed\n"); grid = -1; return; }
        if (hipOccupancyMaxActiveBlocksPerMultiprocessor(&per_cu, (const void*)fwd_kernel, NWAVES * 64, LDS_BYTES) != hipSuccess || per_cu < 1)
            fprintf(stderr, "kernel_launch: note: occupancy query reports %d workgroups per CU\n", per_cu);
        (void)hipGetLastError();
        grid = cus;
    }
    if (grid < 0) return;
    if (hipMemsetAsync((char*)d_ws + WS_CTL, 0, CTL_ZERO_BYTES, stream) != hipSuccess) { fprintf(stderr, "kernel_launch: memset failed\n"); return; }
    Args a{};
    for (int i = 0; i < 34; ++i) a.in[i] = (const float*)d_in[i];
    a.out = (float*)d_out; a.ws = (unsigned char*)d_ws;
    hipLaunchKernelGGL(fwd_kernel, dim3(grid), dim3(NWAVES * 64), LDS_BYTES, stream, a);
    const hipError_t le = hipPeekAtLastError();
    if (le != hipSuccess) fprintf(stderr, "kernel_launch: launch failed: %s\n", hipGetErrorName(le));
}
```

```cpp
#include <hip/hip_runtime.h>
#include <hip/hip_bf16.h>
#include <cstdio>
#include <cstdint>
#include <cmath>

#ifndef DBG_STAGE
#define DBG_STAGE 0
#endif

constexpr int D = 1024, NB = 8, SEQ = 4096, T = NB * SEQ;
constexpr int S5W = 512, NG = 32, NP = 64, INW = 5632;
constexpr int LC = 32, NCH = SEQ / LC, NRC = T / LC, KS = LC * 16, KY = KS + 128;
constexpr int NEXP = 32, DEXP = 256;
constexpr int KCAT = D + S5W;
constexpr int XS_ROWS = 2 * T + NEXP * 256;
constexpr float EPS = 1e-6f;
constexpr float LAMBDA_INIT = 0.2f;

namespace pg8 {
#define PG8_LAS __attribute__((address_space(3)))
typedef unsigned short bf16_t;
typedef short bf16x8 __attribute__((ext_vector_type(8)));
typedef float f32x4 __attribute__((ext_vector_type(4)));
typedef unsigned u32x4 __attribute__((ext_vector_type(4)));
typedef float f32x2 __attribute__((ext_vector_type(2)));
constexpr int BM = 256, BK = 64, HALF = 128, HTB = HALF * BK * 2, STAGE_BYTES = 8 * HTB, NXCD = 8, WGM = 8;

__host__ __device__ __forceinline__ int lds_byte(int r, int c) { const int st = (r >> 4) * 2 + (c >> 5), rr = r & 15, cc = c & 31, ob = rr * 64 + cc * 2; return st * 1024 + (ob ^ (((ob >> 9) & 1) << 5)); }
__host__ __device__ __forceinline__ void stage_rc(int b, int& R, int& C) { const int st = b / 1024, sb = b % 1024, swz = sb ^ (((sb >> 9) & 1) << 5); R = (st >> 1) * 16 + swz / 64; C = (st & 1) * 32 + (swz % 64) / 2; }
__host__ __device__ __forceinline__ int perm32(int rho) { const int n = rho >> 4, i = rho & 15; return 8 * (i >> 2) + 4 * n + (i & 3); }

struct Unit { int pm, pn, g, lt; const char* a; const char* b; };

struct StaticOrder {
    int nM, nN, nwg, G, c; const char* A; const char* B; size_t tsa, tsb;
    __device__ void init(const void* A_, int lda, const void* B_, int ldb, int M, int N, int G_, int c_) { nM = M / BM; nN = N / BM; nwg = nM * nN; G = G_; c = c_; A = (const char*)A_; B = (const char*)B_; tsa = (size_t)BM * lda * 2; tsb = (size_t)BM * ldb * 2; }
    __device__ bool next(int i, Unit& u) const {
        const long L = (long)i * G + c; if (L >= nwg) return false;
        int wgid = (int)L; { const int q = nwg / NXCD, r = nwg % NXCD, xcd = wgid % NXCD, off = wgid / NXCD; wgid = (xcd < r ? xcd * (q + 1) : r * (q + 1) + (xcd - r) * q) + off; }
        const int nig = WGM * nN, gid = wgid / nig, fm = gid * WGM, gsz = (nM - fm) < WGM ? (nM - fm) : WGM;
        u.pm = fm + ((wgid % nig) % gsz); u.pn = (wgid % nig) / gsz; u.g = 0; u.lt = 0; u.a = A + (size_t)u.pm * tsa; u.b = B + (size_t)u.pn * tsb; return true;
    }
};
struct GroupOrder {
    int nM, nN, ng, G, c; const char* A; const char* B; size_t tsa, tsb, gsa, gsb;
    __device__ void init(const void* A_, int lda, size_t gsa_, const void* B_, int ldb, size_t gsb_, int Mg, int Ng, int ng_, int G_, int c_) {
        nM = Mg / BM; nN = Ng / BM; ng = ng_; G = G_; c = c_; A = (const char*)A_; B = (const char*)B_; tsa = (size_t)BM * lda * 2; tsb = (size_t)BM * ldb * 2; gsa = gsa_; gsb = gsb_; }
    __device__ bool next(int i, Unit& u) const {
        const int per = nM * nN, x = c % NXCD, j = c / NXCD + (G / NXCD) * i; if (j >= (ng / NXCD) * per) return false;
        const int g = x + NXCD * (j / per), r = j % per;
        u.g = g; u.lt = 0; u.pm = r / nN; u.pn = r % nN; u.a = A + (size_t)g * gsa + (size_t)u.pm * tsa; u.b = B + (size_t)g * gsb + (size_t)u.pn * tsb; return true;
    }
};
struct ExpertOrder {
    const PG8_LAS int* tab; int nN, G, c; const char* A; const char* B; size_t tsa, tsb, esb;
    __device__ void init(const PG8_LAS int* tab_, const void* A_, size_t tsa_, const void* B_, int ldb, size_t esb_, int N, int G_, int c_) {
        tab = tab_; nN = N / BM; G = G_; c = c_; A = (const char*)A_; B = (const char*)B_; tsa = tsa_; tsb = (size_t)BM * ldb * 2; esb = esb_; }
    __device__ bool next(int i, Unit& u) const {
        const int NT = __builtin_amdgcn_readfirstlane(tab[XS_ROWS / 256 + 1]);
        const int x = c % NXCD, j = c / NXCD + (G / NXCD) * i, lo = (x * NT) / NXCD, hi = ((x + 1) * NT) / NXCD;
        const int rt = lo + j / nN, pn = j % nN;
        if (rt >= hi) return false;
        const int e = __builtin_amdgcn_readfirstlane(tab[rt]);
        u.g = e & 255; u.lt = e >> 8; u.pm = rt; u.pn = pn; u.a = A + (size_t)rt * tsa; u.b = B + (size_t)u.g * esb + (size_t)pn * tsb; return true;
    }
};

__device__ __forceinline__ unsigned cvt_pk_bf16(float lo, float hi) { unsigned r; asm volatile("v_cvt_pk_bf16_f32 %0, %1, %2" : "=v"(r) : "v"(lo), "v"(hi)); return r; }
__device__ __forceinline__ float bf_lo(unsigned w) { return __uint_as_float(w << 16); }
__device__ __forceinline__ float bf_hi(unsigned w) { return __uint_as_float(w & 0xffff0000u); }
__device__ __forceinline__ float sigmoidf_(float x) { return __builtin_amdgcn_rcpf(1.0f + __builtin_amdgcn_exp2f(-1.4426950408889634f * x)); }
__device__ __forceinline__ void unpack8(const u32x4 w, float (&f)[8]) { f[0] = bf_lo(w.x); f[1] = bf_hi(w.x); f[2] = bf_lo(w.y); f[3] = bf_hi(w.y); f[4] = bf_lo(w.z); f[5] = bf_hi(w.z); f[6] = bf_lo(w.w); f[7] = bf_hi(w.w); }
__device__ __forceinline__ u32x4 pack8(const float (&f)[8]) { u32x4 w; w.x = cvt_pk_bf16(f[0], f[1]); w.y = cvt_pk_bf16(f[2], f[3]); w.z = cvt_pk_bf16(f[4], f[5]); w.w = cvt_pk_bf16(f[6], f[7]); return w; }

#define EPI_LOOP_PERM(...) \
    _Pragma("unroll") for (int ai = 0; ai < 2; ++ai) _Pragma("unroll") for (int m = 0; m < 4; ++m) { const int lrow = ai * HALF + wr * 64 + m * 16 + fr; \
        _Pragma("unroll") for (int bj = 0; bj < 2; ++bj) { const int lcol = bj * HALF + wc * 32 + 8 * fq; \
            float v[8] = {acc[ai][bj][m][0][0], acc[ai][bj][m][0][1], acc[ai][bj][m][0][2], acc[ai][bj][m][0][3], acc[ai][bj][m][1][0], acc[ai][bj][m][1][1], acc[ai][bj][m][1][2], acc[ai][bj][m][1][3]}; __VA_ARGS__ } }

#define EPI_HALF_PRE(...) _Pragma("unroll") for (int m = 0; m < 4; ++m) { const int lrow = ai * HALF + wr * 64 + m * 16 + fr; (void)lrow; \
        _Pragma("unroll") for (int bj = 0; bj < 2; ++bj) { const int lcol = bj * HALF + wc * 32 + 8 * fq; (void)lcol; __VA_ARGS__ } }
#define EPI_HALF_RUN(...) _Pragma("unroll") for (int m = 0; m < 4; ++m) { const int lrow = ai * HALF + wr * 64 + m * 16 + fr; (void)lrow; \
        _Pragma("unroll") for (int bj = 0; bj < 2; ++bj) { const int lcol = bj * HALF + wc * 32 + 8 * fq; (void)lcol; \
            float v[8] = {acc[ai][bj][m][0][0], acc[ai][bj][m][0][1], acc[ai][bj][m][0][2], acc[ai][bj][m][0][3], acc[ai][bj][m][1][0], acc[ai][bj][m][1][1], acc[ai][bj][m][1][2], acc[ai][bj][m][1][3]}; __VA_ARGS__ } }

struct EpiProj {
    static constexpr bool PERM = true, AFTER_DRAIN = false;
    const float* bias; bf16_t* U; bf16_t* Q; bf16_t* Kb; bf16_t* V; bf16_t* Gt; float c2;
    __device__ __forceinline__ void operator()(const f32x4 (&acc)[2][2][4][2], const Unit& u, int wr, int wc, int fr, int fq) const {
        const int ct = u.pn;
        f32x4 bv[2][2];
#pragma unroll
        for (int bj = 0; bj < 2; ++bj) { const int col = ct * BM + bj * HALF + wc * 32 + 8 * fq; bv[bj][0] = *(const f32x4*)(bias + col); bv[bj][1] = *(const f32x4*)(bias + col + 4); }
        EPI_LOOP_PERM({
            const int row = u.pm * BM + lrow, col = ct * BM + lcol;
            v[0] += bv[bj][0][0]; v[1] += bv[bj][0][1]; v[2] += bv[bj][0][2]; v[3] += bv[bj][0][3]; v[4] += bv[bj][1][0]; v[5] += bv[bj][1][1]; v[6] += bv[bj][1][2]; v[7] += bv[bj][1][3];
            bf16_t* dst;
            if (ct < 2) { const int g = col >> 4, ci = col & 15, rc = row / LC, s = row % LC; dst = U + ((size_t)(g * NRC + rc) * KY + s * 16 + ci); }
            else if (ct < 6) { _Pragma("unroll") for (int i = 0; i < 8; ++i) v[i] *= c2; dst = Q + (size_t)row * D + (col - 512); }
            else if (ct < 10) { dst = Kb + (size_t)row * D + (col - 1536); }
            else if (ct < 14) { dst = V + (size_t)row * D + (col - 2560); }
            else { _Pragma("unroll") for (int i = 0; i < 8; ++i) v[i] = sigmoidf_(v[i]); dst = Gt + (size_t)row * 2048 + (col - 3584); }
            *(u32x4*)dst = pack8(v);
        })
    }
};
struct EpiStates {
    static constexpr bool PERM = false, AFTER_DRAIN = false;
    float* S;
    __device__ __forceinline__ void operator()(const f32x4 (&acc)[2][2][4][2], const Unit& u, int wr, int wc, int fr, int fq) const {
#pragma unroll
        for (int ai = 0; ai < 2; ++ai)
#pragma unroll
            for (int m = 0; m < 4; ++m) { const int row = u.pm * BM + ai * HALF + wr * 64 + m * 16 + fr;
#pragma unroll
                for (int n = 0; n < 2; ++n) { const f32x4 v = acc[ai][0][m][n] + acc[ai][1][m][n]; *(f32x4*)(S + ((size_t)(u.g * NRC + row) * 128 + wc * 32 + 16 * n + 4 * fq)) = v; } }
    }
};
struct EpiY {
    static constexpr bool PERM = true, AFTER_DRAIN = false;
    const bf16_t* U; const float* dskip; bf16_t* Y;
    __device__ __forceinline__ void operator()(const f32x4 (&acc)[2][2][4][2], const Unit& u, int wr, int wc, int fr, int fq) const {
        f32x4 dk[2][2];
#pragma unroll
        for (int bj = 0; bj < 2; ++bj) { const int co = (bj * HALF + wc * 32 + 8 * fq) & 15; dk[bj][0] = *(const f32x4*)(dskip + u.g * 16 + co); dk[bj][1] = *(const f32x4*)(dskip + u.g * 16 + co + 4); }
#pragma unroll
        for (int ai = 0; ai < 2; ++ai) {
            u32x4 uw[4][2];
            EPI_HALF_PRE({ const int rc = u.pm * BM + lrow, n = u.pn * BM + lcol; uw[m][bj] = *(const u32x4*)(U + ((size_t)(u.g * NRC + rc) * KY + n)); })
            EPI_HALF_RUN({
                const int rc = u.pm * BM + lrow, n = u.pn * BM + lcol, tt = n >> 4, co = n & 15;
                float uf[8]; unpack8(uw[m][bj], uf);
                const float dd[8] = {dk[bj][0][0], dk[bj][0][1], dk[bj][0][2], dk[bj][0][3], dk[bj][1][0], dk[bj][1][1], dk[bj][1][2], dk[bj][1][3]};
                _Pragma("unroll") for (int i = 0; i < 8; ++i) { const float y = v[i] + dd[i] * uf[i]; const float z = 1.5957691216057308f * (y + 0.044715f * y * y * y); v[i] = y * sigmoidf_(z); }
                *(u32x4*)(Y + ((size_t)(rc * LC + tt) * S5W + u.g * 16 + co)) = pack8(v);
            })
        }
    }
};
struct EpiGlu {
    static constexpr bool PERM = true, AFTER_DRAIN = false;
    const bf16_t* Y; const float* bias; bf16_t* O; int ldo;
    __device__ __forceinline__ void operator()(const f32x4 (&acc)[2][2][4][2], const Unit& u, int wr, int wc, int fr, int fq) const {
        f32x4 bv[2][2];
#pragma unroll
        for (int bj = 0; bj < 2; ++bj) { const int col = u.pn * BM + bj * HALF + wc * 32 + 8 * fq; bv[bj][0] = *(const f32x4*)(bias + col); bv[bj][1] = *(const f32x4*)(bias + col + 4); }
#pragma unroll
        for (int ai = 0; ai < 2; ++ai) {
            u32x4 yw[4][2];
            EPI_HALF_PRE({ const int row = u.pm * BM + lrow, col = u.pn * BM + lcol; yw[m][bj] = *(const u32x4*)(Y + (size_t)row * S5W + col); })
            EPI_HALF_RUN({
                const int row = u.pm * BM + lrow, col = u.pn * BM + lcol;
                float yf[8]; unpack8(yw[m][bj], yf);
                const float bb[8] = {bv[bj][0][0], bv[bj][0][1], bv[bj][0][2], bv[bj][0][3], bv[bj][1][0], bv[bj][1][1], bv[bj][1][2], bv[bj][1][3]};
                _Pragma("unroll") for (int i = 0; i < 8; ++i) v[i] = yf[i] * sigmoidf_(v[i] + bb[i]);
                *(u32x4*)(O + (size_t)row * ldo + col) = pack8(v);
            })
        }
    }
};
struct NoHook { static constexpr int AT = -1; __device__ __forceinline__ void operator()(f32x4 (&)[2][2][4][2], const Unit&, int, int, int, int) const {} };
struct HookGate {
    static constexpr int AT = D / BK;
    const bf16_t* Gt;
    __device__ __forceinline__ void operator()(f32x4 (&acc)[2][2][4][2], const Unit& u, int wr, int wc, int fr, int fq) const {
#pragma unroll
        for (int ai = 0; ai < 2; ++ai)
#pragma unroll
            for (int mh = 0; mh < 2; ++mh) {
                u32x4 gs[2][2], ga[2][2];
#pragma unroll
                for (int mm = 0; mm < 2; ++mm)
#pragma unroll
                    for (int bj = 0; bj < 2; ++bj) { const int lrow = ai * HALF + wr * 64 + (2 * mh + mm) * 16 + fr, lcol = bj * HALF + wc * 32 + 8 * fq;
                        const bf16_t* p = Gt + (size_t)(u.pm * BM + lrow) * 2048 + u.pn * BM + lcol; gs[mm][bj] = *(const u32x4*)p; ga[mm][bj] = *(const u32x4*)(p + D); }
#pragma unroll
                for (int mm = 0; mm < 2; ++mm)
#pragma unroll
                    for (int bj = 0; bj < 2; ++bj) { float fs[8], fa[8]; unpack8(gs[mm][bj], fs); unpack8(ga[mm][bj], fa);
#pragma unroll
                        for (int i = 0; i < 8; ++i) acc[ai][bj][2 * mh + mm][i >> 2][i & 3] *= fa[i] * __builtin_amdgcn_rcpf(__builtin_fmaxf(fs[i], 1e-20f)); }
            }
    }
};
struct EpiMerge {
    static constexpr bool PERM = true, AFTER_DRAIN = false;
    const bf16_t* Gt; bf16_t* O;
    __device__ __forceinline__ void operator()(const f32x4 (&acc)[2][2][4][2], const Unit& u, int wr, int wc, int fr, int fq) const {
#pragma unroll
        for (int ai = 0; ai < 2; ++ai) {
            u32x4 gw[4][2];
            EPI_HALF_PRE({ const int row = u.pm * BM + lrow, col = u.pn * BM + lcol; gw[m][bj] = *(const u32x4*)(Gt + (size_t)row * 2048 + col); })
            EPI_HALF_RUN({
                const int row = u.pm * BM + lrow, col = u.pn * BM + lcol;
                float gf[8]; unpack8(gw[m][bj], gf);
                _Pragma("unroll") for (int i = 0; i < 8; ++i) v[i] = gf[i] * v[i];
                *(u32x4*)(O + (size_t)row * D + col) = pack8(v);
            })
        }
    }
};
struct EpiOut {
    static constexpr bool PERM = true, AFTER_DRAIN = false;
    const float* x; const float* mod; bf16_t* H;
    __device__ __forceinline__ void operator()(const f32x4 (&acc)[2][2][4][2], const Unit& u, int wr, int wc, int fr, int fq) const {
        const int b = (u.pm * BM) / SEQ; const float* gt = mod + (size_t)b * 6 * D + 2 * D;
        f32x4 gv[2][2];
#pragma unroll
        for (int bj = 0; bj < 2; ++bj) { const int col = u.pn * BM + bj * HALF + wc * 32 + 8 * fq; gv[bj][0] = *(const f32x4*)(gt + col); gv[bj][1] = *(const f32x4*)(gt + col + 4); }
#pragma unroll
        for (int ai = 0; ai < 2; ++ai) {
            f32x4 xv[4][2][2];
            EPI_HALF_PRE({ const size_t off = (size_t)(u.pm * BM + lrow) * D + u.pn * BM + lcol; xv[m][bj][0] = *(const f32x4*)(x + off); xv[m][bj][1] = *(const f32x4*)(x + off + 4); })
            EPI_HALF_RUN({
                const size_t off = (size_t)(u.pm * BM + lrow) * D + u.pn * BM + lcol;
                _Pragma("unroll") for (int i = 0; i < 4; ++i) { v[i] = xv[m][bj][0][i] + gv[bj][0][i] * v[i]; v[4 + i] = xv[m][bj][1][i] + gv[bj][1][i] * v[4 + i]; }
                *(u32x4*)(H + off) = pack8(v);
            })
        }
    }
};
struct EpiRouter {
    static constexpr bool PERM = false, AFTER_DRAIN = false;
    float* L;
    __device__ __forceinline__ void operator()(const f32x4 (&acc)[2][2][4][2], const Unit& u, int wr, int wc, int fr, int fq) const {
        if (wc < 2) {
#pragma unroll
            for (int ai = 0; ai < 2; ++ai)
#pragma unroll
                for (int m = 0; m < 4; ++m) { const int row = u.pm * BM + ai * HALF + wr * 64 + m * 16 + fr;
#pragma unroll
                    for (int n = 0; n < 2; ++n) { const f32x4 v = acc[ai][0][m][n] + acc[ai][1][m][n]; *(f32x4*)(L + (size_t)row * 64 + wc * 32 + 16 * n + 4 * fq) = v; } }
        }
    }
};
struct EpiExp1 {
    static constexpr bool PERM = true, AFTER_DRAIN = false;
    bf16_t* Hd;
    __device__ __forceinline__ void operator()(const f32x4 (&acc)[2][2][4][2], const Unit& u, int wr, int wc, int fr, int fq) const {
#pragma unroll
        for (int ai = 0; ai < 2; ++ai)
#pragma unroll
            for (int m = 0; m < 4; ++m) { const int row = u.pm * BM + ai * HALF + wr * 64 + m * 16 + fr; float v[8];
#pragma unroll
                for (int n = 0; n < 2; ++n)
#pragma unroll
                    for (int i = 0; i < 4; ++i) { const float g = acc[ai][0][m][n][i], up = acc[ai][1][m][n][i]; v[n * 4 + i] = g * sigmoidf_(g) * up; }
                *(u32x4*)(Hd + (size_t)row * DEXP + u.pn * HALF + wc * 32 + 8 * fq) = pack8(v); }
    }
};
struct EpiExp2 {
    static constexpr bool PERM = true, AFTER_DRAIN = false;
    const int* list; const float* cwl; const int* cnt; bf16_t* Sl;
    __device__ __forceinline__ void operator()(const f32x4 (&acc)[2][2][4][2], const Unit& u, int wr, int wc, int fr, int fq) const {
        const int n = cnt[u.g];
#pragma unroll
        for (int ai = 0; ai < 2; ++ai) {
            int dd[4]; float ww[4];
#pragma unroll
            for (int m = 0; m < 4; ++m) { const int pos = u.lt * BM + ai * HALF + wr * 64 + m * 16 + fr; const bool ok = pos < n; const size_t li = (size_t)u.g * T + (ok ? pos : 0);
                const int d = list[li]; const float w = cwl[li]; dd[m] = ok ? d : -1; ww[m] = w; }
            EPI_HALF_RUN({
                const int col = u.pn * BM + lcol; const int d = dd[m]; const float w = ww[m];
                if (d >= 0) { _Pragma("unroll") for (int i = 0; i < 8; ++i) v[i] *= w; *(u32x4*)(Sl + (size_t)d * D + col) = pack8(v); }
            })
        }
    }
};

template <class Epi, class Sched, bool ALIGN_EPI = false, bool SP2 = false, bool GATHER = false, class Hook = NoHook>
__device__ __forceinline__ void gemm_phase(PG8_LAS unsigned char* lds, const int K, const int lda, const int ldb, const Sched& S, const Epi& E, const PG8_LAS int* rowtab = nullptr, const Hook& HK = Hook()) {
    int tid = threadIdx.x; asm volatile("" : "+v"(tid));
    const int wid = __builtin_amdgcn_readfirstlane(tid >> 6), lane = tid & 63, wr = wid >> 2, wc = wid & 3, fr = lane & 15, fq = lane >> 4;
    const int nt = K / BK;
    unsigned voffA[2], voffB[2]; int gR[2]; unsigned gC[2];
#pragma unroll
    for (int i = 0; i < 2; ++i) { int R, C; stage_rc(tid * 16 + i * 8192, R, C); const int Rb = Epi::PERM ? ((R & ~31) + perm32(R & 31)) : R;
        voffA[i] = (unsigned)(R * lda + C) * 2u; voffB[i] = (unsigned)(Rb * ldb + C) * 2u; gR[i] = R; gC[i] = (unsigned)C * 2u; }
    unsigned vAc[2][2], vAn[2][2], vA2[2][2];
    (void)gR; (void)gC; (void)vAc; (void)vAn; (void)vA2;
#define PG8_GLOAD(dst, ui_) do { _Pragma("unroll") for (int _h = 0; _h < 2; ++_h) _Pragma("unroll") for (int _i = 0; _i < 2; ++_i) \
        dst[_h][_i] = (unsigned)rowtab[(ui_) * 256 + _h * HALF + gR[_i]] * (unsigned)(lda * 2) + gC[_i]; } while (0)
    const size_t kstep = (size_t)(BK * 2);
    const size_t hstepA = (size_t)HALF * lda * 2, hstepB = (size_t)HALF * ldb * 2;
    const unsigned ldsw = (unsigned)wid * 1024u;
    const int aoff = lds_byte(wr * 64 + fr, fq * 8), boff = lds_byte(wc * 32 + fr, fq * 8);
#define PG8_SA(b, h) (((b) * 2 + (h)) * HTB)
#define PG8_SB(b, h) ((4 + (b) * 2 + (h)) * HTB)
#define PG8_STAGE(bufoff, gbase, voff) do { _Pragma("unroll") for (int _i = 0; _i < 2; ++_i) \
        __builtin_amdgcn_global_load_lds((const unsigned*)((const char*)(gbase) + (voff)[_i]), (PG8_LAS unsigned*)(lds + (bufoff) + ldsw + _i * 8192), 16, 0, 0); } while (0)
#define PG8_STAGE_A(bufoff, gbase, h, vs) do { if constexpr (GATHER) { PG8_STAGE(bufoff, gbase, vs[h]); } else { PG8_STAGE(bufoff, (gbase) + (h) * hstepA, voffA); } } while (0)
#define PG8_LDA(dst, b, h) do { _Pragma("unroll") for (int m = 0; m < 4; ++m) _Pragma("unroll") for (int k = 0; k < 2; ++k) dst[m][k] = *(const PG8_LAS bf16x8*)(lds + PG8_SA(b, h) + aoff + m * 2048 + k * 1024); } while (0)
#define PG8_LDB(dst, b, h) do { _Pragma("unroll") for (int n = 0; n < 2; ++n) _Pragma("unroll") for (int k = 0; k < 2; ++k) dst[n][k] = *(const PG8_LAS bf16x8*)(lds + PG8_SB(b, h) + boff + n * 2048 + k * 1024); } while (0)
#define PG8_MMA(ai, bj, At, Bt) do { __builtin_amdgcn_s_setprio(1); _Pragma("unroll") for (int m = 0; m < 4; ++m) _Pragma("unroll") for (int n = 0; n < 2; ++n) _Pragma("unroll") for (int k = 0; k < 2; ++k) \
        acc[ai][bj][m][n] = __builtin_amdgcn_mfma_f32_16x16x32_bf16(Bt[n][k], At[m][k], acc[ai][bj][m][n], 0, 0, 0); __builtin_amdgcn_s_setprio(0); } while (0)
#define PG8_WAIT_V(n) asm volatile("s_waitcnt vmcnt(" #n ")" ::: "memory")
#define PG8_WAIT_L(n) asm volatile("s_waitcnt lgkmcnt(" #n ")" ::: "memory")
#define PG8_BAR __builtin_amdgcn_s_barrier()
#define PG8_SCHED __builtin_amdgcn_sched_barrier(0)
    Unit cur, nxt; int ui = 0;
    if (!S.next(0, cur)) return;
    f32x4 acc[2][2][4][2];
#pragma unroll
    for (int a = 0; a < 2; ++a)
#pragma unroll
        for (int b = 0; b < 2; ++b)
#pragma unroll
            for (int m = 0; m < 4; ++m)
#pragma unroll
                for (int n = 0; n < 2; ++n) acc[a][b][m][n] = (f32x4){0.f, 0.f, 0.f, 0.f};
    bf16x8 At[4][2], B0[2][2], B1[2][2];
    const char* cA = cur.a; const char* cB = cur.b;
    if constexpr (GATHER) { PG8_GLOAD(vAc, 0); }
    static_assert(SP2 || !GATHER, "GATHER is wired into the SP2 loop only");
    if constexpr (SP2) {
        PG8_STAGE(PG8_SB(0, 0), cB, voffB); PG8_STAGE(PG8_SB(0, 1), cB + hstepB, voffB); PG8_STAGE_A(PG8_SA(0, 0), cA, 0, vAc); PG8_STAGE_A(PG8_SA(0, 1), cA, 1, vAc);
        if (wr == 1) PG8_BAR;
        PG8_WAIT_V(2); PG8_BAR;
        PG8_STAGE(PG8_SB(1, 0), cB + kstep, voffB); PG8_STAGE_A(PG8_SA(1, 0), cA + kstep, 0, vAc); PG8_STAGE(PG8_SB(1, 1), cB + hstepB + kstep, voffB);
        PG8_WAIT_V(6); PG8_BAR;
    } else {
        PG8_STAGE(PG8_SB(0, 0), cB, voffB); PG8_STAGE(PG8_SA(0, 0), cA, voffA); PG8_STAGE(PG8_SB(0, 1), cB + hstepB, voffB); PG8_STAGE(PG8_SA(0, 1), cA + hstepA, voffA);
        if (wr == 1) PG8_BAR;
        PG8_WAIT_V(4); PG8_BAR;
        PG8_STAGE(PG8_SB(1, 0), cB + kstep, voffB); PG8_STAGE(PG8_SA(1, 0), cA + kstep, voffA); PG8_STAGE(PG8_SB(1, 1), cB + hstepB + kstep, voffB);
        PG8_WAIT_V(6); PG8_BAR;
    }
    for (;;) {
        const bool has_next = S.next(ui + 1, nxt);
        const char* nA = has_next ? nxt.a : cA; const char* nB = has_next ? nxt.b : cB;
        if constexpr (GATHER) { if (has_next) { PG8_GLOAD(vAn, ui + 1); } else {
            _Pragma("unroll") for (int _h = 0; _h < 2; ++_h) _Pragma("unroll") for (int _i = 0; _i < 2; ++_i) vAn[_h][_i] = vAc[_h][_i]; } }
        for (int t = 0; t < nt; t += 2) {
            const bool last = (t == nt - 2);
            if constexpr (GATHER) { _Pragma("unroll") for (int _h = 0; _h < 2; ++_h) _Pragma("unroll") for (int _i = 0; _i < 2; ++_i) vA2[_h][_i] = last ? vAn[_h][_i] : vAc[_h][_i]; }
            if constexpr (Hook::AT >= 0) { if (t == Hook::AT) HK(acc, cur, wr, wc, fr, fq); }
            const char* a1 = cA + (size_t)(t + 1) * kstep;
            const char* a2 = last ? nA : cA + (size_t)(t + 2) * kstep; const char* b2 = last ? nB : cB + (size_t)(t + 2) * kstep;
            const char* a3 = a2 + kstep; const char* b3 = b2 + kstep;
            if constexpr (SP2) {
            PG8_LDB(B0, 0, 0); PG8_LDB(B1, 0, 1); PG8_SCHED; PG8_LDA(At, 0, 0); PG8_STAGE_A(PG8_SA(1, 1), a1, 1, vAc);
            PG8_WAIT_V(8); PG8_WAIT_L(0); PG8_BAR; PG8_MMA(0, 0, At, B0); PG8_MMA(0, 1, At, B1); PG8_BAR; PG8_SCHED;
            PG8_LDA(At, 0, 1); PG8_STAGE(PG8_SB(0, 0), b2, voffB); PG8_STAGE(PG8_SB(0, 1), b2 + hstepB, voffB); PG8_STAGE_A(PG8_SA(0, 0), a2, 0, vA2);
            PG8_WAIT_V(8); PG8_WAIT_L(0); PG8_BAR; PG8_MMA(1, 0, At, B0); PG8_MMA(1, 1, At, B1); PG8_BAR; PG8_SCHED;
            PG8_LDB(B0, 1, 0); PG8_LDB(B1, 1, 1); PG8_SCHED; PG8_LDA(At, 1, 0); PG8_STAGE_A(PG8_SA(0, 1), a2, 1, vA2);
            PG8_WAIT_V(8); PG8_WAIT_L(0); PG8_BAR; PG8_MMA(0, 0, At, B0); PG8_MMA(0, 1, At, B1); PG8_BAR; PG8_SCHED;
            PG8_LDA(At, 1, 1); PG8_STAGE(PG8_SB(1, 0), b3, voffB); PG8_STAGE(PG8_SB(1, 1), b3 + hstepB, voffB); PG8_STAGE_A(PG8_SA(1, 0), a3, 0, vA2);
            PG8_WAIT_V(8); PG8_WAIT_L(0); PG8_BAR; PG8_MMA(1, 0, At, B0); PG8_MMA(1, 1, At, B1); PG8_BAR; PG8_SCHED;
            } else {
            PG8_LDB(B0, 0, 0); PG8_SCHED; PG8_LDA(At, 0, 0); PG8_STAGE(PG8_SA(1, 1), a1 + hstepA, voffA);
            PG8_WAIT_L(8); PG8_BAR; PG8_WAIT_L(0); PG8_MMA(0, 0, At, B0); PG8_BAR; PG8_SCHED;
            PG8_LDB(B1, 0, 1); PG8_STAGE(PG8_SB(0, 0), b2, voffB);
            PG8_BAR; PG8_WAIT_L(0); PG8_MMA(0, 1, At, B1); PG8_BAR;
            PG8_LDA(At, 0, 1); PG8_STAGE(PG8_SA(0, 0), a2, voffA);
            PG8_BAR; PG8_WAIT_L(0); PG8_MMA(1, 0, At, B0); PG8_BAR; PG8_SCHED;
            PG8_STAGE(PG8_SB(0, 1), b2 + hstepB, voffB);
            PG8_WAIT_V(6); PG8_BAR; PG8_MMA(1, 1, At, B1); PG8_BAR;
            PG8_LDB(B0, 1, 0); PG8_SCHED; PG8_LDA(At, 1, 0); PG8_STAGE(PG8_SA(0, 1), a2 + hstepA, voffA);
            PG8_WAIT_L(8); PG8_BAR; PG8_WAIT_L(0); PG8_MMA(0, 0, At, B0); PG8_BAR; PG8_SCHED;
            PG8_LDB(B1, 1, 1); PG8_STAGE(PG8_SB(1, 0), b3, voffB);
            PG8_BAR; PG8_WAIT_L(0); PG8_MMA(0, 1, At, B1); PG8_BAR;
            PG8_LDA(At, 1, 1); PG8_STAGE(PG8_SA(1, 0), a3, voffA);
            PG8_BAR; PG8_WAIT_L(0); PG8_MMA(1, 0, At, B0); PG8_BAR; PG8_SCHED;
            PG8_STAGE(PG8_SB(1, 1), b3 + hstepB, voffB);
            PG8_WAIT_V(6); PG8_BAR; PG8_MMA(1, 1, At, B1); PG8_BAR;
            }
        }
        if constexpr (ALIGN_EPI) { if (wr == 0) PG8_BAR; }
        E(acc, cur, wr, wc, fr, fq);
        if (!has_next) break;
#pragma unroll
        for (int a = 0; a < 2; ++a)
#pragma unroll
            for (int b = 0; b < 2; ++b)
#pragma unroll
                for (int m = 0; m < 4; ++m)
#pragma unroll
                    for (int n = 0; n < 2; ++n) acc[a][b][m][n] = (f32x4){0.f, 0.f, 0.f, 0.f};
        cur = nxt; cA = nA; cB = nB; ++ui;
        if constexpr (GATHER) { _Pragma("unroll") for (int _h = 0; _h < 2; ++_h) _Pragma("unroll") for (int _i = 0; _i < 2; ++_i) vAc[_h][_i] = vAn[_h][_i]; }
        if constexpr (ALIGN_EPI) { if (wr == 1) PG8_BAR; }
    }
    PG8_WAIT_V(0);
    if constexpr (!ALIGN_EPI) { if (wr == 0) PG8_BAR; }
    PG8_BAR;
#undef PG8_SA
#undef PG8_SB
#undef PG8_STAGE
#undef PG8_STAGE_A
#undef PG8_GLOAD
#undef PG8_LDA
#undef PG8_LDB
#undef PG8_MMA
#undef PG8_WAIT_V
#undef PG8_WAIT_L
#undef PG8_BAR
#undef PG8_SCHED
}
}

namespace attn_body {
using bf16=__hip_bfloat16;
using bf16x8=__attribute__((ext_vector_type(8)))short;
using s16x4=__attribute__((ext_vector_type(4)))short;
using f32x16=__attribute__((ext_vector_type(16)))float;
using u32x4=__attribute__((ext_vector_type(4)))unsigned;
constexpr int NHEAD=16,SEQ=4096,D=64,DM=NHEAD*D;
constexpr int NW=8,QBLK=32,QB=QBLK*NW,KVBLK=64,NQB=SEQ/QB;
__device__ __forceinline__ int crow(int r,int hi){return (r&3)+8*(r>>2)+4*hi;}
#define SBAR() __builtin_amdgcn_sched_barrier(0)
__device__ __forceinline__ void cmask(f32x16&p0,f32x16&p1,int jb,int wid){
  const float NEG=-INFINITY;
  if(jb>(wid>>1)){
  #pragma unroll
  for(int r=0;r<16;++r){p0[r]=NEG;p1[r]=NEG;}}
}
constexpr int NSLOT=3, SLOTB=8192, VSLOTB=16384;
constexpr int LDS_K=0, LDS_V=NSLOT*SLOTB, LDS_WS=LDS_V+NSLOT*VSLOTB, LDS_OST=LDS_WS+NW*64*4, LDS_BYTES=LDS_OST+NW*8192;
constexpr float C2=0.125f*1.4426950408889634f;
__device__ __forceinline__ void glds16(const char*sbase,unsigned voff,unsigned lds_dst){unsigned keep;
  asm volatile("s_mov_b32 %0, m0\n\ts_mov_b32 m0, %2\n\ts_nop 0\n\tglobal_load_lds_dwordx4 %1, %3\n\ts_mov_b32 m0, %0":"=&s"(keep):"v"(voff),"s"(lds_dst),"s"(sbase):"memory");}
__device__ __forceinline__ float max3f(float a,float b,float c){float r;asm("v_max3_f32 %0, %1, %2, %3":"=v"(r):"v"(a),"v"(b),"v"(c));return r;}
__device__ __forceinline__ float max2f(float a,float b){float r;asm("v_max_f32_e32 %0, %1, %2":"=v"(r):"v"(a),"v"(b));return r;}
typedef float f32x2_t __attribute__((ext_vector_type(2))); typedef __bf16 bf16x2_t __attribute__((ext_vector_type(2)));
__device__ __forceinline__ unsigned cvtpk_s(float lo,float hi){f32x2_t v={lo,hi};bf16x2_t b=__builtin_convertvector(v,bf16x2_t);return __builtin_bit_cast(unsigned,b);}
#define WAIT_BAR(N) asm volatile("s_waitcnt vmcnt(" #N ") lgkmcnt(0)\n\ts_barrier":::"memory")

__device__ __forceinline__ void qkt(f32x16&p0,f32x16&p1,const char*Kslot,const bf16x8*qr,int r32,int hi){
  const char*kb=Kslot+hi*1024+r32*16; const f32x16 z=f32x16{};
  #pragma unroll
  for(int d0=0;d0<4;++d0){
    const bf16x8 b0=*reinterpret_cast<const bf16x8*>(kb+d0*2048);
    const bf16x8 b1=*reinterpret_cast<const bf16x8*>(kb+d0*2048+512);
    if(d0==0){p0=__builtin_amdgcn_mfma_f32_32x32x16_bf16(b0,qr[0],z,0,0,0);p1=__builtin_amdgcn_mfma_f32_32x32x16_bf16(b1,qr[0],z,0,0,0);}
    else{p0=__builtin_amdgcn_mfma_f32_32x32x16_bf16(b0,qr[d0],p0,0,0,0);p1=__builtin_amdgcn_mfma_f32_32x32x16_bf16(b1,qr[d0],p1,0,0,0);}}
}
typedef __attribute__((address_space(3))) const char* lds_cptr;
typedef short v4i16_t __attribute__((ext_vector_type(4)));
__device__ __forceinline__ void kload8(bf16x8*kf,lds_cptr kp){
  kf[0]=*(const __attribute__((address_space(3))) bf16x8*)(kp);      kf[1]=*(const __attribute__((address_space(3))) bf16x8*)(kp+512);
  kf[2]=*(const __attribute__((address_space(3))) bf16x8*)(kp+2048); kf[3]=*(const __attribute__((address_space(3))) bf16x8*)(kp+2560);
  kf[4]=*(const __attribute__((address_space(3))) bf16x8*)(kp+4096); kf[5]=*(const __attribute__((address_space(3))) bf16x8*)(kp+4608);
  kf[6]=*(const __attribute__((address_space(3))) bf16x8*)(kp+6144); kf[7]=*(const __attribute__((address_space(3))) bf16x8*)(kp+6656);
}
__device__ __forceinline__ void kload2(bf16x8*kf,lds_cptr kp,int j){ kf[2*j]=*(const __attribute__((address_space(3))) bf16x8*)(kp+j*2048); kf[2*j+1]=*(const __attribute__((address_space(3))) bf16x8*)(kp+j*2048+512); }
__device__ __forceinline__ s16x4 vtr(lds_cptr p){ return __builtin_bit_cast(s16x4,__builtin_amdgcn_ds_read_tr16_b64_v4i16((__attribute__((address_space(3))) v4i16_t*)p)); }
__device__ __forceinline__ float rowmax(const f32x16&p0,const f32x16&p1){
  float a=max3f(p0[0],p0[1],p1[0]),b=max3f(p0[2],p0[3],p1[1]);a=max3f(a,p1[2],p1[3]);
  #pragma unroll
  for(int r=4;r<16;r+=4){a=max3f(a,p0[r],p0[r+1]);b=max3f(b,p0[r+2],p0[r+3]);a=max3f(a,p1[r],p1[r+1]);b=max3f(b,p1[r+2],p1[r+3]);}
  const float m=max2f(a,b);
  auto rr=__builtin_amdgcn_permlane32_swap(__float_as_uint(m),__float_as_uint(m),false,false);
  return max2f(__uint_as_float(rr[0]),__uint_as_float(rr[1]));
}
__device__ __forceinline__ void pv(f32x16*o,int vb,bf16x8 pa0,bf16x8 pa1,bf16x8 pa2,bf16x8 pa3){
  #pragma unroll
  for(int d0=0;d0<4;++d0){s16x4 lo[4],hi[4];
    #pragma unroll
    for(int ks=0;ks<4;++ks){
      asm volatile("ds_read_b64_tr_b16 %0,%1 offset:%c2":"=&v"(lo[ks]):"v"(vb),"i"(d0*4096+ks*1024):"memory");
      asm volatile("ds_read_b64_tr_b16 %0,%1 offset:%c2":"=&v"(hi[ks]):"v"(vb),"i"(d0*4096+ks*1024+512):"memory");}
    asm volatile("s_waitcnt lgkmcnt(0)":::"memory");SBAR();
    #define PK(k) (bf16x8){lo[k][0],lo[k][1],lo[k][2],lo[k][3],hi[k][0],hi[k][1],hi[k][2],hi[k][3]}
    o[d0]=__builtin_amdgcn_mfma_f32_32x32x16_bf16(pa0,PK(0),o[d0],0,0,0);
    o[d0]=__builtin_amdgcn_mfma_f32_32x32x16_bf16(pa1,PK(1),o[d0],0,0,0);
    o[d0]=__builtin_amdgcn_mfma_f32_32x32x16_bf16(pa2,PK(2),o[d0],0,0,0);
    o[d0]=__builtin_amdgcn_mfma_f32_32x32x16_bf16(pa3,PK(3),o[d0],0,0,0);
    #undef PK
  }
}
template<int THRL,int FTHR,size_t OFF_Q,size_t OFF_K,size_t OFF_V,int GSO,int AOP> __device__ __forceinline__ void attn_unit(int b,int h,int qb,const char*ws,bf16*AO,float lam,char*shm){
  const bf16*Q=(const bf16*)(ws+OFF_Q); const float*gs=(const float*)(shm+GSO);
  int tid=threadIdx.x; asm volatile("":"+v"(tid)); const int lane=tid&63,r32=lane&31,hi=lane>>5; const int wid=__builtin_amdgcn_readfirstlane(tid>>6);
  const long rowbase=(long)b*SEQ; const int q0=qb*QB;
  const unsigned lds0=(unsigned)(uintptr_t)shm;
  float*wsf=(float*)(shm+LDS_WS)+wid*64;
  bf16*stg=(bf16*)(shm+LDS_OST)+wid*4096;
  const unsigned kdst=lds0+LDS_K+wid*1024, vdst=lds0+LDS_V+wid*1024;
  const int vb0=(int)(lds0+LDS_V)+((lane>>4)&1)*32+(lane&3)*8+(4*hi+((lane&15)>>2))*64;
  const char*Kbase=shm+LDS_K;
  const lds_cptr shm3=(lds_cptr)shm; const lds_cptr kp0=shm3+LDS_K+hi*1024+r32*16; const lds_cptr vp0=shm3+LDS_V+((lane>>4)&1)*32+(lane&3)*8+(4*hi+((lane&15)>>2))*64;
  const int NT=(q0+QB)/KVBLK;
  const char*Vh=ws+OFF_V+(rowbase*DM+h*128)*2;
  const unsigned vsrc=(unsigned)(((16*(wid&3)+(lane>>2))*DM+(wid>>2)*32+(lane&3)*8)*2);
  #pragma unroll 1
  for(int mp=0;mp<2;++mp){
  const int hq=2*h+mp;
  const bf16*Qw=Q+(rowbase+q0+wid*QBLK)*DM+hq*D;
  const char*Kh=ws+OFF_K+(rowbase*DM+hq*D)*2;
  const unsigned ksrc=(unsigned)((lane*DM+wid*8)*2);
  bf16x8 kf[8];
  #define DMA_K(t,slot) glds16(Kh+(long)(t)*(KVBLK*DM*2),ksrc,(unsigned)__builtin_amdgcn_readfirstlane(kdst+(slot)))
  #define DMA_V(t,slot) do{ glds16(Vh+(long)(t)*(KVBLK*DM*2),vsrc,(unsigned)__builtin_amdgcn_readfirstlane(vdst+2*(slot))); glds16(Vh+(long)(t)*(KVBLK*DM*2)+128,vsrc,(unsigned)__builtin_amdgcn_readfirstlane(vdst+2*(slot)+8192)); }while(0)
  DMA_K(0,0);DMA_V(0,0);DMA_K(1,SLOTB);
  bf16x8 qr[4];
  #pragma unroll
  for(int d0=0;d0<4;++d0)qr[d0]=*reinterpret_cast<const bf16x8*>(&Qw[(long)r32*DM+d0*16+hi*8]);
  float mhat=0.f,l_reg=0.f;f32x16 o[4];o[0]=f32x16{};o[1]=f32x16{};o[2]=f32x16{};o[3]=f32x16{};
  #define CMASK(P0,P1,t) do{int jb_=(t)-(NT-4); if(jb_>=0)cmask(P0,P1,jb_,wid);}while(0)
  bool resc=false;
  #define RESC() do{ if(resc){ asm volatile("s_waitcnt lgkmcnt(0)":::"memory"); \
      _Pragma("unroll") for(int d_=0;d_<4;++d_) _Pragma("unroll") for(int r=0;r<16;++r)o[d_][r]*=wsf[crow(r,hi)]; } }while(0)
  f32x16 pA0,pA1,pB0,pB1;
  int sl_prev=0,sl_cur=0,sl_next=SLOTB;
  #define ROT() do{sl_prev=sl_cur;sl_cur=sl_next;sl_next=(sl_next==(NSLOT-1)*SLOTB)?0:sl_next+SLOTB;}while(0)
  DMA_K(2,2*SLOTB);
  WAIT_BAR(4);
  qkt(pA0,pA1,Kbase,qr,r32,hi);asm volatile("s_nop 15\n\ts_nop 7":"+v"(pA0),"+v"(pA1));CMASK(pA0,pA1,0);
  bool fastp;
  { const float rm=rowmax(pA0,pA1); fastp=!__any(__builtin_fabsf(rm)>(float)FTHR); mhat=fastp?0.f:rm; resc=false;
    _Pragma("unroll") for(int r=0;r<16;++r){pA0[r]=__builtin_amdgcn_exp2f(pA0[r]-mhat);pA1[r]=__builtin_amdgcn_exp2f(pA1[r]-mhat);} }
  WAIT_BAR(0);
  DMA_K(3,0);DMA_V(1,SLOTB);
  ROT();
  kload8(kf,kp0+sl_cur);
  WAIT_BAR(3);
  s16x4 vlo[8],vhi[8]; u32x4 pw0,pw1,pw2,pw3;
  #define PKW(P,B) cvtpk_s(P[B],P[B+1])
  #define PAF(k) __builtin_bit_cast(bf16x8,pw##k)
  #define VFR(i) (bf16x8){vlo[i][0],vlo[i][1],vlo[i][2],vlo[i][3],vhi[i][0],vhi[i][1],vhi[i][2],vhi[i][3]}
  #define PIN(x) asm volatile("":"+v"(x))
  #define MX3(a,b,c) __builtin_fmaxf(__builtin_fmaxf((a),(b)),(c))
  #define ZC (f32x16{})
  #define GAPA(MF,A0,A1,A2,A3,W0,W1,PW) do{ MF; sacc+=A0; sacc+=A1; sacc+=A2; sacc+=A3; PIN(sacc); W0; W1; PIN(PW); SBAR(); }while(0)
  #define EX0(v) __builtin_amdgcn_exp2f((v)-mhat)
  #define EX1(v) __builtin_amdgcn_exp2f(v)
  #define GAPB(F,MF,X,B) do{ MF; X[B]=EX##F(X[B]); X[B+1]=EX##F(X[B+1]); PIN(X); SBAR(); }while(0)
  #define VRD(i) do{ vlo[i]=vtr(vp_+(((i)>>2)*4096+((i)&3)*1024)); vhi[i]=vtr(vp_+(((i)>>2)*4096+((i)&3)*1024+512)); }while(0)
  #define VRD2(i) do{ vlo[i]=vtr(vp_+((2+((i)>>2))*4096+((i)&3)*1024)); vhi[i]=vtr(vp_+((2+((i)>>2))*4096+((i)&3)*1024+512)); SBAR(); }while(0)
  #define KRD(G,j) do{ if(G){ kload2(kf,kp0+sl_next,j); SBAR(); } }while(0)
  #define STEP(F,C0,C1,P0,P1,t,GK,GV,GL) do{ SBAR(); \
    const lds_cptr vp_=vp0+2*sl_prev; \
    VRD(0); SBAR(); float sacc=(P0[0]+P0[1]); \
    GAPA(C0=__builtin_amdgcn_mfma_f32_32x32x16_bf16(kf[0],qr[0],ZC,0,0,0), P0[2],P0[3],P0[4],P0[5],     pw0[0]=PKW(P0,0), pw0[1]=PKW(P0,2), pw0); \
    VRD(4); SBAR(); GAPA(C1=__builtin_amdgcn_mfma_f32_32x32x16_bf16(kf[1],qr[0],ZC,0,0,0), P0[6],P0[7],P0[8],P0[9],     pw0[2]=PKW(P0,4), pw0[3]=PKW(P0,6), pw0); \
    VRD(1); SBAR(); GAPA(C0=__builtin_amdgcn_mfma_f32_32x32x16_bf16(kf[2],qr[1],C0,0,0,0),   P0[10],P0[11],P0[12],P0[13], pw1[0]=PKW(P0,8), pw1[1]=PKW(P0,10), pw1); \
    VRD(5); SBAR(); GAPA(C1=__builtin_amdgcn_mfma_f32_32x32x16_bf16(kf[3],qr[1],C1,0,0,0),   P0[14],P0[15],P1[0],P1[1],   pw1[2]=PKW(P0,12),pw1[3]=PKW(P0,14), pw1); \
    VRD(2); SBAR(); GAPA(C0=__builtin_amdgcn_mfma_f32_32x32x16_bf16(kf[4],qr[2],C0,0,0,0),   P1[2],P1[3],P1[4],P1[5],     pw2[0]=PKW(P1,0), pw2[1]=PKW(P1,2), pw2); \
    VRD(6); SBAR(); GAPA(C1=__builtin_amdgcn_mfma_f32_32x32x16_bf16(kf[5],qr[2],C1,0,0,0),   P1[6],P1[7],P1[8],P1[9],     pw2[2]=PKW(P1,4), pw2[3]=PKW(P1,6), pw2); \
    VRD(3); SBAR(); GAPA(C0=__builtin_amdgcn_mfma_f32_32x32x16_bf16(kf[6],qr[3],C0,0,0,0),   P1[10],P1[11],P1[12],P1[13], pw3[0]=PKW(P1,8), pw3[1]=PKW(P1,10), pw3); \
    VRD(7); SBAR(); GAPA(C1=__builtin_amdgcn_mfma_f32_32x32x16_bf16(kf[7],qr[3],C1,0,0,0),   P1[14],P1[15],0.f,0.f,       pw3[2]=PKW(P1,12),pw3[3]=PKW(P1,14), pw3); \
    l_reg+=sacc; \
    if(GK){DMA_K((t)+3,sl_cur);} if(GV){DMA_V((t)+1,sl_next);} \
    CMASK(C0,C1,t); \
    { float a=MX3(C0[0],C0[1],C1[0]),b=MX3(C0[2],C0[3],C1[1]); a=MX3(a,C1[2],C1[3]); \
      _Pragma("unroll") for(int r=4;r<16;r+=4){a=MX3(a,C0[r],C0[r+1]);b=MX3(b,C0[r+2],C0[r+3]);a=MX3(a,C1[r],C1[r+1]);b=MX3(b,C1[r+2],C1[r+3]);} \
      float rm=__builtin_fmaxf(a,b); { auto rr=__builtin_amdgcn_permlane32_swap(__float_as_uint(rm),__float_as_uint(rm),false,false); rm=__builtin_fmaxf(__uint_as_float(rr[0]),__uint_as_float(rr[1])); } \
      rm-=mhat; resc=false; \
      if(__builtin_expect(__any(rm>(float)((F)?FTHR:THRL)),0)){ const float dl=__builtin_fmaxf(rm,0.f); mhat+=dl; \
        if(F){ fastp=false; _Pragma("unroll") for(int r=0;r<16;++r){C0[r]-=dl;C1[r]-=dl;} } \
        const float f=__builtin_amdgcn_exp2f(-dl); l_reg*=f; if(hi==0)wsf[r32]=f; resc=true; } } \
    SBAR(); \
    GAPB(F,o[0]=__builtin_amdgcn_mfma_f32_32x32x16_bf16(PAF(0),VFR(0),o[0],0,0,0), C0,0);  VRD2(0); \
    GAPB(F,o[1]=__builtin_amdgcn_mfma_f32_32x32x16_bf16(PAF(0),VFR(4),o[1],0,0,0), C0,2);  VRD2(4); \
    GAPB(F,o[0]=__builtin_amdgcn_mfma_f32_32x32x16_bf16(PAF(1),VFR(1),o[0],0,0,0), C0,4);  VRD2(1); \
    GAPB(F,o[1]=__builtin_amdgcn_mfma_f32_32x32x16_bf16(PAF(1),VFR(5),o[1],0,0,0), C0,6);  VRD2(5); \
    GAPB(F,o[0]=__builtin_amdgcn_mfma_f32_32x32x16_bf16(PAF(2),VFR(2),o[0],0,0,0), C0,8);  VRD2(2); \
    GAPB(F,o[1]=__builtin_amdgcn_mfma_f32_32x32x16_bf16(PAF(2),VFR(6),o[1],0,0,0), C0,10); VRD2(6); \
    GAPB(F,o[0]=__builtin_amdgcn_mfma_f32_32x32x16_bf16(PAF(3),VFR(3),o[0],0,0,0), C0,12); VRD2(3); \
    GAPB(F,o[1]=__builtin_amdgcn_mfma_f32_32x32x16_bf16(PAF(3),VFR(7),o[1],0,0,0), C0,14); VRD2(7); \
    KRD(GL,0); GAPB(F,o[2]=__builtin_amdgcn_mfma_f32_32x32x16_bf16(PAF(0),VFR(0),o[2],0,0,0), C1,0); \
    KRD(GL,1); GAPB(F,o[3]=__builtin_amdgcn_mfma_f32_32x32x16_bf16(PAF(0),VFR(4),o[3],0,0,0), C1,2); \
    KRD(GL,2); GAPB(F,o[2]=__builtin_amdgcn_mfma_f32_32x32x16_bf16(PAF(1),VFR(1),o[2],0,0,0), C1,4); \
    KRD(GL,3); GAPB(F,o[3]=__builtin_amdgcn_mfma_f32_32x32x16_bf16(PAF(1),VFR(5),o[3],0,0,0), C1,6); \
    GAPB(F,o[2]=__builtin_amdgcn_mfma_f32_32x32x16_bf16(PAF(2),VFR(2),o[2],0,0,0), C1,8); \
    GAPB(F,o[3]=__builtin_amdgcn_mfma_f32_32x32x16_bf16(PAF(2),VFR(6),o[3],0,0,0), C1,10); \
    GAPB(F,o[2]=__builtin_amdgcn_mfma_f32_32x32x16_bf16(PAF(3),VFR(3),o[2],0,0,0), C1,12); \
    GAPB(F,o[3]=__builtin_amdgcn_mfma_f32_32x32x16_bf16(PAF(3),VFR(7),o[3],0,0,0), C1,14); \
    }while(0)
  int t=1;
  #undef CMASK
  #define CMASK(P0,P1,t) do{}while(0)
  for(;fastp&&t+5<NT;t+=2){
    STEP(1,pB0,pB1,pA0,pA1,t,true,true,true);     WAIT_BAR(3); RESC(); ROT();
    STEP(1,pA0,pA1,pB0,pB1,t+1,true,true,true);   WAIT_BAR(3); RESC(); ROT();
  }
  for(;t+5<NT;t+=2){
    STEP(0,pB0,pB1,pA0,pA1,t,true,true,true);     WAIT_BAR(3); RESC(); ROT();
    STEP(0,pA0,pA1,pB0,pB1,t+1,true,true,true);   WAIT_BAR(3); RESC(); ROT();
  }
  #undef CMASK
  #define CMASK(P0,P1,t) do{int jb_=(t)-(NT-4); if(jb_>=0)cmask(P0,P1,jb_,wid);}while(0)
  #define ENDW(tt) do{ if((tt)+3<NT){WAIT_BAR(3);} else if((tt)+2<NT){WAIT_BAR(2);} else {WAIT_BAR(0);} }while(0)
  for(;t+1<NT;t+=2){
    STEP(0,pB0,pB1,pA0,pA1,t,(t+3<NT),(t+1<NT),(t+1<NT));       ENDW(t);   RESC(); ROT();
    STEP(0,pA0,pA1,pB0,pB1,t+1,(t+4<NT),(t+2<NT),(t+2<NT));     ENDW(t+1); RESC(); ROT();
  }
  STEP(0,pB0,pB1,pA0,pA1,NT-1,false,false,false); RESC();
  { float sacc=pB0[0]+pB0[1]; _Pragma("unroll") for(int r=2;r<16;++r)sacc+=pB0[r]; _Pragma("unroll") for(int r=0;r<16;++r)sacc+=pB1[r]; l_reg+=sacc;
    pw0=(u32x4){PKW(pB0,0),PKW(pB0,2),PKW(pB0,4),PKW(pB0,6)};pw1=(u32x4){PKW(pB0,8),PKW(pB0,10),PKW(pB0,12),PKW(pB0,14)};pw2=(u32x4){PKW(pB1,0),PKW(pB1,2),PKW(pB1,4),PKW(pB1,6)};pw3=(u32x4){PKW(pB1,8),PKW(pB1,10),PKW(pB1,12),PKW(pB1,14)};
    SBAR(); pv(o,vb0+2*sl_cur,PAF(0),PAF(1),PAF(2),PAF(3)); }
  #undef PKW
  #undef PAF
  #undef VFR
  #undef PIN
  #undef MX3
  #undef ZC
  #undef GAPA
  #undef GAPB
  #undef EX0
  #undef EX1
  #undef VRD
  #undef VRD2
  #undef KRD
  #undef STEP
  #undef ENDW
  #undef DMA_K
  #undef DMA_V
  #undef CMASK
  #undef RESC
  #undef ROT
  {auto rr=__builtin_amdgcn_permlane32_swap(__float_as_uint(l_reg),__float_as_uint(l_reg),false,false);l_reg=__uint_as_float(rr[0])+__uint_as_float(rr[1]);}
  if(hi==0)wsf[32+r32]=l_reg;asm volatile("s_waitcnt lgkmcnt(0)":::"memory");
  float rli[16];
  #pragma unroll
  for(int r=0;r<16;++r)rli[r]=__builtin_amdgcn_rcpf(wsf[32+crow(r,hi)]);
  if(mp==0){
    #pragma unroll
    for(int r=0;r<16;++r){const int orow=crow(r,hi);
      #pragma unroll
      for(int d0=0;d0<4;++d0)stg[orow*128+d0*32+r32]=__float2bfloat16(o[d0][r]*rli[r]);}
  } else {
    #pragma unroll
    for(int r=0;r<16;++r){const int orow=crow(r,hi);
      #pragma unroll
      for(int d0=0;d0<4;++d0){ const float c=__bfloat162float(stg[orow*128+d0*32+r32])-lam*(o[d0][r]*rli[r]); stg[orow*128+d0*32+r32]=__float2bfloat16(c);} }
    asm volatile("s_waitcnt lgkmcnt(0)":::"memory");
    const int row=lane>>1,hf=lane&1; float cv[64]; float ss=0.f;
    #pragma unroll
    for(int i=0;i<8;++i){ const u32x4 w=*(const u32x4*)(stg+row*128+hf*64+i*8);
      cv[8*i+0]=__uint_as_float(w.x<<16);cv[8*i+1]=__uint_as_float(w.x&0xffff0000u);cv[8*i+2]=__uint_as_float(w.y<<16);cv[8*i+3]=__uint_as_float(w.y&0xffff0000u);
      cv[8*i+4]=__uint_as_float(w.z<<16);cv[8*i+5]=__uint_as_float(w.z&0xffff0000u);cv[8*i+6]=__uint_as_float(w.w<<16);cv[8*i+7]=__uint_as_float(w.w&0xffff0000u); }
    #pragma unroll
    for(int i=0;i<64;++i)ss+=cv[i]*cv[i];
    ss+=__int_as_float(__builtin_amdgcn_ds_bpermute((lane^1)<<2,__float_as_int(ss)));
    const float rstd=1.0f/sqrtf(ss*(1.0f/128.0f)+1e-6f);
    bf16*Ow=AO+(rowbase+q0+wid*QBLK+row)*AOP+h*128+hf*64;
    #pragma unroll
    for(int i=0;i<8;++i){ const float4 g0=*(const float4*)(gs+hf*64+i*8),g1=*(const float4*)(gs+hf*64+i*8+4); u32x4 w;
      w.x=cvtpk_s(cv[8*i+0]*rstd*g0.x,cv[8*i+1]*rstd*g0.y); w.y=cvtpk_s(cv[8*i+2]*rstd*g0.z,cv[8*i+3]*rstd*g0.w);
      w.z=cvtpk_s(cv[8*i+4]*rstd*g1.x,cv[8*i+5]*rstd*g1.y); w.w=cvtpk_s(cv[8*i+6]*rstd*g1.z,cv[8*i+7]*rstd*g1.w);
      *(u32x4*)(Ow+i*8)=w; }
  }
  asm volatile("s_waitcnt lgkmcnt(0)\n\ts_barrier":::"memory");
  }
}
constexpr int ATTN_LDS_BYTES=LDS_BYTES;
#undef SBAR
#undef WAIT_BAR
}

constexpr size_t MiB = 1u << 20;
constexpr size_t WS_CTL = 0, CTL_ZERO_BYTES = 1 * MiB;
constexpr size_t WS_WIN = 2 * MiB;
constexpr size_t WS_WGLU = 13 * MiB;
constexpr size_t WS_WCAT = 14 * MiB;
constexpr size_t WS_WOUT = 17 * MiB;
constexpr size_t WS_WR = 19 * MiB;
constexpr size_t WS_BTP = 20 * MiB;
constexpr size_t WS_BTY = 28 * MiB;
constexpr size_t WS_WE1 = 48 * MiB;
constexpr size_t WS_WE2 = 80 * MiB;
constexpr size_t WS_ETAB = 96 * MiB;
constexpr size_t WS_MOD = 104 * MiB;
constexpr size_t WS_UG = 112 * MiB;
constexpr size_t WS_Q = 152 * MiB, WS_K = 216 * MiB, WS_V = 280 * MiB;
constexpr size_t WS_GATES = 344 * MiB;
constexpr size_t WS_SLOC = 472 * MiB;
constexpr size_t WS_YACT = 152 * MiB;
constexpr size_t WS_MERGED = 216 * MiB;
constexpr size_t WS_H = 344 * MiB;
constexpr size_t WS_HDN = 256 * MiB;
constexpr size_t WS_SLOTS = 112 * MiB;
constexpr size_t WS_LIST = 472 * MiB;
constexpr size_t WS_CWL = 476 * MiB;
constexpr size_t WS_END = 512 * MiB;
constexpr int CW_TMO = 0, CW_BAR = 4096, CW_CNT = 16384;

constexpr int NWAVES = 8;
constexpr int RING_OFF = 0, RING_BYTES = 147456;
constexpr int LDSCTL_OFF = RING_BYTES, MISC_OFF = LDSCTL_OFF + 320;
constexpr int GS_OFF = MISC_OFF + 2048;
constexpr int ROWTAB_OFF = LDSCTL_OFF + 4096;
constexpr int LDS_BYTES = RING_BYTES + 8192;
static_assert(attn_body::ATTN_LDS_BYTES <= RING_BYTES, "attention LDS");

#define GAS __attribute__((address_space(1)))
#define LAS __attribute__((address_space(3)))
typedef unsigned short bf16;
typedef unsigned v4u __attribute__((ext_vector_type(4)));
typedef unsigned v2u __attribute__((ext_vector_type(2)));
typedef float f32x4 __attribute__((ext_vector_type(4)));
typedef GAS unsigned gu32;
#define RLX_AGENT __ATOMIC_RELAXED, __HIP_MEMORY_SCOPE_AGENT
#define LDS_WAIT() asm volatile("s_waitcnt lgkmcnt(0)" ::: "memory")
#define VM_WAIT() asm volatile("s_waitcnt vmcnt(0)" ::: "memory")
__device__ __forceinline__ unsigned f2bf(float f) { unsigned u = __builtin_bit_cast(unsigned, f); return (u + 0x7fffu + ((u >> 16) & 1u)) >> 16; }
__device__ __forceinline__ unsigned pk2(float lo, float hi) { return f2bf(lo) | (f2bf(hi) << 16); }
__device__ __forceinline__ float bf2f(unsigned b) { return __uint_as_float(b << 16); }

#define XB_TMO      128
#define XB_XCNT(j)  (256  + 64 * (j))
#define XB_XSUB(j)  (1280 + 64 * (j))
#define XB_XGEN(j)  (2304 + 64 * (j))
#define XB_TOP      3328
#define XB_TOPGEN   3392
#define XCD_BAR_WORDS 3456
#define XB_SPIN_CAP (1u << 18)
__device__ __forceinline__ unsigned xb_ld(unsigned* p)              { return __hip_atomic_load(p, __ATOMIC_RELAXED, __HIP_MEMORY_SCOPE_AGENT); }
__device__ __forceinline__ unsigned xb_add(unsigned* p, unsigned v) { return __hip_atomic_fetch_add(p, v, __ATOMIC_RELAXED, __HIP_MEMORY_SCOPE_AGENT); }
__device__ __forceinline__ unsigned xb_xcc_id() { return (unsigned)__builtin_amdgcn_s_getreg((3 << 11) | 20) & 0xFu; }
#define XB_SPIN(cond, bar) do { unsigned _sp = 0; while (cond) { __builtin_amdgcn_s_sleep(1); \
    if ((++_sp & 255u) == 0u) { if (xb_ld(&(bar)[XB_TMO])) break; if (_sp > XB_SPIN_CAP) { atomicAdd(&(bar)[XB_TMO], 1u); break; } } } } while (0)
struct XcdBarrier { unsigned* bar; unsigned x; volatile LAS unsigned* st; };
__device__ __forceinline__ XcdBarrier xcd_barrier_post(unsigned* bar, volatile LAS unsigned* st) {
    XcdBarrier b; b.bar = bar; b.x = xb_xcc_id(); b.st = st;
    if (threadIdx.x == 0) (void)xb_add(&bar[XB_XCNT(b.x)], 1u);
    return b;
}
__device__ __forceinline__ void xcd_barrier_complete(unsigned* bar, unsigned x, unsigned& nloc, unsigned& nx) {
    const unsigned G = gridDim.x * gridDim.y * gridDim.z;
    unsigned sum, cnt, mine, sp = 0u;
    for (;;) {
        sum = 0u; cnt = 0u; mine = 0u;
#pragma unroll
        for (unsigned j = 0; j < 16; ++j) { const unsigned c = xb_ld(&bar[XB_XCNT(j)]); sum += c; cnt += (c > 0u) ? 1u : 0u; mine = (j == x) ? c : mine; }
        if (sum == G) break;
        __builtin_amdgcn_s_sleep(1);
        if ((++sp & 255u) == 0u) { if (xb_ld(&bar[XB_TMO])) break; if (sp > XB_SPIN_CAP) { atomicAdd(&bar[XB_TMO], 1u); break; } }
    }
    nloc = mine > 0u ? mine : 1u; nx = cnt > 0u ? cnt : 1u;
}
__device__ __forceinline__ void xcd_barrier(const XcdBarrier& b) {
    asm volatile("s_waitcnt vmcnt(0)" ::: "memory");
    __syncthreads();
    if (threadIdx.x == 0) {
        unsigned* bar = b.bar;
        __builtin_amdgcn_s_waitcnt(0);
        unsigned nloc = b.st[0], nx = b.st[1];
        if (nloc == 0u) { xcd_barrier_complete(bar, b.x, nloc, nx); b.st[0] = nloc; b.st[1] = nx; }
        const unsigned old = xb_add(&bar[XB_XSUB(b.x)], 1u);
        const unsigned gen = old / nloc;
        if (old + 1u == (gen + 1u) * nloc) {
            __builtin_amdgcn_fence(__ATOMIC_RELEASE, "agent");
            asm volatile("s_waitcnt vmcnt(0)" ::: "memory");
            const unsigned og = xb_add(&bar[XB_TOP], 1u);
            const unsigned tg = og / nx;
            if (og + 1u == (tg + 1u) * nx) xb_add(&bar[XB_TOPGEN], 1u);
            else XB_SPIN(xb_ld(&bar[XB_TOPGEN]) == tg, bar);
            __builtin_amdgcn_fence(__ATOMIC_ACQUIRE, "agent");
            xb_add(&bar[XB_XGEN(b.x)], 1u);
            asm volatile("s_waitcnt vmcnt(0)" ::: "memory");
        } else {
            XB_SPIN(xb_ld(&bar[XB_XGEN(b.x)]) == gen, bar);
            __builtin_amdgcn_fence(__ATOMIC_ACQUIRE, "agent");
            asm volatile("s_waitcnt vmcnt(0)" ::: "memory");
        }
    }
    __syncthreads();
}

__device__ __forceinline__ float shfl_xor_l(float v, int o, int lane) { return __int_as_float(__builtin_amdgcn_ds_bpermute((lane ^ o) << 2, __float_as_int(v))); }
__device__ __forceinline__ float wave_sum(float v, int lane) {
#pragma unroll
    for (int o = 1; o < 64; o <<= 1) v += shfl_xor_l(v, o, lane);
    return v;
}
__device__ __forceinline__ void transpose_tile(const float* W, int N, int k0, int n0, bf16* WT, int ldo, int orow0, int ocol0, LAS float* scr, int lane) {
#pragma unroll 8
    for (int i = 0; i < 32; ++i) { const int kk = 2 * i + (lane >> 5); scr[kk * 33 + (lane & 31)] = W[(size_t)(k0 + kk) * N + n0 + (lane & 31)]; }
    LDS_WAIT(); asm volatile("" ::: "memory");
    const int c = lane & 7;
#pragma unroll
    for (int j = 0; j < 4; ++j) { const int n = (lane >> 3) + 8 * j; const LAS float* s = scr + (8 * c) * 33 + n;
        v4u o; o.x = pk2(s[0 * 33], s[1 * 33]); o.y = pk2(s[2 * 33], s[3 * 33]); o.z = pk2(s[4 * 33], s[5 * 33]); o.w = pk2(s[6 * 33], s[7 * 33]);
        *(GAS v4u*)(WT + (size_t)(orow0 + n) * ldo + ocol0 + 8 * c) = o; }
    LDS_WAIT(); asm volatile("" ::: "memory");
}
__device__ __forceinline__ void abar_pow(float lr, float li, float dt, float j, float& re, float& im) {
    const float mag = expf(lr * dt * j); float s, c; sincosf(li * dt * j, &s, &c); re = mag * c; im = mag * s;
}

constexpr int ETAB_OFF = MISC_OFF + 256;
__device__ __forceinline__ void build_expert_table(LAS unsigned char* L, const int* CNT, int tid) {
    LAS int* tab = (LAS int*)(L + ETAB_OFF); LAS int* cl = tab + (XS_ROWS / 256 + 2);
    __syncthreads();
    if (tid < NEXP) cl[tid] = CNT[tid];
    __syncthreads();
    if (tid == 0) { int rt = 0;
#pragma unroll 1
        for (int e = 0; e < NEXP; ++e) { const int nt = (cl[e] + 255) >> 8;
#pragma unroll 1
            for (int q = 0; q < nt; ++q) tab[rt++] = e | (q << 8); }
        tab[XS_ROWS / 256 + 1] = rt;
#pragma unroll 1
        for (; rt <= XS_ROWS / 256; ++rt) tab[rt] = -1; }
    __syncthreads();
}
struct Args { const float* in[34]; float* out; unsigned char* ws; };
typedef __attribute__((address_space(4))) const char* kconst_ptr;
__device__ __forceinline__ void* karg(int k) { kconst_ptr kp = (kconst_ptr)__builtin_amdgcn_kernarg_segment_ptr(); asm volatile("" : "+s"(kp)); return *(void* const __attribute__((address_space(4)))*)(kp + 8 * k); }

__global__ void __launch_bounds__(NWAVES * 64, 2) fwd_kernel(Args args) {
    extern __shared__ __attribute__((aligned(16))) unsigned char lds[];
    LAS unsigned char* L = (LAS unsigned char*)lds;
    volatile LAS unsigned* MISC = (volatile LAS unsigned*)(L + MISC_OFF);
#define PHASE_IDS() \
    int tid = threadIdx.x; asm volatile("" : "+v"(tid)); \
    const int lane = tid & 63, wave = __builtin_amdgcn_readfirstlane(tid >> 6); \
    int G = gridDim.x, bx = blockIdx.x; asm volatile("" : "+s"(G), "+s"(bx)); \
    const int vcu = (G % 8 == 0) ? (bx % 8) * (G / 8) + bx / 8 : bx; \
    const int gw = vcu * NWAVES + wave, NGW = G * NWAVES; \
    const int gt = bx * (NWAVES * 64) + tid, NGT = G * NWAVES * 64; \
    (void)lane; (void)wave; (void)vcu; (void)gw; (void)NGW; (void)gt; (void)NGT;
    gu32* ctl = (gu32*)(args.ws + WS_CTL);
    for (int u = threadIdx.x; u < (LDS_BYTES - LDSCTL_OFF) / 4; u += NWAVES * 64) ((LAS unsigned*)(L + LDSCTL_OFF))[u] = 0u;
    __syncthreads();
    XcdBarrier bar = xcd_barrier_post((unsigned*)(ctl + CW_BAR), MISC + 8);
#define GRID_BAR() xcd_barrier(bar)

#define KIN(k) ((const float*)karg(k))
#define WSP(T_, off) ((T_*)(((unsigned char*)karg(35)) + (off)))
#define OUTP() ((float*)karg(34))

#if DBG_STAGE != 1
    asm volatile("; PHASE_MARK P0" ::: "memory");
    {
        PHASE_IDS();
        const float* log_dt = KIN(14); const float* a_re = KIN(7); const float* a_im = KIN(8); const float* sb_re = KIN(9); const float* sb_im = KIN(10);
        float* Ere = WSP(float, WS_ETAB); float* Eim = Ere + NG * LC * NP * 16;
        for (int idx = gt; idx < NG * LC * NP; idx += NGT) {
            const int p = idx % NP, j = (idx / NP) % LC, g = idx / (NP * LC);
            const float dt = expf(log_dt[g]), lr = a_re[g * NP + p], li = a_im[g * NP + p];
            float ar, ai; abar_pow(lr, li, dt, 1.0f, ar, ai);
            const float den = lr * lr + li * li, nr = ar - 1.0f;
            const float fre = (nr * lr + ai * li) / den, fim = (ai * lr - nr * li) / den;
            float pr, pi; abar_pow(lr, li, dt, (float)j, pr, pi);
            const float gr = pr * fre - pi * fim, gi = pr * fim + pi * fre;
            const float* br = sb_re + (size_t)(g * NP + p) * 16; const float* bi = sb_im + (size_t)(g * NP + p) * 16;
            float* er = Ere + (size_t)((g * LC + j) * NP + p) * 16; float* ei = Eim + (size_t)((g * LC + j) * NP + p) * 16;
#pragma unroll
            for (int ci = 0; ci < 16; ++ci) { er[ci] = gr * br[ci] - gi * bi[ci]; ei[ci] = gr * bi[ci] + gi * br[ci]; }
        }
        {
            const float* cvec = KIN(1); const float* w_ada = KIN(2); const float* b_ada = KIN(3); float* MOD = WSP(float, WS_MOD);
            LAS float* cs = (LAS float*)(L + RING_OFF);
            LAS float* red = (LAS float*)(L + RING_OFF + 32768);
            bool loaded = false;
            for (int it = vcu; it < 6 * D / 32; it += G) {
                if (!loaded) { __syncthreads(); for (int i = tid; i < NB * D; i += NWAVES * 64) { const float c = cvec[i]; cs[i] = c / (1.0f + expf(-c)); } __syncthreads(); loaded = true; }
                const int col = it * 32 + (lane & 31), ksub = (lane >> 5) + 2 * wave;
                float accb[NB];
#pragma unroll
                for (int b = 0; b < NB; ++b) accb[b] = 0.f;
#pragma unroll 8
                for (int i = 0; i < 64; ++i) { const int k = ksub + 16 * i; const float w = w_ada[(size_t)k * (6 * D) + col];
#pragma unroll
                    for (int b = 0; b < NB; ++b) accb[b] += cs[b * D + k] * w; }
#pragma unroll
                for (int b = 0; b < NB; ++b) red[(ksub * NB + b) * 32 + (lane & 31)] = accb[b];
                __syncthreads();
                if (tid < NB * 32) { const int b = tid >> 5, c = tid & 31; float s = 0.f;
#pragma unroll
                    for (int q = 0; q < 16; ++q) s += red[(q * NB + b) * 32 + c];
                    MOD[(size_t)b * 6 * D + it * 32 + c] = s + b_ada[it * 32 + c]; }
                __syncthreads();
            }
            __syncthreads();
        }
    }
    GRID_BAR();
#endif

#if DBG_STAGE != 1
    asm volatile("; PHASE_MARK P0b" ::: "memory");
    {
        PHASE_IDS();
        const float* x = KIN(0); const float* g_mix = KIN(4); const float* MOD = WSP(float, WS_MOD); bf16* UBUF = (bf16*)OUTP();
        const float* Ere = WSP(float, WS_ETAB); const float* Eim = Ere + NG * LC * NP * 16; bf16* BtY = WSP(bf16, WS_BTY); bf16* BtP = WSP(bf16, WS_BTP);
        const float* sc_re = KIN(11); const float* sc_im = KIN(12); const float* log_dt = KIN(14); const float* a_re = KIN(7); const float* a_im = KIN(8);
        const int gti = (wave * G + bx) * 64 + lane;
        for (int blk = gw; blk < T / 16; blk += NGW) {
            const int row0 = blk * 16, b = row0 / SEQ; const float* md = MOD + (size_t)b * 6 * D;
            f32x4 av[4], sv[4];
#pragma unroll
            for (int j = 0; j < 4; ++j) { const int c = 4 * lane + 256 * j; const f32x4 g = *(const f32x4*)(g_mix + c), sc = *(const f32x4*)(md + D + c); av[j] = g * (sc + 1.0f); sv[j] = *(const f32x4*)(md + c); }
            f32x4 nx[4];
#pragma unroll
            for (int j = 0; j < 4; ++j) nx[j] = *(const f32x4*)(x + (size_t)row0 * D + 4 * lane + 256 * j);
#pragma unroll 2
            for (int r = 0; r < 16; ++r) {
                f32x4 v[4]; float ss = 0.f;
#pragma unroll
                for (int j = 0; j < 4; ++j) v[j] = nx[j];
                const float* xn = x + (size_t)(row0 + (r < 15 ? r + 1 : r)) * D;
#pragma unroll
                for (int j = 0; j < 4; ++j) nx[j] = *(const f32x4*)(xn + 4 * lane + 256 * j);
#pragma unroll
                for (int j = 0; j < 4; ++j) ss += (v[j][0] * v[j][0] + v[j][1] * v[j][1]) + (v[j][2] * v[j][2] + v[j][3] * v[j][3]);
                const float rstd = 1.0f / sqrtf(wave_sum(ss, lane) * (1.0f / D) + EPS);
                bf16* ur = UBUF + (size_t)(row0 + r) * D;
#pragma unroll
                for (int j = 0; j < 4; ++j) { const f32x4 o = v[j] * rstd * av[j] + sv[j]; *(GAS v2u*)(ur + 4 * lane + 256 * j) = (v2u){pk2(o[0], o[1]), pk2(o[2], o[3])}; }
            }
        }
        for (int idx = gti; idx < NG * LC * 16 * 2; idx += NGT) {
            const int cih = idx & 1, co = (idx >> 1) & 15, j = (idx >> 5) % LC, g = idx / (32 * LC);
            float kv[8];
#pragma unroll
            for (int i = 0; i < 8; ++i) kv[i] = 0.f;
            const float* er = Ere + (size_t)((g * LC + j) * NP) * 16 + cih * 8; const float* ei = Eim + (size_t)((g * LC + j) * NP) * 16 + cih * 8;
            const float* cr = sc_re + (size_t)(g * 16 + co) * NP; const float* ci_ = sc_im + (size_t)(g * 16 + co) * NP;
            for (int p = 0; p < NP; ++p) { const float c_r = cr[p], c_i = ci_[p]; const f32x4 e0 = *(const f32x4*)(er + p * 16), e1 = *(const f32x4*)(er + p * 16 + 4), f0 = *(const f32x4*)(ei + p * 16), f1 = *(const f32x4*)(ei + p * 16 + 4);
#pragma unroll
                for (int i = 0; i < 4; ++i) { kv[i] += c_r * e0[i] - c_i * f0[i]; kv[4 + i] += c_r * e1[i] - c_i * f1[i]; } }
            const v4u kw = (v4u){pk2(kv[0], kv[1]), pk2(kv[2], kv[3]), pk2(kv[4], kv[5]), pk2(kv[6], kv[7])};
            bf16* base = BtY + (size_t)g * 512 * KY;
            for (int t = j; t < LC; ++t) *(GAS v4u*)(base + (size_t)(t * 16 + co) * KY + (t - j) * 16 + cih * 8) = kw;
            if (j >= 1) for (int t = 0; t + j < LC; ++t) *(GAS v4u*)(base + (size_t)(t * 16 + co) * KY + (t + j) * 16 + cih * 8) = (v4u){0u, 0u, 0u, 0u};
        }
        for (int idx = gti; idx < NG * LC * NP; idx += NGT) {
            const int p = idx % NP, t = (idx / NP) % LC, g = idx / (NP * LC);
            const float dt = expf(log_dt[g]); float ar, ai; abar_pow(a_re[g * NP + p], a_im[g * NP + p], dt, (float)(t + 1), ar, ai);
#pragma unroll
            for (int co = 0; co < 16; ++co) { const float c_r = sc_re[(size_t)(g * 16 + co) * NP + p], c_i = sc_im[(size_t)(g * 16 + co) * NP + p];
                bf16* rowp = BtY + (size_t)(g * 512 + t * 16 + co) * KY;
                rowp[512 + p] = (bf16)f2bf(c_r * ar - c_i * ai); rowp[576 + p] = (bf16)f2bf(-(c_r * ai + c_i * ar)); }
        }
        for (int idx = gti; idx < NG * 128 * LC; idx += NGT) {
            const int s = idx % LC, nn = (idx / LC) % 128, g = idx / (LC * 128); const int p = nn & 63, im = nn >> 6;
            const float* src = (im ? Eim : Ere) + (size_t)((g * LC + (LC - 1 - s)) * NP + p) * 16;
            unsigned hw[8], lw[8];
#pragma unroll
            for (int i = 0; i < 8; ++i) { const float f0 = src[2 * i], f1 = src[2 * i + 1]; const unsigned h0 = f2bf(f0), h1 = f2bf(f1); hw[i] = h0 | (h1 << 16); lw[i] = pk2(f0 - bf2f(h0), f1 - bf2f(h1)); }
            bf16* d0 = BtP + (size_t)(g * 256 + nn) * KS + s * 16; bf16* d1 = BtP + (size_t)(g * 256 + 128 + nn) * KS + s * 16;
            *(GAS v4u*)d0 = (v4u){hw[0], hw[1], hw[2], hw[3]}; *(GAS v4u*)(d0 + 8) = (v4u){hw[4], hw[5], hw[6], hw[7]};
            *(GAS v4u*)d1 = (v4u){lw[0], lw[1], lw[2], lw[3]}; *(GAS v4u*)(d1 + 8) = (v4u){lw[4], lw[5], lw[6], lw[7]};
        }
        __syncthreads();
        {
        const float* w_in = KIN(5); const float* w_glu = KIN(15); const float* w_br_ssm = KIN(22); const float* w_br_attn = KIN(23); const float* w_out = KIN(24);
        const float* w_eg = KIN(30); const float* w_eu = KIN(31); const float* w_ed = KIN(32);
        bf16* WinT = WSP(bf16, WS_WIN); bf16* WgluT = WSP(bf16, WS_WGLU); bf16* WcatT = WSP(bf16, WS_WCAT); bf16* WoutT = WSP(bf16, WS_WOUT);
        bf16* WE1 = WSP(bf16, WS_WE1); bf16* WE2 = WSP(bf16, WS_WE2);
        LAS float* scr = (LAS float*)(L + RING_OFF + wave * 16384);
        constexpr int I_IN = 16 * 176, I_GLU = 8 * 16, I_SSM = 8 * 32, I_ATT = 16 * 32, I_OUT = 16 * 32, I_EG = NEXP * 16 * 8, I_EU = I_EG, I_ED = NEXP * 4 * 32;
        constexpr int NITEMS = I_IN + I_GLU + I_SSM + I_ATT + I_OUT + I_EG + I_EU + I_ED;
        for (int it = gw; it < NITEMS; it += NGW) {
            int r = it;
            if (r < I_IN) { const int kb = r / 176, nb = r % 176; transpose_tile(w_in, INW, 64 * kb, 32 * nb, WinT, D, 32 * nb, 64 * kb, scr, lane); continue; } r -= I_IN;
            if (r < I_GLU) { const int kb = r / 16, nb = r % 16; transpose_tile(w_glu, S5W, 64 * kb, 32 * nb, WgluT, S5W, 32 * nb, 64 * kb, scr, lane); continue; } r -= I_GLU;
            if (r < I_SSM) { const int kb = r / 32, nb = r % 32; transpose_tile(w_br_ssm, D, 64 * kb, 32 * nb, WcatT, KCAT, 32 * nb, D + 64 * kb, scr, lane); continue; } r -= I_SSM;
            if (r < I_ATT) { const int kb = r / 32, nb = r % 32; transpose_tile(w_br_attn, D, 64 * kb, 32 * nb, WcatT, KCAT, 32 * nb, 64 * kb, scr, lane); continue; } r -= I_ATT;
            if (r < I_OUT) { const int kb = r / 32, nb = r % 32; transpose_tile(w_out, D, 64 * kb, 32 * nb, WoutT, D, 32 * nb, 64 * kb, scr, lane); continue; } r -= I_OUT;
            if (r < I_EG + I_EU) { const bool up = r >= I_EG; if (up) r -= I_EG; const int e = r / 128, q = r % 128, kb = q / 8, nb = q % 8;
                transpose_tile((up ? w_eu : w_eg) + (size_t)e * D * DEXP, DEXP, 64 * kb, 32 * nb, WE1 + (size_t)e * 512 * D, D, (nb >> 2) * 256 + (up ? 128 : 0) + (nb & 3) * 32, 64 * kb, scr, lane); continue; } r -= I_EG + I_EU;
            { const int e = r / 128, q = r % 128, kb = q / 32, nb = q % 32; transpose_tile(w_ed + (size_t)e * DEXP * D, D, 64 * kb, 32 * nb, WE2 + (size_t)e * D * DEXP, DEXP, 32 * nb, 64 * kb, scr, lane); }
        }
        const float* w_rg = KIN(26); const float* w_re = KIN(28); bf16* WR = WSP(bf16, WS_WR);
        for (int idx = gti; idx < 2 * 64 * 128; idx += NGT) {
            const int k0 = (idx & 127) * 8, n = (idx >> 7) & 63, part = idx >> 13;
            unsigned w[4] = {0u, 0u, 0u, 0u};
            if (n < 36) {
                float hv[8];
#pragma unroll
                for (int i = 0; i < 8; ++i) { const float f = (n < 4) ? w_rg[(size_t)(k0 + i) * 4 + n] : w_re[(size_t)(k0 + i) * NEXP + (n - 4)]; const float h = bf2f(f2bf(f)); hv[i] = part ? (f - h) : h; }
#pragma unroll
                for (int i = 0; i < 4; ++i) w[i] = pk2(hv[2 * i], hv[2 * i + 1]);
            }
            *(GAS v4u*)(WR + (size_t)(part * 64 + n) * D + k0) = (v4u){w[0], w[1], w[2], w[3]};
        }
        }
    }
    GRID_BAR();

    asm volatile("; PHASE_MARK P1" ::: "memory");
    {
        PHASE_IDS();
        pg8::StaticOrder S; S.init(OUTP(), D, WSP(bf16, WS_WIN), D, T, INW, G, bx);
        pg8::EpiProj E{KIN(6), WSP(bf16, WS_UG), WSP(bf16, WS_Q), WSP(bf16, WS_K), WSP(bf16, WS_V), WSP(bf16, WS_GATES), attn_body::C2};
        pg8::gemm_phase<pg8::EpiProj, pg8::StaticOrder, true, true>(L + RING_OFF, D, D, D, S, E);
    }
    GRID_BAR();

    asm volatile("; PHASE_MARK P2" ::: "memory");
    {
        PHASE_IDS();
        pg8::GroupOrder S; S.init(WSP(bf16, WS_UG), KY, (size_t)NRC * KY * 2, WSP(bf16, WS_BTP), KS, (size_t)256 * KS * 2, NRC, 256, NG, G, bx);
        pg8::EpiStates E{WSP(float, WS_SLOC)};
        pg8::gemm_phase<pg8::EpiStates, pg8::GroupOrder, true, true>(L + RING_OFF, KS, KY, KS, S, E);
    }
    GRID_BAR();

    asm volatile("; PHASE_MARK P3" ::: "memory");
    {
        PHASE_IDS();
        const float* log_dt = KIN(14); const float* a_re = KIN(7); const float* a_im = KIN(8); const float* SLOC = WSP(float, WS_SLOC); bf16* UG = WSP(bf16, WS_UG);
        LAS float* seg = (LAS float*)(L + RING_OFF);
        for (int bg = vcu; bg < NB * NG; bg += G) {
            const int b = bg / NG, g = bg % NG, p = lane;
            const float dt = expf(log_dt[g]), lr = a_re[g * NP + p], li = a_im[g * NP + p];
            float alr, ali; abar_pow(lr, li, dt, (float)LC, alr, ali);
            constexpr int SEGC = NCH / NWAVES;
            float locr[SEGC], loci[SEGC]; float cr = 0.f, ci = 0.f;
            const float* sp = SLOC + ((size_t)(g * NRC + b * NCH + wave * SEGC)) * 128;
#pragma unroll
            for (int k = 0; k < SEGC; ++k) { locr[k] = cr; loci[k] = ci; const float sr = sp[k * 128 + p], si = sp[k * 128 + 64 + p]; const float nr = alr * cr - ali * ci + sr, ni = alr * ci + ali * cr + si; cr = nr; ci = ni; }
            __syncthreads();
            seg[(wave * 64 + p) * 2] = cr; seg[(wave * 64 + p) * 2 + 1] = ci;
            __syncthreads();
            float a16r = alr, a16i = ali;
#pragma unroll
            for (int q = 0; q < 4; ++q) { const float nr = a16r * a16r - a16i * a16i, ni = 2.f * a16r * a16i; a16r = nr; a16i = ni; }
            float inr = 0.f, ini = 0.f;
            for (int w = 0; w < wave; ++w) { const float er = seg[(w * 64 + p) * 2], ei = seg[(w * 64 + p) * 2 + 1]; const float nr = a16r * inr - a16i * ini + er, ni = a16r * ini + a16i * inr + ei; inr = nr; ini = ni; }
            bf16* up = UG + ((size_t)(g * NRC + b * NCH + wave * SEGC)) * KY + KS;
#pragma unroll
            for (int k = 0; k < SEGC; ++k) { up[(size_t)k * KY + p] = (bf16)f2bf(inr + locr[k]); up[(size_t)k * KY + 64 + p] = (bf16)f2bf(ini + loci[k]); const float nr = alr * inr - ali * ini, ni = alr * ini + ali * inr; inr = nr; ini = ni; }
        }
        __syncthreads();
        const char* wsb = (const char*)karg(35);
        const float* lq1 = KIN(17); const float* lk1 = KIN(18); const float* lq2 = KIN(19); const float* lk2 = KIN(20); const float* g_subln = KIN(21);
        const float lam = expf(wave_sum(lq1[lane] * lk1[lane], lane)) - expf(wave_sum(lq2[lane] * lk2[lane], lane)) + LAMBDA_INIT;
        LAS float* gsl = (LAS float*)(L + GS_OFF);
        if (tid < 128) gsl[tid] = g_subln[tid] * (1.0f - LAMBDA_INIT);
        __syncthreads();
        for (int un = vcu; un < NB * 8 * 4; un += G) {
            const int s4 = un & 3, h = (un >> 2) & 7, b = un >> 5;
#pragma unroll 1
            for (int i = 0; i < 4; ++i) { const int qb = (i == 0) ? 15 - s4 : (i == 1) ? 8 + s4 : (i == 2) ? 7 - s4 : s4;
                attn_body::attn_unit<8, 40, WS_Q, WS_K, WS_V, GS_OFF - RING_OFF, KCAT>(b, h, qb, wsb, (attn_body::bf16*)OUTP(), lam, (char*)lds + RING_OFF); }
        }
    }
    GRID_BAR();

    asm volatile("; PHASE_MARK P4" ::: "memory");
    {
        PHASE_IDS();
        pg8::GroupOrder S; S.init(WSP(bf16, WS_UG), KY, (size_t)NRC * KY * 2, WSP(bf16, WS_BTY), KY, (size_t)512 * KY * 2, NRC, 512, NG, G, bx);
        pg8::EpiY E{WSP(bf16, WS_UG), KIN(13), WSP(bf16, WS_YACT)};
        pg8::gemm_phase<pg8::EpiY, pg8::GroupOrder, true, true>(L + RING_OFF, KY, KY, KY, S, E);
    }
    GRID_BAR();

    asm volatile("; PHASE_MARK P5" ::: "memory");
    {
        PHASE_IDS();
        pg8::StaticOrder S; S.init(WSP(bf16, WS_YACT), S5W, WSP(bf16, WS_WGLU), S5W, T, S5W, G, bx);
        pg8::EpiGlu E{WSP(bf16, WS_YACT), KIN(16), (bf16*)OUTP() + D, KCAT};
        pg8::gemm_phase<pg8::EpiGlu, pg8::StaticOrder, true, true>(L + RING_OFF, S5W, S5W, S5W, S, E);
    }
    GRID_BAR();

    asm volatile("; PHASE_MARK P6" ::: "memory");
    {
        PHASE_IDS();
        pg8::StaticOrder S; S.init(OUTP(), KCAT, WSP(bf16, WS_WCAT), KCAT, T, D, G, bx);
        pg8::EpiMerge E{WSP(bf16, WS_GATES), WSP(bf16, WS_MERGED)};
        pg8::HookGate HK{WSP(bf16, WS_GATES)};
        pg8::gemm_phase<pg8::EpiMerge, pg8::StaticOrder, true, true, false, pg8::HookGate>(L + RING_OFF, KCAT, KCAT, KCAT, S, E, nullptr, HK);
    }
    GRID_BAR();

    asm volatile("; PHASE_MARK P8" ::: "memory");
    {
        PHASE_IDS();
        pg8::StaticOrder S; S.init(WSP(bf16, WS_MERGED), D, WSP(bf16, WS_WOUT), D, T, D, G, bx);
        pg8::EpiOut E{KIN(0), WSP(float, WS_MOD), WSP(bf16, WS_H)};
        pg8::gemm_phase<pg8::EpiOut, pg8::StaticOrder, true, true>(L + RING_OFF, D, D, D, S, E);
    }
    GRID_BAR();
#endif

#if DBG_STAGE == 0
    asm volatile("; PHASE_MARK P9" ::: "memory");
    {
        PHASE_IDS();
        const float* g_ffn = KIN(25); const float* MOD = WSP(float, WS_MOD); const bf16* Hbuf = WSP(bf16, WS_H); bf16* U2 = (bf16*)OUTP();
        const bf16* WRh = WSP(bf16, WS_WR); const bf16* WRl = WRh + 64 * D;
        const float* b_rg = KIN(27); const float* b_re = KIN(29); int* CNT = WSP(int, WS_CTL) + CW_CNT; int* LIST = WSP(int, WS_LIST); float* CWL = WSP(float, WS_CWL);
        constexpr int APITCH = 1032;
        LAS bf16* AH = (LAS bf16*)(L + RING_OFF); LAS bf16* AL = AH + 16 * APITCH;
        LAS float* PART = (LAS float*)(L + RING_OFF + 2 * 16 * APITCH * 2);
        LAS float* LG = PART + 8 * 256;
        LAS int* lcnt = (LAS int*)(LG + 16 * 64); LAS int* lbase = lcnt + NEXP; LAS int* TOK = lbase + NEXP;
        const int per = T / G, t0 = bx * per, b = t0 / SEQ;
        const float* md = MOD + (size_t)b * 6 * D;
        f32x4 av[4], sv[4];
#pragma unroll
        for (int j = 0; j < 4; ++j) { const int c = 4 * lane + 256 * j; const f32x4 g = *(const f32x4*)(g_ffn + c), sc = *(const f32x4*)(md + 4 * D + c); av[j] = g * (sc + 1.0f); sv[j] = *(const f32x4*)(md + 3 * D + c); }
        const int cb = wave & 3, kh = wave >> 2, fr = lane & 15, fq = lane >> 4;
        pg8::bf16x8 bh[16], bl[16];
#pragma unroll
        for (int ks = 0; ks < 16; ++ks) { const size_t o = (size_t)(cb * 16 + fr) * D + kh * 512 + ks * 32 + fq * 8; bh[ks] = *(const pg8::bf16x8*)(WRh + o); bl[ks] = *(const pg8::bf16x8*)(WRl + o); }
        if (tid < NEXP) lcnt[tid] = 0;
        for (int c = 0; c < per / 16; ++c) {
#pragma unroll
            for (int rr = 0; rr < 2; ++rr) {
                const int r = 2 * wave + rr, tok = t0 + c * 16 + r;
                const bf16* hr = Hbuf + (size_t)tok * D; f32x4 v[4]; float ss = 0.f;
#pragma unroll
                for (int j = 0; j < 4; ++j) { const v2u hw = *(const GAS v2u*)(hr + 4 * lane + 256 * j); v[j] = (f32x4){pg8::bf_lo(hw.x), pg8::bf_hi(hw.x), pg8::bf_lo(hw.y), pg8::bf_hi(hw.y)}; ss += (v[j][0] * v[j][0] + v[j][1] * v[j][1]) + (v[j][2] * v[j][2] + v[j][3] * v[j][3]); }
                const float rstd = 1.0f / sqrtf(wave_sum(ss, lane) * (1.0f / D) + EPS);
                bf16* ur = U2 + (size_t)tok * D;
#pragma unroll
                for (int j = 0; j < 4; ++j) { const f32x4 o = v[j] * rstd * av[j] + sv[j];
                    const unsigned h0 = f2bf(o[0]), h1 = f2bf(o[1]), h2 = f2bf(o[2]), h3 = f2bf(o[3]);
                    const v2u hv = (v2u){h0 | (h1 << 16), h2 | (h3 << 16)}, lv = (v2u){pk2(o[0] - bf2f(h0), o[1] - bf2f(h1)), pk2(o[2] - bf2f(h2), o[3] - bf2f(h3))};
                    *(GAS v2u*)(ur + 4 * lane + 256 * j) = hv;
                    *(LAS v2u*)(AH + r * APITCH + 4 * lane + 256 * j) = hv; *(LAS v2u*)(AL + r * APITCH + 4 * lane + 256 * j) = lv; }
            }
            __syncthreads();
            { pg8::f32x4 acc = (pg8::f32x4){0.f, 0.f, 0.f, 0.f};
#pragma unroll
              for (int ks = 0; ks < 16; ++ks) { const int ko = fr * APITCH + kh * 512 + ks * 32 + fq * 8;
                  const pg8::bf16x8 ah = *(const LAS pg8::bf16x8*)(AH + ko), al = *(const LAS pg8::bf16x8*)(AL + ko);
                  acc = __builtin_amdgcn_mfma_f32_16x16x32_bf16(ah, bh[ks], acc, 0, 0, 0);
                  acc = __builtin_amdgcn_mfma_f32_16x16x32_bf16(al, bh[ks], acc, 0, 0, 0);
                  acc = __builtin_amdgcn_mfma_f32_16x16x32_bf16(ah, bl[ks], acc, 0, 0, 0); }
#pragma unroll
              for (int i = 0; i < 4; ++i) PART[wave * 256 + (fq * 4 + i) * 16 + fr] = acc[i]; }
            __syncthreads();
#pragma unroll
            for (int i = 0; i < 2; ++i) { const int o = tid * 2 + i, row = o >> 6, col = o & 63, cbb = col >> 4; LG[o] = PART[cbb * 256 + row * 16 + (col & 15)] + PART[(4 + cbb) * 256 + row * 16 + (col & 15)]; }
            __syncthreads();
            if (tid < 16) {
                const LAS float* lg = LG + tid * 64;
                float gl[4]; int gi = 0;
#pragma unroll
                for (int i = 0; i < 4; ++i) gl[i] = lg[i] + b_rg[i];
#pragma unroll
                for (int i = 1; i < 4; ++i) if (gl[i] > gl[gi]) gi = i;
                float gsum = 0.f;
#pragma unroll
                for (int i = 0; i < 4; ++i) gsum += expf(gl[i] - gl[gi]);
                const float gp = 1.0f / gsum;
                float el[8];
#pragma unroll
                for (int i = 0; i < 8; ++i) el[i] = lg[4 + gi * 8 + i] + b_re[gi * 8 + i];
                int i0 = 0;
#pragma unroll
                for (int i = 1; i < 8; ++i) if (el[i] > el[i0]) i0 = i;
                int i1 = (i0 == 0) ? 1 : 0;
#pragma unroll
                for (int i = 0; i < 8; ++i) if (i != i0 && el[i] > el[i1]) i1 = i;
                const float ex = expf(el[i1] - el[i0]);
                const float w0 = gp / (1.0f + ex), w1 = gp * ex / (1.0f + ex);
                const int e0 = gi * 8 + i0, e1 = gi * 8 + i1;
                const int p0 = atomicAdd((int*)(lds + ((char*)&lcnt[e0] - (char*)L)), 1), p1 = atomicAdd((int*)(lds + ((char*)&lcnt[e1] - (char*)L)), 1);
                LAS int* tk = TOK + (c * 16 + tid) * 6; tk[0] = e0; tk[1] = p0; tk[2] = __float_as_int(w0); tk[3] = e1; tk[4] = p1; tk[5] = __float_as_int(w1);
            }
        }
        __syncthreads();
        if (tid < NEXP) lbase[tid] = atomicAdd(&CNT[tid], lcnt[tid]);
        __syncthreads();
        if (tid < per) { const LAS int* tk = TOK + tid * 6; const int tok = t0 + tid;
            const size_t i0 = (size_t)tk[0] * T + lbase[tk[0]] + tk[1], i1 = (size_t)tk[3] * T + lbase[tk[3]] + tk[4];
            LIST[i0] = tok * 2; CWL[i0] = __int_as_float(tk[2]); LIST[i1] = tok * 2 + 1; CWL[i1] = __int_as_float(tk[5]); }
        __syncthreads();
    }
    GRID_BAR();

    asm volatile("; PHASE_MARK P13" ::: "memory");
    {
        PHASE_IDS();
        const int* CNT = WSP(int, WS_CTL) + CW_CNT; const int* LIST = WSP(int, WS_LIST);
        build_expert_table(L, CNT, tid);
        pg8::ExpertOrder S; S.init((const LAS int*)(L + ETAB_OFF), OUTP(), 0, WSP(bf16, WS_WE1), D, (size_t)512 * D * 2, 512, G, bx);
        LAS int* rowtab = (LAS int*)(L + ROWTAB_OFF);
        { pg8::Unit u;
#pragma unroll 1
          for (int i = 0; i < 4 && S.next(i, u); ++i) { const int n = CNT[u.g];
              for (int r = tid; r < 256; r += NWAVES * 64) { const int pos = u.lt * 256 + r; rowtab[i * 256 + r] = (pos < n) ? (LIST[(size_t)u.g * T + pos] >> 1) : 0; } }
          __syncthreads(); }
        pg8::EpiExp1 E{WSP(bf16, WS_HDN)};
        pg8::gemm_phase<pg8::EpiExp1, pg8::ExpertOrder, true, true, true>(L + RING_OFF, D, D, D, S, E, (const LAS int*)rowtab);
    }
    GRID_BAR();

    asm volatile("; PHASE_MARK P14" ::: "memory");
    {
        PHASE_IDS();
        build_expert_table(L, WSP(int, WS_CTL) + CW_CNT, tid);
        pg8::ExpertOrder S; S.init((const LAS int*)(L + ETAB_OFF), WSP(bf16, WS_HDN), (size_t)256 * DEXP * 2, WSP(bf16, WS_WE2), DEXP, (size_t)D * DEXP * 2, D, G, bx);
        pg8::EpiExp2 E{WSP(int, WS_LIST), WSP(float, WS_CWL), WSP(int, WS_CTL) + CW_CNT, WSP(bf16, WS_SLOTS)};
        pg8::gemm_phase<pg8::EpiExp2, pg8::ExpertOrder, true, true>(L + RING_OFF, DEXP, DEXP, DEXP, S, E);
    }
    GRID_BAR();
#endif

    asm volatile("; PHASE_MARK P15" ::: "memory");
    {
        PHASE_IDS();
        const float* x = KIN(0); const float* g_final = KIN(33); const bf16* Hbuf = WSP(bf16, WS_H); const float* MOD = WSP(float, WS_MOD); const bf16* SLOTS = WSP(bf16, WS_SLOTS); float* out = OUTP();
        (void)x; (void)Hbuf; (void)MOD; (void)SLOTS;
#if DBG_STAGE == 0
        v2u nh[4], n0[4], n1[4];
#pragma unroll
        for (int j = 0; j < 4; ++j) { const int c = 4 * lane + 256 * j; nh[j] = *(const GAS v2u*)(Hbuf + (size_t)gw * D + c); n0[j] = *(const GAS v2u*)(SLOTS + (size_t)(2 * gw) * D + c); n1[j] = *(const GAS v2u*)(SLOTS + (size_t)(2 * gw + 1) * D + c); }
#pragma unroll 2
        for (int row = gw; row < T; row += NGW) {
            const int b = row / SEQ; f32x4 v[4]; float ss = 0.f; v2u ch[4], c0[4], c1[4];
#pragma unroll
            for (int j = 0; j < 4; ++j) { ch[j] = nh[j]; c0[j] = n0[j]; c1[j] = n1[j]; }
            const int rn = (row + NGW < T) ? row + NGW : row;
#pragma unroll
            for (int j = 0; j < 4; ++j) { const int c = 4 * lane + 256 * j; nh[j] = *(const GAS v2u*)(Hbuf + (size_t)rn * D + c); n0[j] = *(const GAS v2u*)(SLOTS + (size_t)(2 * rn) * D + c); n1[j] = *(const GAS v2u*)(SLOTS + (size_t)(2 * rn + 1) * D + c); }
#pragma unroll
            for (int j = 0; j < 4; ++j) { const int c = 4 * lane + 256 * j;
                v[j] = (f32x4){pg8::bf_lo(ch[j].x), pg8::bf_hi(ch[j].x), pg8::bf_lo(ch[j].y), pg8::bf_hi(ch[j].y)};
                const f32x4 gt = *(const f32x4*)(MOD + (size_t)b * 6 * D + 5 * D + c);
                const f32x4 f = (f32x4){pg8::bf_lo(c0[j].x) + pg8::bf_lo(c1[j].x), pg8::bf_hi(c0[j].x) + pg8::bf_hi(c1[j].x), pg8::bf_lo(c0[j].y) + pg8::bf_lo(c1[j].y), pg8::bf_hi(c0[j].y) + pg8::bf_hi(c1[j].y)};
                v[j] = v[j] + gt * f;
                ss += (v[j][0] * v[j][0] + v[j][1] * v[j][1]) + (v[j][2] * v[j][2] + v[j][3] * v[j][3]); }
            const float rstd = 1.0f / sqrtf(wave_sum(ss, lane) * (1.0f / D) + EPS);
#pragma unroll
            for (int j = 0; j < 4; ++j) { const int c = 4 * lane + 256 * j; const f32x4 g = *(const f32x4*)(g_final + c); *(f32x4*)(out + (size_t)row * D + c) = v[j] * rstd * g; }
        }
#else
        for (int row = gw; row < T; row += NGW) {
            f32x4 v[4]; float ss = 0.f;
#pragma unroll
            for (int j = 0; j < 4; ++j) { const int c = 4 * lane + 256 * j;
#if DBG_STAGE == 1
                v[j] = *(const f32x4*)(x + (size_t)row * D + c);
#else
                { const v2u hw = *(const GAS v2u*)(Hbuf + (size_t)row * D + c); v[j] = (f32x4){pg8::bf_lo(hw.x), pg8::bf_hi(hw.x), pg8::bf_lo(hw.y), pg8::bf_hi(hw.y)}; }
#endif
                ss += (v[j][0] * v[j][0] + v[j][1] * v[j][1]) + (v[j][2] * v[j][2] + v[j][3] * v[j][3]); }
            const float rstd = 1.0f / sqrtf(wave_sum(ss, lane) * (1.0f / D) + EPS);
#pragma unroll
            for (int j = 0; j < 4; ++j) { const int c = 4 * lane + 256 * j; const f32x4 g = *(const f32x4*)(g_final + c); *(f32x4*)(out + (size_t)row * D + c) = v[j] * rstd * g; }
        }
#endif
    }
}

extern "C" void kernel_launch(void* const* d_in, const int* in_sizes, int n_in, void* d_out, int out_size, void* d_ws, size_t ws_size, hipStream_t stream) {
    static int grid = 0;
    if (grid == 0) {
        if (n_in != 34 || out_size != T * D || ws_size < WS_END) { fprintf(stderr, "kernel_launch: unexpected shapes (n_in %d, out %d, ws %zu)\n", n_in, out_size, ws_size); grid = -1; return; }
        int dev = 0, cus = 0, per_cu = 0;
        if (hipGetDevice(&dev) != hipSuccess || hipDeviceGetAttribute(&cus, hipDeviceAttributeMultiprocessorCount, dev) != hipSuccess) { grid = -1; return; }
        if (hipFuncSetAttribute((const void*)fwd_kernel, hipFuncAttributeMaxDynamicSharedMemorySize, LDS_BYTES) != hipSuccess) { fprintf(stderr, "kernel_launch: hipFuncSetAttribute failed\n"); grid = -1; return; }
        if (hipOccupancyMaxActiveBlocksPerMultiprocessor(&per_cu, (const void*)fwd_kernel, NWAVES * 64, LDS_BYTES) != hipSuccess || per_cu < 1)
            fprintf(stderr, "kernel_launch: note: occupancy query reports %d workgroups per CU\n", per_cu);
        (void)hipGetLastError();
        grid = cus;
    }
    if (grid < 0) return;
    if (hipMemsetAsync((char*)d_ws + WS_CTL, 0, CTL_ZERO_BYTES, stream) != hipSuccess) { fprintf(stderr, "kernel_launch: memset failed\n"); return; }
    Args a{};
    for (int i = 0; i < 34; ++i) a.in[i] = (const float*)d_in[i];
    a.out = (float*)d_out; a.ws = (unsigned char*)d_ws;
    hipLaunchKernelGGL(fwd_kernel, dim3(grid), dim3(NWAVES * 64), LDS_BYTES, stream, a);
    const hipError_t le = hipPeekAtLastError();
    if (le != hipSuccess) fprintf(stderr, "kernel_launch: launch failed: %s\n", hipGetErrorName(le));
}
```
